# Optimizing an MI355X kernel written in HIP

```python
import jax
import jax.numpy as jnp
from jax import lax
import numpy as np


D_MODEL = 1024
BATCH = 8
SEQ = 4096
DEPTH = 2

CHUNK = 64
Q_BLOCK = 128
N_MEM = 256
MEM_HEADS = 4
MEM_W = D_MODEL // 4
MEM_HD = MEM_W // MEM_HEADS
SELF_W = D_MODEL - MEM_W
GLA_HEADS = 4
GLA_KDIM = SELF_W // 2
GLA_DK = GLA_KDIM // GLA_HEADS
GLA_DV = SELF_W // GLA_HEADS
GLA_GATE_RANK = 16
GLA_TAU = 16.0
FOX_HD = 64
FOX_HEADS = SELF_W // FOX_HD
N_EXPERTS = 16
N_GROUPS = 4
EXPERTS_PER_GROUP = N_EXPERTS // N_GROUPS
TOP_K = 2
D_EXPERT = D_MODEL // 2
N_A_LAYERS = DEPTH // 2
N_B_LAYERS = DEPTH - N_A_LAYERS
DN_ALPHA = (2.0 * DEPTH) ** 0.25
DN_BETA = (8.0 * DEPTH) ** -0.25
LN_EPS = 1e-5
RMS_EPS = 1e-6
A_IN = 2 * GLA_KDIM + 2 * SELF_W + GLA_GATE_RANK + MEM_W
A_SPLITS = (GLA_KDIM, 2 * GLA_KDIM, 2 * GLA_KDIM + SELF_W, 2 * GLA_KDIM + SELF_W + GLA_GATE_RANK, 2 * GLA_KDIM + 2 * SELF_W + GLA_GATE_RANK)
B_IN = 2 * SELF_W + MEM_W
B_SPLITS = (SELF_W, 2 * SELF_W)
KV_SHARED = 2 * SELF_W + FOX_HEADS
KV_SPLITS = (SELF_W, 2 * SELF_W)

kernel_name = 'yoco_gla_fox_grouped_moe_block'


def layer_norm(x, g, b):
    xf = x.astype(jnp.float32)
    mu = jnp.mean(xf, axis=-1, keepdims=True)
    var = jnp.mean(jnp.square(xf - mu), axis=-1, keepdims=True)
    return ((xf - mu) * lax.rsqrt(var + LN_EPS) * g + b).astype(x.dtype)


def rms_norm(x, g):
    xf = x.astype(jnp.float32)
    return xf * lax.rsqrt(jnp.mean(xf * xf, axis=-1, keepdims=True) + RMS_EPS) * g


def split_heads(t, n):
    return t.reshape(t.shape[:-1] + (n, t.shape[-1] // n))


def gla_chunked(q, k, v, log_a):
    B, S, H, dk = q.shape
    dv = v.shape[-1]
    nc = S // CHUNK
    qc = q.reshape(B, nc, CHUNK, H, dk)
    kc = k.reshape(B, nc, CHUNK, H, dk)
    vc = v.reshape(B, nc, CHUNK, H, dv)
    b = jnp.cumsum(log_a.reshape(B, nc, CHUNK, H, dk), axis=2)
    b_last = b[:, :, -1]
    q_dec = qc * jnp.exp(b)
    k_inv = kc * jnp.exp(-b)
    k_end = kc * jnp.exp(b_last[:, :, None] - b)
    causal = jnp.tril(jnp.ones((CHUNK, CHUNK), dtype=bool))
    att = jnp.einsum('bnthk,bnshk->bnhts', q_dec, k_inv)
    att = jnp.where(causal, att, 0.0)
    o_intra = jnp.einsum('bnhts,bnshv->bnthv', att, vc)
    chunk_kv = jnp.einsum('bnshk,bnshv->bnhkv', k_end, vc)

    def step(state, inp):
        decay, kv = inp
        return decay[..., None] * state + kv, state

    state0 = jnp.zeros((B, H, dk, dv), dtype=chunk_kv.dtype)
    _, states = lax.scan(step, state0, (jnp.moveaxis(jnp.exp(b_last), 1, 0), jnp.moveaxis(chunk_kv, 1, 0)))
    states = jnp.moveaxis(states, 0, 1)
    o_inter = jnp.einsum('bnthk,bnhkv->bnthv', q_dec, states)
    return (o_intra + o_inter).reshape(B, S, H, dv)


def fox_attention(q, k, v, cum_logf):
    S = q.shape[2]
    scale = FOX_HD ** -0.5
    outs = []
    for blk in range(S // Q_BLOCK):
        lo = blk * Q_BLOCK
        hi = lo + Q_BLOCK
        logits = jnp.einsum('bhqd,bhkd->bhqk', q[:, :, lo:hi], k[:, :, :hi]).astype(jnp.float32) * scale
        logits = logits + cum_logf[:, :, lo:hi, None] - cum_logf[:, :, None, :hi]
        mask = (lo + jnp.arange(Q_BLOCK))[:, None] >= jnp.arange(hi)[None, :]
        p = jax.nn.softmax(jnp.where(mask, logits, -jnp.inf), axis=-1)
        outs.append(jnp.einsum('bhqk,bhkd->bhqd', p.astype(v.dtype), v[:, :, :hi]))
    return jnp.concatenate(outs, axis=2)


def mem_attention(q, mk, mv):
    logits = jnp.einsum('bshd,bmhd->bhsm', q, mk).astype(jnp.float32) * (MEM_HD ** -0.5)
    p = jax.nn.softmax(logits, axis=-1)
    return jnp.einsum('bhsm,bmhd->bshd', p.astype(mv.dtype), mv)


def grouped_moe(x, w_router, b_router, w_gate, w_up, w_down):
    B, S, D = x.shape
    xt = x.reshape(B * S, D)
    n = xt.shape[0]
    affinity = jax.nn.sigmoid((xt @ w_router).astype(jnp.float32))
    sel = (affinity + b_router.astype(jnp.float32)).reshape(n, N_GROUPS, EXPERTS_PER_GROUP)
    group_score = jnp.sum(lax.top_k(sel, TOP_K)[0], axis=-1)
    g_idx = jnp.argmax(group_score, axis=-1)
    in_group = jnp.take_along_axis(sel, jnp.broadcast_to(g_idx[:, None, None], (n, 1, EXPERTS_PER_GROUP)), axis=1)[:, 0]
    _, local = lax.top_k(in_group, TOP_K)
    e_idx = g_idx[:, None] * EXPERTS_PER_GROUP + local
    w = jnp.take_along_axis(affinity, e_idx, axis=-1)
    w = w / jnp.sum(w, axis=-1, keepdims=True)
    gates = jnp.sum(jax.nn.one_hot(e_idx, N_EXPERTS, dtype=jnp.float32) * w[..., None], axis=1).astype(x.dtype)
    out = jnp.zeros_like(xt)
    for e in range(N_EXPERTS):
        h = jax.nn.silu(xt @ w_gate[e]) * (xt @ w_up[e])
        out = out + gates[:, e:e + 1] * (h @ w_down[e])
    return out.reshape(B, S, D)


def setup_inputs(seed: int = 0) -> dict:
    key = jax.random.key(seed)
    ks = iter(jax.random.split(key, 32))

    def nrm(shape, scale):
        return jax.random.normal(next(ks), shape, jnp.float32) * scale

    d = D_MODEL
    x = nrm((BATCH, SEQ, d), 1.0)
    mem = nrm((BATCH, N_MEM, d), 1.0)
    col_a = jnp.concatenate([jnp.ones((2 * GLA_KDIM,)), jnp.full((SELF_W,), DN_BETA), jnp.ones((GLA_GATE_RANK + SELF_W + MEM_W,))])
    w_in_a = nrm((N_A_LAYERS, d, A_IN), d ** -0.5) * col_a
    w_gate_up_a = nrm((N_A_LAYERS, GLA_GATE_RANK, GLA_KDIM), GLA_GATE_RANK ** -0.5)
    b_gate_a = nrm((N_A_LAYERS, GLA_KDIM), 0.1)
    gla_norm_g = 1.0 + nrm((N_A_LAYERS, GLA_DV), 0.02)
    w_in_b = nrm((N_B_LAYERS, d, B_IN), d ** -0.5)
    q_norm_g = 1.0 + nrm((N_B_LAYERS, FOX_HD), 0.02)
    col_kv = jnp.concatenate([jnp.ones((SELF_W,)), jnp.full((SELF_W,), DN_BETA), jnp.ones((FOX_HEADS,))])
    w_kv_shared = nrm((d, KV_SHARED), d ** -0.5) * col_kv
    b_forget = 3.0 + nrm((FOX_HEADS,), 0.5)
    k_norm_g = 1.0 + nrm((FOX_HD,), 0.02)
    col_m = jnp.concatenate([jnp.ones((MEM_W,)), jnp.full((MEM_W,), DN_BETA)])
    w_mem_kv = nrm((DEPTH, d, 2 * MEM_W), d ** -0.5) * col_m
    w_out = nrm((DEPTH, d, d), d ** -0.5 * DN_BETA)
    ln_mix_g = 1.0 + nrm((DEPTH, d), 0.02)
    ln_mix_b = nrm((DEPTH, d), 0.02)
    ln_ffn_g = 1.0 + nrm((DEPTH, d), 0.02)
    ln_ffn_b = nrm((DEPTH, d), 0.02)
    w_router = nrm((d, N_EXPERTS), d ** -0.5)
    b_router = nrm((N_EXPERTS,), 0.01)
    w_exp_gate = nrm((DEPTH, N_EXPERTS, d, D_EXPERT), d ** -0.5)
    w_exp_up = nrm((DEPTH, N_EXPERTS, d, D_EXPERT), d ** -0.5 * DN_BETA)
    w_exp_down = nrm((DEPTH, N_EXPERTS, D_EXPERT, d), D_EXPERT ** -0.5 * DN_BETA)
    return {'x': x, 'mem': mem, 'w_in_a': w_in_a, 'w_gate_up_a': w_gate_up_a, 'b_gate_a': b_gate_a,
            'gla_norm_g': gla_norm_g, 'w_in_b': w_in_b, 'q_norm_g': q_norm_g, 'w_kv_shared': w_kv_shared,
            'b_forget': b_forget, 'k_norm_g': k_norm_g, 'w_mem_kv': w_mem_kv, 'w_out': w_out,
            'ln_mix_g': ln_mix_g, 'ln_mix_b': ln_mix_b, 'ln_ffn_g': ln_ffn_g, 'ln_ffn_b': ln_ffn_b,
            'w_router': w_router, 'b_router': b_router, 'w_exp_gate': w_exp_gate, 'w_exp_up': w_exp_up,
            'w_exp_down': w_exp_down}


def reference(x, mem, w_in_a, w_gate_up_a, b_gate_a, gla_norm_g, w_in_b, q_norm_g, w_kv_shared,
              b_forget, k_norm_g, w_mem_kv, w_out, ln_mix_g, ln_mix_b, ln_ffn_g, ln_ffn_b,
              w_router, b_router, w_exp_gate, w_exp_up, w_exp_down):
    B, S, D = x.shape
    shared_k = shared_v = shared_cum = None
    for layer in range(DEPTH):
        if layer < N_A_LAYERS:
            i = layer
            h = x @ w_in_a[i]
            q, k, v, g_lr, r, mq = jnp.split(h, A_SPLITS, axis=-1)
            log_a = jax.nn.log_sigmoid((g_lr @ w_gate_up_a[i] + b_gate_a[i]).astype(jnp.float32)) / GLA_TAU
            o = gla_chunked(split_heads(q, GLA_HEADS) * (GLA_DK ** -0.5), split_heads(k, GLA_HEADS),
                            split_heads(v, GLA_HEADS), split_heads(log_a, GLA_HEADS))
            o = rms_norm(o, gla_norm_g[i]).astype(x.dtype).reshape(B, S, SELF_W) * jax.nn.silu(r)
        else:
            if shared_k is None:
                kvf = x @ w_kv_shared
                ks_, vs_, f_logit = jnp.split(kvf, KV_SPLITS, axis=-1)
                shared_k = jnp.transpose(rms_norm(split_heads(ks_, FOX_HEADS), k_norm_g).astype(x.dtype), (0, 2, 1, 3))
                shared_v = jnp.transpose(split_heads(vs_, FOX_HEADS), (0, 2, 1, 3))
                log_f = jax.nn.log_sigmoid(f_logit.astype(jnp.float32) + b_forget)
                shared_cum = jnp.transpose(jnp.cumsum(log_f, axis=1), (0, 2, 1))
            j = layer - N_A_LAYERS
            h = x @ w_in_b[j]
            q, og, mq = jnp.split(h, B_SPLITS, axis=-1)
            q = jnp.transpose(rms_norm(split_heads(q, FOX_HEADS), q_norm_g[j]).astype(x.dtype), (0, 2, 1, 3))
            o = fox_attention(q, shared_k, shared_v, shared_cum)
            o = jnp.transpose(o, (0, 2, 1, 3)).reshape(B, S, SELF_W) * jax.nn.sigmoid(og)
        mkv = mem @ w_mem_kv[layer]
        mk, mv = jnp.split(mkv, 2, axis=-1)
        m_out = mem_attention(split_heads(mq, MEM_HEADS), split_heads(mk, MEM_HEADS), split_heads(mv, MEM_HEADS))
        y = jnp.concatenate([o, m_out.reshape(B, S, MEM_W)], axis=-1) @ w_out[layer]
        x = layer_norm(DN_ALPHA * x + y, ln_mix_g[layer], ln_mix_b[layer])
        f = grouped_moe(x, w_router, b_router, w_exp_gate[layer], w_exp_up[layer], w_exp_down[layer])
        x = layer_norm(DN_ALPHA * x + f, ln_ffn_g[layer], ln_ffn_b[layer])
    return x
```

```cpp
#include <hip/hip_runtime.h>
#include <cstdio>
#include <cstdint>

typedef unsigned short bf16;
constexpr int NB = 8, SEQ = 4096, D = 1024, NTOK = NB * SEQ;
constexpr int NMEM = 256, A_IN = 2576, B_IN = 1792, KV_IN = 1548;
constexpr int GLA_H = 4, GLA_DK = 96, GLA_DV = 192, FOX_H = 12;
constexpr int NEXP = 16, DEXP = 512;
constexpr float DN_ALPHA = 1.41421356237309515f;
constexpr float LN_EPS = 1e-5f, RMS_EPS = 1e-6f;
constexpr float LOG2E = 1.4426950408889634f;
constexpr float QC2 = 0.125f * LOG2E;
constexpr size_t MiB = 1u << 20;
constexpr size_t WS_CTL = 0, CTL_ZERO_BYTES = 1 * MiB;
constexpr size_t WS_GLR = 1 * MiB, WS_LOGF = 3 * MiB, WS_CUM = 5 * MiB, WS_DEC = 7 * MiB, WS_MEMB = 8 * MiB, WS_MKV = 12 * MiB;
constexpr size_t WS_TOKE = 16 * MiB, WS_TOKW = WS_TOKE + 256 * 1024, WS_TOKS = WS_TOKW + 256 * 1024, WS_CNT = WS_TOKS + 256 * 1024, WS_SLOTTOK = 17 * MiB;
constexpr size_t WS_WA = 20 * MiB, WS_WB = 25 * MiB, WS_WMKV = 32 * MiB, WS_WO = 34 * MiB, WS_WGU = 38 * MiB, WS_WD = 102 * MiB;
constexpr size_t WS_XB = 134 * MiB, WS_GREG = 198 * MiB, WS_HREG = 270 * MiB, WS_END = 478 * MiB;
constexpr size_t HR_48 = 48 * MiB;

__device__ __forceinline__ float bf2f(bf16 v) { return __uint_as_float(((unsigned)v) << 16); }
__device__ __forceinline__ bf16 f2bf(float f) { unsigned u = __float_as_uint(f); return (bf16)((u + 0x7fffu + ((u >> 16) & 1u)) >> 16); }
__device__ __forceinline__ float wave_sum(float v) {
#pragma unroll
    for (int o = 1; o < 64; o <<= 1) v += __shfl_xor(v, o);
    return v;
}
__device__ __forceinline__ float log_sigmoid(float z) { return fminf(z, 0.f) - log1pf(expf(-fabsf(z))); }
__device__ __forceinline__ float sigmoidf(float z) { return 1.f / (1.f + expf(-z)); }

namespace nv {
__global__ void __launch_bounds__(256) p0_x(const float* x, const float* w_in_a, bf16* XB, float* GLR) {
    const int row = blockIdx.x * 4 + (threadIdx.x >> 6), lane = threadIdx.x & 63;
    float acc[16];
#pragma unroll
    for (int j = 0; j < 16; ++j) acc[j] = 0.f;
    for (int k = lane; k < D; k += 64) {
        const float v = x[(size_t)row * D + k]; XB[(size_t)row * D + k] = f2bf(v);
#pragma unroll
        for (int j = 0; j < 16; ++j) acc[j] += v * w_in_a[(size_t)k * A_IN + 1536 + j];
    }
#pragma unroll
    for (int j = 0; j < 16; ++j) { const float s = wave_sum(acc[j]); if (lane == 0) GLR[(size_t)row * 16 + j] = s; }
}
__global__ void __launch_bounds__(256) p0_mem(const float* mem, bf16* MEMB) {
    const size_t i = (size_t)blockIdx.x * 256 + threadIdx.x; MEMB[i] = f2bf(mem[i]);
}
struct GemmArgs { const bf16* A; int lda; const float* W; int ldw; int wcol0; int M, Nn, K; };
struct EpiBf { bf16* dst; int ldd; int dcol0; __device__ void operator()(int m, int n, float v) const { dst[(size_t)m * ldd + dcol0 + n] = f2bf(v); } };
struct EpiRes { const float* xres; float* out; __device__ void operator()(int m, int n, float v) const { out[(size_t)m * D + n] = DN_ALPHA * xres[(size_t)m * D + n] + v; } };
template <class Epi> __global__ void __launch_bounds__(256) gemm(GemmArgs g, Epi E) {
    const int n = blockIdx.x * 64 + (threadIdx.x & 63), m0 = (blockIdx.y * 4 + (threadIdx.x >> 6)) * 4;
    if (n >= g.Nn) return;
    float acc[4] = {0.f, 0.f, 0.f, 0.f};
    for (int k = 0; k < g.K; k += 8) {
        float w[8];
#pragma unroll
        for (int j = 0; j < 8; ++j) w[j] = g.W[(size_t)(k + j) * g.ldw + g.wcol0 + n];
#pragma unroll
        for (int i = 0; i < 4; ++i) {
            const uint4 a = *(const uint4*)(g.A + (size_t)(m0 + i) * g.lda + k);
            const unsigned aw[4] = {a.x, a.y, a.z, a.w};
#pragma unroll
            for (int j = 0; j < 4; ++j) { acc[i] += __uint_as_float(aw[j] << 16) * w[2 * j]; acc[i] += __uint_as_float(aw[j] & 0xffff0000u) * w[2 * j + 1]; }
        }
    }
#pragma unroll
    for (int i = 0; i < 4; ++i) E(m0 + i, n, acc[i]);
}
__global__ void __launch_bounds__(192) gla(const bf16* QK, const bf16* V, const bf16* R, const float* GLR, const float* w_up, const float* b_gate, const float* g_norm, bf16* OC) {
    const int b = blockIdx.x / GLA_H, h = blockIdx.x % GLA_H, tid = threadIdx.x;
    __shared__ float sq[96], sk[96], sa[96], red[4];
    float S[96];
#pragma unroll
    for (int k = 0; k < 96; ++k) S[k] = 0.f;
    float wup[16]; float bg = 0.f;
    if (tid < 96) { for (int j = 0; j < 16; ++j) wup[j] = w_up[j * 384 + h * 96 + tid]; bg = b_gate[h * 96 + tid]; }
    const float gn = g_norm[tid];
    const float qs = 0.10206207261596577f;
    for (int t = 0; t < SEQ; ++t) {
        const size_t m = (size_t)b * SEQ + t;
        __syncthreads();
        if (tid < 96) {
            float z = bg;
#pragma unroll
            for (int j = 0; j < 16; ++j) z += GLR[m * 16 + j] * wup[j];
            sa[tid] = expf(log_sigmoid(z) * (1.f / 16.f));
            sq[tid] = bf2f(QK[m * 768 + h * 96 + tid]) * qs;
            sk[tid] = bf2f(QK[m * 768 + 384 + h * 96 + tid]);
        }
        __syncthreads();
        const float v = bf2f(V[m * 768 + h * 192 + tid]);
        float o = 0.f;
#pragma unroll
        for (int k = 0; k < 96; ++k) { S[k] = sa[k] * S[k] + sk[k] * v; o += sq[k] * S[k]; }
        float ss = wave_sum(o * o);
        if ((tid & 63) == 0) red[tid >> 6] = ss;
        __syncthreads();
        ss = red[0] + red[1] + red[2];
        const float r = bf2f(R[m * 768 + h * 192 + tid]);
        const float on = o * rsqrtf(ss * (1.f / 192.f) + RMS_EPS) * gn;
        OC[m * D + h * 192 + tid] = f2bf(on * (r * sigmoidf(r)));
    }
}
__global__ void __launch_bounds__(256) memattn(const bf16* MQ, const bf16* MKV, int layer, bf16* OC) {
    const int m = blockIdx.x * 256 + threadIdx.x, hd = blockIdx.y, b = m / SEQ;
    float q[64], acc[64];
#pragma unroll
    for (int d = 0; d < 64; ++d) { q[d] = bf2f(MQ[(size_t)m * 256 + hd * 64 + d]) * 0.125f; acc[d] = 0.f; }
    float mx = -1e30f, l = 0.f;
    for (int j = 0; j < NMEM; ++j) {
        const bf16* kr = MKV + (size_t)(b * NMEM + j) * 1024 + layer * 512 + hd * 64;
        float s = 0.f;
#pragma unroll
        for (int d = 0; d < 64; ++d) s += q[d] * bf2f(kr[d]);
        const float mn = fmaxf(mx, s), f = expf(mx - mn), p = expf(s - mn);
        l = l * f + p; mx = mn;
#pragma unroll
        for (int d = 0; d < 64; ++d) acc[d] = acc[d] * f + p * bf2f(kr[256 + d]);
    }
    const float il = 1.f / l;
#pragma unroll
    for (int d = 0; d < 64; ++d) OC[(size_t)m * D + 768 + hd * 64 + d] = f2bf(acc[d] * il);
}
__global__ void __launch_bounds__(256) ln_router(float* XF, bf16* XB, const float* g, const float* bta, const float* w_router, const float* b_router, int* TOK_E, float* TOK_W) {
    const int row = blockIdx.x * 4 + (threadIdx.x >> 6), lane = threadIdx.x & 63;
    float v[16]; float s = 0.f;
#pragma unroll
    for (int i = 0; i < 16; ++i) { v[i] = XF[(size_t)row * D + lane + 64 * i]; s += v[i]; }
    const float mean = wave_sum(s) * (1.f / D); float q = 0.f;
#pragma unroll
    for (int i = 0; i < 16; ++i) { v[i] -= mean; q += v[i] * v[i]; }
    const float rstd = rsqrtf(wave_sum(q) * (1.f / D) + LN_EPS);
    float lg[16];
#pragma unroll
    for (int e = 0; e < 16; ++e) lg[e] = 0.f;
#pragma unroll
    for (int i = 0; i < 16; ++i) { const int k = lane + 64 * i; const float o = v[i] * rstd * g[k] + bta[k]; XF[(size_t)row * D + k] = o; XB[(size_t)row * D + k] = f2bf(o);
#pragma unroll
        for (int e = 0; e < 16; ++e) lg[e] += o * w_router[k * 16 + e]; }
#pragma unroll
    for (int e = 0; e < 16; ++e) lg[e] = wave_sum(lg[e]);
    if (lane == 0) {
        float aff[16], sel[16];
#pragma unroll
        for (int e = 0; e < 16; ++e) { aff[e] = sigmoidf(lg[e]); sel[e] = aff[e] + b_router[e]; }
        int gbest = 0; float gs = -1e30f;
#pragma unroll
        for (int gi = 0; gi < 4; ++gi) { float a = -1e30f, b2 = -1e30f;
#pragma unroll
            for (int j = 0; j < 4; ++j) { const float x = sel[gi * 4 + j]; if (x > a) { b2 = a; a = x; } else if (x > b2) b2 = x; }
            if (a + b2 > gs) { gs = a + b2; gbest = gi; } }
        int i0 = 0, i1 = 0; float a = -1e30f, b2 = -1e30f;
#pragma unroll
        for (int j = 0; j < 4; ++j) { float x = -1e30f;
#pragma unroll
            for (int gi = 0; gi < 4; ++gi) if (gi == gbest) x = sel[gi * 4 + j];
            if (x > a) { b2 = a; i1 = i0; a = x; i0 = j; } else if (x > b2) { b2 = x; i1 = j; } }
        const int e0 = gbest * 4 + i0, e1 = gbest * 4 + i1; float w0 = 0.f, w1 = 0.f;
#pragma unroll
        for (int e = 0; e < 16; ++e) { if (e == e0) w0 = aff[e]; if (e == e1) w1 = aff[e]; }
        const float inv = 1.f / (w0 + w1);
        TOK_E[row * 2] = e0; TOK_E[row * 2 + 1] = e1; TOK_W[row * 2] = w0 * inv; TOK_W[row * 2 + 1] = w1 * inv;
    }
}
__global__ void __launch_bounds__(256) moe(const bf16* XB, const int* TOK_E, const float* wg, const float* wu, const float* wd, bf16* YS, int* TOK_SLOT) {
    const int tok = blockIdx.x >> 1, j = blockIdx.x & 1, tid = threadIdx.x;
    __shared__ float xs[1024], hs[512];
    for (int k = tid; k < 1024; k += 256) xs[k] = bf2f(XB[(size_t)tok * D + k]);
    const int e = TOK_E[tok * 2 + j];
    __syncthreads();
    const float* G = wg + (size_t)e * 1024 * 512; const float* U = wu + (size_t)e * 1024 * 512; const float* Dn = wd + (size_t)e * 512 * 1024;
    float g0 = 0.f, g1 = 0.f, u0 = 0.f, u1 = 0.f;
    for (int k = 0; k < 1024; ++k) { const float x = xs[k]; g0 += x * G[k * 512 + tid]; g1 += x * G[k * 512 + 256 + tid]; u0 += x * U[k * 512 + tid]; u1 += x * U[k * 512 + 256 + tid]; }
    hs[tid] = g0 * sigmoidf(g0) * u0; hs[tid + 256] = g1 * sigmoidf(g1) * u1;
    __syncthreads();
    float o[4] = {0.f, 0.f, 0.f, 0.f};
    for (int k = 0; k < 512; ++k) { const float hh = hs[k];
#pragma unroll
        for (int c = 0; c < 4; ++c) o[c] += hh * Dn[k * 1024 + c * 256 + tid]; }
    const int slot = tok * 2 + j;
#pragma unroll
    for (int c = 0; c < 4; ++c) YS[(size_t)slot * D + c * 256 + tid] = f2bf(o[c]);
    if (tid == 0) TOK_SLOT[slot] = slot;
}
__global__ void __launch_bounds__(256) ln_ffn(float* XF, bf16* XB, const bf16* YS, const int* TOK_SLOT, const float* TOK_W, const float* g, const float* bta,
                                              const float* w_kv, const float* b_forget, float* LOGF, int do_logf) {
    const int row = blockIdx.x * 4 + (threadIdx.x >> 6), lane = threadIdx.x & 63;
    const int s0 = TOK_SLOT[row * 2], s1 = TOK_SLOT[row * 2 + 1]; const float w0 = TOK_W[row * 2], w1 = TOK_W[row * 2 + 1];
    float v[16]; float s = 0.f;
#pragma unroll
    for (int i = 0; i < 16; ++i) { const int k = lane + 64 * i; v[i] = DN_ALPHA * XF[(size_t)row * D + k] + w0 * bf2f(YS[(size_t)s0 * D + k]) + w1 * bf2f(YS[(size_t)s1 * D + k]); s += v[i]; }
    const float mean = wave_sum(s) * (1.f / D); float q = 0.f;
#pragma unroll
    for (int i = 0; i < 16; ++i) { v[i] -= mean; q += v[i] * v[i]; }
    const float rstd = rsqrtf(wave_sum(q) * (1.f / D) + LN_EPS);
    float lf[12];
#pragma unroll
    for (int e = 0; e < 12; ++e) lf[e] = 0.f;
#pragma unroll
    for (int i = 0; i < 16; ++i) { const int k = lane + 64 * i; const float o = v[i] * rstd * g[k] + bta[k]; XF[(size_t)row * D + k] = o; XB[(size_t)row * D + k] = f2bf(o);
        if (do_logf) {
#pragma unroll
            for (int e = 0; e < 12; ++e) lf[e] += o * w_kv[(size_t)k * KV_IN + 1536 + e]; } }
    if (do_logf) {
#pragma unroll
        for (int e = 0; e < 12; ++e) { const float t = wave_sum(lf[e]); if (lane == 0) LOGF[(size_t)row * 12 + e] = log_sigmoid(t + b_forget[e]); }
    }
}
__global__ void __launch_bounds__(256) headproj(const bf16* XB, const float* W, int ldw, const float* gn, float scale, bf16* dst) {
    const int m = blockIdx.x, col = blockIdx.y * 256 + threadIdx.x, lane = threadIdx.x & 63;
    float acc = 0.f;
    for (int k = 0; k < D; k += 8) {
        const uint4 a = *(const uint4*)(XB + (size_t)m * D + k); const unsigned aw[4] = {a.x, a.y, a.z, a.w};
#pragma unroll
        for (int j = 0; j < 4; ++j) { acc += __uint_as_float(aw[j] << 16) * W[(size_t)(k + 2 * j) * ldw + col]; acc += __uint_as_float(aw[j] & 0xffff0000u) * W[(size_t)(k + 2 * j + 1) * ldw + col]; }
    }
    const float ss = wave_sum(acc * acc);
    dst[(size_t)m * 768 + col] = f2bf(acc * rsqrtf(ss * (1.f / 64.f) + RMS_EPS) * gn[lane] * scale);
}
__global__ void __launch_bounds__(64) cumk(const float* LOGF, float* CUM) {
    const int b = blockIdx.x / FOX_H, h = blockIdx.x % FOX_H, lane = threadIdx.x;
    float loc[64]; float s = 0.f;
#pragma unroll
    for (int i = 0; i < 64; ++i) { s += LOGF[((size_t)b * SEQ + lane * 64 + i) * 12 + h]; loc[i] = s; }
    float inc = s;
#pragma unroll
    for (int o = 1; o < 64; o <<= 1) { const float t = __shfl_up(inc, o); if (lane >= o) inc += t; }
    const float base = inc - s;
#pragma unroll
    for (int i = 0; i < 64; ++i) CUM[((size_t)b * FOX_H + h) * SEQ + lane * 64 + i] = base + loc[i];
}
__global__ void __launch_bounds__(256) fox(const bf16* Q, const bf16* K, const bf16* V, const bf16* OG, const float* CUM, bf16* OC) {
    const int t = blockIdx.x * 256 + threadIdx.x, h = blockIdx.y, b = blockIdx.z;
    const size_t m = (size_t)b * SEQ + t;
    float q[64], acc[64];
#pragma unroll
    for (int d = 0; d < 64; ++d) { q[d] = bf2f(Q[m * 768 + h * 64 + d]); acc[d] = 0.f; }
    const float* cum = CUM + ((size_t)b * FOX_H + h) * SEQ; const float ct = cum[t] * LOG2E;
    float mx = -1e30f, l = 0.f;
    const int tmax = blockIdx.x * 256 + 255;
    for (int s = 0; s <= tmax; ++s) {
        const bf16* kr = K + ((size_t)b * SEQ + s) * 768 + h * 64; const bf16* vr = V + ((size_t)b * SEQ + s) * 768 + h * 64;
        float sc = ct - cum[s] * LOG2E;
#pragma unroll
        for (int d = 0; d < 64; ++d) sc += q[d] * bf2f(kr[d]);
        if (s <= t) {
            const float mn = fmaxf(mx, sc), f = exp2f(mx - mn), p = exp2f(sc - mn);
            l = l * f + p; mx = mn;
#pragma unroll
            for (int d = 0; d < 64; ++d) acc[d] = acc[d] * f + p * bf2f(vr[d]);
        }
    }
    const float il = 1.f / l;
#pragma unroll
    for (int d = 0; d < 64; ++d) { const float og = bf2f(OG[m * 768 + h * 64 + d]); OC[m * D + h * 64 + d] = f2bf(acc[d] * il * sigmoidf(og)); }
}
}

namespace pk {
#define LAS __attribute__((address_space(3)))
#define GAS __attribute__((address_space(1)))
typedef short bf16x8 __attribute__((ext_vector_type(8)));
typedef short s16x4 __attribute__((ext_vector_type(4)));
typedef float f32x4 __attribute__((ext_vector_type(4)));
typedef float f32x16 __attribute__((ext_vector_type(16)));
typedef unsigned u32x4 __attribute__((ext_vector_type(4)));
typedef unsigned u32x2 __attribute__((ext_vector_type(2)));
constexpr int NWAVES = 8, NTHREADS = 512;
constexpr int BM = 256, BK = 64, HALF = 128, HTB = HALF * BK * 2, STAGE_BYTES = 8 * HTB, NXCD = 8, WGM = 8;
constexpr int RING_OFF = 0, RING_BYTES = 131072;
constexpr int MISC_OFF = RING_BYTES;
constexpr int ROWTOK_OFF = MISC_OFF + 256;
constexpr int LDS_BYTES = 155648;
static_assert(ROWTOK_OFF + 6 * 1024 <= LDS_BYTES, "LDS map");

__device__ __forceinline__ int lds_byte(int r, int c) { const int st = (r >> 4) * 2 + (c >> 5), rr = r & 15, cc = c & 31, ob = rr * 64 + cc * 2; return st * 1024 + (ob ^ (((ob >> 9) & 1) << 5)); }
__device__ __forceinline__ void stage_rc(int b, int& R, int& C) { const int st = b / 1024, sb = b % 1024, swz = sb ^ (((sb >> 9) & 1) << 5); R = (st >> 1) * 16 + swz / 64; C = (st & 1) * 32 + (swz % 64) / 2; }
__device__ __forceinline__ unsigned cvt_pk_bf16(float lo, float hi) { unsigned r; asm volatile("v_cvt_pk_bf16_f32 %0, %1, %2" : "=v"(r) : "v"(lo), "v"(hi)); return r; }
__device__ __forceinline__ int perm8(int c) { return (c & ~31) | (16 * ((c >> 2) & 1) + 4 * ((c >> 3) & 3) + (c & 3)); }
__device__ __forceinline__ int head64(int c) { return 128 * ((c >> 5) & 1) + 32 * (c >> 6) + 16 * ((c >> 2) & 1) + 4 * ((c >> 3) & 3) + (c & 3); }

__device__ __forceinline__ int fresh_lane() { int l; asm volatile("v_mbcnt_lo_u32_b32 %0, -1, 0\n\tv_mbcnt_hi_u32_b32 %0, -1, %0" : "=v"(l)); return l; }
__device__ __forceinline__ int fresh_tid(int wave_s) { asm volatile("" : "+s"(wave_s)); return wave_s * 64 + fresh_lane(); }
struct Unit { const char* A; const char* B; int pm, pn, e, ord; };

struct TileOrder {
    const char* A; const char* Bt; int K, nM, nN, nwg, G, c;
    __device__ void init(const void* A_, const void* Bt_, int M, int N, int K_, int G_, int c_) { A = (const char*)A_; Bt = (const char*)Bt_; K = K_; nM = M / BM; nN = N / BM; nwg = nM * nN; G = G_; c = c_; }
    __device__ __forceinline__ bool next(int i, Unit& u) const {
        const long L = (long)i * G + c; if (L >= nwg) return false;
        int wgid = (int)L; { const int q = nwg / NXCD, r = nwg % NXCD, xcd = wgid % NXCD, off = wgid / NXCD; wgid = (xcd < r ? xcd * (q + 1) : r * (q + 1) + (xcd - r) * q) + off; }
        const int nig = WGM * nN, gid = wgid / nig, fm = gid * WGM, gsz = (nM - fm) < WGM ? (nM - fm) : WGM;
        u.pm = fm + ((wgid % nig) % gsz); u.pn = (wgid % nig) / gsz; u.e = 0; u.ord = i;
        u.A = A + (size_t)u.pm * BM * K * 2; u.B = Bt + (size_t)u.pn * BM * K * 2; return true;
    }
    __device__ __forceinline__ unsigned a_off(const Unit&, int h, int R, int C) const { return (unsigned)((R + HALF * h) * K + C) * 2u; }
};

template <class Epi, class Sched>
__device__ __forceinline__ void gemm_phase(LAS unsigned char* lds, const int K, const Sched& S, const Epi& E, const int wave_s) {
    const int tid = fresh_tid(wave_s), wid = wave_s, lane = tid & 63, wr = wid >> 2, wc = wid & 3, fr = lane & 15, fq = lane >> 4;
    const int nt = K / BK;
    int sR[2], sC[2];
    unsigned voffA[2][2], voffB[2];
#pragma unroll
    for (int i = 0; i < 2; ++i) { stage_rc(tid * 16 + i * 8192, sR[i], sC[i]); voffB[i] = (unsigned)(sR[i] * K + sC[i]) * 2u; }
    const size_t kstep = (size_t)(BK * 2);
    const size_t hstep = (size_t)HALF * K * 2;
    const unsigned ldsw = (unsigned)wid * 1024u;
    const int aoff = lds_byte(wr * 64 + fr, fq * 8), boff = lds_byte(wc * 32 + fr, fq * 8);
#define PG8_SA(b, h) (((b) * 2 + (h)) * HTB)
#define PG8_SB(b, h) ((4 + (b) * 2 + (h)) * HTB)
#define PG8_STAGE(bufoff, gbase, voff) do { _Pragma("unroll") for (int _i = 0; _i < 2; ++_i) \
        __builtin_amdgcn_global_load_lds((const unsigned*)((const char*)(gbase) + (voff)[_i]), (LAS unsigned*)(lds + (bufoff) + ldsw + _i * 8192), 16, 0, 0); } while (0)
#define PG8_LDA(dst, b, h) do { _Pragma("unroll") for (int m = 0; m < 4; ++m) _Pragma("unroll") for (int k = 0; k < 2; ++k) dst[m][k] = *(const LAS bf16x8*)(lds + PG8_SA(b, h) + aoff + m * 2048 + k * 1024); } while (0)
#define PG8_LDB(dst, b, h) do { _Pragma("unroll") for (int n = 0; n < 2; ++n) _Pragma("unroll") for (int k = 0; k < 2; ++k) dst[n][k] = *(const LAS bf16x8*)(lds + PG8_SB(b, h) + boff + n * 2048 + k * 1024); } while (0)
#define PG8_MMA(ai, bj, At, Bt) do { __builtin_amdgcn_s_setprio(1); _Pragma("unroll") for (int m = 0; m < 4; ++m) _Pragma("unroll") for (int n = 0; n < 2; ++n) _Pragma("unroll") for (int k = 0; k < 2; ++k) \
        acc[ai][bj][m][n] = __builtin_amdgcn_mfma_f32_16x16x32_bf16(Bt[n][k], At[m][k], acc[ai][bj][m][n], 0, 0, 0); __builtin_amdgcn_s_setprio(0); } while (0)
#define PG8_WAIT_V(n) asm volatile("s_waitcnt vmcnt(" #n ")" ::: "memory")
#define PG8_WAIT_L(n) asm volatile("s_waitcnt lgkmcnt(" #n ")" ::: "memory")
#define PG8_BAR __builtin_amdgcn_s_barrier()
#define PG8_SCHED __builtin_amdgcn_sched_barrier(0)
    Unit cur, nxt; int ui = 0;
    if (!S.next(0, cur)) return;
    f32x4 acc[2][2][4][2];
#pragma unroll
    for (int a = 0; a < 2; ++a)
#pragma unroll
        for (int b = 0; b < 2; ++b)
#pragma unroll
            for (int m = 0; m < 4; ++m)
#pragma unroll
                for (int n = 0; n < 2; ++n) acc[a][b][m][n] = (f32x4){0.f, 0.f, 0.f, 0.f};
    bf16x8 At[4][2], B0[2][2], B1[2][2];
    const char* cA = cur.A; const char* cB = cur.B;
#pragma unroll
    for (int h = 0; h < 2; ++h)
#pragma unroll
        for (int i = 0; i < 2; ++i) voffA[h][i] = S.a_off(cur, h, sR[i], sC[i]);
    PG8_STAGE(PG8_SB(0, 0), cB, voffB); PG8_STAGE(PG8_SB(0, 1), cB + hstep, voffB); PG8_STAGE(PG8_SA(0, 0), cA, voffA[0]); PG8_STAGE(PG8_SA(0, 1), cA, voffA[1]);
    if (wr == 1) PG8_BAR;
    PG8_WAIT_V(2); PG8_BAR;
    PG8_STAGE(PG8_SB(1, 0), cB + kstep, voffB); PG8_STAGE(PG8_SA(1, 0), cA + kstep, voffA[0]); PG8_STAGE(PG8_SB(1, 1), cB + hstep + kstep, voffB);
    PG8_WAIT_V(6); PG8_BAR;
    for (;;) {
        const bool has_next = S.next(ui + 1, nxt);
        const char* nA = has_next ? nxt.A : cA; const char* nB = has_next ? nxt.B : cB;
        for (int t = 0; t < nt; t += 2) {
            const bool last = (t == nt - 2);
            const char* a1 = cA + (size_t)(t + 1) * kstep;
            const char* a2 = last ? nA : cA + (size_t)(t + 2) * kstep; const char* b2 = last ? nB : cB + (size_t)(t + 2) * kstep;
            const char* a3 = a2 + kstep; const char* b3 = b2 + kstep;
            PG8_LDB(B0, 0, 0); PG8_LDB(B1, 0, 1); PG8_SCHED; PG8_LDA(At, 0, 0); PG8_STAGE(PG8_SA(1, 1), a1, voffA[1]);
            if (last && has_next) {
#pragma unroll
                for (int h = 0; h < 2; ++h)
#pragma unroll
                    for (int i = 0; i < 2; ++i) { int R2, C2; stage_rc(fresh_tid(wave_s) * 16 + i * 8192, R2, C2); voffA[h][i] = S.a_off(nxt, h, R2, C2); }
            }
            PG8_WAIT_V(8); PG8_WAIT_L(0); PG8_BAR; PG8_MMA(0, 0, At, B0); PG8_MMA(0, 1, At, B1); PG8_BAR; PG8_SCHED;
            PG8_LDA(At, 0, 1); PG8_STAGE(PG8_SB(0, 0), b2, voffB); PG8_STAGE(PG8_SB(0, 1), b2 + hstep, voffB); PG8_STAGE(PG8_SA(0, 0), a2, voffA[0]);
            PG8_WAIT_V(8); PG8_WAIT_L(0); PG8_BAR; PG8_MMA(1, 0, At, B0); PG8_MMA(1, 1, At, B1); PG8_BAR; PG8_SCHED;
            PG8_LDB(B0, 1, 0); PG8_LDB(B1, 1, 1); PG8_SCHED; PG8_LDA(At, 1, 0); PG8_STAGE(PG8_SA(0, 1), a2, voffA[1]);
            PG8_WAIT_V(8); PG8_WAIT_L(0); PG8_BAR; PG8_MMA(0, 0, At, B0); PG8_MMA(0, 1, At, B1); PG8_BAR; PG8_SCHED;
            PG8_LDA(At, 1, 1); PG8_STAGE(PG8_SB(1, 0), b3, voffB); PG8_STAGE(PG8_SB(1, 1), b3 + hstep, voffB); PG8_STAGE(PG8_SA(1, 0), a3, voffA[0]);
            PG8_WAIT_V(8); PG8_WAIT_L(0); PG8_BAR; PG8_MMA(1, 0, At, B0); PG8_MMA(1, 1, At, B1); PG8_BAR; PG8_SCHED;
        }
        if (wr == 0) PG8_BAR;
        E(acc, cur, wr, wc, fr, fq);
        if (!has_next) break;
#pragma unroll
        for (int a = 0; a < 2; ++a)
#pragma unroll
            for (int b = 0; b < 2; ++b)
#pragma unroll
                for (int m = 0; m < 4; ++m)
#pragma unroll
                    for (int n = 0; n < 2; ++n) acc[a][b][m][n] = (f32x4){0.f, 0.f, 0.f, 0.f};
        cur = nxt; cA = nA; cB = nB; ++ui;
        if (wr == 1) PG8_BAR;
    }
    PG8_WAIT_V(0);
    PG8_BAR;
#undef PG8_SA
#undef PG8_SB
#undef PG8_STAGE
#undef PG8_LDA
#undef PG8_LDB
#undef PG8_MMA
#undef PG8_WAIT_V
#undef PG8_WAIT_L
#undef PG8_BAR
#undef PG8_SCHED
}

__device__ __forceinline__ void store_bf16_tile(const f32x4 (&acc)[2][2][4][2], bf16* base, int ldd, int row0, int c0, int wr, int wc, int fr, int fq) {
    bf16* rowp = base + (size_t)(row0 + wr * 64 + fr) * ldd + (c0 + wc * 32 + 8 * fq);
#pragma unroll
    for (int ai = 0; ai < 2; ++ai) {
#pragma unroll
        for (int m = 0; m < 4; ++m) {
#pragma unroll
            for (int bj = 0; bj < 2; ++bj) { const f32x4 v0 = acc[ai][bj][m][0], v1 = acc[ai][bj][m][1];
                u32x4 w; w.x = cvt_pk_bf16(v0[0], v0[1]); w.y = cvt_pk_bf16(v0[2], v0[3]); w.z = cvt_pk_bf16(v1[0], v1[1]); w.w = cvt_pk_bf16(v1[2], v1[3]);
                *(u32x4*)(rowp + bj * HALF) = w; }
            rowp += (size_t)16 * ldd; asm volatile("" : "+v"(rowp)); }
        rowp += (size_t)64 * ldd; }
}
struct EpiInA { bf16 *QK, *V, *R, *MQ;
    __device__ __forceinline__ void operator()(const f32x4 (&acc)[2][2][4][2], const Unit& u, int wr, int wc, int fr, int fq) const {
        bf16* base; int ldd, c0; const int pn = u.pn;
        if (pn < 3) { base = QK; ldd = 768; c0 = pn * 256; } else if (pn < 6) { base = V; ldd = 768; c0 = (pn - 3) * 256; } else if (pn < 9) { base = R; ldd = 768; c0 = (pn - 6) * 256; } else { base = MQ; ldd = 256; c0 = 0; }
        store_bf16_tile(acc, base, ldd, u.pm * BM, c0, wr, wc, fr, fq);
    } };
struct EpiPlain { bf16* dst; int ldd;
    __device__ __forceinline__ void operator()(const f32x4 (&acc)[2][2][4][2], const Unit& u, int wr, int wc, int fr, int fq) const { store_bf16_tile(acc, dst, ldd, u.pm * BM, u.pn * BM, wr, wc, fr, fq); } };

#define XB_TMO      128
#define XB_XCNT(j)  (256  + 64 * (j))
#define XB_XSUB(j)  (1280 + 64 * (j))
#define XB_XGEN(j)  (2304 + 64 * (j))
#define XB_TOP      3328
#define XB_TOPGEN   3392
#define XCD_BAR_WORDS 3456
#define XB_SPIN_CAP (1u << 18)
__device__ __forceinline__ unsigned xb_ld(unsigned* p)              { return __hip_atomic_load(p, __ATOMIC_RELAXED, __HIP_MEMORY_SCOPE_AGENT); }
__device__ __forceinline__ unsigned xb_add(unsigned* p, unsigned v) { return __hip_atomic_fetch_add(p, v, __ATOMIC_RELAXED, __HIP_MEMORY_SCOPE_AGENT); }
__device__ __forceinline__ unsigned xb_xcc_id() { return (unsigned)__builtin_amdgcn_s_getreg((3 << 11) | 20) & 0xFu; }
#define XB_SPIN(cond, bar) do { unsigned _sp = 0; while (cond) { __builtin_amdgcn_s_sleep(1); \
    if ((++_sp & 255u) == 0u) { if (xb_ld(&(bar)[XB_TMO])) break; if (_sp > XB_SPIN_CAP) { atomicAdd(&(bar)[XB_TMO], 1u); break; } } } } while (0)
struct XcdBarrier { unsigned* bar; unsigned x; volatile LAS unsigned* st; };
__device__ __forceinline__ XcdBarrier xcd_barrier_post(unsigned* bar, volatile LAS unsigned* st) {
    XcdBarrier b; b.bar = bar; b.x = xb_xcc_id(); b.st = st;
    if (threadIdx.x == 0) (void)xb_add(&bar[XB_XCNT(b.x)], 1u);
    return b;
}
__device__ __forceinline__ void xcd_barrier_complete(unsigned* bar, unsigned x, unsigned& nloc, unsigned& nx) {
    const unsigned G = gridDim.x * gridDim.y * gridDim.z;
    unsigned sum, cnt, mine, sp = 0u;
    for (;;) {
        sum = 0u; cnt = 0u; mine = 0u;
#pragma unroll
        for (unsigned j = 0; j < 16; ++j) { const unsigned c = xb_ld(&bar[XB_XCNT(j)]); sum += c; cnt += (c > 0u) ? 1u : 0u; mine = (j == x) ? c : mine; }
        if (sum == G) break;
        __builtin_amdgcn_s_sleep(1);
        if ((++sp & 255u) == 0u) { if (xb_ld(&bar[XB_TMO])) break; if (sp > XB_SPIN_CAP) { atomicAdd(&bar[XB_TMO], 1u); break; } }
    }
    nloc = mine > 0u ? mine : 1u; nx = cnt > 0u ? cnt : 1u;
}
__device__ __forceinline__ void xcd_barrier(const XcdBarrier& b) {
    asm volatile("s_waitcnt vmcnt(0)" ::: "memory");
    __syncthreads();
    if (threadIdx.x == 0) {
        unsigned* bar = b.bar;
        __builtin_amdgcn_s_waitcnt(0);
        unsigned nloc = b.st[0], nx = b.st[1];
        if (nloc == 0u) { xcd_barrier_complete(bar, b.x, nloc, nx); b.st[0] = nloc; b.st[1] = nx; }
        const unsigned old = xb_add(&bar[XB_XSUB(b.x)], 1u);
        const unsigned gen = old / nloc;
        if (old + 1u == (gen + 1u) * nloc) {
            __builtin_amdgcn_fence(__ATOMIC_RELEASE, "agent");
            asm volatile("s_waitcnt vmcnt(0)" ::: "memory");
            const unsigned og = xb_add(&bar[XB_TOP], 1u);
            const unsigned tg = og / nx;
            if (og + 1u == (tg + 1u) * nx) xb_add(&bar[XB_TOPGEN], 1u);
            else XB_SPIN(xb_ld(&bar[XB_TOPGEN]) == tg, bar);
            __builtin_amdgcn_fence(__ATOMIC_ACQUIRE, "agent");
            xb_add(&bar[XB_XGEN(b.x)], 1u);
            asm volatile("s_waitcnt vmcnt(0)" ::: "memory");
        } else {
            XB_SPIN(xb_ld(&bar[XB_XGEN(b.x)]) == gen, bar);
            __builtin_amdgcn_fence(__ATOMIC_ACQUIRE, "agent");
            asm volatile("s_waitcnt vmcnt(0)" ::: "memory");
        }
    }
    __syncthreads();
}
#define LDS_WAIT() asm volatile("s_waitcnt lgkmcnt(0)" ::: "memory")
__device__ __forceinline__ unsigned pk2(float lo, float hi) { return (unsigned)f2bf(lo) | ((unsigned)f2bf(hi) << 16); }

__device__ __forceinline__ float multi_reduce16(const float (&a)[16], int lane) {
    float b[8], c[4], d[2], e;
    { const bool hi = (lane & 32) != 0;
#pragma unroll
      for (int i = 0; i < 8; ++i) { const float send = hi ? a[i] : a[i + 8], keep = hi ? a[i + 8] : a[i]; b[i] = keep + __shfl_xor(send, 32); } }
    { const bool hi = (lane & 16) != 0;
#pragma unroll
      for (int i = 0; i < 4; ++i) { const float send = hi ? b[i] : b[i + 4], keep = hi ? b[i + 4] : b[i]; c[i] = keep + __shfl_xor(send, 16); } }
    { const bool hi = (lane & 8) != 0;
#pragma unroll
      for (int i = 0; i < 2; ++i) { const float send = hi ? c[i] : c[i + 2], keep = hi ? c[i + 2] : c[i]; d[i] = keep + __shfl_xor(send, 8); } }
    { const bool hi = (lane & 4) != 0; const float send = hi ? d[0] : d[1], keep = hi ? d[1] : d[0]; e = keep + __shfl_xor(send, 4); }
    e += __shfl_xor(e, 2); e += __shfl_xor(e, 1);
    return e;
}

template <class F> __device__ __forceinline__ void transpose_item(const float* W, int ldw, int ncols, int K, bf16* WT, LAS float* scr, int item, int nblk, int lane, F dstrow) {
    const int kb = item / nblk, nb = item % nblk, k0 = 64 * kb, n0 = 32 * nb;
    const int col = n0 + (lane & 31); const bool ok = col < ncols;
#pragma unroll 8
    for (int i = 0; i < 32; ++i) { const int kk = 2 * i + (lane >> 5); scr[kk * 33 + (lane & 31)] = ok ? W[(size_t)(k0 + kk) * ldw + col] : 0.f; }
    LDS_WAIT(); asm volatile("" ::: "memory");
    const int c = lane & 7;
#pragma unroll
    for (int j = 0; j < 4; ++j) { const int n = (lane >> 3) + 8 * j; const LAS float* s = scr + (8 * c) * 33 + n;
        u32x4 o; o.x = pk2(s[0 * 33], s[1 * 33]); o.y = pk2(s[2 * 33], s[3 * 33]); o.z = pk2(s[4 * 33], s[5 * 33]); o.w = pk2(s[6 * 33], s[7 * 33]);
        const int dr = (n0 + n) < ncols ? dstrow(n0 + n) : -1;
        if (dr >= 0) *(u32x4*)(WT + (size_t)dr * K + k0 + 8 * c) = o; }
    LDS_WAIT(); asm volatile("" ::: "memory");
}
struct Params { const float* in[22]; float* out; unsigned char* ws; int ph_lo, ph_hi, bar_li, pad; };
enum { I_X = 0, I_MEM, I_WINA, I_WGUP, I_BGATE, I_GLAG, I_WINB, I_QNG, I_WKV, I_BFORGET, I_KNG, I_WMKV, I_WOUT, I_LMG, I_LMB, I_LFG, I_LFB, I_WR, I_BR, I_WEG, I_WEU, I_WED };
constexpr int CW_BAR = 4096;

typedef const __attribute__((address_space(4))) Params* KP;
__device__ __forceinline__ KP fresh_kp() { KP q = (KP)__builtin_amdgcn_kernarg_segment_ptr(); asm volatile("" : "+s"(q)); return q; }

__device__ __forceinline__ void phase_prologue(KP p, LAS unsigned char* lds, int G, int bid, const int wave_s) {
    const int tid = fresh_tid(wave_s), lane = tid & 63, wave = wave_s;
    unsigned char* ws = p->ws;
    LAS float* scr = (LAS float*)(lds + wave * 8448);
    const int gw = bid * NWAVES + wave, NGW = G * NWAVES;
    bf16* WA = (bf16*)(ws + WS_WA); bf16* WB = (bf16*)(ws + WS_WB); bf16* WMKV = (bf16*)(ws + WS_WMKV); bf16* WO = (bf16*)(ws + WS_WO); bf16* WGU = (bf16*)(ws + WS_WGU); bf16* WD = (bf16*)(ws + WS_WD);
    constexpr int NB_A = 81, NB_B = 56, NB_KV = 48;
    constexpr int I_A = 16 * NB_A, I_B = 16 * NB_B, I_KV = 16 * NB_KV, I_MK = 2 * 16 * 16, I_O = 2 * 16 * 32, I_G = 32 * 16 * 16, I_U = I_G, I_D = 32 * 8 * 32;
    constexpr int NITEMS = I_A + I_B + I_KV + I_MK + I_O + I_G + I_U + I_D;
    for (int it = gw; it < NITEMS; it += NGW) {
        int r = it;
        if (r < I_G) { const int mat = r / 256, q = r % 256; transpose_item(p->in[I_WEG] + (size_t)mat * D * DEXP, DEXP, DEXP, D, WGU + (size_t)mat * 1024 * D, scr, q, 16, lane, [](int c) { return 256 * (c >> 7) + perm8(c & 127); }); continue; } r -= I_G;
        if (r < I_U) { const int mat = r / 256, q = r % 256; transpose_item(p->in[I_WEU] + (size_t)mat * D * DEXP, DEXP, DEXP, D, WGU + (size_t)mat * 1024 * D, scr, q, 16, lane, [](int c) { return 256 * (c >> 7) + 128 + perm8(c & 127); }); continue; } r -= I_U;
        if (r < I_D) { const int mat = r / 256, q = r % 256; transpose_item(p->in[I_WED] + (size_t)mat * DEXP * D, D, D, DEXP, WD + (size_t)mat * D * DEXP, scr, q, 32, lane, [](int c) { return perm8(c); }); continue; } r -= I_D;
        if (r < I_A) { transpose_item(p->in[I_WINA], A_IN, A_IN, D, WA, scr, r, NB_A, lane, [](int c) { if (c >= 1536 && c < 1552) return -1; const int L = c < 1536 ? c : c - 16; return perm8(L); }); continue; } r -= I_A;
        if (r < I_B) { transpose_item(p->in[I_WINB], B_IN, B_IN, D, WB, scr, r, NB_B, lane, [](int c) { if (c < 768) return (c & ~255) + head64(c & 255); return perm8(1536 + c); }); continue; } r -= I_B;
        if (r < I_KV) { transpose_item(p->in[I_WKV], KV_IN, KV_IN, D, WB, scr, r, NB_KV, lane, [](int c) { if (c < 768) { const int L = 768 + c; return (L & ~255) + head64(L & 255); } if (c < 1536) return perm8(768 + c); return -1; }); continue; } r -= I_KV;
        if (r < I_MK) { const int l = r / 256, q = r % 256; transpose_item(p->in[I_WMKV] + (size_t)l * D * 512, 512, 512, D, WMKV, scr, q, 16, lane, [l](int c) { return perm8(l * 512 + c); }); continue; } r -= I_MK;
        { const int l = r / 512, q = r % 512; transpose_item(p->in[I_WOUT] + (size_t)l * D * D, D, D, D, WO + (size_t)l * D * D, scr, q, 32, lane, [](int c) { return c; }); }
    }
    { const f32x4* src = (const f32x4*)p->in[I_MEM]; u32x2* dst = (u32x2*)(ws + WS_MEMB);
      for (int i = bid * NTHREADS + tid; i < NB * NMEM * D / 4; i += G * NTHREADS) { const f32x4 v = src[i]; u32x2 o; o.x = pk2(v[0], v[1]); o.y = pk2(v[2], v[3]); dst[i] = o; } }
    __syncthreads();
    LAS float* WG = (LAS float*)(lds);
    for (int idx = tid; idx < 16 * D; idx += NTHREADS) { const int j = idx & 15, k = idx >> 4; WG[j * D + k] = p->in[I_WINA][(size_t)k * A_IN + 1536 + j]; }
    __syncthreads();
    bf16* XB = (bf16*)(ws + WS_XB); float* GLR = (float*)(ws + WS_GLR);
    for (int m = gw; m < NTOK; m += NGW) {
        const f32x4* xr = (const f32x4*)(p->in[I_X] + (size_t)m * D) + lane;
        f32x4 v[4];
#pragma unroll
        for (int j = 0; j < 4; ++j) v[j] = xr[64 * j];
        u32x2* o8 = (u32x2*)(XB + (size_t)m * D) + lane;
#pragma unroll
        for (int j = 0; j < 4; ++j) { u32x2 o; o.x = pk2(v[j][0], v[j][1]); o.y = pk2(v[j][2], v[j][3]); o8[64 * j] = o; }
        float acc[16];
        const LAS float* wl = WG + 4 * lane; asm volatile("" : "+v"(wl));
#pragma unroll
        for (int n = 0; n < 16; ++n) { float a = 0.f;
#pragma unroll
            for (int j = 0; j < 4; ++j) { const f32x4 w = *(const LAS f32x4*)(wl + n * D + 256 * j); a += v[j][0] * w[0] + v[j][1] * w[1] + v[j][2] * w[2] + v[j][3] * w[3]; }
            acc[n] = a; if (n & 1) asm volatile("" : "+v"(acc[n - 1]), "+v"(acc[n]) :: "memory"); }
        const float r = multi_reduce16(acc, lane);
        if ((lane & 3) == 0) GLR[(size_t)m * 16 + (lane >> 2)] = r;
    }
}

struct EpiRes { const float* xres; float* out;
    __device__ __forceinline__ void operator()(const f32x4 (&acc)[2][2][4][2], const Unit& u, int wr, int wc, int fr, int fq) const {
        size_t off = (size_t)(u.pm * BM + wr * 64 + fr) * D + (u.pn * BM + wc * 32 + 4 * fq);
#pragma unroll
        for (int ai = 0; ai < 2; ++ai) {
#pragma unroll
            for (int m = 0; m < 4; ++m) { const float* xp = xres + off; float* op = out + off;
#pragma unroll
                for (int bj = 0; bj < 2; ++bj)
#pragma unroll
                    for (int n = 0; n < 2; ++n) { const f32x4 xr = *(const f32x4*)(xp + bj * HALF + n * 16); *(f32x4*)(op + bj * HALF + n * 16) = xr * DN_ALPHA + acc[ai][bj][m][n]; }
                off += (size_t)16 * D; asm volatile("" : "+v"(off) :: "memory"); }
            off += (size_t)64 * D; }
    } };
struct EpiInB { bf16 *Q, *K, *V, *OG, *MQ; const float* qg; const float* kg;
    __device__ __forceinline__ void operator()(const f32x4 (&acc)[2][2][4][2], const Unit& u, int wr, int wc, int fr, int fq) const {
        const int pn = u.pn;
        if (pn >= 6) { bf16* base; int ldd, c0;
            if (pn < 9) { base = V; ldd = 768; c0 = (pn - 6) * 256; } else if (pn < 12) { base = OG; ldd = 768; c0 = (pn - 9) * 256; } else { base = MQ; ldd = 256; c0 = 0; }
            store_bf16_tile(acc, base, ldd, u.pm * BM, c0, wr, wc, fr, fq); return; }
        const bool isq = pn < 3; bf16* base = isq ? Q : K; const float* g = isq ? qg : kg; const float sc = isq ? QC2 : 1.0f;
        const int c0 = (isq ? pn : pn - 3) * 256 + wc * 64 + 8 * fq, r0 = u.pm * BM + wr * 64 + fr;
        f32x4 gv[2][2];
#pragma unroll
        for (int bj = 0; bj < 2; ++bj)
#pragma unroll
            for (int n = 0; n < 2; ++n) gv[bj][n] = *(const f32x4*)(g + 32 * bj + 8 * fq + 4 * n) * sc;
        bf16* rowp = base + (size_t)r0 * 768 + c0;
#pragma unroll
        for (int ai = 0; ai < 2; ++ai) {
#pragma unroll
            for (int m = 0; m < 4; ++m) {
                float ss = 0.f;
#pragma unroll
                for (int bj = 0; bj < 2; ++bj)
#pragma unroll
                    for (int n = 0; n < 2; ++n) { const f32x4 v = acc[ai][bj][m][n]; ss += (v[0] * v[0] + v[1] * v[1]) + (v[2] * v[2] + v[3] * v[3]); }
                ss += __shfl_xor(ss, 16); ss += __shfl_xor(ss, 32);
                const float rs = rsqrtf(ss * (1.f / 64.f) + RMS_EPS);
#pragma unroll
                for (int bj = 0; bj < 2; ++bj) { const f32x4 v0 = acc[ai][bj][m][0] * rs * gv[bj][0], v1 = acc[ai][bj][m][1] * rs * gv[bj][1];
                    u32x4 w; w.x = cvt_pk_bf16(v0[0], v0[1]); w.y = cvt_pk_bf16(v0[2], v0[3]); w.z = cvt_pk_bf16(v1[0], v1[1]); w.w = cvt_pk_bf16(v1[2], v1[3]);
                    *(u32x4*)(rowp + 32 * bj) = w; }
                rowp += (size_t)16 * 768; asm volatile("" : "+v"(rowp)); }
            rowp += (size_t)64 * 768; }
    } };

__device__ __forceinline__ void load_wtab(LAS float* WT, const float* W, int ldw, int col0, int ncols, int tid) {
    for (int idx = tid; idx < 16 * D; idx += NTHREADS) { const int j = idx & 15, k = idx >> 4; WT[j * D + k] = j < ncols ? W[(size_t)k * ldw + col0 + j] : 0.f; }
}
__device__ __forceinline__ float row_dots16(const f32x4 (&v)[4], const LAS float* WT, int lane) {
    float acc[16];
    const LAS float* wl = WT + 4 * lane; asm volatile("" : "+v"(wl));
#pragma unroll
    for (int n = 0; n < 16; ++n) { float a = 0.f;
#pragma unroll
        for (int j = 0; j < 4; ++j) { const f32x4 w = *(const LAS f32x4*)(wl + n * D + 256 * j); a += v[j][0] * w[0] + v[j][1] * w[1] + v[j][2] * w[2] + v[j][3] * w[3]; }
        acc[n] = a; if (n & 1) asm volatile("" : "+v"(acc[n - 1]), "+v"(acc[n]) :: "memory"); }
    return multi_reduce16(acc, lane);
}
__device__ __forceinline__ void ln_row(f32x4 (&v)[4], const float* g, const float* b, int lane) {
    float s = 0.f;
#pragma unroll
    for (int j = 0; j < 4; ++j) s += (v[j][0] + v[j][1]) + (v[j][2] + v[j][3]);
    const float mean = wave_sum(s) * (1.f / D); float q = 0.f;
#pragma unroll
    for (int j = 0; j < 4; ++j) { v[j] = v[j] - mean; q += (v[j][0] * v[j][0] + v[j][1] * v[j][1]) + (v[j][2] * v[j][2] + v[j][3] * v[j][3]); }
    const float rstd = rsqrtf(wave_sum(q) * (1.f / D) + LN_EPS);
#pragma unroll
    for (int j = 0; j < 4; ++j) { const f32x4 gg = *(const f32x4*)(g + 4 * lane + 256 * j), bb = *(const f32x4*)(b + 4 * lane + 256 * j); v[j] = v[j] * rstd * gg + bb; }
}
__device__ __forceinline__ void store_row_f32_bf16(const f32x4 (&v)[4], float* xf, bf16* xb, int lane) {
#pragma unroll
    for (int j = 0; j < 4; ++j) { if (xf) ((f32x4*)xf)[lane + 64 * j] = v[j]; if (xb) { u32x2 o; o.x = pk2(v[j][0], v[j][1]); o.y = pk2(v[j][2], v[j][3]); ((u32x2*)xb)[lane + 64 * j] = o; } }
}

__device__ __forceinline__ void phase_ln_router(KP p, int layer, LAS unsigned char* lds, int G, int bid, const int wave_s) {
    const int tid = fresh_tid(wave_s), lane = tid & 63, wave = wave_s;
    unsigned char* ws = p->ws;
    LAS float* WT = (LAS float*)lds; LAS int* tokE = (LAS int*)(lds + 65536);
    load_wtab(WT, p->in[I_WR], 16, 0, 16, tid);
    float br = p->in[I_BR][(lane >> 2) & 15];
    __syncthreads();
    float* XF = p->out; bf16* XB = (bf16*)(ws + WS_XB); int* TOK_E = (int*)(ws + WS_TOKE); float* TOK_W = (float*)(ws + WS_TOKW); int* CNT = (int*)(ws + WS_CNT); int* SLOT_TOK = (int*)(ws + WS_SLOTTOK);
    const float* g = p->in[I_LMG] + layer * D; const float* b = p->in[I_LMB] + layer * D;
    for (int tb = bid; tb < NTOK / 128; tb += G) {
        for (int rr = 0; rr < 16; ++rr) {
            const int lt = wave * 16 + rr, m = tb * 128 + lt;
            f32x4 v[4];
#pragma unroll
            for (int j = 0; j < 4; ++j) v[j] = ((const f32x4*)(XF + (size_t)m * D))[lane + 64 * j];
            ln_row(v, g, b, lane);
            store_row_f32_bf16(v, XF + (size_t)m * D, XB + (size_t)m * D, lane);
            const float lg = row_dots16(v, WT, lane);
            const float af = 1.f / (1.f + __expf(-lg)), sl = af + br;
            float aff[16], sel[16];
#pragma unroll
            for (int e = 0; e < 16; ++e) { aff[e] = __shfl(af, 4 * e); sel[e] = __shfl(sl, 4 * e); }
            int gbest = 0; float gs = -1e30f;
#pragma unroll
            for (int gi = 0; gi < 4; ++gi) { float a = -1e30f, b2 = -1e30f;
#pragma unroll
                for (int j = 0; j < 4; ++j) { const float x = sel[gi * 4 + j]; if (x > a) { b2 = a; a = x; } else if (x > b2) b2 = x; }
                if (a + b2 > gs) { gs = a + b2; gbest = gi; } }
            int i0 = 0, i1 = 0; float a = -1e30f, b2 = -1e30f; float ga[4];
#pragma unroll
            for (int j = 0; j < 4; ++j) { float x = sel[j], y = aff[j];
#pragma unroll
                for (int gi = 1; gi < 4; ++gi) if (gi == gbest) { x = sel[gi * 4 + j]; y = aff[gi * 4 + j]; }
                ga[j] = y;
                if (x > a) { b2 = a; i1 = i0; a = x; i0 = j; } else if (x > b2) { b2 = x; i1 = j; } }
            float w0 = ga[0], w1 = ga[0];
#pragma unroll
            for (int j = 1; j < 4; ++j) { if (i0 == j) w0 = ga[j]; if (i1 == j) w1 = ga[j]; }
            const float inv = 1.f / (w0 + w1); const int e0 = gbest * 4 + i0, e1 = gbest * 4 + i1;
            if (lane == 0) { TOK_E[m * 2] = e0; TOK_E[m * 2 + 1] = e1; TOK_W[m * 2] = w0 * inv; TOK_W[m * 2 + 1] = w1 * inv; tokE[lt * 2] = e0; tokE[lt * 2 + 1] = e1; }
        }
        __syncthreads();
        if (tid < 256) {
            const int e = tokE[tid]; int rank = 0;
            for (int i = 0; i < tid; ++i) rank += (tokE[i] == e) ? 1 : 0;
            SLOT_TOK[(e * 256 + tb) * 128 + rank] = tb * 256 + tid;
        } else if (tid < 272) { const int e = tid - 256; int c = 0; for (int i = 0; i < 256; ++i) c += (tokE[i] == e) ? 1 : 0; CNT[tb * 16 + e] = c; }
        __syncthreads();
    }
}
__device__ __forceinline__ void phase_ln_ffn(KP p, int layer, LAS unsigned char* lds, int G, int bid, const int wave_s) {
    const int tid = fresh_tid(wave_s), lane = tid & 63, wave = wave_s;
    unsigned char* ws = p->ws;
    LAS float* WT = (LAS float*)lds;
    if (layer == 0) { load_wtab(WT, p->in[I_WKV], KV_IN, 1536, 12, tid); __syncthreads(); }
    const int eo = (lane >> 2) & 15; const float bf = (layer == 0 && eo < 12) ? p->in[I_BFORGET][eo] : 0.f;
    float* XF = p->out; bf16* XB = (bf16*)(ws + WS_XB); const bf16* YS = (const bf16*)(ws + WS_HREG);
    const int* TOK_S = (const int*)(ws + WS_TOKS); const float* TOK_W = (const float*)(ws + WS_TOKW); float* LOGF = (float*)(ws + WS_LOGF);
    const float* g = p->in[I_LFG] + layer * D; const float* b = p->in[I_LFB] + layer * D;
    const int gw = bid * NWAVES + wave, NGW = G * NWAVES;
    for (int m = gw; m < NTOK; m += NGW) {
        const int s0 = TOK_S[m * 2], s1 = TOK_S[m * 2 + 1]; const float w0 = TOK_W[m * 2], w1 = TOK_W[m * 2 + 1];
        f32x4 v[4];
#pragma unroll
        for (int j = 0; j < 4; ++j) { const f32x4 x = ((const f32x4*)(XF + (size_t)m * D))[lane + 64 * j];
            const u32x2 a = ((const u32x2*)(YS + (size_t)s0 * D))[lane + 64 * j], c = ((const u32x2*)(YS + (size_t)s1 * D))[lane + 64 * j];
            f32x4 ya, yc; ya[0] = __uint_as_float(a.x << 16); ya[1] = __uint_as_float(a.x & 0xffff0000u); ya[2] = __uint_as_float(a.y << 16); ya[3] = __uint_as_float(a.y & 0xffff0000u);
            yc[0] = __uint_as_float(c.x << 16); yc[1] = __uint_as_float(c.x & 0xffff0000u); yc[2] = __uint_as_float(c.y << 16); yc[3] = __uint_as_float(c.y & 0xffff0000u);
            v[j] = x * DN_ALPHA + ya * w0 + yc * w1; }
        ln_row(v, g, b, lane);
        store_row_f32_bf16(v, XF + (size_t)m * D, layer == 0 ? XB + (size_t)m * D : (bf16*)nullptr, lane);
        if (layer == 0) { const float t = row_dots16(v, WT, lane); if ((lane & 3) == 0 && eo < 12) LOGF[(size_t)m * 12 + eo] = log_sigmoid(t + bf); }
    }
}
__device__ __forceinline__ void cum_wave(const float* LOGF, float* CUM, int bh, int lane) {
    const int b = bh / FOX_H, h = bh % FOX_H;
    float loc[64]; float s = 0.f;
#pragma unroll
    for (int i = 0; i < 64; ++i) { s += LOGF[((size_t)b * SEQ + lane * 64 + i) * 12 + h]; loc[i] = s; }
    float inc = s;
#pragma unroll
    for (int o = 1; o < 64; o <<= 1) { const float t = __shfl_up(inc, o); if (lane >= o) inc += t; }
    const float base = inc - s;
#pragma unroll
    for (int i = 0; i < 64; ++i) CUM[(size_t)bh * SEQ + lane * 64 + i] = base + loc[i];
}
constexpr int MOE_MAXU = 6;
__device__ __forceinline__ int moe_setup(unsigned char* ws, LAS unsigned char* lds, int G, int bid, const int wave_s, const bool build_rows) {
    const int tid = fresh_tid(wave_s), lane = tid & 63, wave = wave_s;
    LAS int* PRE = (LAS int*)lds; LAS int* TB = (LAS int*)(lds + 16640); LAS int* TE = TB + 17;
    volatile LAS int* UL = (volatile LAS int*)(lds + MISC_OFF) + 16; LAS int* rowtok = (LAS int*)(lds + ROWTOK_OFF);
    const int* CNT = (const int*)(ws + WS_CNT); const int* SLOT_TOK = (const int*)(ws + WS_SLOTTOK); int* TOK_S = (int*)(ws + WS_TOKS);
#pragma unroll
    for (int q = 0; q < 2; ++q) { const int e = 2 * wave + q;
        int c[4]; int s = 0;
#pragma unroll
        for (int i = 0; i < 4; ++i) { c[i] = CNT[(4 * lane + i) * 16 + e]; s += c[i]; }
        int inc = s;
#pragma unroll
        for (int o = 1; o < 64; o <<= 1) { const int t = __shfl_up(inc, o); if (lane >= o) inc += t; }
        int run = inc - s;
#pragma unroll
        for (int i = 0; i < 4; ++i) { PRE[e * 257 + 4 * lane + i] = run; run += c[i]; }
        if (lane == 63) { PRE[e * 257 + 256] = inc; TE[e] = inc; } }
    __syncthreads();
    if (tid == 0) { int t = 0; for (int e = 0; e < 16; ++e) { TB[e] = t; t += (TE[e] + 255) >> 8; } TB[16] = t; }
    __syncthreads();
    const int NT = TB[16];
    if (tid == 0) { int n = 0;
        for (int i = 0; i < MOE_MAXU; ++i) { const int L = i * G + bid, tile = (L & 7) + 8 * (L >> 5), pn = (L >> 3) & 3; if (tile >= NT) break;
            int e = 0; for (int k = 1; k < 16; ++k) if (TB[k] <= tile) e = k;
            UL[3 * n] = tile; UL[3 * n + 1] = pn; UL[3 * n + 2] = e; ++n; }
        UL[24] = n; }
    __syncthreads();
    const int nunits = __builtin_amdgcn_readfirstlane(UL[24]);
    if (build_rows) {
        for (int i = (tid >> 8); i < nunits; i += 2) { const int tile = UL[3 * i], pn = UL[3 * i + 1], e = UL[3 * i + 2], j = tid & 255;
            const int r = 256 * (tile - TB[e]) + j; int tok = 0;
            if (r < TE[e]) { int lo = 0, hi = 256;
                while (hi - lo > 1) { const int mid = (lo + hi) >> 1; if (PRE[e * 257 + mid] <= r) lo = mid; else hi = mid; }
                const int ent = SLOT_TOK[(e * 256 + lo) * 128 + (r - PRE[e * 257 + lo])]; tok = ent >> 1;
                if (pn == 0) TOK_S[ent] = 256 * tile + j; }
            rowtok[i * 256 + j] = tok; }
    }
    __syncthreads();
    return nunits;
}
struct MoeGU {
    const char* XBp; const char* W; LAS const int* UL; LAS const int* rowtok; int nunits;
    __device__ __forceinline__ bool next(int i, Unit& u) const { if (i >= nunits) return false;
        u.pm = __builtin_amdgcn_readfirstlane(UL[3 * i]); u.pn = __builtin_amdgcn_readfirstlane(UL[3 * i + 1]); u.e = __builtin_amdgcn_readfirstlane(UL[3 * i + 2]); u.ord = i;
        u.A = XBp; u.B = W + ((size_t)u.e * 1024 + (size_t)u.pn * 256) * D * 2; return true; }
    __device__ __forceinline__ unsigned a_off(const Unit& u, int h, int R, int C) const { return (unsigned)(rowtok[u.ord * 256 + R + HALF * h] * D + C) * 2u; }
};
struct MoeDown {
    const char* Hp; const char* W; LAS const int* UL; int nunits;
    __device__ __forceinline__ bool next(int i, Unit& u) const { if (i >= nunits) return false;
        u.pm = __builtin_amdgcn_readfirstlane(UL[3 * i]); u.pn = __builtin_amdgcn_readfirstlane(UL[3 * i + 1]); u.e = __builtin_amdgcn_readfirstlane(UL[3 * i + 2]); u.ord = i;
        u.A = Hp + (size_t)u.pm * BM * DEXP * 2; u.B = W + ((size_t)u.e * 1024 + (size_t)u.pn * 256) * DEXP * 2; return true; }
    __device__ __forceinline__ unsigned a_off(const Unit&, int h, int R, int C) const { return (unsigned)((R + HALF * h) * DEXP + C) * 2u; }
};
struct EpiGateUp { bf16* H;
    __device__ __forceinline__ void operator()(const f32x4 (&acc)[2][2][4][2], const Unit& u, int wr, int wc, int fr, int fq) const {
        bf16* rowp = H + (size_t)(u.pm * BM + wr * 64 + fr) * DEXP + (u.pn * 128 + wc * 32 + 8 * fq);
#pragma unroll
        for (int ai = 0; ai < 2; ++ai) {
#pragma unroll
            for (int m = 0; m < 4; ++m) { float hv[8];
#pragma unroll
                for (int n = 0; n < 2; ++n)
#pragma unroll
                    for (int j = 0; j < 4; ++j) { const float g = acc[ai][0][m][n][j], up = acc[ai][1][m][n][j]; hv[4 * n + j] = g * __builtin_amdgcn_rcpf(1.f + __expf(-g)) * up; }
                u32x4 w; w.x = cvt_pk_bf16(hv[0], hv[1]); w.y = cvt_pk_bf16(hv[2], hv[3]); w.z = cvt_pk_bf16(hv[4], hv[5]); w.w = cvt_pk_bf16(hv[6], hv[7]);
                *(u32x4*)rowp = w;
                rowp += (size_t)16 * DEXP; asm volatile("" : "+v"(rowp)); }
            rowp += (size_t)64 * DEXP; }
    } };
constexpr int AT_K = 0, AT_V = 8192, AT_KB = 16384, AT_WS = 16640, AT_OST = 18688, AT_BYTES = AT_OST + 8 * 4096;
__device__ __forceinline__ int crow(int r, int hi) { return (r & 3) + 8 * (r >> 2) + 4 * hi; }
__device__ __forceinline__ unsigned cvtpk_s(float lo, float hi) { typedef float f2 __attribute__((ext_vector_type(2))); typedef __bf16 b2 __attribute__((ext_vector_type(2))); f2 v = {lo, hi}; b2 b = __builtin_convertvector(v, b2); return __builtin_bit_cast(unsigned, b); }
__device__ __forceinline__ float bfbits2f(unsigned short v) { return __uint_as_float(((unsigned)v) << 16); }

template <bool FOX>
__device__ __forceinline__ void attn_unit(LAS unsigned char* lds, const bf16* Qp, int qpitch, const bf16* Kp, const bf16* Vp, int kvpitch, int NT, const float* cum, bf16* Op, int opitch, const bf16* OGp, int gpitch, const int wave_s) {
    const int tid = fresh_tid(wave_s), lane = tid & 63, wid = wave_s, r32 = lane & 31, hi = lane >> 5;
    LAS float* wsf = (LAS float*)(lds + AT_WS) + wid * 64;
    LAS float* kbs = (LAS float*)(lds + AT_KB);
    bf16x8 qr[4];
#pragma unroll
    for (int d0 = 0; d0 < 4; ++d0) qr[d0] = *(const bf16x8*)(Qp + (size_t)(wid * 32 + r32) * qpitch + d0 * 16 + hi * 8);
    const bf16* ksrc = Kp + (size_t)lane * kvpitch + wid * 8;
    const bf16* vsrc = Vp + (size_t)(16 * (wid & 3) + (lane >> 2)) * kvpitch + (wid >> 2) * 32 + (lane & 3) * 8;
    LAS unsigned char* kdst = lds + AT_K + wid * 1024 + lane * 16; LAS unsigned char* vdst = lds + AT_V + wid * 1024 + lane * 16;
    const LAS unsigned char* kb = lds + AT_K + hi * 1024 + r32 * 16;
    const int vb0 = (int)(unsigned)(size_t)(lds + AT_V) + ((lane >> 4) & 1) * 32 + (lane & 3) * 8 + (4 * hi + ((lane & 15) >> 2)) * 64;
    float mrun = -1e30f, lrun = 0.f; f32x16 o[2]; o[0] = f32x16{}; o[1] = f32x16{};
    u32x4 kreg = *(const u32x4*)ksrc, vreg = *(const u32x4*)vsrc; float breg = 0.f;
    if (FOX && wid == 0) breg = -cum[lane] * LOG2E;
    const int qrel = wid * 32 + r32;
#pragma unroll 1
    for (int t = 0; t < NT; ++t) {
        __syncthreads();
        *(LAS u32x4*)kdst = kreg; *(LAS u32x4*)vdst = vreg; if (FOX && wid == 0) kbs[lane] = breg;
        __syncthreads();
        if (t + 1 < NT) { kreg = *(const u32x4*)(ksrc + (size_t)(t + 1) * 64 * kvpitch); vreg = *(const u32x4*)(vsrc + (size_t)(t + 1) * 64 * kvpitch); if (FOX && wid == 0) breg = -cum[(t + 1) * 64 + lane] * LOG2E; }
        f32x16 p0 = f32x16{}, p1 = f32x16{};
#pragma unroll
        for (int d0 = 0; d0 < 4; ++d0) { const bf16x8 b0 = *(const LAS bf16x8*)(kb + d0 * 2048), b1 = *(const LAS bf16x8*)(kb + d0 * 2048 + 512);
            p0 = __builtin_amdgcn_mfma_f32_32x32x16_bf16(b0, qr[d0], p0, 0, 0, 0); p1 = __builtin_amdgcn_mfma_f32_32x32x16_bf16(b1, qr[d0], p1, 0, 0, 0); }
        if (FOX) {
#pragma unroll
            for (int g = 0; g < 4; ++g) { const f32x4 b0 = *(const LAS f32x4*)(kbs + 8 * g + 4 * hi), b1 = *(const LAS f32x4*)(kbs + 32 + 8 * g + 4 * hi);
#pragma unroll
                for (int j = 0; j < 4; ++j) { p0[4 * g + j] += b0[j]; p1[4 * g + j] += b1[j]; } }
            const int jb = t - (NT - 4);
            if (jb >= 0) { const int kbase = 64 * jb + 4 * hi;
#pragma unroll
                for (int r = 0; r < 16; ++r) { const int kv = kbase + (r & 3) + 8 * (r >> 2); if (kv > qrel) p0[r] = -INFINITY; if (kv + 32 > qrel) p1[r] = -INFINITY; } }
        } else {
#pragma unroll
            for (int r = 0; r < 16; ++r) { p0[r] *= QC2; p1[r] *= QC2; }
        }
        float rm = fmaxf(p0[0], p1[0]);
#pragma unroll
        for (int r = 1; r < 16; ++r) rm = fmaxf(rm, fmaxf(p0[r], p1[r]));
        { auto rr = __builtin_amdgcn_permlane32_swap(__float_as_uint(rm), __float_as_uint(rm), false, false); rm = fmaxf(__uint_as_float(rr[0]), __uint_as_float(rr[1])); }
        const float mn = fmaxf(mrun, rm), alpha = __builtin_amdgcn_exp2f(mrun - mn); mrun = mn;
        float rs = 0.f;
#pragma unroll
        for (int r = 0; r < 16; ++r) { p0[r] = __builtin_amdgcn_exp2f(p0[r] - mn); p1[r] = __builtin_amdgcn_exp2f(p1[r] - mn); rs += p0[r] + p1[r]; }
        lrun = lrun * alpha + rs;
        if (hi == 0) wsf[r32] = alpha;
        asm volatile("s_waitcnt lgkmcnt(0)" ::: "memory");
#pragma unroll
        for (int g = 0; g < 4; ++g) { const f32x4 a = *(const LAS f32x4*)(wsf + 8 * g + 4 * hi);
#pragma unroll
            for (int j = 0; j < 4; ++j) { o[0][4 * g + j] *= a[j]; o[1][4 * g + j] *= a[j]; } }
        u32x4 pw[4];
#pragma unroll
        for (int k = 0; k < 2; ++k) {
            pw[k] = (u32x4){cvtpk_s(p0[8 * k], p0[8 * k + 1]), cvtpk_s(p0[8 * k + 2], p0[8 * k + 3]), cvtpk_s(p0[8 * k + 4], p0[8 * k + 5]), cvtpk_s(p0[8 * k + 6], p0[8 * k + 7])};
            pw[2 + k] = (u32x4){cvtpk_s(p1[8 * k], p1[8 * k + 1]), cvtpk_s(p1[8 * k + 2], p1[8 * k + 3]), cvtpk_s(p1[8 * k + 4], p1[8 * k + 5]), cvtpk_s(p1[8 * k + 6], p1[8 * k + 7])}; }
#pragma unroll
        for (int d0 = 0; d0 < 2; ++d0) { s16x4 vlo[4], vhi[4];
#pragma unroll
            for (int ks = 0; ks < 4; ++ks) {
                asm volatile("ds_read_b64_tr_b16 %0,%1 offset:%c2" : "=&v"(vlo[ks]) : "v"(vb0), "i"(d0 * 4096 + ks * 1024) : "memory");
                asm volatile("ds_read_b64_tr_b16 %0,%1 offset:%c2" : "=&v"(vhi[ks]) : "v"(vb0), "i"(d0 * 4096 + ks * 1024 + 512) : "memory"); }
            asm volatile("s_waitcnt lgkmcnt(0)" ::: "memory"); __builtin_amdgcn_sched_barrier(0);
#pragma unroll
            for (int ks = 0; ks < 4; ++ks) { const bf16x8 vf = (bf16x8){vlo[ks][0], vlo[ks][1], vlo[ks][2], vlo[ks][3], vhi[ks][0], vhi[ks][1], vhi[ks][2], vhi[ks][3]};
                o[d0] = __builtin_amdgcn_mfma_f32_32x32x16_bf16(__builtin_bit_cast(bf16x8, pw[ks]), vf, o[d0], 0, 0, 0); }
        }
    }
    { auto rr = __builtin_amdgcn_permlane32_swap(__float_as_uint(lrun), __float_as_uint(lrun), false, false); lrun = __uint_as_float(rr[0]) + __uint_as_float(rr[1]); }
    if (hi == 0) wsf[32 + r32] = lrun;
    asm volatile("s_waitcnt lgkmcnt(0)" ::: "memory");
    LAS bf16* stg = (LAS bf16*)(lds + AT_OST) + wid * 2048;
#pragma unroll
    for (int r = 0; r < 16; ++r) { const int orow = crow(r, hi); const float rl = __builtin_amdgcn_rcpf(wsf[32 + orow]);
#pragma unroll
        for (int d0 = 0; d0 < 2; ++d0) stg[orow * 64 + d0 * 32 + r32] = f2bf(o[d0][r] * rl); }
    asm volatile("s_waitcnt lgkmcnt(0)" ::: "memory");
#pragma unroll
    for (int i = 0; i < 4; ++i) { const int row = i * 8 + (lane >> 3), ch = lane & 7; u32x4 v = *(const LAS u32x4*)(stg + row * 64 + ch * 8);
        const size_t go = (size_t)(wid * 32 + row) * opitch + ch * 8;
        if (FOX) { const u32x4 g = *(const u32x4*)(OGp + (size_t)(wid * 32 + row) * gpitch + ch * 8); unsigned vv[4] = {v.x, v.y, v.z, v.w}; const unsigned gg[4] = {g.x, g.y, g.z, g.w};
#pragma unroll
            for (int k = 0; k < 4; ++k) { const float a0 = __uint_as_float(vv[k] << 16), a1 = __uint_as_float(vv[k] & 0xffff0000u), g0 = __uint_as_float(gg[k] << 16), g1 = __uint_as_float(gg[k] & 0xffff0000u);
                vv[k] = cvtpk_s(a0 * __builtin_amdgcn_rcpf(1.f + __expf(-g0)), a1 * __builtin_amdgcn_rcpf(1.f + __expf(-g1))); }
            v = (u32x4){vv[0], vv[1], vv[2], vv[3]}; }
        *(u32x4*)(Op + go) = v; }
    __syncthreads();
}
__device__ __forceinline__ void phase_attn_fox(unsigned char* ws, LAS unsigned char* lds, int G, int bid, const int wave_s) {
    const bf16* Q = (const bf16*)(ws + WS_HREG); const bf16* K = (const bf16*)(ws + WS_HREG + HR_48); const bf16* V = (const bf16*)(ws + WS_HREG + 2 * HR_48); const bf16* OG = (const bf16*)(ws + WS_HREG + 3 * HR_48);
    const float* CUM = (const float*)(ws + WS_CUM); bf16* OC = (bf16*)(ws + WS_XB);
    for (int v = bid; v < 256; v += G) {
        const int g = v & 31, jm = v >> 5;
        for (int i = 0; i < 6; ++i) { const int pidx = 3 * jm + (i >> 1), bh = 3 * g + (pidx >> 3), s = pidx & 7, qb = (i & 1) ? 15 - s : s;
            const int b = bh / FOX_H, h = bh % FOX_H; const size_t row0 = (size_t)b * SEQ;
            attn_unit<true>(lds, Q + (row0 + qb * 256) * 768 + h * 64, 768, K + row0 * 768 + h * 64, V + row0 * 768 + h * 64, 768, 4 * (qb + 1), CUM + (size_t)bh * SEQ,
                            OC + (row0 + qb * 256) * D + h * 64, D, OG + (row0 + qb * 256) * 768 + h * 64, 768, wave_s); }
    }
}
__device__ __forceinline__ void phase_attn_mem(unsigned char* ws, LAS unsigned char* lds, int layer, int G, int bid, const int wave_s) {
    const bf16* MQ = (const bf16*)(ws + WS_HREG + (layer == 0 ? 3 : 4) * HR_48); const bf16* MKV = (const bf16*)(ws + WS_MKV); bf16* OC = (bf16*)(ws + WS_XB);
    for (int u = bid; u < 512; u += G) { const int b = u >> 6, hd = (u >> 4) & 3, qblk = u & 15; const size_t row0 = (size_t)b * SEQ + qblk * 256;
        const bf16* Kp = MKV + (size_t)b * NMEM * 1024 + layer * 512 + hd * 64;
        attn_unit<false>(lds, MQ + row0 * 256 + hd * 64, 256, Kp, Kp + 256, 1024, 4, nullptr, OC + row0 * D + 768 + hd * 64, D, nullptr, 0, wave_s); }
}
constexpr int GL_QP = 208, GL_VP = 448, GL_KX = 0, GL_QD = 13312, GL_VT = 26624, GL_HEAD = 55296;
constexpr int GL_GLR = 2 * GL_HEAD, GL_TOT = GL_GLR + 4096, GL_SSX = GL_TOT + 1536, GL_BYTES = GL_SSX + 1024;
static_assert(GL_BYTES <= RING_BYTES, "GLA LDS");
typedef short v4i16_t __attribute__((ext_vector_type(4)));
__device__ __forceinline__ s16x4 trd(const LAS unsigned char* p) { return __builtin_bit_cast(s16x4, __builtin_amdgcn_ds_read_tr16_b64_v4i16((LAS v4i16_t*)p)); }
__device__ __forceinline__ float fast_log_sigmoid(float z) { return fminf(z, 0.f) - __logf(1.f + __expf(-fabsf(z))); }

__device__ __forceinline__ void gla_stage(unsigned char* ws, LAS unsigned char* lds, int tid, int b, int n, int hp) {
    const bf16* V = (const bf16*)(ws + WS_HREG + HR_48); const float* GLR = (const float*)(ws + WS_GLR);
    const size_t m0 = (size_t)b * SEQ + n * 64;
#pragma unroll
    for (int i = 0; i < 6; ++i) { const int pi = tid + 512 * i, u = pi / 1536, rem = pi % 1536, row = rem / 24, ch = rem % 24;
        const u32x4 v = *(const u32x4*)(V + (m0 + row) * 768 + 192 * (2 * hp + u) + 8 * ch);
        *(LAS u32x4*)(lds + u * GL_HEAD + GL_VT + row * GL_VP + ch * 16) = v; }
    if (tid < 256) { const f32x4 g = *(const f32x4*)(GLR + m0 * 16 + 4 * tid); *(LAS f32x4*)(lds + GL_GLR + 16 * tid) = g; }
}
template <int MODE>
__device__ __forceinline__ void gla_gates(KP p, unsigned char* ws, LAS unsigned char* lds, int tid, int b, int n, int hp) {
    const bf16* QK = (const bf16*)(ws + WS_HREG); float* DEC = (float*)(ws + WS_DEC);
    const size_t m0 = (size_t)b * SEQ + n * 64;
    LAS float* glr = (LAS float*)(lds + GL_GLR); LAS float* totl = (LAS float*)(lds + GL_TOT);
    float la[32]; float tot = 0.f; int col = 0, th = 0, u = 0, kidx = 0, head = 0;
    if (tid < 384) { col = tid % 192; th = tid / 192; u = col / 96; kidx = col % 96; head = 2 * hp + u;
        float w[16];
#pragma unroll
        for (int j = 0; j < 16; ++j) w[j] = p->in[I_WGUP][j * 384 + 96 * head + kidx];
        const float bg = p->in[I_BGATE][96 * head + kidx];
#pragma unroll
        for (int i = 0; i < 32; ++i) { const LAS float* gr = glr + (32 * th + i) * 16; float z = bg;
#pragma unroll
            for (int j4 = 0; j4 < 4; ++j4) { const f32x4 g = *(const LAS f32x4*)(gr + 4 * j4); z += g[0] * w[4 * j4] + g[1] * w[4 * j4 + 1] + g[2] * w[4 * j4 + 2] + g[3] * w[4 * j4 + 3]; }
            la[i] = fast_log_sigmoid(z) * (1.f / 16.f); tot += la[i]; }
        totl[th * 192 + col] = tot; }
    __syncthreads();
    if (tid < 384) {
        LAS bf16* KX = (LAS bf16*)(lds + u * GL_HEAD + GL_KX); LAS bf16* QD = (LAS bf16*)(lds + u * GL_HEAD + GL_QD);
        const bf16* qk = QK + (m0 + 32 * th) * 768 + 96 * head + kidx;
        if (MODE == 0) {
            float run = (th == 1) ? 0.f : totl[192 + col];
#pragma unroll
            for (int i = 31; i >= 0; --i) { const float kv = bf2f(qk[(size_t)i * 768 + 384]); KX[(32 * th + i) * (GL_QP / 2) + kidx] = f2bf(kv * __expf(run)); run += la[i]; }
            if (th == 0) DEC[(((size_t)b * 64 + n) * 4 + head) * 96 + kidx] = __expf(run);
        } else {
            float run = (th == 0) ? 0.f : totl[col];
#pragma unroll
            for (int i = 0; i < 32; ++i) { run += la[i]; const float qv = bf2f(qk[(size_t)i * 768]), kv = bf2f(qk[(size_t)i * 768 + 384]);
                QD[(32 * th + i) * (GL_QP / 2) + kidx] = f2bf(qv * __expf(run) * 0.10206207261596577f); KX[(32 * th + i) * (GL_QP / 2) + kidx] = f2bf(kv * __expf(-run)); }
        }
    }
    __syncthreads();
}
__device__ __forceinline__ void phase_gla_kv(KP p, LAS unsigned char* lds, int G, int bid, const int wave_s) {
    unsigned char* ws = p->ws; bf16* SKV = (bf16*)(ws + WS_GREG);
    for (int unit = bid; unit < NB * 64 * 2; unit += G) {
        const int tid = fresh_tid(wave_s), lane = tid & 63, wid = wave_s;
        const int hp = unit & 1, n = (unit >> 1) & 63, b = unit >> 7;
        gla_stage(ws, lds, tid, b, n, hp);
        __syncthreads();
        gla_gates<0>(p, ws, lds, tid, b, n, hp);
        const int u = wid >> 2, j4 = wid & 3, head = 2 * hp + u, r32 = lane & 31, h2 = lane >> 5, q = (lane & 15) >> 2, pp = lane & 3, g1 = (lane >> 4) & 1;
        const LAS unsigned char* ka = lds + u * GL_HEAD + GL_KX + (8 * h2 + q) * GL_QP + (16 * g1 + 4 * pp) * 2;
        const LAS unsigned char* va = lds + u * GL_HEAD + GL_VT + (8 * h2 + q) * GL_VP + (16 * g1 + 4 * pp) * 2;
        bf16* outb = SKV + ((((size_t)b * 64 + n) * 4 + head) * 192) * 96;
        for (int id = j4; id < 18; id += 4) { const int kb = id / 6, cb = id % 6;
            f32x16 acc = f32x16{};
#pragma unroll
            for (int ks = 0; ks < 4; ++ks) {
                const s16x4 a0 = trd(ka + ks * 16 * GL_QP + kb * 64), a1 = trd(ka + ks * 16 * GL_QP + 4 * GL_QP + kb * 64);
                const s16x4 b0 = trd(va + ks * 16 * GL_VP + cb * 64), b1 = trd(va + ks * 16 * GL_VP + 4 * GL_VP + cb * 64);
                acc = __builtin_amdgcn_mfma_f32_32x32x16_bf16((bf16x8){a0[0], a0[1], a0[2], a0[3], a1[0], a1[1], a1[2], a1[3]}, (bf16x8){b0[0], b0[1], b0[2], b0[3], b1[0], b1[1], b1[2], b1[3]}, acc, 0, 0, 0); }
            bf16* op = outb + (size_t)(32 * cb + r32) * 96 + 32 * kb + 4 * h2;
#pragma unroll
            for (int g = 0; g < 4; ++g) { u32x2 w; w.x = cvtpk_s(acc[4 * g], acc[4 * g + 1]); w.y = cvtpk_s(acc[4 * g + 2], acc[4 * g + 3]); *(u32x2*)(op + 8 * g) = w; }
        }
        __syncthreads();
    }
}
__device__ __forceinline__ void phase_gla_scan(unsigned char* ws, int G, int bid, const int wave_s) {
    bf16* SKV = (bf16*)(ws + WS_GREG); const float* DEC = (const float*)(ws + WS_DEC);
    const int tid = fresh_tid(wave_s);
    const int per = (NB * 4 * 192 * 12 + G - 1) / G;
    for (int it = tid; it < per; it += NTHREADS) { const int item = bid * per + it; if (item >= NB * 4 * 192 * 12) break;
        const int k8 = item % 12, c = (item / 12) % 192, bh = item / (12 * 192), b = bh >> 2, h = bh & 3;
        float s[8];
#pragma unroll
        for (int j = 0; j < 8; ++j) s[j] = 0.f;
#pragma unroll 4
        for (int n = 0; n < 64; ++n) { const size_t ub = ((size_t)b * 64 + n) * 4 + h;
            u32x4* ptr = (u32x4*)(SKV + (ub * 192 + c) * 96 + 8 * k8); const u32x4 kv = *ptr;
            const f32x4 d0 = *(const f32x4*)(DEC + ub * 96 + 8 * k8), d1 = *(const f32x4*)(DEC + ub * 96 + 8 * k8 + 4);
            u32x4 o; o.x = cvtpk_s(s[0], s[1]); o.y = cvtpk_s(s[2], s[3]); o.z = cvtpk_s(s[4], s[5]); o.w = cvtpk_s(s[6], s[7]); *ptr = o;
            const unsigned kw[4] = {kv.x, kv.y, kv.z, kv.w};
#pragma unroll
            for (int j = 0; j < 4; ++j) { const float dlo = j < 2 ? d0[2 * j] : d1[2 * j - 4], dhi = j < 2 ? d0[2 * j + 1] : d1[2 * j - 3];
                s[2 * j] = dlo * s[2 * j] + __uint_as_float(kw[j] << 16); s[2 * j + 1] = dhi * s[2 * j + 1] + __uint_as_float(kw[j] & 0xffff0000u); } }
    }
}
__device__ __forceinline__ void phase_gla_out(KP p, LAS unsigned char* lds, int G, int bid, const int wave_s) {
    unsigned char* ws = p->ws; const bf16* SKV = (const bf16*)(ws + WS_GREG); const bf16* R = (const bf16*)(ws + WS_HREG + 2 * HR_48); bf16* OC = (bf16*)(ws + WS_XB);
    for (int unit = bid; unit < NB * 64 * 2; unit += G) {
        const int tid = fresh_tid(wave_s), lane = tid & 63, wid = wave_s;
        const int hp = unit & 1, n = (unit >> 1) & 63, b = unit >> 7;
        gla_stage(ws, lds, tid, b, n, hp);
        __syncthreads();
        gla_gates<1>(p, ws, lds, tid, b, n, hp);
        const int u = wid >> 2, tb = wid & 1, ch = (wid >> 1) & 1, head = 2 * hp + u, r32 = lane & 31, h2 = lane >> 5, q = (lane & 15) >> 2, pp = lane & 3, g1 = (lane >> 4) & 1;
        const LAS unsigned char* kx = lds + u * GL_HEAD + GL_KX + r32 * GL_QP + 16 * h2;
        const LAS unsigned char* qd = lds + u * GL_HEAD + GL_QD + (32 * tb + r32) * GL_QP + 16 * h2;
        const LAS unsigned char* va = lds + u * GL_HEAD + GL_VT + (4 * h2 + q) * GL_VP + (16 * g1 + 4 * pp) * 2;
        bf16x8 qf[6];
#pragma unroll
        for (int ks = 0; ks < 6; ++ks) qf[ks] = *(const LAS bf16x8*)(qd + 32 * ks);
        f32x16 at0 = f32x16{}, at1 = f32x16{};
#pragma unroll
        for (int ks = 0; ks < 6; ++ks) at0 = __builtin_amdgcn_mfma_f32_32x32x16_bf16(*(const LAS bf16x8*)(kx + 32 * ks), qf[ks], at0, 0, 0, 0);
        if (tb == 1) {
#pragma unroll
            for (int ks = 0; ks < 6; ++ks) at1 = __builtin_amdgcn_mfma_f32_32x32x16_bf16(*(const LAS bf16x8*)(kx + 32 * GL_QP + 32 * ks), qf[ks], at1, 0, 0, 0);
        }
#pragma unroll
        for (int r = 0; r < 16; ++r) { const bool keep = crow(r, h2) <= r32; if (tb == 0) { if (!keep) at0[r] = 0.f; } else { if (!keep) at1[r] = 0.f; } }
        bf16x8 pb[4];
#pragma unroll
        for (int k2 = 0; k2 < 2; ++k2) {
            pb[k2] = __builtin_bit_cast(bf16x8, (u32x4){cvtpk_s(at0[8 * k2], at0[8 * k2 + 1]), cvtpk_s(at0[8 * k2 + 2], at0[8 * k2 + 3]), cvtpk_s(at0[8 * k2 + 4], at0[8 * k2 + 5]), cvtpk_s(at0[8 * k2 + 6], at0[8 * k2 + 7])});
            pb[2 + k2] = __builtin_bit_cast(bf16x8, (u32x4){cvtpk_s(at1[8 * k2], at1[8 * k2 + 1]), cvtpk_s(at1[8 * k2 + 2], at1[8 * k2 + 3]), cvtpk_s(at1[8 * k2 + 4], at1[8 * k2 + 5]), cvtpk_s(at1[8 * k2 + 6], at1[8 * k2 + 7])}); }
        const bf16* sg = SKV + ((((size_t)b * 64 + n) * 4 + head) * 192 + 96 * ch + r32) * 96 + 8 * h2;
        f32x16 o[3];
#pragma unroll
        for (int cbl = 0; cbl < 3; ++cbl) { const int cb = 3 * ch + cbl; f32x16 acc = f32x16{};
#pragma unroll
            for (int kq = 0; kq < 4; ++kq) { if (kq < 2 || tb == 1) {
                const s16x4 a0 = trd(va + kq * 16 * GL_VP + cb * 64), a1 = trd(va + kq * 16 * GL_VP + 8 * GL_VP + cb * 64);
                acc = __builtin_amdgcn_mfma_f32_32x32x16_bf16((bf16x8){a0[0], a0[1], a0[2], a0[3], a1[0], a1[1], a1[2], a1[3]}, pb[kq], acc, 0, 0, 0); } }
#pragma unroll
            for (int ks = 0; ks < 6; ++ks) { const bf16x8 sf = *(const bf16x8*)(sg + (size_t)(32 * cbl) * 96 + 16 * ks);
                acc = __builtin_amdgcn_mfma_f32_32x32x16_bf16(sf, qf[ks], acc, 0, 0, 0); }
            o[cbl] = acc; }
        float ss = 0.f;
#pragma unroll
        for (int cbl = 0; cbl < 3; ++cbl)
#pragma unroll
            for (int r = 0; r < 16; ++r) ss += o[cbl][r] * o[cbl][r];
        { auto rr = __builtin_amdgcn_permlane32_swap(__float_as_uint(ss), __float_as_uint(ss), false, false); ss = __uint_as_float(rr[0]) + __uint_as_float(rr[1]); }
        LAS float* ssx = (LAS float*)(lds + GL_SSX);
        if (h2 == 0) ssx[((u * 2 + tb) * 2 + ch) * 32 + r32] = ss;
        __syncthreads();
        ss += ssx[((u * 2 + tb) * 2 + (ch ^ 1)) * 32 + r32];
        const float rs = rsqrtf(ss * (1.f / 192.f) + RMS_EPS);
        const size_t m = (size_t)b * SEQ + n * 64 + 32 * tb + r32;
        const bf16* rp = R + m * 768 + 192 * head + 96 * ch + 4 * h2; bf16* op = OC + m * D + 192 * head + 96 * ch + 4 * h2; const float* gp = p->in[I_GLAG] + 96 * ch + 4 * h2;
#pragma unroll
        for (int cbl = 0; cbl < 3; ++cbl)
#pragma unroll
            for (int g = 0; g < 4; ++g) { const int co = 32 * cbl + 8 * g; const u32x2 rv = *(const u32x2*)(rp + co); const f32x4 gn = *(const f32x4*)(gp + co);
                const float r0 = __uint_as_float(rv.x << 16), r1 = __uint_as_float(rv.x & 0xffff0000u), r2 = __uint_as_float(rv.y << 16), r3 = __uint_as_float(rv.y & 0xffff0000u);
                const float v0 = o[cbl][4 * g] * rs * gn[0] * (r0 * __builtin_amdgcn_rcpf(1.f + __expf(-r0))), v1 = o[cbl][4 * g + 1] * rs * gn[1] * (r1 * __builtin_amdgcn_rcpf(1.f + __expf(-r1)));
                const float v2 = o[cbl][4 * g + 2] * rs * gn[2] * (r2 * __builtin_amdgcn_rcpf(1.f + __expf(-r2))), v3 = o[cbl][4 * g + 3] * rs * gn[3] * (r3 * __builtin_amdgcn_rcpf(1.f + __expf(-r3)));
                u32x2 w; w.x = cvtpk_s(v0, v1); w.y = cvtpk_s(v2, v3); *(u32x2*)(op + co) = w; }
        __syncthreads();
    }
}
__global__ void __launch_bounds__(NTHREADS, 2) mega(Params p_unused) {
    extern __shared__ __attribute__((aligned(16))) unsigned char lds_raw[];
    LAS unsigned char* lds = (LAS unsigned char*)lds_raw;
    const int G = gridDim.x, bid = blockIdx.x; const int wave_s = __builtin_amdgcn_readfirstlane(threadIdx.x >> 6);
    volatile LAS unsigned* MISC = (volatile LAS unsigned*)(lds + MISC_OFF);
    if (threadIdx.x < 64) MISC[threadIdx.x] = 0u;
    __syncthreads();
    KP p = fresh_kp();
    unsigned char* ws = p->ws;
    XcdBarrier bar = xcd_barrier_post((unsigned*)(ws + WS_CTL) + CW_BAR + p->bar_li * XCD_BAR_WORDS, MISC + 8);
#define WS (fresh_kp()->ws)
#define IN(k) ({ KP _q = fresh_kp(); const bool _r = _q->ph_lo <= (k) && (k) < _q->ph_hi; _r; })
#define SEAM(k) do { if (IN(k) && IN((k) + 1)) xcd_barrier(bar); } while (0)

    if (IN(0)) { phase_prologue(fresh_kp(), lds, G, bid, wave_s); }
    SEAM(0);
    if (IN(1)) { unsigned char* wsl = WS;
        { TileOrder S; S.init(wsl + WS_XB, wsl + WS_WA, NTOK, 2560, D, G, bid);
          EpiInA E{(bf16*)(wsl + WS_HREG), (bf16*)(wsl + WS_HREG + HR_48), (bf16*)(wsl + WS_HREG + 2 * HR_48), (bf16*)(wsl + WS_HREG + 3 * HR_48)};
          gemm_phase(lds + RING_OFF, D, S, E, wave_s); }
        { TileOrder S; S.init(wsl + WS_MEMB, wsl + WS_WMKV, NB * NMEM, 1024, D, G, bid);
          EpiPlain E{(bf16*)(wsl + WS_MKV), 1024};
          gemm_phase(lds + RING_OFF, D, S, E, wave_s); }
    }
    SEAM(1);
    if (IN(2)) phase_gla_kv(fresh_kp(), lds, G, bid, wave_s);
    SEAM(2);
    if (IN(3)) { unsigned char* wsl = WS; phase_gla_scan(wsl, G, bid, wave_s); }
    SEAM(3);
    if (IN(4)) { phase_gla_out(fresh_kp(), lds, G, bid, wave_s); unsigned char* wsl = WS; phase_attn_mem(wsl, lds, 0, G, bid, wave_s); }
    SEAM(4);
        if (IN(5)) { unsigned char* wsl = WS;
            KP q = fresh_kp();
            TileOrder S; S.init(wsl + WS_XB, wsl + WS_WO + (size_t)0 * D * D * 2, NTOK, D, D, G, bid);
            EpiRes E{true ? q->in[I_X] : (const float*)q->out, q->out};
            gemm_phase(lds + RING_OFF, D, S, E, wave_s);
        }
        SEAM(5);
        if (IN(5 + 1)) phase_ln_router(fresh_kp(), 0, lds, G, bid, wave_s);
        SEAM(5 + 1);
        if (IN(5 + 2)) { unsigned char* wsl = WS;
            const int nu = moe_setup(wsl, lds, G, bid, wave_s, true);
            MoeGU S{(const char*)(wsl + WS_XB), (const char*)(wsl + WS_WGU) + (size_t)0 * NEXP * 1024 * D * 2, (LAS const int*)(lds + MISC_OFF) + 16, (LAS const int*)(lds + ROWTOK_OFF), nu};
            EpiGateUp E{(bf16*)(wsl + WS_GREG)};
            gemm_phase(lds + RING_OFF, D, S, E, wave_s);
        }
        SEAM(5 + 2);
        if (IN(5 + 3)) { unsigned char* wsl = WS;
            const int nu = moe_setup(wsl, lds, G, bid, wave_s, false);
            MoeDown S{(const char*)(wsl + WS_GREG), (const char*)(wsl + WS_WD) + (size_t)0 * NEXP * 1024 * DEXP * 2, (LAS const int*)(lds + MISC_OFF) + 16, nu};
            EpiPlain E{(bf16*)(wsl + WS_HREG), 1024};
            gemm_phase(lds + RING_OFF, DEXP, S, E, wave_s);
        }
        SEAM(5 + 3);
        if (IN(5 + 4)) phase_ln_ffn(fresh_kp(), 0, lds, G, bid, wave_s);

            SEAM(9);
            if (IN(10)) { unsigned char* wsl = WS;
                KP q = fresh_kp();
                TileOrder S; S.init(wsl + WS_XB, wsl + WS_WB, NTOK, 3328, D, G, bid);
                EpiInB E{(bf16*)(wsl + WS_HREG), (bf16*)(wsl + WS_HREG + HR_48), (bf16*)(wsl + WS_HREG + 2 * HR_48), (bf16*)(wsl + WS_HREG + 3 * HR_48), (bf16*)(wsl + WS_HREG + 4 * HR_48), q->in[I_QNG], q->in[I_KNG]};
                gemm_phase(lds + RING_OFF, D, S, E, wave_s);
                const int gwr = (G - 1 - bid) * NWAVES + wave_s;
                if (gwr < NB * FOX_H) cum_wave((const float*)(wsl + WS_LOGF), (float*)(wsl + WS_CUM), gwr, fresh_lane());
            }
            SEAM(10);
            if (IN(11)) { unsigned char* wsl = WS; phase_attn_fox(wsl, lds, G, bid, wave_s); phase_attn_mem(wsl, lds, 1, G, bid, wave_s); }
            SEAM(11);
        if (IN(12)) { unsigned char* wsl = WS;
            KP q = fresh_kp();
            TileOrder S; S.init(wsl + WS_XB, wsl + WS_WO + (size_t)1 * D * D * 2, NTOK, D, D, G, bid);
            EpiRes E{false ? q->in[I_X] : (const float*)q->out, q->out};
            gemm_phase(lds + RING_OFF, D, S, E, wave_s);
        }
        SEAM(12);
        if (IN(12 + 1)) phase_ln_router(fresh_kp(), 1, lds, G, bid, wave_s);
        SEAM(12 + 1);
        if (IN(12 + 2)) { unsigned char* wsl = WS;
            const int nu = moe_setup(wsl, lds, G, bid, wave_s, true);
            MoeGU S{(const char*)(wsl + WS_XB), (const char*)(wsl + WS_WGU) + (size_t)1 * NEXP * 1024 * D * 2, (LAS const int*)(lds + MISC_OFF) + 16, (LAS const int*)(lds + ROWTOK_OFF), nu};
            EpiGateUp E{(bf16*)(wsl + WS_GREG)};
            gemm_phase(lds + RING_OFF, D, S, E, wave_s);
        }
        SEAM(12 + 2);
        if (IN(12 + 3)) { unsigned char* wsl = WS;
            const int nu = moe_setup(wsl, lds, G, bid, wave_s, false);
            MoeDown S{(const char*)(wsl + WS_GREG), (const char*)(wsl + WS_WD) + (size_t)1 * NEXP * 1024 * DEXP * 2, (LAS const int*)(lds + MISC_OFF) + 16, nu};
            EpiPlain E{(bf16*)(wsl + WS_HREG), 1024};
            gemm_phase(lds + RING_OFF, DEXP, S, E, wave_s);
        }
        SEAM(12 + 3);
        if (IN(12 + 4)) phase_ln_ffn(fresh_kp(), 1, lds, G, bid, wave_s);
#undef IN
#undef SEAM
#undef WS
}
#undef LAS
#undef GAS
}

static int pk_grid() {
    static int grid = 0;
    if (grid == 0) {
        int dev = 0, cus = 0;
        if (hipGetDevice(&dev) != hipSuccess || hipDeviceGetAttribute(&cus, hipDeviceAttributeMultiprocessorCount, dev) != hipSuccess) { grid = -1; return grid; }
        if (hipFuncSetAttribute((const void*)pk::mega, hipFuncAttributeMaxDynamicSharedMemorySize, pk::LDS_BYTES) != hipSuccess) { fprintf(stderr, "kernel_launch: hipFuncSetAttribute failed\n"); grid = -1; return grid; }
        int per_cu = 0;
        if (hipOccupancyMaxActiveBlocksPerMultiprocessor(&per_cu, (const void*)pk::mega, pk::NTHREADS, pk::LDS_BYTES) != hipSuccess || per_cu < 1) fprintf(stderr, "kernel_launch: occupancy query says %d\n", per_cu);
        (void)hipGetLastError();
        grid = cus;
    }
    return grid;
}
static void pk_launch(pk::Params& P, int lo, int hi, hipStream_t stream) {
    const int grid = pk_grid(); if (grid <= 0) return;
    P.ph_lo = lo; P.ph_hi = hi; P.bar_li += 1;
    hipLaunchKernelGGL(pk::mega, dim3(grid), dim3(pk::NTHREADS), pk::LDS_BYTES, stream, P);
}
extern "C" void kernel_launch(void* const* d_in, const int* in_sizes, int n_in, void* d_out, int out_size, void* d_ws, size_t ws_size, hipStream_t stream) {
    if (n_in != 22 || out_size != NTOK * D || ws_size < WS_END) { fprintf(stderr, "kernel_launch: unexpected shapes (n_in %d out %d ws %zu)\n", n_in, out_size, ws_size); return; }
    const float* w_gate_up = (const float*)d_in[3]; const float* b_gate = (const float*)d_in[4]; const float* gla_g = (const float*)d_in[5];
    const float* w_eg = (const float*)d_in[19]; const float* w_eu = (const float*)d_in[20]; const float* w_ed = (const float*)d_in[21];
    unsigned char* ws = (unsigned char*)d_ws;
    float* GLR = (float*)(ws + WS_GLR); float* CUM = (float*)(ws + WS_CUM);
    bf16* MKV = (bf16*)(ws + WS_MKV);
    int* TOK_E = (int*)(ws + WS_TOKE); int* TOK_S = (int*)(ws + WS_TOKS);
    bf16* XB = (bf16*)(ws + WS_XB); bf16* YS = (bf16*)(ws + WS_HREG);
    bf16* T0 = (bf16*)(ws + WS_HREG), *T1 = (bf16*)(ws + WS_HREG + HR_48), *T2 = (bf16*)(ws + WS_HREG + 2 * HR_48), *T3 = (bf16*)(ws + WS_HREG + 3 * HR_48), *T4 = (bf16*)(ws + WS_HREG + 4 * HR_48);
    (void)hipMemsetAsync(ws + WS_CTL, 0, CTL_ZERO_BYTES, stream);
    pk::Params P{}; for (int i = 0; i < 22; ++i) P.in[i] = (const float*)d_in[i]; P.out = (float*)d_out; P.ws = ws; P.bar_li = -1;
    pk_launch(P, 0, 17, stream);
}
```

```cpp
#include <hip/hip_runtime.h>
#include <cstdio>
#include <cstdint>

typedef unsigned short bf16;
constexpr int NB = 8, SEQ = 4096, D = 1024, NTOK = NB * SEQ;
constexpr int NMEM = 256, A_IN = 2576, B_IN = 1792, KV_IN = 1548;
constexpr int GLA_H = 4, GLA_DK = 96, GLA_DV = 192, FOX_H = 12;
constexpr int NEXP = 16, DEXP = 512;
constexpr float DN_ALPHA = 1.41421356237309515f;
constexpr float LN_EPS = 1e-5f, RMS_EPS = 1e-6f;
constexpr float LOG2E = 1.4426950408889634f;
constexpr float QC2 = 0.125f * LOG2E;
constexpr size_t MiB = 1u << 20;
constexpr size_t WS_CTL = 0, CTL_ZERO_BYTES = 1 * MiB;
constexpr size_t WS_GLR = 1 * MiB, WS_LOGF = 3 * MiB, WS_CUM = 5 * MiB, WS_DEC = 7 * MiB, WS_MEMB = 8 * MiB, WS_MKV = 12 * MiB;
constexpr size_t WS_TOKE = 16 * MiB, WS_TOKW = WS_TOKE + 256 * 1024, WS_TOKS = WS_TOKW + 256 * 1024, WS_CNT = WS_TOKS + 256 * 1024, WS_SLOTTOK = 17 * MiB;
constexpr size_t WS_WA = 20 * MiB, WS_WB = 25 * MiB, WS_WMKV = 32 * MiB, WS_WO = 34 * MiB, WS_WGU = 38 * MiB, WS_WD = 102 * MiB;
constexpr size_t WS_XB = 134 * MiB, WS_GREG = 198 * MiB, WS_HREG = 270 * MiB, WS_END = 478 * MiB;
constexpr size_t HR_48 = 48 * MiB;

__device__ __forceinline__ float bf2f(bf16 v) { return __uint_as_float(((unsigned)v) << 16); }
__device__ __forceinline__ bf16 f2bf(float f) { unsigned u = __float_as_uint(f); return (bf16)((u + 0x7fffu + ((u >> 16) & 1u)) >> 16); }
__device__ __forceinline__ float wave_sum(float v) {
#pragma unroll
    for (int o = 1; o < 64; o <<= 1) v += __shfl_xor(v, o);
    return v;
}
__device__ __forceinline__ float log_sigmoid(float z) { return fminf(z, 0.f) - log1pf(expf(-fabsf(z))); }
__device__ __forceinline__ float sigmoidf(float z) { return 1.f / (1.f + expf(-z)); }

namespace nv {
__global__ void __launch_bounds__(256) p0_x(const float* x, const float* w_in_a, bf16* XB, float* GLR) {
    const int row = blockIdx.x * 4 + (threadIdx.x >> 6), lane = threadIdx.x & 63;
    float acc[16];
#pragma unroll
    for (int j = 0; j < 16; ++j) acc[j] = 0.f;
    for (int k = lane; k < D; k += 64) {
        const float v = x[(size_t)row * D + k]; XB[(size_t)row * D + k] = f2bf(v);
#pragma unroll
        for (int j = 0; j < 16; ++j) acc[j] += v * w_in_a[(size_t)k * A_IN + 1536 + j];
    }
#pragma unroll
    for (int j = 0; j < 16; ++j) { const float s = wave_sum(acc[j]); if (lane == 0) GLR[(size_t)row * 16 + j] = s; }
}
__global__ void __launch_bounds__(256) p0_mem(const float* mem, bf16* MEMB) {
    const size_t i = (size_t)blockIdx.x * 256 + threadIdx.x; MEMB[i] = f2bf(mem[i]);
}
struct GemmArgs { const bf16* A; int lda; const float* W; int ldw; int wcol0; int M, Nn, K; };
struct EpiBf { bf16* dst; int ldd; int dcol0; __device__ void operator()(int m, int n, float v) const { dst[(size_t)m * ldd + dcol0 + n] = f2bf(v); } };
struct EpiRes { const float* xres; float* out; __device__ void operator()(int m, int n, float v) const { out[(size_t)m * D + n] = DN_ALPHA * xres[(size_t)m * D + n] + v; } };
template <class Epi> __global__ void __launch_bounds__(256) gemm(GemmArgs g, Epi E) {
    const int n = blockIdx.x * 64 + (threadIdx.x & 63), m0 = (blockIdx.y * 4 + (threadIdx.x >> 6)) * 4;
    if (n >= g.Nn) return;
    float acc[4] = {0.f, 0.f, 0.f, 0.f};
    for (int k = 0; k < g.K; k += 8) {
        float w[8];
#pragma unroll
        for (int j = 0; j < 8; ++j) w[j] = g.W[(size_t)(k + j) * g.ldw + g.wcol0 + n];
#pragma unroll
        for (int i = 0; i < 4; ++i) {
            const uint4 a = *(const uint4*)(g.A + (size_t)(m0 + i) * g.lda + k);
            const unsigned aw[4] = {a.x, a.y, a.z, a.w};
#pragma unroll
            for (int j = 0; j < 4; ++j) { acc[i] += __uint_as_float(aw[j] << 16) * w[2 * j]; acc[i] += __uint_as_float(aw[j] & 0xffff0000u) * w[2 * j + 1]; }
        }
    }
#pragma unroll
    for (int i = 0; i < 4; ++i) E(m0 + i, n, acc[i]);
}
__global__ void __launch_bounds__(192) gla(const bf16* QK, const bf16* V, const bf16* R, const float* GLR, const float* w_up, const float* b_gate, const float* g_norm, bf16* OC) {
    const int b = blockIdx.x / GLA_H, h = blockIdx.x % GLA_H, tid = threadIdx.x;
    __shared__ float sq[96], sk[96], sa[96], red[4];
    float S[96];
#pragma unroll
    for (int k = 0; k < 96; ++k) S[k] = 0.f;
    float wup[16]; float bg = 0.f;
    if (tid < 96) { for (int j = 0; j < 16; ++j) wup[j] = w_up[j * 384 + h * 96 + tid]; bg = b_gate[h * 96 + tid]; }
    const float gn = g_norm[tid];
    const float qs = 0.10206207261596577f;
    for (int t = 0; t < SEQ; ++t) {
        const size_t m = (size_t)b * SEQ + t;
        __syncthreads();
        if (tid < 96) {
            float z = bg;
#pragma unroll
            for (int j = 0; j < 16; ++j) z += GLR[m * 16 + j] * wup[j];
            sa[tid] = expf(log_sigmoid(z) * (1.f / 16.f));
            sq[tid] = bf2f(QK[m * 768 + h * 96 + tid]) * qs;
            sk[tid] = bf2f(QK[m * 768 + 384 + h * 96 + tid]);
        }
        __syncthreads();
        const float v = bf2f(V[m * 768 + h * 192 + tid]);
        float o = 0.f;
#pragma unroll
        for (int k = 0; k < 96; ++k) { S[k] = sa[k] * S[k] + sk[k] * v; o += sq[k] * S[k]; }
        float ss = wave_sum(o * o);
        if ((tid & 63) == 0) red[tid >> 6] = ss;
        __syncthreads();
        ss = red[0] + red[1] + red[2];
        const float r = bf2f(R[m * 768 + h * 192 + tid]);
        const float on = o * rsqrtf(ss * (1.f / 192.f) + RMS_EPS) * gn;
        OC[m * D + h * 192 + tid] = f2bf(on * (r * sigmoidf(r)));
    }
}
__global__ void __launch_bounds__(256) memattn(const bf16* MQ, const bf16* MKV, int layer, bf16* OC) {
    const int m = blockIdx.x * 256 + threadIdx.x, hd = blockIdx.y, b = m / SEQ;
    float q[64], acc[64];
#pragma unroll
    for (int d = 0; d < 64; ++d) { q[d] = bf2f(MQ[(size_t)m * 256 + hd * 64 + d]) * 0.125f; acc[d] = 0.f; }
    float mx = -1e30f, l = 0.f;
    for (int j = 0; j < NMEM; ++j) {
        const bf16* kr = MKV + (size_t)(b * NMEM + j) * 1024 + layer * 512 + hd * 64;
        float s = 0.f;
#pragma unroll
        for (int d = 0; d < 64; ++d) s += q[d] * bf2f(kr[d]);
        const float mn = fmaxf(mx, s), f = expf(mx - mn), p = expf(s - mn);
        l = l * f + p; mx = mn;
#pragma unroll
        for (int d = 0; d < 64; ++d) acc[d] = acc[d] * f + p * bf2f(kr[256 + d]);
    }
    const float il = 1.f / l;
#pragma unroll
    for (int d = 0; d < 64; ++d) OC[(size_t)m * D + 768 + hd * 64 + d] = f2bf(acc[d] * il);
}
__global__ void __launch_bounds__(256) ln_router(float* XF, bf16* XB, const float* g, const float* bta, const float* w_router, const float* b_router, int* TOK_E, float* TOK_W) {
    const int row = blockIdx.x * 4 + (threadIdx.x >> 6), lane = threadIdx.x & 63;
    float v[16]; float s = 0.f;
#pragma unroll
    for (int i = 0; i < 16; ++i) { v[i] = XF[(size_t)row * D + lane + 64 * i]; s += v[i]; }
    const float mean = wave_sum(s) * (1.f / D); float q = 0.f;
#pragma unroll
    for (int i = 0; i < 16; ++i) { v[i] -= mean; q += v[i] * v[i]; }
    const float rstd = rsqrtf(wave_sum(q) * (1.f / D) + LN_EPS);
    float lg[16];
#pragma unroll
    for (int e = 0; e < 16; ++e) lg[e] = 0.f;
#pragma unroll
    for (int i = 0; i < 16; ++i) { const int k = lane + 64 * i; const float o = v[i] * rstd * g[k] + bta[k]; XF[(size_t)row * D + k] = o; XB[(size_t)row * D + k] = f2bf(o);
#pragma unroll
        for (int e = 0; e < 16; ++e) lg[e] += o * w_router[k * 16 + e]; }
#pragma unroll
    for (int e = 0; e < 16; ++e) lg[e] = wave_sum(lg[e]);
    if (lane == 0) {
        float aff[16], sel[16];
#pragma unroll
        for (int e = 0; e < 16; ++e) { aff[e] = sigmoidf(lg[e]); sel[e] = aff[e] + b_router[e]; }
        int gbest = 0; float gs = -1e30f;
#pragma unroll
        for (int gi = 0; gi < 4; ++gi) { float a = -1e30f, b2 = -1e30f;
#pragma unroll
            for (int j = 0; j < 4; ++j) { const float x = sel[gi * 4 + j]; if (x > a) { b2 = a; a = x; } else if (x > b2) b2 = x; }
            if (a + b2 > gs) { gs = a + b2; gbest = gi; } }
        int i0 = 0, i1 = 0; float a = -1e30f, b2 = -1e30f;
#pragma unroll
        for (int j = 0; j < 4; ++j) { float x = -1e30f;
#pragma unroll
            for (int gi = 0; gi < 4; ++gi) if (gi == gbest) x = sel[gi * 4 + j];
            if (x > a) { b2 = a; i1 = i0; a = x; i0 = j; } else if (x > b2) { b2 = x; i1 = j; } }
        const int e0 = gbest * 4 + i0, e1 = gbest * 4 + i1; float w0 = 0.f, w1 = 0.f;
#pragma unroll
        for (int e = 0; e < 16; ++e) { if (e == e0) w0 = aff[e]; if (e == e1) w1 = aff[e]; }
        const float inv = 1.f / (w0 + w1);
        TOK_E[row * 2] = e0; TOK_E[row * 2 + 1] = e1; TOK_W[row * 2] = w0 * inv; TOK_W[row * 2 + 1] = w1 * inv;
    }
}
__global__ void __launch_bounds__(256) moe(const bf16* XB, const int* TOK_E, const float* wg, const float* wu, const float* wd, bf16* YS, int* TOK_SLOT) {
    const int tok = blockIdx.x >> 1, j = blockIdx.x & 1, tid = threadIdx.x;
    __shared__ float xs[1024], hs[512];
    for (int k = tid; k < 1024; k += 256) xs[k] = bf2f(XB[(size_t)tok * D + k]);
    const int e = TOK_E[tok * 2 + j];
    __syncthreads();
    const float* G = wg + (size_t)e * 1024 * 512; const float* U = wu + (size_t)e * 1024 * 512; const float* Dn = wd + (size_t)e * 512 * 1024;
    float g0 = 0.f, g1 = 0.f, u0 = 0.f, u1 = 0.f;
    for (int k = 0; k < 1024; ++k) { const float x = xs[k]; g0 += x * G[k * 512 + tid]; g1 += x * G[k * 512 + 256 + tid]; u0 += x * U[k * 512 + tid]; u1 += x * U[k * 512 + 256 + tid]; }
    hs[tid] = g0 * sigmoidf(g0) * u0; hs[tid + 256] = g1 * sigmoidf(g1) * u1;
    __syncthreads();
    float o[4] = {0.f, 0.f, 0.f, 0.f};
    for (int k = 0; k < 512; ++k) { const float hh = hs[k];
#pragma unroll
        for (int c = 0; c < 4; ++c) o[c] += hh * Dn[k * 1024 + c * 256 + tid]; }
    const int slot = tok * 2 + j;
#pragma unroll
    for (int c = 0; c < 4; ++c) YS[(size_t)slot * D + c * 256 + tid] = f2bf(o[c]);
    if (tid == 0) TOK_SLOT[slot] = slot;
}
__global__ void __launch_bounds__(256) ln_ffn(float* XF, bf16* XB, const bf16* YS, const int* TOK_SLOT, const float* TOK_W, const float* g, const float* bta,
                                              const float* w_kv, const float* b_forget, float* LOGF, int do_logf) {
    const int row = blockIdx.x * 4 + (threadIdx.x >> 6), lane = threadIdx.x & 63;
    const int s0 = TOK_SLOT[row * 2], s1 = TOK_SLOT[row * 2 + 1]; const float w0 = TOK_W[row * 2], w1 = TOK_W[row * 2 + 1];
    float v[16]; float s = 0.f;
#pragma unroll
    for (int i = 0; i < 16; ++i) { const int k = lane + 64 * i; v[i] = DN_ALPHA * XF[(size_t)row * D + k] + w0 * bf2f(YS[(size_t)s0 * D + k]) + w1 * bf2f(YS[(size_t)s1 * D + k]); s += v[i]; }
    const float mean = wave_sum(s) * (1.f / D); float q = 0.f;
#pragma unroll
    for (int i = 0; i < 16; ++i) { v[i] -= mean; q += v[i] * v[i]; }
    const float rstd = rsqrtf(wave_sum(q) * (1.f / D) + LN_EPS);
    float lf[12];
#pragma unroll
    for (int e = 0; e < 12; ++e) lf[e] = 0.f;
#pragma unroll
    for (int i = 0; i < 16; ++i) { const int k = lane + 64 * i; const float o = v[i] * rstd * g[k] + bta[k]; XF[(size_t)row * D + k] = o; XB[(size_t)row * D + k] = f2bf(o);
        if (do_logf) {
#pragma unroll
            for (int e = 0; e < 12; ++e) lf[e] += o * w_kv[(size_t)k * KV_IN + 1536 + e]; } }
    if (do_logf) {
#pragma unroll
        for (int e = 0; e < 12; ++e) { const float t = wave_sum(lf[e]); if (lane == 0) LOGF[(size_t)row * 12 + e] = log_sigmoid(t + b_forget[e]); }
    }
}
__global__ void __launch_bounds__(256) headproj(const bf16* XB, const float* W, int ldw, const float* gn, float scale, bf16* dst) {
    const int m = blockIdx.x, col = blockIdx.y * 256 + threadIdx.x, lane = threadIdx.x & 63;
    float acc = 0.f;
    for (int k = 0; k < D; k += 8) {
        const uint4 a = *(const uint4*)(XB + (size_t)m * D + k); const unsigned aw[4] = {a.x, a.y, a.z, a.w};
#pragma unroll
        for (int j = 0; j < 4; ++j) { acc += __uint_as_float(aw[j] << 16) * W[(size_t)(k + 2 * j) * ldw + col]; acc += __uint_as_float(aw[j] & 0xffff0000u) * W[(size_t)(k + 2 * j + 1) * ldw + col]; }
    }
    const float ss = wave_sum(acc * acc);
    dst[(size_t)m * 768 + col] = f2bf(acc * rsqrtf(ss * (1.f / 64.f) + RMS_EPS) * gn[lane] * scale);
}
__global__ void __launch_bounds__(64) cumk(const float* LOGF, float* CUM) {
    const int b = blockIdx.x / FOX_H, h = blockIdx.x % FOX_H, lane = threadIdx.x;
    float loc[64]; float s = 0.f;
#pragma unroll
    for (int i = 0; i < 64; ++i) { s += LOGF[((size_t)b * SEQ + lane * 64 + i) * 12 + h]; loc[i] = s; }
    float inc = s;
#pragma unroll
    for (int o = 1; o < 64; o <<= 1) { const float t = __shfl_up(inc, o); if (lane >= o) inc += t; }
    const float base = inc - s;
#pragma unroll
    for (int i = 0; i < 64; ++i) CUM[((size_t)b * FOX_H + h) * SEQ + lane * 64 + i] = base + loc[i];
}
__global__ void __launch_bounds__(256) fox(const bf16* Q, const bf16* K, const bf16* V, const bf16* OG, const float* CUM, bf16* OC) {
    const int t = blockIdx.x * 256 + threadIdx.x, h = blockIdx.y, b = blockIdx.z;
    const size_t m = (size_t)b * SEQ + t;
    float q[64], acc[64];
#pragma unroll
    for (int d = 0; d < 64; ++d) { q[d] = bf2f(Q[m * 768 + h * 64 + d]); acc[d] = 0.f; }
    const float* cum = CUM + ((size_t)b * FOX_H + h) * SEQ; const float ct = cum[t] * LOG2E;
    float mx = -1e30f, l = 0.f;
    const int tmax = blockIdx.x * 256 + 255;
    for (int s = 0; s <= tmax; ++s) {
        const bf16* kr = K + ((size_t)b * SEQ + s) * 768 + h * 64; const bf16* vr = V + ((size_t)b * SEQ + s) * 768 + h * 64;
        float sc = ct - cum[s] * LOG2E;
#pragma unroll
        for (int d = 0; d < 64; ++d) sc += q[d] * bf2f(kr[d]);
        if (s <= t) {
            const float mn = fmaxf(mx, sc), f = exp2f(mx - mn), p = exp2f(sc - mn);
            l = l * f + p; mx = mn;
#pragma unroll
            for (int d = 0; d < 64; ++d) acc[d] = acc[d] * f + p * bf2f(vr[d]);
        }
    }
    const float il = 1.f / l;
#pragma unroll
    for (int d = 0; d < 64; ++d) { const float og = bf2f(OG[m * 768 + h * 64 + d]); OC[m * D + h * 64 + d] = f2bf(acc[d] * il * sigmoidf(og)); }
}
}

namespace pk {
#define LAS __attribute__((address_space(3)))
#define GAS __attribute__((address_space(1)))
typedef short bf16x8 __attribute__((ext_vector_type(8)));
typedef short s16x4 __attribute__((ext_vector_type(4)));
typedef float f32x4 __attribute__((ext_vector_type(4)));
typedef float f32x16 __attribute__((ext_vector_type(16)));
typedef unsigned u32x4 __attribute__((ext_vector_type(4)));
typedef unsigned u32x2 __attribute__((ext_vector_type(2)));
constexpr int NWAVES = 8, NTHREADS = 512;
constexpr int BM = 256, BK = 64, HALF = 128, HTB = HALF * BK * 2, STAGE_BYTES = 8 * HTB, NXCD = 8, WGM = 8;
constexpr int RING_OFF = 0, RING_BYTES = 131072;
constexpr int MISC_OFF = RING_BYTES;
constexpr int ROWTOK_OFF = MISC_OFF + 256;
constexpr int LDS_BYTES = 155648;
static_assert(ROWTOK_OFF + 6 * 1024 <= LDS_BYTES, "LDS map");

__device__ __forceinline__ int lds_byte(int r, int c) { const int st = (r >> 4) * 2 + (c >> 5), rr = r & 15, cc = c & 31, ob = rr * 64 + cc * 2; return st * 1024 + (ob ^ (((ob >> 9) & 1) << 5)); }
__device__ __forceinline__ void stage_rc(int b, int& R, int& C) { const int st = b / 1024, sb = b % 1024, swz = sb ^ (((sb >> 9) & 1) << 5); R = (st >> 1) * 16 + swz / 64; C = (st & 1) * 32 + (swz % 64) / 2; }
__device__ __forceinline__ unsigned cvt_pk_bf16(float lo, float hi) { unsigned r; asm volatile("v_cvt_pk_bf16_f32 %0, %1, %2" : "=v"(r) : "v"(lo), "v"(hi)); return r; }
__device__ __forceinline__ int perm8(int c) { return (c & ~31) | (16 * ((c >> 2) & 1) + 4 * ((c >> 3) & 3) + (c & 3)); }
__device__ __forceinline__ int head64(int c) { return 128 * ((c >> 5) & 1) + 32 * (c >> 6) + 16 * ((c >> 2) & 1) + 4 * ((c >> 3) & 3) + (c & 3); }

__device__ __forceinline__ int fresh_lane() { int l; asm volatile("v_mbcnt_lo_u32_b32 %0, -1, 0\n\tv_mbcnt_hi_u32_b32 %0, -1, %0" : "=v"(l)); return l; }
__device__ __forceinline__ int fresh_tid(int wave_s) { asm volatile("" : "+s"(wave_s)); return wave_s * 64 + fresh_lane(); }
constexpr int PROBE_SEC = -1;
constexpr int PSEC_OFF = 131072 + 256 + 6144 + 512;
#define PSEC_BEGIN(id) unsigned long long _ps##id = 0; if (PROBE_SEC == (id) && bid == 0 && wave_s == 0) _ps##id = __builtin_amdgcn_s_memrealtime()
#define PSEC_END(id) do { if (PROBE_SEC == (id) && bid == 0 && wave_s == 0) { const unsigned d_ = (unsigned)(__builtin_amdgcn_s_memrealtime() - _ps##id); volatile LAS unsigned* a_ = (volatile LAS unsigned*)(lds + PSEC_OFF); if (fresh_lane() == 0) a_[0] = a_[0] + d_; } } while (0)
struct Unit { const char* A; const char* B; int pm, pn, e, ord; };

struct TileOrder {
    const char* A; const char* Bt; int K, nM, nN, nwg, G, c;
    __device__ void init(const void* A_, const void* Bt_, int M, int N, int K_, int G_, int c_) { A = (const char*)A_; Bt = (const char*)Bt_; K = K_; nM = M / BM; nN = N / BM; nwg = nM * nN; G = G_; c = c_; }
    __device__ __forceinline__ bool next(int i, Unit& u) const {
        const long L = (long)i * G + c; if (L >= nwg) return false;
        int wgid = (int)L; { const int q = nwg / NXCD, r = nwg % NXCD, xcd = wgid % NXCD, off = wgid / NXCD; wgid = (xcd < r ? xcd * (q + 1) : r * (q + 1) + (xcd - r) * q) + off; }
        const int nig = WGM * nN, gid = wgid / nig, fm = gid * WGM, gsz = (nM - fm) < WGM ? (nM - fm) : WGM;
        u.pm = fm + ((wgid % nig) % gsz); u.pn = (wgid % nig) / gsz; u.e = 0; u.ord = i;
        u.A = A + (size_t)u.pm * BM * K * 2; u.B = Bt + (size_t)u.pn * BM * K * 2; return true;
    }
    __device__ __forceinline__ unsigned a_off(const Unit&, int h, int R, int C) const { return (unsigned)((R + HALF * h) * K + C) * 2u; }
};

template <class Epi, class Sched>
__device__ __forceinline__ void gemm_phase(LAS unsigned char* lds, const int K, const Sched& S, const Epi& E, const int wave_s) {
    const int tid = fresh_tid(wave_s), wid = wave_s, lane = tid & 63, wr = wid >> 2, wc = wid & 3, fr = lane & 15, fq = lane >> 4;
    const int nt = K / BK;
    int sR[2], sC[2];
    unsigned voffA[2][2], voffB[2];
#pragma unroll
    for (int i = 0; i < 2; ++i) { stage_rc(tid * 16 + i * 8192, sR[i], sC[i]); voffB[i] = (unsigned)(sR[i] * K + sC[i]) * 2u; }
    const size_t kstep = (size_t)(BK * 2);
    const size_t hstep = (size_t)HALF * K * 2;
    const unsigned ldsw = (unsigned)wid * 1024u;
    const int aoff = lds_byte(wr * 64 + fr, fq * 8), boff = lds_byte(wc * 32 + fr, fq * 8);
#define PG8_SA(b, h) (((b) * 2 + (h)) * HTB)
#define PG8_SB(b, h) ((4 + (b) * 2 + (h)) * HTB)
#define PG8_STAGE(bufoff, gbase, voff) do { _Pragma("unroll") for (int _i = 0; _i < 2; ++_i) \
        __builtin_amdgcn_global_load_lds((const unsigned*)((const char*)(gbase) + (voff)[_i]), (LAS unsigned*)(lds + (bufoff) + ldsw + _i * 8192), 16, 0, 0); } while (0)
#define PG8_LDA(dst, b, h) do { _Pragma("unroll") for (int m = 0; m < 4; ++m) _Pragma("unroll") for (int k = 0; k < 2; ++k) dst[m][k] = *(const LAS bf16x8*)(lds + PG8_SA(b, h) + aoff + m * 2048 + k * 1024); } while (0)
#define PG8_LDB(dst, b, h) do { _Pragma("unroll") for (int n = 0; n < 2; ++n) _Pragma("unroll") for (int k = 0; k < 2; ++k) dst[n][k] = *(const LAS bf16x8*)(lds + PG8_SB(b, h) + boff + n * 2048 + k * 1024); } while (0)
#define PG8_MMA(ai, bj, At, Bt) do { __builtin_amdgcn_s_setprio(1); _Pragma("unroll") for (int m = 0; m < 4; ++m) _Pragma("unroll") for (int n = 0; n < 2; ++n) _Pragma("unroll") for (int k = 0; k < 2; ++k) \
        acc[ai][bj][m][n] = __builtin_amdgcn_mfma_f32_16x16x32_bf16(Bt[n][k], At[m][k], acc[ai][bj][m][n], 0, 0, 0); __builtin_amdgcn_s_setprio(0); } while (0)
#define PG8_WAIT_V(n) asm volatile("s_waitcnt vmcnt(" #n ")" ::: "memory")
#define PG8_WAIT_L(n) asm volatile("s_waitcnt lgkmcnt(" #n ")" ::: "memory")
#define PG8_BAR __builtin_amdgcn_s_barrier()
#define PG8_SCHED __builtin_amdgcn_sched_barrier(0)
    Unit cur, nxt; int ui = 0;
    if (!S.next(0, cur)) return;
    f32x4 acc[2][2][4][2];
#pragma unroll
    for (int a = 0; a < 2; ++a)
#pragma unroll
        for (int b = 0; b < 2; ++b)
#pragma unroll
            for (int m = 0; m < 4; ++m)
#pragma unroll
                for (int n = 0; n < 2; ++n) acc[a][b][m][n] = (f32x4){0.f, 0.f, 0.f, 0.f};
    bf16x8 At[4][2], B0[2][2], B1[2][2];
    const char* cA = cur.A; const char* cB = cur.B;
#pragma unroll
    for (int h = 0; h < 2; ++h)
#pragma unroll
        for (int i = 0; i < 2; ++i) voffA[h][i] = S.a_off(cur, h, sR[i], sC[i]);
    PG8_STAGE(PG8_SB(0, 0), cB, voffB); PG8_STAGE(PG8_SB(0, 1), cB + hstep, voffB); PG8_STAGE(PG8_SA(0, 0), cA, voffA[0]); PG8_STAGE(PG8_SA(0, 1), cA, voffA[1]);
    if (wr == 1) PG8_BAR;
    PG8_WAIT_V(2); PG8_BAR;
    PG8_STAGE(PG8_SB(1, 0), cB + kstep, voffB); PG8_STAGE(PG8_SA(1, 0), cA + kstep, voffA[0]); PG8_STAGE(PG8_SB(1, 1), cB + hstep + kstep, voffB);
    PG8_WAIT_V(6); PG8_BAR;
    for (;;) {
        const bool has_next = S.next(ui + 1, nxt);
        const char* nA = has_next ? nxt.A : cA; const char* nB = has_next ? nxt.B : cB;
        for (int t = 0; t < nt; t += 2) {
            const bool last = (t == nt - 2);
            const char* a1 = cA + (size_t)(t + 1) * kstep;
            const char* a2 = last ? nA : cA + (size_t)(t + 2) * kstep; const char* b2 = last ? nB : cB + (size_t)(t + 2) * kstep;
            const char* a3 = a2 + kstep; const char* b3 = b2 + kstep;
            PG8_LDB(B0, 0, 0); PG8_LDB(B1, 0, 1); PG8_SCHED; PG8_LDA(At, 0, 0); PG8_STAGE(PG8_SA(1, 1), a1, voffA[1]);
            if (last && has_next) {
#pragma unroll
                for (int h = 0; h < 2; ++h)
#pragma unroll
                    for (int i = 0; i < 2; ++i) { int R2, C2; stage_rc(fresh_tid(wave_s) * 16 + i * 8192, R2, C2); voffA[h][i] = S.a_off(nxt, h, R2, C2); }
            }
            PG8_WAIT_V(8); PG8_WAIT_L(0); PG8_BAR; PG8_MMA(0, 0, At, B0); PG8_MMA(0, 1, At, B1); PG8_BAR; PG8_SCHED;
            PG8_LDA(At, 0, 1); PG8_STAGE(PG8_SB(0, 0), b2, voffB); PG8_STAGE(PG8_SB(0, 1), b2 + hstep, voffB); PG8_STAGE(PG8_SA(0, 0), a2, voffA[0]);
            PG8_WAIT_V(8); PG8_WAIT_L(0); PG8_BAR; PG8_MMA(1, 0, At, B0); PG8_MMA(1, 1, At, B1); PG8_BAR; PG8_SCHED;
            PG8_LDB(B0, 1, 0); PG8_LDB(B1, 1, 1); PG8_SCHED; PG8_LDA(At, 1, 0); PG8_STAGE(PG8_SA(0, 1), a2, voffA[1]);
            PG8_WAIT_V(8); PG8_WAIT_L(0); PG8_BAR; PG8_MMA(0, 0, At, B0); PG8_MMA(0, 1, At, B1); PG8_BAR; PG8_SCHED;
            PG8_LDA(At, 1, 1); PG8_STAGE(PG8_SB(1, 0), b3, voffB); PG8_STAGE(PG8_SB(1, 1), b3 + hstep, voffB); PG8_STAGE(PG8_SA(1, 0), a3, voffA[0]);
            PG8_WAIT_V(8); PG8_WAIT_L(0); PG8_BAR; PG8_MMA(1, 0, At, B0); PG8_MMA(1, 1, At, B1); PG8_BAR; PG8_SCHED;
        }
        if (wr == 0) PG8_BAR;
        E(acc, cur, wr, wc, fr, fq);
        if (!has_next) break;
#pragma unroll
        for (int a = 0; a < 2; ++a)
#pragma unroll
            for (int b = 0; b < 2; ++b)
#pragma unroll
                for (int m = 0; m < 4; ++m)
#pragma unroll
                    for (int n = 0; n < 2; ++n) acc[a][b][m][n] = (f32x4){0.f, 0.f, 0.f, 0.f};
        cur = nxt; cA = nA; cB = nB; ++ui;
        if (wr == 1) PG8_BAR;
    }
    PG8_WAIT_V(0);
    PG8_BAR;
#undef PG8_SA
#undef PG8_SB
#undef PG8_STAGE
#undef PG8_LDA
#undef PG8_LDB
#undef PG8_MMA
#undef PG8_WAIT_V
#undef PG8_WAIT_L
#undef PG8_BAR
#undef PG8_SCHED
}

__device__ __forceinline__ void store_bf16_tile(const f32x4 (&acc)[2][2][4][2], bf16* base, int ldd, int row0, int c0, int wr, int wc, int fr, int fq) {
    bf16* rowp = base + (size_t)(row0 + wr * 64 + fr) * ldd + (c0 + wc * 32 + 8 * fq);
#pragma unroll
    for (int ai = 0; ai < 2; ++ai) {
#pragma unroll
        for (int m = 0; m < 4; ++m) {
#pragma unroll
            for (int bj = 0; bj < 2; ++bj) { const f32x4 v0 = acc[ai][bj][m][0], v1 = acc[ai][bj][m][1];
                u32x4 w; w.x = cvt_pk_bf16(v0[0], v0[1]); w.y = cvt_pk_bf16(v0[2], v0[3]); w.z = cvt_pk_bf16(v1[0], v1[1]); w.w = cvt_pk_bf16(v1[2], v1[3]);
                *(u32x4*)(rowp + bj * HALF) = w; }
            rowp += (size_t)16 * ldd; asm volatile("" : "+v"(rowp)); }
        rowp += (size_t)64 * ldd; }
}
struct EpiInA { bf16 *QK, *V, *R, *MQ;
    __device__ __forceinline__ void operator()(const f32x4 (&acc)[2][2][4][2], const Unit& u, int wr, int wc, int fr, int fq) const {
        bf16* base; int ldd, c0; const int pn = u.pn;
        if (pn < 3) { base = QK; ldd = 768; c0 = pn * 256; } else if (pn < 6) { base = V; ldd = 768; c0 = (pn - 3) * 256; } else if (pn < 9) { base = R; ldd = 768; c0 = (pn - 6) * 256; } else { base = MQ; ldd = 256; c0 = 0; }
        store_bf16_tile(acc, base, ldd, u.pm * BM, c0, wr, wc, fr, fq);
    } };
struct EpiPlain { bf16* dst; int ldd;
    __device__ __forceinline__ void operator()(const f32x4 (&acc)[2][2][4][2], const Unit& u, int wr, int wc, int fr, int fq) const { store_bf16_tile(acc, dst, ldd, u.pm * BM, u.pn * BM, wr, wc, fr, fq); } };

#define XB_TMO      128
#define XB_XCNT(j)  (256  + 64 * (j))
#define XB_XSUB(j)  (1280 + 64 * (j))
#define XB_XGEN(j)  (2304 + 64 * (j))
#define XB_TOP      3328
#define XB_TOPGEN   3392
#define XCD_BAR_WORDS 3456
#define XB_SPIN_CAP (1u << 18)
__device__ __forceinline__ unsigned xb_ld(unsigned* p)              { return __hip_atomic_load(p, __ATOMIC_RELAXED, __HIP_MEMORY_SCOPE_AGENT); }
__device__ __forceinline__ unsigned xb_add(unsigned* p, unsigned v) { return __hip_atomic_fetch_add(p, v, __ATOMIC_RELAXED, __HIP_MEMORY_SCOPE_AGENT); }
__device__ __forceinline__ unsigned xb_xcc_id() { return (unsigned)__builtin_amdgcn_s_getreg((3 << 11) | 20) & 0xFu; }
#define XB_SPIN(cond, bar) do { unsigned _sp = 0; while (cond) { __builtin_amdgcn_s_sleep(1); \
    if ((++_sp & 255u) == 0u) { if (xb_ld(&(bar)[XB_TMO])) break; if (_sp > XB_SPIN_CAP) { atomicAdd(&(bar)[XB_TMO], 1u); break; } } } } while (0)
struct XcdBarrier { unsigned* bar; unsigned x; volatile LAS unsigned* st; };
__device__ __forceinline__ XcdBarrier xcd_barrier_post(unsigned* bar, volatile LAS unsigned* st) {
    XcdBarrier b; b.bar = bar; b.x = xb_xcc_id(); b.st = st;
    if (threadIdx.x == 0) (void)xb_add(&bar[XB_XCNT(b.x)], 1u);
    return b;
}
__device__ __forceinline__ void xcd_barrier_complete(unsigned* bar, unsigned x, unsigned& nloc, unsigned& nx) {
    const unsigned G = gridDim.x * gridDim.y * gridDim.z;
    unsigned sum, cnt, mine, sp = 0u;
    for (;;) {
        sum = 0u; cnt = 0u; mine = 0u;
#pragma unroll
        for (unsigned j = 0; j < 16; ++j) { const unsigned c = xb_ld(&bar[XB_XCNT(j)]); sum += c; cnt += (c > 0u) ? 1u : 0u; mine = (j == x) ? c : mine; }
        if (sum == G) break;
        __builtin_amdgcn_s_sleep(1);
        if ((++sp & 255u) == 0u) { if (xb_ld(&bar[XB_TMO])) break; if (sp > XB_SPIN_CAP) { atomicAdd(&bar[XB_TMO], 1u); break; } }
    }
    nloc = mine > 0u ? mine : 1u; nx = cnt > 0u ? cnt : 1u;
}
__device__ __forceinline__ void xcd_barrier(const XcdBarrier& b) {
    asm volatile("s_waitcnt vmcnt(0)" ::: "memory");
    __syncthreads();
    if (threadIdx.x == 0) {
        unsigned* bar = b.bar;
        __builtin_amdgcn_s_waitcnt(0);
        unsigned nloc = b.st[0], nx = b.st[1];
        if (nloc == 0u) { xcd_barrier_complete(bar, b.x, nloc, nx); b.st[0] = nloc; b.st[1] = nx; }
        const unsigned old = xb_add(&bar[XB_XSUB(b.x)], 1u);
        const unsigned gen = old / nloc;
        if (old + 1u == (gen + 1u) * nloc) {
            __builtin_amdgcn_fence(__ATOMIC_RELEASE, "agent");
            asm volatile("s_waitcnt vmcnt(0)" ::: "memory");
            const unsigned og = xb_add(&bar[XB_TOP], 1u);
            const unsigned tg = og / nx;
            if (og + 1u == (tg + 1u) * nx) xb_add(&bar[XB_TOPGEN], 1u);
            else XB_SPIN(xb_ld(&bar[XB_TOPGEN]) == tg, bar);
            __builtin_amdgcn_fence(__ATOMIC_ACQUIRE, "agent");
            xb_add(&bar[XB_XGEN(b.x)], 1u);
            asm volatile("s_waitcnt vmcnt(0)" ::: "memory");
        } else {
            XB_SPIN(xb_ld(&bar[XB_XGEN(b.x)]) == gen, bar);
            __builtin_amdgcn_fence(__ATOMIC_ACQUIRE, "agent");
            asm volatile("s_waitcnt vmcnt(0)" ::: "memory");
        }
    }
    __syncthreads();
}
#define LDS_WAIT() asm volatile("s_waitcnt lgkmcnt(0)" ::: "memory")
__device__ __forceinline__ unsigned pk2(float lo, float hi) { return (unsigned)f2bf(lo) | ((unsigned)f2bf(hi) << 16); }

template <int CTRL> __device__ __forceinline__ float dppf(float v) { return __builtin_bit_cast(float, __builtin_amdgcn_update_dpp(0, __builtin_bit_cast(int, v), CTRL, 0xf, 0xf, true)); }
__device__ __forceinline__ float sum_swap32(float a, float b) { auto r = __builtin_amdgcn_permlane32_swap(__float_as_uint(a), __float_as_uint(b), false, false); return __uint_as_float(r[0]) + __uint_as_float(r[1]); }
__device__ __forceinline__ float sum_swap16(float a, float b) { auto r = __builtin_amdgcn_permlane16_swap(__float_as_uint(a), __float_as_uint(b), false, false); return __uint_as_float(r[0]) + __uint_as_float(r[1]); }
__device__ __forceinline__ float wsum(float v) {
    v += dppf<0xB1>(v); v += dppf<0x4E>(v); v += dppf<0x141>(v); v += dppf<0x140>(v);
    v = sum_swap16(v, v); v = sum_swap32(v, v); return v;
}
__device__ __forceinline__ float multi_reduce16(const float (&a)[16], int lane) {
    float b[8], c[4], d[2], e;
#pragma unroll
    for (int i = 0; i < 8; ++i) b[i] = sum_swap32(a[i], a[i + 8]);
#pragma unroll
    for (int i = 0; i < 4; ++i) c[i] = sum_swap16(b[i], b[i + 4]);
    { const bool hi = (lane & 8) != 0;
#pragma unroll
      for (int i = 0; i < 2; ++i) { const float send = hi ? c[i] : c[i + 2], keep = hi ? c[i + 2] : c[i]; d[i] = keep + dppf<0x140>(send); } }
    { const bool hi = (lane & 4) != 0; const float send = hi ? d[0] : d[1], keep = hi ? d[1] : d[0]; e = keep + dppf<0x141>(send); }
    e += dppf<0x4E>(e); e += dppf<0xB1>(e);
    return e;
}

template <class F> __device__ __forceinline__ void transpose_item(const float* W, int ldw, int ncols, int K, bf16* WT, LAS float* scr, int item, int nblk, int lane, F dstrow) {
    const int kb = item / nblk, nb = item % nblk, k0 = 64 * kb, n0 = 32 * nb;
    const int col = n0 + (lane & 31); const bool ok = col < ncols;
#pragma unroll 8
    for (int i = 0; i < 32; ++i) { const int kk = 2 * i + (lane >> 5); scr[kk * 33 + (lane & 31)] = ok ? W[(size_t)(k0 + kk) * ldw + col] : 0.f; }
    LDS_WAIT(); asm volatile("" ::: "memory");
    const int c = lane & 7;
#pragma unroll
    for (int j = 0; j < 4; ++j) { const int n = (lane >> 3) + 8 * j; const LAS float* s = scr + (8 * c) * 33 + n;
        u32x4 o; o.x = pk2(s[0 * 33], s[1 * 33]); o.y = pk2(s[2 * 33], s[3 * 33]); o.z = pk2(s[4 * 33], s[5 * 33]); o.w = pk2(s[6 * 33], s[7 * 33]);
        const int dr = (n0 + n) < ncols ? dstrow(n0 + n) : -1;
        if (dr >= 0) *(u32x4*)(WT + (size_t)dr * K + k0 + 8 * c) = o; }
    LDS_WAIT(); asm volatile("" ::: "memory");
}
struct Params { const float* in[22]; float* out; unsigned char* ws; int ph_lo, ph_hi, bar_li, pad; };
enum { I_X = 0, I_MEM, I_WINA, I_WGUP, I_BGATE, I_GLAG, I_WINB, I_QNG, I_WKV, I_BFORGET, I_KNG, I_WMKV, I_WOUT, I_LMG, I_LMB, I_LFG, I_LFB, I_WR, I_BR, I_WEG, I_WEU, I_WED };
constexpr int CW_BAR = 4096;

typedef const __attribute__((address_space(4))) Params* KP;
__device__ __forceinline__ KP fresh_kp() { KP q = (KP)__builtin_amdgcn_kernarg_segment_ptr(); asm volatile("" : "+s"(q)); return q; }

__device__ __forceinline__ void phase_prologue(KP p, LAS unsigned char* lds, int G, int bid, const int wave_s) {
    const int tid = fresh_tid(wave_s), lane = tid & 63, wave = wave_s;
    unsigned char* ws = p->ws;
    LAS float* scr = (LAS float*)(lds + wave * 8448);
    const int gw = bid * NWAVES + wave, NGW = G * NWAVES;
    bf16* WA = (bf16*)(ws + WS_WA); bf16* WB = (bf16*)(ws + WS_WB); bf16* WMKV = (bf16*)(ws + WS_WMKV); bf16* WO = (bf16*)(ws + WS_WO); bf16* WGU = (bf16*)(ws + WS_WGU); bf16* WD = (bf16*)(ws + WS_WD);
    constexpr int NB_A = 81, NB_B = 56, NB_KV = 48;
    constexpr int I_A = 16 * NB_A, I_B = 16 * NB_B, I_KV = 16 * NB_KV, I_MK = 2 * 16 * 16, I_O = 2 * 16 * 32, I_G = 32 * 16 * 16, I_U = I_G, I_D = 32 * 8 * 32;
    constexpr int NITEMS = I_A + I_B + I_KV + I_MK + I_O + I_G + I_U + I_D;
    for (int it = gw; it < NITEMS; it += NGW) {
        int r = it;
        if (r < I_G) { const int mat = r / 256, q = r % 256; transpose_item(p->in[I_WEG] + (size_t)mat * D * DEXP, DEXP, DEXP, D, WGU + (size_t)mat * 1024 * D, scr, q, 16, lane, [](int c) { return 256 * (c >> 7) + perm8(c & 127); }); continue; } r -= I_G;
        if (r < I_U) { const int mat = r / 256, q = r % 256; transpose_item(p->in[I_WEU] + (size_t)mat * D * DEXP, DEXP, DEXP, D, WGU + (size_t)mat * 1024 * D, scr, q, 16, lane, [](int c) { return 256 * (c >> 7) + 128 + perm8(c & 127); }); continue; } r -= I_U;
        if (r < I_D) { const int mat = r / 256, q = r % 256; transpose_item(p->in[I_WED] + (size_t)mat * DEXP * D, D, D, DEXP, WD + (size_t)mat * D * DEXP, scr, q, 32, lane, [](int c) { return perm8(c); }); continue; } r -= I_D;
        if (r < I_A) { transpose_item(p->in[I_WINA], A_IN, A_IN, D, WA, scr, r, NB_A, lane, [](int c) { if (c >= 1536 && c < 1552) return -1; const int L = c < 1536 ? c : c - 16; return perm8(L); }); continue; } r -= I_A;
        if (r < I_B) { transpose_item(p->in[I_WINB], B_IN, B_IN, D, WB, scr, r, NB_B, lane, [](int c) { if (c < 768) return (c & ~255) + head64(c & 255); return perm8(1536 + c); }); continue; } r -= I_B;
        if (r < I_KV) { transpose_item(p->in[I_WKV], KV_IN, KV_IN, D, WB, scr, r, NB_KV, lane, [](int c) { if (c < 768) { const int L = 768 + c; return (L & ~255) + head64(L & 255); } if (c < 1536) return perm8(768 + c); return -1; }); continue; } r -= I_KV;
        if (r < I_MK) { const int l = r / 256, q = r % 256; transpose_item(p->in[I_WMKV] + (size_t)l * D * 512, 512, 512, D, WMKV, scr, q, 16, lane, [l](int c) { return perm8(l * 512 + c); }); continue; } r -= I_MK;
        { const int l = r / 512, q = r % 512; transpose_item(p->in[I_WOUT] + (size_t)l * D * D, D, D, D, WO + (size_t)l * D * D, scr, q, 32, lane, [](int c) { return c; }); }
    }
    { const f32x4* src = (const f32x4*)p->in[I_MEM]; u32x2* dst = (u32x2*)(ws + WS_MEMB);
      for (int i = bid * NTHREADS + tid; i < NB * NMEM * D / 4; i += G * NTHREADS) { const f32x4 v = src[i]; u32x2 o; o.x = pk2(v[0], v[1]); o.y = pk2(v[2], v[3]); dst[i] = o; } }
    __syncthreads();
    LAS float* WG = (LAS float*)(lds);
    for (int idx = tid; idx < 16 * D; idx += NTHREADS) { const int j = idx & 15, k = idx >> 4; WG[j * D + k] = p->in[I_WINA][(size_t)k * A_IN + 1536 + j]; }
    __syncthreads();
    bf16* XB = (bf16*)(ws + WS_XB); float* GLR = (float*)(ws + WS_GLR);
    for (int m = gw; m < NTOK; m += NGW) {
        const f32x4* xr = (const f32x4*)(p->in[I_X] + (size_t)m * D) + lane;
        f32x4 v[4];
#pragma unroll
        for (int j = 0; j < 4; ++j) v[j] = xr[64 * j];
        u32x2* o8 = (u32x2*)(XB + (size_t)m * D) + lane;
#pragma unroll
        for (int j = 0; j < 4; ++j) { u32x2 o; o.x = pk2(v[j][0], v[j][1]); o.y = pk2(v[j][2], v[j][3]); o8[64 * j] = o; }
        float acc[16];
        const LAS float* wl = WG + 4 * lane; asm volatile("" : "+v"(wl));
#pragma unroll
        for (int n = 0; n < 16; ++n) { float a = 0.f;
#pragma unroll
            for (int j = 0; j < 4; ++j) { const f32x4 w = *(const LAS f32x4*)(wl + n * D + 256 * j); a += v[j][0] * w[0] + v[j][1] * w[1] + v[j][2] * w[2] + v[j][3] * w[3]; }
            acc[n] = a; if (n & 1) asm volatile("" : "+v"(acc[n - 1]), "+v"(acc[n]) :: "memory"); }
        const float r = multi_reduce16(acc, lane);
        if ((lane & 3) == 0) GLR[(size_t)m * 16 + (lane >> 2)] = r;
    }
}

template <bool RB> struct EpiRes { const void* xres; float* out;
    __device__ __forceinline__ void operator()(const f32x4 (&acc)[2][2][4][2], const Unit& u, int wr, int wc, int fr, int fq) const {
        size_t off = (size_t)(u.pm * BM + wr * 64 + fr) * D + (u.pn * BM + wc * 32 + 4 * fq);
#pragma unroll
        for (int ai = 0; ai < 2; ++ai) {
#pragma unroll
            for (int m = 0; m < 4; ++m) { float* op = out + off;
#pragma unroll
                for (int bj = 0; bj < 2; ++bj)
#pragma unroll
                    for (int n = 0; n < 2; ++n) { f32x4 xr;
                        if (RB) { const u32x2 t = *(const u32x2*)((const bf16*)xres + off + bj * HALF + n * 16); xr[0] = __uint_as_float(t.x << 16); xr[1] = __uint_as_float(t.x & 0xffff0000u); xr[2] = __uint_as_float(t.y << 16); xr[3] = __uint_as_float(t.y & 0xffff0000u); }
                        else xr = *(const f32x4*)((const float*)xres + off + bj * HALF + n * 16);
                        *(f32x4*)(op + bj * HALF + n * 16) = xr * DN_ALPHA + acc[ai][bj][m][n]; }
                off += (size_t)16 * D; asm volatile("" : "+v"(off) :: "memory"); }
            off += (size_t)64 * D; }
    } };
struct EpiInB { bf16 *Q, *K, *V, *OG, *MQ; const float* qg; const float* kg;
    __device__ __forceinline__ void operator()(const f32x4 (&acc)[2][2][4][2], const Unit& u, int wr, int wc, int fr, int fq) const {
        const int pn = u.pn;
        if (pn >= 6) { bf16* base; int ldd, c0;
            if (pn < 9) { base = V; ldd = 768; c0 = (pn - 6) * 256; } else if (pn < 12) { base = OG; ldd = 768; c0 = (pn - 9) * 256; } else { base = MQ; ldd = 256; c0 = 0; }
            store_bf16_tile(acc, base, ldd, u.pm * BM, c0, wr, wc, fr, fq); return; }
        const bool isq = pn < 3; bf16* base = isq ? Q : K; const float* g = isq ? qg : kg; const float sc = isq ? QC2 : 1.0f;
        const int c0 = (isq ? pn : pn - 3) * 256 + wc * 64 + 8 * fq, r0 = u.pm * BM + wr * 64 + fr;
        f32x4 gv[2][2];
#pragma unroll
        for (int bj = 0; bj < 2; ++bj)
#pragma unroll
            for (int n = 0; n < 2; ++n) gv[bj][n] = *(const f32x4*)(g + 32 * bj + 8 * fq + 4 * n) * sc;
        bf16* rowp = base + (size_t)r0 * 768 + c0;
#pragma unroll
        for (int ai = 0; ai < 2; ++ai) {
#pragma unroll
            for (int m = 0; m < 4; ++m) {
                float ss = 0.f;
#pragma unroll
                for (int bj = 0; bj < 2; ++bj)
#pragma unroll
                    for (int n = 0; n < 2; ++n) { const f32x4 v = acc[ai][bj][m][n]; ss += (v[0] * v[0] + v[1] * v[1]) + (v[2] * v[2] + v[3] * v[3]); }
                ss = sum_swap16(ss, ss); ss = sum_swap32(ss, ss);
                const float rs = rsqrtf(ss * (1.f / 64.f) + RMS_EPS);
#pragma unroll
                for (int bj = 0; bj < 2; ++bj) { const f32x4 v0 = acc[ai][bj][m][0] * rs * gv[bj][0], v1 = acc[ai][bj][m][1] * rs * gv[bj][1];
                    u32x4 w; w.x = cvt_pk_bf16(v0[0], v0[1]); w.y = cvt_pk_bf16(v0[2], v0[3]); w.z = cvt_pk_bf16(v1[0], v1[1]); w.w = cvt_pk_bf16(v1[2], v1[3]);
                    *(u32x4*)(rowp + 32 * bj) = w; }
                rowp += (size_t)16 * 768; asm volatile("" : "+v"(rowp)); }
            rowp += (size_t)64 * 768; }
    } };

__device__ __forceinline__ void load_wtab(LAS float* WT, const float* W, int ldw, int col0, int ncols, int tid) {
    for (int idx = tid; idx < 16 * D; idx += NTHREADS) { const int j = idx & 15, k = idx >> 4; WT[j * D + k] = j < ncols ? W[(size_t)k * ldw + col0 + j] : 0.f; }
}
__device__ __forceinline__ float row_dots16(const f32x4 (&v)[4], const LAS float* WT, int lane) {
    float acc[16];
    const LAS float* wl = WT + 4 * lane; asm volatile("" : "+v"(wl));
#pragma unroll
    for (int n = 0; n < 16; ++n) { float a = 0.f;
#pragma unroll
        for (int j = 0; j < 4; ++j) { const f32x4 w = *(const LAS f32x4*)(wl + n * D + 256 * j); a += v[j][0] * w[0] + v[j][1] * w[1] + v[j][2] * w[2] + v[j][3] * w[3]; }
        acc[n] = a; if (n & 1) asm volatile("" : "+v"(acc[n - 1]), "+v"(acc[n]) :: "memory"); }
    return multi_reduce16(acc, lane);
}
__device__ __forceinline__ void row_dots16x2(const f32x4 (&v0)[4], const f32x4 (&v1)[4], const LAS float* WT, int lane, float& r0, float& r1) {
    float a0[16], a1[16];
    const LAS float* wl = WT + 4 * lane; asm volatile("" : "+v"(wl));
    f32x4 wa[8], wb[8];
#pragma unroll
    for (int q = 0; q < 8; ++q) wa[q] = *(const LAS f32x4*)(wl + (q >> 2) * D + 256 * (q & 3));
#pragma unroll
    for (int g = 0; g < 8; ++g) {
        if (g + 1 < 8) {
#pragma unroll
            for (int q = 0; q < 8; ++q) { const f32x4 w = *(const LAS f32x4*)(wl + (2 * (g + 1) + (q >> 2)) * D + 256 * (q & 3)); if (g & 1) wa[q] = w; else wb[q] = w; } }
#pragma unroll
        for (int h = 0; h < 2; ++h) { float x = 0.f, y = 0.f;
#pragma unroll
            for (int j = 0; j < 4; ++j) { const f32x4 w = (g & 1) ? wb[4 * h + j] : wa[4 * h + j];
                x += v0[j][0] * w[0] + v0[j][1] * w[1] + v0[j][2] * w[2] + v0[j][3] * w[3]; y += v1[j][0] * w[0] + v1[j][1] * w[1] + v1[j][2] * w[2] + v1[j][3] * w[3]; }
            a0[2 * g + h] = x; a1[2 * g + h] = y; }
        asm volatile("" : "+v"(a0[2 * g]), "+v"(a0[2 * g + 1]), "+v"(a1[2 * g]), "+v"(a1[2 * g + 1]));
    }
    r0 = multi_reduce16(a0, lane); r1 = multi_reduce16(a1, lane);
}
__device__ __forceinline__ void ln_row(f32x4 (&v)[4], const float* g, const float* b, int lane) {
    float s = 0.f;
#pragma unroll
    for (int j = 0; j < 4; ++j) s += (v[j][0] + v[j][1]) + (v[j][2] + v[j][3]);
    const float mean = wsum(s) * (1.f / D); float q = 0.f;
#pragma unroll
    for (int j = 0; j < 4; ++j) { v[j] = v[j] - mean; q += (v[j][0] * v[j][0] + v[j][1] * v[j][1]) + (v[j][2] * v[j][2] + v[j][3] * v[j][3]); }
    const float rstd = rsqrtf(wsum(q) * (1.f / D) + LN_EPS);
#pragma unroll
    for (int j = 0; j < 4; ++j) { const f32x4 gg = *(const f32x4*)(g + 4 * lane + 256 * j), bb = *(const f32x4*)(b + 4 * lane + 256 * j); v[j] = v[j] * rstd * gg + bb; }
}
__device__ __forceinline__ void store_row_f32_bf16(const f32x4 (&v)[4], float* xf, bf16* xb, int lane) {
#pragma unroll
    for (int j = 0; j < 4; ++j) { if (xf) ((f32x4*)xf)[lane + 64 * j] = v[j]; if (xb) { u32x2 o; o.x = cvt_pk_bf16(v[j][0], v[j][1]); o.y = cvt_pk_bf16(v[j][2], v[j][3]); ((u32x2*)xb)[lane + 64 * j] = o; } }
}

__device__ __forceinline__ void route_thread(const float (&lg)[16], const float (&brv)[16], int m, int lt, int* TOK_E, float* TOK_W, LAS int* tokE) {
    float aff[16], sel[16];
#pragma unroll
    for (int e = 0; e < 16; ++e) { aff[e] = 1.f / (1.f + __expf(-lg[e])); sel[e] = aff[e] + brv[e]; }
    int gbest = 0; float gs = -1e30f;
#pragma unroll
    for (int gi = 0; gi < 4; ++gi) { float a = -1e30f, b2 = -1e30f;
#pragma unroll
        for (int j = 0; j < 4; ++j) { const float x = sel[gi * 4 + j]; const bool gt = x > a; b2 = gt ? a : fmaxf(b2, x); a = gt ? x : a; }
        const bool better = a + b2 > gs; gs = better ? a + b2 : gs; gbest = better ? gi : gbest; }
    int i0 = 0, i1 = 0; float a = -1e30f, b2 = -1e30f, wa = 0.f, wb = 0.f;
#pragma unroll
    for (int j = 0; j < 4; ++j) { float x = sel[j], y = aff[j];
#pragma unroll
        for (int gi = 1; gi < 4; ++gi) { x = (gi == gbest) ? sel[gi * 4 + j] : x; y = (gi == gbest) ? aff[gi * 4 + j] : y; }
        const bool g1 = x > a, g2 = x > b2;
        const float nb = g1 ? a : (g2 ? x : b2), nwb = g1 ? wa : (g2 ? y : wb); const int ni1 = g1 ? i0 : (g2 ? j : i1);
        a = g1 ? x : a; wa = g1 ? y : wa; i0 = g1 ? j : i0; b2 = nb; wb = nwb; i1 = ni1; }
    const float inv = 1.f / (wa + wb); const int e0 = gbest * 4 + i0, e1 = gbest * 4 + i1;
    TOK_E[m * 2] = e0; TOK_E[m * 2 + 1] = e1; TOK_W[m * 2] = wa * inv; TOK_W[m * 2 + 1] = wb * inv; tokE[lt * 2] = e0; tokE[lt * 2 + 1] = e1;
}
__device__ __forceinline__ void phase_ln_router(KP p, int layer, LAS unsigned char* lds, int G, int bid, const int wave_s) {
    const int tid = fresh_tid(wave_s), lane = tid & 63, wave = wave_s;
    PSEC_BEGIN(0);
    unsigned char* ws = p->ws;
    LAS float* WT = (LAS float*)lds; LAS int* tokE = (LAS int*)(lds + 65536);
    load_wtab(WT, p->in[I_WR], 16, 0, 16, tid);
    __syncthreads();
    float* XF = p->out; bf16* XB = (bf16*)(ws + WS_XB); int* TOK_E = (int*)(ws + WS_TOKE); float* TOK_W = (float*)(ws + WS_TOKW); int* CNT = (int*)(ws + WS_CNT); int* SLOT_TOK = (int*)(ws + WS_SLOTTOK);
    const float* g = p->in[I_LMG] + layer * D; const float* b = p->in[I_LMB] + layer * D;
#define LNR_LOAD(va, vb, pr) do { const f32x4* s0_ = (const f32x4*)(XF + (size_t)(tb * 128 + wave * 16 + 2 * (pr)) * D) + lane; _Pragma("unroll") for (int j = 0; j < 4; ++j) { va[j] = s0_[64 * j]; vb[j] = s0_[64 * j + 256]; } } while (0)
#define LNR_PROC(va, vb, pr) do { const int lt_ = wave * 16 + 2 * (pr), m_ = tb * 128 + lt_; \
        { PSEC_BEGIN(1); ln_row(va, g, b, lane); ln_row(vb, g, b, lane); \
        store_row_f32_bf16(va, (float*)nullptr, XB + (size_t)m_ * D, lane); store_row_f32_bf16(vb, (float*)nullptr, XB + (size_t)(m_ + 1) * D, lane); PSEC_END(1); } \
        float l0_, l1_; { PSEC_BEGIN(2); row_dots16x2(va, vb, WT, lane, l0_, l1_); asm volatile("" : "+v"(l0_), "+v"(l1_)); PSEC_END(2); } \
        if ((lane & 3) == 0) { LG[lt_ * 16 + (lane >> 2)] = l0_; LG[(lt_ + 1) * 16 + (lane >> 2)] = l1_; } } while (0)
    LAS float* LG = (LAS float*)(lds + 65536 + 1024);
    for (int tb = bid; tb < NTOK / 128; tb += G) {
        f32x4 a0[4], a1[4], b0[4], b1[4];
        LNR_LOAD(a0, a1, 0);
#pragma unroll 1
        for (int pr = 0; pr < 8; pr += 2) {
            LNR_LOAD(b0, b1, pr + 1);
            LNR_PROC(a0, a1, pr);
            if (pr + 2 < 8) LNR_LOAD(a0, a1, pr + 2);
            LNR_PROC(b0, b1, pr + 1);
        }
        __syncthreads();
        if (tid < 128) { PSEC_BEGIN(3); float lg[16], brv[16];
#pragma unroll
            for (int q = 0; q < 4; ++q) { const f32x4 t4 = *(const LAS f32x4*)(LG + tid * 16 + 4 * q); const f32x4 b4 = *(const f32x4*)(p->in[I_BR] + 4 * q);
#pragma unroll
                for (int j = 0; j < 4; ++j) { lg[4 * q + j] = t4[j]; brv[4 * q + j] = b4[j]; } }
            route_thread(lg, brv, tb * 128 + tid, tid, TOK_E, TOK_W, tokE); PSEC_END(3); }
        __syncthreads();
        if (tid < 256) {
            const int e = tokE[tid]; int rank = 0;
            for (int i = 0; i < tid; ++i) rank += (tokE[i] == e) ? 1 : 0;
            SLOT_TOK[(e * 256 + tb) * 128 + rank] = tb * 256 + tid;
        } else if (tid < 272) { const int e = tid - 256; int c = 0; for (int i = 0; i < 256; ++i) c += (tokE[i] == e) ? 1 : 0; CNT[tb * 16 + e] = c; }
        __syncthreads();
    }
    PSEC_END(0);
#undef LNR_LOAD
#undef LNR_PROC
}
struct FfnRow { u32x2 x[4], ya[4], yc[4]; float w0, w1; };
__device__ __forceinline__ void ffn_combine(FfnRow& r, f32x4 (&v)[4]) {
#pragma unroll
    for (int j = 0; j < 4; ++j) { const u32x2 a = r.ya[j], c = r.yc[j]; f32x4 ya, yc;
        ya[0] = __uint_as_float(a.x << 16); ya[1] = __uint_as_float(a.x & 0xffff0000u); ya[2] = __uint_as_float(a.y << 16); ya[3] = __uint_as_float(a.y & 0xffff0000u);
        yc[0] = __uint_as_float(c.x << 16); yc[1] = __uint_as_float(c.x & 0xffff0000u); yc[2] = __uint_as_float(c.y << 16); yc[3] = __uint_as_float(c.y & 0xffff0000u);
        const u32x2 xx = r.x[j]; f32x4 xv; xv[0] = __uint_as_float(xx.x << 16); xv[1] = __uint_as_float(xx.x & 0xffff0000u); xv[2] = __uint_as_float(xx.y << 16); xv[3] = __uint_as_float(xx.y & 0xffff0000u);
        v[j] = xv * DN_ALPHA + ya * r.w0 + yc * r.w1; }
}
__device__ __forceinline__ void phase_ln_ffn(KP p, int layer, LAS unsigned char* lds, int G, int bid, const int wave_s) {
    const int tid = fresh_tid(wave_s), lane = tid & 63, wave = wave_s;
    unsigned char* ws = p->ws;
    LAS float* WT = (LAS float*)lds;
    if (layer == 0) { load_wtab(WT, p->in[I_WKV], KV_IN, 1536, 12, tid); __syncthreads(); }
    const int eo = (lane >> 2) & 15; const float bf = (layer == 0 && eo < 12) ? p->in[I_BFORGET][eo] : 0.f;
    float* XF = p->out; bf16* XB = (bf16*)(ws + WS_XB); const bf16* YS = (const bf16*)(ws + WS_HREG);
    const int* TOK_S = (const int*)(ws + WS_TOKS); const float* TOK_W = (const float*)(ws + WS_TOKW); float* LOGF = (float*)(ws + WS_LOGF);
    const float* g = p->in[I_LFG] + layer * D; const float* b = p->in[I_LFB] + layer * D;
    const int gw = bid * NWAVES + wave, NGW = G * NWAVES;
#define FFN_LOAD(R, m_) do { const int mm_ = (m_); const int s0_ = TOK_S[mm_ * 2], s1_ = TOK_S[mm_ * 2 + 1]; R.w0 = TOK_W[mm_ * 2]; R.w1 = TOK_W[mm_ * 2 + 1]; \
        _Pragma("unroll") for (int j = 0; j < 4; ++j) { R.x[j] = ((const u32x2*)(XB + (size_t)mm_ * D))[lane + 64 * j]; R.ya[j] = ((const u32x2*)(YS + (size_t)s0_ * D))[lane + 64 * j]; R.yc[j] = ((const u32x2*)(YS + (size_t)s1_ * D))[lane + 64 * j]; } } while (0)
#define FFN_PROC(R, m_) do { const int mm_ = (m_); f32x4 v_[4]; ffn_combine(R, v_); ln_row(v_, g, b, lane); \
        store_row_f32_bf16(v_, layer == 0 ? (float*)nullptr : XF + (size_t)mm_ * D, layer == 0 ? XB + (size_t)mm_ * D : (bf16*)nullptr, lane); \
        if (layer == 0) { const float t_ = row_dots16(v_, WT, lane); if ((lane & 3) == 0 && eo < 12) LOGF[(size_t)mm_ * 12 + eo] = log_sigmoid(t_ + bf); } } while (0)
    FfnRow A, B;
    int m = gw;
    if (m < NTOK) FFN_LOAD(A, m);
#pragma unroll 1
    for (; m < NTOK; m += 2 * NGW) {
        const bool hb = (m + NGW) < NTOK;
        if (hb) FFN_LOAD(B, m + NGW);
        FFN_PROC(A, m);
        if (m + 2 * NGW < NTOK) FFN_LOAD(A, m + 2 * NGW);
        if (hb) FFN_PROC(B, m + NGW);
    }
#undef FFN_LOAD
#undef FFN_PROC
}
__device__ __forceinline__ void cum_wave(const float* LOGF, float* CUM, int bh, int lane) {
    const int b = bh / FOX_H, h = bh % FOX_H;
    float loc[64]; float s = 0.f;
#pragma unroll
    for (int i = 0; i < 64; ++i) { s += LOGF[((size_t)b * SEQ + lane * 64 + i) * 12 + h]; loc[i] = s; }
    float inc = s;
#pragma unroll
    for (int o = 1; o < 64; o <<= 1) { const float t = __shfl_up(inc, o); if (lane >= o) inc += t; }
    const float base = inc - s;
#pragma unroll
    for (int i = 0; i < 64; ++i) CUM[(size_t)bh * SEQ + lane * 64 + i] = base + loc[i];
}
constexpr int MOE_MAXU = 6;
__device__ __forceinline__ int moe_setup(unsigned char* ws, LAS unsigned char* lds, int G, int bid, const int wave_s, const bool build_rows) {
    const int tid = fresh_tid(wave_s), lane = tid & 63, wave = wave_s;
    LAS int* PRE = (LAS int*)lds; LAS int* TB = (LAS int*)(lds + 16640); LAS int* TE = TB + 17;
    volatile LAS int* UL = (volatile LAS int*)(lds + MISC_OFF) + 16; LAS int* rowtok = (LAS int*)(lds + ROWTOK_OFF);
    const int* CNT = (const int*)(ws + WS_CNT); const int* SLOT_TOK = (const int*)(ws + WS_SLOTTOK); int* TOK_S = (int*)(ws + WS_TOKS);
#pragma unroll
    for (int q = 0; q < 2; ++q) { const int e = 2 * wave + q;
        int c[4]; int s = 0;
#pragma unroll
        for (int i = 0; i < 4; ++i) { c[i] = CNT[(4 * lane + i) * 16 + e]; s += c[i]; }
        int inc = s;
#pragma unroll
        for (int o = 1; o < 64; o <<= 1) { const int t = __shfl_up(inc, o); if (lane >= o) inc += t; }
        int run = inc - s;
#pragma unroll
        for (int i = 0; i < 4; ++i) { PRE[e * 257 + 4 * lane + i] = run; run += c[i]; }
        if (lane == 63) { PRE[e * 257 + 256] = inc; TE[e] = inc; } }
    __syncthreads();
    if (tid == 0) { int t = 0; for (int e = 0; e < 16; ++e) { TB[e] = t; t += (TE[e] + 255) >> 8; } TB[16] = t; }
    __syncthreads();
    const int NT = TB[16];
    if (tid == 0) { int n = 0;
        for (int i = 0; i < MOE_MAXU; ++i) { const int L = i * G + bid, tile = (L & 7) + 8 * (L >> 5), pn = (L >> 3) & 3; if (tile >= NT) break;
            int e = 0; for (int k = 1; k < 16; ++k) if (TB[k] <= tile) e = k;
            UL[3 * n] = tile; UL[3 * n + 1] = pn; UL[3 * n + 2] = e; ++n; }
        UL[24] = n; }
    __syncthreads();
    const int nunits = __builtin_amdgcn_readfirstlane(UL[24]);
    if (build_rows) {
        for (int i = (tid >> 8); i < nunits; i += 2) { const int tile = UL[3 * i], pn = UL[3 * i + 1], e = UL[3 * i + 2], j = tid & 255;
            const int r = 256 * (tile - TB[e]) + j; int tok = 0;
            if (r < TE[e]) { int lo = 0, hi = 256;
                while (hi - lo > 1) { const int mid = (lo + hi) >> 1; if (PRE[e * 257 + mid] <= r) lo = mid; else hi = mid; }
                const int ent = SLOT_TOK[(e * 256 + lo) * 128 + (r - PRE[e * 257 + lo])]; tok = ent >> 1;
                if (pn == 0) TOK_S[ent] = 256 * tile + j; }
            rowtok[i * 256 + j] = tok; }
    }
    __syncthreads();
    return nunits;
}
struct MoeGU {
    const char* XBp; const char* W; LAS const int* UL; LAS const int* rowtok; int nunits;
    __device__ __forceinline__ bool next(int i, Unit& u) const { if (i >= nunits) return false;
        u.pm = __builtin_amdgcn_readfirstlane(UL[3 * i]); u.pn = __builtin_amdgcn_readfirstlane(UL[3 * i + 1]); u.e = __builtin_amdgcn_readfirstlane(UL[3 * i + 2]); u.ord = i;
        u.A = XBp; u.B = W + ((size_t)u.e * 1024 + (size_t)u.pn * 256) * D * 2; return true; }
    __device__ __forceinline__ unsigned a_off(const Unit& u, int h, int R, int C) const { return (unsigned)(rowtok[u.ord * 256 + R + HALF * h] * D + C) * 2u; }
};
struct MoeDown {
    const char* Hp; const char* W; LAS const int* UL; int nunits;
    __device__ __forceinline__ bool next(int i, Unit& u) const { if (i >= nunits) return false;
        u.pm = __builtin_amdgcn_readfirstlane(UL[3 * i]); u.pn = __builtin_amdgcn_readfirstlane(UL[3 * i + 1]); u.e = __builtin_amdgcn_readfirstlane(UL[3 * i + 2]); u.ord = i;
        u.A = Hp + (size_t)u.pm * BM * DEXP * 2; u.B = W + ((size_t)u.e * 1024 + (size_t)u.pn * 256) * DEXP * 2; return true; }
    __device__ __forceinline__ unsigned a_off(const Unit&, int h, int R, int C) const { return (unsigned)((R + HALF * h) * DEXP + C) * 2u; }
};
struct EpiGateUp { bf16* H;
    __device__ __forceinline__ void operator()(const f32x4 (&acc)[2][2][4][2], const Unit& u, int wr, int wc, int fr, int fq) const {
        bf16* rowp = H + (size_t)(u.pm * BM + wr * 64 + fr) * DEXP + (u.pn * 128 + wc * 32 + 8 * fq);
#pragma unroll
        for (int ai = 0; ai < 2; ++ai) {
#pragma unroll
            for (int m = 0; m < 4; ++m) { float hv[8];
#pragma unroll
                for (int n = 0; n < 2; ++n)
#pragma unroll
                    for (int j = 0; j < 4; ++j) { const float g = acc[ai][0][m][n][j], up = acc[ai][1][m][n][j]; hv[4 * n + j] = g * __builtin_amdgcn_rcpf(1.f + __expf(-g)) * up; }
                u32x4 w; w.x = cvt_pk_bf16(hv[0], hv[1]); w.y = cvt_pk_bf16(hv[2], hv[3]); w.z = cvt_pk_bf16(hv[4], hv[5]); w.w = cvt_pk_bf16(hv[6], hv[7]);
                *(u32x4*)rowp = w;
                rowp += (size_t)16 * DEXP; asm volatile("" : "+v"(rowp)); }
            rowp += (size_t)64 * DEXP; }
    } };
__device__ __forceinline__ int crow(int r, int hi) { return (r & 3) + 8 * (r >> 2) + 4 * hi; }
__device__ __forceinline__ unsigned cvtpk_s(float lo, float hi) { typedef float f2 __attribute__((ext_vector_type(2))); typedef __bf16 b2 __attribute__((ext_vector_type(2))); f2 v = {lo, hi}; b2 b = __builtin_convertvector(v, b2); return __builtin_bit_cast(unsigned, b); }
__device__ __forceinline__ float bfbits2f(unsigned short v) { return __uint_as_float(((unsigned)v) << 16); }

constexpr int AT_NSLOT = 4, AT_SLOT = 16640, AT_K = 0, AT_V = 8192, AT_KB = 16384, AT_WS = AT_NSLOT * AT_SLOT, AT_OST = AT_WS + 2048, AT_BYTES = AT_OST + 8 * 4096;
static_assert(AT_BYTES <= RING_BYTES, "attention LDS");
__device__ __forceinline__ void glds_asm16(const void* gsrc, unsigned lds_dst) { unsigned keep;
    asm volatile("s_mov_b32 %0, m0\n\ts_mov_b32 m0, %2\n\ts_nop 0\n\tglobal_load_lds_dwordx4 %1, off\n\ts_mov_b32 m0, %0" : "=&s"(keep) : "v"(gsrc), "s"(lds_dst) : "memory"); }
__device__ __forceinline__ void glds_asm4(const void* gsrc, unsigned lds_dst) { unsigned keep;
    asm volatile("s_mov_b32 %0, m0\n\ts_mov_b32 m0, %2\n\ts_nop 0\n\tglobal_load_lds_dword %1, off\n\ts_mov_b32 m0, %0" : "=&s"(keep) : "v"(gsrc), "s"(lds_dst) : "memory"); }
constexpr float AT_THR = 10.0f;
template <bool FOX>
__device__ __forceinline__ void attn_qk(const LAS unsigned char* slot, const bf16x8 (&qr)[4], float mref, f32x16& p0, f32x16& p1, int r32, int hi) {
    const LAS unsigned char* kb = slot + AT_K + hi * 1024 + r32 * 16; const LAS float* kbs = (const LAS float*)(slot + AT_KB);
    if (FOX) { const float nm = -mref;
#pragma unroll
        for (int g = 0; g < 4; ++g) { const f32x4 b0 = *(const LAS f32x4*)(kbs + 8 * g + 4 * hi), b1 = *(const LAS f32x4*)(kbs + 32 + 8 * g + 4 * hi);
#pragma unroll
            for (int j = 0; j < 4; ++j) { p0[4 * g + j] = __builtin_fmaf(b0[j], -LOG2E, nm); p1[4 * g + j] = __builtin_fmaf(b1[j], -LOG2E, nm); } }
    } else { p0 = f32x16{}; p1 = f32x16{}; }
#pragma unroll
    for (int d0 = 0; d0 < 4; ++d0) { const bf16x8 b0 = *(const LAS bf16x8*)(kb + d0 * 2048), b1 = *(const LAS bf16x8*)(kb + d0 * 2048 + 512);
        p0 = __builtin_amdgcn_mfma_f32_32x32x16_bf16(b0, qr[d0], p0, 0, 0, 0); p1 = __builtin_amdgcn_mfma_f32_32x32x16_bf16(b1, qr[d0], p1, 0, 0, 0); }
}
template <bool FOX>
__device__ __forceinline__ void attn_sm_pv(const LAS unsigned char* slot, f32x16& p0, f32x16& p1, f32x16& n0, f32x16& n1, bool has_next, f32x16 (&o)[2], float& mref, float& lrun, LAS float* wsf, int vb0, int jb, int qrel, int r32, int hi) {
    if (FOX) {
        if (jb >= 0) { const int kbase = 64 * jb + 4 * hi;
#pragma unroll
            for (int r = 0; r < 16; ++r) { const int kv = kbase + (r & 3) + 8 * (r >> 2); if (kv > qrel) p0[r] = -INFINITY; if (kv + 32 > qrel) p1[r] = -INFINITY; } }
    } else { const float nm = -mref;
#pragma unroll
        for (int r = 0; r < 16; ++r) { p0[r] = __builtin_fmaf(p0[r], QC2, nm); p1[r] = __builtin_fmaf(p1[r], QC2, nm); }
    }
    float rm = fmaxf(p0[0], p1[0]);
#pragma unroll
    for (int r = 1; r < 16; ++r) rm = fmaxf(rm, fmaxf(p0[r], p1[r]));
    { auto rr = __builtin_amdgcn_permlane32_swap(__float_as_uint(rm), __float_as_uint(rm), false, false); rm = fmaxf(__uint_as_float(rr[0]), __uint_as_float(rr[1])); }
    const bool move = (rm > AT_THR) || (lrun == 0.f && rm > -1e30f);
    if (__builtin_expect(__any(move), 0)) {
        const float dl = move ? rm : 0.f, f = __builtin_amdgcn_exp2f(fminf(-dl, 64.f));
        mref += dl; lrun *= f;
#pragma unroll
        for (int r = 0; r < 16; ++r) { p0[r] -= dl; p1[r] -= dl; }
        if (FOX && has_next) {
#pragma unroll
            for (int r = 0; r < 16; ++r) { n0[r] -= dl; n1[r] -= dl; } }
        if (hi == 0) wsf[r32] = f;
        asm volatile("s_waitcnt lgkmcnt(0)" ::: "memory");
#pragma unroll
        for (int g = 0; g < 4; ++g) { const f32x4 a = *(const LAS f32x4*)(wsf + 8 * g + 4 * hi);
#pragma unroll
            for (int j = 0; j < 4; ++j) { o[0][4 * g + j] *= a[j]; o[1][4 * g + j] *= a[j]; } }
    }
    float rs = 0.f;
#pragma unroll
    for (int r = 0; r < 16; ++r) { p0[r] = __builtin_amdgcn_exp2f(p0[r]); p1[r] = __builtin_amdgcn_exp2f(p1[r]); rs += p0[r] + p1[r]; }
    { auto rr = __builtin_amdgcn_permlane32_swap(__float_as_uint(rs), __float_as_uint(rs), false, false); rs = __uint_as_float(rr[0]) + __uint_as_float(rr[1]); }
    lrun += rs;
    u32x4 pw[4];
#pragma unroll
    for (int k = 0; k < 2; ++k) {
        pw[k] = (u32x4){cvtpk_s(p0[8 * k], p0[8 * k + 1]), cvtpk_s(p0[8 * k + 2], p0[8 * k + 3]), cvtpk_s(p0[8 * k + 4], p0[8 * k + 5]), cvtpk_s(p0[8 * k + 6], p0[8 * k + 7])};
        pw[2 + k] = (u32x4){cvtpk_s(p1[8 * k], p1[8 * k + 1]), cvtpk_s(p1[8 * k + 2], p1[8 * k + 3]), cvtpk_s(p1[8 * k + 4], p1[8 * k + 5]), cvtpk_s(p1[8 * k + 6], p1[8 * k + 7])}; }
    const int vb = vb0 + (int)(unsigned)(size_t)slot;
#pragma unroll
    for (int d0 = 0; d0 < 2; ++d0) { s16x4 vlo[4], vhi[4];
#pragma unroll
        for (int ks = 0; ks < 4; ++ks) {
            asm volatile("ds_read_b64_tr_b16 %0,%1 offset:%c2" : "=&v"(vlo[ks]) : "v"(vb), "i"(d0 * 4096 + ks * 1024) : "memory");
            asm volatile("ds_read_b64_tr_b16 %0,%1 offset:%c2" : "=&v"(vhi[ks]) : "v"(vb), "i"(d0 * 4096 + ks * 1024 + 512) : "memory"); }
        asm volatile("s_waitcnt lgkmcnt(0)" ::: "memory"); __builtin_amdgcn_sched_barrier(0);
#pragma unroll
        for (int ks = 0; ks < 4; ++ks) { const bf16x8 vf = (bf16x8){vlo[ks][0], vlo[ks][1], vlo[ks][2], vlo[ks][3], vhi[ks][0], vhi[ks][1], vhi[ks][2], vhi[ks][3]};
            o[d0] = __builtin_amdgcn_mfma_f32_32x32x16_bf16(__builtin_bit_cast(bf16x8, pw[ks]), vf, o[d0], 0, 0, 0); }
    }
}
template <bool FOX>
__device__ __forceinline__ void attn_unit(LAS unsigned char* lds, const bf16* Qp, int qpitch, const bf16* Kp, const bf16* Vp, int kvpitch, int NT, const float* cum, bf16* Op, int opitch, const bf16* OGp, int gpitch, const int wave_s) {
    const int tid = fresh_tid(wave_s), lane = tid & 63, wid = wave_s, r32 = lane & 31, hi = lane >> 5;
    LAS float* wsf = (LAS float*)(lds + AT_WS) + wid * 64;
    bf16x8 qr[4];
#pragma unroll
    for (int d0 = 0; d0 < 4; ++d0) qr[d0] = *(const bf16x8*)(Qp + (size_t)(wid * 32 + r32) * qpitch + d0 * 16 + hi * 8);
    const bf16* ksrc = Kp + (size_t)lane * kvpitch + wid * 8;
    const bf16* vsrc = Vp + (size_t)(16 * (wid & 3) + (lane >> 2)) * kvpitch + (wid >> 2) * 32 + (lane & 3) * 8;
    const int vb0 = AT_V + ((lane >> 4) & 1) * 32 + (lane & 3) * 8 + (4 * hi + ((lane & 15) >> 2)) * 64;
    float mref = 0.f, lrun = 0.f; f32x16 o[2]; o[0] = f32x16{}; o[1] = f32x16{};
    const int qrel = wid * 32 + r32; const size_t tstep = (size_t)64 * kvpitch;
    constexpr int ND = FOX ? 3 : 2;
#define AT_TILE(tt) (FOX ? NT - 1 - (tt) : (tt))
#define AT_ISSUE(tt) do { const unsigned sl_ = ldsb + (unsigned)(((tt) & (AT_NSLOT - 1)) * AT_SLOT); const int kt_ = AT_TILE(tt); \
        glds_asm16(ksrc + (size_t)kt_ * tstep, (unsigned)__builtin_amdgcn_readfirstlane(sl_ + AT_K + wid * 1024)); \
        glds_asm16(vsrc + (size_t)kt_ * tstep, (unsigned)__builtin_amdgcn_readfirstlane(sl_ + AT_V + wid * 1024)); \
        if (FOX) glds_asm4(cum + kt_ * 64 + lane, (unsigned)__builtin_amdgcn_readfirstlane(sl_ + AT_KB)); } while (0)
    const unsigned ldsb = (unsigned)(size_t)lds;
    AT_ISSUE(0); AT_ISSUE(1); AT_ISSUE(2);
#define AT_WAIT1() do { if (FOX) asm volatile("s_waitcnt vmcnt(3)" ::: "memory"); else asm volatile("s_waitcnt vmcnt(2)" ::: "memory"); } while (0)
#define AT_SLOTP(tt) (lds + ((tt) & (AT_NSLOT - 1)) * AT_SLOT)
#define AT_STEP(PC0, PC1, PN0, PN1, tt) do { const int t_ = (tt); const bool hn_ = t_ + 1 < NT; \
        if (t_ + 2 < NT) AT_WAIT1(); else asm volatile("s_waitcnt vmcnt(0)" ::: "memory"); \
        __builtin_amdgcn_s_barrier(); asm volatile("" ::: "memory"); \
        if (t_ + 3 < NT) AT_ISSUE(t_ + 3); \
        if (hn_) attn_qk<FOX>(AT_SLOTP(t_ + 1), qr, mref, PN0, PN1, r32, hi); \
        attn_sm_pv<FOX>(AT_SLOTP(t_), PC0, PC1, PN0, PN1, hn_, o, mref, lrun, wsf, vb0, AT_TILE(t_) - (NT - 4), qrel, r32, hi); } while (0)
    f32x16 a0, a1, b0, b1;
    if (FOX) asm volatile("s_waitcnt vmcnt(6)" ::: "memory"); else asm volatile("s_waitcnt vmcnt(4)" ::: "memory");
    __builtin_amdgcn_s_barrier(); asm volatile("" ::: "memory");
    attn_qk<FOX>(AT_SLOTP(0), qr, mref, a0, a1, r32, hi);
#pragma unroll 1
    for (int t = 0; t < NT; t += 2) { AT_STEP(a0, a1, b0, b1, t); AT_STEP(b0, b1, a0, a1, t + 1); }
#undef AT_STEP
#undef AT_WAIT1
#undef AT_SLOTP
#undef AT_ISSUE
#undef AT_TILE
    static_assert(ND == 3 || ND == 2, "");
    if (hi == 0) wsf[32 + r32] = lrun;
    asm volatile("s_waitcnt lgkmcnt(0)" ::: "memory");
    LAS bf16* stg = (LAS bf16*)(lds + AT_OST) + wid * 2048;
#pragma unroll
    for (int r = 0; r < 16; ++r) { const int orow = crow(r, hi); const float rl = __builtin_amdgcn_rcpf(wsf[32 + orow]);
#pragma unroll
        for (int d0 = 0; d0 < 2; ++d0) stg[orow * 64 + d0 * 32 + r32] = f2bf(o[d0][r] * rl); }
    asm volatile("s_waitcnt lgkmcnt(0)" ::: "memory");
#pragma unroll
    for (int i = 0; i < 4; ++i) { const int row = i * 8 + (lane >> 3), ch = lane & 7; u32x4 v = *(const LAS u32x4*)(stg + row * 64 + ch * 8);
        const size_t go = (size_t)(wid * 32 + row) * opitch + ch * 8;
        if (FOX) { const u32x4 g = *(const u32x4*)(OGp + (size_t)(wid * 32 + row) * gpitch + ch * 8); unsigned vv[4] = {v.x, v.y, v.z, v.w}; const unsigned gg[4] = {g.x, g.y, g.z, g.w};
#pragma unroll
            for (int k = 0; k < 4; ++k) { const float a0 = __uint_as_float(vv[k] << 16), a1 = __uint_as_float(vv[k] & 0xffff0000u), g0 = __uint_as_float(gg[k] << 16), g1 = __uint_as_float(gg[k] & 0xffff0000u);
                vv[k] = cvtpk_s(a0 * __builtin_amdgcn_rcpf(1.f + __expf(-g0)), a1 * __builtin_amdgcn_rcpf(1.f + __expf(-g1))); }
            v = (u32x4){vv[0], vv[1], vv[2], vv[3]}; }
        *(u32x4*)(Op + go) = v; }
    __syncthreads();
}
__device__ __forceinline__ void phase_attn_fox(unsigned char* ws, LAS unsigned char* lds, int G, int bid, const int wave_s) {
    const bf16* Q = (const bf16*)(ws + WS_HREG); const bf16* K = (const bf16*)(ws + WS_HREG + HR_48); const bf16* V = (const bf16*)(ws + WS_HREG + 2 * HR_48); const bf16* OG = (const bf16*)(ws + WS_HREG + 3 * HR_48);
    const float* CUM = (const float*)(ws + WS_CUM); bf16* OC = (bf16*)(ws + WS_GREG);
    for (int v = bid; v < 256; v += G) {
        const int g = v & 31, jm = v >> 5;
        for (int i = 0; i < 6; ++i) { const int pidx = 3 * jm + (i >> 1), bh = 3 * g + (pidx >> 3), s = pidx & 7, qb = (i & 1) ? 15 - s : s;
            const int b = bh / FOX_H, h = bh % FOX_H; const size_t row0 = (size_t)b * SEQ;
            attn_unit<true>(lds, Q + (row0 + qb * 256) * 768 + h * 64, 768, K + row0 * 768 + h * 64, V + row0 * 768 + h * 64, 768, 4 * (qb + 1), CUM + (size_t)bh * SEQ,
                            OC + (row0 + qb * 256) * D + h * 64, D, OG + (row0 + qb * 256) * 768 + h * 64, 768, wave_s); }
    }
}
__device__ __forceinline__ void phase_attn_mem(unsigned char* ws, LAS unsigned char* lds, int layer, int G, int bid, const int wave_s) {
    const bf16* MQ = (const bf16*)(ws + WS_HREG + (layer == 0 ? 3 : 4) * HR_48); const bf16* MKV = (const bf16*)(ws + WS_MKV); bf16* OC = (bf16*)(ws + (layer == 0 ? WS_XB : WS_GREG));
    for (int u = bid; u < 512; u += G) { const int b = u >> 6, hd = (u >> 4) & 3, qblk = u & 15; const size_t row0 = (size_t)b * SEQ + qblk * 256;
        const bf16* Kp = MKV + (size_t)b * NMEM * 1024 + layer * 512 + hd * 64;
        attn_unit<false>(lds, MQ + row0 * 256 + hd * 64, 256, Kp, Kp + 256, 1024, 4, nullptr, OC + row0 * D + 768 + hd * 64, D, nullptr, 0, wave_s); }
}
constexpr int GL_QP = 208, GL_VP = 448, GL_KX = 0, GL_QD = 13312, GL_VT = 26624, GL_HEAD = 55296;
constexpr int GL_GLR = 2 * GL_HEAD, GL_TOT = GL_GLR + 4096, GL_SSX = GL_TOT + 1536, GL_BYTES = GL_SSX + 1024;
static_assert(GL_BYTES <= RING_BYTES, "GLA LDS");
typedef short v4i16_t __attribute__((ext_vector_type(4)));
__device__ __forceinline__ s16x4 trd(const LAS unsigned char* p) { return __builtin_bit_cast(s16x4, __builtin_amdgcn_ds_read_tr16_b64_v4i16((LAS v4i16_t*)p)); }
__device__ __forceinline__ float fast_log_sigmoid(float z) { return fminf(z, 0.f) - __logf(1.f + __expf(-fabsf(z))); }

__device__ __forceinline__ void gla_stage(unsigned char* ws, LAS unsigned char* lds, int tid, int b, int n, int hp) {
    const bf16* V = (const bf16*)(ws + WS_HREG + HR_48); const float* GLR = (const float*)(ws + WS_GLR);
    const size_t m0 = (size_t)b * SEQ + n * 64;
#pragma unroll
    for (int i = 0; i < 6; ++i) { const int pi = tid + 512 * i, u = pi / 1536, rem = pi % 1536, row = rem / 24, ch = rem % 24;
        const u32x4 v = *(const u32x4*)(V + (m0 + row) * 768 + 192 * (2 * hp + u) + 8 * ch);
        *(LAS u32x4*)(lds + u * GL_HEAD + GL_VT + row * GL_VP + ch * 16) = v; }
    if (tid < 256) { const f32x4 g = *(const f32x4*)(GLR + m0 * 16 + 4 * tid); *(LAS f32x4*)(lds + GL_GLR + 16 * tid) = g; }
}
template <int MODE>
__device__ __forceinline__ void gla_gates(KP p, unsigned char* ws, LAS unsigned char* lds, int tid, int b, int n, int hp) {
    const bf16* QK = (const bf16*)(ws + WS_HREG); float* DEC = (float*)(ws + WS_DEC);
    const size_t m0 = (size_t)b * SEQ + n * 64;
    LAS float* glr = (LAS float*)(lds + GL_GLR); LAS float* totl = (LAS float*)(lds + GL_TOT);
    float la[32]; float tot = 0.f; int col = 0, th = 0, u = 0, kidx = 0, head = 0;
    if (tid < 384) { col = tid % 192; th = tid / 192; u = col / 96; kidx = col % 96; head = 2 * hp + u;
        float w[16];
#pragma unroll
        for (int j = 0; j < 16; ++j) w[j] = p->in[I_WGUP][j * 384 + 96 * head + kidx];
        const float bg = p->in[I_BGATE][96 * head + kidx];
#pragma unroll
        for (int i = 0; i < 32; ++i) { const LAS float* gr = glr + (32 * th + i) * 16; float z = bg;
#pragma unroll
            for (int j4 = 0; j4 < 4; ++j4) { const f32x4 g = *(const LAS f32x4*)(gr + 4 * j4); z += g[0] * w[4 * j4] + g[1] * w[4 * j4 + 1] + g[2] * w[4 * j4 + 2] + g[3] * w[4 * j4 + 3]; }
            la[i] = fast_log_sigmoid(z) * (1.f / 16.f); tot += la[i]; }
        totl[th * 192 + col] = tot; }
    __syncthreads();
    if (tid < 384) {
        LAS bf16* KX = (LAS bf16*)(lds + u * GL_HEAD + GL_KX); LAS bf16* QD = (LAS bf16*)(lds + u * GL_HEAD + GL_QD);
        const bf16* qk = QK + (m0 + 32 * th) * 768 + 96 * head + kidx;
        if (MODE == 0) {
            float run = (th == 1) ? 0.f : totl[192 + col];
#pragma unroll
            for (int i = 31; i >= 0; --i) { const float kv = bf2f(qk[(size_t)i * 768 + 384]); KX[(32 * th + i) * (GL_QP / 2) + kidx] = f2bf(kv * __expf(run)); run += la[i]; }
            if (th == 0) DEC[(((size_t)b * 64 + n) * 4 + head) * 96 + kidx] = __expf(run);
        } else {
            float run = (th == 0) ? 0.f : totl[col];
#pragma unroll
            for (int i = 0; i < 32; ++i) { run += la[i]; const float qv = bf2f(qk[(size_t)i * 768]), kv = bf2f(qk[(size_t)i * 768 + 384]);
                QD[(32 * th + i) * (GL_QP / 2) + kidx] = f2bf(qv * __expf(run) * 0.10206207261596577f); KX[(32 * th + i) * (GL_QP / 2) + kidx] = f2bf(kv * __expf(-run)); }
        }
    }
    __syncthreads();
}
__device__ __forceinline__ void phase_gla_kv(KP p, LAS unsigned char* lds, int G, int bid, const int wave_s) {
    unsigned char* ws = p->ws; bf16* SKV = (bf16*)(ws + WS_GREG);
    for (int unit = bid; unit < NB * 64 * 2; unit += G) {
        const int tid = fresh_tid(wave_s), lane = tid & 63, wid = wave_s;
        const int hp = unit & 1, n = (unit >> 1) & 63, b = unit >> 7;
        gla_stage(ws, lds, tid, b, n, hp);
        __syncthreads();
        gla_gates<0>(p, ws, lds, tid, b, n, hp);
        const int u = wid >> 2, j4 = wid & 3, head = 2 * hp + u, r32 = lane & 31, h2 = lane >> 5, q = (lane & 15) >> 2, pp = lane & 3, g1 = (lane >> 4) & 1;
        const LAS unsigned char* ka = lds + u * GL_HEAD + GL_KX + (8 * h2 + q) * GL_QP + (16 * g1 + 4 * pp) * 2;
        const LAS unsigned char* va = lds + u * GL_HEAD + GL_VT + (8 * h2 + q) * GL_VP + (16 * g1 + 4 * pp) * 2;
        bf16* outb = SKV + ((((size_t)b * 64 + n) * 4 + head) * 192) * 96;
        for (int id = j4; id < 18; id += 4) { const int kb = id / 6, cb = id % 6;
            f32x16 acc = f32x16{};
#pragma unroll
            for (int ks = 0; ks < 4; ++ks) {
                const s16x4 a0 = trd(ka + ks * 16 * GL_QP + kb * 64), a1 = trd(ka + ks * 16 * GL_QP + 4 * GL_QP + kb * 64);
                const s16x4 b0 = trd(va + ks * 16 * GL_VP + cb * 64), b1 = trd(va + ks * 16 * GL_VP + 4 * GL_VP + cb * 64);
                acc = __builtin_amdgcn_mfma_f32_32x32x16_bf16((bf16x8){a0[0], a0[1], a0[2], a0[3], a1[0], a1[1], a1[2], a1[3]}, (bf16x8){b0[0], b0[1], b0[2], b0[3], b1[0], b1[1], b1[2], b1[3]}, acc, 0, 0, 0); }
            bf16* op = outb + (size_t)(32 * cb + r32) * 96 + 32 * kb + 4 * h2;
#pragma unroll
            for (int g = 0; g < 4; ++g) { u32x2 w; w.x = cvtpk_s(acc[4 * g], acc[4 * g + 1]); w.y = cvtpk_s(acc[4 * g + 2], acc[4 * g + 3]); *(u32x2*)(op + 8 * g) = w; }
        }
        __syncthreads();
    }
}
__device__ __forceinline__ void phase_gla_scan(unsigned char* ws, int G, int bid, const int wave_s) {
    bf16* SKV = (bf16*)(ws + WS_GREG); const float* DEC = (const float*)(ws + WS_DEC);
    const int tid = fresh_tid(wave_s);
    constexpr int NITEM = NB * 4 * 192 * 12;
    const int per = (NITEM + G - 1) / G;
    for (int it = tid; it < per; it += NTHREADS) { const int item = bid * per + it; if (item >= NITEM) break;
        const int k8 = item % 12, c = (item / 12) % 192, bh = item / (12 * 192), b = bh >> 2, h = bh & 3;
        float s[8];
#pragma unroll
        for (int j = 0; j < 8; ++j) s[j] = 0.f;
        u32x4* ptr = (u32x4*)(SKV + ((((size_t)b * 64) * 4 + h) * 192 + c) * 96 + 8 * k8); const float* dp = DEC + (((size_t)b * 64) * 4 + h) * 96 + 8 * k8;
#pragma unroll 1
        for (int n0 = 0; n0 < 64; n0 += 8) { u32x4 kv[8]; f32x4 d0[8], d1[8];
#pragma unroll
            for (int i = 0; i < 8; ++i) { kv[i] = ptr[(size_t)(n0 + i) * (4 * 192 * 96 / 8)]; d0[i] = *(const f32x4*)(dp + (size_t)(n0 + i) * 4 * 96); d1[i] = *(const f32x4*)(dp + (size_t)(n0 + i) * 4 * 96 + 4); }
#pragma unroll
            for (int i = 0; i < 8; ++i) { u32x4 o; o.x = cvtpk_s(s[0], s[1]); o.y = cvtpk_s(s[2], s[3]); o.z = cvtpk_s(s[4], s[5]); o.w = cvtpk_s(s[6], s[7]); ptr[(size_t)(n0 + i) * (4 * 192 * 96 / 8)] = o;
                const unsigned kw[4] = {kv[i].x, kv[i].y, kv[i].z, kv[i].w};
#pragma unroll
                for (int j = 0; j < 4; ++j) { const float dlo = j < 2 ? d0[i][2 * j] : d1[i][2 * j - 4], dhi = j < 2 ? d0[i][2 * j + 1] : d1[i][2 * j - 3];
                    s[2 * j] = dlo * s[2 * j] + __uint_as_float(kw[j] << 16); s[2 * j + 1] = dhi * s[2 * j + 1] + __uint_as_float(kw[j] & 0xffff0000u); } } }
    }
}
__device__ __forceinline__ void phase_gla_out(KP p, LAS unsigned char* lds, int G, int bid, const int wave_s) {
    unsigned char* ws = p->ws; const bf16* SKV = (const bf16*)(ws + WS_GREG); const bf16* R = (const bf16*)(ws + WS_HREG + 2 * HR_48); bf16* OC = (bf16*)(ws + WS_XB);
    for (int unit = bid; unit < NB * 64 * 2; unit += G) {
        const int tid = fresh_tid(wave_s), lane = tid & 63, wid = wave_s;
        const int hp = unit & 1, n = (unit >> 1) & 63, b = unit >> 7;
        gla_stage(ws, lds, tid, b, n, hp);
        __syncthreads();
        gla_gates<1>(p, ws, lds, tid, b, n, hp);
        const int u = wid >> 2, tb = wid & 1, ch = (wid >> 1) & 1, head = 2 * hp + u, r32 = lane & 31, h2 = lane >> 5, q = (lane & 15) >> 2, pp = lane & 3, g1 = (lane >> 4) & 1;
        const LAS unsigned char* kx = lds + u * GL_HEAD + GL_KX + r32 * GL_QP + 16 * h2;
        const LAS unsigned char* qd = lds + u * GL_HEAD + GL_QD + (32 * tb + r32) * GL_QP + 16 * h2;
        const LAS unsigned char* va = lds + u * GL_HEAD + GL_VT + (4 * h2 + q) * GL_VP + (16 * g1 + 4 * pp) * 2;
        bf16x8 qf[6];
#pragma unroll
        for (int ks = 0; ks < 6; ++ks) qf[ks] = *(const LAS bf16x8*)(qd + 32 * ks);
        f32x16 at0 = f32x16{}, at1 = f32x16{};
#pragma unroll
        for (int ks = 0; ks < 6; ++ks) at0 = __builtin_amdgcn_mfma_f32_32x32x16_bf16(*(const LAS bf16x8*)(kx + 32 * ks), qf[ks], at0, 0, 0, 0);
        if (tb == 1) {
#pragma unroll
            for (int ks = 0; ks < 6; ++ks) at1 = __builtin_amdgcn_mfma_f32_32x32x16_bf16(*(const LAS bf16x8*)(kx + 32 * GL_QP + 32 * ks), qf[ks], at1, 0, 0, 0);
        }
#pragma unroll
        for (int r = 0; r < 16; ++r) { const bool keep = crow(r, h2) <= r32; if (tb == 0) { if (!keep) at0[r] = 0.f; } else { if (!keep) at1[r] = 0.f; } }
        bf16x8 pb[4];
#pragma unroll
        for (int k2 = 0; k2 < 2; ++k2) {
            pb[k2] = __builtin_bit_cast(bf16x8, (u32x4){cvtpk_s(at0[8 * k2], at0[8 * k2 + 1]), cvtpk_s(at0[8 * k2 + 2], at0[8 * k2 + 3]), cvtpk_s(at0[8 * k2 + 4], at0[8 * k2 + 5]), cvtpk_s(at0[8 * k2 + 6], at0[8 * k2 + 7])});
            pb[2 + k2] = __builtin_bit_cast(bf16x8, (u32x4){cvtpk_s(at1[8 * k2], at1[8 * k2 + 1]), cvtpk_s(at1[8 * k2 + 2], at1[8 * k2 + 3]), cvtpk_s(at1[8 * k2 + 4], at1[8 * k2 + 5]), cvtpk_s(at1[8 * k2 + 6], at1[8 * k2 + 7])}); }
        const bf16* sg = SKV + ((((size_t)b * 64 + n) * 4 + head) * 192 + 96 * ch + r32) * 96 + 8 * h2;
        f32x16 o[3];
#pragma unroll
        for (int cbl = 0; cbl < 3; ++cbl) { const int cb = 3 * ch + cbl; f32x16 acc = f32x16{};
#pragma unroll
            for (int kq = 0; kq < 4; ++kq) { if (kq < 2 || tb == 1) {
                const s16x4 a0 = trd(va + kq * 16 * GL_VP + cb * 64), a1 = trd(va + kq * 16 * GL_VP + 8 * GL_VP + cb * 64);
                acc = __builtin_amdgcn_mfma_f32_32x32x16_bf16((bf16x8){a0[0], a0[1], a0[2], a0[3], a1[0], a1[1], a1[2], a1[3]}, pb[kq], acc, 0, 0, 0); } }
#pragma unroll
            for (int ks = 0; ks < 6; ++ks) { const bf16x8 sf = *(const bf16x8*)(sg + (size_t)(32 * cbl) * 96 + 16 * ks);
                acc = __builtin_amdgcn_mfma_f32_32x32x16_bf16(sf, qf[ks], acc, 0, 0, 0); }
            o[cbl] = acc; }
        float ss = 0.f;
#pragma unroll
        for (int cbl = 0; cbl < 3; ++cbl)
#pragma unroll
            for (int r = 0; r < 16; ++r) ss += o[cbl][r] * o[cbl][r];
        { auto rr = __builtin_amdgcn_permlane32_swap(__float_as_uint(ss), __float_as_uint(ss), false, false); ss = __uint_as_float(rr[0]) + __uint_as_float(rr[1]); }
        LAS float* ssx = (LAS float*)(lds + GL_SSX);
        if (h2 == 0) ssx[((u * 2 + tb) * 2 + ch) * 32 + r32] = ss;
        __syncthreads();
        ss += ssx[((u * 2 + tb) * 2 + (ch ^ 1)) * 32 + r32];
        const float rs = rsqrtf(ss * (1.f / 192.f) + RMS_EPS);
        const size_t m = (size_t)b * SEQ + n * 64 + 32 * tb + r32;
        const bf16* rp = R + m * 768 + 192 * head + 96 * ch + 4 * h2; bf16* op = OC + m * D + 192 * head + 96 * ch + 4 * h2; const float* gp = p->in[I_GLAG] + 96 * ch + 4 * h2;
#pragma unroll
        for (int cbl = 0; cbl < 3; ++cbl)
#pragma unroll
            for (int g = 0; g < 4; ++g) { const int co = 32 * cbl + 8 * g; const u32x2 rv = *(const u32x2*)(rp + co); const f32x4 gn = *(const f32x4*)(gp + co);
                const float r0 = __uint_as_float(rv.x << 16), r1 = __uint_as_float(rv.x & 0xffff0000u), r2 = __uint_as_float(rv.y << 16), r3 = __uint_as_float(rv.y & 0xffff0000u);
                const float v0 = o[cbl][4 * g] * rs * gn[0] * (r0 * __builtin_amdgcn_rcpf(1.f + __expf(-r0))), v1 = o[cbl][4 * g + 1] * rs * gn[1] * (r1 * __builtin_amdgcn_rcpf(1.f + __expf(-r1)));
                const float v2 = o[cbl][4 * g + 2] * rs * gn[2] * (r2 * __builtin_amdgcn_rcpf(1.f + __expf(-r2))), v3 = o[cbl][4 * g + 3] * rs * gn[3] * (r3 * __builtin_amdgcn_rcpf(1.f + __expf(-r3)));
                u32x2 w; w.x = cvtpk_s(v0, v1); w.y = cvtpk_s(v2, v3); *(u32x2*)(op + co) = w; }
        __syncthreads();
    }
}
constexpr int PROBE_J = -1, PROBE_B = 0, PROBE_K = 4;
__global__ void __launch_bounds__(NTHREADS, 2) mega(Params p_unused) {
    extern __shared__ __attribute__((aligned(16))) unsigned char lds_raw[];
    LAS unsigned char* lds = (LAS unsigned char*)lds_raw;
    const int G = gridDim.x, bid = blockIdx.x; const int wave_s = __builtin_amdgcn_readfirstlane(threadIdx.x >> 6);
    volatile LAS unsigned* MISC = (volatile LAS unsigned*)(lds + MISC_OFF);
    if (threadIdx.x < 64) MISC[threadIdx.x] = 0u;
    __syncthreads();
    KP p = fresh_kp();
    unsigned char* ws = p->ws;
    volatile LAS unsigned* STAMPS = (volatile LAS unsigned*)(lds + ROWTOK_OFF + 6144);
    if (PROBE_J >= 0 && threadIdx.x == 0) { const unsigned long long t_ = __builtin_amdgcn_s_memrealtime(); STAMPS[0] = (unsigned)t_; STAMPS[1] = (unsigned)(t_ >> 32); }
    if (PROBE_SEC >= 0 && threadIdx.x == 0) *(volatile LAS unsigned*)(lds + PSEC_OFF) = 0u;
    XcdBarrier bar = xcd_barrier_post((unsigned*)(ws + WS_CTL) + CW_BAR + p->bar_li * XCD_BAR_WORDS, MISC + 8);
#define WS (fresh_kp()->ws)
#define IN(k) ({ KP _q = fresh_kp(); const bool _r = _q->ph_lo <= (k) && (k) < _q->ph_hi; _r; })
#define SEAM(k) do { if (IN(k) && IN((k) + 1)) xcd_barrier(bar); if (PROBE_J >= 0 && threadIdx.x == 0) { const unsigned long long t_ = __builtin_amdgcn_s_memrealtime(); STAMPS[2 * ((k) + 1)] = (unsigned)t_; STAMPS[2 * ((k) + 1) + 1] = (unsigned)(t_ >> 32); } } while (0)

    if (IN(0)) { phase_prologue(fresh_kp(), lds, G, bid, wave_s); }
    SEAM(0);
    if (IN(1)) { unsigned char* wsl = WS;
        { TileOrder S; S.init(wsl + WS_XB, wsl + WS_WA, NTOK, 2560, D, G, bid);
          EpiInA E{(bf16*)(wsl + WS_HREG), (bf16*)(wsl + WS_HREG + HR_48), (bf16*)(wsl + WS_HREG + 2 * HR_48), (bf16*)(wsl + WS_HREG + 3 * HR_48)};
          gemm_phase(lds + RING_OFF, D, S, E, wave_s); }
        { TileOrder S; S.init(wsl + WS_MEMB, wsl + WS_WMKV, NB * NMEM, 1024, D, G, bid);
          EpiPlain E{(bf16*)(wsl + WS_MKV), 1024};
          gemm_phase(lds + RING_OFF, D, S, E, wave_s); }
    }
    SEAM(1);
    if (IN(2)) phase_gla_kv(fresh_kp(), lds, G, bid, wave_s);
    SEAM(2);
    if (IN(3)) { unsigned char* wsl = WS; phase_gla_scan(wsl, G, bid, wave_s); }
    SEAM(3);
    if (IN(4)) { phase_gla_out(fresh_kp(), lds, G, bid, wave_s); unsigned char* wsl = WS; phase_attn_mem(wsl, lds, 0, G, bid, wave_s); }
    SEAM(4);
        if (IN(5)) { unsigned char* wsl = WS;
            KP q = fresh_kp();
            TileOrder S; S.init(wsl + WS_XB, wsl + WS_WO + (size_t)0 * D * D * 2, NTOK, D, D, G, bid);
            EpiRes<false> E{(const void*)q->in[I_X], q->out};
            gemm_phase(lds + RING_OFF, D, S, E, wave_s);
        }
        SEAM(5);
        if (IN(5 + 1)) phase_ln_router(fresh_kp(), 0, lds, G, bid, wave_s);
        SEAM(5 + 1);
        if (IN(5 + 2)) { unsigned char* wsl = WS;
            const int nu = moe_setup(wsl, lds, G, bid, wave_s, true);
            MoeGU S{(const char*)(wsl + WS_XB), (const char*)(wsl + WS_WGU) + (size_t)0 * NEXP * 1024 * D * 2, (LAS const int*)(lds + MISC_OFF) + 16, (LAS const int*)(lds + ROWTOK_OFF), nu};
            EpiGateUp E{(bf16*)(wsl + WS_GREG)};
            gemm_phase(lds + RING_OFF, D, S, E, wave_s);
        }
        SEAM(5 + 2);
        if (IN(5 + 3)) { unsigned char* wsl = WS;
            const int nu = moe_setup(wsl, lds, G, bid, wave_s, false);
            MoeDown S{(const char*)(wsl + WS_GREG), (const char*)(wsl + WS_WD) + (size_t)0 * NEXP * 1024 * DEXP * 2, (LAS const int*)(lds + MISC_OFF) + 16, nu};
            EpiPlain E{(bf16*)(wsl + WS_HREG), 1024};
            gemm_phase(lds + RING_OFF, DEXP, S, E, wave_s);
        }
        SEAM(5 + 3);
        if (IN(5 + 4)) phase_ln_ffn(fresh_kp(), 0, lds, G, bid, wave_s);

            SEAM(9);
            if (IN(10)) { unsigned char* wsl = WS;
                KP q = fresh_kp();
                TileOrder S; S.init(wsl + WS_XB, wsl + WS_WB, NTOK, 3328, D, G, bid);
                EpiInB E{(bf16*)(wsl + WS_HREG), (bf16*)(wsl + WS_HREG + HR_48), (bf16*)(wsl + WS_HREG + 2 * HR_48), (bf16*)(wsl + WS_HREG + 3 * HR_48), (bf16*)(wsl + WS_HREG + 4 * HR_48), q->in[I_QNG], q->in[I_KNG]};
                gemm_phase(lds + RING_OFF, D, S, E, wave_s);
                const int gwr = (G - 1 - bid) * NWAVES + wave_s;
                if (gwr < NB * FOX_H) cum_wave((const float*)(wsl + WS_LOGF), (float*)(wsl + WS_CUM), gwr, fresh_lane());
            }
            SEAM(10);
            if (IN(11)) { unsigned char* wsl = WS; phase_attn_fox(wsl, lds, G, bid, wave_s); phase_attn_mem(wsl, lds, 1, G, bid, wave_s); }
            SEAM(11);
        if (IN(12)) { unsigned char* wsl = WS;
            KP q = fresh_kp();
            TileOrder S; S.init(wsl + WS_GREG, wsl + WS_WO + (size_t)1 * D * D * 2, NTOK, D, D, G, bid);
            EpiRes<true> E{(const void*)(wsl + WS_XB), q->out};
            gemm_phase(lds + RING_OFF, D, S, E, wave_s);
        }
        SEAM(12);
        if (IN(12 + 1)) phase_ln_router(fresh_kp(), 1, lds, G, bid, wave_s);
        SEAM(12 + 1);
        if (IN(12 + 2)) { unsigned char* wsl = WS;
            const int nu = moe_setup(wsl, lds, G, bid, wave_s, true);
            MoeGU S{(const char*)(wsl + WS_XB), (const char*)(wsl + WS_WGU) + (size_t)1 * NEXP * 1024 * D * 2, (LAS const int*)(lds + MISC_OFF) + 16, (LAS const int*)(lds + ROWTOK_OFF), nu};
            EpiGateUp E{(bf16*)(wsl + WS_GREG)};
            gemm_phase(lds + RING_OFF, D, S, E, wave_s);
        }
        SEAM(12 + 2);
        if (IN(12 + 3)) { unsigned char* wsl = WS;
            const int nu = moe_setup(wsl, lds, G, bid, wave_s, false);
            MoeDown S{(const char*)(wsl + WS_GREG), (const char*)(wsl + WS_WD) + (size_t)1 * NEXP * 1024 * DEXP * 2, (LAS const int*)(lds + MISC_OFF) + 16, nu};
            EpiPlain E{(bf16*)(wsl + WS_HREG), 1024};
            gemm_phase(lds + RING_OFF, DEXP, S, E, wave_s);
        }
        SEAM(12 + 3);
        if (IN(12 + 4)) phase_ln_ffn(fresh_kp(), 1, lds, G, bid, wave_s);
        SEAM(16);
    if (PROBE_J >= 0 && blockIdx.x == 0 && threadIdx.x == 0) {
        const unsigned long long t1 = ((unsigned long long)STAMPS[2 * PROBE_B + 1] << 32) | STAMPS[2 * PROBE_B], t0 = ((unsigned long long)STAMPS[2 * PROBE_J + 1] << 32) | STAMPS[2 * PROBE_J];
        const unsigned long long wait = (t1 - t0) * PROBE_K, ts = __builtin_amdgcn_s_memrealtime();
        while (__builtin_amdgcn_s_memrealtime() - ts < wait) __builtin_amdgcn_s_sleep(8);
    }
    if (PROBE_SEC >= 0 && blockIdx.x == 0 && threadIdx.x == 0) {
        const unsigned long long wait = (unsigned long long)(*(volatile LAS unsigned*)(lds + PSEC_OFF)) * PROBE_K, ts = __builtin_amdgcn_s_memrealtime();
        while (__builtin_amdgcn_s_memrealtime() - ts < wait) __builtin_amdgcn_s_sleep(8);
    }
#undef IN
#undef SEAM
#undef WS
}
#undef LAS
#undef GAS
}

static int pk_grid() {
    static int grid = 0;
    if (grid == 0) {
        int dev = 0, cus = 0;
        if (hipGetDevice(&dev) != hipSuccess || hipDeviceGetAttribute(&cus, hipDeviceAttributeMultiprocessorCount, dev) != hipSuccess) { grid = -1; return grid; }
        if (hipFuncSetAttribute((const void*)pk::mega, hipFuncAttributeMaxDynamicSharedMemorySize, pk::LDS_BYTES) != hipSuccess) { fprintf(stderr, "kernel_launch: hipFuncSetAttribute failed\n"); grid = -1; return grid; }
        int per_cu = 0;
        if (hipOccupancyMaxActiveBlocksPerMultiprocessor(&per_cu, (const void*)pk::mega, pk::NTHREADS, pk::LDS_BYTES) != hipSuccess || per_cu < 1) fprintf(stderr, "kernel_launch: occupancy query says %d\n", per_cu);
        (void)hipGetLastError();
        grid = cus;
    }
    return grid;
}
static void pk_launch(pk::Params& P, int lo, int hi, hipStream_t stream) {
    const int grid = pk_grid(); if (grid <= 0) return;
    P.ph_lo = lo; P.ph_hi = hi; P.bar_li += 1;
    hipLaunchKernelGGL(pk::mega, dim3(grid), dim3(pk::NTHREADS), pk::LDS_BYTES, stream, P);
}
extern "C" void kernel_launch(void* const* d_in, const int* in_sizes, int n_in, void* d_out, int out_size, void* d_ws, size_t ws_size, hipStream_t stream) {
    if (n_in != 22 || out_size != NTOK * D || ws_size < WS_END) { fprintf(stderr, "kernel_launch: unexpected shapes (n_in %d out %d ws %zu)\n", n_in, out_size, ws_size); return; }
    const float* w_gate_up = (const float*)d_in[3]; const float* b_gate = (const float*)d_in[4]; const float* gla_g = (const float*)d_in[5];
    const float* w_eg = (const float*)d_in[19]; const float* w_eu = (const float*)d_in[20]; const float* w_ed = (const float*)d_in[21];
    unsigned char* ws = (unsigned char*)d_ws;
    float* GLR = (float*)(ws + WS_GLR); float* CUM = (float*)(ws + WS_CUM);
    bf16* MKV = (bf16*)(ws + WS_MKV);
    int* TOK_E = (int*)(ws + WS_TOKE); int* TOK_S = (int*)(ws + WS_TOKS);
    bf16* XB = (bf16*)(ws + WS_XB); bf16* YS = (bf16*)(ws + WS_HREG);
    bf16* T0 = (bf16*)(ws + WS_HREG), *T1 = (bf16*)(ws + WS_HREG + HR_48), *T2 = (bf16*)(ws + WS_HREG + 2 * HR_48), *T3 = (bf16*)(ws + WS_HREG + 3 * HR_48), *T4 = (bf16*)(ws + WS_HREG + 4 * HR_48);
    (void)hipMemsetAsync(ws + WS_CTL, 0, CTL_ZERO_BYTES, stream);
    pk::Params P{}; for (int i = 0; i < 22; ++i) P.in[i] = (const float*)d_in[i]; P.out = (float*)d_out; P.ws = ws; P.bar_li = -1;
    pk_launch(P, 0, 17, stream);
}
```

```cpp
#include <hip/hip_runtime.h>
#include <cstdio>
#include <cstdint>

typedef unsigned short bf16;
constexpr int NB = 8, SEQ = 4096, D = 1024, NTOK = NB * SEQ;
constexpr int NMEM = 256, A_IN = 2576, B_IN = 1792, KV_IN = 1548;
constexpr int GLA_H = 4, GLA_DK = 96, GLA_DV = 192, FOX_H = 12;
constexpr int NEXP = 16, DEXP = 512;
constexpr float DN_ALPHA = 1.41421356237309515f;
constexpr float LN_EPS = 1e-5f, RMS_EPS = 1e-6f;
constexpr float LOG2E = 1.4426950408889634f;
constexpr float QC2 = 0.125f * LOG2E;
constexpr size_t MiB = 1u << 20;
constexpr size_t WS_CTL = 0, CTL_ZERO_BYTES = 1 * MiB;
constexpr size_t WS_GLR = 1 * MiB, WS_LOGF = 3 * MiB, WS_CUM = 5 * MiB, WS_DEC = 7 * MiB, WS_MEMB = 8 * MiB, WS_MKV = 12 * MiB;
constexpr size_t WS_TOKE = 16 * MiB, WS_TOKW = WS_TOKE + 256 * 1024, WS_TOKS = WS_TOKW + 256 * 1024, WS_CNT = WS_TOKS + 256 * 1024, WS_SLOTTOK = 17 * MiB;
constexpr size_t WS_WA = 20 * MiB, WS_WB = 25 * MiB, WS_WMKV = 32 * MiB, WS_WO = 34 * MiB, WS_WGU = 38 * MiB, WS_WD = 102 * MiB;
constexpr size_t WS_XB = 134 * MiB, WS_GREG = 198 * MiB, WS_HREG = 270 * MiB, WS_END = 478 * MiB;
constexpr size_t HR_48 = 48 * MiB;

__device__ __forceinline__ float bf2f(bf16 v) { return __uint_as_float(((unsigned)v) << 16); }
__device__ __forceinline__ bf16 f2bf(float f) { unsigned u = __float_as_uint(f); return (bf16)((u + 0x7fffu + ((u >> 16) & 1u)) >> 16); }
__device__ __forceinline__ float wave_sum(float v) {
#pragma unroll
    for (int o = 1; o < 64; o <<= 1) v += __shfl_xor(v, o);
    return v;
}
__device__ __forceinline__ float log_sigmoid(float z) { return fminf(z, 0.f) - log1pf(expf(-fabsf(z))); }
__device__ __forceinline__ float sigmoidf(float z) { return 1.f / (1.f + expf(-z)); }

namespace nv {
__global__ void __launch_bounds__(256) p0_x(const float* x, const float* w_in_a, bf16* XB, float* GLR) {
    const int row = blockIdx.x * 4 + (threadIdx.x >> 6), lane = threadIdx.x & 63;
    float acc[16];
#pragma unroll
    for (int j = 0; j < 16; ++j) acc[j] = 0.f;
    for (int k = lane; k < D; k += 64) {
        const float v = x[(size_t)row * D + k]; XB[(size_t)row * D + k] = f2bf(v);
#pragma unroll
        for (int j = 0; j < 16; ++j) acc[j] += v * w_in_a[(size_t)k * A_IN + 1536 + j];
    }
#pragma unroll
    for (int j = 0; j < 16; ++j) { const float s = wave_sum(acc[j]); if (lane == 0) GLR[(size_t)row * 16 + j] = s; }
}
__global__ void __launch_bounds__(256) p0_mem(const float* mem, bf16* MEMB) {
    const size_t i = (size_t)blockIdx.x * 256 + threadIdx.x; MEMB[i] = f2bf(mem[i]);
}
struct GemmArgs { const bf16* A; int lda; const float* W; int ldw; int wcol0; int M, Nn, K; };
struct EpiBf { bf16* dst; int ldd; int dcol0; __device__ void operator()(int m, int n, float v) const { dst[(size_t)m * ldd + dcol0 + n] = f2bf(v); } };
struct EpiRes { const float* xres; float* out; __device__ void operator()(int m, int n, float v) const { out[(size_t)m * D + n] = DN_ALPHA * xres[(size_t)m * D + n] + v; } };
template <class Epi> __global__ void __launch_bounds__(256) gemm(GemmArgs g, Epi E) {
    const int n = blockIdx.x * 64 + (threadIdx.x & 63), m0 = (blockIdx.y * 4 + (threadIdx.x >> 6)) * 4;
    if (n >= g.Nn) return;
    float acc[4] = {0.f, 0.f, 0.f, 0.f};
    for (int k = 0; k < g.K; k += 8) {
        float w[8];
#pragma unroll
        for (int j = 0; j < 8; ++j) w[j] = g.W[(size_t)(k + j) * g.ldw + g.wcol0 + n];
#pragma unroll
        for (int i = 0; i < 4; ++i) {
            const uint4 a = *(const uint4*)(g.A + (size_t)(m0 + i) * g.lda + k);
            const unsigned aw[4] = {a.x, a.y, a.z, a.w};
#pragma unroll
            for (int j = 0; j < 4; ++j) { acc[i] += __uint_as_float(aw[j] << 16) * w[2 * j]; acc[i] += __uint_as_float(aw[j] & 0xffff0000u) * w[2 * j + 1]; }
        }
    }
#pragma unroll
    for (int i = 0; i < 4; ++i) E(m0 + i, n, acc[i]);
}
__global__ void __launch_bounds__(192) gla(const bf16* QK, const bf16* V, const bf16* R, const float* GLR, const float* w_up, const float* b_gate, const float* g_norm, bf16* OC) {
    const int b = blockIdx.x / GLA_H, h = blockIdx.x % GLA_H, tid = threadIdx.x;
    __shared__ float sq[96], sk[96], sa[96], red[4];
    float S[96];
#pragma unroll
    for (int k = 0; k < 96; ++k) S[k] = 0.f;
    float wup[16]; float bg = 0.f;
    if (tid < 96) { for (int j = 0; j < 16; ++j) wup[j] = w_up[j * 384 + h * 96 + tid]; bg = b_gate[h * 96 + tid]; }
    const float gn = g_norm[tid];
    const float qs = 0.10206207261596577f;
    for (int t = 0; t < SEQ; ++t) {
        const size_t m = (size_t)b * SEQ + t;
        __syncthreads();
        if (tid < 96) {
            float z = bg;
#pragma unroll
            for (int j = 0; j < 16; ++j) z += GLR[m * 16 + j] * wup[j];
            sa[tid] = expf(log_sigmoid(z) * (1.f / 16.f));
            sq[tid] = bf2f(QK[m * 768 + h * 96 + tid]) * qs;
            sk[tid] = bf2f(QK[m * 768 + 384 + h * 96 + tid]);
        }
        __syncthreads();
        const float v = bf2f(V[m * 768 + h * 192 + tid]);
        float o = 0.f;
#pragma unroll
        for (int k = 0; k < 96; ++k) { S[k] = sa[k] * S[k] + sk[k] * v; o += sq[k] * S[k]; }
        float ss = wave_sum(o * o);
        if ((tid & 63) == 0) red[tid >> 6] = ss;
        __syncthreads();
        ss = red[0] + red[1] + red[2];
        const float r = bf2f(R[m * 768 + h * 192 + tid]);
        const float on = o * rsqrtf(ss * (1.f / 192.f) + RMS_EPS) * gn;
        OC[m * D + h * 192 + tid] = f2bf(on * (r * sigmoidf(r)));
    }
}
__global__ void __launch_bounds__(256) memattn(const bf16* MQ, const bf16* MKV, int layer, bf16* OC) {
    const int m = blockIdx.x * 256 + threadIdx.x, hd = blockIdx.y, b = m / SEQ;
    float q[64], acc[64];
#pragma unroll
    for (int d = 0; d < 64; ++d) { q[d] = bf2f(MQ[(size_t)m * 256 + hd * 64 + d]) * 0.125f; acc[d] = 0.f; }
    float mx = -1e30f, l = 0.f;
    for (int j = 0; j < NMEM; ++j) {
        const bf16* kr = MKV + (size_t)(b * NMEM + j) * 1024 + layer * 512 + hd * 64;
        float s = 0.f;
#pragma unroll
        for (int d = 0; d < 64; ++d) s += q[d] * bf2f(kr[d]);
        const float mn = fmaxf(mx, s), f = expf(mx - mn), p = expf(s - mn);
        l = l * f + p; mx = mn;
#pragma unroll
        for (int d = 0; d < 64; ++d) acc[d] = acc[d] * f + p * bf2f(kr[256 + d]);
    }
    const float il = 1.f / l;
#pragma unroll
    for (int d = 0; d < 64; ++d) OC[(size_t)m * D + 768 + hd * 64 + d] = f2bf(acc[d] * il);
}
__global__ void __launch_bounds__(256) ln_router(float* XF, bf16* XB, const float* g, const float* bta, const float* w_router, const float* b_router, int* TOK_E, float* TOK_W) {
    const int row = blockIdx.x * 4 + (threadIdx.x >> 6), lane = threadIdx.x & 63;
    float v[16]; float s = 0.f;
#pragma unroll
    for (int i = 0; i < 16; ++i) { v[i] = XF[(size_t)row * D + lane + 64 * i]; s += v[i]; }
    const float mean = wave_sum(s) * (1.f / D); float q = 0.f;
#pragma unroll
    for (int i = 0; i < 16; ++i) { v[i] -= mean; q += v[i] * v[i]; }
    const float rstd = rsqrtf(wave_sum(q) * (1.f / D) + LN_EPS);
    float lg[16];
#pragma unroll
    for (int e = 0; e < 16; ++e) lg[e] = 0.f;
#pragma unroll
    for (int i = 0; i < 16; ++i) { const int k = lane + 64 * i; const float o = v[i] * rstd * g[k] + bta[k]; XF[(size_t)row * D + k] = o; XB[(size_t)row * D + k] = f2bf(o);
#pragma unroll
        for (int e = 0; e < 16; ++e) lg[e] += o * w_router[k * 16 + e]; }
#pragma unroll
    for (int e = 0; e < 16; ++e) lg[e] = wave_sum(lg[e]);
    if (lane == 0) {
        float aff[16], sel[16];
#pragma unroll
        for (int e = 0; e < 16; ++e) { aff[e] = sigmoidf(lg[e]); sel[e] = aff[e] + b_router[e]; }
        int gbest = 0; float gs = -1e30f;
#pragma unroll
        for (int gi = 0; gi < 4; ++gi) { float a = -1e30f, b2 = -1e30f;
#pragma unroll
            for (int j = 0; j < 4; ++j) { const float x = sel[gi * 4 + j]; if (x > a) { b2 = a; a = x; } else if (x > b2) b2 = x; }
            if (a + b2 > gs) { gs = a + b2; gbest = gi; } }
        int i0 = 0, i1 = 0; float a = -1e30f, b2 = -1e30f;
#pragma unroll
        for (int j = 0; j < 4; ++j) { float x = -1e30f;
#pragma unroll
            for (int gi = 0; gi < 4; ++gi) if (gi == gbest) x = sel[gi * 4 + j];
            if (x > a) { b2 = a; i1 = i0; a = x; i0 = j; } else if (x > b2) { b2 = x; i1 = j; } }
        const int e0 = gbest * 4 + i0, e1 = gbest * 4 + i1; float w0 = 0.f, w1 = 0.f;
#pragma unroll
        for (int e = 0; e < 16; ++e) { if (e == e0) w0 = aff[e]; if (e == e1) w1 = aff[e]; }
        const float inv = 1.f / (w0 + w1);
        TOK_E[row * 2] = e0; TOK_E[row * 2 + 1] = e1; TOK_W[row * 2] = w0 * inv; TOK_W[row * 2 + 1] = w1 * inv;
    }
}
__global__ void __launch_bounds__(256) moe(const bf16* XB, const int* TOK_E, const float* wg, const float* wu, const float* wd, bf16* YS, int* TOK_SLOT) {
    const int tok = blockIdx.x >> 1, j = blockIdx.x & 1, tid = threadIdx.x;
    __shared__ float xs[1024], hs[512];
    for (int k = tid; k < 1024; k += 256) xs[k] = bf2f(XB[(size_t)tok * D + k]);
    const int e = TOK_E[tok * 2 + j];
    __syncthreads();
    const float* G = wg + (size_t)e * 1024 * 512; const float* U = wu + (size_t)e * 1024 * 512; const float* Dn = wd + (size_t)e * 512 * 1024;
    float g0 = 0.f, g1 = 0.f, u0 = 0.f, u1 = 0.f;
    for (int k = 0; k < 1024; ++k) { const float x = xs[k]; g0 += x * G[k * 512 + tid]; g1 += x * G[k * 512 + 256 + tid]; u0 += x * U[k * 512 + tid]; u1 += x * U[k * 512 + 256 + tid]; }
    hs[tid] = g0 * sigmoidf(g0) * u0; hs[tid + 256] = g1 * sigmoidf(g1) * u1;
    __syncthreads();
    float o[4] = {0.f, 0.f, 0.f, 0.f};
    for (int k = 0; k < 512; ++k) { const float hh = hs[k];
#pragma unroll
        for (int c = 0; c < 4; ++c) o[c] += hh * Dn[k * 1024 + c * 256 + tid]; }
    const int slot = tok * 2 + j;
#pragma unroll
    for (int c = 0; c < 4; ++c) YS[(size_t)slot * D + c * 256 + tid] = f2bf(o[c]);
    if (tid == 0) TOK_SLOT[slot] = slot;
}
__global__ void __launch_bounds__(256) ln_ffn(float* XF, bf16* XB, const bf16* YS, const int* TOK_SLOT, const float* TOK_W, const float* g, const float* bta,
                                              const float* w_kv, const float* b_forget, float* LOGF, int do_logf) {
    const int row = blockIdx.x * 4 + (threadIdx.x >> 6), lane = threadIdx.x & 63;
    const int s0 = TOK_SLOT[row * 2], s1 = TOK_SLOT[row * 2 + 1]; const float w0 = TOK_W[row * 2], w1 = TOK_W[row * 2 + 1];
    float v[16]; float s = 0.f;
#pragma unroll
    for (int i = 0; i < 16; ++i) { const int k = lane + 64 * i; v[i] = DN_ALPHA * XF[(size_t)row * D + k] + w0 * bf2f(YS[(size_t)s0 * D + k]) + w1 * bf2f(YS[(size_t)s1 * D + k]); s += v[i]; }
    const float mean = wave_sum(s) * (1.f / D); float q = 0.f;
#pragma unroll
    for (int i = 0; i < 16; ++i) { v[i] -= mean; q += v[i] * v[i]; }
    const float rstd = rsqrtf(wave_sum(q) * (1.f / D) + LN_EPS);
    float lf[12];
#pragma unroll
    for (int e = 0; e < 12; ++e) lf[e] = 0.f;
#pragma unroll
    for (int i = 0; i < 16; ++i) { const int k = lane + 64 * i; const float o = v[i] * rstd * g[k] + bta[k]; XF[(size_t)row * D + k] = o; XB[(size_t)row * D + k] = f2bf(o);
        if (do_logf) {
#pragma unroll
            for (int e = 0; e < 12; ++e) lf[e] += o * w_kv[(size_t)k * KV_IN + 1536 + e]; } }
    if (do_logf) {
#pragma unroll
        for (int e = 0; e < 12; ++e) { const float t = wave_sum(lf[e]); if (lane == 0) LOGF[(size_t)row * 12 + e] = log_sigmoid(t + b_forget[e]); }
    }
}
__global__ void __launch_bounds__(256) headproj(const bf16* XB, const float* W, int ldw, const float* gn, float scale, bf16* dst) {
    const int m = blockIdx.x, col = blockIdx.y * 256 + threadIdx.x, lane = threadIdx.x & 63;
    float acc = 0.f;
    for (int k = 0; k < D; k += 8) {
        const uint4 a = *(const uint4*)(XB + (size_t)m * D + k); const unsigned aw[4] = {a.x, a.y, a.z, a.w};
#pragma unroll
        for (int j = 0; j < 4; ++j) { acc += __uint_as_float(aw[j] << 16) * W[(size_t)(k + 2 * j) * ldw + col]; acc += __uint_as_float(aw[j] & 0xffff0000u) * W[(size_t)(k + 2 * j + 1) * ldw + col]; }
    }
    const float ss = wave_sum(acc * acc);
    dst[(size_t)m * 768 + col] = f2bf(acc * rsqrtf(ss * (1.f / 64.f) + RMS_EPS) * gn[lane] * scale);
}
__global__ void __launch_bounds__(64) cumk(const float* LOGF, float* CUM) {
    const int b = blockIdx.x / FOX_H, h = blockIdx.x % FOX_H, lane = threadIdx.x;
    float loc[64]; float s = 0.f;
#pragma unroll
    for (int i = 0; i < 64; ++i) { s += LOGF[((size_t)b * SEQ + lane * 64 + i) * 12 + h]; loc[i] = s; }
    float inc = s;
#pragma unroll
    for (int o = 1; o < 64; o <<= 1) { const float t = __shfl_up(inc, o); if (lane >= o) inc += t; }
    const float base = inc - s;
#pragma unroll
    for (int i = 0; i < 64; ++i) CUM[((size_t)b * FOX_H + h) * SEQ + lane * 64 + i] = base + loc[i];
}
__global__ void __launch_bounds__(256) fox(const bf16* Q, const bf16* K, const bf16* V, const bf16* OG, const float* CUM, bf16* OC) {
    const int t = blockIdx.x * 256 + threadIdx.x, h = blockIdx.y, b = blockIdx.z;
    const size_t m = (size_t)b * SEQ + t;
    float q[64], acc[64];
#pragma unroll
    for (int d = 0; d < 64; ++d) { q[d] = bf2f(Q[m * 768 + h * 64 + d]); acc[d] = 0.f; }
    const float* cum = CUM + ((size_t)b * FOX_H + h) * SEQ; const float ct = cum[t] * LOG2E;
    float mx = -1e30f, l = 0.f;
    const int tmax = blockIdx.x * 256 + 255;
    for (int s = 0; s <= tmax; ++s) {
        const bf16* kr = K + ((size_t)b * SEQ + s) * 768 + h * 64; const bf16* vr = V + ((size_t)b * SEQ + s) * 768 + h * 64;
        float sc = ct - cum[s] * LOG2E;
#pragma unroll
        for (int d = 0; d < 64; ++d) sc += q[d] * bf2f(kr[d]);
        if (s <= t) {
            const float mn = fmaxf(mx, sc), f = exp2f(mx - mn), p = exp2f(sc - mn);
            l = l * f + p; mx = mn;
#pragma unroll
            for (int d = 0; d < 64; ++d) acc[d] = acc[d] * f + p * bf2f(vr[d]);
        }
    }
    const float il = 1.f / l;
#pragma unroll
    for (int d = 0; d < 64; ++d) { const float og = bf2f(OG[m * 768 + h * 64 + d]); OC[m * D + h * 64 + d] = f2bf(acc[d] * il * sigmoidf(og)); }
}
}

namespace pk {
#define LAS __attribute__((address_space(3)))
#define GAS __attribute__((address_space(1)))
typedef short bf16x8 __attribute__((ext_vector_type(8)));
typedef short s16x4 __attribute__((ext_vector_type(4)));
typedef float f32x4 __attribute__((ext_vector_type(4)));
typedef float f32x16 __attribute__((ext_vector_type(16)));
typedef unsigned u32x4 __attribute__((ext_vector_type(4)));
typedef unsigned u32x2 __attribute__((ext_vector_type(2)));
constexpr int NWAVES = 8, NTHREADS = 512;
constexpr int BM = 256, BK = 64, HALF = 128, HTB = HALF * BK * 2, STAGE_BYTES = 8 * HTB, NXCD = 8, WGM = 8;
constexpr int RING_OFF = 0, RING_BYTES = 131072;
constexpr int MISC_OFF = RING_BYTES;
constexpr int ROWTOK_OFF = MISC_OFF + 256;
constexpr int LDS_BYTES = 155648;
static_assert(ROWTOK_OFF + 6 * 1024 <= LDS_BYTES, "LDS map");

__device__ __forceinline__ int lds_byte(int r, int c) { const int st = (r >> 4) * 2 + (c >> 5), rr = r & 15, cc = c & 31, ob = rr * 64 + cc * 2; return st * 1024 + (ob ^ (((ob >> 9) & 1) << 5)); }
__device__ __forceinline__ void stage_rc(int b, int& R, int& C) { const int st = b / 1024, sb = b % 1024, swz = sb ^ (((sb >> 9) & 1) << 5); R = (st >> 1) * 16 + swz / 64; C = (st & 1) * 32 + (swz % 64) / 2; }
__device__ __forceinline__ unsigned cvt_pk_bf16(float lo, float hi) { unsigned r; asm volatile("v_cvt_pk_bf16_f32 %0, %1, %2" : "=v"(r) : "v"(lo), "v"(hi)); return r; }
__device__ __forceinline__ int perm8(int c) { return (c & ~31) | (16 * ((c >> 2) & 1) + 4 * ((c >> 3) & 3) + (c & 3)); }
__device__ __forceinline__ int head64(int c) { return 128 * ((c >> 5) & 1) + 32 * (c >> 6) + 16 * ((c >> 2) & 1) + 4 * ((c >> 3) & 3) + (c & 3); }

__device__ __forceinline__ int fresh_lane() { int l; asm volatile("v_mbcnt_lo_u32_b32 %0, -1, 0\n\tv_mbcnt_hi_u32_b32 %0, -1, %0" : "=v"(l)); return l; }
__device__ __forceinline__ int fresh_tid(int wave_s) { asm volatile("" : "+s"(wave_s)); return wave_s * 64 + fresh_lane(); }
constexpr int PROBE_SEC = -1;
constexpr int PSEC_OFF = 131072 + 256 + 6144 + 512;
#define PSEC_BEGIN(id) unsigned long long _ps##id = 0; if (PROBE_SEC == (id) && bid == 0 && wave_s == 0) _ps##id = __builtin_amdgcn_s_memrealtime()
#define PSEC_END(id) do { if (PROBE_SEC == (id) && bid == 0 && wave_s == 0) { const unsigned d_ = (unsigned)(__builtin_amdgcn_s_memrealtime() - _ps##id); volatile LAS unsigned* a_ = (volatile LAS unsigned*)(lds + PSEC_OFF); if (fresh_lane() == 0) a_[0] = a_[0] + d_; } } while (0)
struct Unit { const char* A; const char* B; int pm, pn, e, ord; };

struct TileOrder {
    const char* A; const char* Bt; int K, nM, nN, nwg, G, c;
    __device__ void init(const void* A_, const void* Bt_, int M, int N, int K_, int G_, int c_) { A = (const char*)A_; Bt = (const char*)Bt_; K = K_; nM = M / BM; nN = N / BM; nwg = nM * nN; G = G_; c = c_; }
    __device__ __forceinline__ bool next(int i, Unit& u) const {
        const long L = (long)i * G + c; if (L >= nwg) return false;
        int wgid = (int)L; { const int q = nwg / NXCD, r = nwg % NXCD, xcd = wgid % NXCD, off = wgid / NXCD; wgid = (xcd < r ? xcd * (q + 1) : r * (q + 1) + (xcd - r) * q) + off; }
        const int nig = WGM * nN, gid = wgid / nig, fm = gid * WGM, gsz = (nM - fm) < WGM ? (nM - fm) : WGM;
        u.pm = fm + ((wgid % nig) % gsz); u.pn = (wgid % nig) / gsz; u.e = 0; u.ord = i;
        u.A = A + (size_t)u.pm * BM * K * 2; u.B = Bt + (size_t)u.pn * BM * K * 2; return true;
    }
    __device__ __forceinline__ unsigned a_off(const Unit&, int h, int R, int C) const { return (unsigned)((R + HALF * h) * K + C) * 2u; }
};

template <class Epi, class Sched>
__device__ __forceinline__ void gemm_phase(LAS unsigned char* lds, const int K, const Sched& S, const Epi& E, const int wave_s) {
    const int tid = fresh_tid(wave_s), wid = wave_s, lane = tid & 63, wr = wid >> 2, wc = wid & 3, fr = lane & 15, fq = lane >> 4;
    const int nt = K / BK;
    int sR[2], sC[2];
    unsigned voffA[2][2], voffB[2];
#pragma unroll
    for (int i = 0; i < 2; ++i) { stage_rc(tid * 16 + i * 8192, sR[i], sC[i]); voffB[i] = (unsigned)(sR[i] * K + sC[i]) * 2u; }
    const size_t kstep = (size_t)(BK * 2);
    const size_t hstep = (size_t)HALF * K * 2;
    const unsigned ldsw = (unsigned)wid * 1024u;
    const int aoff = lds_byte(wr * 64 + fr, fq * 8), boff = lds_byte(wc * 32 + fr, fq * 8);
#define PG8_SA(b, h) (((b) * 2 + (h)) * HTB)
#define PG8_SB(b, h) ((4 + (b) * 2 + (h)) * HTB)
#define PG8_STAGE(bufoff, gbase, voff) do { _Pragma("unroll") for (int _i = 0; _i < 2; ++_i) \
        __builtin_amdgcn_global_load_lds((const unsigned*)((const char*)(gbase) + (voff)[_i]), (LAS unsigned*)(lds + (bufoff) + ldsw + _i * 8192), 16, 0, 0); } while (0)
#define PG8_LDA(dst, b, h) do { _Pragma("unroll") for (int m = 0; m < 4; ++m) _Pragma("unroll") for (int k = 0; k < 2; ++k) dst[m][k] = *(const LAS bf16x8*)(lds + PG8_SA(b, h) + aoff + m * 2048 + k * 1024); } while (0)
#define PG8_LDB(dst, b, h) do { _Pragma("unroll") for (int n = 0; n < 2; ++n) _Pragma("unroll") for (int k = 0; k < 2; ++k) dst[n][k] = *(const LAS bf16x8*)(lds + PG8_SB(b, h) + boff + n * 2048 + k * 1024); } while (0)
#define PG8_MMA(ai, bj, At, Bt) do { __builtin_amdgcn_s_setprio(1); _Pragma("unroll") for (int m = 0; m < 4; ++m) _Pragma("unroll") for (int n = 0; n < 2; ++n) _Pragma("unroll") for (int k = 0; k < 2; ++k) \
        acc[ai][bj][m][n] = __builtin_amdgcn_mfma_f32_16x16x32_bf16(Bt[n][k], At[m][k], acc[ai][bj][m][n], 0, 0, 0); __builtin_amdgcn_s_setprio(0); } while (0)
#define PG8_WAIT_V(n) asm volatile("s_waitcnt vmcnt(" #n ")" ::: "memory")
#define PG8_WAIT_L(n) asm volatile("s_waitcnt lgkmcnt(" #n ")" ::: "memory")
#define PG8_BAR __builtin_amdgcn_s_barrier()
#define PG8_SCHED __builtin_amdgcn_sched_barrier(0)
    Unit cur, nxt; int ui = 0;
    if (!S.next(0, cur)) return;
    f32x4 acc[2][2][4][2];
#pragma unroll
    for (int a = 0; a < 2; ++a)
#pragma unroll
        for (int b = 0; b < 2; ++b)
#pragma unroll
            for (int m = 0; m < 4; ++m)
#pragma unroll
                for (int n = 0; n < 2; ++n) acc[a][b][m][n] = (f32x4){0.f, 0.f, 0.f, 0.f};
    bf16x8 At[4][2], B0[2][2], B1[2][2];
    const char* cA = cur.A; const char* cB = cur.B;
#pragma unroll
    for (int h = 0; h < 2; ++h)
#pragma unroll
        for (int i = 0; i < 2; ++i) voffA[h][i] = S.a_off(cur, h, sR[i], sC[i]);
    PG8_STAGE(PG8_SB(0, 0), cB, voffB); PG8_STAGE(PG8_SB(0, 1), cB + hstep, voffB); PG8_STAGE(PG8_SA(0, 0), cA, voffA[0]); PG8_STAGE(PG8_SA(0, 1), cA, voffA[1]);
    if (wr == 1) PG8_BAR;
    PG8_WAIT_V(2); PG8_BAR;
    PG8_STAGE(PG8_SB(1, 0), cB + kstep, voffB); PG8_STAGE(PG8_SA(1, 0), cA + kstep, voffA[0]); PG8_STAGE(PG8_SB(1, 1), cB + hstep + kstep, voffB);
    PG8_WAIT_V(6); PG8_BAR;
    for (;;) {
        const bool has_next = S.next(ui + 1, nxt);
        const char* nA = has_next ? nxt.A : cA; const char* nB = has_next ? nxt.B : cB;
        for (int t = 0; t < nt; t += 2) {
            const bool last = (t == nt - 2);
            const char* a1 = cA + (size_t)(t + 1) * kstep;
            const char* a2 = last ? nA : cA + (size_t)(t + 2) * kstep; const char* b2 = last ? nB : cB + (size_t)(t + 2) * kstep;
            const char* a3 = a2 + kstep; const char* b3 = b2 + kstep;
            PG8_LDB(B0, 0, 0); PG8_LDB(B1, 0, 1); PG8_SCHED; PG8_LDA(At, 0, 0); PG8_STAGE(PG8_SA(1, 1), a1, voffA[1]);
            if (last && has_next) {
#pragma unroll
                for (int h = 0; h < 2; ++h)
#pragma unroll
                    for (int i = 0; i < 2; ++i) { int R2, C2; stage_rc(fresh_tid(wave_s) * 16 + i * 8192, R2, C2); voffA[h][i] = S.a_off(nxt, h, R2, C2); }
            }
            PG8_WAIT_V(8); PG8_WAIT_L(0); PG8_BAR; PG8_MMA(0, 0, At, B0); PG8_MMA(0, 1, At, B1); PG8_BAR; PG8_SCHED;
            PG8_LDA(At, 0, 1); PG8_STAGE(PG8_SB(0, 0), b2, voffB); PG8_STAGE(PG8_SB(0, 1), b2 + hstep, voffB); PG8_STAGE(PG8_SA(0, 0), a2, voffA[0]);
            PG8_WAIT_V(8); PG8_WAIT_L(0); PG8_BAR; PG8_MMA(1, 0, At, B0); PG8_MMA(1, 1, At, B1); PG8_BAR; PG8_SCHED;
            PG8_LDB(B0, 1, 0); PG8_LDB(B1, 1, 1); PG8_SCHED; PG8_LDA(At, 1, 0); PG8_STAGE(PG8_SA(0, 1), a2, voffA[1]);
            PG8_WAIT_V(8); PG8_WAIT_L(0); PG8_BAR; PG8_MMA(0, 0, At, B0); PG8_MMA(0, 1, At, B1); PG8_BAR; PG8_SCHED;
            PG8_LDA(At, 1, 1); PG8_STAGE(PG8_SB(1, 0), b3, voffB); PG8_STAGE(PG8_SB(1, 1), b3 + hstep, voffB); PG8_STAGE(PG8_SA(1, 0), a3, voffA[0]);
            PG8_WAIT_V(8); PG8_WAIT_L(0); PG8_BAR; PG8_MMA(1, 0, At, B0); PG8_MMA(1, 1, At, B1); PG8_BAR; PG8_SCHED;
        }
        if (wr == 0) PG8_BAR;
        E(acc, cur, wr, wc, fr, fq);
        if (!has_next) break;
#pragma unroll
        for (int a = 0; a < 2; ++a)
#pragma unroll
            for (int b = 0; b < 2; ++b)
#pragma unroll
                for (int m = 0; m < 4; ++m)
#pragma unroll
                    for (int n = 0; n < 2; ++n) acc[a][b][m][n] = (f32x4){0.f, 0.f, 0.f, 0.f};
        cur = nxt; cA = nA; cB = nB; ++ui;
        if (wr == 1) PG8_BAR;
    }
    PG8_WAIT_V(0);
    PG8_BAR;
#undef PG8_SA
#undef PG8_SB
#undef PG8_STAGE
#undef PG8_LDA
#undef PG8_LDB
#undef PG8_MMA
#undef PG8_WAIT_V
#undef PG8_WAIT_L
#undef PG8_BAR
#undef PG8_SCHED
}

__device__ __forceinline__ void store_bf16_tile(const f32x4 (&acc)[2][2][4][2], bf16* base, int ldd, int row0, int c0, int wr, int wc, int fr, int fq) {
    bf16* rowp = base + (size_t)(row0 + wr * 64 + fr) * ldd + (c0 + wc * 32 + 8 * fq);
#pragma unroll
    for (int ai = 0; ai < 2; ++ai) {
#pragma unroll
        for (int m = 0; m < 4; ++m) {
#pragma unroll
            for (int bj = 0; bj < 2; ++bj) { const f32x4 v0 = acc[ai][bj][m][0], v1 = acc[ai][bj][m][1];
                u32x4 w; w.x = cvt_pk_bf16(v0[0], v0[1]); w.y = cvt_pk_bf16(v0[2], v0[3]); w.z = cvt_pk_bf16(v1[0], v1[1]); w.w = cvt_pk_bf16(v1[2], v1[3]);
                *(u32x4*)(rowp + bj * HALF) = w; }
            rowp += (size_t)16 * ldd; asm volatile("" : "+v"(rowp)); }
        rowp += (size_t)64 * ldd; }
}
struct EpiInA { bf16 *QK, *V, *R, *MQ;
    __device__ __forceinline__ void operator()(const f32x4 (&acc)[2][2][4][2], const Unit& u, int wr, int wc, int fr, int fq) const {
        bf16* base; int ldd, c0; const int pn = u.pn;
        if (pn < 3) { base = QK; ldd = 768; c0 = pn * 256; } else if (pn < 6) { base = V; ldd = 768; c0 = (pn - 3) * 256; } else if (pn < 9) { base = R; ldd = 768; c0 = (pn - 6) * 256; } else { base = MQ; ldd = 256; c0 = 0; }
        store_bf16_tile(acc, base, ldd, u.pm * BM, c0, wr, wc, fr, fq);
    } };
struct EpiPlain { bf16* dst; int ldd;
    __device__ __forceinline__ void operator()(const f32x4 (&acc)[2][2][4][2], const Unit& u, int wr, int wc, int fr, int fq) const { store_bf16_tile(acc, dst, ldd, u.pm * BM, u.pn * BM, wr, wc, fr, fq); } };

#define XB_TMO      128
#define XB_XCNT(j)  (256  + 64 * (j))
#define XB_XSUB(j)  (1280 + 64 * (j))
#define XB_XGEN(j)  (2304 + 64 * (j))
#define XB_TOP      3328
#define XB_TOPGEN   3392
#define XCD_BAR_WORDS 3456
#define XB_SPIN_CAP (1u << 18)
__device__ __forceinline__ unsigned xb_ld(unsigned* p)              { return __hip_atomic_load(p, __ATOMIC_RELAXED, __HIP_MEMORY_SCOPE_AGENT); }
__device__ __forceinline__ unsigned xb_add(unsigned* p, unsigned v) { return __hip_atomic_fetch_add(p, v, __ATOMIC_RELAXED, __HIP_MEMORY_SCOPE_AGENT); }
__device__ __forceinline__ unsigned xb_xcc_id() { return (unsigned)__builtin_amdgcn_s_getreg((3 << 11) | 20) & 0xFu; }
#define XB_SPIN(cond, bar) do { unsigned _sp = 0; while (cond) { __builtin_amdgcn_s_sleep(1); \
    if ((++_sp & 255u) == 0u) { if (xb_ld(&(bar)[XB_TMO])) break; if (_sp > XB_SPIN_CAP) { atomicAdd(&(bar)[XB_TMO], 1u); break; } } } } while (0)
struct XcdBarrier { unsigned* bar; unsigned x; volatile LAS unsigned* st; };
__device__ __forceinline__ XcdBarrier xcd_barrier_post(unsigned* bar, volatile LAS unsigned* st) {
    XcdBarrier b; b.bar = bar; b.x = xb_xcc_id(); b.st = st;
    if (threadIdx.x == 0) (void)xb_add(&bar[XB_XCNT(b.x)], 1u);
    return b;
}
__device__ __forceinline__ void xcd_barrier_complete(unsigned* bar, unsigned x, unsigned& nloc, unsigned& nx) {
    const unsigned G = gridDim.x * gridDim.y * gridDim.z;
    unsigned sum, cnt, mine, sp = 0u;
    for (;;) {
        sum = 0u; cnt = 0u; mine = 0u;
#pragma unroll
        for (unsigned j = 0; j < 16; ++j) { const unsigned c = xb_ld(&bar[XB_XCNT(j)]); sum += c; cnt += (c > 0u) ? 1u : 0u; mine = (j == x) ? c : mine; }
        if (sum == G) break;
        __builtin_amdgcn_s_sleep(1);
        if ((++sp & 255u) == 0u) { if (xb_ld(&bar[XB_TMO])) break; if (sp > XB_SPIN_CAP) { atomicAdd(&bar[XB_TMO], 1u); break; } }
    }
    nloc = mine > 0u ? mine : 1u; nx = cnt > 0u ? cnt : 1u;
}
__device__ __forceinline__ void xcd_barrier(const XcdBarrier& b) {
    asm volatile("s_waitcnt vmcnt(0)" ::: "memory");
    __syncthreads();
    if (threadIdx.x == 0) {
        unsigned* bar = b.bar;
        __builtin_amdgcn_s_waitcnt(0);
        unsigned nloc = b.st[0], nx = b.st[1];
        if (nloc == 0u) { xcd_barrier_complete(bar, b.x, nloc, nx); b.st[0] = nloc; b.st[1] = nx; }
        const unsigned old = xb_add(&bar[XB_XSUB(b.x)], 1u);
        const unsigned gen = old / nloc;
        if (old + 1u == (gen + 1u) * nloc) {
            __builtin_amdgcn_fence(__ATOMIC_RELEASE, "agent");
            asm volatile("s_waitcnt vmcnt(0)" ::: "memory");
            const unsigned og = xb_add(&bar[XB_TOP], 1u);
            const unsigned tg = og / nx;
            if (og + 1u == (tg + 1u) * nx) xb_add(&bar[XB_TOPGEN], 1u);
            else XB_SPIN(xb_ld(&bar[XB_TOPGEN]) == tg, bar);
            __builtin_amdgcn_fence(__ATOMIC_ACQUIRE, "agent");
            xb_add(&bar[XB_XGEN(b.x)], 1u);
            asm volatile("s_waitcnt vmcnt(0)" ::: "memory");
        } else {
            XB_SPIN(xb_ld(&bar[XB_XGEN(b.x)]) == gen, bar);
            __builtin_amdgcn_fence(__ATOMIC_ACQUIRE, "agent");
            asm volatile("s_waitcnt vmcnt(0)" ::: "memory");
        }
    }
    __syncthreads();
}
#define LDS_WAIT() asm volatile("s_waitcnt lgkmcnt(0)" ::: "memory")
__device__ __forceinline__ unsigned pk2(float lo, float hi) { return (unsigned)f2bf(lo) | ((unsigned)f2bf(hi) << 16); }

template <int CTRL> __device__ __forceinline__ float dppf(float v) { return __builtin_bit_cast(float, __builtin_amdgcn_update_dpp(0, __builtin_bit_cast(int, v), CTRL, 0xf, 0xf, true)); }
__device__ __forceinline__ float sum_swap32(float a, float b) { auto r = __builtin_amdgcn_permlane32_swap(__float_as_uint(a), __float_as_uint(b), false, false); return __uint_as_float(r[0]) + __uint_as_float(r[1]); }
__device__ __forceinline__ float sum_swap16(float a, float b) { auto r = __builtin_amdgcn_permlane16_swap(__float_as_uint(a), __float_as_uint(b), false, false); return __uint_as_float(r[0]) + __uint_as_float(r[1]); }
__device__ __forceinline__ float wsum(float v) {
    v += dppf<0xB1>(v); v += dppf<0x4E>(v); v += dppf<0x141>(v); v += dppf<0x140>(v);
    v = sum_swap16(v, v); v = sum_swap32(v, v); return v;
}
__device__ __forceinline__ float multi_reduce16(const float (&a)[16], int lane) {
    float b[8], c[4], d[2], e;
#pragma unroll
    for (int i = 0; i < 8; ++i) b[i] = sum_swap32(a[i], a[i + 8]);
#pragma unroll
    for (int i = 0; i < 4; ++i) c[i] = sum_swap16(b[i], b[i + 4]);
    { const bool hi = (lane & 8) != 0;
#pragma unroll
      for (int i = 0; i < 2; ++i) { const float send = hi ? c[i] : c[i + 2], keep = hi ? c[i + 2] : c[i]; d[i] = keep + dppf<0x140>(send); } }
    { const bool hi = (lane & 4) != 0; const float send = hi ? d[0] : d[1], keep = hi ? d[1] : d[0]; e = keep + dppf<0x141>(send); }
    e += dppf<0x4E>(e); e += dppf<0xB1>(e);
    return e;
}

__device__ __forceinline__ void row_dots16x2(const f32x4 (&v0)[4], const f32x4 (&v1)[4], const LAS float* WT, int lane, float& r0, float& r1) {
    float a0[16], a1[16];
    const LAS float* wl = WT + 4 * lane; asm volatile("" : "+v"(wl));
    f32x4 wa[8], wb[8];
#pragma unroll
    for (int q = 0; q < 8; ++q) wa[q] = *(const LAS f32x4*)(wl + (q >> 2) * D + 256 * (q & 3));
#pragma unroll
    for (int g = 0; g < 8; ++g) {
        if (g + 1 < 8) {
#pragma unroll
            for (int q = 0; q < 8; ++q) { const f32x4 w = *(const LAS f32x4*)(wl + (2 * (g + 1) + (q >> 2)) * D + 256 * (q & 3)); if (g & 1) wa[q] = w; else wb[q] = w; } }
#pragma unroll
        for (int h = 0; h < 2; ++h) { float x = 0.f, y = 0.f;
#pragma unroll
            for (int j = 0; j < 4; ++j) { const f32x4 w = (g & 1) ? wb[4 * h + j] : wa[4 * h + j];
                x += v0[j][0] * w[0] + v0[j][1] * w[1] + v0[j][2] * w[2] + v0[j][3] * w[3]; y += v1[j][0] * w[0] + v1[j][1] * w[1] + v1[j][2] * w[2] + v1[j][3] * w[3]; }
            a0[2 * g + h] = x; a1[2 * g + h] = y; }
        asm volatile("" : "+v"(a0[2 * g]), "+v"(a0[2 * g + 1]), "+v"(a1[2 * g]), "+v"(a1[2 * g + 1]));
    }
    r0 = multi_reduce16(a0, lane); r1 = multi_reduce16(a1, lane);
}
struct TItem { const float* src; bf16* WT; int K, ncols, n0, k0, kind, aux; bool ok; };
__device__ __forceinline__ int titem_dstrow(const TItem& t, int c) {
    switch (t.kind) {
        case 0: return 256 * (c >> 7) + perm8(c & 127);
        case 1: return 256 * (c >> 7) + 128 + perm8(c & 127);
        case 2: return perm8(c);
        case 3: { if (c >= 1536 && c < 1552) return -1; const int L = c < 1536 ? c : c - 16; return perm8(L); }
        case 4: { if (c < 768) return (c & ~255) + head64(c & 255); return perm8(1536 + c); }
        case 5: { if (c < 768) { const int L = 768 + c; return (L & ~255) + head64(L & 255); } if (c < 1536) return perm8(768 + c); return -1; }
        default: return perm8(t.aux * 512 + c);
    }
}
__device__ __forceinline__ void titem_load(const TItem& t, float (&r)[32]) {
#pragma unroll
    for (int i = 0; i < 32; ++i) r[i] = t.ok ? t.src[(size_t)(2 * i) * t.ncols] : 0.f;
}
__device__ __forceinline__ void titem_store(const TItem& t, const float (&r)[32], LAS float* scr, int lane) {
#pragma unroll
    for (int i = 0; i < 32; ++i) scr[(2 * i + (lane >> 5)) * 33 + (lane & 31)] = r[i];
    LDS_WAIT(); asm volatile("" ::: "memory");
    const int c = lane & 7;
#pragma unroll
    for (int j = 0; j < 4; ++j) { const int n = (lane >> 3) + 8 * j; const LAS float* s = scr + (8 * c) * 33 + n;
        u32x4 o; o.x = cvt_pk_bf16(s[0 * 33], s[1 * 33]); o.y = cvt_pk_bf16(s[2 * 33], s[3 * 33]); o.z = cvt_pk_bf16(s[4 * 33], s[5 * 33]); o.w = cvt_pk_bf16(s[6 * 33], s[7 * 33]);
        const int dr = (t.n0 + n) < t.ncols ? titem_dstrow(t, t.n0 + n) : -1;
        if (dr >= 0) *(u32x4*)(t.WT + (size_t)dr * t.K + t.k0 + 8 * c) = o; }
    LDS_WAIT(); asm volatile("" ::: "memory");
}
struct Params { const float* in[22]; float* out; unsigned char* ws; int ph_lo, ph_hi, bar_li, pad; };
enum { I_X = 0, I_MEM, I_WINA, I_WGUP, I_BGATE, I_GLAG, I_WINB, I_QNG, I_WKV, I_BFORGET, I_KNG, I_WMKV, I_WOUT, I_LMG, I_LMB, I_LFG, I_LFB, I_WR, I_BR, I_WEG, I_WEU, I_WED };
constexpr int CW_BAR = 4096;

typedef const __attribute__((address_space(4))) Params* KP;
__device__ __forceinline__ KP fresh_kp() { KP q = (KP)__builtin_amdgcn_kernarg_segment_ptr(); asm volatile("" : "+s"(q)); return q; }

__device__ __forceinline__ void phase_prologue(KP p, LAS unsigned char* lds, int G, int bid, const int wave_s) {
    const int tid = fresh_tid(wave_s), lane = tid & 63, wave = wave_s;
    unsigned char* ws = p->ws;
    LAS float* scr = (LAS float*)(lds + wave * 8448);
    const int gw = bid * NWAVES + wave, NGW = G * NWAVES;
    constexpr int NB_A = 81, NB_B = 56, NB_KV = 48;
    constexpr int I_G = 32 * 16 * 16, I_U = I_G, I_D = 32 * 8 * 32, I_A = 16 * NB_A, I_B = 16 * NB_B, I_KV = 16 * NB_KV, I_MK = 2 * 16 * 16, I_O = 2 * 16 * 32;
    constexpr int NITEMS = I_G + I_U + I_D + I_A + I_B + I_KV + I_MK + I_O;
    auto decode = [&](int it, TItem& t) {
        int r = it; const float* W; int nblk, q; t.aux = 0;
        if (r < I_G) { const int mat = r / 256; q = r % 256; W = p->in[I_WEG] + (size_t)mat * D * DEXP; t.ncols = DEXP; t.K = D; t.WT = (bf16*)(ws + WS_WGU) + (size_t)mat * 1024 * D; nblk = 16; t.kind = 0; }
        else if ((r -= I_G) < I_U) { const int mat = r / 256; q = r % 256; W = p->in[I_WEU] + (size_t)mat * D * DEXP; t.ncols = DEXP; t.K = D; t.WT = (bf16*)(ws + WS_WGU) + (size_t)mat * 1024 * D; nblk = 16; t.kind = 1; }
        else if ((r -= I_U) < I_D) { const int mat = r / 256; q = r % 256; W = p->in[I_WED] + (size_t)mat * DEXP * D; t.ncols = D; t.K = DEXP; t.WT = (bf16*)(ws + WS_WD) + (size_t)mat * D * DEXP; nblk = 32; t.kind = 2; }
        else if ((r -= I_D) < I_A) { q = r; W = p->in[I_WINA]; t.ncols = A_IN; t.K = D; t.WT = (bf16*)(ws + WS_WA); nblk = NB_A; t.kind = 3; }
        else if ((r -= I_A) < I_B) { q = r; W = p->in[I_WINB]; t.ncols = B_IN; t.K = D; t.WT = (bf16*)(ws + WS_WB); nblk = NB_B; t.kind = 4; }
        else if ((r -= I_B) < I_KV) { q = r; W = p->in[I_WKV]; t.ncols = KV_IN; t.K = D; t.WT = (bf16*)(ws + WS_WB); nblk = NB_KV; t.kind = 5; }
        else if ((r -= I_KV) < I_MK) { const int l = r / 256; q = r % 256; W = p->in[I_WMKV] + (size_t)l * D * 512; t.ncols = 512; t.K = D; t.WT = (bf16*)(ws + WS_WMKV); nblk = 16; t.kind = 6; t.aux = l; }
        else { r -= I_MK; const int l = r / 512; q = r % 512; W = p->in[I_WOUT] + (size_t)l * D * D; t.ncols = D; t.K = D; t.WT = (bf16*)(ws + WS_WO) + (size_t)l * D * D; nblk = 32; t.kind = 2; }
        t.k0 = 64 * (q / nblk); t.n0 = 32 * (q % nblk);
        const int col = t.n0 + (lane & 31); t.ok = col < t.ncols;
        t.src = W + (size_t)(t.k0 + (lane >> 5)) * t.ncols + (t.ok ? col : 0);
    };
    { PSEC_BEGIN(20);
    {
        LAS float* T = (LAS float*)lds;
        TItem ta; f32x4 ra[8], rb[8];
        auto decode2 = [&](int it, TItem& t) {
            int r = it; const float* W; int nblk, q; t.aux = 0;
            if (r < 1024) { const int mat = r / 32; q = r % 32; W = p->in[I_WEG] + (size_t)mat * D * DEXP; t.ncols = DEXP; t.K = D; t.WT = (bf16*)(ws + WS_WGU) + (size_t)mat * 1024 * D; nblk = 2; t.kind = 0; }
            else if ((r -= 1024) < 1024) { const int mat = r / 32; q = r % 32; W = p->in[I_WEU] + (size_t)mat * D * DEXP; t.ncols = DEXP; t.K = D; t.WT = (bf16*)(ws + WS_WGU) + (size_t)mat * 1024 * D; nblk = 2; t.kind = 1; }
            else if ((r -= 1024) < 1024) { const int mat = r / 32; q = r % 32; W = p->in[I_WED] + (size_t)mat * DEXP * D; t.ncols = D; t.K = DEXP; t.WT = (bf16*)(ws + WS_WD) + (size_t)mat * D * DEXP; nblk = 4; t.kind = 2; }
            else if ((r -= 1024) < 176) { q = r; W = p->in[I_WINA]; t.ncols = A_IN; t.K = D; t.WT = (bf16*)(ws + WS_WA); nblk = 11; t.kind = 3; }
            else if ((r -= 176) < 112) { q = r; W = p->in[I_WINB]; t.ncols = B_IN; t.K = D; t.WT = (bf16*)(ws + WS_WB); nblk = 7; t.kind = 4; }
            else if ((r -= 112) < 96) { q = r; W = p->in[I_WKV]; t.ncols = KV_IN; t.K = D; t.WT = (bf16*)(ws + WS_WB); nblk = 6; t.kind = 5; }
            else if ((r -= 96) < 64) { const int l = r / 32; q = r % 32; W = p->in[I_WMKV] + (size_t)l * D * 512; t.ncols = 512; t.K = D; t.WT = (bf16*)(ws + WS_WMKV); nblk = 2; t.kind = 6; t.aux = l; }
            else { r -= 64; const int l = r / 64; q = r % 64; W = p->in[I_WOUT] + (size_t)l * D * D; t.ncols = D; t.K = D; t.WT = (bf16*)(ws + WS_WO) + (size_t)l * D * D; nblk = 4; t.kind = 2; }
            t.k0 = 64 * (q / nblk); t.n0 = 256 * (q % nblk);
            const int col = t.n0 + 4 * lane; t.ok = col < t.ncols;
            t.src = W + (size_t)(t.k0 + 8 * wave) * t.ncols + (t.ok ? col : 0);
        };
        constexpr int NIT2 = 3 * 1024 + 176 + 112 + 96 + 64 + 128;
#define P0_TLOAD(t, r) do { _Pragma("unroll") for (int i = 0; i < 8; ++i) r[i] = t.ok ? *(const f32x4*)(t.src + (size_t)i * t.ncols) : (f32x4){0.f, 0.f, 0.f, 0.f}; } while (0)
#define P0_TSTORE(t, r) do { __syncthreads(); \
            _Pragma("unroll") for (int i = 0; i < 8; ++i) { LAS float* d_ = T + (8 * wave + i) * 257 + 4 * lane; d_[0] = r[i][0]; d_[1] = r[i][1]; d_[2] = r[i][2]; d_[3] = r[i][3]; } \
            __syncthreads(); \
            const int c_ = lane & 7; \
            _Pragma("unroll") for (int j = 0; j < 4; ++j) { const int n_ = 32 * wave + (lane >> 3) + 8 * j; const LAS float* s_ = T + (8 * c_) * 257 + n_; \
                u32x4 o_; o_.x = cvt_pk_bf16(s_[0 * 257], s_[1 * 257]); o_.y = cvt_pk_bf16(s_[2 * 257], s_[3 * 257]); o_.z = cvt_pk_bf16(s_[4 * 257], s_[5 * 257]); o_.w = cvt_pk_bf16(s_[6 * 257], s_[7 * 257]); \
                const int dr_ = (t.n0 + n_) < t.ncols ? titem_dstrow(t, t.n0 + n_) : -1; \
                if (dr_ >= 0) *(u32x4*)(t.WT + (size_t)dr_ * t.K + t.k0 + 8 * c_) = o_; } } while (0)
        int it = bid;
        if (it < NIT2) { decode2(it, ta); P0_TLOAD(ta, ra); }
#pragma unroll 1
        for (; it < NIT2; it += 2 * G) {
            TItem tb; const bool hb = it + G < NIT2;
            if (hb) { decode2(it + G, tb); P0_TLOAD(tb, rb); }
            P0_TSTORE(ta, ra);
            if (it + 2 * G < NIT2) { decode2(it + 2 * G, ta); P0_TLOAD(ta, ra); }
            if (hb) P0_TSTORE(tb, rb);
        }
#undef P0_TLOAD
#undef P0_TSTORE
    }
    PSEC_END(20); }
    { const f32x4* src = (const f32x4*)p->in[I_MEM]; u32x2* dst = (u32x2*)(ws + WS_MEMB);
      for (int i = bid * NTHREADS + tid; i < NB * NMEM * D / 4; i += G * NTHREADS) { const f32x4 v = src[i]; u32x2 o; o.x = pk2(v[0], v[1]); o.y = pk2(v[2], v[3]); dst[i] = o; } }
    __syncthreads();
    LAS float* WG = (LAS float*)(lds);
    for (int idx = tid; idx < 16 * D; idx += NTHREADS) { const int j = idx & 15, k = idx >> 4; WG[j * D + k] = p->in[I_WINA][(size_t)k * A_IN + 1536 + j]; }
    __syncthreads();
    bf16* XB = (bf16*)(ws + WS_XB); float* GLR = (float*)(ws + WS_GLR);
    { PSEC_BEGIN(22);
    {   f32x4 a0[4], a1[4], b0[4], b1[4];
#define P0_LOAD(va, vb, mm) do { const f32x4* xr_ = (const f32x4*)(p->in[I_X] + (size_t)(mm) * D) + lane; _Pragma("unroll") for (int j = 0; j < 4; ++j) { va[j] = xr_[64 * j]; vb[j] = xr_[64 * j + 256]; } } while (0)
#define P0_PROC(va, vb, mm) do { u32x2* o8_ = (u32x2*)(XB + (size_t)(mm) * D) + lane; \
            _Pragma("unroll") for (int j = 0; j < 4; ++j) { u32x2 o; o.x = cvt_pk_bf16(va[j][0], va[j][1]); o.y = cvt_pk_bf16(va[j][2], va[j][3]); o8_[64 * j] = o; o.x = cvt_pk_bf16(vb[j][0], vb[j][1]); o.y = cvt_pk_bf16(vb[j][2], vb[j][3]); o8_[64 * j + 256] = o; } \
            float r0_, r1_; row_dots16x2(va, vb, WG, lane, r0_, r1_); \
            if ((lane & 3) == 0) { GLR[(size_t)(mm) * 16 + (lane >> 2)] = r0_; GLR[(size_t)((mm) + 1) * 16 + (lane >> 2)] = r1_; } } while (0)
        int m = 2 * gw;
        if (m < NTOK) P0_LOAD(a0, a1, m);
#pragma unroll 1
        for (; m < NTOK; m += 4 * NGW) {
            const bool hb = m + 2 * NGW < NTOK;
            if (hb) P0_LOAD(b0, b1, m + 2 * NGW);
            P0_PROC(a0, a1, m);
            if (m + 4 * NGW < NTOK) P0_LOAD(a0, a1, m + 4 * NGW);
            if (hb) P0_PROC(b0, b1, m + 2 * NGW);
        }
#undef P0_LOAD
#undef P0_PROC
    }
    PSEC_END(22); }
}

template <bool RB> struct EpiRes { const void* xres; bf16* out;
    __device__ __forceinline__ void operator()(const f32x4 (&acc)[2][2][4][2], const Unit& u, int wr, int wc, int fr, int fq) const {
        size_t off = (size_t)(u.pm * BM + wr * 64 + fr) * D + (u.pn * BM + wc * 32 + 8 * fq);
#pragma unroll
        for (int ai = 0; ai < 2; ++ai) {
#pragma unroll
            for (int m = 0; m < 4; ++m) {
#pragma unroll
                for (int bj = 0; bj < 2; ++bj) { f32x4 x0, x1;
                    if (RB) { const u32x4 t = *(const u32x4*)((const bf16*)xres + off + bj * HALF); x0[0] = __uint_as_float(t.x << 16); x0[1] = __uint_as_float(t.x & 0xffff0000u); x0[2] = __uint_as_float(t.y << 16); x0[3] = __uint_as_float(t.y & 0xffff0000u);
                        x1[0] = __uint_as_float(t.z << 16); x1[1] = __uint_as_float(t.z & 0xffff0000u); x1[2] = __uint_as_float(t.w << 16); x1[3] = __uint_as_float(t.w & 0xffff0000u); }
                    else { x0 = *(const f32x4*)((const float*)xres + off + bj * HALF); x1 = *(const f32x4*)((const float*)xres + off + bj * HALF + 4); }
                    const f32x4 v0 = x0 * DN_ALPHA + acc[ai][bj][m][0], v1 = x1 * DN_ALPHA + acc[ai][bj][m][1];
                    u32x4 w; w.x = cvt_pk_bf16(v0[0], v0[1]); w.y = cvt_pk_bf16(v0[2], v0[3]); w.z = cvt_pk_bf16(v1[0], v1[1]); w.w = cvt_pk_bf16(v1[2], v1[3]);
                    *(u32x4*)(out + off + bj * HALF) = w; }
                off += (size_t)16 * D; asm volatile("" : "+v"(off) :: "memory"); }
            off += (size_t)64 * D; }
    } };
struct EpiInB { bf16 *Q, *K, *V, *OG, *MQ; const float* qg; const float* kg;
    __device__ __forceinline__ void operator()(const f32x4 (&acc)[2][2][4][2], const Unit& u, int wr, int wc, int fr, int fq) const {
        const int pn = u.pn;
        if (pn >= 6) { bf16* base; int ldd, c0;
            if (pn < 9) { base = V; ldd = 768; c0 = (pn - 6) * 256; } else if (pn < 12) { base = OG; ldd = 768; c0 = (pn - 9) * 256; } else { base = MQ; ldd = 256; c0 = 0; }
            store_bf16_tile(acc, base, ldd, u.pm * BM, c0, wr, wc, fr, fq); return; }
        const bool isq = pn < 3; bf16* base = isq ? Q : K; const float* g = isq ? qg : kg; const float sc = isq ? QC2 : 1.0f;
        const int c0 = (isq ? pn : pn - 3) * 256 + wc * 64 + 8 * fq, r0 = u.pm * BM + wr * 64 + fr;
        f32x4 gv[2][2];
#pragma unroll
        for (int bj = 0; bj < 2; ++bj)
#pragma unroll
            for (int n = 0; n < 2; ++n) gv[bj][n] = *(const f32x4*)(g + 32 * bj + 8 * fq + 4 * n) * sc;
        bf16* rowp = base + (size_t)r0 * 768 + c0;
#pragma unroll
        for (int ai = 0; ai < 2; ++ai) {
#pragma unroll
            for (int m = 0; m < 4; ++m) {
                float ss = 0.f;
#pragma unroll
                for (int bj = 0; bj < 2; ++bj)
#pragma unroll
                    for (int n = 0; n < 2; ++n) { const f32x4 v = acc[ai][bj][m][n]; ss += (v[0] * v[0] + v[1] * v[1]) + (v[2] * v[2] + v[3] * v[3]); }
                ss = sum_swap16(ss, ss); ss = sum_swap32(ss, ss);
                const float rs = rsqrtf(ss * (1.f / 64.f) + RMS_EPS);
#pragma unroll
                for (int bj = 0; bj < 2; ++bj) { const f32x4 v0 = acc[ai][bj][m][0] * rs * gv[bj][0], v1 = acc[ai][bj][m][1] * rs * gv[bj][1];
                    u32x4 w; w.x = cvt_pk_bf16(v0[0], v0[1]); w.y = cvt_pk_bf16(v0[2], v0[3]); w.z = cvt_pk_bf16(v1[0], v1[1]); w.w = cvt_pk_bf16(v1[2], v1[3]);
                    *(u32x4*)(rowp + 32 * bj) = w; }
                rowp += (size_t)16 * 768; asm volatile("" : "+v"(rowp)); }
            rowp += (size_t)64 * 768; }
    } };

__device__ __forceinline__ void load_wtab(LAS float* WT, const float* W, int ldw, int col0, int ncols, int tid) {
    for (int idx = tid; idx < 16 * D; idx += NTHREADS) { const int j = idx & 15, k = idx >> 4; WT[j * D + k] = j < ncols ? W[(size_t)k * ldw + col0 + j] : 0.f; }
}
__device__ __forceinline__ float row_dots16(const f32x4 (&v)[4], const LAS float* WT, int lane) {
    float acc[16];
    const LAS float* wl = WT + 4 * lane; asm volatile("" : "+v"(wl));
#pragma unroll
    for (int n = 0; n < 16; ++n) { float a = 0.f;
#pragma unroll
        for (int j = 0; j < 4; ++j) { const f32x4 w = *(const LAS f32x4*)(wl + n * D + 256 * j); a += v[j][0] * w[0] + v[j][1] * w[1] + v[j][2] * w[2] + v[j][3] * w[3]; }
        acc[n] = a; if (n & 1) asm volatile("" : "+v"(acc[n - 1]), "+v"(acc[n]) :: "memory"); }
    return multi_reduce16(acc, lane);
}
__device__ __forceinline__ void ln_row(f32x4 (&v)[4], const float* g, const float* b, int lane) {
    float s = 0.f;
#pragma unroll
    for (int j = 0; j < 4; ++j) s += (v[j][0] + v[j][1]) + (v[j][2] + v[j][3]);
    const float mean = wsum(s) * (1.f / D); float q = 0.f;
#pragma unroll
    for (int j = 0; j < 4; ++j) { v[j] = v[j] - mean; q += (v[j][0] * v[j][0] + v[j][1] * v[j][1]) + (v[j][2] * v[j][2] + v[j][3] * v[j][3]); }
    const float rstd = rsqrtf(wsum(q) * (1.f / D) + LN_EPS);
#pragma unroll
    for (int j = 0; j < 4; ++j) { const f32x4 gg = *(const f32x4*)(g + 4 * lane + 256 * j), bb = *(const f32x4*)(b + 4 * lane + 256 * j); v[j] = v[j] * rstd * gg + bb; }
}
__device__ __forceinline__ void store_row_f32_bf16(const f32x4 (&v)[4], float* xf, bf16* xb, int lane) {
#pragma unroll
    for (int j = 0; j < 4; ++j) { if (xf) ((f32x4*)xf)[lane + 64 * j] = v[j]; if (xb) { u32x2 o; o.x = cvt_pk_bf16(v[j][0], v[j][1]); o.y = cvt_pk_bf16(v[j][2], v[j][3]); ((u32x2*)xb)[lane + 64 * j] = o; } }
}

__device__ __forceinline__ void route_thread(const float (&lg)[16], const float (&brv)[16], int m, int lt, int* TOK_E, float* TOK_W, LAS int* tokE) {
    float aff[16], sel[16];
#pragma unroll
    for (int e = 0; e < 16; ++e) { aff[e] = 1.f / (1.f + __expf(-lg[e])); sel[e] = aff[e] + brv[e]; }
    int gbest = 0; float gs = -1e30f;
#pragma unroll
    for (int gi = 0; gi < 4; ++gi) { float a = -1e30f, b2 = -1e30f;
#pragma unroll
        for (int j = 0; j < 4; ++j) { const float x = sel[gi * 4 + j]; const bool gt = x > a; b2 = gt ? a : fmaxf(b2, x); a = gt ? x : a; }
        const bool better = a + b2 > gs; gs = better ? a + b2 : gs; gbest = better ? gi : gbest; }
    int i0 = 0, i1 = 0; float a = -1e30f, b2 = -1e30f, wa = 0.f, wb = 0.f;
#pragma unroll
    for (int j = 0; j < 4; ++j) { float x = sel[j], y = aff[j];
#pragma unroll
        for (int gi = 1; gi < 4; ++gi) { x = (gi == gbest) ? sel[gi * 4 + j] : x; y = (gi == gbest) ? aff[gi * 4 + j] : y; }
        const bool g1 = x > a, g2 = x > b2;
        const float nb = g1 ? a : (g2 ? x : b2), nwb = g1 ? wa : (g2 ? y : wb); const int ni1 = g1 ? i0 : (g2 ? j : i1);
        a = g1 ? x : a; wa = g1 ? y : wa; i0 = g1 ? j : i0; b2 = nb; wb = nwb; i1 = ni1; }
    const float inv = 1.f / (wa + wb); const int e0 = gbest * 4 + i0, e1 = gbest * 4 + i1;
    TOK_E[m * 2] = e0; TOK_E[m * 2 + 1] = e1; TOK_W[m * 2] = wa * inv; TOK_W[m * 2 + 1] = wb * inv; tokE[lt * 2] = e0; tokE[lt * 2 + 1] = e1;
}
__device__ __forceinline__ void phase_ln_router(KP p, int layer, LAS unsigned char* lds, int G, int bid, const int wave_s) {
    const int tid = fresh_tid(wave_s), lane = tid & 63, wave = wave_s;
    PSEC_BEGIN(0);
    unsigned char* ws = p->ws;
    LAS float* WT = (LAS float*)lds; LAS int* tokE = (LAS int*)(lds + 65536);
    load_wtab(WT, p->in[I_WR], 16, 0, 16, tid);
    __syncthreads();
    const bf16* Y1 = (const bf16*)p->out; bf16* XB = (bf16*)(ws + WS_XB); int* TOK_E = (int*)(ws + WS_TOKE); float* TOK_W = (float*)(ws + WS_TOKW); int* CNT = (int*)(ws + WS_CNT); int* SLOT_TOK = (int*)(ws + WS_SLOTTOK);
    const float* g = p->in[I_LMG] + layer * D; const float* b = p->in[I_LMB] + layer * D;
#define LNR_LOAD(va, vb, pr) do { const u32x2* s0_ = (const u32x2*)(Y1 + (size_t)(tb * 128 + wave * 16 + 2 * (pr)) * D) + lane; _Pragma("unroll") for (int j = 0; j < 4; ++j) { const u32x2 a_ = s0_[64 * j], b_ = s0_[64 * j + 256]; \
        va[j][0] = __uint_as_float(a_.x << 16); va[j][1] = __uint_as_float(a_.x & 0xffff0000u); va[j][2] = __uint_as_float(a_.y << 16); va[j][3] = __uint_as_float(a_.y & 0xffff0000u); \
        vb[j][0] = __uint_as_float(b_.x << 16); vb[j][1] = __uint_as_float(b_.x & 0xffff0000u); vb[j][2] = __uint_as_float(b_.y << 16); vb[j][3] = __uint_as_float(b_.y & 0xffff0000u); } } while (0)
#define LNR_PROC(va, vb, pr) do { const int lt_ = wave * 16 + 2 * (pr), m_ = tb * 128 + lt_; \
        { PSEC_BEGIN(1); ln_row(va, g, b, lane); ln_row(vb, g, b, lane); \
        store_row_f32_bf16(va, (float*)nullptr, XB + (size_t)m_ * D, lane); store_row_f32_bf16(vb, (float*)nullptr, XB + (size_t)(m_ + 1) * D, lane); PSEC_END(1); } \
        float l0_, l1_; { PSEC_BEGIN(2); row_dots16x2(va, vb, WT, lane, l0_, l1_); asm volatile("" : "+v"(l0_), "+v"(l1_)); PSEC_END(2); } \
        if ((lane & 3) == 0) { LG[lt_ * 16 + (lane >> 2)] = l0_; LG[(lt_ + 1) * 16 + (lane >> 2)] = l1_; } } while (0)
    LAS float* LG = (LAS float*)(lds + 65536 + 1024);
    for (int tb = bid; tb < NTOK / 128; tb += G) {
        f32x4 a0[4], a1[4], b0[4], b1[4];
        LNR_LOAD(a0, a1, 0);
#pragma unroll 1
        for (int pr = 0; pr < 8; pr += 2) {
            LNR_LOAD(b0, b1, pr + 1);
            LNR_PROC(a0, a1, pr);
            if (pr + 2 < 8) LNR_LOAD(a0, a1, pr + 2);
            LNR_PROC(b0, b1, pr + 1);
        }
        __syncthreads();
        if (tid < 128) { PSEC_BEGIN(3); float lg[16], brv[16];
#pragma unroll
            for (int q = 0; q < 4; ++q) { const f32x4 t4 = *(const LAS f32x4*)(LG + tid * 16 + 4 * q); const f32x4 b4 = *(const f32x4*)(p->in[I_BR] + 4 * q);
#pragma unroll
                for (int j = 0; j < 4; ++j) { lg[4 * q + j] = t4[j]; brv[4 * q + j] = b4[j]; } }
            route_thread(lg, brv, tb * 128 + tid, tid, TOK_E, TOK_W, tokE); PSEC_END(3); }
        __syncthreads();
        if (tid < 256) {
            const int e = tokE[tid]; int rank = 0;
            for (int i = 0; i < tid; ++i) rank += (tokE[i] == e) ? 1 : 0;
            SLOT_TOK[(e * 256 + tb) * 128 + rank] = tb * 256 + tid;
        } else if (tid < 272) { const int e = tid - 256; int c = 0; for (int i = 0; i < 256; ++i) c += (tokE[i] == e) ? 1 : 0; CNT[tb * 16 + e] = c; }
        __syncthreads();
    }
    PSEC_END(0);
#undef LNR_LOAD
#undef LNR_PROC
}
struct FfnRow { u32x2 x[4], ya[4], yc[4]; float w0, w1; };
__device__ __forceinline__ void ffn_combine(FfnRow& r, f32x4 (&v)[4]) {
#pragma unroll
    for (int j = 0; j < 4; ++j) { const u32x2 a = r.ya[j], c = r.yc[j]; f32x4 ya, yc;
        ya[0] = __uint_as_float(a.x << 16); ya[1] = __uint_as_float(a.x & 0xffff0000u); ya[2] = __uint_as_float(a.y << 16); ya[3] = __uint_as_float(a.y & 0xffff0000u);
        yc[0] = __uint_as_float(c.x << 16); yc[1] = __uint_as_float(c.x & 0xffff0000u); yc[2] = __uint_as_float(c.y << 16); yc[3] = __uint_as_float(c.y & 0xffff0000u);
        const u32x2 xx = r.x[j]; f32x4 xv; xv[0] = __uint_as_float(xx.x << 16); xv[1] = __uint_as_float(xx.x & 0xffff0000u); xv[2] = __uint_as_float(xx.y << 16); xv[3] = __uint_as_float(xx.y & 0xffff0000u);
        v[j] = xv * DN_ALPHA + ya * r.w0 + yc * r.w1; }
}
__device__ __forceinline__ void phase_ln_ffn(KP p, int layer, LAS unsigned char* lds, int G, int bid, const int wave_s) {
    const int tid = fresh_tid(wave_s), lane = tid & 63, wave = wave_s;
    unsigned char* ws = p->ws;
    LAS float* WT = (LAS float*)lds;
    if (layer == 0) { load_wtab(WT, p->in[I_WKV], KV_IN, 1536, 12, tid); __syncthreads(); }
    const int eo = (lane >> 2) & 15; const float bf = (layer == 0 && eo < 12) ? p->in[I_BFORGET][eo] : 0.f;
    float* XF = p->out; bf16* XB = (bf16*)(ws + WS_XB); const bf16* YS = (const bf16*)(ws + WS_HREG);
    const int* TOK_S = (const int*)(ws + WS_TOKS); const float* TOK_W = (const float*)(ws + WS_TOKW); float* LOGF = (float*)(ws + WS_LOGF);
    const float* g = p->in[I_LFG] + layer * D; const float* b = p->in[I_LFB] + layer * D;
    const int gw = bid * NWAVES + wave, NGW = G * NWAVES;
#define FFN_LOAD(R, m_) do { const int mm_ = (m_); int mv_ = mm_ * 2; asm volatile("" : "+v"(mv_));        \
        const int s0_ = TOK_S[mv_], s1_ = TOK_S[mv_ + 1]; R.w0 = TOK_W[mv_]; R.w1 = TOK_W[mv_ + 1]; \
        _Pragma("unroll") for (int j = 0; j < 4; ++j) { R.x[j] = ((const u32x2*)(XB + (size_t)mm_ * D))[lane + 64 * j]; R.ya[j] = ((const u32x2*)(YS + (size_t)s0_ * D))[lane + 64 * j]; R.yc[j] = ((const u32x2*)(YS + (size_t)s1_ * D))[lane + 64 * j]; } } while (0)
#define FFN_PROC(R, m_) do { const int mm_ = (m_); f32x4 v_[4]; ffn_combine(R, v_); ln_row(v_, g, b, lane); \
        store_row_f32_bf16(v_, layer == 0 ? (float*)nullptr : XF + (size_t)mm_ * D, layer == 0 ? XB + (size_t)mm_ * D : (bf16*)nullptr, lane); \
        if (layer == 0) { const float t_ = row_dots16(v_, WT, lane); if ((lane & 3) == 0 && eo < 12) LOGF[(size_t)mm_ * 12 + eo] = log_sigmoid(t_ + bf); } } while (0)
    FfnRow A, B;
    int m = gw;
    if (m < NTOK) FFN_LOAD(A, m);
#pragma unroll 1
    for (; m < NTOK; m += 2 * NGW) {
        const bool hb = (m + NGW) < NTOK;
        if (hb) FFN_LOAD(B, m + NGW);
        FFN_PROC(A, m);
        if (m + 2 * NGW < NTOK) FFN_LOAD(A, m + 2 * NGW);
        if (hb) FFN_PROC(B, m + NGW);
    }
#undef FFN_LOAD
#undef FFN_PROC
}
__device__ __forceinline__ void cum_wave(const float* LOGF, float* CUM, int bh, int lane) {
    const int b = bh / FOX_H, h = bh % FOX_H;
    float loc[64]; float s = 0.f;
#pragma unroll
    for (int i = 0; i < 64; ++i) { s += LOGF[((size_t)b * SEQ + lane * 64 + i) * 12 + h]; loc[i] = s; }
    float inc = s;
#pragma unroll
    for (int o = 1; o < 64; o <<= 1) { const float t = __shfl_up(inc, o); if (lane >= o) inc += t; }
    const float base = inc - s;
#pragma unroll
    for (int i = 0; i < 64; ++i) CUM[(size_t)bh * SEQ + lane * 64 + i] = base + loc[i];
}
constexpr int MOE_MAXU = 6;
__device__ __forceinline__ int moe_setup(unsigned char* ws, LAS unsigned char* lds, int G, int bid, const int wave_s, const bool build_rows) {
    const int tid = fresh_tid(wave_s), lane = tid & 63, wave = wave_s;
    LAS int* PRE = (LAS int*)lds; LAS int* TB = (LAS int*)(lds + 16640); LAS int* TE = TB + 17;
    volatile LAS int* UL = (volatile LAS int*)(lds + MISC_OFF) + 16; LAS int* rowtok = (LAS int*)(lds + ROWTOK_OFF);
    const int* CNT = (const int*)(ws + WS_CNT); const int* SLOT_TOK = (const int*)(ws + WS_SLOTTOK); int* TOK_S = (int*)(ws + WS_TOKS);
#pragma unroll
    for (int q = 0; q < 2; ++q) { const int e = 2 * wave + q;
        int c[4]; int s = 0;
#pragma unroll
        for (int i = 0; i < 4; ++i) { c[i] = CNT[(4 * lane + i) * 16 + e]; s += c[i]; }
        int inc = s;
#pragma unroll
        for (int o = 1; o < 64; o <<= 1) { const int t = __shfl_up(inc, o); if (lane >= o) inc += t; }
        int run = inc - s;
#pragma unroll
        for (int i = 0; i < 4; ++i) { PRE[e * 257 + 4 * lane + i] = run; run += c[i]; }
        if (lane == 63) { PRE[e * 257 + 256] = inc; TE[e] = inc; } }
    __syncthreads();
    if (tid == 0) { int t = 0; for (int e = 0; e < 16; ++e) { TB[e] = t; t += (TE[e] + 255) >> 8; } TB[16] = t; }
    __syncthreads();
    const int NT = TB[16];
    if (tid == 0) { int n = 0;
        for (int i = 0; i < MOE_MAXU; ++i) { const int L = i * G + bid, tile = (L & 7) + 8 * (L >> 5), pn = (L >> 3) & 3; if (tile >= NT) break;
            int e = 0; for (int k = 1; k < 16; ++k) if (TB[k] <= tile) e = k;
            UL[3 * n] = tile; UL[3 * n + 1] = pn; UL[3 * n + 2] = e; ++n; }
        UL[24] = n; }
    __syncthreads();
    const int nunits = __builtin_amdgcn_readfirstlane(UL[24]);
    if (build_rows) {
        for (int i = (tid >> 8); i < nunits; i += 2) { const int tile = UL[3 * i], pn = UL[3 * i + 1], e = UL[3 * i + 2], j = tid & 255;
            const int r = 256 * (tile - TB[e]) + j; int tok = 0;
            if (r < TE[e]) { int lo = 0, hi = 256;
                while (hi - lo > 1) { const int mid = (lo + hi) >> 1; if (PRE[e * 257 + mid] <= r) lo = mid; else hi = mid; }
                const int ent = SLOT_TOK[(e * 256 + lo) * 128 + (r - PRE[e * 257 + lo])]; tok = ent >> 1;
                if (pn == 0) TOK_S[ent] = 256 * tile + j; }
            rowtok[i * 256 + j] = tok; }
    }
    __syncthreads();
    return nunits;
}
struct MoeGU {
    const char* XBp; const char* W; LAS const int* UL; LAS const int* rowtok; int nunits;
    __device__ __forceinline__ bool next(int i, Unit& u) const { if (i >= nunits) return false;
        u.pm = __builtin_amdgcn_readfirstlane(UL[3 * i]); u.pn = __builtin_amdgcn_readfirstlane(UL[3 * i + 1]); u.e = __builtin_amdgcn_readfirstlane(UL[3 * i + 2]); u.ord = i;
        u.A = XBp; u.B = W + ((size_t)u.e * 1024 + (size_t)u.pn * 256) * D * 2; return true; }
    __device__ __forceinline__ unsigned a_off(const Unit& u, int h, int R, int C) const { return (unsigned)(rowtok[u.ord * 256 + R + HALF * h] * D + C) * 2u; }
};
struct MoeDown {
    const char* Hp; const char* W; LAS const int* UL; int nunits;
    __device__ __forceinline__ bool next(int i, Unit& u) const { if (i >= nunits) return false;
        u.pm = __builtin_amdgcn_readfirstlane(UL[3 * i]); u.pn = __builtin_amdgcn_readfirstlane(UL[3 * i + 1]); u.e = __builtin_amdgcn_readfirstlane(UL[3 * i + 2]); u.ord = i;
        u.A = Hp + (size_t)u.pm * BM * DEXP * 2; u.B = W + ((size_t)u.e * 1024 + (size_t)u.pn * 256) * DEXP * 2; return true; }
    __device__ __forceinline__ unsigned a_off(const Unit&, int h, int R, int C) const { return (unsigned)((R + HALF * h) * DEXP + C) * 2u; }
};
struct EpiGateUp { bf16* H;
    __device__ __forceinline__ void operator()(const f32x4 (&acc)[2][2][4][2], const Unit& u, int wr, int wc, int fr, int fq) const {
        bf16* rowp = H + (size_t)(u.pm * BM + wr * 64 + fr) * DEXP + (u.pn * 128 + wc * 32 + 8 * fq);
#pragma unroll
        for (int ai = 0; ai < 2; ++ai) {
#pragma unroll
            for (int m = 0; m < 4; ++m) { float hv[8];
#pragma unroll
                for (int n = 0; n < 2; ++n)
#pragma unroll
                    for (int j = 0; j < 4; ++j) { const float g = acc[ai][0][m][n][j], up = acc[ai][1][m][n][j]; hv[4 * n + j] = g * __builtin_amdgcn_rcpf(1.f + __expf(-g)) * up; }
                u32x4 w; w.x = cvt_pk_bf16(hv[0], hv[1]); w.y = cvt_pk_bf16(hv[2], hv[3]); w.z = cvt_pk_bf16(hv[4], hv[5]); w.w = cvt_pk_bf16(hv[6], hv[7]);
                *(u32x4*)rowp = w;
                rowp += (size_t)16 * DEXP; asm volatile("" : "+v"(rowp)); }
            rowp += (size_t)64 * DEXP; }
    } };
__device__ __forceinline__ int crow(int r, int hi) { return (r & 3) + 8 * (r >> 2) + 4 * hi; }
__device__ __forceinline__ unsigned cvtpk_s(float lo, float hi) { typedef float f2 __attribute__((ext_vector_type(2))); typedef __bf16 b2 __attribute__((ext_vector_type(2))); f2 v = {lo, hi}; b2 b = __builtin_convertvector(v, b2); return __builtin_bit_cast(unsigned, b); }
__device__ __forceinline__ float bfbits2f(unsigned short v) { return __uint_as_float(((unsigned)v) << 16); }

constexpr int AT_NSLOT = 4, AT_SLOT = 16640, AT_K = 0, AT_V = 8192, AT_KB = 16384, AT_WS = AT_NSLOT * AT_SLOT, AT_OST = AT_WS + 2048, AT_BYTES = AT_OST + 8 * 4096;
static_assert(AT_BYTES <= RING_BYTES, "attention LDS");
__device__ __forceinline__ void glds_asm16(const void* gsrc, unsigned lds_dst) { unsigned keep;
    asm volatile("s_mov_b32 %0, m0\n\ts_mov_b32 m0, %2\n\ts_nop 0\n\tglobal_load_lds_dwordx4 %1, off\n\ts_mov_b32 m0, %0" : "=&s"(keep) : "v"(gsrc), "s"(lds_dst) : "memory"); }
__device__ __forceinline__ void glds_asm4(const void* gsrc, unsigned lds_dst) { unsigned keep;
    asm volatile("s_mov_b32 %0, m0\n\ts_mov_b32 m0, %2\n\ts_nop 0\n\tglobal_load_lds_dword %1, off\n\ts_mov_b32 m0, %0" : "=&s"(keep) : "v"(gsrc), "s"(lds_dst) : "memory"); }
constexpr float AT_THR = 10.0f, AT_SKIP = 50.0f;
template <bool FOX>
__device__ __forceinline__ void attn_qk(const LAS unsigned char* slot, const bf16x8 (&qr)[4], float mref, f32x16& p0, f32x16& p1, int r32, int hi) {
    const LAS unsigned char* kb = slot + AT_K + hi * 1024 + r32 * 16; const LAS float* kbs = (const LAS float*)(slot + AT_KB);
    if (FOX) { const float nm = -mref;
#pragma unroll
        for (int g = 0; g < 4; ++g) { const f32x4 b0 = *(const LAS f32x4*)(kbs + 8 * g + 4 * hi), b1 = *(const LAS f32x4*)(kbs + 32 + 8 * g + 4 * hi);
#pragma unroll
            for (int j = 0; j < 4; ++j) { p0[4 * g + j] = __builtin_fmaf(b0[j], -LOG2E, nm); p1[4 * g + j] = __builtin_fmaf(b1[j], -LOG2E, nm); } }
    } else { p0 = f32x16{}; p1 = f32x16{}; }
#pragma unroll
    for (int d0 = 0; d0 < 4; ++d0) { const bf16x8 b0 = *(const LAS bf16x8*)(kb + d0 * 2048), b1 = *(const LAS bf16x8*)(kb + d0 * 2048 + 512);
        p0 = __builtin_amdgcn_mfma_f32_32x32x16_bf16(b0, qr[d0], p0, 0, 0, 0); p1 = __builtin_amdgcn_mfma_f32_32x32x16_bf16(b1, qr[d0], p1, 0, 0, 0); }
}
template <bool FOX>
__device__ __forceinline__ void attn_sm_pv(const LAS unsigned char* slot, f32x16& p0, f32x16& p1, f32x16& n0, f32x16& n1, bool has_next, f32x16 (&o)[2], float& mref, float& lrun, LAS float* wsf, int vb0, int jb, int qrel, int r32, int hi) {
    if (FOX) {
        if (jb >= 0) { const int kbase = 64 * jb + 4 * hi;
#pragma unroll
            for (int r = 0; r < 16; ++r) { const int kv = kbase + (r & 3) + 8 * (r >> 2); if (kv > qrel) p0[r] = -INFINITY; if (kv + 32 > qrel) p1[r] = -INFINITY; } }
    } else { const float nm = -mref;
#pragma unroll
        for (int r = 0; r < 16; ++r) { p0[r] = __builtin_fmaf(p0[r], QC2, nm); p1[r] = __builtin_fmaf(p1[r], QC2, nm); }
    }
    float rm = fmaxf(p0[0], p1[0]);
#pragma unroll
    for (int r = 1; r < 16; ++r) rm = fmaxf(rm, fmaxf(p0[r], p1[r]));
    { auto rr = __builtin_amdgcn_permlane32_swap(__float_as_uint(rm), __float_as_uint(rm), false, false); rm = fmaxf(__uint_as_float(rr[0]), __uint_as_float(rr[1])); }
    const bool move = (rm > AT_THR) || (lrun == 0.f && rm > -1e30f);
    if (__builtin_expect(__any(move), 0)) {
        const float dl = move ? rm : 0.f, f = __builtin_amdgcn_exp2f(fminf(-dl, 64.f));
        mref += dl; lrun *= f;
#pragma unroll
        for (int r = 0; r < 16; ++r) { p0[r] -= dl; p1[r] -= dl; }
        if (FOX && has_next) {
#pragma unroll
            for (int r = 0; r < 16; ++r) { n0[r] -= dl; n1[r] -= dl; } }
        if (hi == 0) wsf[r32] = f;
        asm volatile("s_waitcnt lgkmcnt(0)" ::: "memory");
#pragma unroll
        for (int g = 0; g < 4; ++g) { const f32x4 a = *(const LAS f32x4*)(wsf + 8 * g + 4 * hi);
#pragma unroll
            for (int j = 0; j < 4; ++j) { o[0][4 * g + j] *= a[j]; o[1][4 * g + j] *= a[j]; } }
    }
    float rs = 0.f;
#pragma unroll
    for (int r = 0; r < 16; ++r) { p0[r] = __builtin_amdgcn_exp2f(p0[r]); p1[r] = __builtin_amdgcn_exp2f(p1[r]); rs += p0[r] + p1[r]; }
    { auto rr = __builtin_amdgcn_permlane32_swap(__float_as_uint(rs), __float_as_uint(rs), false, false); rs = __uint_as_float(rr[0]) + __uint_as_float(rr[1]); }
    lrun += rs;
    u32x4 pw[4];
#pragma unroll
    for (int k = 0; k < 2; ++k) {
        pw[k] = (u32x4){cvtpk_s(p0[8 * k], p0[8 * k + 1]), cvtpk_s(p0[8 * k + 2], p0[8 * k + 3]), cvtpk_s(p0[8 * k + 4], p0[8 * k + 5]), cvtpk_s(p0[8 * k + 6], p0[8 * k + 7])};
        pw[2 + k] = (u32x4){cvtpk_s(p1[8 * k], p1[8 * k + 1]), cvtpk_s(p1[8 * k + 2], p1[8 * k + 3]), cvtpk_s(p1[8 * k + 4], p1[8 * k + 5]), cvtpk_s(p1[8 * k + 6], p1[8 * k + 7])}; }
    const int vb = vb0 + (int)(unsigned)(size_t)slot;
#pragma unroll
    for (int d0 = 0; d0 < 2; ++d0) { s16x4 vlo[4], vhi[4];
#pragma unroll
        for (int ks = 0; ks < 4; ++ks) {
            asm volatile("ds_read_b64_tr_b16 %0,%1 offset:%c2" : "=&v"(vlo[ks]) : "v"(vb), "i"(d0 * 4096 + ks * 1024) : "memory");
            asm volatile("ds_read_b64_tr_b16 %0,%1 offset:%c2" : "=&v"(vhi[ks]) : "v"(vb), "i"(d0 * 4096 + ks * 1024 + 512) : "memory"); }
        asm volatile("s_waitcnt lgkmcnt(0)" ::: "memory"); __builtin_amdgcn_sched_barrier(0);
#pragma unroll
        for (int ks = 0; ks < 4; ++ks) { const bf16x8 vf = (bf16x8){vlo[ks][0], vlo[ks][1], vlo[ks][2], vlo[ks][3], vhi[ks][0], vhi[ks][1], vhi[ks][2], vhi[ks][3]};
            o[d0] = __builtin_amdgcn_mfma_f32_32x32x16_bf16(__builtin_bit_cast(bf16x8, pw[ks]), vf, o[d0], 0, 0, 0); }
    }
}
template <bool FOX>
__device__ __forceinline__ void attn_unit(LAS unsigned char* lds, const bf16* Qp, int qpitch, const bf16* Kp, const bf16* Vp, int kvpitch, int NT, const float* cum, float qk_bound, bf16* Op, int opitch, const bf16* OGp, int gpitch, const int wave_s) {
    const int tid = fresh_tid(wave_s), lane = tid & 63, wid = wave_s, r32 = lane & 31, hi = lane >> 5; const int bid = blockIdx.x;
    LAS float* wsf = (LAS float*)(lds + AT_WS) + wid * 64;
    bf16x8 qr[4];
#pragma unroll
    for (int d0 = 0; d0 < 4; ++d0) qr[d0] = *(const bf16x8*)(Qp + (size_t)(wid * 32 + r32) * qpitch + d0 * 16 + hi * 8);
    const bf16* ksrc = Kp + (size_t)lane * kvpitch + wid * 8;
    const bf16* vsrc = Vp + (size_t)(16 * (wid & 3) + (lane >> 2)) * kvpitch + (wid >> 2) * 32 + (lane & 3) * 8;
    const int vb0 = AT_V + ((lane >> 4) & 1) * 32 + (lane & 3) * 8 + (4 * hi + ((lane & 15) >> 2)) * 64;
    float mref = 0.f, lrun = 0.f; f32x16 o[2]; o[0] = f32x16{}; o[1] = f32x16{};
    const int NTF = NT;
    if (FOX) { int i0 = NTF * 64 - 256; asm volatile("" : "+v"(i0));
        const float c0 = cum[i0], cl = cum[(lane < NTF ? lane : NTF - 1) * 64 + 63];
        const bool need = (lane < NTF) && ((c0 - cl) * LOG2E + 2.f * qk_bound >= -AT_SKIP);
        const int cnt = __builtin_popcountll(__ballot(need)); NT = cnt < 4 ? 4 : ((cnt + 1) & ~1); if (NT > NTF) NT = NTF; }
    const int qrel = wid * 32 + r32; const size_t tstep = (size_t)64 * kvpitch;
    constexpr int ND = FOX ? 3 : 2;
#define AT_TILE(tt) (FOX ? NTF - 1 - (tt) : (tt))
#define AT_ISSUE(tt) do { const unsigned sl_ = ldsb + (unsigned)(((tt) & (AT_NSLOT - 1)) * AT_SLOT); const int kt_ = AT_TILE(tt); \
        glds_asm16(ksrc + (size_t)kt_ * tstep, (unsigned)__builtin_amdgcn_readfirstlane(sl_ + AT_K + wid * 1024)); \
        glds_asm16(vsrc + (size_t)kt_ * tstep, (unsigned)__builtin_amdgcn_readfirstlane(sl_ + AT_V + wid * 1024)); \
        if (FOX) glds_asm4(cum + kt_ * 64 + lane, (unsigned)__builtin_amdgcn_readfirstlane(sl_ + AT_KB)); } while (0)
    const unsigned ldsb = (unsigned)(size_t)lds;
    AT_ISSUE(0); AT_ISSUE(1); AT_ISSUE(2);
#define AT_WAIT1() do { if (FOX) asm volatile("s_waitcnt vmcnt(3)" ::: "memory"); else asm volatile("s_waitcnt vmcnt(2)" ::: "memory"); } while (0)
#define AT_SLOTP(tt) (lds + ((tt) & (AT_NSLOT - 1)) * AT_SLOT)
#define AT_STEP(PC0, PC1, PN0, PN1, tt) do { const int t_ = (tt); const bool hn_ = t_ + 1 < NT; \
        { PSEC_BEGIN(10); if (t_ + 2 < NT) AT_WAIT1(); else asm volatile("s_waitcnt vmcnt(0)" ::: "memory"); \
        __builtin_amdgcn_s_barrier(); asm volatile("" ::: "memory"); PSEC_END(10); } \
        { PSEC_BEGIN(11); if (t_ + 3 < NT) AT_ISSUE(t_ + 3); PSEC_END(11); } \
        { PSEC_BEGIN(12); if (hn_) attn_qk<FOX>(AT_SLOTP(t_ + 1), qr, mref, PN0, PN1, r32, hi); PSEC_END(12); } \
        { PSEC_BEGIN(13); attn_sm_pv<FOX>(AT_SLOTP(t_), PC0, PC1, PN0, PN1, hn_, o, mref, lrun, wsf, vb0, AT_TILE(t_) - (NTF - 4), qrel, r32, hi); PSEC_END(13); } } while (0)
    f32x16 a0, a1, b0, b1;
    if (FOX) asm volatile("s_waitcnt vmcnt(6)" ::: "memory"); else asm volatile("s_waitcnt vmcnt(4)" ::: "memory");
    __builtin_amdgcn_s_barrier(); asm volatile("" ::: "memory");
    attn_qk<FOX>(AT_SLOTP(0), qr, mref, a0, a1, r32, hi);
#pragma unroll 1
    for (int t = 0; t < NT; t += 2) { AT_STEP(a0, a1, b0, b1, t); AT_STEP(b0, b1, a0, a1, t + 1); }
#undef AT_STEP
#undef AT_WAIT1
#undef AT_SLOTP
#undef AT_ISSUE
#undef AT_TILE
    static_assert(ND == 3 || ND == 2, "");
    if (hi == 0) wsf[32 + r32] = lrun;
    asm volatile("s_waitcnt lgkmcnt(0)" ::: "memory");
    LAS bf16* stg = (LAS bf16*)(lds + AT_OST) + wid * 2048;
#pragma unroll
    for (int r = 0; r < 16; ++r) { const int orow = crow(r, hi); const float rl = __builtin_amdgcn_rcpf(wsf[32 + orow]);
#pragma unroll
        for (int d0 = 0; d0 < 2; ++d0) stg[orow * 64 + d0 * 32 + r32] = f2bf(o[d0][r] * rl); }
    asm volatile("s_waitcnt lgkmcnt(0)" ::: "memory");
#pragma unroll
    for (int i = 0; i < 4; ++i) { const int row = i * 8 + (lane >> 3), ch = lane & 7; u32x4 v = *(const LAS u32x4*)(stg + row * 64 + ch * 8);
        const size_t go = (size_t)(wid * 32 + row) * opitch + ch * 8;
        if (FOX) { const u32x4 g = *(const u32x4*)(OGp + (size_t)(wid * 32 + row) * gpitch + ch * 8); unsigned vv[4] = {v.x, v.y, v.z, v.w}; const unsigned gg[4] = {g.x, g.y, g.z, g.w};
#pragma unroll
            for (int k = 0; k < 4; ++k) { const float a0 = __uint_as_float(vv[k] << 16), a1 = __uint_as_float(vv[k] & 0xffff0000u), g0 = __uint_as_float(gg[k] << 16), g1 = __uint_as_float(gg[k] & 0xffff0000u);
                vv[k] = cvtpk_s(a0 * __builtin_amdgcn_rcpf(1.f + __expf(-g0)), a1 * __builtin_amdgcn_rcpf(1.f + __expf(-g1))); }
            v = (u32x4){vv[0], vv[1], vv[2], vv[3]}; }
        *(u32x4*)(Op + go) = v; }
    __syncthreads();
}
constexpr int CW_Q11 = 1024;
__device__ __forceinline__ float wave_max64(float v) {
    v = fmaxf(v, dppf<0xB1>(v)); v = fmaxf(v, dppf<0x4E>(v)); v = fmaxf(v, dppf<0x141>(v)); v = fmaxf(v, dppf<0x140>(v));
    { auto r = __builtin_amdgcn_permlane16_swap(__float_as_uint(v), __float_as_uint(v), false, false); v = fmaxf(__uint_as_float(r[0]), __uint_as_float(r[1])); }
    { auto r = __builtin_amdgcn_permlane32_swap(__float_as_uint(v), __float_as_uint(v), false, false); v = fmaxf(__uint_as_float(r[0]), __uint_as_float(r[1])); }
    return v;
}
__device__ __forceinline__ void phase_attn_b(KP p, LAS unsigned char* lds, const int wave_s) {
    unsigned char* ws = p->ws;
    const bf16* Q = (const bf16*)(ws + WS_HREG); const bf16* K = (const bf16*)(ws + WS_HREG + HR_48); const bf16* V = (const bf16*)(ws + WS_HREG + 2 * HR_48); const bf16* OG = (const bf16*)(ws + WS_HREG + 3 * HR_48);
    const bf16* MQ = (const bf16*)(ws + WS_HREG + 4 * HR_48); const bf16* MKV = (const bf16*)(ws + WS_MKV);
    const float* CUM = (const float*)(ws + WS_CUM); bf16* OC = (bf16*)(ws + WS_GREG);
    unsigned* qhead = (unsigned*)(ws + WS_CTL) + CW_Q11;
    volatile LAS unsigned* slotw = (volatile LAS unsigned*)(lds + MISC_OFF) + 48;
    float qkb; { const int lane = fresh_lane(); const float gq = wave_max64(fabsf(p->in[I_QNG][lane])), gk = wave_max64(fabsf(p->in[I_KNG][lane])); qkb = 64.f * gq * gk * QC2 * 1.02f; }
    for (;;) {
        if (fresh_tid(wave_s) == 0) slotw[0] = __hip_atomic_fetch_add(qhead, 1u, __ATOMIC_RELAXED, __HIP_MEMORY_SCOPE_AGENT);
        __syncthreads();
        const int u = (int)__builtin_amdgcn_readfirstlane(slotw[0]);
        if (u >= 1536 + 512) break;
        if (u < 1536) { const int qb = 15 - u / 96, bh = u % 96, b = bh / FOX_H, h = bh % FOX_H; const size_t row0 = (size_t)b * SEQ;
            attn_unit<true>(lds, Q + (row0 + qb * 256) * 768 + h * 64, 768, K + row0 * 768 + h * 64, V + row0 * 768 + h * 64, 768, 4 * (qb + 1), CUM + (size_t)bh * SEQ, qkb,
                            OC + (row0 + qb * 256) * D + h * 64, D, OG + (row0 + qb * 256) * 768 + h * 64, 768, wave_s); }
        else { const int m = u - 1536, b = m >> 6, hd = (m >> 4) & 3, qblk = m & 15; const size_t row0 = (size_t)b * SEQ + qblk * 256;
            const bf16* Kp = MKV + (size_t)b * NMEM * 1024 + 512 + hd * 64;
            attn_unit<false>(lds, MQ + row0 * 256 + hd * 64, 256, Kp, Kp + 256, 1024, 4, nullptr, 0.f, OC + row0 * D + 768 + hd * 64, D, nullptr, 0, wave_s); }
    }
}
__device__ __forceinline__ void phase_attn_mem(unsigned char* ws, LAS unsigned char* lds, int layer, int G, int bid, const int wave_s) {
    const bf16* MQ = (const bf16*)(ws + WS_HREG + (layer == 0 ? 3 : 4) * HR_48); const bf16* MKV = (const bf16*)(ws + WS_MKV); bf16* OC = (bf16*)(ws + (layer == 0 ? WS_XB : WS_GREG));
    for (int u = bid; u < 512; u += G) { const int b = u >> 6, hd = (u >> 4) & 3, qblk = u & 15; const size_t row0 = (size_t)b * SEQ + qblk * 256;
        const bf16* Kp = MKV + (size_t)b * NMEM * 1024 + layer * 512 + hd * 64;
        attn_unit<false>(lds, MQ + row0 * 256 + hd * 64, 256, Kp, Kp + 256, 1024, 4, nullptr, 0.f, OC + row0 * D + 768 + hd * 64, D, nullptr, 0, wave_s); }
}
constexpr int GL_QP = 208, GL_VP = 448, GL_KX = 0, GL_QD = 13312, GL_VT = 26624, GL_HEAD = 55296;
constexpr int GL_GLR = 2 * GL_HEAD, GL_TOT = GL_GLR + 4096, GL_SSX = GL_TOT + 1536, GL_BYTES = GL_SSX + 1024;
static_assert(GL_BYTES <= RING_BYTES, "GLA LDS");
typedef short v4i16_t __attribute__((ext_vector_type(4)));
__device__ __forceinline__ s16x4 trd(const LAS unsigned char* p) { return __builtin_bit_cast(s16x4, __builtin_amdgcn_ds_read_tr16_b64_v4i16((LAS v4i16_t*)p)); }
__device__ __forceinline__ float fast_log_sigmoid(float z) { return fminf(z, 0.f) - __logf(1.f + __expf(-fabsf(z))); }

template <int MODE>
__device__ __forceinline__ void gla_stage(unsigned char* ws, LAS unsigned char* lds, int tid, int b, int n, int hp) {
    const bf16* V = (const bf16*)(ws + WS_HREG + HR_48); const float* GLR = (const float*)(ws + WS_GLR); const bf16* QK = (const bf16*)(ws + WS_HREG);
    const size_t m0 = (size_t)b * SEQ + n * 64;
#pragma unroll
    for (int i = 0; i < 6; ++i) { const int pi = tid + 512 * i, u = pi / 1536, rem = pi % 1536, row = rem / 24, ch = rem % 24;
        const u32x4 v = *(const u32x4*)(V + (m0 + row) * 768 + 192 * (2 * hp + u) + 8 * ch);
        *(LAS u32x4*)(lds + u * GL_HEAD + GL_VT + row * GL_VP + ch * 16) = v; }
#pragma unroll
    for (int i = 0; i < (MODE == 1 ? 6 : 3); ++i) { const int pi = tid + 512 * i, ts = pi / 1536, rem = pi % 1536, u = rem / 768, r2 = rem % 768, row = r2 / 12, ch = r2 % 12;
        const u32x4 v = *(const u32x4*)(QK + (m0 + row) * 768 + (ts == 0 ? 384 : 0) + 96 * (2 * hp + u) + 8 * ch);
        *(LAS u32x4*)(lds + u * GL_HEAD + (ts == 0 ? GL_KX : GL_QD) + row * GL_QP + ch * 16) = v; }
    if (tid < 256) { const f32x4 g = *(const f32x4*)(GLR + m0 * 16 + 4 * tid); *(LAS f32x4*)(lds + GL_GLR + 16 * tid) = g; }
}
template <int MODE>
__device__ __forceinline__ void gla_gates(KP p, unsigned char* ws, LAS unsigned char* lds, int tid, int b, int n, int hp) {
    float* DEC = (float*)(ws + WS_DEC);
    const size_t m0 = (size_t)b * SEQ + n * 64;
    LAS float* glr = (LAS float*)(lds + GL_GLR); LAS float* totl = (LAS float*)(lds + GL_TOT);
    float la[32]; float tot = 0.f; int col = 0, th = 0, u = 0, kidx = 0, head = 0;
    if (tid < 384) { col = tid % 192; th = tid / 192; u = col / 96; kidx = col % 96; head = 2 * hp + u;
        float w[16];
#pragma unroll
        for (int j = 0; j < 16; ++j) w[j] = p->in[I_WGUP][j * 384 + 96 * head + kidx];
        const float bg = p->in[I_BGATE][96 * head + kidx];
#pragma unroll
        for (int i = 0; i < 32; ++i) { const LAS float* gr = glr + (32 * th + i) * 16; float z = bg;
#pragma unroll
            for (int j4 = 0; j4 < 4; ++j4) { const f32x4 g = *(const LAS f32x4*)(gr + 4 * j4); z += g[0] * w[4 * j4] + g[1] * w[4 * j4 + 1] + g[2] * w[4 * j4 + 2] + g[3] * w[4 * j4 + 3]; }
            la[i] = fast_log_sigmoid(z) * (1.f / 16.f); tot += la[i]; }
        totl[th * 192 + col] = tot; }
    __syncthreads();
    if (tid < 384) {
        LAS bf16* KX = (LAS bf16*)(lds + u * GL_HEAD + GL_KX); LAS bf16* QD = (LAS bf16*)(lds + u * GL_HEAD + GL_QD);
        if (MODE == 0) {
            float run = (th == 1) ? 0.f : totl[192 + col];
#pragma unroll
            for (int i = 31; i >= 0; --i) { LAS bf16* kp = KX + (32 * th + i) * (GL_QP / 2) + kidx; const float kv = bf2f(*kp); *kp = f2bf(kv * __expf(run)); run += la[i]; }
            if (th == 0) DEC[(((size_t)b * 64 + n) * 4 + head) * 96 + kidx] = __expf(run);
        } else {
            float run = (th == 0) ? 0.f : totl[col];
#pragma unroll
            for (int i = 0; i < 32; ++i) { run += la[i]; LAS bf16* qp = QD + (32 * th + i) * (GL_QP / 2) + kidx; LAS bf16* kp = KX + (32 * th + i) * (GL_QP / 2) + kidx; const float qv = bf2f(*qp), kv = bf2f(*kp);
                *qp = f2bf(qv * __expf(run) * 0.10206207261596577f); *kp = f2bf(kv * __expf(-run)); }
        }
    }
    __syncthreads();
}
__device__ __forceinline__ void phase_gla_kv(KP p, LAS unsigned char* lds, int G, int bid, const int wave_s) {
    unsigned char* ws = p->ws; bf16* SKV = (bf16*)(ws + WS_GREG);
    for (int unit = bid; unit < NB * 64 * 2; unit += G) {
        const int tid = fresh_tid(wave_s), lane = tid & 63, wid = wave_s;
        const int hp = unit & 1, n = (unit >> 1) & 63, b = unit >> 7;
        gla_stage<0>(ws, lds, tid, b, n, hp);
        __syncthreads();
        gla_gates<0>(p, ws, lds, tid, b, n, hp);
        const int u = wid >> 2, j4 = wid & 3, head = 2 * hp + u, r32 = lane & 31, h2 = lane >> 5, q = (lane & 15) >> 2, pp = lane & 3, g1 = (lane >> 4) & 1;
        const LAS unsigned char* ka = lds + u * GL_HEAD + GL_KX + (8 * h2 + q) * GL_QP + (16 * g1 + 4 * pp) * 2;
        const LAS unsigned char* va = lds + u * GL_HEAD + GL_VT + (8 * h2 + q) * GL_VP + (16 * g1 + 4 * pp) * 2;
        bf16* outb = SKV + ((((size_t)b * 64 + n) * 4 + head) * 192) * 96;
        for (int id = j4; id < 18; id += 4) { const int kb = id / 6, cb = id % 6;
            f32x16 acc = f32x16{};
#pragma unroll
            for (int ks = 0; ks < 4; ++ks) {
                const s16x4 a0 = trd(ka + ks * 16 * GL_QP + kb * 64), a1 = trd(ka + ks * 16 * GL_QP + 4 * GL_QP + kb * 64);
                const s16x4 b0 = trd(va + ks * 16 * GL_VP + cb * 64), b1 = trd(va + ks * 16 * GL_VP + 4 * GL_VP + cb * 64);
                acc = __builtin_amdgcn_mfma_f32_32x32x16_bf16((bf16x8){a0[0], a0[1], a0[2], a0[3], a1[0], a1[1], a1[2], a1[3]}, (bf16x8){b0[0], b0[1], b0[2], b0[3], b1[0], b1[1], b1[2], b1[3]}, acc, 0, 0, 0); }
            bf16* op = outb + (size_t)(32 * cb + r32) * 96 + 32 * kb + 4 * h2;
#pragma unroll
            for (int g = 0; g < 4; ++g) { u32x2 w; w.x = cvtpk_s(acc[4 * g], acc[4 * g + 1]); w.y = cvtpk_s(acc[4 * g + 2], acc[4 * g + 3]); *(u32x2*)(op + 8 * g) = w; }
        }
        __syncthreads();
    }
}
__device__ __forceinline__ void phase_gla_scan(unsigned char* ws, int G, int bid, const int wave_s) {
    bf16* SKV = (bf16*)(ws + WS_GREG); const float* DEC = (const float*)(ws + WS_DEC);
    const int tid = fresh_tid(wave_s);
    constexpr int NITEM = NB * 4 * 192 * 12;
    const int per = (NITEM + G - 1) / G;
    for (int it = tid; it < per; it += NTHREADS) { const int item = bid * per + it; if (item >= NITEM) break;
        const int k8 = item % 12, c = (item / 12) % 192, bh = item / (12 * 192), b = bh >> 2, h = bh & 3;
        float s[8];
#pragma unroll
        for (int j = 0; j < 8; ++j) s[j] = 0.f;
        u32x4* ptr = (u32x4*)(SKV + ((((size_t)b * 64) * 4 + h) * 192 + c) * 96 + 8 * k8); const float* dp = DEC + (((size_t)b * 64) * 4 + h) * 96 + 8 * k8;
#pragma unroll 1
        for (int n0 = 0; n0 < 64; n0 += 8) { u32x4 kv[8]; f32x4 d0[8], d1[8];
#pragma unroll
            for (int i = 0; i < 8; ++i) { kv[i] = ptr[(size_t)(n0 + i) * (4 * 192 * 96 / 8)]; d0[i] = *(const f32x4*)(dp + (size_t)(n0 + i) * 4 * 96); d1[i] = *(const f32x4*)(dp + (size_t)(n0 + i) * 4 * 96 + 4); }
#pragma unroll
            for (int i = 0; i < 8; ++i) { u32x4 o; o.x = cvtpk_s(s[0], s[1]); o.y = cvtpk_s(s[2], s[3]); o.z = cvtpk_s(s[4], s[5]); o.w = cvtpk_s(s[6], s[7]); ptr[(size_t)(n0 + i) * (4 * 192 * 96 / 8)] = o;
                const unsigned kw[4] = {kv[i].x, kv[i].y, kv[i].z, kv[i].w};
#pragma unroll
                for (int j = 0; j < 4; ++j) { const float dlo = j < 2 ? d0[i][2 * j] : d1[i][2 * j - 4], dhi = j < 2 ? d0[i][2 * j + 1] : d1[i][2 * j - 3];
                    s[2 * j] = dlo * s[2 * j] + __uint_as_float(kw[j] << 16); s[2 * j + 1] = dhi * s[2 * j + 1] + __uint_as_float(kw[j] & 0xffff0000u); } } }
    }
}
__device__ __forceinline__ void phase_gla_out(KP p, LAS unsigned char* lds, int G, int bid, const int wave_s) {
    unsigned char* ws = p->ws; const bf16* SKV = (const bf16*)(ws + WS_GREG); const bf16* R = (const bf16*)(ws + WS_HREG + 2 * HR_48); bf16* OC = (bf16*)(ws + WS_XB);
    for (int unit = bid; unit < NB * 64 * 2; unit += G) {
        const int tid = fresh_tid(wave_s), lane = tid & 63, wid = wave_s;
        const int hp = unit & 1, n = (unit >> 1) & 63, b = unit >> 7;
        u32x2 rv12[12];
        { const int tb_ = wid & 1, ch_ = (wid >> 1) & 1, head_ = 2 * hp + (wid >> 2); const size_t m_ = (size_t)b * SEQ + n * 64 + 32 * tb_ + (lane & 31);
          const bf16* rp_ = R + m_ * 768 + 192 * head_ + 96 * ch_ + 4 * (lane >> 5);
#pragma unroll
          for (int q = 0; q < 12; ++q) rv12[q] = *(const u32x2*)(rp_ + 32 * (q >> 2) + 8 * (q & 3)); }
        { PSEC_BEGIN(30); gla_stage<1>(ws, lds, tid, b, n, hp);
        __syncthreads(); PSEC_END(30); }
        { PSEC_BEGIN(31); gla_gates<1>(p, ws, lds, tid, b, n, hp); PSEC_END(31); }
        PSEC_BEGIN(32);
        const int u = wid >> 2, tb = wid & 1, ch = (wid >> 1) & 1, head = 2 * hp + u, r32 = lane & 31, h2 = lane >> 5, q = (lane & 15) >> 2, pp = lane & 3, g1 = (lane >> 4) & 1;
        const LAS unsigned char* kx = lds + u * GL_HEAD + GL_KX + r32 * GL_QP + 16 * h2;
        const LAS unsigned char* qd = lds + u * GL_HEAD + GL_QD + (32 * tb + r32) * GL_QP + 16 * h2;
        const LAS unsigned char* va = lds + u * GL_HEAD + GL_VT + (4 * h2 + q) * GL_VP + (16 * g1 + 4 * pp) * 2;
        bf16x8 qf[6];
#pragma unroll
        for (int ks = 0; ks < 6; ++ks) qf[ks] = *(const LAS bf16x8*)(qd + 32 * ks);
        f32x16 at0 = f32x16{}, at1 = f32x16{};
#pragma unroll
        for (int ks = 0; ks < 6; ++ks) at0 = __builtin_amdgcn_mfma_f32_32x32x16_bf16(*(const LAS bf16x8*)(kx + 32 * ks), qf[ks], at0, 0, 0, 0);
        if (tb == 1) {
#pragma unroll
            for (int ks = 0; ks < 6; ++ks) at1 = __builtin_amdgcn_mfma_f32_32x32x16_bf16(*(const LAS bf16x8*)(kx + 32 * GL_QP + 32 * ks), qf[ks], at1, 0, 0, 0);
        }
#pragma unroll
        for (int r = 0; r < 16; ++r) { const bool keep = crow(r, h2) <= r32; if (tb == 0) { if (!keep) at0[r] = 0.f; } else { if (!keep) at1[r] = 0.f; } }
        bf16x8 pb[4];
#pragma unroll
        for (int k2 = 0; k2 < 2; ++k2) {
            pb[k2] = __builtin_bit_cast(bf16x8, (u32x4){cvtpk_s(at0[8 * k2], at0[8 * k2 + 1]), cvtpk_s(at0[8 * k2 + 2], at0[8 * k2 + 3]), cvtpk_s(at0[8 * k2 + 4], at0[8 * k2 + 5]), cvtpk_s(at0[8 * k2 + 6], at0[8 * k2 + 7])});
            pb[2 + k2] = __builtin_bit_cast(bf16x8, (u32x4){cvtpk_s(at1[8 * k2], at1[8 * k2 + 1]), cvtpk_s(at1[8 * k2 + 2], at1[8 * k2 + 3]), cvtpk_s(at1[8 * k2 + 4], at1[8 * k2 + 5]), cvtpk_s(at1[8 * k2 + 6], at1[8 * k2 + 7])}); }
        const bf16* sg = SKV + ((((size_t)b * 64 + n) * 4 + head) * 192 + 96 * ch + r32) * 96 + 8 * h2;
        f32x16 o[3];
#pragma unroll
        for (int cbl = 0; cbl < 3; ++cbl) { const int cb = 3 * ch + cbl; f32x16 acc = f32x16{};
#pragma unroll
            for (int kq = 0; kq < 4; ++kq) { if (kq < 2 || tb == 1) {
                const s16x4 a0 = trd(va + kq * 16 * GL_VP + cb * 64), a1 = trd(va + kq * 16 * GL_VP + 8 * GL_VP + cb * 64);
                acc = __builtin_amdgcn_mfma_f32_32x32x16_bf16((bf16x8){a0[0], a0[1], a0[2], a0[3], a1[0], a1[1], a1[2], a1[3]}, pb[kq], acc, 0, 0, 0); } }
#pragma unroll
            for (int ks = 0; ks < 6; ++ks) { const bf16x8 sf = *(const bf16x8*)(sg + (size_t)(32 * cbl) * 96 + 16 * ks);
                acc = __builtin_amdgcn_mfma_f32_32x32x16_bf16(sf, qf[ks], acc, 0, 0, 0); }
            o[cbl] = acc; }
        asm volatile("" : "+v"(o[0]), "+v"(o[1]), "+v"(o[2])); PSEC_END(32);
        PSEC_BEGIN(33);
        float ss = 0.f;
#pragma unroll
        for (int cbl = 0; cbl < 3; ++cbl)
#pragma unroll
            for (int r = 0; r < 16; ++r) ss += o[cbl][r] * o[cbl][r];
        { auto rr = __builtin_amdgcn_permlane32_swap(__float_as_uint(ss), __float_as_uint(ss), false, false); ss = __uint_as_float(rr[0]) + __uint_as_float(rr[1]); }
        LAS float* ssx = (LAS float*)(lds + GL_SSX);
        if (h2 == 0) ssx[((u * 2 + tb) * 2 + ch) * 32 + r32] = ss;
        __syncthreads();
        ss += ssx[((u * 2 + tb) * 2 + (ch ^ 1)) * 32 + r32];
        const float rs = rsqrtf(ss * (1.f / 192.f) + RMS_EPS);
        const size_t m = (size_t)b * SEQ + n * 64 + 32 * tb + r32;
        bf16* op = OC + m * D + 192 * head + 96 * ch + 4 * h2; const float* gp = p->in[I_GLAG] + 96 * ch + 4 * h2;
#pragma unroll
        for (int cbl = 0; cbl < 3; ++cbl)
#pragma unroll
            for (int g = 0; g < 4; ++g) { const int co = 32 * cbl + 8 * g; const u32x2 rv = rv12[4 * cbl + g]; const f32x4 gn = *(const f32x4*)(gp + co);
                const float r0 = __uint_as_float(rv.x << 16), r1 = __uint_as_float(rv.x & 0xffff0000u), r2 = __uint_as_float(rv.y << 16), r3 = __uint_as_float(rv.y & 0xffff0000u);
                const float v0 = o[cbl][4 * g] * rs * gn[0] * (r0 * __builtin_amdgcn_rcpf(1.f + __expf(-r0))), v1 = o[cbl][4 * g + 1] * rs * gn[1] * (r1 * __builtin_amdgcn_rcpf(1.f + __expf(-r1)));
                const float v2 = o[cbl][4 * g + 2] * rs * gn[2] * (r2 * __builtin_amdgcn_rcpf(1.f + __expf(-r2))), v3 = o[cbl][4 * g + 3] * rs * gn[3] * (r3 * __builtin_amdgcn_rcpf(1.f + __expf(-r3)));
                u32x2 w; w.x = cvtpk_s(v0, v1); w.y = cvtpk_s(v2, v3); *(u32x2*)(op + co) = w; }
        __syncthreads();
        PSEC_END(33);
    }
}
constexpr int PROBE_J = -1, PROBE_B = 0, PROBE_K = 4;
__global__ void __launch_bounds__(NTHREADS, 2) mega(Params p_unused) {
    extern __shared__ __attribute__((aligned(16))) unsigned char lds_raw[];
    LAS unsigned char* lds = (LAS unsigned char*)lds_raw;
    const int G = gridDim.x, bid = blockIdx.x; const int wave_s = __builtin_amdgcn_readfirstlane(threadIdx.x >> 6);
    volatile LAS unsigned* MISC = (volatile LAS unsigned*)(lds + MISC_OFF);
    if (threadIdx.x < 64) MISC[threadIdx.x] = 0u;
    __syncthreads();
    KP p = fresh_kp();
    unsigned char* ws = p->ws;
    volatile LAS unsigned* STAMPS = (volatile LAS unsigned*)(lds + ROWTOK_OFF + 6144);
    if (PROBE_J >= 0 && threadIdx.x == 0) { const unsigned long long t_ = __builtin_amdgcn_s_memrealtime(); STAMPS[0] = (unsigned)t_; STAMPS[1] = (unsigned)(t_ >> 32); }
    if (PROBE_SEC >= 0 && threadIdx.x == 0) *(volatile LAS unsigned*)(lds + PSEC_OFF) = 0u;
    XcdBarrier bar = xcd_barrier_post((unsigned*)(ws + WS_CTL) + CW_BAR + p->bar_li * XCD_BAR_WORDS, MISC + 8);
#define WS (fresh_kp()->ws)
#define IN(k) ({ KP _q = fresh_kp(); const bool _r = _q->ph_lo <= (k) && (k) < _q->ph_hi; _r; })
#define SEAM(k) do { if (IN(k) && IN((k) + 1)) xcd_barrier(bar); if (PROBE_J >= 0 && threadIdx.x == 0) { const unsigned long long t_ = __builtin_amdgcn_s_memrealtime(); STAMPS[2 * ((k) + 1)] = (unsigned)t_; STAMPS[2 * ((k) + 1) + 1] = (unsigned)(t_ >> 32); } } while (0)

    if (IN(0)) { phase_prologue(fresh_kp(), lds, G, bid, wave_s); }
    SEAM(0);
    if (IN(1)) { unsigned char* wsl = WS;
        { TileOrder S; S.init(wsl + WS_XB, wsl + WS_WA, NTOK, 2560, D, G, bid);
          EpiInA E{(bf16*)(wsl + WS_HREG), (bf16*)(wsl + WS_HREG + HR_48), (bf16*)(wsl + WS_HREG + 2 * HR_48), (bf16*)(wsl + WS_HREG + 3 * HR_48)};
          gemm_phase(lds + RING_OFF, D, S, E, wave_s); }
    }
    SEAM(1);
    if (IN(2)) phase_gla_kv(fresh_kp(), lds, G, bid, wave_s);
    SEAM(2);
    if (IN(3)) { unsigned char* wsl = WS;
        if (G > 32 && bid < 16) { TileOrder S; S.init(wsl + WS_MEMB, wsl + WS_WMKV, NB * NMEM, 512, D, 16, bid);
            EpiPlain E{(bf16*)(wsl + WS_MKV), 1024};
            gemm_phase(lds + RING_OFF, D, S, E, wave_s); }
        else phase_gla_scan(wsl, G > 32 ? G - 16 : G, G > 32 ? bid - 16 : bid, wave_s);
        if (G <= 32) { TileOrder S; S.init(wsl + WS_MEMB, wsl + WS_WMKV, NB * NMEM, 512, D, G, bid); EpiPlain E{(bf16*)(wsl + WS_MKV), 1024}; gemm_phase(lds + RING_OFF, D, S, E, wave_s); } }
    SEAM(3);
    if (IN(4)) { phase_gla_out(fresh_kp(), lds, G, bid, wave_s); unsigned char* wsl = WS; phase_attn_mem(wsl, lds, 0, G, bid, wave_s); }
    SEAM(4);
        if (IN(5)) { unsigned char* wsl = WS;
            KP q = fresh_kp();
            TileOrder S; S.init(wsl + WS_XB, wsl + WS_WO + (size_t)0 * D * D * 2, NTOK, D, D, G, bid);
            EpiRes<false> E{(const void*)q->in[I_X], (bf16*)q->out};
            gemm_phase(lds + RING_OFF, D, S, E, wave_s);
        }
        SEAM(5);
        if (IN(5 + 1)) phase_ln_router(fresh_kp(), 0, lds, G, bid, wave_s);
        SEAM(5 + 1);
        if (IN(5 + 2)) { unsigned char* wsl = WS;
            const int nu = moe_setup(wsl, lds, G, bid, wave_s, true);
            MoeGU S{(const char*)(wsl + WS_XB), (const char*)(wsl + WS_WGU) + (size_t)0 * NEXP * 1024 * D * 2, (LAS const int*)(lds + MISC_OFF) + 16, (LAS const int*)(lds + ROWTOK_OFF), nu};
            EpiGateUp E{(bf16*)(wsl + WS_GREG)};
            gemm_phase(lds + RING_OFF, D, S, E, wave_s);
        }
        SEAM(5 + 2);
        if (IN(5 + 3)) { unsigned char* wsl = WS;
            const int nu = moe_setup(wsl, lds, G, bid, wave_s, false);
            MoeDown S{(const char*)(wsl + WS_GREG), (const char*)(wsl + WS_WD) + (size_t)0 * NEXP * 1024 * DEXP * 2, (LAS const int*)(lds + MISC_OFF) + 16, nu};
            EpiPlain E{(bf16*)(wsl + WS_HREG), 1024};
            gemm_phase(lds + RING_OFF, DEXP, S, E, wave_s);
        }
        SEAM(5 + 3);
        if (IN(5 + 4)) phase_ln_ffn(fresh_kp(), 0, lds, G, bid, wave_s);

            SEAM(9);
            if (IN(10)) { unsigned char* wsl = WS;
                KP q = fresh_kp();
                TileOrder S; S.init(wsl + WS_XB, wsl + WS_WB, NTOK, 3328, D, G, bid);
                EpiInB E{(bf16*)(wsl + WS_HREG), (bf16*)(wsl + WS_HREG + HR_48), (bf16*)(wsl + WS_HREG + 2 * HR_48), (bf16*)(wsl + WS_HREG + 3 * HR_48), (bf16*)(wsl + WS_HREG + 4 * HR_48), q->in[I_QNG], q->in[I_KNG]};
                gemm_phase(lds + RING_OFF, D, S, E, wave_s);
                {
                    const int c2 = (G >= 160) ? bid - 128 : bid; const int G2 = (G >= 160) ? 16 : G;
                    if (c2 >= 0 && c2 < G2) { TileOrder S2; S2.init(wsl + WS_MEMB, wsl + WS_WMKV + (size_t)512 * D * 2, NB * NMEM, 512, D, G2, c2);
                        EpiPlain E2{(bf16*)(wsl + WS_MKV) + 512, 1024};
                        gemm_phase(lds + RING_OFF, D, S2, E2, wave_s); } }
                const int gwr = (G - 1 - bid) * NWAVES + wave_s;
                if (gwr < NB * FOX_H) cum_wave((const float*)(wsl + WS_LOGF), (float*)(wsl + WS_CUM), gwr, fresh_lane());
            }
            SEAM(10);
            if (IN(11)) phase_attn_b(fresh_kp(), lds, wave_s);
            SEAM(11);
        if (IN(12)) { unsigned char* wsl = WS;
            KP q = fresh_kp();
            TileOrder S; S.init(wsl + WS_GREG, wsl + WS_WO + (size_t)1 * D * D * 2, NTOK, D, D, G, bid);
            EpiRes<true> E{(const void*)(wsl + WS_XB), (bf16*)q->out};
            gemm_phase(lds + RING_OFF, D, S, E, wave_s);
        }
        SEAM(12);
        if (IN(12 + 1)) phase_ln_router(fresh_kp(), 1, lds, G, bid, wave_s);
        SEAM(12 + 1);
        if (IN(12 + 2)) { unsigned char* wsl = WS;
            const int nu = moe_setup(wsl, lds, G, bid, wave_s, true);
            MoeGU S{(const char*)(wsl + WS_XB), (const char*)(wsl + WS_WGU) + (size_t)1 * NEXP * 1024 * D * 2, (LAS const int*)(lds + MISC_OFF) + 16, (LAS const int*)(lds + ROWTOK_OFF), nu};
            EpiGateUp E{(bf16*)(wsl + WS_GREG)};
            gemm_phase(lds + RING_OFF, D, S, E, wave_s);
        }
        SEAM(12 + 2);
        if (IN(12 + 3)) { unsigned char* wsl = WS;
            const int nu = moe_setup(wsl, lds, G, bid, wave_s, false);
            MoeDown S{(const char*)(wsl + WS_GREG), (const char*)(wsl + WS_WD) + (size_t)1 * NEXP * 1024 * DEXP * 2, (LAS const int*)(lds + MISC_OFF) + 16, nu};
            EpiPlain E{(bf16*)(wsl + WS_HREG), 1024};
            gemm_phase(lds + RING_OFF, DEXP, S, E, wave_s);
        }
        SEAM(12 + 3);
        if (IN(12 + 4)) phase_ln_ffn(fresh_kp(), 1, lds, G, bid, wave_s);
        SEAM(16);
    if (PROBE_J >= 0 && blockIdx.x == 0 && threadIdx.x == 0) {
        const unsigned long long t1 = ((unsigned long long)STAMPS[2 * PROBE_B + 1] << 32) | STAMPS[2 * PROBE_B], t0 = ((unsigned long long)STAMPS[2 * PROBE_J + 1] << 32) | STAMPS[2 * PROBE_J];
        const unsigned long long wait = (t1 - t0) * PROBE_K, ts = __builtin_amdgcn_s_memrealtime();
        while (__builtin_amdgcn_s_memrealtime() - ts < wait) __builtin_amdgcn_s_sleep(8);
    }
    if (PROBE_SEC >= 0 && blockIdx.x == 0 && threadIdx.x == 0) {
        const unsigned long long wait = (unsigned long long)(*(volatile LAS unsigned*)(lds + PSEC_OFF)) * PROBE_K, ts = __builtin_amdgcn_s_memrealtime();
        while (__builtin_amdgcn_s_memrealtime() - ts < wait) __builtin_amdgcn_s_sleep(8);
    }
#undef IN
#undef SEAM
#undef WS
}
#undef LAS
#undef GAS
}

static int pk_grid() {
    static int grid = 0;
    if (grid == 0) {
        int dev = 0, cus = 0;
        if (hipGetDevice(&dev) != hipSuccess || hipDeviceGetAttribute(&cus, hipDeviceAttributeMultiprocessorCount, dev) != hipSuccess) { grid = -1; return grid; }
        if (hipFuncSetAttribute((const void*)pk::mega, hipFuncAttributeMaxDynamicSharedMemorySize, pk::LDS_BYTES) != hipSuccess) { fprintf(stderr, "kernel_launch: hipFuncSetAttribute failed\n"); grid = -1; return grid; }
        int per_cu = 0;
        if (hipOccupancyMaxActiveBlocksPerMultiprocessor(&per_cu, (const void*)pk::mega, pk::NTHREADS, pk::LDS_BYTES) != hipSuccess || per_cu < 1) fprintf(stderr, "kernel_launch: occupancy query says %d\n", per_cu);
        (void)hipGetLastError();
        grid = cus;
    }
    return grid;
}
static void pk_launch(pk::Params& P, int lo, int hi, hipStream_t stream) {
    const int grid = pk_grid(); if (grid <= 0) return;
    P.ph_lo = lo; P.ph_hi = hi; P.bar_li += 1;
    hipLaunchKernelGGL(pk::mega, dim3(grid), dim3(pk::NTHREADS), pk::LDS_BYTES, stream, P);
}
extern "C" void kernel_launch(void* const* d_in, const int* in_sizes, int n_in, void* d_out, int out_size, void* d_ws, size_t ws_size, hipStream_t stream) {
    if (n_in != 22 || out_size != NTOK * D || ws_size < WS_END) { fprintf(stderr, "kernel_launch: unexpected shapes (n_in %d out %d ws %zu)\n", n_in, out_size, ws_size); return; }
    const float* w_gate_up = (const float*)d_in[3]; const float* b_gate = (const float*)d_in[4]; const float* gla_g = (const float*)d_in[5];
    const float* w_eg = (const float*)d_in[19]; const float* w_eu = (const float*)d_in[20]; const float* w_ed = (const float*)d_in[21];
    unsigned char* ws = (unsigned char*)d_ws;
    float* GLR = (float*)(ws + WS_GLR); float* CUM = (float*)(ws + WS_CUM);
    bf16* MKV = (bf16*)(ws + WS_MKV);
    int* TOK_E = (int*)(ws + WS_TOKE); int* TOK_S = (int*)(ws + WS_TOKS);
    bf16* XB = (bf16*)(ws + WS_XB); bf16* YS = (bf16*)(ws + WS_HREG);
    bf16* T0 = (bf16*)(ws + WS_HREG), *T1 = (bf16*)(ws + WS_HREG + HR_48), *T2 = (bf16*)(ws + WS_HREG + 2 * HR_48), *T3 = (bf16*)(ws + WS_HREG + 3 * HR_48), *T4 = (bf16*)(ws + WS_HREG + 4 * HR_48);
    (void)hipMemsetAsync(ws + WS_CTL, 0, CTL_ZERO_BYTES, stream);
    pk::Params P{}; for (int i = 0; i < 22; ++i) P.in[i] = (const float*)d_in[i]; P.out = (float*)d_out; P.ws = ws; P.bar_li = -1;
    pk_launch(P, 0, 17, stream);
}
```

```cpp
#include <hip/hip_runtime.h>
#include <cstdio>
#include <cstdint>

typedef unsigned short bf16;
constexpr int NB = 8, SEQ = 4096, D = 1024, NTOK = NB * SEQ;
constexpr int NMEM = 256, A_IN = 2576, B_IN = 1792, KV_IN = 1548;
constexpr int GLA_H = 4, GLA_DK = 96, GLA_DV = 192, FOX_H = 12;
constexpr int NEXP = 16, DEXP = 512;
constexpr float DN_ALPHA = 1.41421356237309515f;
constexpr float LN_EPS = 1e-5f, RMS_EPS = 1e-6f;
constexpr float LOG2E = 1.4426950408889634f;
constexpr float QC2 = 0.125f * LOG2E;
constexpr size_t MiB = 1u << 20;
constexpr size_t WS_CTL = 0, CTL_ZERO_BYTES = 1 * MiB;
constexpr size_t WS_GLR = 1 * MiB, WS_LOGF = 3 * MiB, WS_CUM = 5 * MiB, WS_DEC = 7 * MiB, WS_MEMB = 8 * MiB, WS_MKV = 12 * MiB;
constexpr size_t WS_TOKE = 16 * MiB, WS_TOKW = WS_TOKE + 256 * 1024, WS_TOKS = WS_TOKW + 256 * 1024, WS_CNT = WS_TOKS + 256 * 1024, WS_SLOTTOK = 17 * MiB;
constexpr size_t WS_WA = 20 * MiB, WS_WB = 25 * MiB, WS_WMKV = 32 * MiB, WS_WO = 34 * MiB, WS_WGU = 38 * MiB, WS_WD = 102 * MiB;
constexpr size_t WS_XB = 134 * MiB, WS_GREG = 198 * MiB, WS_HREG = 270 * MiB, WS_END = 478 * MiB;
constexpr size_t HR_48 = 48 * MiB;

__device__ __forceinline__ float bf2f(bf16 v) { return __uint_as_float(((unsigned)v) << 16); }
__device__ __forceinline__ bf16 f2bf(float f) { unsigned u = __float_as_uint(f); return (bf16)((u + 0x7fffu + ((u >> 16) & 1u)) >> 16); }
__device__ __forceinline__ float wave_sum(float v) {
#pragma unroll
    for (int o = 1; o < 64; o <<= 1) v += __shfl_xor(v, o);
    return v;
}
__device__ __forceinline__ float log_sigmoid(float z) { return fminf(z, 0.f) - log1pf(expf(-fabsf(z))); }
__device__ __forceinline__ float sigmoidf(float z) { return 1.f / (1.f + expf(-z)); }

namespace nv {
__global__ void __launch_bounds__(256) p0_x(const float* x, const float* w_in_a, bf16* XB, float* GLR) {
    const int row = blockIdx.x * 4 + (threadIdx.x >> 6), lane = threadIdx.x & 63;
    float acc[16];
#pragma unroll
    for (int j = 0; j < 16; ++j) acc[j] = 0.f;
    for (int k = lane; k < D; k += 64) {
        const float v = x[(size_t)row * D + k]; XB[(size_t)row * D + k] = f2bf(v);
#pragma unroll
        for (int j = 0; j < 16; ++j) acc[j] += v * w_in_a[(size_t)k * A_IN + 1536 + j];
    }
#pragma unroll
    for (int j = 0; j < 16; ++j) { const float s = wave_sum(acc[j]); if (lane == 0) GLR[(size_t)row * 16 + j] = s; }
}
__global__ void __launch_bounds__(256) p0_mem(const float* mem, bf16* MEMB) {
    const size_t i = (size_t)blockIdx.x * 256 + threadIdx.x; MEMB[i] = f2bf(mem[i]);
}
struct GemmArgs { const bf16* A; int lda; const float* W; int ldw; int wcol0; int M, Nn, K; };
struct EpiBf { bf16* dst; int ldd; int dcol0; __device__ void operator()(int m, int n, float v) const { dst[(size_t)m * ldd + dcol0 + n] = f2bf(v); } };
struct EpiRes { const float* xres; float* out; __device__ void operator()(int m, int n, float v) const { out[(size_t)m * D + n] = DN_ALPHA * xres[(size_t)m * D + n] + v; } };
template <class Epi> __global__ void __launch_bounds__(256) gemm(GemmArgs g, Epi E) {
    const int n = blockIdx.x * 64 + (threadIdx.x & 63), m0 = (blockIdx.y * 4 + (threadIdx.x >> 6)) * 4;
    if (n >= g.Nn) return;
    float acc[4] = {0.f, 0.f, 0.f, 0.f};
    for (int k = 0; k < g.K; k += 8) {
        float w[8];
#pragma unroll
        for (int j = 0; j < 8; ++j) w[j] = g.W[(size_t)(k + j) * g.ldw + g.wcol0 + n];
#pragma unroll
        for (int i = 0; i < 4; ++i) {
            const uint4 a = *(const uint4*)(g.A + (size_t)(m0 + i) * g.lda + k);
            const unsigned aw[4] = {a.x, a.y, a.z, a.w};
#pragma unroll
            for (int j = 0; j < 4; ++j) { acc[i] += __uint_as_float(aw[j] << 16) * w[2 * j]; acc[i] += __uint_as_float(aw[j] & 0xffff0000u) * w[2 * j + 1]; }
        }
    }
#pragma unroll
    for (int i = 0; i < 4; ++i) E(m0 + i, n, acc[i]);
}
__global__ void __launch_bounds__(192) gla(const bf16* QK, const bf16* V, const bf16* R, const float* GLR, const float* w_up, const float* b_gate, const float* g_norm, bf16* OC) {
    const int b = blockIdx.x / GLA_H, h = blockIdx.x % GLA_H, tid = threadIdx.x;
    __shared__ float sq[96], sk[96], sa[96], red[4];
    float S[96];
#pragma unroll
    for (int k = 0; k < 96; ++k) S[k] = 0.f;
    float wup[16]; float bg = 0.f;
    if (tid < 96) { for (int j = 0; j < 16; ++j) wup[j] = w_up[j * 384 + h * 96 + tid]; bg = b_gate[h * 96 + tid]; }
    const float gn = g_norm[tid];
    const float qs = 0.10206207261596577f;
    for (int t = 0; t < SEQ; ++t) {
        const size_t m = (size_t)b * SEQ + t;
        __syncthreads();
        if (tid < 96) {
            float z = bg;
#pragma unroll
            for (int j = 0; j < 16; ++j) z += GLR[m * 16 + j] * wup[j];
            sa[tid] = expf(log_sigmoid(z) * (1.f / 16.f));
            sq[tid] = bf2f(QK[m * 768 + h * 96 + tid]) * qs;
            sk[tid] = bf2f(QK[m * 768 + 384 + h * 96 + tid]);
        }
        __syncthreads();
        const float v = bf2f(V[m * 768 + h * 192 + tid]);
        float o = 0.f;
#pragma unroll
        for (int k = 0; k < 96; ++k) { S[k] = sa[k] * S[k] + sk[k] * v; o += sq[k] * S[k]; }
        float ss = wave_sum(o * o);
        if ((tid & 63) == 0) red[tid >> 6] = ss;
        __syncthreads();
        ss = red[0] + red[1] + red[2];
        const float r = bf2f(R[m * 768 + h * 192 + tid]);
        const float on = o * rsqrtf(ss * (1.f / 192.f) + RMS_EPS) * gn;
        OC[m * D + h * 192 + tid] = f2bf(on * (r * sigmoidf(r)));
    }
}
__global__ void __launch_bounds__(256) memattn(const bf16* MQ, const bf16* MKV, int layer, bf16* OC) {
    const int m = blockIdx.x * 256 + threadIdx.x, hd = blockIdx.y, b = m / SEQ;
    float q[64], acc[64];
#pragma unroll
    for (int d = 0; d < 64; ++d) { q[d] = bf2f(MQ[(size_t)m * 256 + hd * 64 + d]) * 0.125f; acc[d] = 0.f; }
    float mx = -1e30f, l = 0.f;
    for (int j = 0; j < NMEM; ++j) {
        const bf16* kr = MKV + (size_t)(b * NMEM + j) * 1024 + layer * 512 + hd * 64;
        float s = 0.f;
#pragma unroll
        for (int d = 0; d < 64; ++d) s += q[d] * bf2f(kr[d]);
        const float mn = fmaxf(mx, s), f = expf(mx - mn), p = expf(s - mn);
        l = l * f + p; mx = mn;
#pragma unroll
        for (int d = 0; d < 64; ++d) acc[d] = acc[d] * f + p * bf2f(kr[256 + d]);
    }
    const float il = 1.f / l;
#pragma unroll
    for (int d = 0; d < 64; ++d) OC[(size_t)m * D + 768 + hd * 64 + d] = f2bf(acc[d] * il);
}
__global__ void __launch_bounds__(256) ln_router(float* XF, bf16* XB, const float* g, const float* bta, const float* w_router, const float* b_router, int* TOK_E, float* TOK_W) {
    const int row = blockIdx.x * 4 + (threadIdx.x >> 6), lane = threadIdx.x & 63;
    float v[16]; float s = 0.f;
#pragma unroll
    for (int i = 0; i < 16; ++i) { v[i] = XF[(size_t)row * D + lane + 64 * i]; s += v[i]; }
    const float mean = wave_sum(s) * (1.f / D); float q = 0.f;
#pragma unroll
    for (int i = 0; i < 16; ++i) { v[i] -= mean; q += v[i] * v[i]; }
    const float rstd = rsqrtf(wave_sum(q) * (1.f / D) + LN_EPS);
    float lg[16];
#pragma unroll
    for (int e = 0; e < 16; ++e) lg[e] = 0.f;
#pragma unroll
    for (int i = 0; i < 16; ++i) { const int k = lane + 64 * i; const float o = v[i] * rstd * g[k] + bta[k]; XF[(size_t)row * D + k] = o; XB[(size_t)row * D + k] = f2bf(o);
#pragma unroll
        for (int e = 0; e < 16; ++e) lg[e] += o * w_router[k * 16 + e]; }
#pragma unroll
    for (int e = 0; e < 16; ++e) lg[e] = wave_sum(lg[e]);
    if (lane == 0) {
        float aff[16], sel[16];
#pragma unroll
        for (int e = 0; e < 16; ++e) { aff[e] = sigmoidf(lg[e]); sel[e] = aff[e] + b_router[e]; }
        int gbest = 0; float gs = -1e30f;
#pragma unroll
        for (int gi = 0; gi < 4; ++gi) { float a = -1e30f, b2 = -1e30f;
#pragma unroll
            for (int j = 0; j < 4; ++j) { const float x = sel[gi * 4 + j]; if (x > a) { b2 = a; a = x; } else if (x > b2) b2 = x; }
            if (a + b2 > gs) { gs = a + b2; gbest = gi; } }
        int i0 = 0, i1 = 0; float a = -1e30f, b2 = -1e30f;
#pragma unroll
        for (int j = 0; j < 4; ++j) { float x = -1e30f;
#pragma unroll
            for (int gi = 0; gi < 4; ++gi) if (gi == gbest) x = sel[gi * 4 + j];
            if (x > a) { b2 = a; i1 = i0; a = x; i0 = j; } else if (x > b2) { b2 = x; i1 = j; } }
        const int e0 = gbest * 4 + i0, e1 = gbest * 4 + i1; float w0 = 0.f, w1 = 0.f;
#pragma unroll
        for (int e = 0; e < 16; ++e) { if (e == e0) w0 = aff[e]; if (e == e1) w1 = aff[e]; }
        const float inv = 1.f / (w0 + w1);
        TOK_E[row * 2] = e0; TOK_E[row * 2 + 1] = e1; TOK_W[row * 2] = w0 * inv; TOK_W[row * 2 + 1] = w1 * inv;
    }
}
__global__ void __launch_bounds__(256) moe(const bf16* XB, const int* TOK_E, const float* wg, const float* wu, const float* wd, bf16* YS, int* TOK_SLOT) {
    const int tok = blockIdx.x >> 1, j = blockIdx.x & 1, tid = threadIdx.x;
    __shared__ float xs[1024], hs[512];
    for (int k = tid; k < 1024; k += 256) xs[k] = bf2f(XB[(size_t)tok * D + k]);
    const int e = TOK_E[tok * 2 + j];
    __syncthreads();
    const float* G = wg + (size_t)e * 1024 * 512; const float* U = wu + (size_t)e * 1024 * 512; const float* Dn = wd + (size_t)e * 512 * 1024;
    float g0 = 0.f, g1 = 0.f, u0 = 0.f, u1 = 0.f;
    for (int k = 0; k < 1024; ++k) { const float x = xs[k]; g0 += x * G[k * 512 + tid]; g1 += x * G[k * 512 + 256 + tid]; u0 += x * U[k * 512 + tid]; u1 += x * U[k * 512 + 256 + tid]; }
    hs[tid] = g0 * sigmoidf(g0) * u0; hs[tid + 256] = g1 * sigmoidf(g1) * u1;
    __syncthreads();
    float o[4] = {0.f, 0.f, 0.f, 0.f};
    for (int k = 0; k < 512; ++k) { const float hh = hs[k];
#pragma unroll
        for (int c = 0; c < 4; ++c) o[c] += hh * Dn[k * 1024 + c * 256 + tid]; }
    const int slot = tok * 2 + j;
#pragma unroll
    for (int c = 0; c < 4; ++c) YS[(size_t)slot * D + c * 256 + tid] = f2bf(o[c]);
    if (tid == 0) TOK_SLOT[slot] = slot;
}
__global__ void __launch_bounds__(256) ln_ffn(float* XF, bf16* XB, const bf16* YS, const int* TOK_SLOT, const float* TOK_W, const float* g, const float* bta,
                                              const float* w_kv, const float* b_forget, float* LOGF, int do_logf) {
    const int row = blockIdx.x * 4 + (threadIdx.x >> 6), lane = threadIdx.x & 63;
    const int s0 = TOK_SLOT[row * 2], s1 = TOK_SLOT[row * 2 + 1]; const float w0 = TOK_W[row * 2], w1 = TOK_W[row * 2 + 1];
    float v[16]; float s = 0.f;
#pragma unroll
    for (int i = 0; i < 16; ++i) { const int k = lane + 64 * i; v[i] = DN_ALPHA * XF[(size_t)row * D + k] + w0 * bf2f(YS[(size_t)s0 * D + k]) + w1 * bf2f(YS[(size_t)s1 * D + k]); s += v[i]; }
    const float mean = wave_sum(s) * (1.f / D); float q = 0.f;
#pragma unroll
    for (int i = 0; i < 16; ++i) { v[i] -= mean; q += v[i] * v[i]; }
    const float rstd = rsqrtf(wave_sum(q) * (1.f / D) + LN_EPS);
    float lf[12];
#pragma unroll
    for (int e = 0; e < 12; ++e) lf[e] = 0.f;
#pragma unroll
    for (int i = 0; i < 16; ++i) { const int k = lane + 64 * i; const float o = v[i] * rstd * g[k] + bta[k]; XF[(size_t)row * D + k] = o; XB[(size_t)row * D + k] = f2bf(o);
        if (do_logf) {
#pragma unroll
            for (int e = 0; e < 12; ++e) lf[e] += o * w_kv[(size_t)k * KV_IN + 1536 + e]; } }
    if (do_logf) {
#pragma unroll
        for (int e = 0; e < 12; ++e) { const float t = wave_sum(lf[e]); if (lane == 0) LOGF[(size_t)row * 12 + e] = log_sigmoid(t + b_forget[e]); }
    }
}
__global__ void __launch_bounds__(256) headproj(const bf16* XB, const float* W, int ldw, const float* gn, float scale, bf16* dst) {
    const int m = blockIdx.x, col = blockIdx.y * 256 + threadIdx.x, lane = threadIdx.x & 63;
    float acc = 0.f;
    for (int k = 0; k < D; k += 8) {
        const uint4 a = *(const uint4*)(XB + (size_t)m * D + k); const unsigned aw[4] = {a.x, a.y, a.z, a.w};
#pragma unroll
        for (int j = 0; j < 4; ++j) { acc += __uint_as_float(aw[j] << 16) * W[(size_t)(k + 2 * j) * ldw + col]; acc += __uint_as_float(aw[j] & 0xffff0000u) * W[(size_t)(k + 2 * j + 1) * ldw + col]; }
    }
    const float ss = wave_sum(acc * acc);
    dst[(size_t)m * 768 + col] = f2bf(acc * rsqrtf(ss * (1.f / 64.f) + RMS_EPS) * gn[lane] * scale);
}
__global__ void __launch_bounds__(64) cumk(const float* LOGF, float* CUM) {
    const int b = blockIdx.x / FOX_H, h = blockIdx.x % FOX_H, lane = threadIdx.x;
    float loc[64]; float s = 0.f;
#pragma unroll
    for (int i = 0; i < 64; ++i) { s += LOGF[((size_t)b * SEQ + lane * 64 + i) * 12 + h]; loc[i] = s; }
    float inc = s;
#pragma unroll
    for (int o = 1; o < 64; o <<= 1) { const float t = __shfl_up(inc, o); if (lane >= o) inc += t; }
    const float base = inc - s;
#pragma unroll
    for (int i = 0; i < 64; ++i) CUM[((size_t)b * FOX_H + h) * SEQ + lane * 64 + i] = base + loc[i];
}
__global__ void __launch_bounds__(256) fox(const bf16* Q, const bf16* K, const bf16* V, const bf16* OG, const float* CUM, bf16* OC) {
    const int t = blockIdx.x * 256 + threadIdx.x, h = blockIdx.y, b = blockIdx.z;
    const size_t m = (size_t)b * SEQ + t;
    float q[64], acc[64];
#pragma unroll
    for (int d = 0; d < 64; ++d) { q[d] = bf2f(Q[m * 768 + h * 64 + d]); acc[d] = 0.f; }
    const float* cum = CUM + ((size_t)b * FOX_H + h) * SEQ; const float ct = cum[t] * LOG2E;
    float mx = -1e30f, l = 0.f;
    const int tmax = blockIdx.x * 256 + 255;
    for (int s = 0; s <= tmax; ++s) {
        const bf16* kr = K + ((size_t)b * SEQ + s) * 768 + h * 64; const bf16* vr = V + ((size_t)b * SEQ + s) * 768 + h * 64;
        float sc = ct - cum[s] * LOG2E;
#pragma unroll
        for (int d = 0; d < 64; ++d) sc += q[d] * bf2f(kr[d]);
        if (s <= t) {
            const float mn = fmaxf(mx, sc), f = exp2f(mx - mn), p = exp2f(sc - mn);
            l = l * f + p; mx = mn;
#pragma unroll
            for (int d = 0; d < 64; ++d) acc[d] = acc[d] * f + p * bf2f(vr[d]);
        }
    }
    const float il = 1.f / l;
#pragma unroll
    for (int d = 0; d < 64; ++d) { const float og = bf2f(OG[m * 768 + h * 64 + d]); OC[m * D + h * 64 + d] = f2bf(acc[d] * il * sigmoidf(og)); }
}
}

namespace pk {
#define LAS __attribute__((address_space(3)))
#define GAS __attribute__((address_space(1)))
typedef short bf16x8 __attribute__((ext_vector_type(8)));
typedef short s16x4 __attribute__((ext_vector_type(4)));
typedef float f32x4 __attribute__((ext_vector_type(4)));
typedef float f32x16 __attribute__((ext_vector_type(16)));
typedef unsigned u32x4 __attribute__((ext_vector_type(4)));
typedef unsigned u32x2 __attribute__((ext_vector_type(2)));
constexpr int NWAVES = 8, NTHREADS = 512;
constexpr int BM = 256, BK = 64, HALF = 128, HTB = HALF * BK * 2, STAGE_BYTES = 8 * HTB, NXCD = 8, WGM = 8;
constexpr int RING_OFF = 0, RING_BYTES = 131072;
constexpr int MISC_OFF = RING_BYTES;
constexpr int ROWTOK_OFF = MISC_OFF + 256;
constexpr int LDS_BYTES = 155648;
static_assert(ROWTOK_OFF + 6 * 1024 <= LDS_BYTES, "LDS map");

__device__ __forceinline__ int lds_byte(int r, int c) { const int st = (r >> 4) * 2 + (c >> 5), rr = r & 15, cc = c & 31, ob = rr * 64 + cc * 2; return st * 1024 + (ob ^ (((ob >> 9) & 1) << 5)); }
__device__ __forceinline__ void stage_rc(int b, int& R, int& C) { const int st = b / 1024, sb = b % 1024, swz = sb ^ (((sb >> 9) & 1) << 5); R = (st >> 1) * 16 + swz / 64; C = (st & 1) * 32 + (swz % 64) / 2; }
__device__ __forceinline__ unsigned cvt_pk_bf16(float lo, float hi) { unsigned r; asm volatile("v_cvt_pk_bf16_f32 %0, %1, %2" : "=v"(r) : "v"(lo), "v"(hi)); return r; }
__device__ __forceinline__ int perm8(int c) { return (c & ~31) | (16 * ((c >> 2) & 1) + 4 * ((c >> 3) & 3) + (c & 3)); }
__device__ __forceinline__ int head64(int c) { return 128 * ((c >> 5) & 1) + 32 * (c >> 6) + 16 * ((c >> 2) & 1) + 4 * ((c >> 3) & 3) + (c & 3); }

__device__ __forceinline__ int fresh_lane() { int l; asm volatile("v_mbcnt_lo_u32_b32 %0, -1, 0\n\tv_mbcnt_hi_u32_b32 %0, -1, %0" : "=v"(l)); return l; }
__device__ __forceinline__ int fresh_tid(int wave_s) { asm volatile("" : "+s"(wave_s)); return wave_s * 64 + fresh_lane(); }
constexpr int PROBE_SEC = -1;
constexpr int PSEC_OFF = 131072 + 256 + 6144 + 512;
#define PSEC_BEGIN(id) unsigned long long _ps##id = 0; if (PROBE_SEC == (id) && bid == 0 && wave_s == 0) _ps##id = __builtin_amdgcn_s_memrealtime()
#define PSEC_END(id) do { if (PROBE_SEC == (id) && bid == 0 && wave_s == 0) { const unsigned d_ = (unsigned)(__builtin_amdgcn_s_memrealtime() - _ps##id); volatile LAS unsigned* a_ = (volatile LAS unsigned*)(lds + PSEC_OFF); if (fresh_lane() == 0) a_[0] = a_[0] + d_; } } while (0)
struct Unit { const char* A; const char* B; int pm, pn, e, ord; };

struct TileOrder {
    const char* A; const char* Bt; int K, nM, nN, nwg, G, c;
    __device__ void init(const void* A_, const void* Bt_, int M, int N, int K_, int G_, int c_) { A = (const char*)A_; Bt = (const char*)Bt_; K = K_; nM = M / BM; nN = N / BM; nwg = nM * nN; G = G_; c = c_; }
    __device__ __forceinline__ bool next(int i, Unit& u) const {
        const long L = (long)i * G + c; if (L >= nwg) return false;
        int wgid = (int)L; { const int q = nwg / NXCD, r = nwg % NXCD, xcd = wgid % NXCD, off = wgid / NXCD; wgid = (xcd < r ? xcd * (q + 1) : r * (q + 1) + (xcd - r) * q) + off; }
        const int nig = WGM * nN, gid = wgid / nig, fm = gid * WGM, gsz = (nM - fm) < WGM ? (nM - fm) : WGM;
        u.pm = fm + ((wgid % nig) % gsz); u.pn = (wgid % nig) / gsz; u.e = 0; u.ord = i;
        u.A = A + (size_t)u.pm * BM * K * 2; u.B = Bt + (size_t)u.pn * BM * K * 2; return true;
    }
    __device__ __forceinline__ unsigned a_off(const Unit&, int h, int R, int C) const { return (unsigned)((R + HALF * h) * K + C) * 2u; }
};

template <class Epi, class Sched>
__device__ __forceinline__ void gemm_phase(LAS unsigned char* lds, const int K, const Sched& S, const Epi& E, const int wave_s) {
    const int tid = fresh_tid(wave_s), wid = wave_s, lane = tid & 63, wr = wid >> 2, wc = wid & 3, fr = lane & 15, fq = lane >> 4;
    const int nt = K / BK;
    int sR[2], sC[2];
    unsigned voffA[2][2], voffB[2];
#pragma unroll
    for (int i = 0; i < 2; ++i) { stage_rc(tid * 16 + i * 8192, sR[i], sC[i]); voffB[i] = (unsigned)(sR[i] * K + sC[i]) * 2u; }
    const size_t kstep = (size_t)(BK * 2);
    const size_t hstep = (size_t)HALF * K * 2;
    const unsigned ldsw = (unsigned)wid * 1024u;
    const int aoff = lds_byte(wr * 64 + fr, fq * 8), boff = lds_byte(wc * 32 + fr, fq * 8);
#define PG8_SA(b, h) (((b) * 2 + (h)) * HTB)
#define PG8_SB(b, h) ((4 + (b) * 2 + (h)) * HTB)
#define PG8_STAGE(bufoff, gbase, voff) do { _Pragma("unroll") for (int _i = 0; _i < 2; ++_i) \
        __builtin_amdgcn_global_load_lds((const unsigned*)((const char*)(gbase) + (voff)[_i]), (LAS unsigned*)(lds + (bufoff) + ldsw + _i * 8192), 16, 0, 0); } while (0)
#define PG8_LDA(dst, b, h) do { _Pragma("unroll") for (int m = 0; m < 4; ++m) _Pragma("unroll") for (int k = 0; k < 2; ++k) dst[m][k] = *(const LAS bf16x8*)(lds + PG8_SA(b, h) + aoff + m * 2048 + k * 1024); } while (0)
#define PG8_LDB(dst, b, h) do { _Pragma("unroll") for (int n = 0; n < 2; ++n) _Pragma("unroll") for (int k = 0; k < 2; ++k) dst[n][k] = *(const LAS bf16x8*)(lds + PG8_SB(b, h) + boff + n * 2048 + k * 1024); } while (0)
#define PG8_MMA(ai, bj, At, Bt) do { __builtin_amdgcn_s_setprio(1); _Pragma("unroll") for (int m = 0; m < 4; ++m) _Pragma("unroll") for (int n = 0; n < 2; ++n) _Pragma("unroll") for (int k = 0; k < 2; ++k) \
        acc[ai][bj][m][n] = __builtin_amdgcn_mfma_f32_16x16x32_bf16(Bt[n][k], At[m][k], acc[ai][bj][m][n], 0, 0, 0); __builtin_amdgcn_s_setprio(0); } while (0)
#define PG8_WAIT_V(n) asm volatile("s_waitcnt vmcnt(" #n ")" ::: "memory")
#define PG8_WAIT_L(n) asm volatile("s_waitcnt lgkmcnt(" #n ")" ::: "memory")
#define PG8_BAR __builtin_amdgcn_s_barrier()
#define PG8_SCHED __builtin_amdgcn_sched_barrier(0)
    Unit cur, nxt; int ui = 0;
    if (!S.next(0, cur)) return;
    f32x4 acc[2][2][4][2];
#pragma unroll
    for (int a = 0; a < 2; ++a)
#pragma unroll
        for (int b = 0; b < 2; ++b)
#pragma unroll
            for (int m = 0; m < 4; ++m)
#pragma unroll
                for (int n = 0; n < 2; ++n) acc[a][b][m][n] = (f32x4){0.f, 0.f, 0.f, 0.f};
    bf16x8 At[4][2], B0[2][2], B1[2][2];
    const char* cA = cur.A; const char* cB = cur.B;
#pragma unroll
    for (int h = 0; h < 2; ++h)
#pragma unroll
        for (int i = 0; i < 2; ++i) voffA[h][i] = S.a_off(cur, h, sR[i], sC[i]);
    PG8_STAGE(PG8_SB(0, 0), cB, voffB); PG8_STAGE(PG8_SB(0, 1), cB + hstep, voffB); PG8_STAGE(PG8_SA(0, 0), cA, voffA[0]); PG8_STAGE(PG8_SA(0, 1), cA, voffA[1]);
    if (wr == 1) PG8_BAR;
    PG8_WAIT_V(2); PG8_BAR;
    PG8_STAGE(PG8_SB(1, 0), cB + kstep, voffB); PG8_STAGE(PG8_SA(1, 0), cA + kstep, voffA[0]); PG8_STAGE(PG8_SB(1, 1), cB + hstep + kstep, voffB);
    PG8_WAIT_V(6); PG8_BAR;
    for (;;) {
        const bool has_next = S.next(ui + 1, nxt);
        const char* nA = has_next ? nxt.A : cA; const char* nB = has_next ? nxt.B : cB;
        for (int t = 0; t < nt; t += 2) {
            const bool last = (t == nt - 2);
            const char* a1 = cA + (size_t)(t + 1) * kstep;
            const char* a2 = last ? nA : cA + (size_t)(t + 2) * kstep; const char* b2 = last ? nB : cB + (size_t)(t + 2) * kstep;
            const char* a3 = a2 + kstep; const char* b3 = b2 + kstep;
            PG8_LDB(B0, 0, 0); PG8_LDB(B1, 0, 1); PG8_SCHED; PG8_LDA(At, 0, 0); PG8_STAGE(PG8_SA(1, 1), a1, voffA[1]);
            if (last && has_next) {
#pragma unroll
                for (int h = 0; h < 2; ++h)
#pragma unroll
                    for (int i = 0; i < 2; ++i) { int R2, C2; stage_rc(fresh_tid(wave_s) * 16 + i * 8192, R2, C2); voffA[h][i] = S.a_off(nxt, h, R2, C2); }
            }
            PG8_WAIT_V(8); PG8_WAIT_L(0); PG8_BAR; PG8_MMA(0, 0, At, B0); PG8_MMA(0, 1, At, B1); PG8_BAR; PG8_SCHED;
            PG8_LDA(At, 0, 1); PG8_STAGE(PG8_SB(0, 0), b2, voffB); PG8_STAGE(PG8_SB(0, 1), b2 + hstep, voffB); PG8_STAGE(PG8_SA(0, 0), a2, voffA[0]);
            PG8_WAIT_V(8); PG8_WAIT_L(0); PG8_BAR; PG8_MMA(1, 0, At, B0); PG8_MMA(1, 1, At, B1); PG8_BAR; PG8_SCHED;
            PG8_LDB(B0, 1, 0); PG8_LDB(B1, 1, 1); PG8_SCHED; PG8_LDA(At, 1, 0); PG8_STAGE(PG8_SA(0, 1), a2, voffA[1]);
            PG8_WAIT_V(8); PG8_WAIT_L(0); PG8_BAR; PG8_MMA(0, 0, At, B0); PG8_MMA(0, 1, At, B1); PG8_BAR; PG8_SCHED;
            PG8_LDA(At, 1, 1); PG8_STAGE(PG8_SB(1, 0), b3, voffB); PG8_STAGE(PG8_SB(1, 1), b3 + hstep, voffB); PG8_STAGE(PG8_SA(1, 0), a3, voffA[0]);
            PG8_WAIT_V(8); PG8_WAIT_L(0); PG8_BAR; PG8_MMA(1, 0, At, B0); PG8_MMA(1, 1, At, B1); PG8_BAR; PG8_SCHED;
        }
        if (wr == 0) PG8_BAR;
        E(acc, cur, wr, wc, fr, fq);
        if (!has_next) break;
#pragma unroll
        for (int a = 0; a < 2; ++a)
#pragma unroll
            for (int b = 0; b < 2; ++b)
#pragma unroll
                for (int m = 0; m < 4; ++m)
#pragma unroll
                    for (int n = 0; n < 2; ++n) acc[a][b][m][n] = (f32x4){0.f, 0.f, 0.f, 0.f};
        cur = nxt; cA = nA; cB = nB; ++ui;
        if (wr == 1) PG8_BAR;
    }
    PG8_WAIT_V(0);
    PG8_BAR;
#undef PG8_SA
#undef PG8_SB
#undef PG8_STAGE
#undef PG8_LDA
#undef PG8_LDB
#undef PG8_MMA
#undef PG8_WAIT_V
#undef PG8_WAIT_L
#undef PG8_BAR
#undef PG8_SCHED
}

__device__ __forceinline__ void store_bf16_tile(const f32x4 (&acc)[2][2][4][2], bf16* base, int ldd, int row0, int c0, int wr, int wc, int fr, int fq) {
    bf16* rowp = base + (size_t)(row0 + wr * 64 + fr) * ldd + (c0 + wc * 32 + 8 * fq);
#pragma unroll
    for (int ai = 0; ai < 2; ++ai) {
#pragma unroll
        for (int m = 0; m < 4; ++m) {
#pragma unroll
            for (int bj = 0; bj < 2; ++bj) { const f32x4 v0 = acc[ai][bj][m][0], v1 = acc[ai][bj][m][1];
                u32x4 w; w.x = cvt_pk_bf16(v0[0], v0[1]); w.y = cvt_pk_bf16(v0[2], v0[3]); w.z = cvt_pk_bf16(v1[0], v1[1]); w.w = cvt_pk_bf16(v1[2], v1[3]);
                *(u32x4*)(rowp + bj * HALF) = w; }
            rowp += (size_t)16 * ldd; asm volatile("" : "+v"(rowp)); }
        rowp += (size_t)64 * ldd; }
}
struct EpiInA { bf16 *QK, *V, *R, *MQ;
    __device__ __forceinline__ void operator()(const f32x4 (&acc)[2][2][4][2], const Unit& u, int wr, int wc, int fr, int fq) const {
        bf16* base; int ldd, c0; const int pn = u.pn;
        if (pn < 3) { base = QK; ldd = 768; c0 = pn * 256; } else if (pn < 6) { base = V; ldd = 768; c0 = (pn - 3) * 256; } else if (pn < 9) { base = R; ldd = 768; c0 = (pn - 6) * 256; } else { base = MQ; ldd = 256; c0 = 0; }
        store_bf16_tile(acc, base, ldd, u.pm * BM, c0, wr, wc, fr, fq);
    } };
struct EpiPlain { bf16* dst; int ldd;
    __device__ __forceinline__ void operator()(const f32x4 (&acc)[2][2][4][2], const Unit& u, int wr, int wc, int fr, int fq) const { store_bf16_tile(acc, dst, ldd, u.pm * BM, u.pn * BM, wr, wc, fr, fq); } };

#define XB_TMO      128
#define XB_XCNT(j)  (256  + 64 * (j))
#define XB_XSUB(j)  (1280 + 64 * (j))
#define XB_XGEN(j)  (2304 + 64 * (j))
#define XB_TOP      3328
#define XB_TOPGEN   3392
#define XCD_BAR_WORDS 3456
#define XB_SPIN_CAP (1u << 18)
__device__ __forceinline__ unsigned xb_ld(unsigned* p)              { return __hip_atomic_load(p, __ATOMIC_RELAXED, __HIP_MEMORY_SCOPE_AGENT); }
__device__ __forceinline__ unsigned xb_add(unsigned* p, unsigned v) { return __hip_atomic_fetch_add(p, v, __ATOMIC_RELAXED, __HIP_MEMORY_SCOPE_AGENT); }
__device__ __forceinline__ unsigned xb_xcc_id() { return (unsigned)__builtin_amdgcn_s_getreg((3 << 11) | 20) & 0xFu; }
#define XB_SPIN(cond, bar) do { unsigned _sp = 0; while (cond) { __builtin_amdgcn_s_sleep(1); \
    if ((++_sp & 255u) == 0u) { if (xb_ld(&(bar)[XB_TMO])) break; if (_sp > XB_SPIN_CAP) { atomicAdd(&(bar)[XB_TMO], 1u); break; } } } } while (0)
struct XcdBarrier { unsigned* bar; unsigned x; volatile LAS unsigned* st; };
__device__ __forceinline__ XcdBarrier xcd_barrier_post(unsigned* bar, volatile LAS unsigned* st) {
    XcdBarrier b; b.bar = bar; b.x = xb_xcc_id(); b.st = st;
    if (threadIdx.x == 0) (void)xb_add(&bar[XB_XCNT(b.x)], 1u);
    return b;
}
__device__ __forceinline__ void xcd_barrier_complete(unsigned* bar, unsigned x, unsigned& nloc, unsigned& nx) {
    const unsigned G = gridDim.x * gridDim.y * gridDim.z;
    unsigned sum, cnt, mine, sp = 0u;
    for (;;) {
        sum = 0u; cnt = 0u; mine = 0u;
#pragma unroll
        for (unsigned j = 0; j < 16; ++j) { const unsigned c = xb_ld(&bar[XB_XCNT(j)]); sum += c; cnt += (c > 0u) ? 1u : 0u; mine = (j == x) ? c : mine; }
        if (sum == G) break;
        __builtin_amdgcn_s_sleep(1);
        if ((++sp & 255u) == 0u) { if (xb_ld(&bar[XB_TMO])) break; if (sp > XB_SPIN_CAP) { atomicAdd(&bar[XB_TMO], 1u); break; } }
    }
    nloc = mine > 0u ? mine : 1u; nx = cnt > 0u ? cnt : 1u;
}
__device__ __forceinline__ void xcd_barrier(const XcdBarrier& b) {
    asm volatile("s_waitcnt vmcnt(0)" ::: "memory");
    __syncthreads();
    if (threadIdx.x == 0) {
        unsigned* bar = b.bar;
        __builtin_amdgcn_s_waitcnt(0);
        unsigned nloc = b.st[0], nx = b.st[1];
        if (nloc == 0u) { xcd_barrier_complete(bar, b.x, nloc, nx); b.st[0] = nloc; b.st[1] = nx; }
        const unsigned old = xb_add(&bar[XB_XSUB(b.x)], 1u);
        const unsigned gen = old / nloc;
        if (old + 1u == (gen + 1u) * nloc) {
            __builtin_amdgcn_fence(__ATOMIC_RELEASE, "agent");
            asm volatile("s_waitcnt vmcnt(0)" ::: "memory");
            const unsigned og = xb_add(&bar[XB_TOP], 1u);
            const unsigned tg = og / nx;
            if (og + 1u == (tg + 1u) * nx) xb_add(&bar[XB_TOPGEN], 1u);
            else XB_SPIN(xb_ld(&bar[XB_TOPGEN]) == tg, bar);
            __builtin_amdgcn_fence(__ATOMIC_ACQUIRE, "agent");
            xb_add(&bar[XB_XGEN(b.x)], 1u);
            asm volatile("s_waitcnt vmcnt(0)" ::: "memory");
        } else {
            XB_SPIN(xb_ld(&bar[XB_XGEN(b.x)]) == gen, bar);
            __builtin_amdgcn_fence(__ATOMIC_ACQUIRE, "agent");
            asm volatile("s_waitcnt vmcnt(0)" ::: "memory");
        }
    }
    __syncthreads();
}
#define LDS_WAIT() asm volatile("s_waitcnt lgkmcnt(0)" ::: "memory")
__device__ __forceinline__ unsigned pk2(float lo, float hi) { return (unsigned)f2bf(lo) | ((unsigned)f2bf(hi) << 16); }

template <int CTRL> __device__ __forceinline__ float dppf(float v) { return __builtin_bit_cast(float, __builtin_amdgcn_update_dpp(0, __builtin_bit_cast(int, v), CTRL, 0xf, 0xf, true)); }
__device__ __forceinline__ float sum_swap32(float a, float b) { auto r = __builtin_amdgcn_permlane32_swap(__float_as_uint(a), __float_as_uint(b), false, false); return __uint_as_float(r[0]) + __uint_as_float(r[1]); }
__device__ __forceinline__ float sum_swap16(float a, float b) { auto r = __builtin_amdgcn_permlane16_swap(__float_as_uint(a), __float_as_uint(b), false, false); return __uint_as_float(r[0]) + __uint_as_float(r[1]); }
__device__ __forceinline__ float wsum(float v) {
    v += dppf<0xB1>(v); v += dppf<0x4E>(v); v += dppf<0x141>(v); v += dppf<0x140>(v);
    v = sum_swap16(v, v); v = sum_swap32(v, v); return v;
}
__device__ __forceinline__ float multi_reduce16(const float (&a)[16], int lane) {
    float b[8], c[4], d[2], e;
#pragma unroll
    for (int i = 0; i < 8; ++i) b[i] = sum_swap32(a[i], a[i + 8]);
#pragma unroll
    for (int i = 0; i < 4; ++i) c[i] = sum_swap16(b[i], b[i + 4]);
    { const bool hi = (lane & 8) != 0;
#pragma unroll
      for (int i = 0; i < 2; ++i) { const float send = hi ? c[i] : c[i + 2], keep = hi ? c[i + 2] : c[i]; d[i] = keep + dppf<0x140>(send); } }
    { const bool hi = (lane & 4) != 0; const float send = hi ? d[0] : d[1], keep = hi ? d[1] : d[0]; e = keep + dppf<0x141>(send); }
    e += dppf<0x4E>(e); e += dppf<0xB1>(e);
    return e;
}

__device__ __forceinline__ void row_dots16x2(const f32x4 (&v0)[4], const f32x4 (&v1)[4], const LAS float* WT, int lane, float& r0, float& r1) {
    float a0[16], a1[16];
    const LAS float* wl = WT + 4 * lane; asm volatile("" : "+v"(wl));
    f32x4 wa[8], wb[8];
#pragma unroll
    for (int q = 0; q < 8; ++q) wa[q] = *(const LAS f32x4*)(wl + (q >> 2) * D + 256 * (q & 3));
#pragma unroll
    for (int g = 0; g < 8; ++g) {
        if (g + 1 < 8) {
#pragma unroll
            for (int q = 0; q < 8; ++q) { const f32x4 w = *(const LAS f32x4*)(wl + (2 * (g + 1) + (q >> 2)) * D + 256 * (q & 3)); if (g & 1) wa[q] = w; else wb[q] = w; } }
#pragma unroll
        for (int h = 0; h < 2; ++h) { float x = 0.f, y = 0.f;
#pragma unroll
            for (int j = 0; j < 4; ++j) { const f32x4 w = (g & 1) ? wb[4 * h + j] : wa[4 * h + j];
                x += v0[j][0] * w[0] + v0[j][1] * w[1] + v0[j][2] * w[2] + v0[j][3] * w[3]; y += v1[j][0] * w[0] + v1[j][1] * w[1] + v1[j][2] * w[2] + v1[j][3] * w[3]; }
            a0[2 * g + h] = x; a1[2 * g + h] = y; }
        asm volatile("" : "+v"(a0[2 * g]), "+v"(a0[2 * g + 1]), "+v"(a1[2 * g]), "+v"(a1[2 * g + 1]));
    }
    r0 = multi_reduce16(a0, lane); r1 = multi_reduce16(a1, lane);
}
struct TItem { const float* src; bf16* WT; int K, ncols, n0, k0, kind, aux; bool ok; };
__device__ __forceinline__ int titem_dstrow(const TItem& t, int c) {
    switch (t.kind) {
        case 0: return 256 * (c >> 7) + perm8(c & 127);
        case 1: return 256 * (c >> 7) + 128 + perm8(c & 127);
        case 2: return perm8(c);
        case 3: { if (c >= 1536 && c < 1552) return -1; const int L = c < 1536 ? c : c - 16; return perm8(L); }
        case 4: { if (c < 768) return (c & ~255) + head64(c & 255); return perm8(1536 + c); }
        case 5: { if (c < 768) { const int L = 768 + c; return (L & ~255) + head64(L & 255); } if (c < 1536) return perm8(768 + c); return -1; }
        default: return perm8(t.aux * 512 + c);
    }
}
__device__ __forceinline__ void titem_load(const TItem& t, float (&r)[32]) {
#pragma unroll
    for (int i = 0; i < 32; ++i) r[i] = t.ok ? t.src[(size_t)(2 * i) * t.ncols] : 0.f;
}
__device__ __forceinline__ void titem_store(const TItem& t, const float (&r)[32], LAS float* scr, int lane) {
#pragma unroll
    for (int i = 0; i < 32; ++i) scr[(2 * i + (lane >> 5)) * 33 + (lane & 31)] = r[i];
    LDS_WAIT(); asm volatile("" ::: "memory");
    const int c = lane & 7;
#pragma unroll
    for (int j = 0; j < 4; ++j) { const int n = (lane >> 3) + 8 * j; const LAS float* s = scr + (8 * c) * 33 + n;
        u32x4 o; o.x = cvt_pk_bf16(s[0 * 33], s[1 * 33]); o.y = cvt_pk_bf16(s[2 * 33], s[3 * 33]); o.z = cvt_pk_bf16(s[4 * 33], s[5 * 33]); o.w = cvt_pk_bf16(s[6 * 33], s[7 * 33]);
        const int dr = (t.n0 + n) < t.ncols ? titem_dstrow(t, t.n0 + n) : -1;
        if (dr >= 0) *(u32x4*)(t.WT + (size_t)dr * t.K + t.k0 + 8 * c) = o; }
    LDS_WAIT(); asm volatile("" ::: "memory");
}
struct Params { const float* in[22]; float* out; unsigned char* ws; int ph_lo, ph_hi, bar_li, pad; };
enum { I_X = 0, I_MEM, I_WINA, I_WGUP, I_BGATE, I_GLAG, I_WINB, I_QNG, I_WKV, I_BFORGET, I_KNG, I_WMKV, I_WOUT, I_LMG, I_LMB, I_LFG, I_LFB, I_WR, I_BR, I_WEG, I_WEU, I_WED };
constexpr int CW_BAR = 4096;

typedef const __attribute__((address_space(4))) Params* KP;
__device__ __forceinline__ KP fresh_kp() { KP q = (KP)__builtin_amdgcn_kernarg_segment_ptr(); asm volatile("" : "+s"(q)); return q; }

constexpr int CV_STATIC = 3 * 512 + 176 + 112 + 96 + 64 + 128, CV_QUEUE = 3 * 512;
constexpr int CV_A_STATIC = 576, CV_NSTAT = CV_A_STATIC + (CV_STATIC - 1536), CV_QA = 1536 - CV_A_STATIC;
constexpr int CW_CVQ = 1040, CW_CVQA = 1056;
__device__ __forceinline__ void cv_decode(KP p, unsigned char* ws, int it, int lane, int wave, TItem& t) {
    int r = it; const float* W; int nblk, q, l = 0; t.aux = 0;
    if (r >= CV_STATIC) { r -= CV_STATIC; l = 1; }
    else if (r >= 1536) { r -= 1536;
        if (r < 176) { q = r; W = p->in[I_WINA]; t.ncols = A_IN; t.K = D; t.WT = (bf16*)(ws + WS_WA); nblk = 11; t.kind = 3; }
        else if ((r -= 176) < 112) { q = r; W = p->in[I_WINB]; t.ncols = B_IN; t.K = D; t.WT = (bf16*)(ws + WS_WB); nblk = 7; t.kind = 4; }
        else if ((r -= 112) < 96) { q = r; W = p->in[I_WKV]; t.ncols = KV_IN; t.K = D; t.WT = (bf16*)(ws + WS_WB); nblk = 6; t.kind = 5; }
        else if ((r -= 96) < 64) { const int lm = r / 32; q = r % 32; W = p->in[I_WMKV] + (size_t)lm * D * 512; t.ncols = 512; t.K = D; t.WT = (bf16*)(ws + WS_WMKV); nblk = 2; t.kind = 6; t.aux = lm; }
        else { r -= 64; const int lo = r / 64; q = r % 64; W = p->in[I_WOUT] + (size_t)lo * D * D; t.ncols = D; t.K = D; t.WT = (bf16*)(ws + WS_WO) + (size_t)lo * D * D; nblk = 4; t.kind = 2; }
        goto done; }
    if (r < 512) { const int mat = 16 * l + r / 32; q = r % 32; W = p->in[I_WEG] + (size_t)mat * D * DEXP; t.ncols = DEXP; t.K = D; t.WT = (bf16*)(ws + WS_WGU) + (size_t)mat * 1024 * D; nblk = 2; t.kind = 0; }
    else if ((r -= 512) < 512) { const int mat = 16 * l + r / 32; q = r % 32; W = p->in[I_WEU] + (size_t)mat * D * DEXP; t.ncols = DEXP; t.K = D; t.WT = (bf16*)(ws + WS_WGU) + (size_t)mat * 1024 * D; nblk = 2; t.kind = 1; }
    else { r -= 512; const int mat = 16 * l + r / 32; q = r % 32; W = p->in[I_WED] + (size_t)mat * DEXP * D; t.ncols = D; t.K = DEXP; t.WT = (bf16*)(ws + WS_WD) + (size_t)mat * D * DEXP; nblk = 4; t.kind = 2; }
done:
    t.k0 = 64 * (q / nblk); t.n0 = 256 * (q % nblk);
    const int col = t.n0 + 4 * lane; t.ok = col < t.ncols;
    t.src = W + (size_t)(t.k0 + 8 * wave) * t.ncols + (t.ok ? col : 0);
}
#define CV_TLOAD(t, r) do { _Pragma("unroll") for (int i = 0; i < 8; ++i) r[i] = t.ok ? *(const f32x4*)(t.src + (size_t)i * t.ncols) : (f32x4){0.f, 0.f, 0.f, 0.f}; } while (0)
#define CV_TSTORE(t, r) do { __syncthreads(); \
        _Pragma("unroll") for (int i = 0; i < 8; ++i) { LAS float* d_ = T + (8 * wave + i) * 257 + 4 * lane; d_[0] = r[i][0]; d_[1] = r[i][1]; d_[2] = r[i][2]; d_[3] = r[i][3]; } \
        __syncthreads(); \
        const int c_ = lane & 7; \
        _Pragma("unroll") for (int j = 0; j < 4; ++j) { const int n_ = 32 * wave + (lane >> 3) + 8 * j; const LAS float* s_ = T + (8 * c_) * 257 + n_; \
            u32x4 o_; o_.x = cvt_pk_bf16(s_[0 * 257], s_[1 * 257]); o_.y = cvt_pk_bf16(s_[2 * 257], s_[3 * 257]); o_.z = cvt_pk_bf16(s_[4 * 257], s_[5 * 257]); o_.w = cvt_pk_bf16(s_[6 * 257], s_[7 * 257]); \
            const int dr_ = (t.n0 + n_) < t.ncols ? titem_dstrow(t, t.n0 + n_) : -1; \
            if (dr_ >= 0) *(u32x4*)(t.WT + (size_t)dr_ * t.K + t.k0 + 8 * c_) = o_; } } while (0)
__device__ __forceinline__ void convert_static(KP p, unsigned char* ws, LAS unsigned char* lds, int lane, int wave, int G, int bid) {
    LAS float* T = (LAS float*)lds;
    TItem ta; f32x4 ra[8], rb[8];
#define CV_SID(s) ((s) < CV_A_STATIC ? (s) : 1536 + ((s) - CV_A_STATIC))
    int it = bid;
    if (it < CV_NSTAT) { cv_decode(p, ws, CV_SID(it), lane, wave, ta); CV_TLOAD(ta, ra); }
#pragma unroll 1
    for (; it < CV_NSTAT; it += 2 * G) {
        TItem tb; const bool hb = it + G < CV_NSTAT;
        if (hb) { cv_decode(p, ws, CV_SID(it + G), lane, wave, tb); CV_TLOAD(tb, rb); }
        CV_TSTORE(ta, ra);
        if (it + 2 * G < CV_NSTAT) { cv_decode(p, ws, CV_SID(it + 2 * G), lane, wave, ta); CV_TLOAD(ta, ra); }
        if (hb) CV_TSTORE(tb, rb);
    }
#undef CV_SID
    __syncthreads();
}
__device__ __forceinline__ void convert_from_queue(KP p, LAS unsigned char* lds, const int wave_s, int budget, const int qword = CW_CVQ, const int qbase = CV_STATIC, const int qcount = CV_QUEUE) {
    unsigned char* ws = p->ws; LAS float* T = (LAS float*)lds;
    const int tid = fresh_tid(wave_s), lane = tid & 63, wave = wave_s;
    unsigned* qh = (unsigned*)(ws + WS_CTL) + qword; volatile LAS unsigned* slotw = (volatile LAS unsigned*)(lds + MISC_OFF) + 56;
    for (int n = 0; budget < 0 || n < budget; ++n) {
        if (tid == 0) slotw[0] = __hip_atomic_fetch_add(qh, 1u, __ATOMIC_RELAXED, __HIP_MEMORY_SCOPE_AGENT);
        __syncthreads();
        const int q = (int)__builtin_amdgcn_readfirstlane(slotw[0]);
        if (q >= qcount) break;
        TItem t; f32x4 r[8]; cv_decode(p, ws, qbase + q, lane, wave, t); CV_TLOAD(t, r); CV_TSTORE(t, r);
        __syncthreads();
    }
    __syncthreads();
}
__device__ __forceinline__ void phase_prologue(KP p, LAS unsigned char* lds, int G, int bid, const int wave_s) {
    const int tid = fresh_tid(wave_s), lane = tid & 63, wave = wave_s;
    unsigned char* ws = p->ws;
    LAS float* scr = (LAS float*)(lds + wave * 8448);
    const int gw = bid * NWAVES + wave, NGW = G * NWAVES;
    constexpr int NB_A = 81, NB_B = 56, NB_KV = 48;
    constexpr int I_G = 32 * 16 * 16, I_U = I_G, I_D = 32 * 8 * 32, I_A = 16 * NB_A, I_B = 16 * NB_B, I_KV = 16 * NB_KV, I_MK = 2 * 16 * 16, I_O = 2 * 16 * 32;
    constexpr int NITEMS = I_G + I_U + I_D + I_A + I_B + I_KV + I_MK + I_O;
    auto decode = [&](int it, TItem& t) {
        int r = it; const float* W; int nblk, q; t.aux = 0;
        if (r < I_G) { const int mat = r / 256; q = r % 256; W = p->in[I_WEG] + (size_t)mat * D * DEXP; t.ncols = DEXP; t.K = D; t.WT = (bf16*)(ws + WS_WGU) + (size_t)mat * 1024 * D; nblk = 16; t.kind = 0; }
        else if ((r -= I_G) < I_U) { const int mat = r / 256; q = r % 256; W = p->in[I_WEU] + (size_t)mat * D * DEXP; t.ncols = DEXP; t.K = D; t.WT = (bf16*)(ws + WS_WGU) + (size_t)mat * 1024 * D; nblk = 16; t.kind = 1; }
        else if ((r -= I_U) < I_D) { const int mat = r / 256; q = r % 256; W = p->in[I_WED] + (size_t)mat * DEXP * D; t.ncols = D; t.K = DEXP; t.WT = (bf16*)(ws + WS_WD) + (size_t)mat * D * DEXP; nblk = 32; t.kind = 2; }
        else if ((r -= I_D) < I_A) { q = r; W = p->in[I_WINA]; t.ncols = A_IN; t.K = D; t.WT = (bf16*)(ws + WS_WA); nblk = NB_A; t.kind = 3; }
        else if ((r -= I_A) < I_B) { q = r; W = p->in[I_WINB]; t.ncols = B_IN; t.K = D; t.WT = (bf16*)(ws + WS_WB); nblk = NB_B; t.kind = 4; }
        else if ((r -= I_B) < I_KV) { q = r; W = p->in[I_WKV]; t.ncols = KV_IN; t.K = D; t.WT = (bf16*)(ws + WS_WB); nblk = NB_KV; t.kind = 5; }
        else if ((r -= I_KV) < I_MK) { const int l = r / 256; q = r % 256; W = p->in[I_WMKV] + (size_t)l * D * 512; t.ncols = 512; t.K = D; t.WT = (bf16*)(ws + WS_WMKV); nblk = 16; t.kind = 6; t.aux = l; }
        else { r -= I_MK; const int l = r / 512; q = r % 512; W = p->in[I_WOUT] + (size_t)l * D * D; t.ncols = D; t.K = D; t.WT = (bf16*)(ws + WS_WO) + (size_t)l * D * D; nblk = 32; t.kind = 2; }
        t.k0 = 64 * (q / nblk); t.n0 = 32 * (q % nblk);
        const int col = t.n0 + (lane & 31); t.ok = col < t.ncols;
        t.src = W + (size_t)(t.k0 + (lane >> 5)) * t.ncols + (t.ok ? col : 0);
    };
    { PSEC_BEGIN(20); convert_static(p, ws, lds, lane, wave, G, bid); PSEC_END(20); }
    { const f32x4* src = (const f32x4*)p->in[I_MEM]; u32x2* dst = (u32x2*)(ws + WS_MEMB);
      for (int i = bid * NTHREADS + tid; i < NB * NMEM * D / 4; i += G * NTHREADS) { const f32x4 v = src[i]; u32x2 o; o.x = pk2(v[0], v[1]); o.y = pk2(v[2], v[3]); dst[i] = o; } }
    __syncthreads();
    LAS float* WG = (LAS float*)(lds);
    for (int idx = tid; idx < 16 * D; idx += NTHREADS) { const int j = idx & 15, k = idx >> 4; WG[j * D + k] = p->in[I_WINA][(size_t)k * A_IN + 1536 + j]; }
    __syncthreads();
    bf16* XB = (bf16*)(ws + WS_XB); float* GLR = (float*)(ws + WS_GLR);
    { PSEC_BEGIN(22);
    {   f32x4 a0[4], a1[4], b0[4], b1[4];
#define P0_LOAD(va, vb, mm) do { const f32x4* xr_ = (const f32x4*)(p->in[I_X] + (size_t)(mm) * D) + lane; _Pragma("unroll") for (int j = 0; j < 4; ++j) { va[j] = xr_[64 * j]; vb[j] = xr_[64 * j + 256]; } } while (0)
#define P0_PROC(va, vb, mm) do { u32x2* o8_ = (u32x2*)(XB + (size_t)(mm) * D) + lane; \
            _Pragma("unroll") for (int j = 0; j < 4; ++j) { u32x2 o; o.x = cvt_pk_bf16(va[j][0], va[j][1]); o.y = cvt_pk_bf16(va[j][2], va[j][3]); o8_[64 * j] = o; o.x = cvt_pk_bf16(vb[j][0], vb[j][1]); o.y = cvt_pk_bf16(vb[j][2], vb[j][3]); o8_[64 * j + 256] = o; } \
            float r0_, r1_; row_dots16x2(va, vb, WG, lane, r0_, r1_); \
            if ((lane & 3) == 0) { GLR[(size_t)(mm) * 16 + (lane >> 2)] = r0_; GLR[(size_t)((mm) + 1) * 16 + (lane >> 2)] = r1_; } } while (0)
        int m = 2 * gw;
        if (m < NTOK) P0_LOAD(a0, a1, m);
#pragma unroll 1
        for (; m < NTOK; m += 4 * NGW) {
            const bool hb = m + 2 * NGW < NTOK;
            if (hb) P0_LOAD(b0, b1, m + 2 * NGW);
            P0_PROC(a0, a1, m);
            if (m + 4 * NGW < NTOK) P0_LOAD(a0, a1, m + 4 * NGW);
            if (hb) P0_PROC(b0, b1, m + 2 * NGW);
        }
#undef P0_LOAD
#undef P0_PROC
    }
    PSEC_END(22); }
}

template <bool RB> struct EpiRes { const void* xres; bf16* out;
    __device__ __forceinline__ void operator()(const f32x4 (&acc)[2][2][4][2], const Unit& u, int wr, int wc, int fr, int fq) const {
        size_t off = (size_t)(u.pm * BM + wr * 64 + fr) * D + (u.pn * BM + wc * 32 + 8 * fq);
#pragma unroll
        for (int ai = 0; ai < 2; ++ai) {
#pragma unroll
            for (int m = 0; m < 4; ++m) {
#pragma unroll
                for (int bj = 0; bj < 2; ++bj) { f32x4 x0, x1;
                    if (RB) { const u32x4 t = *(const u32x4*)((const bf16*)xres + off + bj * HALF); x0[0] = __uint_as_float(t.x << 16); x0[1] = __uint_as_float(t.x & 0xffff0000u); x0[2] = __uint_as_float(t.y << 16); x0[3] = __uint_as_float(t.y & 0xffff0000u);
                        x1[0] = __uint_as_float(t.z << 16); x1[1] = __uint_as_float(t.z & 0xffff0000u); x1[2] = __uint_as_float(t.w << 16); x1[3] = __uint_as_float(t.w & 0xffff0000u); }
                    else { x0 = *(const f32x4*)((const float*)xres + off + bj * HALF); x1 = *(const f32x4*)((const float*)xres + off + bj * HALF + 4); }
                    const f32x4 v0 = x0 * DN_ALPHA + acc[ai][bj][m][0], v1 = x1 * DN_ALPHA + acc[ai][bj][m][1];
                    u32x4 w; w.x = cvt_pk_bf16(v0[0], v0[1]); w.y = cvt_pk_bf16(v0[2], v0[3]); w.z = cvt_pk_bf16(v1[0], v1[1]); w.w = cvt_pk_bf16(v1[2], v1[3]);
                    *(u32x4*)(out + off + bj * HALF) = w; }
                off += (size_t)16 * D; asm volatile("" : "+v"(off) :: "memory"); }
            off += (size_t)64 * D; }
    } };
struct EpiInB { bf16 *Q, *K, *V, *OG, *MQ; const float* qg; const float* kg;
    __device__ __forceinline__ void operator()(const f32x4 (&acc)[2][2][4][2], const Unit& u, int wr, int wc, int fr, int fq) const {
        const int pn = u.pn;
        if (pn >= 6) { bf16* base; int ldd, c0;
            if (pn < 9) { base = V; ldd = 768; c0 = (pn - 6) * 256; } else if (pn < 12) { base = OG; ldd = 768; c0 = (pn - 9) * 256; } else { base = MQ; ldd = 256; c0 = 0; }
            store_bf16_tile(acc, base, ldd, u.pm * BM, c0, wr, wc, fr, fq); return; }
        const bool isq = pn < 3; bf16* base = isq ? Q : K; const float* g = isq ? qg : kg; const float sc = isq ? QC2 : 1.0f;
        const int c0 = (isq ? pn : pn - 3) * 256 + wc * 64 + 8 * fq, r0 = u.pm * BM + wr * 64 + fr;
        f32x4 gv[2][2];
#pragma unroll
        for (int bj = 0; bj < 2; ++bj)
#pragma unroll
            for (int n = 0; n < 2; ++n) gv[bj][n] = *(const f32x4*)(g + 32 * bj + 8 * fq + 4 * n) * sc;
        bf16* rowp = base + (size_t)r0 * 768 + c0;
#pragma unroll
        for (int ai = 0; ai < 2; ++ai) {
#pragma unroll
            for (int m = 0; m < 4; ++m) {
                float ss = 0.f;
#pragma unroll
                for (int bj = 0; bj < 2; ++bj)
#pragma unroll
                    for (int n = 0; n < 2; ++n) { const f32x4 v = acc[ai][bj][m][n]; ss += (v[0] * v[0] + v[1] * v[1]) + (v[2] * v[2] + v[3] * v[3]); }
                ss = sum_swap16(ss, ss); ss = sum_swap32(ss, ss);
                const float rs = rsqrtf(ss * (1.f / 64.f) + RMS_EPS);
#pragma unroll
                for (int bj = 0; bj < 2; ++bj) { const f32x4 v0 = acc[ai][bj][m][0] * rs * gv[bj][0], v1 = acc[ai][bj][m][1] * rs * gv[bj][1];
                    u32x4 w; w.x = cvt_pk_bf16(v0[0], v0[1]); w.y = cvt_pk_bf16(v0[2], v0[3]); w.z = cvt_pk_bf16(v1[0], v1[1]); w.w = cvt_pk_bf16(v1[2], v1[3]);
                    *(u32x4*)(rowp + 32 * bj) = w; }
                rowp += (size_t)16 * 768; asm volatile("" : "+v"(rowp)); }
            rowp += (size_t)64 * 768; }
    } };

__device__ __forceinline__ void load_wtab(LAS float* WT, const float* W, int ldw, int col0, int ncols, int tid) {
    for (int idx = tid; idx < 16 * D; idx += NTHREADS) { const int j = idx & 15, k = idx >> 4; WT[j * D + k] = j < ncols ? W[(size_t)k * ldw + col0 + j] : 0.f; }
}
__device__ __forceinline__ float row_dots16(const f32x4 (&v)[4], const LAS float* WT, int lane) {
    float acc[16];
    const LAS float* wl = WT + 4 * lane; asm volatile("" : "+v"(wl));
#pragma unroll
    for (int n = 0; n < 16; ++n) { float a = 0.f;
#pragma unroll
        for (int j = 0; j < 4; ++j) { const f32x4 w = *(const LAS f32x4*)(wl + n * D + 256 * j); a += v[j][0] * w[0] + v[j][1] * w[1] + v[j][2] * w[2] + v[j][3] * w[3]; }
        acc[n] = a; if (n & 1) asm volatile("" : "+v"(acc[n - 1]), "+v"(acc[n]) :: "memory"); }
    return multi_reduce16(acc, lane);
}
__device__ __forceinline__ void ln_row(f32x4 (&v)[4], const float* g, const float* b, int lane) {
    float s = 0.f;
#pragma unroll
    for (int j = 0; j < 4; ++j) s += (v[j][0] + v[j][1]) + (v[j][2] + v[j][3]);
    const float mean = wsum(s) * (1.f / D); float q = 0.f;
#pragma unroll
    for (int j = 0; j < 4; ++j) { v[j] = v[j] - mean; q += (v[j][0] * v[j][0] + v[j][1] * v[j][1]) + (v[j][2] * v[j][2] + v[j][3] * v[j][3]); }
    const float rstd = rsqrtf(wsum(q) * (1.f / D) + LN_EPS);
#pragma unroll
    for (int j = 0; j < 4; ++j) { const f32x4 gg = *(const f32x4*)(g + 4 * lane + 256 * j), bb = *(const f32x4*)(b + 4 * lane + 256 * j); v[j] = v[j] * rstd * gg + bb; }
}
__device__ __forceinline__ void store_row_f32_bf16(const f32x4 (&v)[4], float* xf, bf16* xb, int lane) {
#pragma unroll
    for (int j = 0; j < 4; ++j) { if (xf) ((f32x4*)xf)[lane + 64 * j] = v[j]; if (xb) { u32x2 o; o.x = cvt_pk_bf16(v[j][0], v[j][1]); o.y = cvt_pk_bf16(v[j][2], v[j][3]); ((u32x2*)xb)[lane + 64 * j] = o; } }
}

__device__ __forceinline__ void route_thread(const float (&lg)[16], const float (&brv)[16], int m, int lt, int* TOK_E, float* TOK_W, LAS int* tokE) {
    float aff[16], sel[16];
#pragma unroll
    for (int e = 0; e < 16; ++e) { aff[e] = 1.f / (1.f + __expf(-lg[e])); sel[e] = aff[e] + brv[e]; }
    int gbest = 0; float gs = -1e30f;
#pragma unroll
    for (int gi = 0; gi < 4; ++gi) { float a = -1e30f, b2 = -1e30f;
#pragma unroll
        for (int j = 0; j < 4; ++j) { const float x = sel[gi * 4 + j]; const bool gt = x > a; b2 = gt ? a : fmaxf(b2, x); a = gt ? x : a; }
        const bool better = a + b2 > gs; gs = better ? a + b2 : gs; gbest = better ? gi : gbest; }
    int i0 = 0, i1 = 0; float a = -1e30f, b2 = -1e30f, wa = 0.f, wb = 0.f;
#pragma unroll
    for (int j = 0; j < 4; ++j) { float x = sel[j], y = aff[j];
#pragma unroll
        for (int gi = 1; gi < 4; ++gi) { x = (gi == gbest) ? sel[gi * 4 + j] : x; y = (gi == gbest) ? aff[gi * 4 + j] : y; }
        const bool g1 = x > a, g2 = x > b2;
        const float nb = g1 ? a : (g2 ? x : b2), nwb = g1 ? wa : (g2 ? y : wb); const int ni1 = g1 ? i0 : (g2 ? j : i1);
        a = g1 ? x : a; wa = g1 ? y : wa; i0 = g1 ? j : i0; b2 = nb; wb = nwb; i1 = ni1; }
    const float inv = 1.f / (wa + wb); const int e0 = gbest * 4 + i0, e1 = gbest * 4 + i1;
    TOK_E[m * 2] = e0; TOK_E[m * 2 + 1] = e1; TOK_W[m * 2] = wa * inv; TOK_W[m * 2 + 1] = wb * inv; tokE[lt * 2] = e0; tokE[lt * 2 + 1] = e1;
}
__device__ __forceinline__ void phase_ln_router(KP p, int layer, LAS unsigned char* lds, int G, int bid, const int wave_s) {
    const int tid = fresh_tid(wave_s), lane = tid & 63, wave = wave_s;
    PSEC_BEGIN(0);
    unsigned char* ws = p->ws;
    LAS float* WT = (LAS float*)lds; LAS int* tokE = (LAS int*)(lds + 65536);
    load_wtab(WT, p->in[I_WR], 16, 0, 16, tid);
    __syncthreads();
    const bf16* Y1 = (const bf16*)p->out; bf16* XB = (bf16*)(ws + WS_XB); int* TOK_E = (int*)(ws + WS_TOKE); float* TOK_W = (float*)(ws + WS_TOKW); int* CNT = (int*)(ws + WS_CNT); int* SLOT_TOK = (int*)(ws + WS_SLOTTOK);
    const float* g = p->in[I_LMG] + layer * D; const float* b = p->in[I_LMB] + layer * D;
#define LNR_LOAD(va, vb, pr) do { const u32x2* s0_ = (const u32x2*)(Y1 + (size_t)(tb * 128 + wave * 16 + 2 * (pr)) * D) + lane; _Pragma("unroll") for (int j = 0; j < 4; ++j) { const u32x2 a_ = s0_[64 * j], b_ = s0_[64 * j + 256]; \
        va[j][0] = __uint_as_float(a_.x << 16); va[j][1] = __uint_as_float(a_.x & 0xffff0000u); va[j][2] = __uint_as_float(a_.y << 16); va[j][3] = __uint_as_float(a_.y & 0xffff0000u); \
        vb[j][0] = __uint_as_float(b_.x << 16); vb[j][1] = __uint_as_float(b_.x & 0xffff0000u); vb[j][2] = __uint_as_float(b_.y << 16); vb[j][3] = __uint_as_float(b_.y & 0xffff0000u); } } while (0)
#define LNR_PROC(va, vb, pr) do { const int lt_ = wave * 16 + 2 * (pr), m_ = tb * 128 + lt_; \
        { PSEC_BEGIN(1); ln_row(va, g, b, lane); ln_row(vb, g, b, lane); \
        store_row_f32_bf16(va, (float*)nullptr, XB + (size_t)m_ * D, lane); store_row_f32_bf16(vb, (float*)nullptr, XB + (size_t)(m_ + 1) * D, lane); PSEC_END(1); } \
        float l0_, l1_; { PSEC_BEGIN(2); row_dots16x2(va, vb, WT, lane, l0_, l1_); asm volatile("" : "+v"(l0_), "+v"(l1_)); PSEC_END(2); } \
        if ((lane & 3) == 0) { LG[lt_ * 16 + (lane >> 2)] = l0_; LG[(lt_ + 1) * 16 + (lane >> 2)] = l1_; } } while (0)
    LAS float* LG = (LAS float*)(lds + 65536 + 1024);
    for (int tb = bid; tb < NTOK / 128; tb += G) {
        f32x4 a0[4], a1[4], b0[4], b1[4];
        LNR_LOAD(a0, a1, 0);
#pragma unroll 1
        for (int pr = 0; pr < 8; pr += 2) {
            LNR_LOAD(b0, b1, pr + 1);
            LNR_PROC(a0, a1, pr);
            if (pr + 2 < 8) LNR_LOAD(a0, a1, pr + 2);
            LNR_PROC(b0, b1, pr + 1);
        }
        __syncthreads();
        if (tid < 128) { PSEC_BEGIN(3); float lg[16], brv[16];
#pragma unroll
            for (int q = 0; q < 4; ++q) { const f32x4 t4 = *(const LAS f32x4*)(LG + tid * 16 + 4 * q); const f32x4 b4 = *(const f32x4*)(p->in[I_BR] + 4 * q);
#pragma unroll
                for (int j = 0; j < 4; ++j) { lg[4 * q + j] = t4[j]; brv[4 * q + j] = b4[j]; } }
            route_thread(lg, brv, tb * 128 + tid, tid, TOK_E, TOK_W, tokE); PSEC_END(3); }
        __syncthreads();
        if (tid < 256) {
            const int e = tokE[tid]; int rank = 0;
            for (int i = 0; i < tid; ++i) rank += (tokE[i] == e) ? 1 : 0;
            SLOT_TOK[(e * 256 + tb) * 128 + rank] = tb * 256 + tid;
        } else if (tid < 272) { const int e = tid - 256; int c = 0; for (int i = 0; i < 256; ++i) c += (tokE[i] == e) ? 1 : 0; CNT[tb * 16 + e] = c; }
        __syncthreads();
    }
    PSEC_END(0);
#undef LNR_LOAD
#undef LNR_PROC
}
struct FfnRow { u32x2 x[4], ya[4], yc[4]; float w0, w1; };
__device__ __forceinline__ void ffn_combine(FfnRow& r, f32x4 (&v)[4]) {
#pragma unroll
    for (int j = 0; j < 4; ++j) { const u32x2 a = r.ya[j], c = r.yc[j]; f32x4 ya, yc;
        ya[0] = __uint_as_float(a.x << 16); ya[1] = __uint_as_float(a.x & 0xffff0000u); ya[2] = __uint_as_float(a.y << 16); ya[3] = __uint_as_float(a.y & 0xffff0000u);
        yc[0] = __uint_as_float(c.x << 16); yc[1] = __uint_as_float(c.x & 0xffff0000u); yc[2] = __uint_as_float(c.y << 16); yc[3] = __uint_as_float(c.y & 0xffff0000u);
        const u32x2 xx = r.x[j]; f32x4 xv; xv[0] = __uint_as_float(xx.x << 16); xv[1] = __uint_as_float(xx.x & 0xffff0000u); xv[2] = __uint_as_float(xx.y << 16); xv[3] = __uint_as_float(xx.y & 0xffff0000u);
        v[j] = xv * DN_ALPHA + ya * r.w0 + yc * r.w1; }
}
__device__ __forceinline__ void phase_ln_ffn(KP p, int layer, LAS unsigned char* lds, int G, int bid, const int wave_s) {
    const int tid = fresh_tid(wave_s), lane = tid & 63, wave = wave_s;
    unsigned char* ws = p->ws;
    LAS float* WT = (LAS float*)lds;
    if (layer == 0) { load_wtab(WT, p->in[I_WKV], KV_IN, 1536, 12, tid); __syncthreads(); }
    const int eo = (lane >> 2) & 15; const float bf = (layer == 0 && eo < 12) ? p->in[I_BFORGET][eo] : 0.f;
    float* XF = p->out; bf16* XB = (bf16*)(ws + WS_XB); const bf16* YS = (const bf16*)(ws + WS_HREG);
    const int* TOK_S = (const int*)(ws + WS_TOKS); const float* TOK_W = (const float*)(ws + WS_TOKW); float* LOGF = (float*)(ws + WS_LOGF);
    const float* g = p->in[I_LFG] + layer * D; const float* b = p->in[I_LFB] + layer * D;
    const int gw = bid * NWAVES + wave, NGW = G * NWAVES;
#define FFN_LOAD(R, m_) do { const int mm_ = (m_); int mv_ = mm_ * 2; asm volatile("" : "+v"(mv_));        \
        const int s0_ = TOK_S[mv_], s1_ = TOK_S[mv_ + 1]; R.w0 = TOK_W[mv_]; R.w1 = TOK_W[mv_ + 1]; \
        _Pragma("unroll") for (int j = 0; j < 4; ++j) { R.x[j] = ((const u32x2*)(XB + (size_t)mm_ * D))[lane + 64 * j]; R.ya[j] = ((const u32x2*)(YS + (size_t)s0_ * D))[lane + 64 * j]; R.yc[j] = ((const u32x2*)(YS + (size_t)s1_ * D))[lane + 64 * j]; } } while (0)
#define FFN_PROC(R, m_) do { const int mm_ = (m_); f32x4 v_[4]; ffn_combine(R, v_); ln_row(v_, g, b, lane); \
        store_row_f32_bf16(v_, layer == 0 ? (float*)nullptr : XF + (size_t)mm_ * D, layer == 0 ? XB + (size_t)mm_ * D : (bf16*)nullptr, lane); \
        if (layer == 0) { const float t_ = row_dots16(v_, WT, lane); if ((lane & 3) == 0 && eo < 12) LOGF[(size_t)mm_ * 12 + eo] = log_sigmoid(t_ + bf); } } while (0)
    FfnRow A0, A1, B0, B1;
#define FFN_PROC2(R0, R1, m0_, m1_) do { const int ma_ = (m0_), mb_ = (m1_); f32x4 va_[4], vb_[4]; ffn_combine(R0, va_); ffn_combine(R1, vb_); ln_row(va_, g, b, lane); ln_row(vb_, g, b, lane); \
        store_row_f32_bf16(va_, layer == 0 ? (float*)nullptr : XF + (size_t)ma_ * D, layer == 0 ? XB + (size_t)ma_ * D : (bf16*)nullptr, lane); \
        store_row_f32_bf16(vb_, layer == 0 ? (float*)nullptr : XF + (size_t)mb_ * D, layer == 0 ? XB + (size_t)mb_ * D : (bf16*)nullptr, lane); \
        if (layer == 0) { float ta_, tb_; row_dots16x2(va_, vb_, WT, lane, ta_, tb_); if ((lane & 3) == 0 && eo < 12) { LOGF[(size_t)ma_ * 12 + eo] = log_sigmoid(ta_ + bf); LOGF[(size_t)mb_ * 12 + eo] = log_sigmoid(tb_ + bf); } } } while (0)
    int m = gw;
    if (m + NGW < NTOK) { FFN_LOAD(A0, m); FFN_LOAD(A1, m + NGW); }
#pragma unroll 1
    for (; m + NGW < NTOK; m += 4 * NGW) {
        const bool hb = (m + 3 * NGW) < NTOK;
        if (hb) { FFN_LOAD(B0, m + 2 * NGW); FFN_LOAD(B1, m + 3 * NGW); }
        FFN_PROC2(A0, A1, m, m + NGW);
        if (m + 5 * NGW < NTOK) { FFN_LOAD(A0, m + 4 * NGW); FFN_LOAD(A1, m + 5 * NGW); }
        if (hb) FFN_PROC2(B0, B1, m + 2 * NGW, m + 3 * NGW); else { m += 2 * NGW; break; }
    }
    if (m < NTOK) { FFN_LOAD(A0, m); FFN_PROC(A0, m); }
#undef FFN_PROC2
#undef FFN_LOAD
#undef FFN_PROC
}
__device__ __forceinline__ void cum_wave(const float* LOGF, float* CUM, int bh, int lane) {
    const int b = bh / FOX_H, h = bh % FOX_H;
    float loc[64]; float s = 0.f;
#pragma unroll
    for (int i = 0; i < 64; ++i) { s += LOGF[((size_t)b * SEQ + lane * 64 + i) * 12 + h]; loc[i] = s; }
    float inc = s;
#pragma unroll
    for (int o = 1; o < 64; o <<= 1) { const float t = __shfl_up(inc, o); if (lane >= o) inc += t; }
    const float base = inc - s;
#pragma unroll
    for (int i = 0; i < 64; ++i) CUM[(size_t)bh * SEQ + lane * 64 + i] = base + loc[i];
}
constexpr int MOE_MAXU = 6;
__device__ __forceinline__ int moe_setup(unsigned char* ws, LAS unsigned char* lds, int G, int bid, const int wave_s, const bool build_rows) {
    const int tid = fresh_tid(wave_s), lane = tid & 63, wave = wave_s;
    LAS int* PRE = (LAS int*)lds; LAS int* TB = (LAS int*)(lds + 16640); LAS int* TE = TB + 17;
    volatile LAS int* UL = (volatile LAS int*)(lds + MISC_OFF) + 16; LAS int* rowtok = (LAS int*)(lds + ROWTOK_OFF);
    const int* CNT = (const int*)(ws + WS_CNT); const int* SLOT_TOK = (const int*)(ws + WS_SLOTTOK); int* TOK_S = (int*)(ws + WS_TOKS);
#pragma unroll
    for (int q = 0; q < 2; ++q) { const int e = 2 * wave + q;
        int c[4]; int s = 0;
#pragma unroll
        for (int i = 0; i < 4; ++i) { c[i] = CNT[(4 * lane + i) * 16 + e]; s += c[i]; }
        int inc = s;
#pragma unroll
        for (int o = 1; o < 64; o <<= 1) { const int t = __shfl_up(inc, o); if (lane >= o) inc += t; }
        int run = inc - s;
#pragma unroll
        for (int i = 0; i < 4; ++i) { PRE[e * 257 + 4 * lane + i] = run; run += c[i]; }
        if (lane == 63) { PRE[e * 257 + 256] = inc; TE[e] = inc; } }
    __syncthreads();
    if (tid <= 16) { int t = 0; for (int e = 0; e < 16; ++e) { if (e < tid) t += (TE[e] + 255) >> 8; } TB[tid] = t; }
    __syncthreads();
    const int NT = TB[16];
    if (tid < MOE_MAXU) { const int L = tid * G + bid, tile = (L & 7) + 8 * (L >> 5), pn = (L >> 3) & 3;
        int e = 0;
#pragma unroll
        for (int k = 1; k < 16; ++k) e += (TB[k] <= tile) ? 1 : 0;
        UL[3 * tid] = tile; UL[3 * tid + 1] = pn; UL[3 * tid + 2] = e; UL[32 + tid] = (tile < NT) ? 1 : 0; }
    __syncthreads();
    if (tid == 0) { int n = 0;
#pragma unroll
        for (int i = 0; i < MOE_MAXU; ++i) n += (int)UL[32 + i]; UL[24] = n; UL[25] = 32 * ((NT + 7) >> 3); }
    __syncthreads();
    const int nunits = __builtin_amdgcn_readfirstlane(UL[24]);
    if (build_rows) {
        for (int i = (tid >> 8); i < nunits; i += 2) { const int tile = UL[3 * i], pn = UL[3 * i + 1], e = UL[3 * i + 2], j = tid & 255;
            const int r = 256 * (tile - TB[e]) + j; int tok = 0;
            if (r < TE[e]) { int lo = 0, hi = 256;
                while (hi - lo > 1) { const int mid = (lo + hi) >> 1; if (PRE[e * 257 + mid] <= r) lo = mid; else hi = mid; }
                const int ent = SLOT_TOK[(e * 256 + lo) * 128 + (r - PRE[e * 257 + lo])]; tok = ent >> 1;
                if (pn == 0) TOK_S[ent] = 256 * tile + j; }
            rowtok[i * 256 + j] = tok; }
    }
    __syncthreads();
    return nunits;
}
struct MoeGU {
    const char* XBp; const char* W; LAS const int* UL; LAS const int* rowtok; int nunits;
    __device__ __forceinline__ bool next(int i, Unit& u) const { if (i >= nunits) return false;
        u.pm = __builtin_amdgcn_readfirstlane(UL[3 * i]); u.pn = __builtin_amdgcn_readfirstlane(UL[3 * i + 1]); u.e = __builtin_amdgcn_readfirstlane(UL[3 * i + 2]); u.ord = i;
        u.A = XBp; u.B = W + ((size_t)u.e * 1024 + (size_t)u.pn * 256) * D * 2; return true; }
    __device__ __forceinline__ unsigned a_off(const Unit& u, int h, int R, int C) const { return (unsigned)(rowtok[u.ord * 256 + R + HALF * h] * D + C) * 2u; }
};
struct MoeDown {
    const char* Hp; const char* W; LAS const int* UL; int nunits;
    __device__ __forceinline__ bool next(int i, Unit& u) const { if (i >= nunits) return false;
        u.pm = __builtin_amdgcn_readfirstlane(UL[3 * i]); u.pn = __builtin_amdgcn_readfirstlane(UL[3 * i + 1]); u.e = __builtin_amdgcn_readfirstlane(UL[3 * i + 2]); u.ord = i;
        u.A = Hp + (size_t)u.pm * BM * DEXP * 2; u.B = W + ((size_t)u.e * 1024 + (size_t)u.pn * 256) * DEXP * 2; return true; }
    __device__ __forceinline__ unsigned a_off(const Unit&, int h, int R, int C) const { return (unsigned)((R + HALF * h) * DEXP + C) * 2u; }
};
struct EpiGateUp { bf16* H;
    __device__ __forceinline__ void operator()(const f32x4 (&acc)[2][2][4][2], const Unit& u, int wr, int wc, int fr, int fq) const {
        bf16* rowp = H + (size_t)(u.pm * BM + wr * 64 + fr) * DEXP + (u.pn * 128 + wc * 32 + 8 * fq);
#pragma unroll
        for (int ai = 0; ai < 2; ++ai) {
#pragma unroll
            for (int m = 0; m < 4; ++m) { float hv[8];
#pragma unroll
                for (int n = 0; n < 2; ++n)
#pragma unroll
                    for (int j = 0; j < 4; ++j) { const float g = acc[ai][0][m][n][j], up = acc[ai][1][m][n][j]; hv[4 * n + j] = g * __builtin_amdgcn_rcpf(1.f + __expf(-g)) * up; }
                u32x4 w; w.x = cvt_pk_bf16(hv[0], hv[1]); w.y = cvt_pk_bf16(hv[2], hv[3]); w.z = cvt_pk_bf16(hv[4], hv[5]); w.w = cvt_pk_bf16(hv[6], hv[7]);
                *(u32x4*)rowp = w;
                rowp += (size_t)16 * DEXP; asm volatile("" : "+v"(rowp)); }
            rowp += (size_t)64 * DEXP; }
    } };
__device__ __forceinline__ int crow(int r, int hi) { return (r & 3) + 8 * (r >> 2) + 4 * hi; }
__device__ __forceinline__ unsigned cvtpk_s(float lo, float hi) { typedef float f2 __attribute__((ext_vector_type(2))); typedef __bf16 b2 __attribute__((ext_vector_type(2))); f2 v = {lo, hi}; b2 b = __builtin_convertvector(v, b2); return __builtin_bit_cast(unsigned, b); }
__device__ __forceinline__ float bfbits2f(unsigned short v) { return __uint_as_float(((unsigned)v) << 16); }

constexpr int AT_NSLOT = 4, AT_SLOT = 16640, AT_K = 0, AT_V = 8192, AT_KB = 16384, AT_WS = AT_NSLOT * AT_SLOT, AT_OST = AT_WS + 2048, AT_BYTES = AT_OST + 8 * 4096;
static_assert(AT_BYTES <= RING_BYTES, "attention LDS");
__device__ __forceinline__ void glds_asm16(const void* gsrc, unsigned lds_dst) { unsigned keep;
    asm volatile("s_mov_b32 %0, m0\n\ts_mov_b32 m0, %2\n\ts_nop 0\n\tglobal_load_lds_dwordx4 %1, off\n\ts_mov_b32 m0, %0" : "=&s"(keep) : "v"(gsrc), "s"(lds_dst) : "memory"); }
__device__ __forceinline__ void glds_asm4(const void* gsrc, unsigned lds_dst) { unsigned keep;
    asm volatile("s_mov_b32 %0, m0\n\ts_mov_b32 m0, %2\n\ts_nop 0\n\tglobal_load_lds_dword %1, off\n\ts_mov_b32 m0, %0" : "=&s"(keep) : "v"(gsrc), "s"(lds_dst) : "memory"); }
constexpr float AT_THR = 10.0f, AT_SKIP = 40.0f;
template <bool FOX>
__device__ __forceinline__ void attn_qk(const LAS unsigned char* slot, const bf16x8 (&qr)[4], float mref, f32x16& p0, f32x16& p1, int r32, int hi) {
    const LAS unsigned char* kb = slot + AT_K + hi * 1024 + r32 * 16; const LAS float* kbs = (const LAS float*)(slot + AT_KB);
    if (FOX) { const float nm = -mref;
#pragma unroll
        for (int g = 0; g < 4; ++g) { const f32x4 b0 = *(const LAS f32x4*)(kbs + 8 * g + 4 * hi), b1 = *(const LAS f32x4*)(kbs + 32 + 8 * g + 4 * hi);
#pragma unroll
            for (int j = 0; j < 4; ++j) { p0[4 * g + j] = __builtin_fmaf(b0[j], -LOG2E, nm); p1[4 * g + j] = __builtin_fmaf(b1[j], -LOG2E, nm); } }
    } else { p0 = f32x16{}; p1 = f32x16{}; }
#pragma unroll
    for (int d0 = 0; d0 < 4; ++d0) { const bf16x8 b0 = *(const LAS bf16x8*)(kb + d0 * 2048), b1 = *(const LAS bf16x8*)(kb + d0 * 2048 + 512);
        p0 = __builtin_amdgcn_mfma_f32_32x32x16_bf16(b0, qr[d0], p0, 0, 0, 0); p1 = __builtin_amdgcn_mfma_f32_32x32x16_bf16(b1, qr[d0], p1, 0, 0, 0); }
}
template <bool FOX>
__device__ __forceinline__ void attn_sm_pv(const LAS unsigned char* slot, f32x16& p0, f32x16& p1, f32x16& n0, f32x16& n1, bool has_next, f32x16 (&o)[2], float& mref, float& lrun, LAS float* wsf, int vb0, int jb, int qrel, int r32, int hi) {
    if (FOX) {
        if (jb >= 0) { const int kbase = 64 * jb + 4 * hi;
#pragma unroll
            for (int r = 0; r < 16; ++r) { const int kv = kbase + (r & 3) + 8 * (r >> 2); if (kv > qrel) p0[r] = -INFINITY; if (kv + 32 > qrel) p1[r] = -INFINITY; } }
    } else { const float nm = -mref;
#pragma unroll
        for (int r = 0; r < 16; ++r) { p0[r] = __builtin_fmaf(p0[r], QC2, nm); p1[r] = __builtin_fmaf(p1[r], QC2, nm); }
    }
    float rm = fmaxf(p0[0], p1[0]);
#pragma unroll
    for (int r = 1; r < 16; ++r) rm = fmaxf(rm, fmaxf(p0[r], p1[r]));
    { auto rr = __builtin_amdgcn_permlane32_swap(__float_as_uint(rm), __float_as_uint(rm), false, false); rm = fmaxf(__uint_as_float(rr[0]), __uint_as_float(rr[1])); }
    const bool move = (rm > AT_THR) || (lrun == 0.f && rm > -1e30f);
    if (__builtin_expect(__any(move), 0)) {
        const float dl = move ? rm : 0.f, f = __builtin_amdgcn_exp2f(fminf(-dl, 64.f));
        mref += dl; lrun *= f;
#pragma unroll
        for (int r = 0; r < 16; ++r) { p0[r] -= dl; p1[r] -= dl; }
        if (FOX && has_next) {
#pragma unroll
            for (int r = 0; r < 16; ++r) { n0[r] -= dl; n1[r] -= dl; } }
        if (hi == 0) wsf[r32] = f;
        asm volatile("s_waitcnt lgkmcnt(0)" ::: "memory");
#pragma unroll
        for (int g = 0; g < 4; ++g) { const f32x4 a = *(const LAS f32x4*)(wsf + 8 * g + 4 * hi);
#pragma unroll
            for (int j = 0; j < 4; ++j) { o[0][4 * g + j] *= a[j]; o[1][4 * g + j] *= a[j]; } }
    }
    float rs = 0.f;
#pragma unroll
    for (int r = 0; r < 16; ++r) { p0[r] = __builtin_amdgcn_exp2f(p0[r]); p1[r] = __builtin_amdgcn_exp2f(p1[r]); rs += p0[r] + p1[r]; }
    { auto rr = __builtin_amdgcn_permlane32_swap(__float_as_uint(rs), __float_as_uint(rs), false, false); rs = __uint_as_float(rr[0]) + __uint_as_float(rr[1]); }
    lrun += rs;
    u32x4 pw[4];
#pragma unroll
    for (int k = 0; k < 2; ++k) {
        pw[k] = (u32x4){cvtpk_s(p0[8 * k], p0[8 * k + 1]), cvtpk_s(p0[8 * k + 2], p0[8 * k + 3]), cvtpk_s(p0[8 * k + 4], p0[8 * k + 5]), cvtpk_s(p0[8 * k + 6], p0[8 * k + 7])};
        pw[2 + k] = (u32x4){cvtpk_s(p1[8 * k], p1[8 * k + 1]), cvtpk_s(p1[8 * k + 2], p1[8 * k + 3]), cvtpk_s(p1[8 * k + 4], p1[8 * k + 5]), cvtpk_s(p1[8 * k + 6], p1[8 * k + 7])}; }
    const int vb = vb0 + (int)(unsigned)(size_t)slot;
#pragma unroll
    for (int d0 = 0; d0 < 2; ++d0) { s16x4 vlo[4], vhi[4];
#pragma unroll
        for (int ks = 0; ks < 4; ++ks) {
            asm volatile("ds_read_b64_tr_b16 %0,%1 offset:%c2" : "=&v"(vlo[ks]) : "v"(vb), "i"(d0 * 4096 + ks * 1024) : "memory");
            asm volatile("ds_read_b64_tr_b16 %0,%1 offset:%c2" : "=&v"(vhi[ks]) : "v"(vb), "i"(d0 * 4096 + ks * 1024 + 512) : "memory"); }
        asm volatile("s_waitcnt lgkmcnt(0)" ::: "memory"); __builtin_amdgcn_sched_barrier(0);
#pragma unroll
        for (int ks = 0; ks < 4; ++ks) { const bf16x8 vf = (bf16x8){vlo[ks][0], vlo[ks][1], vlo[ks][2], vlo[ks][3], vhi[ks][0], vhi[ks][1], vhi[ks][2], vhi[ks][3]};
            o[d0] = __builtin_amdgcn_mfma_f32_32x32x16_bf16(__builtin_bit_cast(bf16x8, pw[ks]), vf, o[d0], 0, 0, 0); }
    }
}
template <bool FOX>
__device__ __forceinline__ void attn_unit(LAS unsigned char* lds, const bf16* Qp, int qpitch, const bf16* Kp, const bf16* Vp, int kvpitch, int NT, const float* cum, float qk_bound, bf16* Op, int opitch, const bf16* OGp, int gpitch, const int wave_s) {
    const int tid = fresh_tid(wave_s), lane = tid & 63, wid = wave_s, r32 = lane & 31, hi = lane >> 5; const int bid = blockIdx.x;
    LAS float* wsf = (LAS float*)(lds + AT_WS) + wid * 64;
    bf16x8 qr[4];
#pragma unroll
    for (int d0 = 0; d0 < 4; ++d0) qr[d0] = *(const bf16x8*)(Qp + (size_t)(wid * 32 + r32) * qpitch + d0 * 16 + hi * 8);
    const bf16* ksrc = Kp + (size_t)lane * kvpitch + wid * 8;
    const bf16* vsrc = Vp + (size_t)(16 * (wid & 3) + (lane >> 2)) * kvpitch + (wid >> 2) * 32 + (lane & 3) * 8;
    const int vb0 = AT_V + ((lane >> 4) & 1) * 32 + (lane & 3) * 8 + (4 * hi + ((lane & 15) >> 2)) * 64;
    float mref = 0.f, lrun = 0.f; f32x16 o[2]; o[0] = f32x16{}; o[1] = f32x16{};
    const int NTF = NT;
    if (FOX) { int i0 = NTF * 64 - 256; asm volatile("" : "+v"(i0));
        const float c0 = cum[i0], cl = cum[(lane < NTF ? lane : NTF - 1) * 64 + 63];
        const bool need = (lane < NTF) && ((c0 - cl) * LOG2E + 2.f * qk_bound >= -AT_SKIP);
        const int cnt = __builtin_popcountll(__ballot(need)); NT = cnt < 4 ? 4 : ((cnt + 1) & ~1); if (NT > NTF) NT = NTF; }
    const int qrel = wid * 32 + r32; const size_t tstep = (size_t)64 * kvpitch;
    constexpr int ND = FOX ? 3 : 2;
#define AT_TILE(tt) (FOX ? NTF - 1 - (tt) : (tt))
#define AT_ISSUE(tt) do { const unsigned sl_ = ldsb + (unsigned)(((tt) & (AT_NSLOT - 1)) * AT_SLOT); const int kt_ = AT_TILE(tt); \
        glds_asm16(ksrc + (size_t)kt_ * tstep, (unsigned)__builtin_amdgcn_readfirstlane(sl_ + AT_K + wid * 1024)); \
        glds_asm16(vsrc + (size_t)kt_ * tstep, (unsigned)__builtin_amdgcn_readfirstlane(sl_ + AT_V + wid * 1024)); \
        if (FOX) glds_asm4(cum + kt_ * 64 + lane, (unsigned)__builtin_amdgcn_readfirstlane(sl_ + AT_KB)); } while (0)
    const unsigned ldsb = (unsigned)(size_t)lds;
    AT_ISSUE(0); AT_ISSUE(1); AT_ISSUE(2);
#define AT_WAIT1() do { if (FOX) asm volatile("s_waitcnt vmcnt(3)" ::: "memory"); else asm volatile("s_waitcnt vmcnt(2)" ::: "memory"); } while (0)
#define AT_SLOTP(tt) (lds + ((tt) & (AT_NSLOT - 1)) * AT_SLOT)
#define AT_STEP(PC0, PC1, PN0, PN1, tt) do { const int t_ = (tt); const bool hn_ = t_ + 1 < NT; \
        { PSEC_BEGIN(10); if (t_ + 2 < NT) AT_WAIT1(); else asm volatile("s_waitcnt vmcnt(0)" ::: "memory"); \
        __builtin_amdgcn_s_barrier(); asm volatile("" ::: "memory"); PSEC_END(10); } \
        { PSEC_BEGIN(11); if (t_ + 3 < NT) AT_ISSUE(t_ + 3); PSEC_END(11); } \
        { PSEC_BEGIN(12); if (hn_) attn_qk<FOX>(AT_SLOTP(t_ + 1), qr, mref, PN0, PN1, r32, hi); PSEC_END(12); } \
        { PSEC_BEGIN(13); attn_sm_pv<FOX>(AT_SLOTP(t_), PC0, PC1, PN0, PN1, hn_, o, mref, lrun, wsf, vb0, AT_TILE(t_) - (NTF - 4), qrel, r32, hi); PSEC_END(13); } } while (0)
    f32x16 a0, a1, b0, b1;
    if (FOX) asm volatile("s_waitcnt vmcnt(6)" ::: "memory"); else asm volatile("s_waitcnt vmcnt(4)" ::: "memory");
    __builtin_amdgcn_s_barrier(); asm volatile("" ::: "memory");
    attn_qk<FOX>(AT_SLOTP(0), qr, mref, a0, a1, r32, hi);
#pragma unroll 1
    for (int t = 0; t < NT; t += 2) { AT_STEP(a0, a1, b0, b1, t); AT_STEP(b0, b1, a0, a1, t + 1); }
#undef AT_STEP
#undef AT_WAIT1
#undef AT_SLOTP
#undef AT_ISSUE
#undef AT_TILE
    static_assert(ND == 3 || ND == 2, "");
    if (hi == 0) wsf[32 + r32] = lrun;
    asm volatile("s_waitcnt lgkmcnt(0)" ::: "memory");
    LAS bf16* stg = (LAS bf16*)(lds + AT_OST) + wid * 2048;
#pragma unroll
    for (int r = 0; r < 16; ++r) { const int orow = crow(r, hi); const float rl = __builtin_amdgcn_rcpf(wsf[32 + orow]);
#pragma unroll
        for (int d0 = 0; d0 < 2; ++d0) stg[orow * 64 + d0 * 32 + r32] = f2bf(o[d0][r] * rl); }
    asm volatile("s_waitcnt lgkmcnt(0)" ::: "memory");
#pragma unroll
    for (int i = 0; i < 4; ++i) { const int row = i * 8 + (lane >> 3), ch = lane & 7; u32x4 v = *(const LAS u32x4*)(stg + row * 64 + ch * 8);
        const size_t go = (size_t)(wid * 32 + row) * opitch + ch * 8;
        if (FOX) { const u32x4 g = *(const u32x4*)(OGp + (size_t)(wid * 32 + row) * gpitch + ch * 8); unsigned vv[4] = {v.x, v.y, v.z, v.w}; const unsigned gg[4] = {g.x, g.y, g.z, g.w};
#pragma unroll
            for (int k = 0; k < 4; ++k) { const float a0 = __uint_as_float(vv[k] << 16), a1 = __uint_as_float(vv[k] & 0xffff0000u), g0 = __uint_as_float(gg[k] << 16), g1 = __uint_as_float(gg[k] & 0xffff0000u);
                vv[k] = cvtpk_s(a0 * __builtin_amdgcn_rcpf(1.f + __expf(-g0)), a1 * __builtin_amdgcn_rcpf(1.f + __expf(-g1))); }
            v = (u32x4){vv[0], vv[1], vv[2], vv[3]}; }
        *(u32x4*)(Op + go) = v; }
    __syncthreads();
}
constexpr int CW_Q11 = 1024;
__device__ __forceinline__ float wave_max64(float v) {
    v = fmaxf(v, dppf<0xB1>(v)); v = fmaxf(v, dppf<0x4E>(v)); v = fmaxf(v, dppf<0x141>(v)); v = fmaxf(v, dppf<0x140>(v));
    { auto r = __builtin_amdgcn_permlane16_swap(__float_as_uint(v), __float_as_uint(v), false, false); v = fmaxf(__uint_as_float(r[0]), __uint_as_float(r[1])); }
    { auto r = __builtin_amdgcn_permlane32_swap(__float_as_uint(v), __float_as_uint(v), false, false); v = fmaxf(__uint_as_float(r[0]), __uint_as_float(r[1])); }
    return v;
}
__device__ __forceinline__ void phase_attn_b(KP p, LAS unsigned char* lds, const int wave_s) {
    unsigned char* ws = p->ws;
    const bf16* Q = (const bf16*)(ws + WS_HREG); const bf16* K = (const bf16*)(ws + WS_HREG + HR_48); const bf16* V = (const bf16*)(ws + WS_HREG + 2 * HR_48); const bf16* OG = (const bf16*)(ws + WS_HREG + 3 * HR_48);
    const bf16* MQ = (const bf16*)(ws + WS_HREG + 4 * HR_48); const bf16* MKV = (const bf16*)(ws + WS_MKV);
    const float* CUM = (const float*)(ws + WS_CUM); bf16* OC = (bf16*)(ws + WS_GREG);
    unsigned* qhead = (unsigned*)(ws + WS_CTL) + CW_Q11;
    volatile LAS unsigned* slotw = (volatile LAS unsigned*)(lds + MISC_OFF) + 48;
    float qkb; { const int lane = fresh_lane(); const float gq = wave_max64(fabsf(p->in[I_QNG][lane])), gk = wave_max64(fabsf(p->in[I_KNG][lane])); qkb = 64.f * gq * gk * QC2 * 1.02f; }
    for (;;) {
        if (fresh_tid(wave_s) == 0) slotw[0] = __hip_atomic_fetch_add(qhead, 1u, __ATOMIC_RELAXED, __HIP_MEMORY_SCOPE_AGENT);
        __syncthreads();
        const int u = (int)__builtin_amdgcn_readfirstlane(slotw[0]);
        if (u >= 1536 + 512) break;
        if (u < 1536) { const int qb = 15 - u / 96, bh = u % 96, b = bh / FOX_H, h = bh % FOX_H; const size_t row0 = (size_t)b * SEQ;
            attn_unit<true>(lds, Q + (row0 + qb * 256) * 768 + h * 64, 768, K + row0 * 768 + h * 64, V + row0 * 768 + h * 64, 768, 4 * (qb + 1), CUM + (size_t)bh * SEQ, qkb,
                            OC + (row0 + qb * 256) * D + h * 64, D, OG + (row0 + qb * 256) * 768 + h * 64, 768, wave_s); }
        else { const int m = u - 1536, b = m >> 6, hd = (m >> 4) & 3, qblk = m & 15; const size_t row0 = (size_t)b * SEQ + qblk * 256;
            const bf16* Kp = MKV + (size_t)b * NMEM * 1024 + 512 + hd * 64;
            attn_unit<false>(lds, MQ + row0 * 256 + hd * 64, 256, Kp, Kp + 256, 1024, 4, nullptr, 0.f, OC + row0 * D + 768 + hd * 64, D, nullptr, 0, wave_s); }
    }
}
__device__ __forceinline__ void phase_attn_mem(unsigned char* ws, LAS unsigned char* lds, int layer, int G, int bid, const int wave_s) {
    const bf16* MQ = (const bf16*)(ws + WS_HREG + (layer == 0 ? 3 : 4) * HR_48); const bf16* MKV = (const bf16*)(ws + WS_MKV); bf16* OC = (bf16*)(ws + (layer == 0 ? WS_XB : WS_GREG));
    for (int u = bid; u < 512; u += G) { const int b = u >> 6, hd = (u >> 4) & 3, qblk = u & 15; const size_t row0 = (size_t)b * SEQ + qblk * 256;
        const bf16* Kp = MKV + (size_t)b * NMEM * 1024 + layer * 512 + hd * 64;
        attn_unit<false>(lds, MQ + row0 * 256 + hd * 64, 256, Kp, Kp + 256, 1024, 4, nullptr, 0.f, OC + row0 * D + 768 + hd * 64, D, nullptr, 0, wave_s); }
}
constexpr int GL_QP = 208, GL_VP = 448, GL_KX = 0, GL_QD = 13312, GL_VT = 26624, GL_HEAD = 55296;
constexpr int GL_GLR = 2 * GL_HEAD, GL_TOT = GL_GLR + 4096, GL_SSX = GL_TOT + 1536, GL_BYTES = GL_SSX + 1024;
static_assert(GL_BYTES <= RING_BYTES, "GLA LDS");
typedef short v4i16_t __attribute__((ext_vector_type(4)));
__device__ __forceinline__ s16x4 trd(const LAS unsigned char* p) { return __builtin_bit_cast(s16x4, __builtin_amdgcn_ds_read_tr16_b64_v4i16((LAS v4i16_t*)p)); }
__device__ __forceinline__ float fast_log_sigmoid(float z) { return fminf(z, 0.f) - __logf(1.f + __expf(-fabsf(z))); }

template <int MODE>
__device__ __forceinline__ void gla_stage(unsigned char* ws, LAS unsigned char* lds, int tid, int b, int n, int hp) {
    const bf16* V = (const bf16*)(ws + WS_HREG + HR_48); const float* GLR = (const float*)(ws + WS_GLR); const bf16* QK = (const bf16*)(ws + WS_HREG);
    const size_t m0 = (size_t)b * SEQ + n * 64;
#pragma unroll
    for (int i = 0; i < 6; ++i) { const int pi = tid + 512 * i, u = pi / 1536, rem = pi % 1536, row = rem / 24, ch = rem % 24;
        const u32x4 v = *(const u32x4*)(V + (m0 + row) * 768 + 192 * (2 * hp + u) + 8 * ch);
        *(LAS u32x4*)(lds + u * GL_HEAD + GL_VT + row * GL_VP + ch * 16) = v; }
#pragma unroll
    for (int i = 0; i < (MODE == 1 ? 6 : 3); ++i) { const int pi = tid + 512 * i, ts = pi / 1536, rem = pi % 1536, u = rem / 768, r2 = rem % 768, row = r2 / 12, ch = r2 % 12;
        const u32x4 v = *(const u32x4*)(QK + (m0 + row) * 768 + (ts == 0 ? 384 : 0) + 96 * (2 * hp + u) + 8 * ch);
        *(LAS u32x4*)(lds + u * GL_HEAD + (ts == 0 ? GL_KX : GL_QD) + row * GL_QP + ch * 16) = v; }
    if (tid < 256) { const f32x4 g = *(const f32x4*)(GLR + m0 * 16 + 4 * tid); *(LAS f32x4*)(lds + GL_GLR + 16 * tid) = g; }
}
template <int MODE>
__device__ __forceinline__ void gla_gates(KP p, unsigned char* ws, LAS unsigned char* lds, int tid, int b, int n, int hp) {
    float* DEC = (float*)(ws + WS_DEC);
    const size_t m0 = (size_t)b * SEQ + n * 64;
    LAS float* glr = (LAS float*)(lds + GL_GLR); LAS float* totl = (LAS float*)(lds + GL_TOT);
    float la[32]; float tot = 0.f; int col = 0, th = 0, u = 0, kidx = 0, head = 0;
    if (tid < 384) { col = tid % 192; th = tid / 192; u = col / 96; kidx = col % 96; head = 2 * hp + u;
        float w[16];
#pragma unroll
        for (int j = 0; j < 16; ++j) w[j] = p->in[I_WGUP][j * 384 + 96 * head + kidx];
        const float bg = p->in[I_BGATE][96 * head + kidx];
#pragma unroll
        for (int i = 0; i < 32; ++i) { const LAS float* gr = glr + (32 * th + i) * 16; float z = bg;
#pragma unroll
            for (int j4 = 0; j4 < 4; ++j4) { const f32x4 g = *(const LAS f32x4*)(gr + 4 * j4); z += g[0] * w[4 * j4] + g[1] * w[4 * j4 + 1] + g[2] * w[4 * j4 + 2] + g[3] * w[4 * j4 + 3]; }
            la[i] = fast_log_sigmoid(z) * (1.f / 16.f); tot += la[i]; }
        totl[th * 192 + col] = tot; }
    __syncthreads();
    if (tid < 384) {
        LAS bf16* KX = (LAS bf16*)(lds + u * GL_HEAD + GL_KX); LAS bf16* QD = (LAS bf16*)(lds + u * GL_HEAD + GL_QD);
        if (MODE == 0) {
            float run = (th == 1) ? 0.f : totl[192 + col];
#pragma unroll
            for (int i = 31; i >= 0; --i) { LAS bf16* kp = KX + (32 * th + i) * (GL_QP / 2) + kidx; const float kv = bf2f(*kp); *kp = f2bf(kv * __expf(run)); run += la[i]; }
            if (th == 0) DEC[(((size_t)b * 64 + n) * 4 + head) * 96 + kidx] = __expf(run);
        } else {
            float run = (th == 0) ? 0.f : totl[col];
#pragma unroll
            for (int i = 0; i < 32; ++i) { run += la[i]; LAS bf16* qp = QD + (32 * th + i) * (GL_QP / 2) + kidx; LAS bf16* kp = KX + (32 * th + i) * (GL_QP / 2) + kidx; const float qv = bf2f(*qp), kv = bf2f(*kp);
                *qp = f2bf(qv * __expf(run) * 0.10206207261596577f); *kp = f2bf(kv * __expf(-run)); }
        }
    }
    __syncthreads();
}
__device__ __forceinline__ void phase_gla_kv(KP p, LAS unsigned char* lds, int G, int bid, const int wave_s) {
    unsigned char* ws = p->ws; bf16* SKV = (bf16*)(ws + WS_GREG);
    for (int unit = bid; unit < NB * 64 * 2; unit += G) {
        const int tid = fresh_tid(wave_s), lane = tid & 63, wid = wave_s;
        const int hp = unit & 1, n = (unit >> 1) & 63, b = unit >> 7;
        gla_stage<0>(ws, lds, tid, b, n, hp);
        __syncthreads();
        gla_gates<0>(p, ws, lds, tid, b, n, hp);
        const int u = wid >> 2, j4 = wid & 3, head = 2 * hp + u, r32 = lane & 31, h2 = lane >> 5, q = (lane & 15) >> 2, pp = lane & 3, g1 = (lane >> 4) & 1;
        const LAS unsigned char* ka = lds + u * GL_HEAD + GL_KX + (8 * h2 + q) * GL_QP + (16 * g1 + 4 * pp) * 2;
        const LAS unsigned char* va = lds + u * GL_HEAD + GL_VT + (8 * h2 + q) * GL_VP + (16 * g1 + 4 * pp) * 2;
        bf16* outb = SKV + ((((size_t)b * 64 + n) * 4 + head) * 192) * 96;
        for (int id = j4; id < 18; id += 4) { const int kb = id / 6, cb = id % 6;
            f32x16 acc = f32x16{};
#pragma unroll
            for (int ks = 0; ks < 4; ++ks) {
                const s16x4 a0 = trd(ka + ks * 16 * GL_QP + kb * 64), a1 = trd(ka + ks * 16 * GL_QP + 4 * GL_QP + kb * 64);
                const s16x4 b0 = trd(va + ks * 16 * GL_VP + cb * 64), b1 = trd(va + ks * 16 * GL_VP + 4 * GL_VP + cb * 64);
                acc = __builtin_amdgcn_mfma_f32_32x32x16_bf16((bf16x8){a0[0], a0[1], a0[2], a0[3], a1[0], a1[1], a1[2], a1[3]}, (bf16x8){b0[0], b0[1], b0[2], b0[3], b1[0], b1[1], b1[2], b1[3]}, acc, 0, 0, 0); }
            bf16* op = outb + (size_t)(32 * cb + r32) * 96 + 32 * kb + 4 * h2;
#pragma unroll
            for (int g = 0; g < 4; ++g) { u32x2 w; w.x = cvtpk_s(acc[4 * g], acc[4 * g + 1]); w.y = cvtpk_s(acc[4 * g + 2], acc[4 * g + 3]); *(u32x2*)(op + 8 * g) = w; }
        }
        __syncthreads();
    }
}
__device__ __forceinline__ void phase_gla_scan(unsigned char* ws, int G, int bid, const int wave_s) {
    bf16* SKV = (bf16*)(ws + WS_GREG); const float* DEC = (const float*)(ws + WS_DEC);
    const int tid = fresh_tid(wave_s);
    constexpr int NITEM = NB * 4 * 192 * 12;
    const int per = (NITEM + G - 1) / G;
    for (int it = tid; it < per; it += NTHREADS) { const int item = bid * per + it; if (item >= NITEM) break;
        const int k8 = item % 12, c = (item / 12) % 192, bh = item / (12 * 192), b = bh >> 2, h = bh & 3;
        float s[8];
#pragma unroll
        for (int j = 0; j < 8; ++j) s[j] = 0.f;
        u32x4* ptr = (u32x4*)(SKV + ((((size_t)b * 64) * 4 + h) * 192 + c) * 96 + 8 * k8); const float* dp = DEC + (((size_t)b * 64) * 4 + h) * 96 + 8 * k8;
#pragma unroll 1
        for (int n0 = 0; n0 < 64; n0 += 8) { u32x4 kv[8]; f32x4 d0[8], d1[8];
#pragma unroll
            for (int i = 0; i < 8; ++i) { kv[i] = ptr[(size_t)(n0 + i) * (4 * 192 * 96 / 8)]; d0[i] = *(const f32x4*)(dp + (size_t)(n0 + i) * 4 * 96); d1[i] = *(const f32x4*)(dp + (size_t)(n0 + i) * 4 * 96 + 4); }
#pragma unroll
            for (int i = 0; i < 8; ++i) { u32x4 o; o.x = cvtpk_s(s[0], s[1]); o.y = cvtpk_s(s[2], s[3]); o.z = cvtpk_s(s[4], s[5]); o.w = cvtpk_s(s[6], s[7]); ptr[(size_t)(n0 + i) * (4 * 192 * 96 / 8)] = o;
                const unsigned kw[4] = {kv[i].x, kv[i].y, kv[i].z, kv[i].w};
#pragma unroll
                for (int j = 0; j < 4; ++j) { const float dlo = j < 2 ? d0[i][2 * j] : d1[i][2 * j - 4], dhi = j < 2 ? d0[i][2 * j + 1] : d1[i][2 * j - 3];
                    s[2 * j] = dlo * s[2 * j] + __uint_as_float(kw[j] << 16); s[2 * j + 1] = dhi * s[2 * j + 1] + __uint_as_float(kw[j] & 0xffff0000u); } } }
    }
}
__device__ __forceinline__ void phase_gla_out(KP p, LAS unsigned char* lds, int G, int bid, const int wave_s) {
    unsigned char* ws = p->ws; const bf16* SKV = (const bf16*)(ws + WS_GREG); const bf16* R = (const bf16*)(ws + WS_HREG + 2 * HR_48); bf16* OC = (bf16*)(ws + WS_XB);
    for (int unit = bid; unit < NB * 64 * 2; unit += G) {
        const int tid = fresh_tid(wave_s), lane = tid & 63, wid = wave_s;
        const int hp = unit & 1, n = (unit >> 1) & 63, b = unit >> 7;
        u32x2 rv12[12];
        { const int tb_ = wid & 1, ch_ = (wid >> 1) & 1, head_ = 2 * hp + (wid >> 2); const size_t m_ = (size_t)b * SEQ + n * 64 + 32 * tb_ + (lane & 31);
          const bf16* rp_ = R + m_ * 768 + 192 * head_ + 96 * ch_ + 4 * (lane >> 5);
#pragma unroll
          for (int q = 0; q < 12; ++q) rv12[q] = *(const u32x2*)(rp_ + 32 * (q >> 2) + 8 * (q & 3)); }
        { PSEC_BEGIN(30); gla_stage<1>(ws, lds, tid, b, n, hp);
        __syncthreads(); PSEC_END(30); }
        { PSEC_BEGIN(31); gla_gates<1>(p, ws, lds, tid, b, n, hp); PSEC_END(31); }
        PSEC_BEGIN(32);
        const int u = wid >> 2, tb = wid & 1, ch = (wid >> 1) & 1, head = 2 * hp + u, r32 = lane & 31, h2 = lane >> 5, q = (lane & 15) >> 2, pp = lane & 3, g1 = (lane >> 4) & 1;
        const LAS unsigned char* kx = lds + u * GL_HEAD + GL_KX + r32 * GL_QP + 16 * h2;
        const LAS unsigned char* qd = lds + u * GL_HEAD + GL_QD + (32 * tb + r32) * GL_QP + 16 * h2;
        const LAS unsigned char* va = lds + u * GL_HEAD + GL_VT + (4 * h2 + q) * GL_VP + (16 * g1 + 4 * pp) * 2;
        bf16x8 qf[6];
#pragma unroll
        for (int ks = 0; ks < 6; ++ks) qf[ks] = *(const LAS bf16x8*)(qd + 32 * ks);
        f32x16 at0 = f32x16{}, at1 = f32x16{};
#pragma unroll
        for (int ks = 0; ks < 6; ++ks) at0 = __builtin_amdgcn_mfma_f32_32x32x16_bf16(*(const LAS bf16x8*)(kx + 32 * ks), qf[ks], at0, 0, 0, 0);
        if (tb == 1) {
#pragma unroll
            for (int ks = 0; ks < 6; ++ks) at1 = __builtin_amdgcn_mfma_f32_32x32x16_bf16(*(const LAS bf16x8*)(kx + 32 * GL_QP + 32 * ks), qf[ks], at1, 0, 0, 0);
        }
#pragma unroll
        for (int r = 0; r < 16; ++r) { const bool keep = crow(r, h2) <= r32; if (tb == 0) { if (!keep) at0[r] = 0.f; } else { if (!keep) at1[r] = 0.f; } }
        bf16x8 pb[4];
#pragma unroll
        for (int k2 = 0; k2 < 2; ++k2) {
            pb[k2] = __builtin_bit_cast(bf16x8, (u32x4){cvtpk_s(at0[8 * k2], at0[8 * k2 + 1]), cvtpk_s(at0[8 * k2 + 2], at0[8 * k2 + 3]), cvtpk_s(at0[8 * k2 + 4], at0[8 * k2 + 5]), cvtpk_s(at0[8 * k2 + 6], at0[8 * k2 + 7])});
            pb[2 + k2] = __builtin_bit_cast(bf16x8, (u32x4){cvtpk_s(at1[8 * k2], at1[8 * k2 + 1]), cvtpk_s(at1[8 * k2 + 2], at1[8 * k2 + 3]), cvtpk_s(at1[8 * k2 + 4], at1[8 * k2 + 5]), cvtpk_s(at1[8 * k2 + 6], at1[8 * k2 + 7])}); }
        const bf16* sg = SKV + ((((size_t)b * 64 + n) * 4 + head) * 192 + 96 * ch + r32) * 96 + 8 * h2;
        f32x16 o[3];
#pragma unroll
        for (int cbl = 0; cbl < 3; ++cbl) { const int cb = 3 * ch + cbl; f32x16 acc = f32x16{};
#pragma unroll
            for (int kq = 0; kq < 4; ++kq) { if (kq < 2 || tb == 1) {
                const s16x4 a0 = trd(va + kq * 16 * GL_VP + cb * 64), a1 = trd(va + kq * 16 * GL_VP + 8 * GL_VP + cb * 64);
                acc = __builtin_amdgcn_mfma_f32_32x32x16_bf16((bf16x8){a0[0], a0[1], a0[2], a0[3], a1[0], a1[1], a1[2], a1[3]}, pb[kq], acc, 0, 0, 0); } }
#pragma unroll
            for (int ks = 0; ks < 6; ++ks) { const bf16x8 sf = *(const bf16x8*)(sg + (size_t)(32 * cbl) * 96 + 16 * ks);
                acc = __builtin_amdgcn_mfma_f32_32x32x16_bf16(sf, qf[ks], acc, 0, 0, 0); }
            o[cbl] = acc; }
        asm volatile("" : "+v"(o[0]), "+v"(o[1]), "+v"(o[2])); PSEC_END(32);
        PSEC_BEGIN(33);
        float ss = 0.f;
#pragma unroll
        for (int cbl = 0; cbl < 3; ++cbl)
#pragma unroll
            for (int r = 0; r < 16; ++r) ss += o[cbl][r] * o[cbl][r];
        { auto rr = __builtin_amdgcn_permlane32_swap(__float_as_uint(ss), __float_as_uint(ss), false, false); ss = __uint_as_float(rr[0]) + __uint_as_float(rr[1]); }
        LAS float* ssx = (LAS float*)(lds + GL_SSX);
        if (h2 == 0) ssx[((u * 2 + tb) * 2 + ch) * 32 + r32] = ss;
        __syncthreads();
        ss += ssx[((u * 2 + tb) * 2 + (ch ^ 1)) * 32 + r32];
        const float rs = rsqrtf(ss * (1.f / 192.f) + RMS_EPS);
        const size_t m = (size_t)b * SEQ + n * 64 + 32 * tb + r32;
        bf16* op = OC + m * D + 192 * head + 96 * ch + 4 * h2; const float* gp = p->in[I_GLAG] + 96 * ch + 4 * h2;
#pragma unroll
        for (int cbl = 0; cbl < 3; ++cbl)
#pragma unroll
            for (int g = 0; g < 4; ++g) { const int co = 32 * cbl + 8 * g; const u32x2 rv = rv12[4 * cbl + g]; const f32x4 gn = *(const f32x4*)(gp + co);
                const float r0 = __uint_as_float(rv.x << 16), r1 = __uint_as_float(rv.x & 0xffff0000u), r2 = __uint_as_float(rv.y << 16), r3 = __uint_as_float(rv.y & 0xffff0000u);
                const float v0 = o[cbl][4 * g] * rs * gn[0] * (r0 * __builtin_amdgcn_rcpf(1.f + __expf(-r0))), v1 = o[cbl][4 * g + 1] * rs * gn[1] * (r1 * __builtin_amdgcn_rcpf(1.f + __expf(-r1)));
                const float v2 = o[cbl][4 * g + 2] * rs * gn[2] * (r2 * __builtin_amdgcn_rcpf(1.f + __expf(-r2))), v3 = o[cbl][4 * g + 3] * rs * gn[3] * (r3 * __builtin_amdgcn_rcpf(1.f + __expf(-r3)));
                u32x2 w; w.x = cvtpk_s(v0, v1); w.y = cvtpk_s(v2, v3); *(u32x2*)(op + co) = w; }
        __syncthreads();
        PSEC_END(33);
    }
}
constexpr int PROBE_J = -1, PROBE_B = 0, PROBE_K = 4;
__global__ void __launch_bounds__(NTHREADS, 2) mega(Params p_unused) {
    extern __shared__ __attribute__((aligned(16))) unsigned char lds_raw[];
    LAS unsigned char* lds = (LAS unsigned char*)lds_raw;
    const int G = gridDim.x, bid = blockIdx.x; const int wave_s = __builtin_amdgcn_readfirstlane(threadIdx.x >> 6);
    volatile LAS unsigned* MISC = (volatile LAS unsigned*)(lds + MISC_OFF);
    if (threadIdx.x < 64) MISC[threadIdx.x] = 0u;
    __syncthreads();
    KP p = fresh_kp();
    unsigned char* ws = p->ws;
    volatile LAS unsigned* STAMPS = (volatile LAS unsigned*)(lds + ROWTOK_OFF + 6144);
    if (PROBE_J >= 0 && threadIdx.x == 0) { const unsigned long long t_ = __builtin_amdgcn_s_memrealtime(); STAMPS[0] = (unsigned)t_; STAMPS[1] = (unsigned)(t_ >> 32); }
    if (PROBE_SEC >= 0 && threadIdx.x == 0) *(volatile LAS unsigned*)(lds + PSEC_OFF) = 0u;
    XcdBarrier bar = xcd_barrier_post((unsigned*)(ws + WS_CTL) + CW_BAR + p->bar_li * XCD_BAR_WORDS, MISC + 8);
#define WS (fresh_kp()->ws)
#define IN(k) ({ KP _q = fresh_kp(); const bool _r = _q->ph_lo <= (k) && (k) < _q->ph_hi; _r; })
#define SEAM(k) do { if (IN(k) && IN((k) + 1)) xcd_barrier(bar); if (PROBE_J >= 0 && threadIdx.x == 0) { const unsigned long long t_ = __builtin_amdgcn_s_memrealtime(); STAMPS[2 * ((k) + 1)] = (unsigned)t_; STAMPS[2 * ((k) + 1) + 1] = (unsigned)(t_ >> 32); } } while (0)

    if (IN(0)) { phase_prologue(fresh_kp(), lds, G, bid, wave_s); }
    SEAM(0);
    if (IN(1)) { unsigned char* wsl = WS;
        { TileOrder S; S.init(wsl + WS_XB, wsl + WS_WA, NTOK, 2560, D, G, bid);
          EpiInA E{(bf16*)(wsl + WS_HREG), (bf16*)(wsl + WS_HREG + HR_48), (bf16*)(wsl + WS_HREG + 2 * HR_48), (bf16*)(wsl + WS_HREG + 3 * HR_48)};
          gemm_phase(lds + RING_OFF, D, S, E, wave_s); }
    }
    SEAM(1);
    if (IN(2)) phase_gla_kv(fresh_kp(), lds, G, bid, wave_s);
    SEAM(2);
    if (IN(3)) { unsigned char* wsl = WS;
        if (G > 32 && bid < 16) { TileOrder S; S.init(wsl + WS_MEMB, wsl + WS_WMKV, NB * NMEM, 512, D, 16, bid);
            EpiPlain E{(bf16*)(wsl + WS_MKV), 1024};
            gemm_phase(lds + RING_OFF, D, S, E, wave_s); }
        else { phase_gla_scan(wsl, G > 32 ? G - 16 : G, G > 32 ? bid - 16 : bid, wave_s); __syncthreads(); if (G > 32) convert_from_queue(fresh_kp(), lds, wave_s, 4, CW_CVQA, CV_A_STATIC, CV_QA); }
        if (G <= 32) { TileOrder S; S.init(wsl + WS_MEMB, wsl + WS_WMKV, NB * NMEM, 512, D, G, bid); EpiPlain E{(bf16*)(wsl + WS_MKV), 1024}; gemm_phase(lds + RING_OFF, D, S, E, wave_s); } }
    SEAM(3);
    if (IN(4)) { phase_gla_out(fresh_kp(), lds, G, bid, wave_s); unsigned char* wsl = WS; phase_attn_mem(wsl, lds, 0, G, bid, wave_s); }
    SEAM(4);
        if (IN(5)) { unsigned char* wsl = WS;
            KP q = fresh_kp();
            TileOrder S; S.init(wsl + WS_XB, wsl + WS_WO + (size_t)0 * D * D * 2, NTOK, D, D, G, bid);
            EpiRes<false> E{(const void*)q->in[I_X], (bf16*)q->out};
            gemm_phase(lds + RING_OFF, D, S, E, wave_s);
        }
        SEAM(5);
        if (IN(5 + 1)) { phase_ln_router(fresh_kp(), 0, lds, G, bid, wave_s); convert_from_queue(fresh_kp(), lds, wave_s, -1, CW_CVQA, CV_A_STATIC, CV_QA); }
        SEAM(5 + 1);
        if (IN(5 + 2)) { unsigned char* wsl = WS;
            const int nu = moe_setup(wsl, lds, G, bid, wave_s, true);
            MoeGU S{(const char*)(wsl + WS_XB), (const char*)(wsl + WS_WGU) + (size_t)0 * NEXP * 1024 * D * 2, (LAS const int*)(lds + MISC_OFF) + 16, (LAS const int*)(lds + ROWTOK_OFF), nu};
            EpiGateUp E{(bf16*)(wsl + WS_GREG)};
            gemm_phase(lds + RING_OFF, D, S, E, wave_s);
            if (nu * G < (int)__builtin_amdgcn_readfirstlane(((volatile LAS int*)(lds + MISC_OFF))[16 + 25])) convert_from_queue(fresh_kp(), lds, wave_s, 4);
        }
        SEAM(5 + 2);
        if (IN(5 + 3)) { unsigned char* wsl = WS;
            const int nu = moe_setup(wsl, lds, G, bid, wave_s, false);
            MoeDown S{(const char*)(wsl + WS_GREG), (const char*)(wsl + WS_WD) + (size_t)0 * NEXP * 1024 * DEXP * 2, (LAS const int*)(lds + MISC_OFF) + 16, nu};
            EpiPlain E{(bf16*)(wsl + WS_HREG), 1024};
            gemm_phase(lds + RING_OFF, DEXP, S, E, wave_s);
            if (nu * G < (int)__builtin_amdgcn_readfirstlane(((volatile LAS int*)(lds + MISC_OFF))[16 + 25])) convert_from_queue(fresh_kp(), lds, wave_s, 2);
        }
        SEAM(5 + 3);
        if (IN(5 + 4)) phase_ln_ffn(fresh_kp(), 0, lds, G, bid, wave_s);

            SEAM(9);
            if (IN(10)) { unsigned char* wsl = WS;
                KP q = fresh_kp();
                TileOrder S; S.init(wsl + WS_XB, wsl + WS_WB, NTOK, 3328, D, G, bid);
                EpiInB E{(bf16*)(wsl + WS_HREG), (bf16*)(wsl + WS_HREG + HR_48), (bf16*)(wsl + WS_HREG + 2 * HR_48), (bf16*)(wsl + WS_HREG + 3 * HR_48), (bf16*)(wsl + WS_HREG + 4 * HR_48), q->in[I_QNG], q->in[I_KNG]};
                gemm_phase(lds + RING_OFF, D, S, E, wave_s);
                {
                    const int c2 = (G >= 160) ? bid - 128 : bid; const int G2 = (G >= 160) ? 16 : G;
                    if (c2 >= 0 && c2 < G2) { TileOrder S2; S2.init(wsl + WS_MEMB, wsl + WS_WMKV + (size_t)512 * D * 2, NB * NMEM, 512, D, G2, c2);
                        EpiPlain E2{(bf16*)(wsl + WS_MKV) + 512, 1024};
                        gemm_phase(lds + RING_OFF, D, S2, E2, wave_s); } }
                if (G == 256 && bid >= 144 && bid < 244) convert_from_queue(fresh_kp(), lds, wave_s, 4);
                const int gwr = (G - 1 - bid) * NWAVES + wave_s;
                if (gwr < NB * FOX_H) cum_wave((const float*)(wsl + WS_LOGF), (float*)(wsl + WS_CUM), gwr, fresh_lane());
            }
            SEAM(10);
            if (IN(11)) phase_attn_b(fresh_kp(), lds, wave_s);
            SEAM(11);
        if (IN(12)) { unsigned char* wsl = WS;
            KP q = fresh_kp();
            TileOrder S; S.init(wsl + WS_GREG, wsl + WS_WO + (size_t)1 * D * D * 2, NTOK, D, D, G, bid);
            EpiRes<true> E{(const void*)(wsl + WS_XB), (bf16*)q->out};
            gemm_phase(lds + RING_OFF, D, S, E, wave_s);
        }
        SEAM(12);
        if (IN(12 + 1)) { phase_ln_router(fresh_kp(), 1, lds, G, bid, wave_s); convert_from_queue(fresh_kp(), lds, wave_s, -1); }
        SEAM(12 + 1);
        if (IN(12 + 2)) { unsigned char* wsl = WS;
            const int nu = moe_setup(wsl, lds, G, bid, wave_s, true);
            MoeGU S{(const char*)(wsl + WS_XB), (const char*)(wsl + WS_WGU) + (size_t)1 * NEXP * 1024 * D * 2, (LAS const int*)(lds + MISC_OFF) + 16, (LAS const int*)(lds + ROWTOK_OFF), nu};
            EpiGateUp E{(bf16*)(wsl + WS_GREG)};
            gemm_phase(lds + RING_OFF, D, S, E, wave_s);
        }
        SEAM(12 + 2);
        if (IN(12 + 3)) { unsigned char* wsl = WS;
            const int nu = moe_setup(wsl, lds, G, bid, wave_s, false);
            MoeDown S{(const char*)(wsl + WS_GREG), (const char*)(wsl + WS_WD) + (size_t)1 * NEXP * 1024 * DEXP * 2, (LAS const int*)(lds + MISC_OFF) + 16, nu};
            EpiPlain E{(bf16*)(wsl + WS_HREG), 1024};
            gemm_phase(lds + RING_OFF, DEXP, S, E, wave_s);
        }
        SEAM(12 + 3);
        if (IN(12 + 4)) phase_ln_ffn(fresh_kp(), 1, lds, G, bid, wave_s);
        SEAM(16);
    if (PROBE_J >= 0 && blockIdx.x == 0 && threadIdx.x == 0) {
        const unsigned long long t1 = ((unsigned long long)STAMPS[2 * PROBE_B + 1] << 32) | STAMPS[2 * PROBE_B], t0 = ((unsigned long long)STAMPS[2 * PROBE_J + 1] << 32) | STAMPS[2 * PROBE_J];
        const unsigned long long wait = (t1 - t0) * PROBE_K, ts = __builtin_amdgcn_s_memrealtime();
        while (__builtin_amdgcn_s_memrealtime() - ts < wait) __builtin_amdgcn_s_sleep(8);
    }
    if (PROBE_SEC >= 0 && blockIdx.x == 0 && threadIdx.x == 0) {
        const unsigned long long wait = (unsigned long long)(*(volatile LAS unsigned*)(lds + PSEC_OFF)) * PROBE_K, ts = __builtin_amdgcn_s_memrealtime();
        while (__builtin_amdgcn_s_memrealtime() - ts < wait) __builtin_amdgcn_s_sleep(8);
    }
#undef IN
#undef SEAM
#undef WS
}
#undef LAS
#undef GAS
}

static int pk_grid() {
    static int grid = 0;
    if (grid == 0) {
        int dev = 0, cus = 0;
        if (hipGetDevice(&dev) != hipSuccess || hipDeviceGetAttribute(&cus, hipDeviceAttributeMultiprocessorCount, dev) != hipSuccess) { grid = -1; return grid; }
        if (hipFuncSetAttribute((const void*)pk::mega, hipFuncAttributeMaxDynamicSharedMemorySize, pk::LDS_BYTES) != hipSuccess) { fprintf(stderr, "kernel_launch: hipFuncSetAttribute failed\n"); grid = -1; return grid; }
        int per_cu = 0;
        if (hipOccupancyMaxActiveBlocksPerMultiprocessor(&per_cu, (const void*)pk::mega, pk::NTHREADS, pk::LDS_BYTES) != hipSuccess || per_cu < 1) fprintf(stderr, "kernel_launch: occupancy query says %d\n", per_cu);
        (void)hipGetLastError();
        grid = cus;
    }
    return grid;
}
static void pk_launch(pk::Params& P, int lo, int hi, hipStream_t stream) {
    const int grid = pk_grid(); if (grid <= 0) return;
    P.ph_lo = lo; P.ph_hi = hi; P.bar_li += 1;
    hipLaunchKernelGGL(pk::mega, dim3(grid), dim3(pk::NTHREADS), pk::LDS_BYTES, stream, P);
}
extern "C" void kernel_launch(void* const* d_in, const int* in_sizes, int n_in, void* d_out, int out_size, void* d_ws, size_t ws_size, hipStream_t stream) {
    if (n_in != 22 || out_size != NTOK * D || ws_size < WS_END) { fprintf(stderr, "kernel_launch: unexpected shapes (n_in %d out %d ws %zu)\n", n_in, out_size, ws_size); return; }
    const float* w_gate_up = (const float*)d_in[3]; const float* b_gate = (const float*)d_in[4]; const float* gla_g = (const float*)d_in[5];
    const float* w_eg = (const float*)d_in[19]; const float* w_eu = (const float*)d_in[20]; const float* w_ed = (const float*)d_in[21];
    unsigned char* ws = (unsigned char*)d_ws;
    float* GLR = (float*)(ws + WS_GLR); float* CUM = (float*)(ws + WS_CUM);
    bf16* MKV = (bf16*)(ws + WS_MKV);
    int* TOK_E = (int*)(ws + WS_TOKE); int* TOK_S = (int*)(ws + WS_TOKS);
    bf16* XB = (bf16*)(ws + WS_XB); bf16* YS = (bf16*)(ws + WS_HREG);
    bf16* T0 = (bf16*)(ws + WS_HREG), *T1 = (bf16*)(ws + WS_HREG + HR_48), *T2 = (bf16*)(ws + WS_HREG + 2 * HR_48), *T3 = (bf16*)(ws + WS_HREG + 3 * HR_48), *T4 = (bf16*)(ws + WS_HREG + 4 * HR_48);
    (void)hipMemsetAsync(ws + WS_CTL, 0, CTL_ZERO_BYTES, stream);
    pk::Params P{}; for (int i = 0; i < 22; ++i) P.in[i] = (const float*)d_in[i]; P.out = (float*)d_out; P.ws = ws; P.bar_li = -1;
    pk_launch(P, 0, 17, stream);
}
```

```cpp
#include <hip/hip_runtime.h>
#include <cstdio>
#include <cstdint>

typedef unsigned short bf16;
constexpr int NB = 8, SEQ = 4096, D = 1024, NTOK = NB * SEQ;
constexpr int NMEM = 256, A_IN = 2576, B_IN = 1792, KV_IN = 1548;
constexpr int GLA_H = 4, GLA_DK = 96, GLA_DV = 192, FOX_H = 12;
constexpr int NEXP = 16, DEXP = 512;
constexpr float DN_ALPHA = 1.41421356237309515f;
constexpr float LN_EPS = 1e-5f, RMS_EPS = 1e-6f;
constexpr float LOG2E = 1.4426950408889634f;
constexpr float QC2 = 0.125f * LOG2E;
constexpr size_t MiB = 1u << 20;
constexpr size_t WS_CTL = 0, CTL_ZERO_BYTES = 1 * MiB;
constexpr size_t WS_GLR = 1 * MiB, WS_LOGF = 3 * MiB, WS_CUM = 5 * MiB, WS_DEC = 7 * MiB, WS_MEMB = 8 * MiB, WS_MKV = 12 * MiB;
constexpr size_t WS_TOKE = 16 * MiB, WS_TOKW = WS_TOKE + 256 * 1024, WS_TOKS = WS_TOKW + 256 * 1024, WS_CNT = WS_TOKS + 256 * 1024, WS_SLOTTOK = 17 * MiB;
constexpr size_t WS_WA = 20 * MiB, WS_WB = 25 * MiB, WS_WMKV = 32 * MiB, WS_WO = 34 * MiB, WS_WGU = 38 * MiB, WS_WD = 102 * MiB;
constexpr size_t WS_XB = 134 * MiB, WS_GREG = 198 * MiB, WS_HREG = 270 * MiB, WS_END = 478 * MiB;
constexpr size_t HR_48 = 48 * MiB;

__device__ __forceinline__ float bf2f(bf16 v) { return __uint_as_float(((unsigned)v) << 16); }
__device__ __forceinline__ bf16 f2bf(float f) { unsigned u = __float_as_uint(f); return (bf16)((u + 0x7fffu + ((u >> 16) & 1u)) >> 16); }
__device__ __forceinline__ float wave_sum(float v) {
#pragma unroll
    for (int o = 1; o < 64; o <<= 1) v += __shfl_xor(v, o);
    return v;
}
__device__ __forceinline__ float log_sigmoid(float z) { return fminf(z, 0.f) - log1pf(expf(-fabsf(z))); }
__device__ __forceinline__ float sigmoidf(float z) { return 1.f / (1.f + expf(-z)); }


namespace pk {
#define LAS __attribute__((address_space(3)))
#define GAS __attribute__((address_space(1)))
typedef short bf16x8 __attribute__((ext_vector_type(8)));
typedef short s16x4 __attribute__((ext_vector_type(4)));
typedef float f32x4 __attribute__((ext_vector_type(4)));
typedef float f32x16 __attribute__((ext_vector_type(16)));
typedef unsigned u32x4 __attribute__((ext_vector_type(4)));
typedef unsigned u32x2 __attribute__((ext_vector_type(2)));
constexpr int NWAVES = 8, NTHREADS = 512;
constexpr int BM = 256, BK = 64, HALF = 128, HTB = HALF * BK * 2, STAGE_BYTES = 8 * HTB, NXCD = 8, WGM = 8;
constexpr int RING_OFF = 0, RING_BYTES = 131072;
constexpr int MISC_OFF = RING_BYTES;
constexpr int ROWTOK_OFF = MISC_OFF + 256;
constexpr int LDS_BYTES = 155648;
static_assert(ROWTOK_OFF + 6 * 1024 <= LDS_BYTES, "LDS map");

__device__ __forceinline__ int lds_byte(int r, int c) { const int st = (r >> 4) * 2 + (c >> 5), rr = r & 15, cc = c & 31, ob = rr * 64 + cc * 2; return st * 1024 + (ob ^ (((ob >> 9) & 1) << 5)); }
__device__ __forceinline__ void stage_rc(int b, int& R, int& C) { const int st = b / 1024, sb = b % 1024, swz = sb ^ (((sb >> 9) & 1) << 5); R = (st >> 1) * 16 + swz / 64; C = (st & 1) * 32 + (swz % 64) / 2; }
__device__ __forceinline__ unsigned cvt_pk_bf16(float lo, float hi) { unsigned r; asm volatile("v_cvt_pk_bf16_f32 %0, %1, %2" : "=v"(r) : "v"(lo), "v"(hi)); return r; }
__device__ __forceinline__ int perm8(int c) { return (c & ~31) | (16 * ((c >> 2) & 1) + 4 * ((c >> 3) & 3) + (c & 3)); }
__device__ __forceinline__ int head64(int c) { return 128 * ((c >> 5) & 1) + 32 * (c >> 6) + 16 * ((c >> 2) & 1) + 4 * ((c >> 3) & 3) + (c & 3); }

__device__ __forceinline__ int fresh_lane() { int l; asm volatile("v_mbcnt_lo_u32_b32 %0, -1, 0\n\tv_mbcnt_hi_u32_b32 %0, -1, %0" : "=v"(l)); return l; }
__device__ __forceinline__ int fresh_tid(int wave_s) { asm volatile("" : "+s"(wave_s)); return wave_s * 64 + fresh_lane(); }
constexpr int PROBE_SEC = -1;
constexpr int PSEC_OFF = 131072 + 256 + 6144 + 512;
#define PSEC_BEGIN(id) unsigned long long _ps##id = 0; if (PROBE_SEC == (id) && bid == 0 && wave_s == 0) _ps##id = __builtin_amdgcn_s_memrealtime()
#define PSEC_END(id) do { if (PROBE_SEC == (id) && bid == 0 && wave_s == 0) { const unsigned d_ = (unsigned)(__builtin_amdgcn_s_memrealtime() - _ps##id); volatile LAS unsigned* a_ = (volatile LAS unsigned*)(lds + PSEC_OFF); if (fresh_lane() == 0) a_[0] = a_[0] + d_; } } while (0)
struct Unit { const char* A; const char* B; int pm, pn, e, ord; };

struct TileOrder {
    const char* A; const char* Bt; int K, nM, nN, nwg, G, c;
    __device__ void init(const void* A_, const void* Bt_, int M, int N, int K_, int G_, int c_) { A = (const char*)A_; Bt = (const char*)Bt_; K = K_; nM = M / BM; nN = N / BM; nwg = nM * nN; G = G_; c = c_; }
    __device__ __forceinline__ bool next(int i, Unit& u) const {
        const long L = (long)i * G + c; if (L >= nwg) return false;
        int wgid = (int)L; { const int q = nwg / NXCD, r = nwg % NXCD, xcd = wgid % NXCD, off = wgid / NXCD; wgid = (xcd < r ? xcd * (q + 1) : r * (q + 1) + (xcd - r) * q) + off; }
        const int nig = WGM * nN, gid = wgid / nig, fm = gid * WGM, gsz = (nM - fm) < WGM ? (nM - fm) : WGM;
        u.pm = fm + ((wgid % nig) % gsz); u.pn = (wgid % nig) / gsz; u.e = 0; u.ord = i;
        u.A = A + (size_t)u.pm * BM * K * 2; u.B = Bt + (size_t)u.pn * BM * K * 2; return true;
    }
    __device__ __forceinline__ unsigned a_off(const Unit&, int h, int R, int C) const { return (unsigned)((R + HALF * h) * K + C) * 2u; }
};

template <class Epi, class Sched>
__device__ __forceinline__ void gemm_phase(LAS unsigned char* lds, const int K, const Sched& S, const Epi& E, const int wave_s) {
    const int tid = fresh_tid(wave_s), wid = wave_s, lane = tid & 63, wr = wid >> 2, wc = wid & 3, fr = lane & 15, fq = lane >> 4;
    const int nt = K / BK;
    int sR[2], sC[2];
    unsigned voffA[2][2], voffB[2];
#pragma unroll
    for (int i = 0; i < 2; ++i) { stage_rc(tid * 16 + i * 8192, sR[i], sC[i]); voffB[i] = (unsigned)(sR[i] * K + sC[i]) * 2u; }
    const size_t kstep = (size_t)(BK * 2);
    const size_t hstep = (size_t)HALF * K * 2;
    const unsigned ldsw = (unsigned)wid * 1024u;
    const int aoff = lds_byte(wr * 64 + fr, fq * 8), boff = lds_byte(wc * 32 + fr, fq * 8);
#define PG8_SA(b, h) (((b) * 2 + (h)) * HTB)
#define PG8_SB(b, h) ((4 + (b) * 2 + (h)) * HTB)
#define PG8_STAGE(bufoff, gbase, voff) do { _Pragma("unroll") for (int _i = 0; _i < 2; ++_i) \
        __builtin_amdgcn_global_load_lds((const unsigned*)((const char*)(gbase) + (voff)[_i]), (LAS unsigned*)(lds + (bufoff) + ldsw + _i * 8192), 16, 0, 0); } while (0)
#define PG8_LDA(dst, b, h) do { _Pragma("unroll") for (int m = 0; m < 4; ++m) _Pragma("unroll") for (int k = 0; k < 2; ++k) dst[m][k] = *(const LAS bf16x8*)(lds + PG8_SA(b, h) + aoff + m * 2048 + k * 1024); } while (0)
#define PG8_LDB(dst, b, h) do { _Pragma("unroll") for (int n = 0; n < 2; ++n) _Pragma("unroll") for (int k = 0; k < 2; ++k) dst[n][k] = *(const LAS bf16x8*)(lds + PG8_SB(b, h) + boff + n * 2048 + k * 1024); } while (0)
#define PG8_MMA(ai, bj, At, Bt) do { __builtin_amdgcn_s_setprio(1); _Pragma("unroll") for (int m = 0; m < 4; ++m) _Pragma("unroll") for (int n = 0; n < 2; ++n) _Pragma("unroll") for (int k = 0; k < 2; ++k) \
        acc[ai][bj][m][n] = __builtin_amdgcn_mfma_f32_16x16x32_bf16(Bt[n][k], At[m][k], acc[ai][bj][m][n], 0, 0, 0); __builtin_amdgcn_s_setprio(0); } while (0)
#define PG8_WAIT_V(n) asm volatile("s_waitcnt vmcnt(" #n ")" ::: "memory")
#define PG8_WAIT_L(n) asm volatile("s_waitcnt lgkmcnt(" #n ")" ::: "memory")
#define PG8_BAR __builtin_amdgcn_s_barrier()
#define PG8_SCHED __builtin_amdgcn_sched_barrier(0)
    Unit cur, nxt; int ui = 0;
    if (!S.next(0, cur)) return;
    f32x4 acc[2][2][4][2];
#pragma unroll
    for (int a = 0; a < 2; ++a)
#pragma unroll
        for (int b = 0; b < 2; ++b)
#pragma unroll
            for (int m = 0; m < 4; ++m)
#pragma unroll
                for (int n = 0; n < 2; ++n) acc[a][b][m][n] = (f32x4){0.f, 0.f, 0.f, 0.f};
    bf16x8 At[4][2], B0[2][2], B1[2][2];
    const char* cA = cur.A; const char* cB = cur.B;
#pragma unroll
    for (int h = 0; h < 2; ++h)
#pragma unroll
        for (int i = 0; i < 2; ++i) voffA[h][i] = S.a_off(cur, h, sR[i], sC[i]);
    PG8_STAGE(PG8_SB(0, 0), cB, voffB); PG8_STAGE(PG8_SB(0, 1), cB + hstep, voffB); PG8_STAGE(PG8_SA(0, 0), cA, voffA[0]); PG8_STAGE(PG8_SA(0, 1), cA, voffA[1]);
    if (wr == 1) PG8_BAR;
    PG8_WAIT_V(2); PG8_BAR;
    PG8_STAGE(PG8_SB(1, 0), cB + kstep, voffB); PG8_STAGE(PG8_SA(1, 0), cA + kstep, voffA[0]); PG8_STAGE(PG8_SB(1, 1), cB + hstep + kstep, voffB);
    PG8_WAIT_V(6); PG8_BAR;
    for (;;) {
        const bool has_next = S.next(ui + 1, nxt);
        const char* nA = has_next ? nxt.A : cA; const char* nB = has_next ? nxt.B : cB;
        for (int t = 0; t < nt; t += 2) {
            const bool last = (t == nt - 2);
            const char* a1 = cA + (size_t)(t + 1) * kstep;
            const char* a2 = last ? nA : cA + (size_t)(t + 2) * kstep; const char* b2 = last ? nB : cB + (size_t)(t + 2) * kstep;
            const char* a3 = a2 + kstep; const char* b3 = b2 + kstep;
            PG8_LDB(B0, 0, 0); PG8_LDB(B1, 0, 1); PG8_SCHED; PG8_LDA(At, 0, 0); PG8_STAGE(PG8_SA(1, 1), a1, voffA[1]);
            if (last && has_next) {
#pragma unroll
                for (int h = 0; h < 2; ++h)
#pragma unroll
                    for (int i = 0; i < 2; ++i) { int R2, C2; stage_rc(fresh_tid(wave_s) * 16 + i * 8192, R2, C2); voffA[h][i] = S.a_off(nxt, h, R2, C2); }
            }
            PG8_WAIT_V(8); PG8_WAIT_L(0); PG8_BAR; PG8_MMA(0, 0, At, B0); PG8_MMA(0, 1, At, B1); PG8_BAR; PG8_SCHED;
            PG8_LDA(At, 0, 1); PG8_STAGE(PG8_SB(0, 0), b2, voffB); PG8_STAGE(PG8_SB(0, 1), b2 + hstep, voffB); PG8_STAGE(PG8_SA(0, 0), a2, voffA[0]);
            PG8_WAIT_V(8); PG8_WAIT_L(0); PG8_BAR; PG8_MMA(1, 0, At, B0); PG8_MMA(1, 1, At, B1); PG8_BAR; PG8_SCHED;
            PG8_LDB(B0, 1, 0); PG8_LDB(B1, 1, 1); PG8_SCHED; PG8_LDA(At, 1, 0); PG8_STAGE(PG8_SA(0, 1), a2, voffA[1]);
            PG8_WAIT_V(8); PG8_WAIT_L(0); PG8_BAR; PG8_MMA(0, 0, At, B0); PG8_MMA(0, 1, At, B1); PG8_BAR; PG8_SCHED;
            PG8_LDA(At, 1, 1); PG8_STAGE(PG8_SB(1, 0), b3, voffB); PG8_STAGE(PG8_SB(1, 1), b3 + hstep, voffB); PG8_STAGE(PG8_SA(1, 0), a3, voffA[0]);
            PG8_WAIT_V(8); PG8_WAIT_L(0); PG8_BAR; PG8_MMA(1, 0, At, B0); PG8_MMA(1, 1, At, B1); PG8_BAR; PG8_SCHED;
        }
        if (wr == 0) PG8_BAR;
        E(acc, cur, wr, wc, fr, fq);
        if (!has_next) break;
#pragma unroll
        for (int a = 0; a < 2; ++a)
#pragma unroll
            for (int b = 0; b < 2; ++b)
#pragma unroll
                for (int m = 0; m < 4; ++m)
#pragma unroll
                    for (int n = 0; n < 2; ++n) acc[a][b][m][n] = (f32x4){0.f, 0.f, 0.f, 0.f};
        cur = nxt; cA = nA; cB = nB; ++ui;
        if (wr == 1) PG8_BAR;
    }
    PG8_WAIT_V(0);
    PG8_BAR;
#undef PG8_SA
#undef PG8_SB
#undef PG8_STAGE
#undef PG8_LDA
#undef PG8_LDB
#undef PG8_MMA
#undef PG8_WAIT_V
#undef PG8_WAIT_L
#undef PG8_BAR
#undef PG8_SCHED
}

__device__ __forceinline__ void store_bf16_tile(const f32x4 (&acc)[2][2][4][2], bf16* base, int ldd, int row0, int c0, int wr, int wc, int fr, int fq) {
    bf16* rowp = base + (size_t)(row0 + wr * 64 + fr) * ldd + (c0 + wc * 32 + 8 * fq);
#pragma unroll
    for (int ai = 0; ai < 2; ++ai) {
#pragma unroll
        for (int m = 0; m < 4; ++m) {
#pragma unroll
            for (int bj = 0; bj < 2; ++bj) { const f32x4 v0 = acc[ai][bj][m][0], v1 = acc[ai][bj][m][1];
                u32x4 w; w.x = cvt_pk_bf16(v0[0], v0[1]); w.y = cvt_pk_bf16(v0[2], v0[3]); w.z = cvt_pk_bf16(v1[0], v1[1]); w.w = cvt_pk_bf16(v1[2], v1[3]);
                *(u32x4*)(rowp + bj * HALF) = w; }
            rowp += (size_t)16 * ldd; asm volatile("" : "+v"(rowp)); }
        rowp += (size_t)64 * ldd; }
}
struct EpiInA { bf16 *QK, *V, *R, *MQ;
    __device__ __forceinline__ void operator()(const f32x4 (&acc)[2][2][4][2], const Unit& u, int wr, int wc, int fr, int fq) const {
        bf16* base; int ldd, c0; const int pn = u.pn;
        if (pn < 3) { base = QK; ldd = 768; c0 = pn * 256; } else if (pn < 6) { base = V; ldd = 768; c0 = (pn - 3) * 256; } else if (pn < 9) { base = R; ldd = 768; c0 = (pn - 6) * 256; } else { base = MQ; ldd = 256; c0 = 0; }
        store_bf16_tile(acc, base, ldd, u.pm * BM, c0, wr, wc, fr, fq);
    } };
struct EpiPlain { bf16* dst; int ldd;
    __device__ __forceinline__ void operator()(const f32x4 (&acc)[2][2][4][2], const Unit& u, int wr, int wc, int fr, int fq) const { store_bf16_tile(acc, dst, ldd, u.pm * BM, u.pn * BM, wr, wc, fr, fq); } };

#define XB_TMO      128
#define XB_XCNT(j)  (256  + 64 * (j))
#define XB_XSUB(j)  (1280 + 64 * (j))
#define XB_XGEN(j)  (2304 + 64 * (j))
#define XB_TOP      3328
#define XB_TOPGEN   3392
#define XCD_BAR_WORDS 3456
#define XB_SPIN_CAP (1u << 18)
__device__ __forceinline__ unsigned xb_ld(unsigned* p)              { return __hip_atomic_load(p, __ATOMIC_RELAXED, __HIP_MEMORY_SCOPE_AGENT); }
__device__ __forceinline__ unsigned xb_add(unsigned* p, unsigned v) { return __hip_atomic_fetch_add(p, v, __ATOMIC_RELAXED, __HIP_MEMORY_SCOPE_AGENT); }
__device__ __forceinline__ unsigned xb_xcc_id() { return (unsigned)__builtin_amdgcn_s_getreg((3 << 11) | 20) & 0xFu; }
#define XB_SPIN(cond, bar) do { unsigned _sp = 0; while (cond) { __builtin_amdgcn_s_sleep(1); \
    if ((++_sp & 255u) == 0u) { if (xb_ld(&(bar)[XB_TMO])) break; if (_sp > XB_SPIN_CAP) { atomicAdd(&(bar)[XB_TMO], 1u); break; } } } } while (0)
struct XcdBarrier { unsigned* bar; unsigned x; volatile LAS unsigned* st; };
__device__ __forceinline__ XcdBarrier xcd_barrier_post(unsigned* bar, volatile LAS unsigned* st) {
    XcdBarrier b; b.bar = bar; b.x = xb_xcc_id(); b.st = st;
    if (threadIdx.x == 0) (void)xb_add(&bar[XB_XCNT(b.x)], 1u);
    return b;
}
__device__ __forceinline__ void xcd_barrier_complete(unsigned* bar, unsigned x, unsigned& nloc, unsigned& nx) {
    const unsigned G = gridDim.x * gridDim.y * gridDim.z;
    unsigned sum, cnt, mine, sp = 0u;
    for (;;) {
        sum = 0u; cnt = 0u; mine = 0u;
#pragma unroll
        for (unsigned j = 0; j < 16; ++j) { const unsigned c = xb_ld(&bar[XB_XCNT(j)]); sum += c; cnt += (c > 0u) ? 1u : 0u; mine = (j == x) ? c : mine; }
        if (sum == G) break;
        __builtin_amdgcn_s_sleep(1);
        if ((++sp & 255u) == 0u) { if (xb_ld(&bar[XB_TMO])) break; if (sp > XB_SPIN_CAP) { atomicAdd(&bar[XB_TMO], 1u); break; } }
    }
    nloc = mine > 0u ? mine : 1u; nx = cnt > 0u ? cnt : 1u;
}
__device__ __forceinline__ void xcd_barrier(const XcdBarrier& b) {
    asm volatile("s_waitcnt vmcnt(0)" ::: "memory");
    __syncthreads();
    if (threadIdx.x == 0) {
        unsigned* bar = b.bar;
        __builtin_amdgcn_s_waitcnt(0);
        unsigned nloc = b.st[0], nx = b.st[1];
        if (nloc == 0u) { xcd_barrier_complete(bar, b.x, nloc, nx); b.st[0] = nloc; b.st[1] = nx; }
        const unsigned old = xb_add(&bar[XB_XSUB(b.x)], 1u);
        const unsigned gen = old / nloc;
        if (old + 1u == (gen + 1u) * nloc) {
            __builtin_amdgcn_fence(__ATOMIC_RELEASE, "agent");
            asm volatile("s_waitcnt vmcnt(0)" ::: "memory");
            const unsigned og = xb_add(&bar[XB_TOP], 1u);
            const unsigned tg = og / nx;
            if (og + 1u == (tg + 1u) * nx) xb_add(&bar[XB_TOPGEN], 1u);
            else XB_SPIN(xb_ld(&bar[XB_TOPGEN]) == tg, bar);
            __builtin_amdgcn_fence(__ATOMIC_ACQUIRE, "agent");
            xb_add(&bar[XB_XGEN(b.x)], 1u);
            asm volatile("s_waitcnt vmcnt(0)" ::: "memory");
        } else {
            XB_SPIN(xb_ld(&bar[XB_XGEN(b.x)]) == gen, bar);
            __builtin_amdgcn_fence(__ATOMIC_ACQUIRE, "agent");
            asm volatile("s_waitcnt vmcnt(0)" ::: "memory");
        }
    }
    __syncthreads();
}
#define LDS_WAIT() asm volatile("s_waitcnt lgkmcnt(0)" ::: "memory")
__device__ __forceinline__ unsigned pk2(float lo, float hi) { return (unsigned)f2bf(lo) | ((unsigned)f2bf(hi) << 16); }

template <int CTRL> __device__ __forceinline__ float dppf(float v) { return __builtin_bit_cast(float, __builtin_amdgcn_update_dpp(0, __builtin_bit_cast(int, v), CTRL, 0xf, 0xf, true)); }
__device__ __forceinline__ float sum_swap32(float a, float b) { auto r = __builtin_amdgcn_permlane32_swap(__float_as_uint(a), __float_as_uint(b), false, false); return __uint_as_float(r[0]) + __uint_as_float(r[1]); }
__device__ __forceinline__ float sum_swap16(float a, float b) { auto r = __builtin_amdgcn_permlane16_swap(__float_as_uint(a), __float_as_uint(b), false, false); return __uint_as_float(r[0]) + __uint_as_float(r[1]); }
__device__ __forceinline__ float wsum(float v) {
    v += dppf<0xB1>(v); v += dppf<0x4E>(v); v += dppf<0x141>(v); v += dppf<0x140>(v);
    v = sum_swap16(v, v); v = sum_swap32(v, v); return v;
}
__device__ __forceinline__ float multi_reduce16(const float (&a)[16], int lane) {
    float b[8], c[4], d[2], e;
#pragma unroll
    for (int i = 0; i < 8; ++i) b[i] = sum_swap32(a[i], a[i + 8]);
#pragma unroll
    for (int i = 0; i < 4; ++i) c[i] = sum_swap16(b[i], b[i + 4]);
    { const bool hi = (lane & 8) != 0;
#pragma unroll
      for (int i = 0; i < 2; ++i) { const float send = hi ? c[i] : c[i + 2], keep = hi ? c[i + 2] : c[i]; d[i] = keep + dppf<0x140>(send); } }
    { const bool hi = (lane & 4) != 0; const float send = hi ? d[0] : d[1], keep = hi ? d[1] : d[0]; e = keep + dppf<0x141>(send); }
    e += dppf<0x4E>(e); e += dppf<0xB1>(e);
    return e;
}

__device__ __forceinline__ void row_dots16x2(const f32x4 (&v0)[4], const f32x4 (&v1)[4], const LAS float* WT, int lane, float& r0, float& r1) {
    float a0[16], a1[16];
    const LAS float* wl = WT + 4 * lane; asm volatile("" : "+v"(wl));
    f32x4 wa[8], wb[8];
#pragma unroll
    for (int q = 0; q < 8; ++q) wa[q] = *(const LAS f32x4*)(wl + (q >> 2) * D + 256 * (q & 3));
#pragma unroll
    for (int g = 0; g < 8; ++g) {
        if (g + 1 < 8) {
#pragma unroll
            for (int q = 0; q < 8; ++q) { const f32x4 w = *(const LAS f32x4*)(wl + (2 * (g + 1) + (q >> 2)) * D + 256 * (q & 3)); if (g & 1) wa[q] = w; else wb[q] = w; } }
#pragma unroll
        for (int h = 0; h < 2; ++h) { float x = 0.f, y = 0.f;
#pragma unroll
            for (int j = 0; j < 4; ++j) { const f32x4 w = (g & 1) ? wb[4 * h + j] : wa[4 * h + j];
                x += v0[j][0] * w[0] + v0[j][1] * w[1] + v0[j][2] * w[2] + v0[j][3] * w[3]; y += v1[j][0] * w[0] + v1[j][1] * w[1] + v1[j][2] * w[2] + v1[j][3] * w[3]; }
            a0[2 * g + h] = x; a1[2 * g + h] = y; }
        asm volatile("" : "+v"(a0[2 * g]), "+v"(a0[2 * g + 1]), "+v"(a1[2 * g]), "+v"(a1[2 * g + 1]));
    }
    r0 = multi_reduce16(a0, lane); r1 = multi_reduce16(a1, lane);
}
struct TItem { const float* src; bf16* WT; int K, ncols, n0, k0, kind, aux; bool ok; };
__device__ __forceinline__ int titem_dstrow(const TItem& t, int c) {
    switch (t.kind) {
        case 0: return 256 * (c >> 7) + perm8(c & 127);
        case 1: return 256 * (c >> 7) + 128 + perm8(c & 127);
        case 2: return perm8(c);
        case 3: { if (c >= 1536 && c < 1552) return -1; const int L = c < 1536 ? c : c - 16; return perm8(L); }
        case 4: { if (c < 768) return (c & ~255) + head64(c & 255); return perm8(1536 + c); }
        case 5: { if (c < 768) { const int L = 768 + c; return (L & ~255) + head64(L & 255); } if (c < 1536) return perm8(768 + c); return -1; }
        default: return perm8(t.aux * 512 + c);
    }
}
__device__ __forceinline__ void titem_load(const TItem& t, float (&r)[32]) {
#pragma unroll
    for (int i = 0; i < 32; ++i) r[i] = t.ok ? t.src[(size_t)(2 * i) * t.ncols] : 0.f;
}
__device__ __forceinline__ void titem_store(const TItem& t, const float (&r)[32], LAS float* scr, int lane) {
#pragma unroll
    for (int i = 0; i < 32; ++i) scr[(2 * i + (lane >> 5)) * 33 + (lane & 31)] = r[i];
    LDS_WAIT(); asm volatile("" ::: "memory");
    const int c = lane & 7;
#pragma unroll
    for (int j = 0; j < 4; ++j) { const int n = (lane >> 3) + 8 * j; const LAS float* s = scr + (8 * c) * 33 + n;
        u32x4 o; o.x = cvt_pk_bf16(s[0 * 33], s[1 * 33]); o.y = cvt_pk_bf16(s[2 * 33], s[3 * 33]); o.z = cvt_pk_bf16(s[4 * 33], s[5 * 33]); o.w = cvt_pk_bf16(s[6 * 33], s[7 * 33]);
        const int dr = (t.n0 + n) < t.ncols ? titem_dstrow(t, t.n0 + n) : -1;
        if (dr >= 0) *(u32x4*)(t.WT + (size_t)dr * t.K + t.k0 + 8 * c) = o; }
    LDS_WAIT(); asm volatile("" ::: "memory");
}
struct Params { const float* in[22]; float* out; unsigned char* ws; int ph_lo, ph_hi, bar_li, pad; };
enum { I_X = 0, I_MEM, I_WINA, I_WGUP, I_BGATE, I_GLAG, I_WINB, I_QNG, I_WKV, I_BFORGET, I_KNG, I_WMKV, I_WOUT, I_LMG, I_LMB, I_LFG, I_LFB, I_WR, I_BR, I_WEG, I_WEU, I_WED };
constexpr int CW_BAR = 4096;

typedef const __attribute__((address_space(4))) Params* KP;
__device__ __forceinline__ KP fresh_kp() { KP q = (KP)__builtin_amdgcn_kernarg_segment_ptr(); asm volatile("" : "+s"(q)); return q; }

constexpr int CV_STATIC = 3 * 512 + 176 + 112 + 96 + 64 + 128, CV_QUEUE = 3 * 512;
constexpr int CV_A_STATIC = 576, CV_NSTAT = CV_A_STATIC + (CV_STATIC - 1536), CV_QA = 1536 - CV_A_STATIC;
constexpr int CW_CVQ = 1040, CW_CVQA = 1056;
__device__ __forceinline__ void cv_decode(KP p, unsigned char* ws, int it, int lane, int wave, TItem& t) {
    int r = it; const float* W; int nblk, q, l = 0; t.aux = 0;
    if (r >= CV_STATIC) { r -= CV_STATIC; l = 1; }
    else if (r >= 1536) { r -= 1536;
        if (r < 176) { q = r; W = p->in[I_WINA]; t.ncols = A_IN; t.K = D; t.WT = (bf16*)(ws + WS_WA); nblk = 11; t.kind = 3; }
        else if ((r -= 176) < 112) { q = r; W = p->in[I_WINB]; t.ncols = B_IN; t.K = D; t.WT = (bf16*)(ws + WS_WB); nblk = 7; t.kind = 4; }
        else if ((r -= 112) < 96) { q = r; W = p->in[I_WKV]; t.ncols = KV_IN; t.K = D; t.WT = (bf16*)(ws + WS_WB); nblk = 6; t.kind = 5; }
        else if ((r -= 96) < 64) { const int lm = r / 32; q = r % 32; W = p->in[I_WMKV] + (size_t)lm * D * 512; t.ncols = 512; t.K = D; t.WT = (bf16*)(ws + WS_WMKV); nblk = 2; t.kind = 6; t.aux = lm; }
        else { r -= 64; const int lo = r / 64; q = r % 64; W = p->in[I_WOUT] + (size_t)lo * D * D; t.ncols = D; t.K = D; t.WT = (bf16*)(ws + WS_WO) + (size_t)lo * D * D; nblk = 4; t.kind = 2; }
        goto done; }
    if (r < 512) { const int mat = 16 * l + r / 32; q = r % 32; W = p->in[I_WEG] + (size_t)mat * D * DEXP; t.ncols = DEXP; t.K = D; t.WT = (bf16*)(ws + WS_WGU) + (size_t)mat * 1024 * D; nblk = 2; t.kind = 0; }
    else if ((r -= 512) < 512) { const int mat = 16 * l + r / 32; q = r % 32; W = p->in[I_WEU] + (size_t)mat * D * DEXP; t.ncols = DEXP; t.K = D; t.WT = (bf16*)(ws + WS_WGU) + (size_t)mat * 1024 * D; nblk = 2; t.kind = 1; }
    else { r -= 512; const int mat = 16 * l + r / 32; q = r % 32; W = p->in[I_WED] + (size_t)mat * DEXP * D; t.ncols = D; t.K = DEXP; t.WT = (bf16*)(ws + WS_WD) + (size_t)mat * D * DEXP; nblk = 4; t.kind = 2; }
done:
    t.k0 = 64 * (q / nblk); t.n0 = 256 * (q % nblk);
    const int col = t.n0 + 4 * lane; t.ok = col < t.ncols;
    t.src = W + (size_t)(t.k0 + 8 * wave) * t.ncols + (t.ok ? col : 0);
}
#define CV_TLOAD(t, r) do { _Pragma("unroll") for (int i = 0; i < 8; ++i) r[i] = t.ok ? *(const f32x4*)(t.src + (size_t)i * t.ncols) : (f32x4){0.f, 0.f, 0.f, 0.f}; } while (0)
#define CV_TSTORE(t, r) do { __syncthreads(); \
        _Pragma("unroll") for (int i = 0; i < 8; ++i) { LAS float* d_ = T + (8 * wave + i) * 257 + 4 * lane; d_[0] = r[i][0]; d_[1] = r[i][1]; d_[2] = r[i][2]; d_[3] = r[i][3]; } \
        __syncthreads(); \
        const int c_ = lane & 7; \
        _Pragma("unroll") for (int j = 0; j < 4; ++j) { const int n_ = 32 * wave + (lane >> 3) + 8 * j; const LAS float* s_ = T + (8 * c_) * 257 + n_; \
            u32x4 o_; o_.x = cvt_pk_bf16(s_[0 * 257], s_[1 * 257]); o_.y = cvt_pk_bf16(s_[2 * 257], s_[3 * 257]); o_.z = cvt_pk_bf16(s_[4 * 257], s_[5 * 257]); o_.w = cvt_pk_bf16(s_[6 * 257], s_[7 * 257]); \
            const int dr_ = (t.n0 + n_) < t.ncols ? titem_dstrow(t, t.n0 + n_) : -1; \
            if (dr_ >= 0) *(u32x4*)(t.WT + (size_t)dr_ * t.K + t.k0 + 8 * c_) = o_; } } while (0)
__device__ __forceinline__ void convert_static(KP p, unsigned char* ws, LAS unsigned char* lds, int lane, int wave, int G, int bid) {
    LAS float* T = (LAS float*)lds;
    TItem ta; f32x4 ra[8], rb[8];
#define CV_SID(s) ((s) < CV_A_STATIC ? (s) : 1536 + ((s) - CV_A_STATIC))
    int it = bid;
    if (it < CV_NSTAT) { cv_decode(p, ws, CV_SID(it), lane, wave, ta); CV_TLOAD(ta, ra); }
#pragma unroll 1
    for (; it < CV_NSTAT; it += 2 * G) {
        TItem tb; const bool hb = it + G < CV_NSTAT;
        if (hb) { cv_decode(p, ws, CV_SID(it + G), lane, wave, tb); CV_TLOAD(tb, rb); }
        CV_TSTORE(ta, ra);
        if (it + 2 * G < CV_NSTAT) { cv_decode(p, ws, CV_SID(it + 2 * G), lane, wave, ta); CV_TLOAD(ta, ra); }
        if (hb) CV_TSTORE(tb, rb);
    }
#undef CV_SID
    __syncthreads();
}
__device__ __forceinline__ void convert_from_queue(KP p, LAS unsigned char* lds, const int wave_s, int budget, const int qword = CW_CVQ, const int qbase = CV_STATIC, const int qcount = CV_QUEUE) {
    unsigned char* ws = p->ws; LAS float* T = (LAS float*)lds;
    const int tid = fresh_tid(wave_s), lane = tid & 63, wave = wave_s;
    unsigned* qh = (unsigned*)(ws + WS_CTL) + qword; volatile LAS unsigned* slotw = (volatile LAS unsigned*)(lds + MISC_OFF) + 56;
    for (int n = 0; budget < 0 || n < budget; ++n) {
        if (tid == 0) slotw[0] = __hip_atomic_fetch_add(qh, 1u, __ATOMIC_RELAXED, __HIP_MEMORY_SCOPE_AGENT);
        __syncthreads();
        const int q = (int)__builtin_amdgcn_readfirstlane(slotw[0]);
        if (q >= qcount) break;
        TItem t; f32x4 r[8]; cv_decode(p, ws, qbase + q, lane, wave, t); CV_TLOAD(t, r); CV_TSTORE(t, r);
        __syncthreads();
    }
    __syncthreads();
}
__device__ __forceinline__ void phase_prologue(KP p, LAS unsigned char* lds, int G, int bid, const int wave_s) {
    const int tid = fresh_tid(wave_s), lane = tid & 63, wave = wave_s;
    unsigned char* ws = p->ws;
    LAS float* scr = (LAS float*)(lds + wave * 8448);
    const int gw = bid * NWAVES + wave, NGW = G * NWAVES;
    constexpr int NB_A = 81, NB_B = 56, NB_KV = 48;
    constexpr int I_G = 32 * 16 * 16, I_U = I_G, I_D = 32 * 8 * 32, I_A = 16 * NB_A, I_B = 16 * NB_B, I_KV = 16 * NB_KV, I_MK = 2 * 16 * 16, I_O = 2 * 16 * 32;
    constexpr int NITEMS = I_G + I_U + I_D + I_A + I_B + I_KV + I_MK + I_O;
    auto decode = [&](int it, TItem& t) {
        int r = it; const float* W; int nblk, q; t.aux = 0;
        if (r < I_G) { const int mat = r / 256; q = r % 256; W = p->in[I_WEG] + (size_t)mat * D * DEXP; t.ncols = DEXP; t.K = D; t.WT = (bf16*)(ws + WS_WGU) + (size_t)mat * 1024 * D; nblk = 16; t.kind = 0; }
        else if ((r -= I_G) < I_U) { const int mat = r / 256; q = r % 256; W = p->in[I_WEU] + (size_t)mat * D * DEXP; t.ncols = DEXP; t.K = D; t.WT = (bf16*)(ws + WS_WGU) + (size_t)mat * 1024 * D; nblk = 16; t.kind = 1; }
        else if ((r -= I_U) < I_D) { const int mat = r / 256; q = r % 256; W = p->in[I_WED] + (size_t)mat * DEXP * D; t.ncols = D; t.K = DEXP; t.WT = (bf16*)(ws + WS_WD) + (size_t)mat * D * DEXP; nblk = 32; t.kind = 2; }
        else if ((r -= I_D) < I_A) { q = r; W = p->in[I_WINA]; t.ncols = A_IN; t.K = D; t.WT = (bf16*)(ws + WS_WA); nblk = NB_A; t.kind = 3; }
        else if ((r -= I_A) < I_B) { q = r; W = p->in[I_WINB]; t.ncols = B_IN; t.K = D; t.WT = (bf16*)(ws + WS_WB); nblk = NB_B; t.kind = 4; }
        else if ((r -= I_B) < I_KV) { q = r; W = p->in[I_WKV]; t.ncols = KV_IN; t.K = D; t.WT = (bf16*)(ws + WS_WB); nblk = NB_KV; t.kind = 5; }
        else if ((r -= I_KV) < I_MK) { const int l = r / 256; q = r % 256; W = p->in[I_WMKV] + (size_t)l * D * 512; t.ncols = 512; t.K = D; t.WT = (bf16*)(ws + WS_WMKV); nblk = 16; t.kind = 6; t.aux = l; }
        else { r -= I_MK; const int l = r / 512; q = r % 512; W = p->in[I_WOUT] + (size_t)l * D * D; t.ncols = D; t.K = D; t.WT = (bf16*)(ws + WS_WO) + (size_t)l * D * D; nblk = 32; t.kind = 2; }
        t.k0 = 64 * (q / nblk); t.n0 = 32 * (q % nblk);
        const int col = t.n0 + (lane & 31); t.ok = col < t.ncols;
        t.src = W + (size_t)(t.k0 + (lane >> 5)) * t.ncols + (t.ok ? col : 0);
    };
    { PSEC_BEGIN(20); convert_static(p, ws, lds, lane, wave, G, bid); PSEC_END(20); }
    { const f32x4* src = (const f32x4*)p->in[I_MEM]; u32x2* dst = (u32x2*)(ws + WS_MEMB);
      for (int i = bid * NTHREADS + tid; i < NB * NMEM * D / 4; i += G * NTHREADS) { const f32x4 v = src[i]; u32x2 o; o.x = pk2(v[0], v[1]); o.y = pk2(v[2], v[3]); dst[i] = o; } }
    __syncthreads();
    LAS float* WG = (LAS float*)(lds);
    for (int idx = tid; idx < 16 * D; idx += NTHREADS) { const int j = idx & 15, k = idx >> 4; WG[j * D + k] = p->in[I_WINA][(size_t)k * A_IN + 1536 + j]; }
    __syncthreads();
    bf16* XB = (bf16*)(ws + WS_XB); float* GLR = (float*)(ws + WS_GLR);
    { PSEC_BEGIN(22);
    {   f32x4 a0[4], a1[4], b0[4], b1[4];
#define P0_LOAD(va, vb, mm) do { const f32x4* xr_ = (const f32x4*)(p->in[I_X] + (size_t)(mm) * D) + lane; _Pragma("unroll") for (int j = 0; j < 4; ++j) { va[j] = xr_[64 * j]; vb[j] = xr_[64 * j + 256]; } } while (0)
#define P0_PROC(va, vb, mm) do { u32x2* o8_ = (u32x2*)(XB + (size_t)(mm) * D) + lane; \
            _Pragma("unroll") for (int j = 0; j < 4; ++j) { u32x2 o; o.x = cvt_pk_bf16(va[j][0], va[j][1]); o.y = cvt_pk_bf16(va[j][2], va[j][3]); o8_[64 * j] = o; o.x = cvt_pk_bf16(vb[j][0], vb[j][1]); o.y = cvt_pk_bf16(vb[j][2], vb[j][3]); o8_[64 * j + 256] = o; } \
            float r0_, r1_; row_dots16x2(va, vb, WG, lane, r0_, r1_); \
            if ((lane & 3) == 0) { GLR[(size_t)(mm) * 16 + (lane >> 2)] = r0_; GLR[(size_t)((mm) + 1) * 16 + (lane >> 2)] = r1_; } } while (0)
        int m = 2 * gw;
        if (m < NTOK) P0_LOAD(a0, a1, m);
#pragma unroll 1
        for (; m < NTOK; m += 4 * NGW) {
            const bool hb = m + 2 * NGW < NTOK;
            if (hb) P0_LOAD(b0, b1, m + 2 * NGW);
            P0_PROC(a0, a1, m);
            if (m + 4 * NGW < NTOK) P0_LOAD(a0, a1, m + 4 * NGW);
            if (hb) P0_PROC(b0, b1, m + 2 * NGW);
        }
#undef P0_LOAD
#undef P0_PROC
    }
    PSEC_END(22); }
}

template <bool RB> struct EpiRes { const void* xres; bf16* out;
    __device__ __forceinline__ void operator()(const f32x4 (&acc)[2][2][4][2], const Unit& u, int wr, int wc, int fr, int fq) const {
        size_t off = (size_t)(u.pm * BM + wr * 64 + fr) * D + (u.pn * BM + wc * 32 + 8 * fq);
#pragma unroll
        for (int ai = 0; ai < 2; ++ai) {
#pragma unroll
            for (int m = 0; m < 4; ++m) {
#pragma unroll
                for (int bj = 0; bj < 2; ++bj) { f32x4 x0, x1;
                    if (RB) { const u32x4 t = *(const u32x4*)((const bf16*)xres + off + bj * HALF); x0[0] = __uint_as_float(t.x << 16); x0[1] = __uint_as_float(t.x & 0xffff0000u); x0[2] = __uint_as_float(t.y << 16); x0[3] = __uint_as_float(t.y & 0xffff0000u);
                        x1[0] = __uint_as_float(t.z << 16); x1[1] = __uint_as_float(t.z & 0xffff0000u); x1[2] = __uint_as_float(t.w << 16); x1[3] = __uint_as_float(t.w & 0xffff0000u); }
                    else { x0 = *(const f32x4*)((const float*)xres + off + bj * HALF); x1 = *(const f32x4*)((const float*)xres + off + bj * HALF + 4); }
                    const f32x4 v0 = x0 * DN_ALPHA + acc[ai][bj][m][0], v1 = x1 * DN_ALPHA + acc[ai][bj][m][1];
                    u32x4 w; w.x = cvt_pk_bf16(v0[0], v0[1]); w.y = cvt_pk_bf16(v0[2], v0[3]); w.z = cvt_pk_bf16(v1[0], v1[1]); w.w = cvt_pk_bf16(v1[2], v1[3]);
                    *(u32x4*)(out + off + bj * HALF) = w; }
                off += (size_t)16 * D; asm volatile("" : "+v"(off) :: "memory"); }
            off += (size_t)64 * D; }
    } };
struct EpiInB { bf16 *Q, *K, *V, *OG, *MQ; const float* qg; const float* kg;
    __device__ __forceinline__ void operator()(const f32x4 (&acc)[2][2][4][2], const Unit& u, int wr, int wc, int fr, int fq) const {
        const int pn = u.pn;
        if (pn >= 6) { bf16* base; int ldd, c0;
            if (pn < 9) { base = V; ldd = 768; c0 = (pn - 6) * 256; } else if (pn < 12) { base = OG; ldd = 768; c0 = (pn - 9) * 256; } else { base = MQ; ldd = 256; c0 = 0; }
            store_bf16_tile(acc, base, ldd, u.pm * BM, c0, wr, wc, fr, fq); return; }
        const bool isq = pn < 3; bf16* base = isq ? Q : K; const float* g = isq ? qg : kg; const float sc = isq ? QC2 : 1.0f;
        const int c0 = (isq ? pn : pn - 3) * 256 + wc * 64 + 8 * fq, r0 = u.pm * BM + wr * 64 + fr;
        f32x4 gv[2][2];
#pragma unroll
        for (int bj = 0; bj < 2; ++bj)
#pragma unroll
            for (int n = 0; n < 2; ++n) gv[bj][n] = *(const f32x4*)(g + 32 * bj + 8 * fq + 4 * n) * sc;
        bf16* rowp = base + (size_t)r0 * 768 + c0;
#pragma unroll
        for (int ai = 0; ai < 2; ++ai) {
#pragma unroll
            for (int m = 0; m < 4; ++m) {
                float ss = 0.f;
#pragma unroll
                for (int bj = 0; bj < 2; ++bj)
#pragma unroll
                    for (int n = 0; n < 2; ++n) { const f32x4 v = acc[ai][bj][m][n]; ss += (v[0] * v[0] + v[1] * v[1]) + (v[2] * v[2] + v[3] * v[3]); }
                ss = sum_swap16(ss, ss); ss = sum_swap32(ss, ss);
                const float rs = rsqrtf(ss * (1.f / 64.f) + RMS_EPS);
#pragma unroll
                for (int bj = 0; bj < 2; ++bj) { const f32x4 v0 = acc[ai][bj][m][0] * rs * gv[bj][0], v1 = acc[ai][bj][m][1] * rs * gv[bj][1];
                    u32x4 w; w.x = cvt_pk_bf16(v0[0], v0[1]); w.y = cvt_pk_bf16(v0[2], v0[3]); w.z = cvt_pk_bf16(v1[0], v1[1]); w.w = cvt_pk_bf16(v1[2], v1[3]);
                    *(u32x4*)(rowp + 32 * bj) = w; }
                rowp += (size_t)16 * 768; asm volatile("" : "+v"(rowp)); }
            rowp += (size_t)64 * 768; }
    } };

__device__ __forceinline__ void load_wtab(LAS float* WT, const float* W, int ldw, int col0, int ncols, int tid) {
    for (int idx = tid; idx < 16 * D; idx += NTHREADS) { const int j = idx & 15, k = idx >> 4; WT[j * D + k] = j < ncols ? W[(size_t)k * ldw + col0 + j] : 0.f; }
}
__device__ __forceinline__ float row_dots16(const f32x4 (&v)[4], const LAS float* WT, int lane) {
    float acc[16];
    const LAS float* wl = WT + 4 * lane; asm volatile("" : "+v"(wl));
#pragma unroll
    for (int n = 0; n < 16; ++n) { float a = 0.f;
#pragma unroll
        for (int j = 0; j < 4; ++j) { const f32x4 w = *(const LAS f32x4*)(wl + n * D + 256 * j); a += v[j][0] * w[0] + v[j][1] * w[1] + v[j][2] * w[2] + v[j][3] * w[3]; }
        acc[n] = a; if (n & 1) asm volatile("" : "+v"(acc[n - 1]), "+v"(acc[n]) :: "memory"); }
    return multi_reduce16(acc, lane);
}
__device__ __forceinline__ void ln_row(f32x4 (&v)[4], const float* g, const float* b, int lane) {
    float s = 0.f;
#pragma unroll
    for (int j = 0; j < 4; ++j) s += (v[j][0] + v[j][1]) + (v[j][2] + v[j][3]);
    const float mean = wsum(s) * (1.f / D); float q = 0.f;
#pragma unroll
    for (int j = 0; j < 4; ++j) { v[j] = v[j] - mean; q += (v[j][0] * v[j][0] + v[j][1] * v[j][1]) + (v[j][2] * v[j][2] + v[j][3] * v[j][3]); }
    const float rstd = rsqrtf(wsum(q) * (1.f / D) + LN_EPS);
#pragma unroll
    for (int j = 0; j < 4; ++j) { const f32x4 gg = *(const f32x4*)(g + 4 * lane + 256 * j), bb = *(const f32x4*)(b + 4 * lane + 256 * j); v[j] = v[j] * rstd * gg + bb; }
}
__device__ __forceinline__ void store_row_f32_bf16(const f32x4 (&v)[4], float* xf, bf16* xb, int lane) {
#pragma unroll
    for (int j = 0; j < 4; ++j) { if (xf) ((f32x4*)xf)[lane + 64 * j] = v[j]; if (xb) { u32x2 o; o.x = cvt_pk_bf16(v[j][0], v[j][1]); o.y = cvt_pk_bf16(v[j][2], v[j][3]); ((u32x2*)xb)[lane + 64 * j] = o; } }
}

__device__ __forceinline__ void route_thread(const float (&lg)[16], const float (&brv)[16], int m, int lt, int* TOK_E, float* TOK_W, LAS int* tokE) {
    float aff[16], sel[16];
#pragma unroll
    for (int e = 0; e < 16; ++e) { aff[e] = 1.f / (1.f + __expf(-lg[e])); sel[e] = aff[e] + brv[e]; }
    int gbest = 0; float gs = -1e30f;
#pragma unroll
    for (int gi = 0; gi < 4; ++gi) { float a = -1e30f, b2 = -1e30f;
#pragma unroll
        for (int j = 0; j < 4; ++j) { const float x = sel[gi * 4 + j]; const bool gt = x > a; b2 = gt ? a : fmaxf(b2, x); a = gt ? x : a; }
        const bool better = a + b2 > gs; gs = better ? a + b2 : gs; gbest = better ? gi : gbest; }
    int i0 = 0, i1 = 0; float a = -1e30f, b2 = -1e30f, wa = 0.f, wb = 0.f;
#pragma unroll
    for (int j = 0; j < 4; ++j) { float x = sel[j], y = aff[j];
#pragma unroll
        for (int gi = 1; gi < 4; ++gi) { x = (gi == gbest) ? sel[gi * 4 + j] : x; y = (gi == gbest) ? aff[gi * 4 + j] : y; }
        const bool g1 = x > a, g2 = x > b2;
        const float nb = g1 ? a : (g2 ? x : b2), nwb = g1 ? wa : (g2 ? y : wb); const int ni1 = g1 ? i0 : (g2 ? j : i1);
        a = g1 ? x : a; wa = g1 ? y : wa; i0 = g1 ? j : i0; b2 = nb; wb = nwb; i1 = ni1; }
    const float inv = 1.f / (wa + wb); const int e0 = gbest * 4 + i0, e1 = gbest * 4 + i1;
    TOK_E[m * 2] = e0; TOK_E[m * 2 + 1] = e1; TOK_W[m * 2] = wa * inv; TOK_W[m * 2 + 1] = wb * inv; tokE[lt * 2] = e0; tokE[lt * 2 + 1] = e1;
}
__device__ __forceinline__ void phase_ln_router(KP p, int layer, LAS unsigned char* lds, int G, int bid, const int wave_s) {
    const int tid = fresh_tid(wave_s), lane = tid & 63, wave = wave_s;
    PSEC_BEGIN(0);
    unsigned char* ws = p->ws;
    LAS float* WT = (LAS float*)lds; LAS int* tokE = (LAS int*)(lds + 65536);
    load_wtab(WT, p->in[I_WR], 16, 0, 16, tid);
    __syncthreads();
    const bf16* Y1 = (const bf16*)p->out; bf16* XB = (bf16*)(ws + WS_XB); int* TOK_E = (int*)(ws + WS_TOKE); float* TOK_W = (float*)(ws + WS_TOKW); int* CNT = (int*)(ws + WS_CNT); int* SLOT_TOK = (int*)(ws + WS_SLOTTOK);
    const float* g = p->in[I_LMG] + layer * D; const float* b = p->in[I_LMB] + layer * D;
#define LNR_LOAD(va, vb, pr) do { const u32x2* s0_ = (const u32x2*)(Y1 + (size_t)(tb * 128 + wave * 16 + 2 * (pr)) * D) + lane; _Pragma("unroll") for (int j = 0; j < 4; ++j) { const u32x2 a_ = s0_[64 * j], b_ = s0_[64 * j + 256]; \
        va[j][0] = __uint_as_float(a_.x << 16); va[j][1] = __uint_as_float(a_.x & 0xffff0000u); va[j][2] = __uint_as_float(a_.y << 16); va[j][3] = __uint_as_float(a_.y & 0xffff0000u); \
        vb[j][0] = __uint_as_float(b_.x << 16); vb[j][1] = __uint_as_float(b_.x & 0xffff0000u); vb[j][2] = __uint_as_float(b_.y << 16); vb[j][3] = __uint_as_float(b_.y & 0xffff0000u); } } while (0)
#define LNR_PROC(va, vb, pr) do { const int lt_ = wave * 16 + 2 * (pr), m_ = tb * 128 + lt_; \
        { PSEC_BEGIN(1); ln_row(va, g, b, lane); ln_row(vb, g, b, lane); \
        store_row_f32_bf16(va, (float*)nullptr, XB + (size_t)m_ * D, lane); store_row_f32_bf16(vb, (float*)nullptr, XB + (size_t)(m_ + 1) * D, lane); PSEC_END(1); } \
        float l0_, l1_; { PSEC_BEGIN(2); row_dots16x2(va, vb, WT, lane, l0_, l1_); asm volatile("" : "+v"(l0_), "+v"(l1_)); PSEC_END(2); } \
        if ((lane & 3) == 0) { LG[lt_ * 16 + (lane >> 2)] = l0_; LG[(lt_ + 1) * 16 + (lane >> 2)] = l1_; } } while (0)
    LAS float* LG = (LAS float*)(lds + 65536 + 1024);
    for (int tb = bid; tb < NTOK / 128; tb += G) {
        f32x4 a0[4], a1[4], b0[4], b1[4];
        LNR_LOAD(a0, a1, 0);
#pragma unroll 1
        for (int pr = 0; pr < 8; pr += 2) {
            LNR_LOAD(b0, b1, pr + 1);
            LNR_PROC(a0, a1, pr);
            if (pr + 2 < 8) LNR_LOAD(a0, a1, pr + 2);
            LNR_PROC(b0, b1, pr + 1);
        }
        __syncthreads();
        if (tid < 128) { PSEC_BEGIN(3); float lg[16], brv[16];
#pragma unroll
            for (int q = 0; q < 4; ++q) { const f32x4 t4 = *(const LAS f32x4*)(LG + tid * 16 + 4 * q); const f32x4 b4 = *(const f32x4*)(p->in[I_BR] + 4 * q);
#pragma unroll
                for (int j = 0; j < 4; ++j) { lg[4 * q + j] = t4[j]; brv[4 * q + j] = b4[j]; } }
            route_thread(lg, brv, tb * 128 + tid, tid, TOK_E, TOK_W, tokE); PSEC_END(3); }
        __syncthreads();
        if (tid < 256) {
            const int e = tokE[tid]; int rank = 0;
            for (int i = 0; i < tid; ++i) rank += (tokE[i] == e) ? 1 : 0;
            SLOT_TOK[(e * 256 + tb) * 128 + rank] = tb * 256 + tid;
        } else if (tid < 272) { const int e = tid - 256; int c = 0; for (int i = 0; i < 256; ++i) c += (tokE[i] == e) ? 1 : 0; CNT[tb * 16 + e] = c; }
        __syncthreads();
    }
    PSEC_END(0);
#undef LNR_LOAD
#undef LNR_PROC
}
struct FfnRow { u32x2 x[4], ya[4], yc[4]; float w0, w1; };
__device__ __forceinline__ void ffn_combine(FfnRow& r, f32x4 (&v)[4]) {
#pragma unroll
    for (int j = 0; j < 4; ++j) { const u32x2 a = r.ya[j], c = r.yc[j]; f32x4 ya, yc;
        ya[0] = __uint_as_float(a.x << 16); ya[1] = __uint_as_float(a.x & 0xffff0000u); ya[2] = __uint_as_float(a.y << 16); ya[3] = __uint_as_float(a.y & 0xffff0000u);
        yc[0] = __uint_as_float(c.x << 16); yc[1] = __uint_as_float(c.x & 0xffff0000u); yc[2] = __uint_as_float(c.y << 16); yc[3] = __uint_as_float(c.y & 0xffff0000u);
        const u32x2 xx = r.x[j]; f32x4 xv; xv[0] = __uint_as_float(xx.x << 16); xv[1] = __uint_as_float(xx.x & 0xffff0000u); xv[2] = __uint_as_float(xx.y << 16); xv[3] = __uint_as_float(xx.y & 0xffff0000u);
        v[j] = xv * DN_ALPHA + ya * r.w0 + yc * r.w1; }
}
__device__ __forceinline__ void phase_ln_ffn(KP p, int layer, LAS unsigned char* lds, int G, int bid, const int wave_s) {
    const int tid = fresh_tid(wave_s), lane = tid & 63, wave = wave_s;
    unsigned char* ws = p->ws;
    LAS float* WT = (LAS float*)lds;
    if (layer == 0) { load_wtab(WT, p->in[I_WKV], KV_IN, 1536, 12, tid); __syncthreads(); }
    const int eo = (lane >> 2) & 15; const float bf = (layer == 0 && eo < 12) ? p->in[I_BFORGET][eo] : 0.f;
    float* XF = p->out; bf16* XB = (bf16*)(ws + WS_XB); const bf16* YS = (const bf16*)(ws + WS_HREG);
    const int* TOK_S = (const int*)(ws + WS_TOKS); const float* TOK_W = (const float*)(ws + WS_TOKW); float* LOGF = (float*)(ws + WS_LOGF);
    const float* g = p->in[I_LFG] + layer * D; const float* b = p->in[I_LFB] + layer * D;
    const int gw = bid * NWAVES + wave, NGW = G * NWAVES;
#define FFN_LOAD(R, m_) do { const int mm_ = (m_); int mv_ = mm_ * 2; asm volatile("" : "+v"(mv_));        \
        const int s0_ = TOK_S[mv_], s1_ = TOK_S[mv_ + 1]; R.w0 = TOK_W[mv_]; R.w1 = TOK_W[mv_ + 1]; \
        _Pragma("unroll") for (int j = 0; j < 4; ++j) { R.x[j] = ((const u32x2*)(XB + (size_t)mm_ * D))[lane + 64 * j]; R.ya[j] = ((const u32x2*)(YS + (size_t)s0_ * D))[lane + 64 * j]; R.yc[j] = ((const u32x2*)(YS + (size_t)s1_ * D))[lane + 64 * j]; } } while (0)
#define FFN_PROC(R, m_) do { const int mm_ = (m_); f32x4 v_[4]; ffn_combine(R, v_); ln_row(v_, g, b, lane); \
        store_row_f32_bf16(v_, layer == 0 ? (float*)nullptr : XF + (size_t)mm_ * D, layer == 0 ? XB + (size_t)mm_ * D : (bf16*)nullptr, lane); \
        if (layer == 0) { const float t_ = row_dots16(v_, WT, lane); if ((lane & 3) == 0 && eo < 12) LOGF[(size_t)mm_ * 12 + eo] = log_sigmoid(t_ + bf); } } while (0)
    FfnRow A0, A1, B0, B1;
#define FFN_PROC2(R0, R1, m0_, m1_) do { const int ma_ = (m0_), mb_ = (m1_); f32x4 va_[4], vb_[4]; ffn_combine(R0, va_); ffn_combine(R1, vb_); ln_row(va_, g, b, lane); ln_row(vb_, g, b, lane); \
        store_row_f32_bf16(va_, layer == 0 ? (float*)nullptr : XF + (size_t)ma_ * D, layer == 0 ? XB + (size_t)ma_ * D : (bf16*)nullptr, lane); \
        store_row_f32_bf16(vb_, layer == 0 ? (float*)nullptr : XF + (size_t)mb_ * D, layer == 0 ? XB + (size_t)mb_ * D : (bf16*)nullptr, lane); \
        if (layer == 0) { float ta_, tb_; row_dots16x2(va_, vb_, WT, lane, ta_, tb_); if ((lane & 3) == 0 && eo < 12) { LOGF[(size_t)ma_ * 12 + eo] = log_sigmoid(ta_ + bf); LOGF[(size_t)mb_ * 12 + eo] = log_sigmoid(tb_ + bf); } } } while (0)
    int m = gw;
    if (m + NGW < NTOK) { FFN_LOAD(A0, m); FFN_LOAD(A1, m + NGW); }
#pragma unroll 1
    for (; m + NGW < NTOK; m += 4 * NGW) {
        const bool hb = (m + 3 * NGW) < NTOK;
        if (hb) { FFN_LOAD(B0, m + 2 * NGW); FFN_LOAD(B1, m + 3 * NGW); }
        FFN_PROC2(A0, A1, m, m + NGW);
        if (m + 5 * NGW < NTOK) { FFN_LOAD(A0, m + 4 * NGW); FFN_LOAD(A1, m + 5 * NGW); }
        if (hb) FFN_PROC2(B0, B1, m + 2 * NGW, m + 3 * NGW); else { m += 2 * NGW; break; }
    }
    if (m < NTOK) { FFN_LOAD(A0, m); FFN_PROC(A0, m); }
#undef FFN_PROC2
#undef FFN_LOAD
#undef FFN_PROC
}
__device__ __forceinline__ void cum_wave(const float* LOGF, float* CUM, int bh, int lane) {
    const int b = bh / FOX_H, h = bh % FOX_H;
    float loc[64]; float s = 0.f;
#pragma unroll
    for (int i = 0; i < 64; ++i) { s += LOGF[((size_t)b * SEQ + lane * 64 + i) * 12 + h]; loc[i] = s; }
    float inc = s;
#pragma unroll
    for (int o = 1; o < 64; o <<= 1) { const float t = __shfl_up(inc, o); if (lane >= o) inc += t; }
    const float base = inc - s;
#pragma unroll
    for (int i = 0; i < 64; ++i) CUM[(size_t)bh * SEQ + lane * 64 + i] = base + loc[i];
}
constexpr int MOE_MAXU = 6;
__device__ __forceinline__ int moe_setup(unsigned char* ws, LAS unsigned char* lds, int G, int bid, const int wave_s, const bool build_rows) {
    const int tid = fresh_tid(wave_s), lane = tid & 63, wave = wave_s;
    LAS int* PRE = (LAS int*)lds; LAS int* TB = (LAS int*)(lds + 16640); LAS int* TE = TB + 17;
    volatile LAS int* UL = (volatile LAS int*)(lds + MISC_OFF) + 16; LAS int* rowtok = (LAS int*)(lds + ROWTOK_OFF);
    const int* CNT = (const int*)(ws + WS_CNT); const int* SLOT_TOK = (const int*)(ws + WS_SLOTTOK); int* TOK_S = (int*)(ws + WS_TOKS);
#pragma unroll
    for (int q = 0; q < 2; ++q) { const int e = 2 * wave + q;
        int c[4]; int s = 0;
#pragma unroll
        for (int i = 0; i < 4; ++i) { c[i] = CNT[(4 * lane + i) * 16 + e]; s += c[i]; }
        int inc = s;
#pragma unroll
        for (int o = 1; o < 64; o <<= 1) { const int t = __shfl_up(inc, o); if (lane >= o) inc += t; }
        int run = inc - s;
#pragma unroll
        for (int i = 0; i < 4; ++i) { PRE[e * 257 + 4 * lane + i] = run; run += c[i]; }
        if (lane == 63) { PRE[e * 257 + 256] = inc; TE[e] = inc; } }
    __syncthreads();
    if (tid <= 16) { int t = 0; for (int e = 0; e < 16; ++e) { if (e < tid) t += (TE[e] + 255) >> 8; } TB[tid] = t; }
    __syncthreads();
    const int NT = TB[16];
    if (tid < MOE_MAXU) { const int L = tid * G + bid, tile = (L & 7) + 8 * (L >> 5), pn = (L >> 3) & 3;
        int e = 0;
#pragma unroll
        for (int k = 1; k < 16; ++k) e += (TB[k] <= tile) ? 1 : 0;
        UL[3 * tid] = tile; UL[3 * tid + 1] = pn; UL[3 * tid + 2] = e; UL[32 + tid] = (tile < NT) ? 1 : 0; }
    __syncthreads();
    if (tid == 0) { int n = 0;
#pragma unroll
        for (int i = 0; i < MOE_MAXU; ++i) n += (int)UL[32 + i]; UL[24] = n; UL[25] = 32 * ((NT + 7) >> 3); }
    __syncthreads();
    const int nunits = __builtin_amdgcn_readfirstlane(UL[24]);
    if (build_rows) {
        for (int i = (tid >> 8); i < nunits; i += 2) { const int tile = UL[3 * i], pn = UL[3 * i + 1], e = UL[3 * i + 2], j = tid & 255;
            const int r = 256 * (tile - TB[e]) + j; int tok = 0;
            if (r < TE[e]) { int lo = 0, hi = 256;
                while (hi - lo > 1) { const int mid = (lo + hi) >> 1; if (PRE[e * 257 + mid] <= r) lo = mid; else hi = mid; }
                const int ent = SLOT_TOK[(e * 256 + lo) * 128 + (r - PRE[e * 257 + lo])]; tok = ent >> 1;
                if (pn == 0) TOK_S[ent] = 256 * tile + j; }
            rowtok[i * 256 + j] = tok; }
    }
    __syncthreads();
    return nunits;
}
struct MoeGU {
    const char* XBp; const char* W; LAS const int* UL; LAS const int* rowtok; int nunits;
    __device__ __forceinline__ bool next(int i, Unit& u) const { if (i >= nunits) return false;
        u.pm = __builtin_amdgcn_readfirstlane(UL[3 * i]); u.pn = __builtin_amdgcn_readfirstlane(UL[3 * i + 1]); u.e = __builtin_amdgcn_readfirstlane(UL[3 * i + 2]); u.ord = i;
        u.A = XBp; u.B = W + ((size_t)u.e * 1024 + (size_t)u.pn * 256) * D * 2; return true; }
    __device__ __forceinline__ unsigned a_off(const Unit& u, int h, int R, int C) const { return (unsigned)(rowtok[u.ord * 256 + R + HALF * h] * D + C) * 2u; }
};
struct MoeDown {
    const char* Hp; const char* W; LAS const int* UL; int nunits;
    __device__ __forceinline__ bool next(int i, Unit& u) const { if (i >= nunits) return false;
        u.pm = __builtin_amdgcn_readfirstlane(UL[3 * i]); u.pn = __builtin_amdgcn_readfirstlane(UL[3 * i + 1]); u.e = __builtin_amdgcn_readfirstlane(UL[3 * i + 2]); u.ord = i;
        u.A = Hp + (size_t)u.pm * BM * DEXP * 2; u.B = W + ((size_t)u.e * 1024 + (size_t)u.pn * 256) * DEXP * 2; return true; }
    __device__ __forceinline__ unsigned a_off(const Unit&, int h, int R, int C) const { return (unsigned)((R + HALF * h) * DEXP + C) * 2u; }
};
struct EpiGateUp { bf16* H;
    __device__ __forceinline__ void operator()(const f32x4 (&acc)[2][2][4][2], const Unit& u, int wr, int wc, int fr, int fq) const {
        bf16* rowp = H + (size_t)(u.pm * BM + wr * 64 + fr) * DEXP + (u.pn * 128 + wc * 32 + 8 * fq);
#pragma unroll
        for (int ai = 0; ai < 2; ++ai) {
#pragma unroll
            for (int m = 0; m < 4; ++m) { float hv[8];
#pragma unroll
                for (int n = 0; n < 2; ++n)
#pragma unroll
                    for (int j = 0; j < 4; ++j) { const float g = acc[ai][0][m][n][j], up = acc[ai][1][m][n][j]; hv[4 * n + j] = g * __builtin_amdgcn_rcpf(1.f + __expf(-g)) * up; }
                u32x4 w; w.x = cvt_pk_bf16(hv[0], hv[1]); w.y = cvt_pk_bf16(hv[2], hv[3]); w.z = cvt_pk_bf16(hv[4], hv[5]); w.w = cvt_pk_bf16(hv[6], hv[7]);
                *(u32x4*)rowp = w;
                rowp += (size_t)16 * DEXP; asm volatile("" : "+v"(rowp)); }
            rowp += (size_t)64 * DEXP; }
    } };
__device__ __forceinline__ int crow(int r, int hi) { return (r & 3) + 8 * (r >> 2) + 4 * hi; }
__device__ __forceinline__ unsigned cvtpk_s(float lo, float hi) { typedef float f2 __attribute__((ext_vector_type(2))); typedef __bf16 b2 __attribute__((ext_vector_type(2))); f2 v = {lo, hi}; b2 b = __builtin_convertvector(v, b2); return __builtin_bit_cast(unsigned, b); }
__device__ __forceinline__ float bfbits2f(unsigned short v) { return __uint_as_float(((unsigned)v) << 16); }

constexpr int AT_NSLOT = 4, AT_SLOT = 16640, AT_K = 0, AT_V = 8192, AT_KB = 16384, AT_WS = AT_NSLOT * AT_SLOT, AT_OST = AT_WS + 2048, AT_BYTES = AT_OST + 8 * 4096;
static_assert(AT_BYTES <= RING_BYTES, "attention LDS");
__device__ __forceinline__ void glds_asm16(const void* gsrc, unsigned lds_dst) { unsigned keep;
    asm volatile("s_mov_b32 %0, m0\n\ts_mov_b32 m0, %2\n\ts_nop 0\n\tglobal_load_lds_dwordx4 %1, off\n\ts_mov_b32 m0, %0" : "=&s"(keep) : "v"(gsrc), "s"(lds_dst) : "memory"); }
__device__ __forceinline__ void glds_asm4(const void* gsrc, unsigned lds_dst) { unsigned keep;
    asm volatile("s_mov_b32 %0, m0\n\ts_mov_b32 m0, %2\n\ts_nop 0\n\tglobal_load_lds_dword %1, off\n\ts_mov_b32 m0, %0" : "=&s"(keep) : "v"(gsrc), "s"(lds_dst) : "memory"); }
constexpr float AT_THR = 10.0f, AT_SKIP = 40.0f;
template <bool FOX>
__device__ __forceinline__ void attn_qk(const LAS unsigned char* slot, const bf16x8 (&qr)[4], float mref, f32x16& p0, f32x16& p1, int r32, int hi) {
    const LAS unsigned char* kb = slot + AT_K + hi * 1024 + r32 * 16; const LAS float* kbs = (const LAS float*)(slot + AT_KB);
    if (FOX) { const float nm = -mref;
#pragma unroll
        for (int g = 0; g < 4; ++g) { const f32x4 b0 = *(const LAS f32x4*)(kbs + 8 * g + 4 * hi), b1 = *(const LAS f32x4*)(kbs + 32 + 8 * g + 4 * hi);
#pragma unroll
            for (int j = 0; j < 4; ++j) { p0[4 * g + j] = __builtin_fmaf(b0[j], -LOG2E, nm); p1[4 * g + j] = __builtin_fmaf(b1[j], -LOG2E, nm); } }
    } else { p0 = f32x16{}; p1 = f32x16{}; }
#pragma unroll
    for (int d0 = 0; d0 < 4; ++d0) { const bf16x8 b0 = *(const LAS bf16x8*)(kb + d0 * 2048), b1 = *(const LAS bf16x8*)(kb + d0 * 2048 + 512);
        p0 = __builtin_amdgcn_mfma_f32_32x32x16_bf16(b0, qr[d0], p0, 0, 0, 0); p1 = __builtin_amdgcn_mfma_f32_32x32x16_bf16(b1, qr[d0], p1, 0, 0, 0); }
}
template <bool FOX>
__device__ __forceinline__ void attn_sm_pv(const LAS unsigned char* slot, f32x16& p0, f32x16& p1, f32x16& n0, f32x16& n1, bool has_next, f32x16 (&o)[2], float& mref, float& lrun, LAS float* wsf, int vb0, int jb, int qrel, int r32, int hi) {
    if (FOX) {
        if (jb >= 0) { const int kbase = 64 * jb + 4 * hi;
#pragma unroll
            for (int r = 0; r < 16; ++r) { const int kv = kbase + (r & 3) + 8 * (r >> 2); if (kv > qrel) p0[r] = -INFINITY; if (kv + 32 > qrel) p1[r] = -INFINITY; } }
    } else { const float nm = -mref;
#pragma unroll
        for (int r = 0; r < 16; ++r) { p0[r] = __builtin_fmaf(p0[r], QC2, nm); p1[r] = __builtin_fmaf(p1[r], QC2, nm); }
    }
    float rm = fmaxf(p0[0], p1[0]);
#pragma unroll
    for (int r = 1; r < 16; ++r) rm = fmaxf(rm, fmaxf(p0[r], p1[r]));
    { auto rr = __builtin_amdgcn_permlane32_swap(__float_as_uint(rm), __float_as_uint(rm), false, false); rm = fmaxf(__uint_as_float(rr[0]), __uint_as_float(rr[1])); }
    const bool move = (rm > AT_THR) || (lrun == 0.f && rm > -1e30f);
    if (__builtin_expect(__any(move), 0)) {
        const float dl = move ? rm : 0.f, f = __builtin_amdgcn_exp2f(fminf(-dl, 64.f));
        mref += dl; lrun *= f;
#pragma unroll
        for (int r = 0; r < 16; ++r) { p0[r] -= dl; p1[r] -= dl; }
        if (FOX && has_next) {
#pragma unroll
            for (int r = 0; r < 16; ++r) { n0[r] -= dl; n1[r] -= dl; } }
        if (hi == 0) wsf[r32] = f;
        asm volatile("s_waitcnt lgkmcnt(0)" ::: "memory");
#pragma unroll
        for (int g = 0; g < 4; ++g) { const f32x4 a = *(const LAS f32x4*)(wsf + 8 * g + 4 * hi);
#pragma unroll
            for (int j = 0; j < 4; ++j) { o[0][4 * g + j] *= a[j]; o[1][4 * g + j] *= a[j]; } }
    }
    float rs = 0.f;
#pragma unroll
    for (int r = 0; r < 16; ++r) { p0[r] = __builtin_amdgcn_exp2f(p0[r]); p1[r] = __builtin_amdgcn_exp2f(p1[r]); rs += p0[r] + p1[r]; }
    { auto rr = __builtin_amdgcn_permlane32_swap(__float_as_uint(rs), __float_as_uint(rs), false, false); rs = __uint_as_float(rr[0]) + __uint_as_float(rr[1]); }
    lrun += rs;
    u32x4 pw[4];
#pragma unroll
    for (int k = 0; k < 2; ++k) {
        pw[k] = (u32x4){cvtpk_s(p0[8 * k], p0[8 * k + 1]), cvtpk_s(p0[8 * k + 2], p0[8 * k + 3]), cvtpk_s(p0[8 * k + 4], p0[8 * k + 5]), cvtpk_s(p0[8 * k + 6], p0[8 * k + 7])};
        pw[2 + k] = (u32x4){cvtpk_s(p1[8 * k], p1[8 * k + 1]), cvtpk_s(p1[8 * k + 2], p1[8 * k + 3]), cvtpk_s(p1[8 * k + 4], p1[8 * k + 5]), cvtpk_s(p1[8 * k + 6], p1[8 * k + 7])}; }
    const int vb = vb0 + (int)(unsigned)(size_t)slot;
#pragma unroll
    for (int d0 = 0; d0 < 2; ++d0) { s16x4 vlo[4], vhi[4];
#pragma unroll
        for (int ks = 0; ks < 4; ++ks) {
            asm volatile("ds_read_b64_tr_b16 %0,%1 offset:%c2" : "=&v"(vlo[ks]) : "v"(vb), "i"(d0 * 4096 + ks * 1024) : "memory");
            asm volatile("ds_read_b64_tr_b16 %0,%1 offset:%c2" : "=&v"(vhi[ks]) : "v"(vb), "i"(d0 * 4096 + ks * 1024 + 512) : "memory"); }
        asm volatile("s_waitcnt lgkmcnt(0)" ::: "memory"); __builtin_amdgcn_sched_barrier(0);
#pragma unroll
        for (int ks = 0; ks < 4; ++ks) { const bf16x8 vf = (bf16x8){vlo[ks][0], vlo[ks][1], vlo[ks][2], vlo[ks][3], vhi[ks][0], vhi[ks][1], vhi[ks][2], vhi[ks][3]};
            o[d0] = __builtin_amdgcn_mfma_f32_32x32x16_bf16(__builtin_bit_cast(bf16x8, pw[ks]), vf, o[d0], 0, 0, 0); }
    }
}
template <bool FOX>
__device__ __forceinline__ void attn_unit(LAS unsigned char* lds, const bf16* Qp, int qpitch, const bf16* Kp, const bf16* Vp, int kvpitch, int NT, const float* cum, float qk_bound, bf16* Op, int opitch, const bf16* OGp, int gpitch, const int wave_s) {
    const int tid = fresh_tid(wave_s), lane = tid & 63, wid = wave_s, r32 = lane & 31, hi = lane >> 5; const int bid = blockIdx.x;
    LAS float* wsf = (LAS float*)(lds + AT_WS) + wid * 64;
    bf16x8 qr[4];
#pragma unroll
    for (int d0 = 0; d0 < 4; ++d0) qr[d0] = *(const bf16x8*)(Qp + (size_t)(wid * 32 + r32) * qpitch + d0 * 16 + hi * 8);
    const bf16* ksrc = Kp + (size_t)lane * kvpitch + wid * 8;
    const bf16* vsrc = Vp + (size_t)(16 * (wid & 3) + (lane >> 2)) * kvpitch + (wid >> 2) * 32 + (lane & 3) * 8;
    const int vb0 = AT_V + ((lane >> 4) & 1) * 32 + (lane & 3) * 8 + (4 * hi + ((lane & 15) >> 2)) * 64;
    float mref = 0.f, lrun = 0.f; f32x16 o[2]; o[0] = f32x16{}; o[1] = f32x16{};
    const int NTF = NT;
    if (FOX) { int i0 = NTF * 64 - 256; asm volatile("" : "+v"(i0));
        const float c0 = cum[i0], cl = cum[(lane < NTF ? lane : NTF - 1) * 64 + 63];
        const bool need = (lane < NTF) && ((c0 - cl) * LOG2E + 2.f * qk_bound >= -AT_SKIP);
        const int cnt = __builtin_popcountll(__ballot(need)); NT = cnt < 4 ? 4 : ((cnt + 1) & ~1); if (NT > NTF) NT = NTF; }
    const int qrel = wid * 32 + r32; const size_t tstep = (size_t)64 * kvpitch;
    constexpr int ND = FOX ? 3 : 2;
#define AT_TILE(tt) (FOX ? NTF - 1 - (tt) : (tt))
#define AT_ISSUE(tt) do { const unsigned sl_ = ldsb + (unsigned)(((tt) & (AT_NSLOT - 1)) * AT_SLOT); const int kt_ = AT_TILE(tt); \
        glds_asm16(ksrc + (size_t)kt_ * tstep, (unsigned)__builtin_amdgcn_readfirstlane(sl_ + AT_K + wid * 1024)); \
        glds_asm16(vsrc + (size_t)kt_ * tstep, (unsigned)__builtin_amdgcn_readfirstlane(sl_ + AT_V + wid * 1024)); \
        if (FOX) glds_asm4(cum + kt_ * 64 + lane, (unsigned)__builtin_amdgcn_readfirstlane(sl_ + AT_KB)); } while (0)
    const unsigned ldsb = (unsigned)(size_t)lds;
    AT_ISSUE(0); AT_ISSUE(1); AT_ISSUE(2);
#define AT_WAIT1() do { if (FOX) asm volatile("s_waitcnt vmcnt(3)" ::: "memory"); else asm volatile("s_waitcnt vmcnt(2)" ::: "memory"); } while (0)
#define AT_SLOTP(tt) (lds + ((tt) & (AT_NSLOT - 1)) * AT_SLOT)
#define AT_STEP(PC0, PC1, PN0, PN1, tt) do { const int t_ = (tt); const bool hn_ = t_ + 1 < NT; \
        { PSEC_BEGIN(10); if (t_ + 2 < NT) AT_WAIT1(); else asm volatile("s_waitcnt vmcnt(0)" ::: "memory"); \
        __builtin_amdgcn_s_barrier(); asm volatile("" ::: "memory"); PSEC_END(10); } \
        { PSEC_BEGIN(11); if (t_ + 3 < NT) AT_ISSUE(t_ + 3); PSEC_END(11); } \
        { PSEC_BEGIN(12); if (hn_) attn_qk<FOX>(AT_SLOTP(t_ + 1), qr, mref, PN0, PN1, r32, hi); PSEC_END(12); } \
        { PSEC_BEGIN(13); attn_sm_pv<FOX>(AT_SLOTP(t_), PC0, PC1, PN0, PN1, hn_, o, mref, lrun, wsf, vb0, AT_TILE(t_) - (NTF - 4), qrel, r32, hi); PSEC_END(13); } } while (0)
    f32x16 a0, a1, b0, b1;
    if (FOX) asm volatile("s_waitcnt vmcnt(6)" ::: "memory"); else asm volatile("s_waitcnt vmcnt(4)" ::: "memory");
    __builtin_amdgcn_s_barrier(); asm volatile("" ::: "memory");
    attn_qk<FOX>(AT_SLOTP(0), qr, mref, a0, a1, r32, hi);
#pragma unroll 1
    for (int t = 0; t < NT; t += 2) { AT_STEP(a0, a1, b0, b1, t); AT_STEP(b0, b1, a0, a1, t + 1); }
#undef AT_STEP
#undef AT_WAIT1
#undef AT_SLOTP
#undef AT_ISSUE
#undef AT_TILE
    static_assert(ND == 3 || ND == 2, "");
    if (hi == 0) wsf[32 + r32] = lrun;
    asm volatile("s_waitcnt lgkmcnt(0)" ::: "memory");
    LAS bf16* stg = (LAS bf16*)(lds + AT_OST) + wid * 2048;
#pragma unroll
    for (int r = 0; r < 16; ++r) { const int orow = crow(r, hi); const float rl = __builtin_amdgcn_rcpf(wsf[32 + orow]);
#pragma unroll
        for (int d0 = 0; d0 < 2; ++d0) stg[orow * 64 + d0 * 32 + r32] = f2bf(o[d0][r] * rl); }
    asm volatile("s_waitcnt lgkmcnt(0)" ::: "memory");
#pragma unroll
    for (int i = 0; i < 4; ++i) { const int row = i * 8 + (lane >> 3), ch = lane & 7; u32x4 v = *(const LAS u32x4*)(stg + row * 64 + ch * 8);
        const size_t go = (size_t)(wid * 32 + row) * opitch + ch * 8;
        if (FOX) { const u32x4 g = *(const u32x4*)(OGp + (size_t)(wid * 32 + row) * gpitch + ch * 8); unsigned vv[4] = {v.x, v.y, v.z, v.w}; const unsigned gg[4] = {g.x, g.y, g.z, g.w};
#pragma unroll
            for (int k = 0; k < 4; ++k) { const float a0 = __uint_as_float(vv[k] << 16), a1 = __uint_as_float(vv[k] & 0xffff0000u), g0 = __uint_as_float(gg[k] << 16), g1 = __uint_as_float(gg[k] & 0xffff0000u);
                vv[k] = cvtpk_s(a0 * __builtin_amdgcn_rcpf(1.f + __expf(-g0)), a1 * __builtin_amdgcn_rcpf(1.f + __expf(-g1))); }
            v = (u32x4){vv[0], vv[1], vv[2], vv[3]}; }
        *(u32x4*)(Op + go) = v; }
    __syncthreads();
}
constexpr int CW_Q11 = 1024;
__device__ __forceinline__ float wave_max64(float v) {
    v = fmaxf(v, dppf<0xB1>(v)); v = fmaxf(v, dppf<0x4E>(v)); v = fmaxf(v, dppf<0x141>(v)); v = fmaxf(v, dppf<0x140>(v));
    { auto r = __builtin_amdgcn_permlane16_swap(__float_as_uint(v), __float_as_uint(v), false, false); v = fmaxf(__uint_as_float(r[0]), __uint_as_float(r[1])); }
    { auto r = __builtin_amdgcn_permlane32_swap(__float_as_uint(v), __float_as_uint(v), false, false); v = fmaxf(__uint_as_float(r[0]), __uint_as_float(r[1])); }
    return v;
}
__device__ __forceinline__ void phase_attn_b(KP p, LAS unsigned char* lds, const int wave_s) {
    unsigned char* ws = p->ws;
    const bf16* Q = (const bf16*)(ws + WS_HREG); const bf16* K = (const bf16*)(ws + WS_HREG + HR_48); const bf16* V = (const bf16*)(ws + WS_HREG + 2 * HR_48); const bf16* OG = (const bf16*)(ws + WS_HREG + 3 * HR_48);
    const bf16* MQ = (const bf16*)(ws + WS_HREG + 4 * HR_48); const bf16* MKV = (const bf16*)(ws + WS_MKV);
    const float* CUM = (const float*)(ws + WS_CUM); bf16* OC = (bf16*)(ws + WS_GREG);
    unsigned* qhead = (unsigned*)(ws + WS_CTL) + CW_Q11;
    volatile LAS unsigned* slotw = (volatile LAS unsigned*)(lds + MISC_OFF) + 48;
    float qkb; { const int lane = fresh_lane(); const float gq = wave_max64(fabsf(p->in[I_QNG][lane])), gk = wave_max64(fabsf(p->in[I_KNG][lane])); qkb = 64.f * gq * gk * QC2 * 1.02f; }
    for (;;) {
        if (fresh_tid(wave_s) == 0) slotw[0] = __hip_atomic_fetch_add(qhead, 1u, __ATOMIC_RELAXED, __HIP_MEMORY_SCOPE_AGENT);
        __syncthreads();
        const int u = (int)__builtin_amdgcn_readfirstlane(slotw[0]);
        if (u >= 1536 + 512) break;
        if (u < 1536) { const int qb = 15 - u / 96, bh = u % 96, b = bh / FOX_H, h = bh % FOX_H; const size_t row0 = (size_t)b * SEQ;
            attn_unit<true>(lds, Q + (row0 + qb * 256) * 768 + h * 64, 768, K + row0 * 768 + h * 64, V + row0 * 768 + h * 64, 768, 4 * (qb + 1), CUM + (size_t)bh * SEQ, qkb,
                            OC + (row0 + qb * 256) * D + h * 64, D, OG + (row0 + qb * 256) * 768 + h * 64, 768, wave_s); }
        else { const int m = u - 1536, b = m >> 6, hd = (m >> 4) & 3, qblk = m & 15; const size_t row0 = (size_t)b * SEQ + qblk * 256;
            const bf16* Kp = MKV + (size_t)b * NMEM * 1024 + 512 + hd * 64;
            attn_unit<false>(lds, MQ + row0 * 256 + hd * 64, 256, Kp, Kp + 256, 1024, 4, nullptr, 0.f, OC + row0 * D + 768 + hd * 64, D, nullptr, 0, wave_s); }
    }
}
__device__ __forceinline__ void phase_attn_mem(unsigned char* ws, LAS unsigned char* lds, int layer, int G, int bid, const int wave_s) {
    const bf16* MQ = (const bf16*)(ws + WS_HREG + (layer == 0 ? 3 : 4) * HR_48); const bf16* MKV = (const bf16*)(ws + WS_MKV); bf16* OC = (bf16*)(ws + (layer == 0 ? WS_XB : WS_GREG));
    for (int u = bid; u < 512; u += G) { const int b = u >> 6, hd = (u >> 4) & 3, qblk = u & 15; const size_t row0 = (size_t)b * SEQ + qblk * 256;
        const bf16* Kp = MKV + (size_t)b * NMEM * 1024 + layer * 512 + hd * 64;
        attn_unit<false>(lds, MQ + row0 * 256 + hd * 64, 256, Kp, Kp + 256, 1024, 4, nullptr, 0.f, OC + row0 * D + 768 + hd * 64, D, nullptr, 0, wave_s); }
}
constexpr int GL_QP = 208, GL_VP = 448, GL_KX = 0, GL_QD = 13312, GL_VT = 26624, GL_HEAD = 55296;
constexpr int GL_GLR = 2 * GL_HEAD, GL_TOT = GL_GLR + 4096, GL_SSX = GL_TOT + 1536, GL_BYTES = GL_SSX + 1024;
static_assert(GL_BYTES <= RING_BYTES, "GLA LDS");
typedef short v4i16_t __attribute__((ext_vector_type(4)));
__device__ __forceinline__ s16x4 trd(const LAS unsigned char* p) { return __builtin_bit_cast(s16x4, __builtin_amdgcn_ds_read_tr16_b64_v4i16((LAS v4i16_t*)p)); }
__device__ __forceinline__ float fast_log_sigmoid(float z) { return fminf(z, 0.f) - __logf(1.f + __expf(-fabsf(z))); }

template <int MODE>
__device__ __forceinline__ void gla_stage(unsigned char* ws, LAS unsigned char* lds, int tid, int b, int n, int hp) {
    const bf16* V = (const bf16*)(ws + WS_HREG + HR_48); const float* GLR = (const float*)(ws + WS_GLR); const bf16* QK = (const bf16*)(ws + WS_HREG);
    const size_t m0 = (size_t)b * SEQ + n * 64;
#pragma unroll
    for (int i = 0; i < 6; ++i) { const int pi = tid + 512 * i, u = pi / 1536, rem = pi % 1536, row = rem / 24, ch = rem % 24;
        const u32x4 v = *(const u32x4*)(V + (m0 + row) * 768 + 192 * (2 * hp + u) + 8 * ch);
        *(LAS u32x4*)(lds + u * GL_HEAD + GL_VT + row * GL_VP + ch * 16) = v; }
#pragma unroll
    for (int i = 0; i < (MODE == 1 ? 6 : 3); ++i) { const int pi = tid + 512 * i, ts = pi / 1536, rem = pi % 1536, u = rem / 768, r2 = rem % 768, row = r2 / 12, ch = r2 % 12;
        const u32x4 v = *(const u32x4*)(QK + (m0 + row) * 768 + (ts == 0 ? 384 : 0) + 96 * (2 * hp + u) + 8 * ch);
        *(LAS u32x4*)(lds + u * GL_HEAD + (ts == 0 ? GL_KX : GL_QD) + row * GL_QP + ch * 16) = v; }
    if (tid < 256) { const f32x4 g = *(const f32x4*)(GLR + m0 * 16 + 4 * tid); *(LAS f32x4*)(lds + GL_GLR + 16 * tid) = g; }
}
template <int MODE>
__device__ __forceinline__ void gla_gates(KP p, unsigned char* ws, LAS unsigned char* lds, int tid, int b, int n, int hp) {
    float* DEC = (float*)(ws + WS_DEC);
    const size_t m0 = (size_t)b * SEQ + n * 64;
    LAS float* glr = (LAS float*)(lds + GL_GLR); LAS float* totl = (LAS float*)(lds + GL_TOT);
    float la[32]; float tot = 0.f; int col = 0, th = 0, u = 0, kidx = 0, head = 0;
    if (tid < 384) { col = tid % 192; th = tid / 192; u = col / 96; kidx = col % 96; head = 2 * hp + u;
        float w[16];
#pragma unroll
        for (int j = 0; j < 16; ++j) w[j] = p->in[I_WGUP][j * 384 + 96 * head + kidx];
        const float bg = p->in[I_BGATE][96 * head + kidx];
#pragma unroll
        for (int i = 0; i < 32; ++i) { const LAS float* gr = glr + (32 * th + i) * 16; float z = bg;
#pragma unroll
            for (int j4 = 0; j4 < 4; ++j4) { const f32x4 g = *(const LAS f32x4*)(gr + 4 * j4); z += g[0] * w[4 * j4] + g[1] * w[4 * j4 + 1] + g[2] * w[4 * j4 + 2] + g[3] * w[4 * j4 + 3]; }
            la[i] = fast_log_sigmoid(z) * (1.f / 16.f); tot += la[i]; }
        totl[th * 192 + col] = tot; }
    __syncthreads();
    if (tid < 384) {
        LAS bf16* KX = (LAS bf16*)(lds + u * GL_HEAD + GL_KX); LAS bf16* QD = (LAS bf16*)(lds + u * GL_HEAD + GL_QD);
        if (MODE == 0) {
            float run = (th == 1) ? 0.f : totl[192 + col];
            float kraw[32];
#pragma unroll
            for (int i = 0; i < 32; ++i) kraw[i] = bf2f(KX[(32 * th + i) * (GL_QP / 2) + kidx]);
#pragma unroll
            for (int i = 31; i >= 0; --i) { KX[(32 * th + i) * (GL_QP / 2) + kidx] = f2bf(kraw[i] * __expf(run)); run += la[i]; }
            if (th == 0) DEC[(((size_t)b * 64 + n) * 4 + head) * 96 + kidx] = __expf(run);
        } else {
            float run = (th == 0) ? 0.f : totl[col];
            float qraw[32], kraw[32];
#pragma unroll
            for (int i = 0; i < 32; ++i) { qraw[i] = bf2f(QD[(32 * th + i) * (GL_QP / 2) + kidx]); kraw[i] = bf2f(KX[(32 * th + i) * (GL_QP / 2) + kidx]); }
#pragma unroll
            for (int i = 0; i < 32; ++i) { run += la[i]; const unsigned pk = cvt_pk_bf16(qraw[i] * __expf(run) * 0.10206207261596577f, kraw[i] * __expf(-run));
                QD[(32 * th + i) * (GL_QP / 2) + kidx] = (bf16)(pk & 0xffffu); KX[(32 * th + i) * (GL_QP / 2) + kidx] = (bf16)(pk >> 16); }
        }
    }
    __syncthreads();
}
__device__ __forceinline__ void phase_gla_kv(KP p, LAS unsigned char* lds, int G, int bid, const int wave_s) {
    unsigned char* ws = p->ws; bf16* SKV = (bf16*)(ws + WS_GREG);
    for (int unit = bid; unit < NB * 64 * 2; unit += G) {
        const int tid = fresh_tid(wave_s), lane = tid & 63, wid = wave_s;
        const int hp = unit & 1, n = (unit >> 1) & 63, b = unit >> 7;
        gla_stage<0>(ws, lds, tid, b, n, hp);
        __syncthreads();
        gla_gates<0>(p, ws, lds, tid, b, n, hp);
        const int u = wid >> 2, j4 = wid & 3, head = 2 * hp + u, r32 = lane & 31, h2 = lane >> 5, q = (lane & 15) >> 2, pp = lane & 3, g1 = (lane >> 4) & 1;
        const LAS unsigned char* ka = lds + u * GL_HEAD + GL_KX + (8 * h2 + q) * GL_QP + (16 * g1 + 4 * pp) * 2;
        const LAS unsigned char* va = lds + u * GL_HEAD + GL_VT + (8 * h2 + q) * GL_VP + (16 * g1 + 4 * pp) * 2;
        bf16* outb = SKV + ((((size_t)b * 64 + n) * 4 + head) * 192) * 96;
        for (int id = j4; id < 18; id += 4) { const int kb = id / 6, cb = id % 6;
            f32x16 acc = f32x16{};
#pragma unroll
            for (int ks = 0; ks < 4; ++ks) {
                const s16x4 a0 = trd(ka + ks * 16 * GL_QP + kb * 64), a1 = trd(ka + ks * 16 * GL_QP + 4 * GL_QP + kb * 64);
                const s16x4 b0 = trd(va + ks * 16 * GL_VP + cb * 64), b1 = trd(va + ks * 16 * GL_VP + 4 * GL_VP + cb * 64);
                acc = __builtin_amdgcn_mfma_f32_32x32x16_bf16((bf16x8){a0[0], a0[1], a0[2], a0[3], a1[0], a1[1], a1[2], a1[3]}, (bf16x8){b0[0], b0[1], b0[2], b0[3], b1[0], b1[1], b1[2], b1[3]}, acc, 0, 0, 0); }
            bf16* op = outb + (size_t)(32 * cb + r32) * 96 + 32 * kb + 4 * h2;
#pragma unroll
            for (int g = 0; g < 4; ++g) { u32x2 w; w.x = cvtpk_s(acc[4 * g], acc[4 * g + 1]); w.y = cvtpk_s(acc[4 * g + 2], acc[4 * g + 3]); *(u32x2*)(op + 8 * g) = w; }
        }
        __syncthreads();
    }
}
__device__ __forceinline__ void phase_gla_scan(unsigned char* ws, int G, int bid, const int wave_s) {
    bf16* SKV = (bf16*)(ws + WS_GREG); const float* DEC = (const float*)(ws + WS_DEC);
    const int tid = fresh_tid(wave_s);
    constexpr int NITEM = NB * 4 * 192 * 12;
    const int per = (NITEM + G - 1) / G;
    for (int it = tid; it < per; it += NTHREADS) { const int item = bid * per + it; if (item >= NITEM) break;
        const int k8 = item % 12, c = (item / 12) % 192, bh = item / (12 * 192), b = bh >> 2, h = bh & 3;
        float s[8];
#pragma unroll
        for (int j = 0; j < 8; ++j) s[j] = 0.f;
        u32x4* ptr = (u32x4*)(SKV + ((((size_t)b * 64) * 4 + h) * 192 + c) * 96 + 8 * k8); const float* dp = DEC + (((size_t)b * 64) * 4 + h) * 96 + 8 * k8;
#pragma unroll 1
        for (int n0 = 0; n0 < 64; n0 += 8) { u32x4 kv[8]; f32x4 d0[8], d1[8];
#pragma unroll
            for (int i = 0; i < 8; ++i) { kv[i] = ptr[(size_t)(n0 + i) * (4 * 192 * 96 / 8)]; d0[i] = *(const f32x4*)(dp + (size_t)(n0 + i) * 4 * 96); d1[i] = *(const f32x4*)(dp + (size_t)(n0 + i) * 4 * 96 + 4); }
#pragma unroll
            for (int i = 0; i < 8; ++i) { u32x4 o; o.x = cvtpk_s(s[0], s[1]); o.y = cvtpk_s(s[2], s[3]); o.z = cvtpk_s(s[4], s[5]); o.w = cvtpk_s(s[6], s[7]); ptr[(size_t)(n0 + i) * (4 * 192 * 96 / 8)] = o;
                const unsigned kw[4] = {kv[i].x, kv[i].y, kv[i].z, kv[i].w};
#pragma unroll
                for (int j = 0; j < 4; ++j) { const float dlo = j < 2 ? d0[i][2 * j] : d1[i][2 * j - 4], dhi = j < 2 ? d0[i][2 * j + 1] : d1[i][2 * j - 3];
                    s[2 * j] = dlo * s[2 * j] + __uint_as_float(kw[j] << 16); s[2 * j + 1] = dhi * s[2 * j + 1] + __uint_as_float(kw[j] & 0xffff0000u); } } }
    }
}
__device__ __forceinline__ void phase_gla_out(KP p, LAS unsigned char* lds, int G, int bid, const int wave_s) {
    unsigned char* ws = p->ws; const bf16* SKV = (const bf16*)(ws + WS_GREG); const bf16* R = (const bf16*)(ws + WS_HREG + 2 * HR_48); bf16* OC = (bf16*)(ws + WS_XB);
    for (int unit = bid; unit < NB * 64 * 2; unit += G) {
        const int tid = fresh_tid(wave_s), lane = tid & 63, wid = wave_s;
        const int hp = unit & 1, n = (unit >> 1) & 63, b = unit >> 7;
        u32x2 rv12[12];
        { const int tb_ = wid & 1, ch_ = (wid >> 1) & 1, head_ = 2 * hp + (wid >> 2); const size_t m_ = (size_t)b * SEQ + n * 64 + 32 * tb_ + (lane & 31);
          const bf16* rp_ = R + m_ * 768 + 192 * head_ + 96 * ch_ + 4 * (lane >> 5);
#pragma unroll
          for (int q = 0; q < 12; ++q) rv12[q] = *(const u32x2*)(rp_ + 32 * (q >> 2) + 8 * (q & 3)); }
        { PSEC_BEGIN(30); gla_stage<1>(ws, lds, tid, b, n, hp);
        __syncthreads(); PSEC_END(30); }
        { PSEC_BEGIN(31); gla_gates<1>(p, ws, lds, tid, b, n, hp); PSEC_END(31); }
        PSEC_BEGIN(32);
        const int u = wid >> 2, tb = wid & 1, ch = (wid >> 1) & 1, head = 2 * hp + u, r32 = lane & 31, h2 = lane >> 5, q = (lane & 15) >> 2, pp = lane & 3, g1 = (lane >> 4) & 1;
        const LAS unsigned char* kx = lds + u * GL_HEAD + GL_KX + r32 * GL_QP + 16 * h2;
        const LAS unsigned char* qd = lds + u * GL_HEAD + GL_QD + (32 * tb + r32) * GL_QP + 16 * h2;
        const LAS unsigned char* va = lds + u * GL_HEAD + GL_VT + (4 * h2 + q) * GL_VP + (16 * g1 + 4 * pp) * 2;
        bf16x8 qf[6];
#pragma unroll
        for (int ks = 0; ks < 6; ++ks) qf[ks] = *(const LAS bf16x8*)(qd + 32 * ks);
        f32x16 at0 = f32x16{}, at1 = f32x16{};
#pragma unroll
        for (int ks = 0; ks < 6; ++ks) at0 = __builtin_amdgcn_mfma_f32_32x32x16_bf16(*(const LAS bf16x8*)(kx + 32 * ks), qf[ks], at0, 0, 0, 0);
        if (tb == 1) {
#pragma unroll
            for (int ks = 0; ks < 6; ++ks) at1 = __builtin_amdgcn_mfma_f32_32x32x16_bf16(*(const LAS bf16x8*)(kx + 32 * GL_QP + 32 * ks), qf[ks], at1, 0, 0, 0);
        }
#pragma unroll
        for (int r = 0; r < 16; ++r) { const bool keep = crow(r, h2) <= r32; if (tb == 0) { if (!keep) at0[r] = 0.f; } else { if (!keep) at1[r] = 0.f; } }
        bf16x8 pb[4];
#pragma unroll
        for (int k2 = 0; k2 < 2; ++k2) {
            pb[k2] = __builtin_bit_cast(bf16x8, (u32x4){cvtpk_s(at0[8 * k2], at0[8 * k2 + 1]), cvtpk_s(at0[8 * k2 + 2], at0[8 * k2 + 3]), cvtpk_s(at0[8 * k2 + 4], at0[8 * k2 + 5]), cvtpk_s(at0[8 * k2 + 6], at0[8 * k2 + 7])});
            pb[2 + k2] = __builtin_bit_cast(bf16x8, (u32x4){cvtpk_s(at1[8 * k2], at1[8 * k2 + 1]), cvtpk_s(at1[8 * k2 + 2], at1[8 * k2 + 3]), cvtpk_s(at1[8 * k2 + 4], at1[8 * k2 + 5]), cvtpk_s(at1[8 * k2 + 6], at1[8 * k2 + 7])}); }
        const bf16* sg = SKV + ((((size_t)b * 64 + n) * 4 + head) * 192 + 96 * ch + r32) * 96 + 8 * h2;
        f32x16 o[3];
#pragma unroll
        for (int cbl = 0; cbl < 3; ++cbl) { const int cb = 3 * ch + cbl; f32x16 acc = f32x16{};
#pragma unroll
            for (int kq = 0; kq < 4; ++kq) { if (kq < 2 || tb == 1) {
                const s16x4 a0 = trd(va + kq * 16 * GL_VP + cb * 64), a1 = trd(va + kq * 16 * GL_VP + 8 * GL_VP + cb * 64);
                acc = __builtin_amdgcn_mfma_f32_32x32x16_bf16((bf16x8){a0[0], a0[1], a0[2], a0[3], a1[0], a1[1], a1[2], a1[3]}, pb[kq], acc, 0, 0, 0); } }
#pragma unroll
            for (int ks = 0; ks < 6; ++ks) { const bf16x8 sf = *(const bf16x8*)(sg + (size_t)(32 * cbl) * 96 + 16 * ks);
                acc = __builtin_amdgcn_mfma_f32_32x32x16_bf16(sf, qf[ks], acc, 0, 0, 0); }
            o[cbl] = acc; }
        asm volatile("" : "+v"(o[0]), "+v"(o[1]), "+v"(o[2])); PSEC_END(32);
        PSEC_BEGIN(33);
        float ss = 0.f;
#pragma unroll
        for (int cbl = 0; cbl < 3; ++cbl)
#pragma unroll
            for (int r = 0; r < 16; ++r) ss += o[cbl][r] * o[cbl][r];
        { auto rr = __builtin_amdgcn_permlane32_swap(__float_as_uint(ss), __float_as_uint(ss), false, false); ss = __uint_as_float(rr[0]) + __uint_as_float(rr[1]); }
        LAS float* ssx = (LAS float*)(lds + GL_SSX);
        if (h2 == 0) ssx[((u * 2 + tb) * 2 + ch) * 32 + r32] = ss;
        __syncthreads();
        ss += ssx[((u * 2 + tb) * 2 + (ch ^ 1)) * 32 + r32];
        const float rs = rsqrtf(ss * (1.f / 192.f) + RMS_EPS);
        const size_t m = (size_t)b * SEQ + n * 64 + 32 * tb + r32;
        bf16* op = OC + m * D + 192 * head + 96 * ch + 4 * h2; const float* gp = p->in[I_GLAG] + 96 * ch + 4 * h2;
#pragma unroll
        for (int cbl = 0; cbl < 3; ++cbl)
#pragma unroll
            for (int g = 0; g < 4; ++g) { const int co = 32 * cbl + 8 * g; const u32x2 rv = rv12[4 * cbl + g]; const f32x4 gn = *(const f32x4*)(gp + co);
                const float r0 = __uint_as_float(rv.x << 16), r1 = __uint_as_float(rv.x & 0xffff0000u), r2 = __uint_as_float(rv.y << 16), r3 = __uint_as_float(rv.y & 0xffff0000u);
                const float v0 = o[cbl][4 * g] * rs * gn[0] * (r0 * __builtin_amdgcn_rcpf(1.f + __expf(-r0))), v1 = o[cbl][4 * g + 1] * rs * gn[1] * (r1 * __builtin_amdgcn_rcpf(1.f + __expf(-r1)));
                const float v2 = o[cbl][4 * g + 2] * rs * gn[2] * (r2 * __builtin_amdgcn_rcpf(1.f + __expf(-r2))), v3 = o[cbl][4 * g + 3] * rs * gn[3] * (r3 * __builtin_amdgcn_rcpf(1.f + __expf(-r3)));
                u32x2 w; w.x = cvtpk_s(v0, v1); w.y = cvtpk_s(v2, v3); *(u32x2*)(op + co) = w; }
        __syncthreads();
        PSEC_END(33);
    }
}
constexpr int PROBE_J = -1, PROBE_B = 0, PROBE_K = 4;
__global__ void __launch_bounds__(NTHREADS, 2) mega(Params p_unused) {
    extern __shared__ __attribute__((aligned(16))) unsigned char lds_raw[];
    LAS unsigned char* lds = (LAS unsigned char*)lds_raw;
    const int G = gridDim.x, bid = blockIdx.x; const int wave_s = __builtin_amdgcn_readfirstlane(threadIdx.x >> 6);
    volatile LAS unsigned* MISC = (volatile LAS unsigned*)(lds + MISC_OFF);
    if (threadIdx.x < 64) MISC[threadIdx.x] = 0u;
    __syncthreads();
    KP p = fresh_kp();
    unsigned char* ws = p->ws;
    volatile LAS unsigned* STAMPS = (volatile LAS unsigned*)(lds + ROWTOK_OFF + 6144);
    if (PROBE_J >= 0 && threadIdx.x == 0) { const unsigned long long t_ = __builtin_amdgcn_s_memrealtime(); STAMPS[0] = (unsigned)t_; STAMPS[1] = (unsigned)(t_ >> 32); }
    if (PROBE_SEC >= 0 && threadIdx.x == 0) *(volatile LAS unsigned*)(lds + PSEC_OFF) = 0u;
    XcdBarrier bar = xcd_barrier_post((unsigned*)(ws + WS_CTL) + CW_BAR + p->bar_li * XCD_BAR_WORDS, MISC + 8);
#define WS (fresh_kp()->ws)
#define IN(k) ({ KP _q = fresh_kp(); const bool _r = _q->ph_lo <= (k) && (k) < _q->ph_hi; _r; })
#define SEAM(k) do { if (IN(k) && IN((k) + 1)) xcd_barrier(bar); if (PROBE_J >= 0 && threadIdx.x == 0) { const unsigned long long t_ = __builtin_amdgcn_s_memrealtime(); STAMPS[2 * ((k) + 1)] = (unsigned)t_; STAMPS[2 * ((k) + 1) + 1] = (unsigned)(t_ >> 32); } } while (0)

    if (IN(0)) { phase_prologue(fresh_kp(), lds, G, bid, wave_s); }
    SEAM(0);
    if (IN(1)) { unsigned char* wsl = WS;
        { TileOrder S; S.init(wsl + WS_XB, wsl + WS_WA, NTOK, 2560, D, G, bid);
          EpiInA E{(bf16*)(wsl + WS_HREG), (bf16*)(wsl + WS_HREG + HR_48), (bf16*)(wsl + WS_HREG + 2 * HR_48), (bf16*)(wsl + WS_HREG + 3 * HR_48)};
          gemm_phase(lds + RING_OFF, D, S, E, wave_s); }
    }
    SEAM(1);
    if (IN(2)) phase_gla_kv(fresh_kp(), lds, G, bid, wave_s);
    SEAM(2);
    if (IN(3)) { unsigned char* wsl = WS;
        if (G > 32 && bid < 16) { TileOrder S; S.init(wsl + WS_MEMB, wsl + WS_WMKV, NB * NMEM, 512, D, 16, bid);
            EpiPlain E{(bf16*)(wsl + WS_MKV), 1024};
            gemm_phase(lds + RING_OFF, D, S, E, wave_s); }
        else { phase_gla_scan(wsl, G > 32 ? G - 16 : G, G > 32 ? bid - 16 : bid, wave_s); __syncthreads(); if (G > 32) convert_from_queue(fresh_kp(), lds, wave_s, 4, CW_CVQA, CV_A_STATIC, CV_QA); }
        if (G <= 32) { TileOrder S; S.init(wsl + WS_MEMB, wsl + WS_WMKV, NB * NMEM, 512, D, G, bid); EpiPlain E{(bf16*)(wsl + WS_MKV), 1024}; gemm_phase(lds + RING_OFF, D, S, E, wave_s); } }
    SEAM(3);
    if (IN(4)) { phase_gla_out(fresh_kp(), lds, G, bid, wave_s); unsigned char* wsl = WS; phase_attn_mem(wsl, lds, 0, G, bid, wave_s); }
    SEAM(4);
        if (IN(5)) { unsigned char* wsl = WS;
            KP q = fresh_kp();
            TileOrder S; S.init(wsl + WS_XB, wsl + WS_WO + (size_t)0 * D * D * 2, NTOK, D, D, G, bid);
            EpiRes<false> E{(const void*)q->in[I_X], (bf16*)q->out};
            gemm_phase(lds + RING_OFF, D, S, E, wave_s);
        }
        SEAM(5);
        if (IN(5 + 1)) { phase_ln_router(fresh_kp(), 0, lds, G, bid, wave_s); convert_from_queue(fresh_kp(), lds, wave_s, -1, CW_CVQA, CV_A_STATIC, CV_QA); }
        SEAM(5 + 1);
        if (IN(5 + 2)) { unsigned char* wsl = WS;
            const int nu = moe_setup(wsl, lds, G, bid, wave_s, true);
            MoeGU S{(const char*)(wsl + WS_XB), (const char*)(wsl + WS_WGU) + (size_t)0 * NEXP * 1024 * D * 2, (LAS const int*)(lds + MISC_OFF) + 16, (LAS const int*)(lds + ROWTOK_OFF), nu};
            EpiGateUp E{(bf16*)(wsl + WS_GREG)};
            gemm_phase(lds + RING_OFF, D, S, E, wave_s);
            if (nu * G < (int)__builtin_amdgcn_readfirstlane(((volatile LAS int*)(lds + MISC_OFF))[16 + 25])) convert_from_queue(fresh_kp(), lds, wave_s, 4);
        }
        SEAM(5 + 2);
        if (IN(5 + 3)) { unsigned char* wsl = WS;
            const int nu = moe_setup(wsl, lds, G, bid, wave_s, false);
            MoeDown S{(const char*)(wsl + WS_GREG), (const char*)(wsl + WS_WD) + (size_t)0 * NEXP * 1024 * DEXP * 2, (LAS const int*)(lds + MISC_OFF) + 16, nu};
            EpiPlain E{(bf16*)(wsl + WS_HREG), 1024};
            gemm_phase(lds + RING_OFF, DEXP, S, E, wave_s);
            if (nu * G < (int)__builtin_amdgcn_readfirstlane(((volatile LAS int*)(lds + MISC_OFF))[16 + 25])) convert_from_queue(fresh_kp(), lds, wave_s, 2);
        }
        SEAM(5 + 3);
        if (IN(5 + 4)) phase_ln_ffn(fresh_kp(), 0, lds, G, bid, wave_s);

            SEAM(9);
            if (IN(10)) { unsigned char* wsl = WS;
                KP q = fresh_kp();
                TileOrder S; S.init(wsl + WS_XB, wsl + WS_WB, NTOK, 3328, D, G, bid);
                EpiInB E{(bf16*)(wsl + WS_HREG), (bf16*)(wsl + WS_HREG + HR_48), (bf16*)(wsl + WS_HREG + 2 * HR_48), (bf16*)(wsl + WS_HREG + 3 * HR_48), (bf16*)(wsl + WS_HREG + 4 * HR_48), q->in[I_QNG], q->in[I_KNG]};
                gemm_phase(lds + RING_OFF, D, S, E, wave_s);
                {
                    const int c2 = (G >= 160) ? bid - 128 : bid; const int G2 = (G >= 160) ? 16 : G;
                    if (c2 >= 0 && c2 < G2) { TileOrder S2; S2.init(wsl + WS_MEMB, wsl + WS_WMKV + (size_t)512 * D * 2, NB * NMEM, 512, D, G2, c2);
                        EpiPlain E2{(bf16*)(wsl + WS_MKV) + 512, 1024};
                        gemm_phase(lds + RING_OFF, D, S2, E2, wave_s); } }
                if (G == 256 && bid >= 144 && bid < 244) convert_from_queue(fresh_kp(), lds, wave_s, 4);
                const int gwr = (G - 1 - bid) * NWAVES + wave_s;
                if (gwr < NB * FOX_H) cum_wave((const float*)(wsl + WS_LOGF), (float*)(wsl + WS_CUM), gwr, fresh_lane());
            }
            SEAM(10);
            if (IN(11)) phase_attn_b(fresh_kp(), lds, wave_s);
            SEAM(11);
        if (IN(12)) { unsigned char* wsl = WS;
            KP q = fresh_kp();
            TileOrder S; S.init(wsl + WS_GREG, wsl + WS_WO + (size_t)1 * D * D * 2, NTOK, D, D, G, bid);
            EpiRes<true> E{(const void*)(wsl + WS_XB), (bf16*)q->out};
            gemm_phase(lds + RING_OFF, D, S, E, wave_s);
        }
        SEAM(12);
        if (IN(12 + 1)) { phase_ln_router(fresh_kp(), 1, lds, G, bid, wave_s); convert_from_queue(fresh_kp(), lds, wave_s, -1); }
        SEAM(12 + 1);
        if (IN(12 + 2)) { unsigned char* wsl = WS;
            const int nu = moe_setup(wsl, lds, G, bid, wave_s, true);
            MoeGU S{(const char*)(wsl + WS_XB), (const char*)(wsl + WS_WGU) + (size_t)1 * NEXP * 1024 * D * 2, (LAS const int*)(lds + MISC_OFF) + 16, (LAS const int*)(lds + ROWTOK_OFF), nu};
            EpiGateUp E{(bf16*)(wsl + WS_GREG)};
            gemm_phase(lds + RING_OFF, D, S, E, wave_s);
        }
        SEAM(12 + 2);
        if (IN(12 + 3)) { unsigned char* wsl = WS;
            const int nu = moe_setup(wsl, lds, G, bid, wave_s, false);
            MoeDown S{(const char*)(wsl + WS_GREG), (const char*)(wsl + WS_WD) + (size_t)1 * NEXP * 1024 * DEXP * 2, (LAS const int*)(lds + MISC_OFF) + 16, nu};
            EpiPlain E{(bf16*)(wsl + WS_HREG), 1024};
            gemm_phase(lds + RING_OFF, DEXP, S, E, wave_s);
        }
        SEAM(12 + 3);
        if (IN(12 + 4)) phase_ln_ffn(fresh_kp(), 1, lds, G, bid, wave_s);
        SEAM(16);
    if (PROBE_J >= 0 && blockIdx.x == 0 && threadIdx.x == 0) {
        const unsigned long long t1 = ((unsigned long long)STAMPS[2 * PROBE_B + 1] << 32) | STAMPS[2 * PROBE_B], t0 = ((unsigned long long)STAMPS[2 * PROBE_J + 1] << 32) | STAMPS[2 * PROBE_J];
        const unsigned long long wait = (t1 - t0) * PROBE_K, ts = __builtin_amdgcn_s_memrealtime();
        while (__builtin_amdgcn_s_memrealtime() - ts < wait) __builtin_amdgcn_s_sleep(8);
    }
    if (PROBE_SEC >= 0 && blockIdx.x == 0 && threadIdx.x == 0) {
        const unsigned long long wait = (unsigned long long)(*(volatile LAS unsigned*)(lds + PSEC_OFF)) * PROBE_K, ts = __builtin_amdgcn_s_memrealtime();
        while (__builtin_amdgcn_s_memrealtime() - ts < wait) __builtin_amdgcn_s_sleep(8);
    }
#undef IN
#undef SEAM
#undef WS
}
#undef LAS
#undef GAS
}

static int pk_grid() {
    static int grid = 0;
    if (grid == 0) {
        int dev = 0, cus = 0;
        if (hipGetDevice(&dev) != hipSuccess || hipDeviceGetAttribute(&cus, hipDeviceAttributeMultiprocessorCount, dev) != hipSuccess) { grid = -1; return grid; }
        if (hipFuncSetAttribute((const void*)pk::mega, hipFuncAttributeMaxDynamicSharedMemorySize, pk::LDS_BYTES) != hipSuccess) { fprintf(stderr, "kernel_launch: hipFuncSetAttribute failed\n"); grid = -1; return grid; }
        int per_cu = 0;
        if (hipOccupancyMaxActiveBlocksPerMultiprocessor(&per_cu, (const void*)pk::mega, pk::NTHREADS, pk::LDS_BYTES) != hipSuccess || per_cu < 1) fprintf(stderr, "kernel_launch: occupancy query says %d\n", per_cu);
        (void)hipGetLastError();
        grid = cus;
    }
    return grid;
}
static void pk_launch(pk::Params& P, int lo, int hi, hipStream_t stream) {
    const int grid = pk_grid(); if (grid <= 0) return;
    P.ph_lo = lo; P.ph_hi = hi; P.bar_li += 1;
    hipLaunchKernelGGL(pk::mega, dim3(grid), dim3(pk::NTHREADS), pk::LDS_BYTES, stream, P);
}
extern "C" void kernel_launch(void* const* d_in, const int* in_sizes, int n_in, void* d_out, int out_size, void* d_ws, size_t ws_size, hipStream_t stream) {
    if (n_in != 22 || out_size != NTOK * D || ws_size < WS_END) { fprintf(stderr, "kernel_launch: unexpected shapes (n_in %d out %d ws %zu)\n", n_in, out_size, ws_size); return; }
    const float* w_gate_up = (const float*)d_in[3]; const float* b_gate = (const float*)d_in[4]; const float* gla_g = (const float*)d_in[5];
    const float* w_eg = (const float*)d_in[19]; const float* w_eu = (const float*)d_in[20]; const float* w_ed = (const float*)d_in[21];
    unsigned char* ws = (unsigned char*)d_ws;
    float* GLR = (float*)(ws + WS_GLR); float* CUM = (float*)(ws + WS_CUM);
    bf16* MKV = (bf16*)(ws + WS_MKV);
    int* TOK_E = (int*)(ws + WS_TOKE); int* TOK_S = (int*)(ws + WS_TOKS);
    bf16* XB = (bf16*)(ws + WS_XB); bf16* YS = (bf16*)(ws + WS_HREG);
    bf16* T0 = (bf16*)(ws + WS_HREG), *T1 = (bf16*)(ws + WS_HREG + HR_48), *T2 = (bf16*)(ws + WS_HREG + 2 * HR_48), *T3 = (bf16*)(ws + WS_HREG + 3 * HR_48), *T4 = (bf16*)(ws + WS_HREG + 4 * HR_48);
    (void)hipMemsetAsync(ws + WS_CTL, 0, CTL_ZERO_BYTES, stream);
    pk::Params P{}; for (int i = 0; i < 22; ++i) P.in[i] = (const float*)d_in[i]; P.out = (float*)d_out; P.ws = ws; P.bar_li = -1;
    pk_launch(P, 0, 17, stream);
}
```

```cpp
#include <hip/hip_runtime.h>
#include <cstdio>
#include <cstdint>

typedef unsigned short bf16;
constexpr int NB = 8, SEQ = 4096, D = 1024, NTOK = NB * SEQ;
constexpr int NMEM = 256, A_IN = 2576, B_IN = 1792, KV_IN = 1548;
constexpr int GLA_H = 4, GLA_DK = 96, GLA_DV = 192, FOX_H = 12;
constexpr int NEXP = 16, DEXP = 512;
constexpr float DN_ALPHA = 1.41421356237309515f;
constexpr float LN_EPS = 1e-5f, RMS_EPS = 1e-6f;
constexpr float LOG2E = 1.4426950408889634f;
constexpr float QC2 = 0.125f * LOG2E;
constexpr size_t MiB = 1u << 20;
constexpr size_t WS_CTL = 0, CTL_ZERO_BYTES = 1 * MiB;
constexpr size_t WS_GLR = 1 * MiB, WS_LOGF = 3 * MiB, WS_CUM = 5 * MiB, WS_DEC = 7 * MiB, WS_MEMB = 8 * MiB, WS_MKV = 12 * MiB;
constexpr size_t WS_TOKE = 16 * MiB, WS_TOKW = WS_TOKE + 256 * 1024, WS_TOKS = WS_TOKW + 256 * 1024, WS_CNT = WS_TOKS + 256 * 1024, WS_SLOTTOK = 17 * MiB;
constexpr size_t WS_WA = 20 * MiB, WS_WB = 25 * MiB, WS_WMKV = 32 * MiB, WS_WO = 34 * MiB, WS_WGU = 38 * MiB, WS_WD = 102 * MiB;
constexpr size_t WS_XB = 134 * MiB, WS_GREG = 198 * MiB, WS_HREG = 270 * MiB, WS_END = 478 * MiB;
constexpr size_t HR_48 = 48 * MiB;

__device__ __forceinline__ float bf2f(bf16 v) { return __uint_as_float(((unsigned)v) << 16); }
__device__ __forceinline__ bf16 f2bf(float f) { unsigned u = __float_as_uint(f); return (bf16)((u + 0x7fffu + ((u >> 16) & 1u)) >> 16); }
__device__ __forceinline__ float wave_sum(float v) {
#pragma unroll
    for (int o = 1; o < 64; o <<= 1) v += __shfl_xor(v, o);
    return v;
}
__device__ __forceinline__ float log_sigmoid(float z) { return fminf(z, 0.f) - log1pf(expf(-fabsf(z))); }
__device__ __forceinline__ float sigmoidf(float z) { return 1.f / (1.f + expf(-z)); }


namespace pk {
#define LAS __attribute__((address_space(3)))
#define GAS __attribute__((address_space(1)))
typedef short bf16x8 __attribute__((ext_vector_type(8)));
typedef short s16x4 __attribute__((ext_vector_type(4)));
typedef float f32x4 __attribute__((ext_vector_type(4)));
typedef float f32x16 __attribute__((ext_vector_type(16)));
typedef unsigned u32x4 __attribute__((ext_vector_type(4)));
typedef unsigned u32x2 __attribute__((ext_vector_type(2)));
constexpr int NWAVES = 8, NTHREADS = 512;
constexpr int BM = 256, BK = 64, HALF = 128, HTB = HALF * BK * 2, STAGE_BYTES = 8 * HTB, NXCD = 8, WGM = 8;
constexpr int RING_OFF = 0, RING_BYTES = 131072;
constexpr int MISC_OFF = RING_BYTES;
constexpr int ROWTOK_OFF = MISC_OFF + 256;
constexpr int LDS_BYTES = 155648;
static_assert(ROWTOK_OFF + 6 * 1024 <= LDS_BYTES, "LDS map");

__device__ __forceinline__ int lds_byte(int r, int c) { const int st = (r >> 4) * 2 + (c >> 5), rr = r & 15, cc = c & 31, ob = rr * 64 + cc * 2; return st * 1024 + (ob ^ (((ob >> 9) & 1) << 5)); }
__device__ __forceinline__ void stage_rc(int b, int& R, int& C) { const int st = b / 1024, sb = b % 1024, swz = sb ^ (((sb >> 9) & 1) << 5); R = (st >> 1) * 16 + swz / 64; C = (st & 1) * 32 + (swz % 64) / 2; }
__device__ __forceinline__ unsigned cvt_pk_bf16(float lo, float hi) { unsigned r; asm volatile("v_cvt_pk_bf16_f32 %0, %1, %2" : "=v"(r) : "v"(lo), "v"(hi)); return r; }
__device__ __forceinline__ int perm8(int c) { return (c & ~31) | (16 * ((c >> 2) & 1) + 4 * ((c >> 3) & 3) + (c & 3)); }
__device__ __forceinline__ int head64(int c) { return 128 * ((c >> 5) & 1) + 32 * (c >> 6) + 16 * ((c >> 2) & 1) + 4 * ((c >> 3) & 3) + (c & 3); }

__device__ __forceinline__ int fresh_lane() { int l; asm volatile("v_mbcnt_lo_u32_b32 %0, -1, 0\n\tv_mbcnt_hi_u32_b32 %0, -1, %0" : "=v"(l)); return l; }
__device__ __forceinline__ int fresh_tid(int wave_s) { asm volatile("" : "+s"(wave_s)); return wave_s * 64 + fresh_lane(); }
constexpr int PROBE_SEC = -1;
constexpr int PSEC_OFF = 131072 + 256 + 6144 + 512;
#define PSEC_BEGIN(id) unsigned long long _ps##id = 0; if (PROBE_SEC == (id) && bid == 0 && wave_s == 0) _ps##id = __builtin_amdgcn_s_memrealtime()
#define PSEC_END(id) do { if (PROBE_SEC == (id) && bid == 0 && wave_s == 0) { const unsigned d_ = (unsigned)(__builtin_amdgcn_s_memrealtime() - _ps##id); volatile LAS unsigned* a_ = (volatile LAS unsigned*)(lds + PSEC_OFF); if (fresh_lane() == 0) a_[0] = a_[0] + d_; } } while (0)
struct Unit { const char* A; const char* B; int pm, pn, e, ord; };

struct TileOrder {
    const char* A; const char* Bt; int K, nM, nN, nwg, G, c;
    __device__ void init(const void* A_, const void* Bt_, int M, int N, int K_, int G_, int c_) { A = (const char*)A_; Bt = (const char*)Bt_; K = K_; nM = M / BM; nN = N / BM; nwg = nM * nN; G = G_; c = c_; }
    __device__ __forceinline__ bool next(int i, Unit& u) const {
        const long L = (long)i * G + c; if (L >= nwg) return false;
        int wgid = (int)L; { const int q = nwg / NXCD, r = nwg % NXCD, xcd = wgid % NXCD, off = wgid / NXCD; wgid = (xcd < r ? xcd * (q + 1) : r * (q + 1) + (xcd - r) * q) + off; }
        const int nig = WGM * nN, gid = wgid / nig, fm = gid * WGM, gsz = (nM - fm) < WGM ? (nM - fm) : WGM;
        u.pm = fm + ((wgid % nig) % gsz); u.pn = (wgid % nig) / gsz; u.e = 0; u.ord = i;
        u.A = A + (size_t)u.pm * BM * K * 2; u.B = Bt + (size_t)u.pn * BM * K * 2; return true;
    }
    __device__ __forceinline__ unsigned a_off(const Unit&, int h, int R, int C) const { return (unsigned)((R + HALF * h) * K + C) * 2u; }
};

template <class Epi, class Sched>
__device__ __forceinline__ void gemm_phase(LAS unsigned char* lds, const int K, const Sched& S, const Epi& E, const int wave_s) {
    const int tid = fresh_tid(wave_s), wid = wave_s, lane = tid & 63, wr = wid >> 2, wc = wid & 3, fr = lane & 15, fq = lane >> 4;
    const int nt = K / BK;
    int sR[2], sC[2];
    unsigned voffA[2][2], voffB[2];
#pragma unroll
    for (int i = 0; i < 2; ++i) { stage_rc(tid * 16 + i * 8192, sR[i], sC[i]); voffB[i] = (unsigned)(sR[i] * K + sC[i]) * 2u; }
    const size_t kstep = (size_t)(BK * 2);
    const size_t hstep = (size_t)HALF * K * 2;
    const unsigned ldsw = (unsigned)wid * 1024u;
    const int aoff = lds_byte(wr * 64 + fr, fq * 8), boff = lds_byte(wc * 32 + fr, fq * 8);
#define PG8_SA(b, h) (((b) * 2 + (h)) * HTB)
#define PG8_SB(b, h) ((4 + (b) * 2 + (h)) * HTB)
#define PG8_STAGE(bufoff, gbase, voff) do { _Pragma("unroll") for (int _i = 0; _i < 2; ++_i) \
        __builtin_amdgcn_global_load_lds((const unsigned*)((const char*)(gbase) + (voff)[_i]), (LAS unsigned*)(lds + (bufoff) + ldsw + _i * 8192), 16, 0, 0); } while (0)
#define PG8_LDA(dst, b, h) do { _Pragma("unroll") for (int m = 0; m < 4; ++m) _Pragma("unroll") for (int k = 0; k < 2; ++k) dst[m][k] = *(const LAS bf16x8*)(lds + PG8_SA(b, h) + aoff + m * 2048 + k * 1024); } while (0)
#define PG8_LDB(dst, b, h) do { _Pragma("unroll") for (int n = 0; n < 2; ++n) _Pragma("unroll") for (int k = 0; k < 2; ++k) dst[n][k] = *(const LAS bf16x8*)(lds + PG8_SB(b, h) + boff + n * 2048 + k * 1024); } while (0)
#define PG8_MMA(ai, bj, At, Bt) do { __builtin_amdgcn_s_setprio(1); _Pragma("unroll") for (int m = 0; m < 4; ++m) _Pragma("unroll") for (int n = 0; n < 2; ++n) _Pragma("unroll") for (int k = 0; k < 2; ++k) \
        acc[ai][bj][m][n] = __builtin_amdgcn_mfma_f32_16x16x32_bf16(Bt[n][k], At[m][k], acc[ai][bj][m][n], 0, 0, 0); __builtin_amdgcn_s_setprio(0); } while (0)
#define PG8_WAIT_V(n) asm volatile("s_waitcnt vmcnt(" #n ")" ::: "memory")
#define PG8_WAIT_L(n) asm volatile("s_waitcnt lgkmcnt(" #n ")" ::: "memory")
#define PG8_BAR __builtin_amdgcn_s_barrier()
#define PG8_SCHED __builtin_amdgcn_sched_barrier(0)
    Unit cur, nxt; int ui = 0;
    if (!S.next(0, cur)) return;
    f32x4 acc[2][2][4][2];
#pragma unroll
    for (int a = 0; a < 2; ++a)
#pragma unroll
        for (int b = 0; b < 2; ++b)
#pragma unroll
            for (int m = 0; m < 4; ++m)
#pragma unroll
                for (int n = 0; n < 2; ++n) acc[a][b][m][n] = (f32x4){0.f, 0.f, 0.f, 0.f};
    bf16x8 At[4][2], B0[2][2], B1[2][2];
    const char* cA = cur.A; const char* cB = cur.B;
#pragma unroll
    for (int h = 0; h < 2; ++h)
#pragma unroll
        for (int i = 0; i < 2; ++i) voffA[h][i] = S.a_off(cur, h, sR[i], sC[i]);
    PG8_STAGE(PG8_SB(0, 0), cB, voffB); PG8_STAGE(PG8_SB(0, 1), cB + hstep, voffB); PG8_STAGE(PG8_SA(0, 0), cA, voffA[0]); PG8_STAGE(PG8_SA(0, 1), cA, voffA[1]);
    if (wr == 1) PG8_BAR;
    PG8_WAIT_V(2); PG8_BAR;
    PG8_STAGE(PG8_SB(1, 0), cB + kstep, voffB); PG8_STAGE(PG8_SA(1, 0), cA + kstep, voffA[0]); PG8_STAGE(PG8_SB(1, 1), cB + hstep + kstep, voffB);
    PG8_WAIT_V(6); PG8_BAR;
    for (;;) {
        const bool has_next = S.next(ui + 1, nxt);
        const char* nA = has_next ? nxt.A : cA; const char* nB = has_next ? nxt.B : cB;
        for (int t = 0; t < nt; t += 2) {
            const bool last = (t == nt - 2);
            const char* a1 = cA + (size_t)(t + 1) * kstep;
            const char* a2 = last ? nA : cA + (size_t)(t + 2) * kstep; const char* b2 = last ? nB : cB + (size_t)(t + 2) * kstep;
            const char* a3 = a2 + kstep; const char* b3 = b2 + kstep;
            PG8_LDB(B0, 0, 0); PG8_LDB(B1, 0, 1); PG8_SCHED; PG8_LDA(At, 0, 0); PG8_STAGE(PG8_SA(1, 1), a1, voffA[1]);
            if (last && has_next) {
#pragma unroll
                for (int h = 0; h < 2; ++h)
#pragma unroll
                    for (int i = 0; i < 2; ++i) { int R2, C2; stage_rc(fresh_tid(wave_s) * 16 + i * 8192, R2, C2); voffA[h][i] = S.a_off(nxt, h, R2, C2); }
            }
            PG8_WAIT_V(8); PG8_WAIT_L(0); PG8_BAR; PG8_MMA(0, 0, At, B0); PG8_MMA(0, 1, At, B1); PG8_BAR; PG8_SCHED;
            PG8_LDA(At, 0, 1); PG8_STAGE(PG8_SB(0, 0), b2, voffB); PG8_STAGE(PG8_SB(0, 1), b2 + hstep, voffB); PG8_STAGE(PG8_SA(0, 0), a2, voffA[0]);
            PG8_WAIT_V(8); PG8_WAIT_L(0); PG8_BAR; PG8_MMA(1, 0, At, B0); PG8_MMA(1, 1, At, B1); PG8_BAR; PG8_SCHED;
            PG8_LDB(B0, 1, 0); PG8_LDB(B1, 1, 1); PG8_SCHED; PG8_LDA(At, 1, 0); PG8_STAGE(PG8_SA(0, 1), a2, voffA[1]);
            PG8_WAIT_V(8); PG8_WAIT_L(0); PG8_BAR; PG8_MMA(0, 0, At, B0); PG8_MMA(0, 1, At, B1); PG8_BAR; PG8_SCHED;
            PG8_LDA(At, 1, 1); PG8_STAGE(PG8_SB(1, 0), b3, voffB); PG8_STAGE(PG8_SB(1, 1), b3 + hstep, voffB); PG8_STAGE(PG8_SA(1, 0), a3, voffA[0]);
            PG8_WAIT_V(8); PG8_WAIT_L(0); PG8_BAR; PG8_MMA(1, 0, At, B0); PG8_MMA(1, 1, At, B1); PG8_BAR; PG8_SCHED;
        }
        if (wr == 0) PG8_BAR;
        E(acc, cur, wr, wc, fr, fq);
        if (!has_next) break;
#pragma unroll
        for (int a = 0; a < 2; ++a)
#pragma unroll
            for (int b = 0; b < 2; ++b)
#pragma unroll
                for (int m = 0; m < 4; ++m)
#pragma unroll
                    for (int n = 0; n < 2; ++n) acc[a][b][m][n] = (f32x4){0.f, 0.f, 0.f, 0.f};
        cur = nxt; cA = nA; cB = nB; ++ui;
        if (wr == 1) PG8_BAR;
    }
    PG8_WAIT_V(0);
    PG8_BAR;
#undef PG8_SA
#undef PG8_SB
#undef PG8_STAGE
#undef PG8_LDA
#undef PG8_LDB
#undef PG8_MMA
#undef PG8_WAIT_V
#undef PG8_WAIT_L
#undef PG8_BAR
#undef PG8_SCHED
}

__device__ __forceinline__ void store_bf16_tile(const f32x4 (&acc)[2][2][4][2], bf16* base, int ldd, int row0, int c0, int wr, int wc, int fr, int fq) {
    bf16* rowp = base + (size_t)(row0 + wr * 64 + fr) * ldd + (c0 + wc * 32 + 8 * fq);
#pragma unroll
    for (int ai = 0; ai < 2; ++ai) {
#pragma unroll
        for (int m = 0; m < 4; ++m) {
#pragma unroll
            for (int bj = 0; bj < 2; ++bj) { const f32x4 v0 = acc[ai][bj][m][0], v1 = acc[ai][bj][m][1];
                u32x4 w; w.x = cvt_pk_bf16(v0[0], v0[1]); w.y = cvt_pk_bf16(v0[2], v0[3]); w.z = cvt_pk_bf16(v1[0], v1[1]); w.w = cvt_pk_bf16(v1[2], v1[3]);
                *(u32x4*)(rowp + bj * HALF) = w; }
            rowp += (size_t)16 * ldd; asm volatile("" : "+v"(rowp)); }
        rowp += (size_t)64 * ldd; }
}
struct EpiInA { bf16 *QK, *V, *R, *MQ;
    __device__ __forceinline__ void operator()(const f32x4 (&acc)[2][2][4][2], const Unit& u, int wr, int wc, int fr, int fq) const {
        bf16* base; int ldd, c0; const int pn = u.pn;
        if (pn < 3) { base = QK; ldd = 768; c0 = pn * 256; } else if (pn < 6) { base = V; ldd = 768; c0 = (pn - 3) * 256; } else if (pn < 9) { base = R; ldd = 768; c0 = (pn - 6) * 256; } else { base = MQ; ldd = 256; c0 = 0; }
        store_bf16_tile(acc, base, ldd, u.pm * BM, c0, wr, wc, fr, fq);
    } };
struct EpiPlain { bf16* dst; int ldd;
    __device__ __forceinline__ void operator()(const f32x4 (&acc)[2][2][4][2], const Unit& u, int wr, int wc, int fr, int fq) const { store_bf16_tile(acc, dst, ldd, u.pm * BM, u.pn * BM, wr, wc, fr, fq); } };

#define XB_TMO      128
#define XB_XCNT(j)  (256  + 64 * (j))
#define XB_XSUB(j)  (1280 + 64 * (j))
#define XB_XGEN(j)  (2304 + 64 * (j))
#define XB_TOP      3328
#define XB_TOPGEN   3392
#define XCD_BAR_WORDS 3456
#define XB_SPIN_CAP (1u << 18)
__device__ __forceinline__ unsigned xb_ld(unsigned* p)              { return __hip_atomic_load(p, __ATOMIC_RELAXED, __HIP_MEMORY_SCOPE_AGENT); }
__device__ __forceinline__ unsigned xb_add(unsigned* p, unsigned v) { return __hip_atomic_fetch_add(p, v, __ATOMIC_RELAXED, __HIP_MEMORY_SCOPE_AGENT); }
__device__ __forceinline__ unsigned xb_xcc_id() { return (unsigned)__builtin_amdgcn_s_getreg((3 << 11) | 20) & 0xFu; }
#define XB_SPIN(cond, bar) do { unsigned _sp = 0; while (cond) { __builtin_amdgcn_s_sleep(1); \
    if ((++_sp & 255u) == 0u) { if (xb_ld(&(bar)[XB_TMO])) break; if (_sp > XB_SPIN_CAP) { atomicAdd(&(bar)[XB_TMO], 1u); break; } } } } while (0)
struct XcdBarrier { unsigned* bar; unsigned x; volatile LAS unsigned* st; };
__device__ __forceinline__ XcdBarrier xcd_barrier_post(unsigned* bar, volatile LAS unsigned* st) {
    XcdBarrier b; b.bar = bar; b.x = xb_xcc_id(); b.st = st;
    if (threadIdx.x == 0) (void)xb_add(&bar[XB_XCNT(b.x)], 1u);
    return b;
}
__device__ __forceinline__ void xcd_barrier_complete(unsigned* bar, unsigned x, unsigned& nloc, unsigned& nx) {
    const unsigned G = gridDim.x * gridDim.y * gridDim.z;
    unsigned sum, cnt, mine, sp = 0u;
    for (;;) {
        sum = 0u; cnt = 0u; mine = 0u;
#pragma unroll
        for (unsigned j = 0; j < 16; ++j) { const unsigned c = xb_ld(&bar[XB_XCNT(j)]); sum += c; cnt += (c > 0u) ? 1u : 0u; mine = (j == x) ? c : mine; }
        if (sum == G) break;
        __builtin_amdgcn_s_sleep(1);
        if ((++sp & 255u) == 0u) { if (xb_ld(&bar[XB_TMO])) break; if (sp > XB_SPIN_CAP) { atomicAdd(&bar[XB_TMO], 1u); break; } }
    }
    nloc = mine > 0u ? mine : 1u; nx = cnt > 0u ? cnt : 1u;
}
__device__ __forceinline__ void xcd_barrier(const XcdBarrier& b) {
    asm volatile("s_waitcnt vmcnt(0)" ::: "memory");
    __syncthreads();
    if (threadIdx.x == 0) {
        unsigned* bar = b.bar;
        __builtin_amdgcn_s_waitcnt(0);
        unsigned nloc = b.st[0], nx = b.st[1];
        if (nloc == 0u) { xcd_barrier_complete(bar, b.x, nloc, nx); b.st[0] = nloc; b.st[1] = nx; }
        const unsigned old = xb_add(&bar[XB_XSUB(b.x)], 1u);
        const unsigned gen = old / nloc;
        if (old + 1u == (gen + 1u) * nloc) {
            __builtin_amdgcn_fence(__ATOMIC_RELEASE, "agent");
            asm volatile("s_waitcnt vmcnt(0)" ::: "memory");
            const unsigned og = xb_add(&bar[XB_TOP], 1u);
            const unsigned tg = og / nx;
            if (og + 1u == (tg + 1u) * nx) xb_add(&bar[XB_TOPGEN], 1u);
            else XB_SPIN(xb_ld(&bar[XB_TOPGEN]) == tg, bar);
            __builtin_amdgcn_fence(__ATOMIC_ACQUIRE, "agent");
            xb_add(&bar[XB_XGEN(b.x)], 1u);
            asm volatile("s_waitcnt vmcnt(0)" ::: "memory");
        } else {
            XB_SPIN(xb_ld(&bar[XB_XGEN(b.x)]) == gen, bar);
            __builtin_amdgcn_fence(__ATOMIC_ACQUIRE, "agent");
            asm volatile("s_waitcnt vmcnt(0)" ::: "memory");
        }
    }
    __syncthreads();
}
#define LDS_WAIT() asm volatile("s_waitcnt lgkmcnt(0)" ::: "memory")
__device__ __forceinline__ unsigned pk2(float lo, float hi) { return (unsigned)f2bf(lo) | ((unsigned)f2bf(hi) << 16); }

template <int CTRL> __device__ __forceinline__ float dppf(float v) { return __builtin_bit_cast(float, __builtin_amdgcn_update_dpp(0, __builtin_bit_cast(int, v), CTRL, 0xf, 0xf, true)); }
__device__ __forceinline__ float sum_swap32(float a, float b) { auto r = __builtin_amdgcn_permlane32_swap(__float_as_uint(a), __float_as_uint(b), false, false); return __uint_as_float(r[0]) + __uint_as_float(r[1]); }
__device__ __forceinline__ float sum_swap16(float a, float b) { auto r = __builtin_amdgcn_permlane16_swap(__float_as_uint(a), __float_as_uint(b), false, false); return __uint_as_float(r[0]) + __uint_as_float(r[1]); }
__device__ __forceinline__ float wsum(float v) {
    v += dppf<0xB1>(v); v += dppf<0x4E>(v); v += dppf<0x141>(v); v += dppf<0x140>(v);
    v = sum_swap16(v, v); v = sum_swap32(v, v); return v;
}
__device__ __forceinline__ float multi_reduce16(const float (&a)[16], int lane) {
    float b[8], c[4], d[2], e;
#pragma unroll
    for (int i = 0; i < 8; ++i) b[i] = sum_swap32(a[i], a[i + 8]);
#pragma unroll
    for (int i = 0; i < 4; ++i) c[i] = sum_swap16(b[i], b[i + 4]);
    { const bool hi = (lane & 8) != 0;
#pragma unroll
      for (int i = 0; i < 2; ++i) { const float send = hi ? c[i] : c[i + 2], keep = hi ? c[i + 2] : c[i]; d[i] = keep + dppf<0x140>(send); } }
    { const bool hi = (lane & 4) != 0; const float send = hi ? d[0] : d[1], keep = hi ? d[1] : d[0]; e = keep + dppf<0x141>(send); }
    e += dppf<0x4E>(e); e += dppf<0xB1>(e);
    return e;
}

__device__ __forceinline__ void row_dots16x2(const f32x4 (&v0)[4], const f32x4 (&v1)[4], const LAS float* WT, int lane, float& r0, float& r1) {
    float a0[16], a1[16];
    const LAS float* wl = WT + 4 * lane; asm volatile("" : "+v"(wl));
    f32x4 wa[8], wb[8];
#pragma unroll
    for (int q = 0; q < 8; ++q) wa[q] = *(const LAS f32x4*)(wl + (q >> 2) * D + 256 * (q & 3));
#pragma unroll
    for (int g = 0; g < 8; ++g) {
        if (g + 1 < 8) {
#pragma unroll
            for (int q = 0; q < 8; ++q) { const f32x4 w = *(const LAS f32x4*)(wl + (2 * (g + 1) + (q >> 2)) * D + 256 * (q & 3)); if (g & 1) wa[q] = w; else wb[q] = w; } }
#pragma unroll
        for (int h = 0; h < 2; ++h) { float x = 0.f, y = 0.f;
#pragma unroll
            for (int j = 0; j < 4; ++j) { const f32x4 w = (g & 1) ? wb[4 * h + j] : wa[4 * h + j];
                x += v0[j][0] * w[0] + v0[j][1] * w[1] + v0[j][2] * w[2] + v0[j][3] * w[3]; y += v1[j][0] * w[0] + v1[j][1] * w[1] + v1[j][2] * w[2] + v1[j][3] * w[3]; }
            a0[2 * g + h] = x; a1[2 * g + h] = y; }
        asm volatile("" : "+v"(a0[2 * g]), "+v"(a0[2 * g + 1]), "+v"(a1[2 * g]), "+v"(a1[2 * g + 1]));
    }
    r0 = multi_reduce16(a0, lane); r1 = multi_reduce16(a1, lane);
}
struct TItem { const float* src; bf16* WT; int K, ncols, n0, k0, kind, aux; bool ok; };
__device__ __forceinline__ int titem_dstrow(const TItem& t, int c) {
    switch (t.kind) {
        case 0: return 256 * (c >> 7) + perm8(c & 127);
        case 1: return 256 * (c >> 7) + 128 + perm8(c & 127);
        case 2: return perm8(c);
        case 3: { if (c >= 1536 && c < 1552) return -1; const int L = c < 1536 ? c : c - 16; return perm8(L); }
        case 4: { if (c < 768) return (c & ~255) + head64(c & 255); return perm8(1536 + c); }
        case 5: { if (c < 768) { const int L = 768 + c; return (L & ~255) + head64(L & 255); } if (c < 1536) return perm8(768 + c); return -1; }
        default: return perm8(t.aux * 512 + c);
    }
}
__device__ __forceinline__ void titem_load(const TItem& t, float (&r)[32]) {
#pragma unroll
    for (int i = 0; i < 32; ++i) r[i] = t.ok ? t.src[(size_t)(2 * i) * t.ncols] : 0.f;
}
__device__ __forceinline__ void titem_store(const TItem& t, const float (&r)[32], LAS float* scr, int lane) {
#pragma unroll
    for (int i = 0; i < 32; ++i) scr[(2 * i + (lane >> 5)) * 33 + (lane & 31)] = r[i];
    LDS_WAIT(); asm volatile("" ::: "memory");
    const int c = lane & 7;
#pragma unroll
    for (int j = 0; j < 4; ++j) { const int n = (lane >> 3) + 8 * j; const LAS float* s = scr + (8 * c) * 33 + n;
        u32x4 o; o.x = cvt_pk_bf16(s[0 * 33], s[1 * 33]); o.y = cvt_pk_bf16(s[2 * 33], s[3 * 33]); o.z = cvt_pk_bf16(s[4 * 33], s[5 * 33]); o.w = cvt_pk_bf16(s[6 * 33], s[7 * 33]);
        const int dr = (t.n0 + n) < t.ncols ? titem_dstrow(t, t.n0 + n) : -1;
        if (dr >= 0) *(u32x4*)(t.WT + (size_t)dr * t.K + t.k0 + 8 * c) = o; }
    LDS_WAIT(); asm volatile("" ::: "memory");
}
struct Params { const float* in[22]; float* out; unsigned char* ws; int ph_lo, ph_hi, bar_li, pad; };
enum { I_X = 0, I_MEM, I_WINA, I_WGUP, I_BGATE, I_GLAG, I_WINB, I_QNG, I_WKV, I_BFORGET, I_KNG, I_WMKV, I_WOUT, I_LMG, I_LMB, I_LFG, I_LFB, I_WR, I_BR, I_WEG, I_WEU, I_WED };
constexpr int CW_BAR = 4096;

typedef const __attribute__((address_space(4))) Params* KP;
__device__ __forceinline__ KP fresh_kp() { KP q = (KP)__builtin_amdgcn_kernarg_segment_ptr(); asm volatile("" : "+s"(q)); return q; }

constexpr int CV_STATIC = 3 * 512 + 176 + 112 + 96 + 64 + 128, CV_QUEUE = 3 * 512;
constexpr int CV_A_STATIC = 576, CV_NSTAT = CV_A_STATIC + (CV_STATIC - 1536), CV_QA = 1536 - CV_A_STATIC;
constexpr int CW_CVQ = 1040, CW_CVQA = 1056;
__device__ __forceinline__ void cv_decode(KP p, unsigned char* ws, int it, int lane, int wave, TItem& t) {
    int r = it; const float* W; int nblk, q, l = 0; t.aux = 0;
    if (r >= CV_STATIC) { r -= CV_STATIC; l = 1; }
    else if (r >= 1536) { r -= 1536;
        if (r < 176) { q = r; W = p->in[I_WINA]; t.ncols = A_IN; t.K = D; t.WT = (bf16*)(ws + WS_WA); nblk = 11; t.kind = 3; }
        else if ((r -= 176) < 112) { q = r; W = p->in[I_WINB]; t.ncols = B_IN; t.K = D; t.WT = (bf16*)(ws + WS_WB); nblk = 7; t.kind = 4; }
        else if ((r -= 112) < 96) { q = r; W = p->in[I_WKV]; t.ncols = KV_IN; t.K = D; t.WT = (bf16*)(ws + WS_WB); nblk = 6; t.kind = 5; }
        else if ((r -= 96) < 64) { const int lm = r / 32; q = r % 32; W = p->in[I_WMKV] + (size_t)lm * D * 512; t.ncols = 512; t.K = D; t.WT = (bf16*)(ws + WS_WMKV); nblk = 2; t.kind = 6; t.aux = lm; }
        else { r -= 64; const int lo = r / 64; q = r % 64; W = p->in[I_WOUT] + (size_t)lo * D * D; t.ncols = D; t.K = D; t.WT = (bf16*)(ws + WS_WO) + (size_t)lo * D * D; nblk = 4; t.kind = 2; }
        goto done; }
    if (r < 512) { const int mat = 16 * l + r / 32; q = r % 32; W = p->in[I_WEG] + (size_t)mat * D * DEXP; t.ncols = DEXP; t.K = D; t.WT = (bf16*)(ws + WS_WGU) + (size_t)mat * 1024 * D; nblk = 2; t.kind = 0; }
    else if ((r -= 512) < 512) { const int mat = 16 * l + r / 32; q = r % 32; W = p->in[I_WEU] + (size_t)mat * D * DEXP; t.ncols = DEXP; t.K = D; t.WT = (bf16*)(ws + WS_WGU) + (size_t)mat * 1024 * D; nblk = 2; t.kind = 1; }
    else { r -= 512; const int mat = 16 * l + r / 32; q = r % 32; W = p->in[I_WED] + (size_t)mat * DEXP * D; t.ncols = D; t.K = DEXP; t.WT = (bf16*)(ws + WS_WD) + (size_t)mat * D * DEXP; nblk = 4; t.kind = 2; }
done:
    t.k0 = 64 * (q / nblk); t.n0 = 256 * (q % nblk);
    const int col = t.n0 + 4 * lane; t.ok = col < t.ncols;
    t.src = W + (size_t)(t.k0 + 8 * wave) * t.ncols + (t.ok ? col : 0);
}
#define CV_TLOAD(t, r) do { _Pragma("unroll") for (int i = 0; i < 8; ++i) r[i] = t.ok ? *(const f32x4*)(t.src + (size_t)i * t.ncols) : (f32x4){0.f, 0.f, 0.f, 0.f}; } while (0)
#define CV_TSTORE(t, r) do { __syncthreads(); \
        _Pragma("unroll") for (int i = 0; i < 8; ++i) { LAS float* d_ = T + (8 * wave + i) * 257 + 4 * lane; d_[0] = r[i][0]; d_[1] = r[i][1]; d_[2] = r[i][2]; d_[3] = r[i][3]; } \
        __syncthreads(); \
        const int c_ = lane & 7; \
        _Pragma("unroll") for (int j = 0; j < 4; ++j) { const int n_ = 32 * wave + (lane >> 3) + 8 * j; const LAS float* s_ = T + (8 * c_) * 257 + n_; \
            u32x4 o_; o_.x = cvt_pk_bf16(s_[0 * 257], s_[1 * 257]); o_.y = cvt_pk_bf16(s_[2 * 257], s_[3 * 257]); o_.z = cvt_pk_bf16(s_[4 * 257], s_[5 * 257]); o_.w = cvt_pk_bf16(s_[6 * 257], s_[7 * 257]); \
            const int dr_ = (t.n0 + n_) < t.ncols ? titem_dstrow(t, t.n0 + n_) : -1; \
            if (dr_ >= 0) *(u32x4*)(t.WT + (size_t)dr_ * t.K + t.k0 + 8 * c_) = o_; } } while (0)
__device__ __forceinline__ void convert_static(KP p, unsigned char* ws, LAS unsigned char* lds, int lane, int wave, int G, int bid) {
    LAS float* T = (LAS float*)lds;
    TItem ta; f32x4 ra[8], rb[8];
#define CV_SID(s) ((s) < CV_A_STATIC ? (s) : 1536 + ((s) - CV_A_STATIC))
    int it = bid;
    if (it < CV_NSTAT) { cv_decode(p, ws, CV_SID(it), lane, wave, ta); CV_TLOAD(ta, ra); }
#pragma unroll 1
    for (; it < CV_NSTAT; it += 2 * G) {
        TItem tb; const bool hb = it + G < CV_NSTAT;
        if (hb) { cv_decode(p, ws, CV_SID(it + G), lane, wave, tb); CV_TLOAD(tb, rb); }
        CV_TSTORE(ta, ra);
        if (it + 2 * G < CV_NSTAT) { cv_decode(p, ws, CV_SID(it + 2 * G), lane, wave, ta); CV_TLOAD(ta, ra); }
        if (hb) CV_TSTORE(tb, rb);
    }
#undef CV_SID
    __syncthreads();
}
__device__ __forceinline__ void convert_from_queue(KP p, LAS unsigned char* lds, const int wave_s, int budget, const int qword = CW_CVQ, const int qbase = CV_STATIC, const int qcount = CV_QUEUE) {
    unsigned char* ws = p->ws; LAS float* T = (LAS float*)lds;
    const int tid = fresh_tid(wave_s), lane = tid & 63, wave = wave_s;
    unsigned* qh = (unsigned*)(ws + WS_CTL) + qword; volatile LAS unsigned* slotw = (volatile LAS unsigned*)(lds + MISC_OFF) + 56;
    for (int n = 0; budget < 0 || n < budget; ++n) {
        if (tid == 0) slotw[0] = __hip_atomic_fetch_add(qh, 1u, __ATOMIC_RELAXED, __HIP_MEMORY_SCOPE_AGENT);
        __syncthreads();
        const int q = (int)__builtin_amdgcn_readfirstlane(slotw[0]);
        if (q >= qcount) break;
        TItem t; f32x4 r[8]; cv_decode(p, ws, qbase + q, lane, wave, t); CV_TLOAD(t, r); CV_TSTORE(t, r);
        __syncthreads();
    }
    __syncthreads();
}
__device__ __forceinline__ void phase_prologue(KP p, LAS unsigned char* lds, int G, int bid, const int wave_s) {
    const int tid = fresh_tid(wave_s), lane = tid & 63, wave = wave_s;
    unsigned char* ws = p->ws;
    LAS float* scr = (LAS float*)(lds + wave * 8448);
    const int gw = bid * NWAVES + wave, NGW = G * NWAVES;
    constexpr int NB_A = 81, NB_B = 56, NB_KV = 48;
    constexpr int I_G = 32 * 16 * 16, I_U = I_G, I_D = 32 * 8 * 32, I_A = 16 * NB_A, I_B = 16 * NB_B, I_KV = 16 * NB_KV, I_MK = 2 * 16 * 16, I_O = 2 * 16 * 32;
    constexpr int NITEMS = I_G + I_U + I_D + I_A + I_B + I_KV + I_MK + I_O;
    auto decode = [&](int it, TItem& t) {
        int r = it; const float* W; int nblk, q; t.aux = 0;
        if (r < I_G) { const int mat = r / 256; q = r % 256; W = p->in[I_WEG] + (size_t)mat * D * DEXP; t.ncols = DEXP; t.K = D; t.WT = (bf16*)(ws + WS_WGU) + (size_t)mat * 1024 * D; nblk = 16; t.kind = 0; }
        else if ((r -= I_G) < I_U) { const int mat = r / 256; q = r % 256; W = p->in[I_WEU] + (size_t)mat * D * DEXP; t.ncols = DEXP; t.K = D; t.WT = (bf16*)(ws + WS_WGU) + (size_t)mat * 1024 * D; nblk = 16; t.kind = 1; }
        else if ((r -= I_U) < I_D) { const int mat = r / 256; q = r % 256; W = p->in[I_WED] + (size_t)mat * DEXP * D; t.ncols = D; t.K = DEXP; t.WT = (bf16*)(ws + WS_WD) + (size_t)mat * D * DEXP; nblk = 32; t.kind = 2; }
        else if ((r -= I_D) < I_A) { q = r; W = p->in[I_WINA]; t.ncols = A_IN; t.K = D; t.WT = (bf16*)(ws + WS_WA); nblk = NB_A; t.kind = 3; }
        else if ((r -= I_A) < I_B) { q = r; W = p->in[I_WINB]; t.ncols = B_IN; t.K = D; t.WT = (bf16*)(ws + WS_WB); nblk = NB_B; t.kind = 4; }
        else if ((r -= I_B) < I_KV) { q = r; W = p->in[I_WKV]; t.ncols = KV_IN; t.K = D; t.WT = (bf16*)(ws + WS_WB); nblk = NB_KV; t.kind = 5; }
        else if ((r -= I_KV) < I_MK) { const int l = r / 256; q = r % 256; W = p->in[I_WMKV] + (size_t)l * D * 512; t.ncols = 512; t.K = D; t.WT = (bf16*)(ws + WS_WMKV); nblk = 16; t.kind = 6; t.aux = l; }
        else { r -= I_MK; const int l = r / 512; q = r % 512; W = p->in[I_WOUT] + (size_t)l * D * D; t.ncols = D; t.K = D; t.WT = (bf16*)(ws + WS_WO) + (size_t)l * D * D; nblk = 32; t.kind = 2; }
        t.k0 = 64 * (q / nblk); t.n0 = 32 * (q % nblk);
        const int col = t.n0 + (lane & 31); t.ok = col < t.ncols;
        t.src = W + (size_t)(t.k0 + (lane >> 5)) * t.ncols + (t.ok ? col : 0);
    };
    { PSEC_BEGIN(20); convert_static(p, ws, lds, lane, wave, G, bid); PSEC_END(20); }
    { const f32x4* src = (const f32x4*)p->in[I_MEM]; u32x2* dst = (u32x2*)(ws + WS_MEMB);
      for (int i = bid * NTHREADS + tid; i < NB * NMEM * D / 4; i += G * NTHREADS) { const f32x4 v = src[i]; u32x2 o; o.x = pk2(v[0], v[1]); o.y = pk2(v[2], v[3]); dst[i] = o; } }
    __syncthreads();
    LAS float* WG = (LAS float*)(lds);
    for (int idx = tid; idx < 16 * D; idx += NTHREADS) { const int j = idx & 15, k = idx >> 4; WG[j * D + k] = p->in[I_WINA][(size_t)k * A_IN + 1536 + j]; }
    __syncthreads();
    bf16* XB = (bf16*)(ws + WS_XB); float* GLR = (float*)(ws + WS_GLR);
    { PSEC_BEGIN(22);
    {   f32x4 a0[4], a1[4], b0[4], b1[4];
#define P0_LOAD(va, vb, mm) do { const f32x4* xr_ = (const f32x4*)(p->in[I_X] + (size_t)(mm) * D) + lane; _Pragma("unroll") for (int j = 0; j < 4; ++j) { va[j] = xr_[64 * j]; vb[j] = xr_[64 * j + 256]; } } while (0)
#define P0_PROC(va, vb, mm) do { u32x2* o8_ = (u32x2*)(XB + (size_t)(mm) * D) + lane; \
            _Pragma("unroll") for (int j = 0; j < 4; ++j) { u32x2 o; o.x = cvt_pk_bf16(va[j][0], va[j][1]); o.y = cvt_pk_bf16(va[j][2], va[j][3]); o8_[64 * j] = o; o.x = cvt_pk_bf16(vb[j][0], vb[j][1]); o.y = cvt_pk_bf16(vb[j][2], vb[j][3]); o8_[64 * j + 256] = o; } \
            float r0_, r1_; row_dots16x2(va, vb, WG, lane, r0_, r1_); \
            if ((lane & 3) == 0) { GLR[(size_t)(mm) * 16 + (lane >> 2)] = r0_; GLR[(size_t)((mm) + 1) * 16 + (lane >> 2)] = r1_; } } while (0)
        int m = 2 * gw;
        if (m < NTOK) P0_LOAD(a0, a1, m);
#pragma unroll 1
        for (; m < NTOK; m += 4 * NGW) {
            const bool hb = m + 2 * NGW < NTOK;
            if (hb) P0_LOAD(b0, b1, m + 2 * NGW);
            P0_PROC(a0, a1, m);
            if (m + 4 * NGW < NTOK) P0_LOAD(a0, a1, m + 4 * NGW);
            if (hb) P0_PROC(b0, b1, m + 2 * NGW);
        }
#undef P0_LOAD
#undef P0_PROC
    }
    PSEC_END(22); }
}

template <bool RB> struct EpiRes { const void* xres; bf16* out;
    __device__ __forceinline__ void operator()(const f32x4 (&acc)[2][2][4][2], const Unit& u, int wr, int wc, int fr, int fq) const {
        size_t off = (size_t)(u.pm * BM + wr * 64 + fr) * D + (u.pn * BM + wc * 32 + 8 * fq);
#pragma unroll
        for (int ai = 0; ai < 2; ++ai) {
#pragma unroll
            for (int m = 0; m < 4; ++m) {
#pragma unroll
                for (int bj = 0; bj < 2; ++bj) { f32x4 x0, x1;
                    if (RB) { const u32x4 t = *(const u32x4*)((const bf16*)xres + off + bj * HALF); x0[0] = __uint_as_float(t.x << 16); x0[1] = __uint_as_float(t.x & 0xffff0000u); x0[2] = __uint_as_float(t.y << 16); x0[3] = __uint_as_float(t.y & 0xffff0000u);
                        x1[0] = __uint_as_float(t.z << 16); x1[1] = __uint_as_float(t.z & 0xffff0000u); x1[2] = __uint_as_float(t.w << 16); x1[3] = __uint_as_float(t.w & 0xffff0000u); }
                    else { x0 = *(const f32x4*)((const float*)xres + off + bj * HALF); x1 = *(const f32x4*)((const float*)xres + off + bj * HALF + 4); }
                    const f32x4 v0 = x0 * DN_ALPHA + acc[ai][bj][m][0], v1 = x1 * DN_ALPHA + acc[ai][bj][m][1];
                    u32x4 w; w.x = cvt_pk_bf16(v0[0], v0[1]); w.y = cvt_pk_bf16(v0[2], v0[3]); w.z = cvt_pk_bf16(v1[0], v1[1]); w.w = cvt_pk_bf16(v1[2], v1[3]);
                    *(u32x4*)(out + off + bj * HALF) = w; }
                off += (size_t)16 * D; asm volatile("" : "+v"(off) :: "memory"); }
            off += (size_t)64 * D; }
    } };
struct EpiInB { bf16 *Q, *K, *V, *OG, *MQ; const float* qg; const float* kg;
    __device__ __forceinline__ void operator()(const f32x4 (&acc)[2][2][4][2], const Unit& u, int wr, int wc, int fr, int fq) const {
        const int pn = u.pn;
        if (pn >= 6) { bf16* base; int ldd, c0;
            if (pn < 9) { base = V; ldd = 768; c0 = (pn - 6) * 256; } else if (pn < 12) { base = OG; ldd = 768; c0 = (pn - 9) * 256; } else { base = MQ; ldd = 256; c0 = 0; }
            store_bf16_tile(acc, base, ldd, u.pm * BM, c0, wr, wc, fr, fq); return; }
        const bool isq = pn < 3; bf16* base = isq ? Q : K; const float* g = isq ? qg : kg; const float sc = isq ? QC2 : 1.0f;
        const int c0 = (isq ? pn : pn - 3) * 256 + wc * 64 + 8 * fq, r0 = u.pm * BM + wr * 64 + fr;
        f32x4 gv[2][2];
#pragma unroll
        for (int bj = 0; bj < 2; ++bj)
#pragma unroll
            for (int n = 0; n < 2; ++n) gv[bj][n] = *(const f32x4*)(g + 32 * bj + 8 * fq + 4 * n) * sc;
        bf16* rowp = base + (size_t)r0 * 768 + c0;
#pragma unroll
        for (int ai = 0; ai < 2; ++ai) {
#pragma unroll
            for (int m = 0; m < 4; ++m) {
                float ss = 0.f;
#pragma unroll
                for (int bj = 0; bj < 2; ++bj)
#pragma unroll
                    for (int n = 0; n < 2; ++n) { const f32x4 v = acc[ai][bj][m][n]; ss += (v[0] * v[0] + v[1] * v[1]) + (v[2] * v[2] + v[3] * v[3]); }
                ss = sum_swap16(ss, ss); ss = sum_swap32(ss, ss);
                const float rs = rsqrtf(ss * (1.f / 64.f) + RMS_EPS);
#pragma unroll
                for (int bj = 0; bj < 2; ++bj) { const f32x4 v0 = acc[ai][bj][m][0] * rs * gv[bj][0], v1 = acc[ai][bj][m][1] * rs * gv[bj][1];
                    u32x4 w; w.x = cvt_pk_bf16(v0[0], v0[1]); w.y = cvt_pk_bf16(v0[2], v0[3]); w.z = cvt_pk_bf16(v1[0], v1[1]); w.w = cvt_pk_bf16(v1[2], v1[3]);
                    *(u32x4*)(rowp + 32 * bj) = w; }
                rowp += (size_t)16 * 768; asm volatile("" : "+v"(rowp)); }
            rowp += (size_t)64 * 768; }
    } };

__device__ __forceinline__ void load_wtab(LAS float* WT, const float* W, int ldw, int col0, int ncols, int tid) {
    for (int idx = tid; idx < 16 * D; idx += NTHREADS) { const int j = idx & 15, k = idx >> 4; WT[j * D + k] = j < ncols ? W[(size_t)k * ldw + col0 + j] : 0.f; }
}
__device__ __forceinline__ float row_dots16(const f32x4 (&v)[4], const LAS float* WT, int lane) {
    float acc[16];
    const LAS float* wl = WT + 4 * lane; asm volatile("" : "+v"(wl));
#pragma unroll
    for (int n = 0; n < 16; ++n) { float a = 0.f;
#pragma unroll
        for (int j = 0; j < 4; ++j) { const f32x4 w = *(const LAS f32x4*)(wl + n * D + 256 * j); a += v[j][0] * w[0] + v[j][1] * w[1] + v[j][2] * w[2] + v[j][3] * w[3]; }
        acc[n] = a; if (n & 1) asm volatile("" : "+v"(acc[n - 1]), "+v"(acc[n]) :: "memory"); }
    return multi_reduce16(acc, lane);
}
__device__ __forceinline__ void ln_row(f32x4 (&v)[4], const float* g, const float* b, int lane) {
    float s = 0.f;
#pragma unroll
    for (int j = 0; j < 4; ++j) s += (v[j][0] + v[j][1]) + (v[j][2] + v[j][3]);
    const float mean = wsum(s) * (1.f / D); float q = 0.f;
#pragma unroll
    for (int j = 0; j < 4; ++j) { v[j] = v[j] - mean; q += (v[j][0] * v[j][0] + v[j][1] * v[j][1]) + (v[j][2] * v[j][2] + v[j][3] * v[j][3]); }
    const float rstd = rsqrtf(wsum(q) * (1.f / D) + LN_EPS);
#pragma unroll
    for (int j = 0; j < 4; ++j) { const f32x4 gg = *(const f32x4*)(g + 4 * lane + 256 * j), bb = *(const f32x4*)(b + 4 * lane + 256 * j); v[j] = v[j] * rstd * gg + bb; }
}
__device__ __forceinline__ void store_row_f32_bf16(const f32x4 (&v)[4], float* xf, bf16* xb, int lane) {
#pragma unroll
    for (int j = 0; j < 4; ++j) { if (xf) ((f32x4*)xf)[lane + 64 * j] = v[j]; if (xb) { u32x2 o; o.x = cvt_pk_bf16(v[j][0], v[j][1]); o.y = cvt_pk_bf16(v[j][2], v[j][3]); ((u32x2*)xb)[lane + 64 * j] = o; } }
}

__device__ __forceinline__ void route_thread(const float (&lg)[16], const float (&brv)[16], int m, int lt, int* TOK_E, float* TOK_W, LAS int* tokE) {
    float aff[16], sel[16];
#pragma unroll
    for (int e = 0; e < 16; ++e) { aff[e] = 1.f / (1.f + __expf(-lg[e])); sel[e] = aff[e] + brv[e]; }
    int gbest = 0; float gs = -1e30f;
#pragma unroll
    for (int gi = 0; gi < 4; ++gi) { float a = -1e30f, b2 = -1e30f;
#pragma unroll
        for (int j = 0; j < 4; ++j) { const float x = sel[gi * 4 + j]; const bool gt = x > a; b2 = gt ? a : fmaxf(b2, x); a = gt ? x : a; }
        const bool better = a + b2 > gs; gs = better ? a + b2 : gs; gbest = better ? gi : gbest; }
    int i0 = 0, i1 = 0; float a = -1e30f, b2 = -1e30f, wa = 0.f, wb = 0.f;
#pragma unroll
    for (int j = 0; j < 4; ++j) { float x = sel[j], y = aff[j];
#pragma unroll
        for (int gi = 1; gi < 4; ++gi) { x = (gi == gbest) ? sel[gi * 4 + j] : x; y = (gi == gbest) ? aff[gi * 4 + j] : y; }
        const bool g1 = x > a, g2 = x > b2;
        const float nb = g1 ? a : (g2 ? x : b2), nwb = g1 ? wa : (g2 ? y : wb); const int ni1 = g1 ? i0 : (g2 ? j : i1);
        a = g1 ? x : a; wa = g1 ? y : wa; i0 = g1 ? j : i0; b2 = nb; wb = nwb; i1 = ni1; }
    const float inv = 1.f / (wa + wb); const int e0 = gbest * 4 + i0, e1 = gbest * 4 + i1;
    TOK_E[m * 2] = e0; TOK_E[m * 2 + 1] = e1; TOK_W[m * 2] = wa * inv; TOK_W[m * 2 + 1] = wb * inv; tokE[lt * 2] = e0; tokE[lt * 2 + 1] = e1;
}
__device__ __forceinline__ void phase_ln_router(KP p, int layer, LAS unsigned char* lds, int G, int bid, const int wave_s) {
    const int tid = fresh_tid(wave_s), lane = tid & 63, wave = wave_s;
    PSEC_BEGIN(0);
    unsigned char* ws = p->ws;
    LAS float* WT = (LAS float*)lds; LAS int* tokE = (LAS int*)(lds + 65536);
    load_wtab(WT, p->in[I_WR], 16, 0, 16, tid);
    __syncthreads();
    const bf16* Y1 = (const bf16*)p->out; bf16* XB = (bf16*)(ws + WS_XB); int* TOK_E = (int*)(ws + WS_TOKE); float* TOK_W = (float*)(ws + WS_TOKW); int* CNT = (int*)(ws + WS_CNT); int* SLOT_TOK = (int*)(ws + WS_SLOTTOK);
    const float* g = p->in[I_LMG] + layer * D; const float* b = p->in[I_LMB] + layer * D;
#define LNR_LOAD(va, vb, pr) do { const u32x2* s0_ = (const u32x2*)(Y1 + (size_t)(tb * 128 + wave * 16 + 2 * (pr)) * D) + lane; _Pragma("unroll") for (int j = 0; j < 4; ++j) { const u32x2 a_ = s0_[64 * j], b_ = s0_[64 * j + 256]; \
        va[j][0] = __uint_as_float(a_.x << 16); va[j][1] = __uint_as_float(a_.x & 0xffff0000u); va[j][2] = __uint_as_float(a_.y << 16); va[j][3] = __uint_as_float(a_.y & 0xffff0000u); \
        vb[j][0] = __uint_as_float(b_.x << 16); vb[j][1] = __uint_as_float(b_.x & 0xffff0000u); vb[j][2] = __uint_as_float(b_.y << 16); vb[j][3] = __uint_as_float(b_.y & 0xffff0000u); } } while (0)
#define LNR_PROC(va, vb, pr) do { const int lt_ = wave * 16 + 2 * (pr), m_ = tb * 128 + lt_; \
        { PSEC_BEGIN(1); ln_row(va, g, b, lane); ln_row(vb, g, b, lane); \
        store_row_f32_bf16(va, (float*)nullptr, XB + (size_t)m_ * D, lane); store_row_f32_bf16(vb, (float*)nullptr, XB + (size_t)(m_ + 1) * D, lane); PSEC_END(1); } \
        float l0_, l1_; { PSEC_BEGIN(2); row_dots16x2(va, vb, WT, lane, l0_, l1_); asm volatile("" : "+v"(l0_), "+v"(l1_)); PSEC_END(2); } \
        if ((lane & 3) == 0) { LG[lt_ * 16 + (lane >> 2)] = l0_; LG[(lt_ + 1) * 16 + (lane >> 2)] = l1_; } } while (0)
    LAS float* LG = (LAS float*)(lds + 65536 + 1024);
    for (int tb = bid; tb < NTOK / 128; tb += G) {
        f32x4 a0[4], a1[4], b0[4], b1[4];
        LNR_LOAD(a0, a1, 0);
#pragma unroll 1
        for (int pr = 0; pr < 8; pr += 2) {
            LNR_LOAD(b0, b1, pr + 1);
            LNR_PROC(a0, a1, pr);
            if (pr + 2 < 8) LNR_LOAD(a0, a1, pr + 2);
            LNR_PROC(b0, b1, pr + 1);
        }
        __syncthreads();
        if (tid < 128) { PSEC_BEGIN(3); float lg[16], brv[16];
#pragma unroll
            for (int q = 0; q < 4; ++q) { const f32x4 t4 = *(const LAS f32x4*)(LG + tid * 16 + 4 * q); const f32x4 b4 = *(const f32x4*)(p->in[I_BR] + 4 * q);
#pragma unroll
                for (int j = 0; j < 4; ++j) { lg[4 * q + j] = t4[j]; brv[4 * q + j] = b4[j]; } }
            route_thread(lg, brv, tb * 128 + tid, tid, TOK_E, TOK_W, tokE); PSEC_END(3); }
        __syncthreads();
        if (tid < 256) {
            const int e = tokE[tid]; int rank = 0;
            for (int i = 0; i < tid; ++i) rank += (tokE[i] == e) ? 1 : 0;
            SLOT_TOK[(e * 256 + tb) * 128 + rank] = tb * 256 + tid;
        } else if (tid < 272) { const int e = tid - 256; int c = 0; for (int i = 0; i < 256; ++i) c += (tokE[i] == e) ? 1 : 0; CNT[tb * 16 + e] = c; }
        __syncthreads();
    }
    PSEC_END(0);
#undef LNR_LOAD
#undef LNR_PROC
}
struct FfnRow { u32x2 x[4], ya[4], yc[4]; float w0, w1; };
__device__ __forceinline__ void ffn_combine(FfnRow& r, f32x4 (&v)[4]) {
#pragma unroll
    for (int j = 0; j < 4; ++j) { const u32x2 a = r.ya[j], c = r.yc[j]; f32x4 ya, yc;
        ya[0] = __uint_as_float(a.x << 16); ya[1] = __uint_as_float(a.x & 0xffff0000u); ya[2] = __uint_as_float(a.y << 16); ya[3] = __uint_as_float(a.y & 0xffff0000u);
        yc[0] = __uint_as_float(c.x << 16); yc[1] = __uint_as_float(c.x & 0xffff0000u); yc[2] = __uint_as_float(c.y << 16); yc[3] = __uint_as_float(c.y & 0xffff0000u);
        const u32x2 xx = r.x[j]; f32x4 xv; xv[0] = __uint_as_float(xx.x << 16); xv[1] = __uint_as_float(xx.x & 0xffff0000u); xv[2] = __uint_as_float(xx.y << 16); xv[3] = __uint_as_float(xx.y & 0xffff0000u);
        v[j] = xv * DN_ALPHA + ya * r.w0 + yc * r.w1; }
}
__device__ __forceinline__ void phase_ln_ffn(KP p, int layer, LAS unsigned char* lds, int G, int bid, const int wave_s) {
    const int tid = fresh_tid(wave_s), lane = tid & 63, wave = wave_s;
    unsigned char* ws = p->ws;
    LAS float* WT = (LAS float*)lds;
    if (layer == 0) { load_wtab(WT, p->in[I_WKV], KV_IN, 1536, 12, tid); __syncthreads(); }
    const int eo = (lane >> 2) & 15; const float bf = (layer == 0 && eo < 12) ? p->in[I_BFORGET][eo] : 0.f;
    float* XF = p->out; bf16* XB = (bf16*)(ws + WS_XB); const bf16* YS = (const bf16*)(ws + WS_HREG);
    const int* TOK_S = (const int*)(ws + WS_TOKS); const float* TOK_W = (const float*)(ws + WS_TOKW); float* LOGF = (float*)(ws + WS_LOGF);
    const float* g = p->in[I_LFG] + layer * D; const float* b = p->in[I_LFB] + layer * D;
    const int gw = bid * NWAVES + wave, NGW = G * NWAVES;
#define FFN_LOAD(R, m_) do { const int mm_ = (m_); int mv_ = mm_ * 2; asm volatile("" : "+v"(mv_));        \
        const int s0_ = TOK_S[mv_], s1_ = TOK_S[mv_ + 1]; R.w0 = TOK_W[mv_]; R.w1 = TOK_W[mv_ + 1]; \
        _Pragma("unroll") for (int j = 0; j < 4; ++j) { R.x[j] = ((const u32x2*)(XB + (size_t)mm_ * D))[lane + 64 * j]; R.ya[j] = ((const u32x2*)(YS + (size_t)s0_ * D))[lane + 64 * j]; R.yc[j] = ((const u32x2*)(YS + (size_t)s1_ * D))[lane + 64 * j]; } } while (0)
#define FFN_PROC(R, m_) do { const int mm_ = (m_); f32x4 v_[4]; ffn_combine(R, v_); ln_row(v_, g, b, lane); \
        store_row_f32_bf16(v_, layer == 0 ? (float*)nullptr : XF + (size_t)mm_ * D, layer == 0 ? XB + (size_t)mm_ * D : (bf16*)nullptr, lane); \
        if (layer == 0) { const float t_ = row_dots16(v_, WT, lane); if ((lane & 3) == 0 && eo < 12) LOGF[(size_t)mm_ * 12 + eo] = log_sigmoid(t_ + bf); } } while (0)
    FfnRow A0, A1, B0, B1;
#define FFN_PROC2(R0, R1, m0_, m1_) do { const int ma_ = (m0_), mb_ = (m1_); f32x4 va_[4], vb_[4]; ffn_combine(R0, va_); ffn_combine(R1, vb_); ln_row(va_, g, b, lane); ln_row(vb_, g, b, lane); \
        store_row_f32_bf16(va_, layer == 0 ? (float*)nullptr : XF + (size_t)ma_ * D, layer == 0 ? XB + (size_t)ma_ * D : (bf16*)nullptr, lane); \
        store_row_f32_bf16(vb_, layer == 0 ? (float*)nullptr : XF + (size_t)mb_ * D, layer == 0 ? XB + (size_t)mb_ * D : (bf16*)nullptr, lane); \
        if (layer == 0) { float ta_, tb_; row_dots16x2(va_, vb_, WT, lane, ta_, tb_); if ((lane & 3) == 0 && eo < 12) { LOGF[(size_t)ma_ * 12 + eo] = log_sigmoid(ta_ + bf); LOGF[(size_t)mb_ * 12 + eo] = log_sigmoid(tb_ + bf); } } } while (0)
    int m = gw;
    if (m + NGW < NTOK) { FFN_LOAD(A0, m); FFN_LOAD(A1, m + NGW); }
#pragma unroll 1
    for (; m + NGW < NTOK; m += 4 * NGW) {
        const bool hb = (m + 3 * NGW) < NTOK;
        if (hb) { FFN_LOAD(B0, m + 2 * NGW); FFN_LOAD(B1, m + 3 * NGW); }
        FFN_PROC2(A0, A1, m, m + NGW);
        if (m + 5 * NGW < NTOK) { FFN_LOAD(A0, m + 4 * NGW); FFN_LOAD(A1, m + 5 * NGW); }
        if (hb) FFN_PROC2(B0, B1, m + 2 * NGW, m + 3 * NGW); else { m += 2 * NGW; break; }
    }
    if (m < NTOK) { FFN_LOAD(A0, m); FFN_PROC(A0, m); }
#undef FFN_PROC2
#undef FFN_LOAD
#undef FFN_PROC
}
__device__ __forceinline__ void cum_wave(const float* LOGF, float* CUM, int bh, int lane) {
    const int b = bh / FOX_H, h = bh % FOX_H;
    float loc[64]; float s = 0.f;
#pragma unroll
    for (int i = 0; i < 64; ++i) { s += LOGF[((size_t)b * SEQ + lane * 64 + i) * 12 + h]; loc[i] = s; }
    float inc = s;
#pragma unroll
    for (int o = 1; o < 64; o <<= 1) { const float t = __shfl_up(inc, o); if (lane >= o) inc += t; }
    const float base = inc - s;
#pragma unroll
    for (int i = 0; i < 64; ++i) CUM[(size_t)bh * SEQ + lane * 64 + i] = base + loc[i];
}
constexpr int MOE_MAXU = 6;
__device__ __forceinline__ int moe_setup(unsigned char* ws, LAS unsigned char* lds, int G, int bid, const int wave_s, const bool build_rows) {
    const int tid = fresh_tid(wave_s), lane = tid & 63, wave = wave_s;
    LAS int* PRE = (LAS int*)lds; LAS int* TB = (LAS int*)(lds + 16640); LAS int* TE = TB + 17;
    volatile LAS int* UL = (volatile LAS int*)(lds + MISC_OFF) + 16; LAS int* rowtok = (LAS int*)(lds + ROWTOK_OFF);
    const int* CNT = (const int*)(ws + WS_CNT); const int* SLOT_TOK = (const int*)(ws + WS_SLOTTOK); int* TOK_S = (int*)(ws + WS_TOKS);
#pragma unroll
    for (int q = 0; q < 2; ++q) { const int e = 2 * wave + q;
        int c[4]; int s = 0;
#pragma unroll
        for (int i = 0; i < 4; ++i) { c[i] = CNT[(4 * lane + i) * 16 + e]; s += c[i]; }
        int inc = s;
#pragma unroll
        for (int o = 1; o < 64; o <<= 1) { const int t = __shfl_up(inc, o); if (lane >= o) inc += t; }
        int run = inc - s;
#pragma unroll
        for (int i = 0; i < 4; ++i) { PRE[e * 257 + 4 * lane + i] = run; run += c[i]; }
        if (lane == 63) { PRE[e * 257 + 256] = inc; TE[e] = inc; } }
    __syncthreads();
    if (tid <= 16) { int t = 0; for (int e = 0; e < 16; ++e) { if (e < tid) t += (TE[e] + 255) >> 8; } TB[tid] = t; }
    __syncthreads();
    const int NT = TB[16];
    if (tid < MOE_MAXU) { const int L = tid * G + bid, tile = (L & 7) + 8 * (L >> 5), pn = (L >> 3) & 3;
        int e = 0;
#pragma unroll
        for (int k = 1; k < 16; ++k) e += (TB[k] <= tile) ? 1 : 0;
        UL[3 * tid] = tile; UL[3 * tid + 1] = pn; UL[3 * tid + 2] = e; UL[32 + tid] = (tile < NT) ? 1 : 0; }
    __syncthreads();
    if (tid == 0) { int n = 0;
#pragma unroll
        for (int i = 0; i < MOE_MAXU; ++i) n += (int)UL[32 + i]; UL[24] = n; UL[25] = 32 * ((NT + 7) >> 3); }
    __syncthreads();
    const int nunits = __builtin_amdgcn_readfirstlane(UL[24]);
    if (build_rows) {
        for (int i = (tid >> 8); i < nunits; i += 2) { const int tile = UL[3 * i], pn = UL[3 * i + 1], e = UL[3 * i + 2], j = tid & 255;
            const int r = 256 * (tile - TB[e]) + j; int tok = 0;
            if (r < TE[e]) { int lo = 0, hi = 256;
                while (hi - lo > 1) { const int mid = (lo + hi) >> 1; if (PRE[e * 257 + mid] <= r) lo = mid; else hi = mid; }
                const int ent = SLOT_TOK[(e * 256 + lo) * 128 + (r - PRE[e * 257 + lo])]; tok = ent >> 1;
                if (pn == 0) TOK_S[ent] = 256 * tile + j; }
            rowtok[i * 256 + j] = tok; }
    }
    __syncthreads();
    return nunits;
}
struct MoeGU {
    const char* XBp; const char* W; LAS const int* UL; LAS const int* rowtok; int nunits;
    __device__ __forceinline__ bool next(int i, Unit& u) const { if (i >= nunits) return false;
        u.pm = __builtin_amdgcn_readfirstlane(UL[3 * i]); u.pn = __builtin_amdgcn_readfirstlane(UL[3 * i + 1]); u.e = __builtin_amdgcn_readfirstlane(UL[3 * i + 2]); u.ord = i;
        u.A = XBp; u.B = W + ((size_t)u.e * 1024 + (size_t)u.pn * 256) * D * 2; return true; }
    __device__ __forceinline__ unsigned a_off(const Unit& u, int h, int R, int C) const { return (unsigned)(rowtok[u.ord * 256 + R + HALF * h] * D + C) * 2u; }
};
struct MoeDown {
    const char* Hp; const char* W; LAS const int* UL; int nunits;
    __device__ __forceinline__ bool next(int i, Unit& u) const { if (i >= nunits) return false;
        u.pm = __builtin_amdgcn_readfirstlane(UL[3 * i]); u.pn = __builtin_amdgcn_readfirstlane(UL[3 * i + 1]); u.e = __builtin_amdgcn_readfirstlane(UL[3 * i + 2]); u.ord = i;
        u.A = Hp + (size_t)u.pm * BM * DEXP * 2; u.B = W + ((size_t)u.e * 1024 + (size_t)u.pn * 256) * DEXP * 2; return true; }
    __device__ __forceinline__ unsigned a_off(const Unit&, int h, int R, int C) const { return (unsigned)((R + HALF * h) * DEXP + C) * 2u; }
};
struct EpiGateUp { bf16* H;
    __device__ __forceinline__ void operator()(const f32x4 (&acc)[2][2][4][2], const Unit& u, int wr, int wc, int fr, int fq) const {
        bf16* rowp = H + (size_t)(u.pm * BM + wr * 64 + fr) * DEXP + (u.pn * 128 + wc * 32 + 8 * fq);
#pragma unroll
        for (int ai = 0; ai < 2; ++ai) {
#pragma unroll
            for (int m = 0; m < 4; ++m) { float hv[8];
#pragma unroll
                for (int n = 0; n < 2; ++n)
#pragma unroll
                    for (int j = 0; j < 4; ++j) { const float g = acc[ai][0][m][n][j], up = acc[ai][1][m][n][j]; hv[4 * n + j] = g * __builtin_amdgcn_rcpf(1.f + __expf(-g)) * up; }
                u32x4 w; w.x = cvt_pk_bf16(hv[0], hv[1]); w.y = cvt_pk_bf16(hv[2], hv[3]); w.z = cvt_pk_bf16(hv[4], hv[5]); w.w = cvt_pk_bf16(hv[6], hv[7]);
                *(u32x4*)rowp = w;
                rowp += (size_t)16 * DEXP; asm volatile("" : "+v"(rowp)); }
            rowp += (size_t)64 * DEXP; }
    } };
__device__ __forceinline__ int crow(int r, int hi) { return (r & 3) + 8 * (r >> 2) + 4 * hi; }
__device__ __forceinline__ unsigned cvtpk_s(float lo, float hi) { typedef float f2 __attribute__((ext_vector_type(2))); typedef __bf16 b2 __attribute__((ext_vector_type(2))); f2 v = {lo, hi}; b2 b = __builtin_convertvector(v, b2); return __builtin_bit_cast(unsigned, b); }
__device__ __forceinline__ float bfbits2f(unsigned short v) { return __uint_as_float(((unsigned)v) << 16); }

constexpr int AT_NSLOT = 4, AT_SLOT = 16640, AT_K = 0, AT_V = 8192, AT_KB = 16384, AT_WS = AT_NSLOT * AT_SLOT, AT_OST = AT_WS + 2048, AT_BYTES = AT_OST + 8 * 4096;
static_assert(AT_BYTES <= RING_BYTES, "attention LDS");
__device__ __forceinline__ void glds_asm16(const void* gsrc, unsigned lds_dst) { unsigned keep;
    asm volatile("s_mov_b32 %0, m0\n\ts_mov_b32 m0, %2\n\ts_nop 0\n\tglobal_load_lds_dwordx4 %1, off\n\ts_mov_b32 m0, %0" : "=&s"(keep) : "v"(gsrc), "s"(lds_dst) : "memory"); }
__device__ __forceinline__ void glds_asm4(const void* gsrc, unsigned lds_dst) { unsigned keep;
    asm volatile("s_mov_b32 %0, m0\n\ts_mov_b32 m0, %2\n\ts_nop 0\n\tglobal_load_lds_dword %1, off\n\ts_mov_b32 m0, %0" : "=&s"(keep) : "v"(gsrc), "s"(lds_dst) : "memory"); }
constexpr float AT_THR = 10.0f, AT_SKIP = 40.0f;
template <bool FOX>
__device__ __forceinline__ void attn_qk(const LAS unsigned char* slot, const bf16x8 (&qr)[4], float mref, f32x16& p0, f32x16& p1, int r32, int hi) {
    const LAS unsigned char* kb = slot + AT_K + hi * 1024 + r32 * 16; const LAS float* kbs = (const LAS float*)(slot + AT_KB);
    if (FOX) { const float nm = -mref;
#pragma unroll
        for (int g = 0; g < 4; ++g) { const f32x4 b0 = *(const LAS f32x4*)(kbs + 8 * g + 4 * hi), b1 = *(const LAS f32x4*)(kbs + 32 + 8 * g + 4 * hi);
#pragma unroll
            for (int j = 0; j < 4; ++j) { p0[4 * g + j] = __builtin_fmaf(b0[j], -LOG2E, nm); p1[4 * g + j] = __builtin_fmaf(b1[j], -LOG2E, nm); } }
    } else { p0 = f32x16{}; p1 = f32x16{}; }
#pragma unroll
    for (int d0 = 0; d0 < 4; ++d0) { const bf16x8 b0 = *(const LAS bf16x8*)(kb + d0 * 2048), b1 = *(const LAS bf16x8*)(kb + d0 * 2048 + 512);
        p0 = __builtin_amdgcn_mfma_f32_32x32x16_bf16(b0, qr[d0], p0, 0, 0, 0); p1 = __builtin_amdgcn_mfma_f32_32x32x16_bf16(b1, qr[d0], p1, 0, 0, 0); }
}
template <bool FOX>
__device__ __forceinline__ void attn_sm_pv(const LAS unsigned char* slot, f32x16& p0, f32x16& p1, f32x16& n0, f32x16& n1, bool has_next, f32x16 (&o)[2], float& mref, float& lrun, LAS float* wsf, int vb0, int jb, int qrel, int r32, int hi) {
    if (FOX) {
        if (jb >= 0) { const int kbase = 64 * jb + 4 * hi;
#pragma unroll
            for (int r = 0; r < 16; ++r) { const int kv = kbase + (r & 3) + 8 * (r >> 2); if (kv > qrel) p0[r] = -INFINITY; if (kv + 32 > qrel) p1[r] = -INFINITY; } }
    } else { const float nm = -mref;
#pragma unroll
        for (int r = 0; r < 16; ++r) { p0[r] = __builtin_fmaf(p0[r], QC2, nm); p1[r] = __builtin_fmaf(p1[r], QC2, nm); }
    }
    float rm = fmaxf(p0[0], p1[0]);
#pragma unroll
    for (int r = 1; r < 16; ++r) rm = fmaxf(rm, fmaxf(p0[r], p1[r]));
    { auto rr = __builtin_amdgcn_permlane32_swap(__float_as_uint(rm), __float_as_uint(rm), false, false); rm = fmaxf(__uint_as_float(rr[0]), __uint_as_float(rr[1])); }
    const bool move = (rm > AT_THR) || (lrun == 0.f && rm > -1e30f);
    if (__builtin_expect(__any(move), 0)) {
        const float dl = move ? rm : 0.f, f = __builtin_amdgcn_exp2f(fminf(-dl, 64.f));
        mref += dl; lrun *= f;
#pragma unroll
        for (int r = 0; r < 16; ++r) { p0[r] -= dl; p1[r] -= dl; }
        if (FOX && has_next) {
#pragma unroll
            for (int r = 0; r < 16; ++r) { n0[r] -= dl; n1[r] -= dl; } }
        if (hi == 0) wsf[r32] = f;
        asm volatile("s_waitcnt lgkmcnt(0)" ::: "memory");
#pragma unroll
        for (int g = 0; g < 4; ++g) { const f32x4 a = *(const LAS f32x4*)(wsf + 8 * g + 4 * hi);
#pragma unroll
            for (int j = 0; j < 4; ++j) { o[0][4 * g + j] *= a[j]; o[1][4 * g + j] *= a[j]; } }
    }
    float rs = 0.f;
#pragma unroll
    for (int r = 0; r < 16; ++r) { p0[r] = __builtin_amdgcn_exp2f(p0[r]); p1[r] = __builtin_amdgcn_exp2f(p1[r]); rs += p0[r] + p1[r]; }
    { auto rr = __builtin_amdgcn_permlane32_swap(__float_as_uint(rs), __float_as_uint(rs), false, false); rs = __uint_as_float(rr[0]) + __uint_as_float(rr[1]); }
    lrun += rs;
    u32x4 pw[4];
#pragma unroll
    for (int k = 0; k < 2; ++k) {
        pw[k] = (u32x4){cvtpk_s(p0[8 * k], p0[8 * k + 1]), cvtpk_s(p0[8 * k + 2], p0[8 * k + 3]), cvtpk_s(p0[8 * k + 4], p0[8 * k + 5]), cvtpk_s(p0[8 * k + 6], p0[8 * k + 7])};
        pw[2 + k] = (u32x4){cvtpk_s(p1[8 * k], p1[8 * k + 1]), cvtpk_s(p1[8 * k + 2], p1[8 * k + 3]), cvtpk_s(p1[8 * k + 4], p1[8 * k + 5]), cvtpk_s(p1[8 * k + 6], p1[8 * k + 7])}; }
    const int vb = vb0 + (int)(unsigned)(size_t)slot;
#pragma unroll
    for (int d0 = 0; d0 < 2; ++d0) { s16x4 vlo[4], vhi[4];
#pragma unroll
        for (int ks = 0; ks < 4; ++ks) {
            asm volatile("ds_read_b64_tr_b16 %0,%1 offset:%c2" : "=&v"(vlo[ks]) : "v"(vb), "i"(d0 * 4096 + ks * 1024) : "memory");
            asm volatile("ds_read_b64_tr_b16 %0,%1 offset:%c2" : "=&v"(vhi[ks]) : "v"(vb), "i"(d0 * 4096 + ks * 1024 + 512) : "memory"); }
        asm volatile("s_waitcnt lgkmcnt(0)" ::: "memory"); __builtin_amdgcn_sched_barrier(0);
#pragma unroll
        for (int ks = 0; ks < 4; ++ks) { const bf16x8 vf = (bf16x8){vlo[ks][0], vlo[ks][1], vlo[ks][2], vlo[ks][3], vhi[ks][0], vhi[ks][1], vhi[ks][2], vhi[ks][3]};
            o[d0] = __builtin_amdgcn_mfma_f32_32x32x16_bf16(__builtin_bit_cast(bf16x8, pw[ks]), vf, o[d0], 0, 0, 0); }
    }
}
template <bool FOX>
__device__ __forceinline__ void attn_unit(LAS unsigned char* lds, const bf16* Qp, int qpitch, const bf16* Kp, const bf16* Vp, int kvpitch, int NT, const float* cum, float qk_bound, bf16* Op, int opitch, const bf16* OGp, int gpitch, const int wave_s) {
    const int tid = fresh_tid(wave_s), lane = tid & 63, wid = wave_s, r32 = lane & 31, hi = lane >> 5; const int bid = blockIdx.x;
    LAS float* wsf = (LAS float*)(lds + AT_WS) + wid * 64;
    bf16x8 qr[4];
#pragma unroll
    for (int d0 = 0; d0 < 4; ++d0) qr[d0] = *(const bf16x8*)(Qp + (size_t)(wid * 32 + r32) * qpitch + d0 * 16 + hi * 8);
    const bf16* ksrc = Kp + (size_t)lane * kvpitch + wid * 8;
    const bf16* vsrc = Vp + (size_t)(16 * (wid & 3) + (lane >> 2)) * kvpitch + (wid >> 2) * 32 + (lane & 3) * 8;
    const int vb0 = AT_V + ((lane >> 4) & 1) * 32 + (lane & 3) * 8 + (4 * hi + ((lane & 15) >> 2)) * 64;
    float mref = 0.f, lrun = 0.f; f32x16 o[2]; o[0] = f32x16{}; o[1] = f32x16{};
    const int NTF = NT;
    if (FOX) { int i0 = NTF * 64 - 256; asm volatile("" : "+v"(i0));
        const float c0 = cum[i0], cl = cum[(lane < NTF ? lane : NTF - 1) * 64 + 63];
        const bool need = (lane < NTF) && ((c0 - cl) * LOG2E + 2.f * qk_bound >= -AT_SKIP);
        const int cnt = __builtin_popcountll(__ballot(need)); NT = cnt < 4 ? 4 : ((cnt + 1) & ~1); if (NT > NTF) NT = NTF; }
    const int qrel = wid * 32 + r32; const size_t tstep = (size_t)64 * kvpitch;
    constexpr int ND = FOX ? 3 : 2;
#define AT_TILE(tt) (FOX ? NTF - 1 - (tt) : (tt))
#define AT_ISSUE(tt) do { const unsigned sl_ = ldsb + (unsigned)(((tt) & (AT_NSLOT - 1)) * AT_SLOT); const int kt_ = AT_TILE(tt); \
        glds_asm16(ksrc + (size_t)kt_ * tstep, (unsigned)__builtin_amdgcn_readfirstlane(sl_ + AT_K + wid * 1024)); \
        glds_asm16(vsrc + (size_t)kt_ * tstep, (unsigned)__builtin_amdgcn_readfirstlane(sl_ + AT_V + wid * 1024)); \
        if (FOX) glds_asm4(cum + kt_ * 64 + lane, (unsigned)__builtin_amdgcn_readfirstlane(sl_ + AT_KB)); } while (0)
    const unsigned ldsb = (unsigned)(size_t)lds;
    AT_ISSUE(0); AT_ISSUE(1); AT_ISSUE(2);
#define AT_WAIT1() do { if (FOX) asm volatile("s_waitcnt vmcnt(3)" ::: "memory"); else asm volatile("s_waitcnt vmcnt(2)" ::: "memory"); } while (0)
#define AT_SLOTP(tt) (lds + ((tt) & (AT_NSLOT - 1)) * AT_SLOT)
#define AT_STEP(PC0, PC1, PN0, PN1, tt) do { const int t_ = (tt); const bool hn_ = t_ + 1 < NT; \
        { PSEC_BEGIN(10); if (t_ + 2 < NT) AT_WAIT1(); else asm volatile("s_waitcnt vmcnt(0)" ::: "memory"); \
        __builtin_amdgcn_s_barrier(); asm volatile("" ::: "memory"); PSEC_END(10); } \
        { PSEC_BEGIN(11); if (t_ + 3 < NT) AT_ISSUE(t_ + 3); PSEC_END(11); } \
        { PSEC_BEGIN(12); if (hn_) attn_qk<FOX>(AT_SLOTP(t_ + 1), qr, mref, PN0, PN1, r32, hi); PSEC_END(12); } \
        { PSEC_BEGIN(13); attn_sm_pv<FOX>(AT_SLOTP(t_), PC0, PC1, PN0, PN1, hn_, o, mref, lrun, wsf, vb0, AT_TILE(t_) - (NTF - 4), qrel, r32, hi); PSEC_END(13); } } while (0)
    f32x16 a0, a1, b0, b1;
    if (FOX) asm volatile("s_waitcnt vmcnt(6)" ::: "memory"); else asm volatile("s_waitcnt vmcnt(4)" ::: "memory");
    __builtin_amdgcn_s_barrier(); asm volatile("" ::: "memory");
    attn_qk<FOX>(AT_SLOTP(0), qr, mref, a0, a1, r32, hi);
#pragma unroll 1
    for (int t = 0; t < NT; t += 2) { AT_STEP(a0, a1, b0, b1, t); AT_STEP(b0, b1, a0, a1, t + 1); }
#undef AT_STEP
#undef AT_WAIT1
#undef AT_SLOTP
#undef AT_ISSUE
#undef AT_TILE
    static_assert(ND == 3 || ND == 2, "");
    if (hi == 0) wsf[32 + r32] = lrun;
    asm volatile("s_waitcnt lgkmcnt(0)" ::: "memory");
    LAS bf16* stg = (LAS bf16*)(lds + AT_OST) + wid * 2048;
#pragma unroll
    for (int r = 0; r < 16; ++r) { const int orow = crow(r, hi); const float rl = __builtin_amdgcn_rcpf(wsf[32 + orow]);
#pragma unroll
        for (int d0 = 0; d0 < 2; ++d0) stg[orow * 64 + d0 * 32 + r32] = f2bf(o[d0][r] * rl); }
    asm volatile("s_waitcnt lgkmcnt(0)" ::: "memory");
#pragma unroll
    for (int i = 0; i < 4; ++i) { const int row = i * 8 + (lane >> 3), ch = lane & 7; u32x4 v = *(const LAS u32x4*)(stg + row * 64 + ch * 8);
        const size_t go = (size_t)(wid * 32 + row) * opitch + ch * 8;
        if (FOX) { const u32x4 g = *(const u32x4*)(OGp + (size_t)(wid * 32 + row) * gpitch + ch * 8); unsigned vv[4] = {v.x, v.y, v.z, v.w}; const unsigned gg[4] = {g.x, g.y, g.z, g.w};
#pragma unroll
            for (int k = 0; k < 4; ++k) { const float a0 = __uint_as_float(vv[k] << 16), a1 = __uint_as_float(vv[k] & 0xffff0000u), g0 = __uint_as_float(gg[k] << 16), g1 = __uint_as_float(gg[k] & 0xffff0000u);
                vv[k] = cvtpk_s(a0 * __builtin_amdgcn_rcpf(1.f + __expf(-g0)), a1 * __builtin_amdgcn_rcpf(1.f + __expf(-g1))); }
            v = (u32x4){vv[0], vv[1], vv[2], vv[3]}; }
        *(u32x4*)(Op + go) = v; }
    __syncthreads();
}
constexpr int CW_Q11 = 1024;
__device__ __forceinline__ float wave_max64(float v) {
    v = fmaxf(v, dppf<0xB1>(v)); v = fmaxf(v, dppf<0x4E>(v)); v = fmaxf(v, dppf<0x141>(v)); v = fmaxf(v, dppf<0x140>(v));
    { auto r = __builtin_amdgcn_permlane16_swap(__float_as_uint(v), __float_as_uint(v), false, false); v = fmaxf(__uint_as_float(r[0]), __uint_as_float(r[1])); }
    { auto r = __builtin_amdgcn_permlane32_swap(__float_as_uint(v), __float_as_uint(v), false, false); v = fmaxf(__uint_as_float(r[0]), __uint_as_float(r[1])); }
    return v;
}
__device__ __forceinline__ void phase_attn_b(KP p, LAS unsigned char* lds, const int wave_s) {
    unsigned char* ws = p->ws;
    const bf16* Q = (const bf16*)(ws + WS_HREG); const bf16* K = (const bf16*)(ws + WS_HREG + HR_48); const bf16* V = (const bf16*)(ws + WS_HREG + 2 * HR_48); const bf16* OG = (const bf16*)(ws + WS_HREG + 3 * HR_48);
    const bf16* MQ = (const bf16*)(ws + WS_HREG + 4 * HR_48); const bf16* MKV = (const bf16*)(ws + WS_MKV);
    const float* CUM = (const float*)(ws + WS_CUM); bf16* OC = (bf16*)(ws + WS_GREG);
    unsigned* qhead = (unsigned*)(ws + WS_CTL) + CW_Q11;
    volatile LAS unsigned* slotw = (volatile LAS unsigned*)(lds + MISC_OFF) + 48;
    float qkb; { const int lane = fresh_lane(); const float gq = wave_max64(fabsf(p->in[I_QNG][lane])), gk = wave_max64(fabsf(p->in[I_KNG][lane])); qkb = 64.f * gq * gk * QC2 * 1.02f; }
    for (;;) {
        if (fresh_tid(wave_s) == 0) slotw[0] = __hip_atomic_fetch_add(qhead, 1u, __ATOMIC_RELAXED, __HIP_MEMORY_SCOPE_AGENT);
        __syncthreads();
        const int u = (int)__builtin_amdgcn_readfirstlane(slotw[0]);
        if (u >= 1536 + 512) break;
        if (u < 1536) { const int qb = 15 - u / 96, bh = u % 96, b = bh / FOX_H, h = bh % FOX_H; const size_t row0 = (size_t)b * SEQ;
            attn_unit<true>(lds, Q + (row0 + qb * 256) * 768 + h * 64, 768, K + row0 * 768 + h * 64, V + row0 * 768 + h * 64, 768, 4 * (qb + 1), CUM + (size_t)bh * SEQ, qkb,
                            OC + (row0 + qb * 256) * D + h * 64, D, OG + (row0 + qb * 256) * 768 + h * 64, 768, wave_s); }
        else { const int m = u - 1536, b = m >> 6, hd = (m >> 4) & 3, qblk = m & 15; const size_t row0 = (size_t)b * SEQ + qblk * 256;
            const bf16* Kp = MKV + (size_t)b * NMEM * 1024 + 512 + hd * 64;
            attn_unit<false>(lds, MQ + row0 * 256 + hd * 64, 256, Kp, Kp + 256, 1024, 4, nullptr, 0.f, OC + row0 * D + 768 + hd * 64, D, nullptr, 0, wave_s); }
    }
}
__device__ __forceinline__ void phase_attn_mem(unsigned char* ws, LAS unsigned char* lds, int layer, int G, int bid, const int wave_s) {
    const bf16* MQ = (const bf16*)(ws + WS_HREG + (layer == 0 ? 3 : 4) * HR_48); const bf16* MKV = (const bf16*)(ws + WS_MKV); bf16* OC = (bf16*)(ws + (layer == 0 ? WS_XB : WS_GREG));
    for (int u = bid; u < 512; u += G) { const int b = u >> 6, hd = (u >> 4) & 3, qblk = u & 15; const size_t row0 = (size_t)b * SEQ + qblk * 256;
        const bf16* Kp = MKV + (size_t)b * NMEM * 1024 + layer * 512 + hd * 64;
        attn_unit<false>(lds, MQ + row0 * 256 + hd * 64, 256, Kp, Kp + 256, 1024, 4, nullptr, 0.f, OC + row0 * D + 768 + hd * 64, D, nullptr, 0, wave_s); }
}
constexpr int GL_QP = 208, GL_VP = 448, GL_KX = 0, GL_QD = 13312, GL_VT = 26624, GL_HEAD = 55296;
constexpr int GL_GLR = 2 * GL_HEAD, GL_TOT = GL_GLR + 4096, GL_SSX = GL_TOT + 1536, GL_BYTES = GL_SSX + 1024;
static_assert(GL_BYTES <= RING_BYTES, "GLA LDS");
typedef short v4i16_t __attribute__((ext_vector_type(4)));
typedef float f32x2 __attribute__((ext_vector_type(2)));
__device__ __forceinline__ s16x4 trd(const LAS unsigned char* p) { return __builtin_bit_cast(s16x4, __builtin_amdgcn_ds_read_tr16_b64_v4i16((LAS v4i16_t*)p)); }
__device__ __forceinline__ float fast_log_sigmoid(float z) { return fminf(z, 0.f) - __logf(1.f + __expf(-fabsf(z))); }

template <int MODE> struct GlaRegs { u32x4 v[6]; u32x4 qk[MODE == 1 ? 6 : 3]; f32x4 g; };
template <int MODE>
__device__ __forceinline__ void gla_fetch(unsigned char* ws, int tid, int unit, GlaRegs<MODE>& R) {
    const int hp = unit & 1, n = (unit >> 1) & 63, b = unit >> 7;
    const bf16* V = (const bf16*)(ws + WS_HREG + HR_48); const float* GLR = (const float*)(ws + WS_GLR); const bf16* QK = (const bf16*)(ws + WS_HREG);
    const size_t m0 = (size_t)b * SEQ + n * 64;
#pragma unroll
    for (int i = 0; i < 6; ++i) { const int pi = tid + 512 * i, u = pi / 1536, rem = pi % 1536, row = rem / 24, ch = rem % 24;
        R.v[i] = *(const u32x4*)(V + (m0 + row) * 768 + 192 * (2 * hp + u) + 8 * ch); }
#pragma unroll
    for (int i = 0; i < (MODE == 1 ? 6 : 3); ++i) { const int pi = tid + 512 * i, ts = pi / 1536, rem = pi % 1536, u = rem / 768, r2 = rem % 768, row = r2 / 12, ch = r2 % 12;
        R.qk[i] = *(const u32x4*)(QK + (m0 + row) * 768 + (ts == 0 ? 384 : 0) + 96 * (2 * hp + u) + 8 * ch); }
    if (tid < 256) R.g = *(const f32x4*)(GLR + m0 * 16 + 4 * tid);
}
template <int MODE>
__device__ __forceinline__ void gla_put(LAS unsigned char* lds, int tid, const GlaRegs<MODE>& R) {
#pragma unroll
    for (int i = 0; i < 6; ++i) { const int pi = tid + 512 * i, u = pi / 1536, rem = pi % 1536, row = rem / 24, ch = rem % 24;
        *(LAS u32x4*)(lds + u * GL_HEAD + GL_VT + row * GL_VP + ch * 16) = R.v[i]; }
#pragma unroll
    for (int i = 0; i < (MODE == 1 ? 6 : 3); ++i) { const int pi = tid + 512 * i, ts = pi / 1536, rem = pi % 1536, u = rem / 768, r2 = rem % 768, row = r2 / 12, ch = r2 % 12;
        *(LAS u32x4*)(lds + u * GL_HEAD + (ts == 0 ? GL_KX : GL_QD) + row * GL_QP + ch * 16) = R.qk[i]; }
    if (tid < 256) *(LAS f32x4*)(lds + GL_GLR + 16 * tid) = R.g;
}
template <int MODE>
__device__ __forceinline__ void gla_gates(KP p, unsigned char* ws, LAS unsigned char* lds, int tid, int b, int n, int hp) {
    float* DEC = (float*)(ws + WS_DEC);
    const size_t m0 = (size_t)b * SEQ + n * 64;
    LAS float* glr = (LAS float*)(lds + GL_GLR); LAS float* totl = (LAS float*)(lds + GL_TOT);
    float la[32]; float tot = 0.f; int col = 0, th = 0, u = 0, kidx = 0, head = 0;
    if (tid < 384) { col = tid % 192; th = tid / 192; u = col / 96; kidx = col % 96; head = 2 * hp + u;
        float w[16];
#pragma unroll
        for (int j = 0; j < 16; ++j) w[j] = p->in[I_WGUP][j * 384 + 96 * head + kidx];
        const float bg = p->in[I_BGATE][96 * head + kidx];
#pragma unroll
        for (int i = 0; i < 32; i += 2) { const LAS float* gr = glr + (32 * th + i) * 16; f32x2 z = (f32x2){bg, bg};
#pragma unroll
            for (int j4 = 0; j4 < 4; ++j4) { const f32x4 g0 = *(const LAS f32x4*)(gr + 4 * j4), g1 = *(const LAS f32x4*)(gr + 16 + 4 * j4);
#pragma unroll
                for (int k = 0; k < 4; ++k) z = (f32x2){g0[k], g1[k]} * w[4 * j4 + k] + z; }
            la[i] = fast_log_sigmoid(z[0]) * (1.f / 16.f); la[i + 1] = fast_log_sigmoid(z[1]) * (1.f / 16.f); tot += la[i] + la[i + 1]; }
        totl[th * 192 + col] = tot; }
    __syncthreads();
    if (tid < 384) {
        LAS bf16* KX = (LAS bf16*)(lds + u * GL_HEAD + GL_KX); LAS bf16* QD = (LAS bf16*)(lds + u * GL_HEAD + GL_QD);
        if (MODE == 0) {
            float run = (th == 1) ? 0.f : totl[192 + col];
            float kraw[32];
#pragma unroll
            for (int i = 0; i < 32; ++i) kraw[i] = bf2f(KX[(32 * th + i) * (GL_QP / 2) + kidx]);
#pragma unroll
            for (int i = 31; i >= 0; --i) { KX[(32 * th + i) * (GL_QP / 2) + kidx] = f2bf(kraw[i] * __expf(run)); run += la[i]; }
            if (th == 0) DEC[(((size_t)b * 64 + n) * 4 + head) * 96 + kidx] = __expf(run);
        } else {
            float run = (th == 0) ? 0.f : totl[col];
            float qraw[32], kraw[32];
#pragma unroll
            for (int i = 0; i < 32; ++i) { qraw[i] = bf2f(QD[(32 * th + i) * (GL_QP / 2) + kidx]); kraw[i] = bf2f(KX[(32 * th + i) * (GL_QP / 2) + kidx]); }
#pragma unroll
            for (int i = 0; i < 32; ++i) { run += la[i]; const unsigned pk = cvt_pk_bf16(qraw[i] * __expf(run) * 0.10206207261596577f, kraw[i] * __expf(-run));
                QD[(32 * th + i) * (GL_QP / 2) + kidx] = (bf16)(pk & 0xffffu); KX[(32 * th + i) * (GL_QP / 2) + kidx] = (bf16)(pk >> 16); }
        }
    }
    __syncthreads();
}
__device__ __forceinline__ void phase_gla_kv(KP p, LAS unsigned char* lds, int G, int bid, const int wave_s) {
    unsigned char* ws = p->ws; bf16* SKV = (bf16*)(ws + WS_GREG);
    GlaRegs<0> R;
    if (bid < NB * 64 * 2) gla_fetch<0>(ws, fresh_tid(wave_s), bid, R);
    for (int unit = bid; unit < NB * 64 * 2; unit += G) {
        const int tid = fresh_tid(wave_s), lane = tid & 63, wid = wave_s;
        const int hp = unit & 1, n = (unit >> 1) & 63, b = unit >> 7;
        { PSEC_BEGIN(40); gla_put<0>(lds, tid, R);
        __syncthreads(); PSEC_END(40); }
        if (unit + G < NB * 64 * 2) gla_fetch<0>(ws, tid, unit + G, R);
        { PSEC_BEGIN(41); gla_gates<0>(p, ws, lds, tid, b, n, hp); PSEC_END(41); }
        PSEC_BEGIN(42);
        const int u = wid >> 2, j4 = wid & 3, head = 2 * hp + u, r32 = lane & 31, h2 = lane >> 5, q = (lane & 15) >> 2, pp = lane & 3, g1 = (lane >> 4) & 1;
        const LAS unsigned char* ka = lds + u * GL_HEAD + GL_KX + (8 * h2 + q) * GL_QP + (16 * g1 + 4 * pp) * 2;
        const LAS unsigned char* va = lds + u * GL_HEAD + GL_VT + (8 * h2 + q) * GL_VP + (16 * g1 + 4 * pp) * 2;
        bf16* outb = SKV + ((((size_t)b * 64 + n) * 4 + head) * 192) * 96;
        for (int id = j4; id < 18; id += 4) { const int kb = id / 6, cb = id % 6;
            f32x16 acc = f32x16{};
#pragma unroll
            for (int ks = 0; ks < 4; ++ks) {
                const s16x4 a0 = trd(ka + ks * 16 * GL_QP + kb * 64), a1 = trd(ka + ks * 16 * GL_QP + 4 * GL_QP + kb * 64);
                const s16x4 b0 = trd(va + ks * 16 * GL_VP + cb * 64), b1 = trd(va + ks * 16 * GL_VP + 4 * GL_VP + cb * 64);
                acc = __builtin_amdgcn_mfma_f32_32x32x16_bf16((bf16x8){a0[0], a0[1], a0[2], a0[3], a1[0], a1[1], a1[2], a1[3]}, (bf16x8){b0[0], b0[1], b0[2], b0[3], b1[0], b1[1], b1[2], b1[3]}, acc, 0, 0, 0); }
            bf16* op = outb + (size_t)(32 * cb + r32) * 96 + 32 * kb + 4 * h2;
#pragma unroll
            for (int g = 0; g < 4; ++g) { u32x2 w; w.x = cvtpk_s(acc[4 * g], acc[4 * g + 1]); w.y = cvtpk_s(acc[4 * g + 2], acc[4 * g + 3]); *(u32x2*)(op + 8 * g) = w; }
        }
        __syncthreads();
        PSEC_END(42);
    }
}
__device__ __forceinline__ void phase_gla_scan(unsigned char* ws, int G, int bid, const int wave_s) {
    bf16* SKV = (bf16*)(ws + WS_GREG); const float* DEC = (const float*)(ws + WS_DEC);
    const int tid = fresh_tid(wave_s);
    constexpr int NITEM = NB * 4 * 192 * 12;
    const int per = (NITEM + G - 1) / G;
    for (int it = tid; it < per; it += NTHREADS) { const int item = bid * per + it; if (item >= NITEM) break;
        const int k8 = item % 12, c = (item / 12) % 192, bh = item / (12 * 192), b = bh >> 2, h = bh & 3;
        float s[8];
#pragma unroll
        for (int j = 0; j < 8; ++j) s[j] = 0.f;
        u32x4* ptr = (u32x4*)(SKV + ((((size_t)b * 64) * 4 + h) * 192 + c) * 96 + 8 * k8); const float* dp = DEC + (((size_t)b * 64) * 4 + h) * 96 + 8 * k8;
#pragma unroll 1
        for (int n0 = 0; n0 < 64; n0 += 8) { u32x4 kv[8]; f32x4 d0[8], d1[8];
#pragma unroll
            for (int i = 0; i < 8; ++i) { kv[i] = ptr[(size_t)(n0 + i) * (4 * 192 * 96 / 8)]; d0[i] = *(const f32x4*)(dp + (size_t)(n0 + i) * 4 * 96); d1[i] = *(const f32x4*)(dp + (size_t)(n0 + i) * 4 * 96 + 4); }
#pragma unroll
            for (int i = 0; i < 8; ++i) { u32x4 o; o.x = cvtpk_s(s[0], s[1]); o.y = cvtpk_s(s[2], s[3]); o.z = cvtpk_s(s[4], s[5]); o.w = cvtpk_s(s[6], s[7]); ptr[(size_t)(n0 + i) * (4 * 192 * 96 / 8)] = o;
                const unsigned kw[4] = {kv[i].x, kv[i].y, kv[i].z, kv[i].w};
#pragma unroll
                for (int j = 0; j < 4; ++j) { const float dlo = j < 2 ? d0[i][2 * j] : d1[i][2 * j - 4], dhi = j < 2 ? d0[i][2 * j + 1] : d1[i][2 * j - 3];
                    s[2 * j] = dlo * s[2 * j] + __uint_as_float(kw[j] << 16); s[2 * j + 1] = dhi * s[2 * j + 1] + __uint_as_float(kw[j] & 0xffff0000u); } } }
    }
}
__device__ __forceinline__ void phase_gla_out(KP p, LAS unsigned char* lds, int G, int bid, const int wave_s) {
    unsigned char* ws = p->ws; const bf16* SKV = (const bf16*)(ws + WS_GREG); const bf16* R = (const bf16*)(ws + WS_HREG + 2 * HR_48); bf16* OC = (bf16*)(ws + WS_XB);
    GlaRegs<1> RG;
    if (bid < NB * 64 * 2) gla_fetch<1>(ws, fresh_tid(wave_s), bid, RG);
    for (int unit = bid; unit < NB * 64 * 2; unit += G) {
        const int tid = fresh_tid(wave_s), lane = tid & 63, wid = wave_s;
        const int hp = unit & 1, n = (unit >> 1) & 63, b = unit >> 7;
        u32x2 rv12[12];
        { const int tb_ = wid & 1, ch_ = (wid >> 1) & 1, head_ = 2 * hp + (wid >> 2); const size_t m_ = (size_t)b * SEQ + n * 64 + 32 * tb_ + (lane & 31);
          const bf16* rp_ = R + m_ * 768 + 192 * head_ + 96 * ch_ + 4 * (lane >> 5);
#pragma unroll
          for (int q = 0; q < 12; ++q) rv12[q] = *(const u32x2*)(rp_ + 32 * (q >> 2) + 8 * (q & 3)); }
        { PSEC_BEGIN(30); gla_put<1>(lds, tid, RG);
        __syncthreads(); PSEC_END(30); }
        if (unit + G < NB * 64 * 2) gla_fetch<1>(ws, tid, unit + G, RG);
        { PSEC_BEGIN(31); gla_gates<1>(p, ws, lds, tid, b, n, hp); PSEC_END(31); }
        PSEC_BEGIN(32);
        const int u = wid >> 2, tb = wid & 1, ch = (wid >> 1) & 1, head = 2 * hp + u, r32 = lane & 31, h2 = lane >> 5, q = (lane & 15) >> 2, pp = lane & 3, g1 = (lane >> 4) & 1;
        const LAS unsigned char* kx = lds + u * GL_HEAD + GL_KX + r32 * GL_QP + 16 * h2;
        const LAS unsigned char* qd = lds + u * GL_HEAD + GL_QD + (32 * tb + r32) * GL_QP + 16 * h2;
        const LAS unsigned char* va = lds + u * GL_HEAD + GL_VT + (4 * h2 + q) * GL_VP + (16 * g1 + 4 * pp) * 2;
        bf16x8 qf[6];
#pragma unroll
        for (int ks = 0; ks < 6; ++ks) qf[ks] = *(const LAS bf16x8*)(qd + 32 * ks);
        f32x16 at0 = f32x16{}, at1 = f32x16{};
#pragma unroll
        for (int ks = 0; ks < 6; ++ks) at0 = __builtin_amdgcn_mfma_f32_32x32x16_bf16(*(const LAS bf16x8*)(kx + 32 * ks), qf[ks], at0, 0, 0, 0);
        if (tb == 1) {
#pragma unroll
            for (int ks = 0; ks < 6; ++ks) at1 = __builtin_amdgcn_mfma_f32_32x32x16_bf16(*(const LAS bf16x8*)(kx + 32 * GL_QP + 32 * ks), qf[ks], at1, 0, 0, 0);
        }
#pragma unroll
        for (int r = 0; r < 16; ++r) { const bool keep = crow(r, h2) <= r32; if (tb == 0) { if (!keep) at0[r] = 0.f; } else { if (!keep) at1[r] = 0.f; } }
        bf16x8 pb[4];
#pragma unroll
        for (int k2 = 0; k2 < 2; ++k2) {
            pb[k2] = __builtin_bit_cast(bf16x8, (u32x4){cvtpk_s(at0[8 * k2], at0[8 * k2 + 1]), cvtpk_s(at0[8 * k2 + 2], at0[8 * k2 + 3]), cvtpk_s(at0[8 * k2 + 4], at0[8 * k2 + 5]), cvtpk_s(at0[8 * k2 + 6], at0[8 * k2 + 7])});
            pb[2 + k2] = __builtin_bit_cast(bf16x8, (u32x4){cvtpk_s(at1[8 * k2], at1[8 * k2 + 1]), cvtpk_s(at1[8 * k2 + 2], at1[8 * k2 + 3]), cvtpk_s(at1[8 * k2 + 4], at1[8 * k2 + 5]), cvtpk_s(at1[8 * k2 + 6], at1[8 * k2 + 7])}); }
        const bf16* sg = SKV + ((((size_t)b * 64 + n) * 4 + head) * 192 + 96 * ch + r32) * 96 + 8 * h2;
        f32x16 o[3];
#pragma unroll
        for (int cbl = 0; cbl < 3; ++cbl) { const int cb = 3 * ch + cbl; f32x16 acc = f32x16{};
#pragma unroll
            for (int kq = 0; kq < 4; ++kq) { if (kq < 2 || tb == 1) {
                const s16x4 a0 = trd(va + kq * 16 * GL_VP + cb * 64), a1 = trd(va + kq * 16 * GL_VP + 8 * GL_VP + cb * 64);
                acc = __builtin_amdgcn_mfma_f32_32x32x16_bf16((bf16x8){a0[0], a0[1], a0[2], a0[3], a1[0], a1[1], a1[2], a1[3]}, pb[kq], acc, 0, 0, 0); } }
#pragma unroll
            for (int ks = 0; ks < 6; ++ks) { const bf16x8 sf = *(const bf16x8*)(sg + (size_t)(32 * cbl) * 96 + 16 * ks);
                acc = __builtin_amdgcn_mfma_f32_32x32x16_bf16(sf, qf[ks], acc, 0, 0, 0); }
            o[cbl] = acc; }
        asm volatile("" : "+v"(o[0]), "+v"(o[1]), "+v"(o[2])); PSEC_END(32);
        PSEC_BEGIN(33);
        float ss = 0.f;
#pragma unroll
        for (int cbl = 0; cbl < 3; ++cbl)
#pragma unroll
            for (int r = 0; r < 16; ++r) ss += o[cbl][r] * o[cbl][r];
        { auto rr = __builtin_amdgcn_permlane32_swap(__float_as_uint(ss), __float_as_uint(ss), false, false); ss = __uint_as_float(rr[0]) + __uint_as_float(rr[1]); }
        LAS float* ssx = (LAS float*)(lds + GL_SSX);
        if (h2 == 0) ssx[((u * 2 + tb) * 2 + ch) * 32 + r32] = ss;
        __syncthreads();
        ss += ssx[((u * 2 + tb) * 2 + (ch ^ 1)) * 32 + r32];
        const float rs = rsqrtf(ss * (1.f / 192.f) + RMS_EPS);
        const size_t m = (size_t)b * SEQ + n * 64 + 32 * tb + r32;
        bf16* op = OC + m * D + 192 * head + 96 * ch + 4 * h2; const float* gp = p->in[I_GLAG] + 96 * ch + 4 * h2;
#pragma unroll
        for (int cbl = 0; cbl < 3; ++cbl)
#pragma unroll
            for (int g = 0; g < 4; ++g) { const int co = 32 * cbl + 8 * g; const u32x2 rv = rv12[4 * cbl + g]; const f32x4 gn = *(const f32x4*)(gp + co);
                const float r0 = __uint_as_float(rv.x << 16), r1 = __uint_as_float(rv.x & 0xffff0000u), r2 = __uint_as_float(rv.y << 16), r3 = __uint_as_float(rv.y & 0xffff0000u);
                const float v0 = o[cbl][4 * g] * rs * gn[0] * (r0 * __builtin_amdgcn_rcpf(1.f + __expf(-r0))), v1 = o[cbl][4 * g + 1] * rs * gn[1] * (r1 * __builtin_amdgcn_rcpf(1.f + __expf(-r1)));
                const float v2 = o[cbl][4 * g + 2] * rs * gn[2] * (r2 * __builtin_amdgcn_rcpf(1.f + __expf(-r2))), v3 = o[cbl][4 * g + 3] * rs * gn[3] * (r3 * __builtin_amdgcn_rcpf(1.f + __expf(-r3)));
                u32x2 w; w.x = cvtpk_s(v0, v1); w.y = cvtpk_s(v2, v3); *(u32x2*)(op + co) = w; }
        __syncthreads();
        PSEC_END(33);
    }
}
constexpr int PROBE_J = -1, PROBE_B = 0, PROBE_K = 4;
__global__ void __launch_bounds__(NTHREADS, 2) mega(Params p_unused) {
    extern __shared__ __attribute__((aligned(16))) unsigned char lds_raw[];
    LAS unsigned char* lds = (LAS unsigned char*)lds_raw;
    const int G = gridDim.x, bid = blockIdx.x; const int wave_s = __builtin_amdgcn_readfirstlane(threadIdx.x >> 6);
    volatile LAS unsigned* MISC = (volatile LAS unsigned*)(lds + MISC_OFF);
    if (threadIdx.x < 64) MISC[threadIdx.x] = 0u;
    __syncthreads();
    KP p = fresh_kp();
    unsigned char* ws = p->ws;
    volatile LAS unsigned* STAMPS = (volatile LAS unsigned*)(lds + ROWTOK_OFF + 6144);
    if (PROBE_J >= 0 && threadIdx.x == 0) { const unsigned long long t_ = __builtin_amdgcn_s_memrealtime(); STAMPS[0] = (unsigned)t_; STAMPS[1] = (unsigned)(t_ >> 32); }
    if (PROBE_SEC >= 0 && threadIdx.x == 0) *(volatile LAS unsigned*)(lds + PSEC_OFF) = 0u;
    XcdBarrier bar = xcd_barrier_post((unsigned*)(ws + WS_CTL) + CW_BAR + p->bar_li * XCD_BAR_WORDS, MISC + 8);
#define WS (fresh_kp()->ws)
#define IN(k) ({ KP _q = fresh_kp(); const bool _r = _q->ph_lo <= (k) && (k) < _q->ph_hi; _r; })
#define SEAM(k) do { if (IN(k) && IN((k) + 1)) xcd_barrier(bar); if (PROBE_J >= 0 && threadIdx.x == 0) { const unsigned long long t_ = __builtin_amdgcn_s_memrealtime(); STAMPS[2 * ((k) + 1)] = (unsigned)t_; STAMPS[2 * ((k) + 1) + 1] = (unsigned)(t_ >> 32); } } while (0)

    if (IN(0)) { phase_prologue(fresh_kp(), lds, G, bid, wave_s); }
    SEAM(0);
    if (IN(1)) { unsigned char* wsl = WS;
        { TileOrder S; S.init(wsl + WS_XB, wsl + WS_WA, NTOK, 2560, D, G, bid);
          EpiInA E{(bf16*)(wsl + WS_HREG), (bf16*)(wsl + WS_HREG + HR_48), (bf16*)(wsl + WS_HREG + 2 * HR_48), (bf16*)(wsl + WS_HREG + 3 * HR_48)};
          gemm_phase(lds + RING_OFF, D, S, E, wave_s); }
    }
    SEAM(1);
    if (IN(2)) phase_gla_kv(fresh_kp(), lds, G, bid, wave_s);
    SEAM(2);
    if (IN(3)) { unsigned char* wsl = WS;
        if (G > 32 && bid < 16) { TileOrder S; S.init(wsl + WS_MEMB, wsl + WS_WMKV, NB * NMEM, 512, D, 16, bid);
            EpiPlain E{(bf16*)(wsl + WS_MKV), 1024};
            gemm_phase(lds + RING_OFF, D, S, E, wave_s); }
        else { phase_gla_scan(wsl, G > 32 ? G - 16 : G, G > 32 ? bid - 16 : bid, wave_s); __syncthreads(); if (G > 32) convert_from_queue(fresh_kp(), lds, wave_s, 4, CW_CVQA, CV_A_STATIC, CV_QA); }
        if (G <= 32) { TileOrder S; S.init(wsl + WS_MEMB, wsl + WS_WMKV, NB * NMEM, 512, D, G, bid); EpiPlain E{(bf16*)(wsl + WS_MKV), 1024}; gemm_phase(lds + RING_OFF, D, S, E, wave_s); } }
    SEAM(3);
    if (IN(4)) { phase_gla_out(fresh_kp(), lds, G, bid, wave_s); unsigned char* wsl = WS; { PSEC_BEGIN(45); phase_attn_mem(wsl, lds, 0, G, bid, wave_s); PSEC_END(45); } }
    SEAM(4);
        if (IN(5)) { unsigned char* wsl = WS;
            KP q = fresh_kp();
            TileOrder S; S.init(wsl + WS_XB, wsl + WS_WO + (size_t)0 * D * D * 2, NTOK, D, D, G, bid);
            EpiRes<false> E{(const void*)q->in[I_X], (bf16*)q->out};
            gemm_phase(lds + RING_OFF, D, S, E, wave_s);
        }
        SEAM(5);
        if (IN(5 + 1)) { phase_ln_router(fresh_kp(), 0, lds, G, bid, wave_s); convert_from_queue(fresh_kp(), lds, wave_s, -1, CW_CVQA, CV_A_STATIC, CV_QA); }
        SEAM(5 + 1);
        if (IN(5 + 2)) { unsigned char* wsl = WS;
            const int nu = moe_setup(wsl, lds, G, bid, wave_s, true);
            MoeGU S{(const char*)(wsl + WS_XB), (const char*)(wsl + WS_WGU) + (size_t)0 * NEXP * 1024 * D * 2, (LAS const int*)(lds + MISC_OFF) + 16, (LAS const int*)(lds + ROWTOK_OFF), nu};
            EpiGateUp E{(bf16*)(wsl + WS_GREG)};
            gemm_phase(lds + RING_OFF, D, S, E, wave_s);
            if (nu * G < (int)__builtin_amdgcn_readfirstlane(((volatile LAS int*)(lds + MISC_OFF))[16 + 25])) convert_from_queue(fresh_kp(), lds, wave_s, 4);
        }
        SEAM(5 + 2);
        if (IN(5 + 3)) { unsigned char* wsl = WS;
            const int nu = moe_setup(wsl, lds, G, bid, wave_s, false);
            MoeDown S{(const char*)(wsl + WS_GREG), (const char*)(wsl + WS_WD) + (size_t)0 * NEXP * 1024 * DEXP * 2, (LAS const int*)(lds + MISC_OFF) + 16, nu};
            EpiPlain E{(bf16*)(wsl + WS_HREG), 1024};
            gemm_phase(lds + RING_OFF, DEXP, S, E, wave_s);
            if (nu * G < (int)__builtin_amdgcn_readfirstlane(((volatile LAS int*)(lds + MISC_OFF))[16 + 25])) convert_from_queue(fresh_kp(), lds, wave_s, 2);
        }
        SEAM(5 + 3);
        if (IN(5 + 4)) phase_ln_ffn(fresh_kp(), 0, lds, G, bid, wave_s);

            SEAM(9);
            if (IN(10)) { unsigned char* wsl = WS;
                KP q = fresh_kp();
                TileOrder S; S.init(wsl + WS_XB, wsl + WS_WB, NTOK, 3328, D, G, bid);
                EpiInB E{(bf16*)(wsl + WS_HREG), (bf16*)(wsl + WS_HREG + HR_48), (bf16*)(wsl + WS_HREG + 2 * HR_48), (bf16*)(wsl + WS_HREG + 3 * HR_48), (bf16*)(wsl + WS_HREG + 4 * HR_48), q->in[I_QNG], q->in[I_KNG]};
                gemm_phase(lds + RING_OFF, D, S, E, wave_s);
                {
                    const int c2 = (G >= 160) ? bid - 128 : bid; const int G2 = (G >= 160) ? 16 : G;
                    if (c2 >= 0 && c2 < G2) { TileOrder S2; S2.init(wsl + WS_MEMB, wsl + WS_WMKV + (size_t)512 * D * 2, NB * NMEM, 512, D, G2, c2);
                        EpiPlain E2{(bf16*)(wsl + WS_MKV) + 512, 1024};
                        gemm_phase(lds + RING_OFF, D, S2, E2, wave_s); } }
                if (G == 256 && bid >= 144 && bid < 244) convert_from_queue(fresh_kp(), lds, wave_s, 4);
                const int gwr = (G - 1 - bid) * NWAVES + wave_s;
                if (gwr < NB * FOX_H) cum_wave((const float*)(wsl + WS_LOGF), (float*)(wsl + WS_CUM), gwr, fresh_lane());
            }
            SEAM(10);
            if (IN(11)) phase_attn_b(fresh_kp(), lds, wave_s);
            SEAM(11);
        if (IN(12)) { unsigned char* wsl = WS;
            KP q = fresh_kp();
            TileOrder S; S.init(wsl + WS_GREG, wsl + WS_WO + (size_t)1 * D * D * 2, NTOK, D, D, G, bid);
            EpiRes<true> E{(const void*)(wsl + WS_XB), (bf16*)q->out};
            gemm_phase(lds + RING_OFF, D, S, E, wave_s);
        }
        SEAM(12);
        if (IN(12 + 1)) { phase_ln_router(fresh_kp(), 1, lds, G, bid, wave_s); convert_from_queue(fresh_kp(), lds, wave_s, -1); }
        SEAM(12 + 1);
        if (IN(12 + 2)) { unsigned char* wsl = WS;
            const int nu = moe_setup(wsl, lds, G, bid, wave_s, true);
            MoeGU S{(const char*)(wsl + WS_XB), (const char*)(wsl + WS_WGU) + (size_t)1 * NEXP * 1024 * D * 2, (LAS const int*)(lds + MISC_OFF) + 16, (LAS const int*)(lds + ROWTOK_OFF), nu};
            EpiGateUp E{(bf16*)(wsl + WS_GREG)};
            gemm_phase(lds + RING_OFF, D, S, E, wave_s);
        }
        SEAM(12 + 2);
        if (IN(12 + 3)) { unsigned char* wsl = WS;
            const int nu = moe_setup(wsl, lds, G, bid, wave_s, false);
            MoeDown S{(const char*)(wsl + WS_GREG), (const char*)(wsl + WS_WD) + (size_t)1 * NEXP * 1024 * DEXP * 2, (LAS const int*)(lds + MISC_OFF) + 16, nu};
            EpiPlain E{(bf16*)(wsl + WS_HREG), 1024};
            gemm_phase(lds + RING_OFF, DEXP, S, E, wave_s);
        }
        SEAM(12 + 3);
        if (IN(12 + 4)) phase_ln_ffn(fresh_kp(), 1, lds, G, bid, wave_s);
        SEAM(16);
    if (PROBE_J >= 0 && blockIdx.x == 0 && threadIdx.x == 0) {
        const unsigned long long t1 = ((unsigned long long)STAMPS[2 * PROBE_B + 1] << 32) | STAMPS[2 * PROBE_B], t0 = ((unsigned long long)STAMPS[2 * PROBE_J + 1] << 32) | STAMPS[2 * PROBE_J];
        const unsigned long long wait = (t1 - t0) * PROBE_K, ts = __builtin_amdgcn_s_memrealtime();
        while (__builtin_amdgcn_s_memrealtime() - ts < wait) __builtin_amdgcn_s_sleep(8);
    }
    if (PROBE_SEC >= 0 && blockIdx.x == 0 && threadIdx.x == 0) {
        const unsigned long long wait = (unsigned long long)(*(volatile LAS unsigned*)(lds + PSEC_OFF)) * PROBE_K, ts = __builtin_amdgcn_s_memrealtime();
        while (__builtin_amdgcn_s_memrealtime() - ts < wait) __builtin_amdgcn_s_sleep(8);
    }
#undef IN
#undef SEAM
#undef WS
}
#undef LAS
#undef GAS
}

static int pk_grid() {
    static int grid = 0;
    if (grid == 0) {
        int dev = 0, cus = 0;
        if (hipGetDevice(&dev) != hipSuccess || hipDeviceGetAttribute(&cus, hipDeviceAttributeMultiprocessorCount, dev) != hipSuccess) { grid = -1; return grid; }
        if (hipFuncSetAttribute((const void*)pk::mega, hipFuncAttributeMaxDynamicSharedMemorySize, pk::LDS_BYTES) != hipSuccess) { fprintf(stderr, "kernel_launch: hipFuncSetAttribute failed\n"); grid = -1; return grid; }
        int per_cu = 0;
        if (hipOccupancyMaxActiveBlocksPerMultiprocessor(&per_cu, (const void*)pk::mega, pk::NTHREADS, pk::LDS_BYTES) != hipSuccess || per_cu < 1) fprintf(stderr, "kernel_launch: occupancy query says %d\n", per_cu);
        (void)hipGetLastError();
        grid = cus;
    }
    return grid;
}
static void pk_launch(pk::Params& P, int lo, int hi, hipStream_t stream) {
    const int grid = pk_grid(); if (grid <= 0) return;
    P.ph_lo = lo; P.ph_hi = hi; P.bar_li += 1;
    hipLaunchKernelGGL(pk::mega, dim3(grid), dim3(pk::NTHREADS), pk::LDS_BYTES, stream, P);
}
extern "C" void kernel_launch(void* const* d_in, const int* in_sizes, int n_in, void* d_out, int out_size, void* d_ws, size_t ws_size, hipStream_t stream) {
    if (n_in != 22 || out_size != NTOK * D || ws_size < WS_END) { fprintf(stderr, "kernel_launch: unexpected shapes (n_in %d out %d ws %zu)\n", n_in, out_size, ws_size); return; }
    const float* w_gate_up = (const float*)d_in[3]; const float* b_gate = (const float*)d_in[4]; const float* gla_g = (const float*)d_in[5];
    const float* w_eg = (const float*)d_in[19]; const float* w_eu = (const float*)d_in[20]; const float* w_ed = (const float*)d_in[21];
    unsigned char* ws = (unsigned char*)d_ws;
    float* GLR = (float*)(ws + WS_GLR); float* CUM = (float*)(ws + WS_CUM);
    bf16* MKV = (bf16*)(ws + WS_MKV);
    int* TOK_E = (int*)(ws + WS_TOKE); int* TOK_S = (int*)(ws + WS_TOKS);
    bf16* XB = (bf16*)(ws + WS_XB); bf16* YS = (bf16*)(ws + WS_HREG);
    bf16* T0 = (bf16*)(ws + WS_HREG), *T1 = (bf16*)(ws + WS_HREG + HR_48), *T2 = (bf16*)(ws + WS_HREG + 2 * HR_48), *T3 = (bf16*)(ws + WS_HREG + 3 * HR_48), *T4 = (bf16*)(ws + WS_HREG + 4 * HR_48);
    (void)hipMemsetAsync(ws + WS_CTL, 0, CTL_ZERO_BYTES, stream);
    pk::Params P{}; for (int i = 0; i < 22; ++i) P.in[i] = (const float*)d_in[i]; P.out = (float*)d_out; P.ws = ws; P.bar_li = -1;
    pk_launch(P, 0, 17, stream);
}
```

```cpp
#include <hip/hip_runtime.h>
#include <cstdio>
#include <cstdint>

typedef unsigned short bf16;
constexpr int NB = 8, SEQ = 4096, D = 1024, NTOK = NB * SEQ;
constexpr int NMEM = 256, A_IN = 2576, B_IN = 1792, KV_IN = 1548;
constexpr int GLA_H = 4, GLA_DK = 96, GLA_DV = 192, FOX_H = 12;
constexpr int NEXP = 16, DEXP = 512;
constexpr float DN_ALPHA = 1.41421356237309515f;
constexpr float LN_EPS = 1e-5f, RMS_EPS = 1e-6f;
constexpr float LOG2E = 1.4426950408889634f;
constexpr float QC2 = 0.125f * LOG2E;
constexpr size_t MiB = 1u << 20;
constexpr size_t WS_CTL = 0, CTL_ZERO_BYTES = 1 * MiB;
constexpr size_t WS_GLR = 1 * MiB, WS_LOGF = 3 * MiB, WS_CUM = 5 * MiB, WS_DEC = 7 * MiB, WS_MEMB = 8 * MiB, WS_MKV = 12 * MiB;
constexpr size_t WS_TOKE = 16 * MiB, WS_TOKW = WS_TOKE + 256 * 1024, WS_TOKS = WS_TOKW + 256 * 1024, WS_CNT = WS_TOKS + 256 * 1024, WS_SLOTTOK = 17 * MiB;
constexpr size_t WS_WA = 20 * MiB, WS_WB = 25 * MiB, WS_WMKV = 32 * MiB, WS_WO = 34 * MiB, WS_WGU = 38 * MiB, WS_WD = 102 * MiB;
constexpr size_t WS_XB = 134 * MiB, WS_GREG = 198 * MiB, WS_HREG = 270 * MiB, WS_END = 478 * MiB;
constexpr size_t HR_48 = 48 * MiB;

__device__ __forceinline__ float bf2f(bf16 v) { return __uint_as_float(((unsigned)v) << 16); }
__device__ __forceinline__ bf16 f2bf(float f) { unsigned u = __float_as_uint(f); return (bf16)((u + 0x7fffu + ((u >> 16) & 1u)) >> 16); }
__device__ __forceinline__ float wave_sum(float v) {
#pragma unroll
    for (int o = 1; o < 64; o <<= 1) v += __shfl_xor(v, o);
    return v;
}
__device__ __forceinline__ float log_sigmoid(float z) { return fminf(z, 0.f) - log1pf(expf(-fabsf(z))); }
__device__ __forceinline__ float sigmoidf(float z) { return 1.f / (1.f + expf(-z)); }

namespace nv {
__global__ void __launch_bounds__(256) p0_x(const float* x, const float* w_in_a, bf16* XB, float* GLR) {
    const int row = blockIdx.x * 4 + (threadIdx.x >> 6), lane = threadIdx.x & 63;
    float acc[16];
#pragma unroll
    for (int j = 0; j < 16; ++j) acc[j] = 0.f;
    for (int k = lane; k < D; k += 64) {
        const float v = x[(size_t)row * D + k]; XB[(size_t)row * D + k] = f2bf(v);
#pragma unroll
        for (int j = 0; j < 16; ++j) acc[j] += v * w_in_a[(size_t)k * A_IN + 1536 + j];
    }
#pragma unroll
    for (int j = 0; j < 16; ++j) { const float s = wave_sum(acc[j]); if (lane == 0) GLR[(size_t)row * 16 + j] = s; }
}
__global__ void __launch_bounds__(256) p0_mem(const float* mem, bf16* MEMB) {
    const size_t i = (size_t)blockIdx.x * 256 + threadIdx.x; MEMB[i] = f2bf(mem[i]);
}
struct GemmArgs { const bf16* A; int lda; const float* W; int ldw; int wcol0; int M, Nn, K; };
struct EpiBf { bf16* dst; int ldd; int dcol0; __device__ void operator()(int m, int n, float v) const { dst[(size_t)m * ldd + dcol0 + n] = f2bf(v); } };
struct EpiRes { const float* xres; float* out; __device__ void operator()(int m, int n, float v) const { out[(size_t)m * D + n] = DN_ALPHA * xres[(size_t)m * D + n] + v; } };
template <class Epi> __global__ void __launch_bounds__(256) gemm(GemmArgs g, Epi E) {
    const int n = blockIdx.x * 64 + (threadIdx.x & 63), m0 = (blockIdx.y * 4 + (threadIdx.x >> 6)) * 4;
    if (n >= g.Nn) return;
    float acc[4] = {0.f, 0.f, 0.f, 0.f};
    for (int k = 0; k < g.K; k += 8) {
        float w[8];
#pragma unroll
        for (int j = 0; j < 8; ++j) w[j] = g.W[(size_t)(k + j) * g.ldw + g.wcol0 + n];
#pragma unroll
        for (int i = 0; i < 4; ++i) {
            const uint4 a = *(const uint4*)(g.A + (size_t)(m0 + i) * g.lda + k);
            const unsigned aw[4] = {a.x, a.y, a.z, a.w};
#pragma unroll
            for (int j = 0; j < 4; ++j) { acc[i] += __uint_as_float(aw[j] << 16) * w[2 * j]; acc[i] += __uint_as_float(aw[j] & 0xffff0000u) * w[2 * j + 1]; }
        }
    }
#pragma unroll
    for (int i = 0; i < 4; ++i) E(m0 + i, n, acc[i]);
}
__global__ void __launch_bounds__(192) gla(const bf16* QK, const bf16* V, const bf16* R, const float* GLR, const float* w_up, const float* b_gate, const float* g_norm, bf16* OC) {
    const int b = blockIdx.x / GLA_H, h = blockIdx.x % GLA_H, tid = threadIdx.x;
    __shared__ float sq[96], sk[96], sa[96], red[4];
    float S[96];
#pragma unroll
    for (int k = 0; k < 96; ++k) S[k] = 0.f;
    float wup[16]; float bg = 0.f;
    if (tid < 96) { for (int j = 0; j < 16; ++j) wup[j] = w_up[j * 384 + h * 96 + tid]; bg = b_gate[h * 96 + tid]; }
    const float gn = g_norm[tid];
    const float qs = 0.10206207261596577f;
    for (int t = 0; t < SEQ; ++t) {
        const size_t m = (size_t)b * SEQ + t;
        __syncthreads();
        if (tid < 96) {
            float z = bg;
#pragma unroll
            for (int j = 0; j < 16; ++j) z += GLR[m * 16 + j] * wup[j];
            sa[tid] = expf(log_sigmoid(z) * (1.f / 16.f));
            sq[tid] = bf2f(QK[m * 768 + h * 96 + tid]) * qs;
            sk[tid] = bf2f(QK[m * 768 + 384 + h * 96 + tid]);
        }
        __syncthreads();
        const float v = bf2f(V[m * 768 + h * 192 + tid]);
        float o = 0.f;
#pragma unroll
        for (int k = 0; k < 96; ++k) { S[k] = sa[k] * S[k] + sk[k] * v; o += sq[k] * S[k]; }
        float ss = wave_sum(o * o);
        if ((tid & 63) == 0) red[tid >> 6] = ss;
        __syncthreads();
        ss = red[0] + red[1] + red[2];
        const float r = bf2f(R[m * 768 + h * 192 + tid]);
        const float on = o * rsqrtf(ss * (1.f / 192.f) + RMS_EPS) * gn;
        OC[m * D + h * 192 + tid] = f2bf(on * (r * sigmoidf(r)));
    }
}
__global__ void __launch_bounds__(256) memattn(const bf16* MQ, const bf16* MKV, int layer, bf16* OC) {
    const int m = blockIdx.x * 256 + threadIdx.x, hd = blockIdx.y, b = m / SEQ;
    float q[64], acc[64];
#pragma unroll
    for (int d = 0; d < 64; ++d) { q[d] = bf2f(MQ[(size_t)m * 256 + hd * 64 + d]) * 0.125f; acc[d] = 0.f; }
    float mx = -1e30f, l = 0.f;
    for (int j = 0; j < NMEM; ++j) {
        const bf16* kr = MKV + (size_t)(b * NMEM + j) * 1024 + layer * 512 + hd * 64;
        float s = 0.f;
#pragma unroll
        for (int d = 0; d < 64; ++d) s += q[d] * bf2f(kr[d]);
        const float mn = fmaxf(mx, s), f = expf(mx - mn), p = expf(s - mn);
        l = l * f + p; mx = mn;
#pragma unroll
        for (int d = 0; d < 64; ++d) acc[d] = acc[d] * f + p * bf2f(kr[256 + d]);
    }
    const float il = 1.f / l;
#pragma unroll
    for (int d = 0; d < 64; ++d) OC[(size_t)m * D + 768 + hd * 64 + d] = f2bf(acc[d] * il);
}
__global__ void __launch_bounds__(256) ln_router(float* XF, bf16* XB, const float* g, const float* bta, const float* w_router, const float* b_router, int* TOK_E, float* TOK_W) {
    const int row = blockIdx.x * 4 + (threadIdx.x >> 6), lane = threadIdx.x & 63;
    float v[16]; float s = 0.f;
#pragma unroll
    for (int i = 0; i < 16; ++i) { v[i] = XF[(size_t)row * D + lane + 64 * i]; s += v[i]; }
    const float mean = wave_sum(s) * (1.f / D); float q = 0.f;
#pragma unroll
    for (int i = 0; i < 16; ++i) { v[i] -= mean; q += v[i] * v[i]; }
    const float rstd = rsqrtf(wave_sum(q) * (1.f / D) + LN_EPS);
    float lg[16];
#pragma unroll
    for (int e = 0; e < 16; ++e) lg[e] = 0.f;
#pragma unroll
    for (int i = 0; i < 16; ++i) { const int k = lane + 64 * i; const float o = v[i] * rstd * g[k] + bta[k]; XF[(size_t)row * D + k] = o; XB[(size_t)row * D + k] = f2bf(o);
#pragma unroll
        for (int e = 0; e < 16; ++e) lg[e] += o * w_router[k * 16 + e]; }
#pragma unroll
    for (int e = 0; e < 16; ++e) lg[e] = wave_sum(lg[e]);
    if (lane == 0) {
        float aff[16], sel[16];
#pragma unroll
        for (int e = 0; e < 16; ++e) { aff[e] = sigmoidf(lg[e]); sel[e] = aff[e] + b_router[e]; }
        int gbest = 0; float gs = -1e30f;
#pragma unroll
        for (int gi = 0; gi < 4; ++gi) { float a = -1e30f, b2 = -1e30f;
#pragma unroll
            for (int j = 0; j < 4; ++j) { const float x = sel[gi * 4 + j]; if (x > a) { b2 = a; a = x; } else if (x > b2) b2 = x; }
            if (a + b2 > gs) { gs = a + b2; gbest = gi; } }
        int i0 = 0, i1 = 0; float a = -1e30f, b2 = -1e30f;
#pragma unroll
        for (int j = 0; j < 4; ++j) { float x = -1e30f;
#pragma unroll
            for (int gi = 0; gi < 4; ++gi) if (gi == gbest) x = sel[gi * 4 + j];
            if (x > a) { b2 = a; i1 = i0; a = x; i0 = j; } else if (x > b2) { b2 = x; i1 = j; } }
        const int e0 = gbest * 4 + i0, e1 = gbest * 4 + i1; float w0 = 0.f, w1 = 0.f;
#pragma unroll
        for (int e = 0; e < 16; ++e) { if (e == e0) w0 = aff[e]; if (e == e1) w1 = aff[e]; }
        const float inv = 1.f / (w0 + w1);
        TOK_E[row * 2] = e0; TOK_E[row * 2 + 1] = e1; TOK_W[row * 2] = w0 * inv; TOK_W[row * 2 + 1] = w1 * inv;
    }
}
__global__ void __launch_bounds__(256) moe(const bf16* XB, const int* TOK_E, const float* wg, const float* wu, const float* wd, bf16* YS, int* TOK_SLOT) {
    const int tok = blockIdx.x >> 1, j = blockIdx.x & 1, tid = threadIdx.x;
    __shared__ float xs[1024], hs[512];
    for (int k = tid; k < 1024; k += 256) xs[k] = bf2f(XB[(size_t)tok * D + k]);
    const int e = TOK_E[tok * 2 + j];
    __syncthreads();
    const float* G = wg + (size_t)e * 1024 * 512; const float* U = wu + (size_t)e * 1024 * 512; const float* Dn = wd + (size_t)e * 512 * 1024;
    float g0 = 0.f, g1 = 0.f, u0 = 0.f, u1 = 0.f;
    for (int k = 0; k < 1024; ++k) { const float x = xs[k]; g0 += x * G[k * 512 + tid]; g1 += x * G[k * 512 + 256 + tid]; u0 += x * U[k * 512 + tid]; u1 += x * U[k * 512 + 256 + tid]; }
    hs[tid] = g0 * sigmoidf(g0) * u0; hs[tid + 256] = g1 * sigmoidf(g1) * u1;
    __syncthreads();
    float o[4] = {0.f, 0.f, 0.f, 0.f};
    for (int k = 0; k < 512; ++k) { const float hh = hs[k];
#pragma unroll
        for (int c = 0; c < 4; ++c) o[c] += hh * Dn[k * 1024 + c * 256 + tid]; }
    const int slot = tok * 2 + j;
#pragma unroll
    for (int c = 0; c < 4; ++c) YS[(size_t)slot * D + c * 256 + tid] = f2bf(o[c]);
    if (tid == 0) TOK_SLOT[slot] = slot;
}
__global__ void __launch_bounds__(256) ln_ffn(float* XF, bf16* XB, const bf16* YS, const int* TOK_SLOT, const float* TOK_W, const float* g, const float* bta,
                                              const float* w_kv, const float* b_forget, float* LOGF, int do_logf) {
    const int row = blockIdx.x * 4 + (threadIdx.x >> 6), lane = threadIdx.x & 63;
    const int s0 = TOK_SLOT[row * 2], s1 = TOK_SLOT[row * 2 + 1]; const float w0 = TOK_W[row * 2], w1 = TOK_W[row * 2 + 1];
    float v[16]; float s = 0.f;
#pragma unroll
    for (int i = 0; i < 16; ++i) { const int k = lane + 64 * i; v[i] = DN_ALPHA * XF[(size_t)row * D + k] + w0 * bf2f(YS[(size_t)s0 * D + k]) + w1 * bf2f(YS[(size_t)s1 * D + k]); s += v[i]; }
    const float mean = wave_sum(s) * (1.f / D); float q = 0.f;
#pragma unroll
    for (int i = 0; i < 16; ++i) { v[i] -= mean; q += v[i] * v[i]; }
    const float rstd = rsqrtf(wave_sum(q) * (1.f / D) + LN_EPS);
    float lf[12];
#pragma unroll
    for (int e = 0; e < 12; ++e) lf[e] = 0.f;
#pragma unroll
    for (int i = 0; i < 16; ++i) { const int k = lane + 64 * i; const float o = v[i] * rstd * g[k] + bta[k]; XF[(size_t)row * D + k] = o; XB[(size_t)row * D + k] = f2bf(o);
        if (do_logf) {
#pragma unroll
            for (int e = 0; e < 12; ++e) lf[e] += o * w_kv[(size_t)k * KV_IN + 1536 + e]; } }
    if (do_logf) {
#pragma unroll
        for (int e = 0; e < 12; ++e) { const float t = wave_sum(lf[e]); if (lane == 0) LOGF[(size_t)row * 12 + e] = log_sigmoid(t + b_forget[e]); }
    }
}
__global__ void __launch_bounds__(256) headproj(const bf16* XB, const float* W, int ldw, const float* gn, float scale, bf16* dst) {
    const int m = blockIdx.x, col = blockIdx.y * 256 + threadIdx.x, lane = threadIdx.x & 63;
    float acc = 0.f;
    for (int k = 0; k < D; k += 8) {
        const uint4 a = *(const uint4*)(XB + (size_t)m * D + k); const unsigned aw[4] = {a.x, a.y, a.z, a.w};
#pragma unroll
        for (int j = 0; j < 4; ++j) { acc += __uint_as_float(aw[j] << 16) * W[(size_t)(k + 2 * j) * ldw + col]; acc += __uint_as_float(aw[j] & 0xffff0000u) * W[(size_t)(k + 2 * j + 1) * ldw + col]; }
    }
    const float ss = wave_sum(acc * acc);
    dst[(size_t)m * 768 + col] = f2bf(acc * rsqrtf(ss * (1.f / 64.f) + RMS_EPS) * gn[lane] * scale);
}
__global__ void __launch_bounds__(64) cumk(const float* LOGF, float* CUM) {
    const int b = blockIdx.x / FOX_H, h = blockIdx.x % FOX_H, lane = threadIdx.x;
    float loc[64]; float s = 0.f;
#pragma unroll
    for (int i = 0; i < 64; ++i) { s += LOGF[((size_t)b * SEQ + lane * 64 + i) * 12 + h]; loc[i] = s; }
    float inc = s;
#pragma unroll
    for (int o = 1; o < 64; o <<= 1) { const float t = __shfl_up(inc, o); if (lane >= o) inc += t; }
    const float base = inc - s;
#pragma unroll
    for (int i = 0; i < 64; ++i) CUM[((size_t)b * FOX_H + h) * SEQ + lane * 64 + i] = base + loc[i];
}
__global__ void __launch_bounds__(256) fox(const bf16* Q, const bf16* K, const bf16* V, const bf16* OG, const float* CUM, bf16* OC) {
    const int t = blockIdx.x * 256 + threadIdx.x, h = blockIdx.y, b = blockIdx.z;
    const size_t m = (size_t)b * SEQ + t;
    float q[64], acc[64];
#pragma unroll
    for (int d = 0; d < 64; ++d) { q[d] = bf2f(Q[m * 768 + h * 64 + d]); acc[d] = 0.f; }
    const float* cum = CUM + ((size_t)b * FOX_H + h) * SEQ; const float ct = cum[t] * LOG2E;
    float mx = -1e30f, l = 0.f;
    const int tmax = blockIdx.x * 256 + 255;
    for (int s = 0; s <= tmax; ++s) {
        const bf16* kr = K + ((size_t)b * SEQ + s) * 768 + h * 64; const bf16* vr = V + ((size_t)b * SEQ + s) * 768 + h * 64;
        float sc = ct - cum[s] * LOG2E;
#pragma unroll
        for (int d = 0; d < 64; ++d) sc += q[d] * bf2f(kr[d]);
        if (s <= t) {
            const float mn = fmaxf(mx, sc), f = exp2f(mx - mn), p = exp2f(sc - mn);
            l = l * f + p; mx = mn;
#pragma unroll
            for (int d = 0; d < 64; ++d) acc[d] = acc[d] * f + p * bf2f(vr[d]);
        }
    }
    const float il = 1.f / l;
#pragma unroll
    for (int d = 0; d < 64; ++d) { const float og = bf2f(OG[m * 768 + h * 64 + d]); OC[m * D + h * 64 + d] = f2bf(acc[d] * il * sigmoidf(og)); }
}
}

namespace pk {
#define LAS __attribute__((address_space(3)))
#define GAS __attribute__((address_space(1)))
typedef short bf16x8 __attribute__((ext_vector_type(8)));
typedef short s16x4 __attribute__((ext_vector_type(4)));
typedef float f32x4 __attribute__((ext_vector_type(4)));
typedef float f32x16 __attribute__((ext_vector_type(16)));
typedef unsigned u32x4 __attribute__((ext_vector_type(4)));
typedef unsigned u32x2 __attribute__((ext_vector_type(2)));
constexpr int NWAVES = 8, NTHREADS = 512;
constexpr int BM = 256, BK = 64, HALF = 128, HTB = HALF * BK * 2, STAGE_BYTES = 8 * HTB, NXCD = 8, WGM = 8;
constexpr int RING_OFF = 0, RING_BYTES = 131072;
constexpr int MISC_OFF = RING_BYTES;
constexpr int ROWTOK_OFF = MISC_OFF + 256;
constexpr int LDS_BYTES = 155648;
static_assert(ROWTOK_OFF + 6 * 1024 <= LDS_BYTES, "LDS map");

__device__ __forceinline__ int lds_byte(int r, int c) { const int st = (r >> 4) * 2 + (c >> 5), rr = r & 15, cc = c & 31, ob = rr * 64 + cc * 2; return st * 1024 + (ob ^ (((ob >> 9) & 1) << 5)); }
__device__ __forceinline__ void stage_rc(int b, int& R, int& C) { const int st = b / 1024, sb = b % 1024, swz = sb ^ (((sb >> 9) & 1) << 5); R = (st >> 1) * 16 + swz / 64; C = (st & 1) * 32 + (swz % 64) / 2; }
__device__ __forceinline__ unsigned cvt_pk_bf16(float lo, float hi) { unsigned r; asm volatile("v_cvt_pk_bf16_f32 %0, %1, %2" : "=v"(r) : "v"(lo), "v"(hi)); return r; }
__device__ __forceinline__ int perm8(int c) { return (c & ~31) | (16 * ((c >> 2) & 1) + 4 * ((c >> 3) & 3) + (c & 3)); }
__device__ __forceinline__ int head64(int c) { return 128 * ((c >> 5) & 1) + 32 * (c >> 6) + 16 * ((c >> 2) & 1) + 4 * ((c >> 3) & 3) + (c & 3); }

__device__ __forceinline__ int fresh_lane() { int l; asm volatile("v_mbcnt_lo_u32_b32 %0, -1, 0\n\tv_mbcnt_hi_u32_b32 %0, -1, %0" : "=v"(l)); return l; }
__device__ __forceinline__ int fresh_tid(int wave_s) { asm volatile("" : "+s"(wave_s)); return wave_s * 64 + fresh_lane(); }
constexpr int PROBE_SEC = -1;
constexpr int PSEC_OFF = 131072 + 256 + 6144 + 512;
#define PSEC_BEGIN(id) unsigned long long _ps##id = 0; if (PROBE_SEC == (id) && bid == 0 && wave_s == 0) _ps##id = __builtin_amdgcn_s_memrealtime()
#define PSEC_END(id) do { if (PROBE_SEC == (id) && bid == 0 && wave_s == 0) { const unsigned d_ = (unsigned)(__builtin_amdgcn_s_memrealtime() - _ps##id); volatile LAS unsigned* a_ = (volatile LAS unsigned*)(lds + PSEC_OFF); if (fresh_lane() == 0) a_[0] = a_[0] + d_; } } while (0)
struct Unit { const char* A; const char* B; int pm, pn, e, ord; };

struct TileOrder {
    const char* A; const char* Bt; int K, nM, nN, nwg, G, c;
    __device__ void init(const void* A_, const void* Bt_, int M, int N, int K_, int G_, int c_) { A = (const char*)A_; Bt = (const char*)Bt_; K = K_; nM = M / BM; nN = N / BM; nwg = nM * nN; G = G_; c = c_; }
    __device__ __forceinline__ bool next(int i, Unit& u) const {
        const long L = (long)i * G + c; if (L >= nwg) return false;
        int wgid = (int)L; { const int q = nwg / NXCD, r = nwg % NXCD, xcd = wgid % NXCD, off = wgid / NXCD; wgid = (xcd < r ? xcd * (q + 1) : r * (q + 1) + (xcd - r) * q) + off; }
        const int nig = WGM * nN, gid = wgid / nig, fm = gid * WGM, gsz = (nM - fm) < WGM ? (nM - fm) : WGM;
        u.pm = fm + ((wgid % nig) % gsz); u.pn = (wgid % nig) / gsz; u.e = 0; u.ord = i;
        u.A = A + (size_t)u.pm * BM * K * 2; u.B = Bt + (size_t)u.pn * BM * K * 2; return true;
    }
    __device__ __forceinline__ unsigned a_off(const Unit&, int h, int R, int C) const { return (unsigned)((R + HALF * h) * K + C) * 2u; }
};

template <class Epi, class Sched>
__device__ __forceinline__ void gemm_phase(LAS unsigned char* lds, const int K, const Sched& S, const Epi& E, const int wave_s) {
    const int tid = fresh_tid(wave_s), wid = wave_s, lane = tid & 63, wr = wid >> 2, wc = wid & 3, fr = lane & 15, fq = lane >> 4;
    const int nt = K / BK;
    int sR[2], sC[2];
    unsigned voffA[2][2], voffB[2];
#pragma unroll
    for (int i = 0; i < 2; ++i) { stage_rc(tid * 16 + i * 8192, sR[i], sC[i]); voffB[i] = (unsigned)(sR[i] * K + sC[i]) * 2u; }
    const size_t kstep = (size_t)(BK * 2);
    const size_t hstep = (size_t)HALF * K * 2;
    const unsigned ldsw = (unsigned)wid * 1024u;
    const int aoff = lds_byte(wr * 64 + fr, fq * 8), boff = lds_byte(wc * 32 + fr, fq * 8);
#define PG8_SA(b, h) (((b) * 2 + (h)) * HTB)
#define PG8_SB(b, h) ((4 + (b) * 2 + (h)) * HTB)
#define PG8_STAGE(bufoff, gbase, voff) do { _Pragma("unroll") for (int _i = 0; _i < 2; ++_i) \
        __builtin_amdgcn_global_load_lds((const unsigned*)((const char*)(gbase) + (voff)[_i]), (LAS unsigned*)(lds + (bufoff) + ldsw + _i * 8192), 16, 0, 0); } while (0)
#define PG8_LDA(dst, b, h) do { _Pragma("unroll") for (int m = 0; m < 4; ++m) _Pragma("unroll") for (int k = 0; k < 2; ++k) dst[m][k] = *(const LAS bf16x8*)(lds + PG8_SA(b, h) + aoff + m * 2048 + k * 1024); } while (0)
#define PG8_LDB(dst, b, h) do { _Pragma("unroll") for (int n = 0; n < 2; ++n) _Pragma("unroll") for (int k = 0; k < 2; ++k) dst[n][k] = *(const LAS bf16x8*)(lds + PG8_SB(b, h) + boff + n * 2048 + k * 1024); } while (0)
#define PG8_MMA(ai, bj, At, Bt) do { __builtin_amdgcn_s_setprio(1); _Pragma("unroll") for (int m = 0; m < 4; ++m) _Pragma("unroll") for (int n = 0; n < 2; ++n) _Pragma("unroll") for (int k = 0; k < 2; ++k) \
        acc[ai][bj][m][n] = __builtin_amdgcn_mfma_f32_16x16x32_bf16(Bt[n][k], At[m][k], acc[ai][bj][m][n], 0, 0, 0); __builtin_amdgcn_s_setprio(0); } while (0)
#define PG8_WAIT_V(n) asm volatile("s_waitcnt vmcnt(" #n ")" ::: "memory")
#define PG8_WAIT_L(n) asm volatile("s_waitcnt lgkmcnt(" #n ")" ::: "memory")
#define PG8_BAR __builtin_amdgcn_s_barrier()
#define PG8_SCHED __builtin_amdgcn_sched_barrier(0)
    Unit cur, nxt; int ui = 0;
    if (!S.next(0, cur)) return;
    f32x4 acc[2][2][4][2];
#pragma unroll
    for (int a = 0; a < 2; ++a)
#pragma unroll
        for (int b = 0; b < 2; ++b)
#pragma unroll
            for (int m = 0; m < 4; ++m)
#pragma unroll
                for (int n = 0; n < 2; ++n) acc[a][b][m][n] = (f32x4){0.f, 0.f, 0.f, 0.f};
    bf16x8 At[4][2], B0[2][2], B1[2][2];
    const char* cA = cur.A; const char* cB = cur.B;
#pragma unroll
    for (int h = 0; h < 2; ++h)
#pragma unroll
        for (int i = 0; i < 2; ++i) voffA[h][i] = S.a_off(cur, h, sR[i], sC[i]);
    PG8_STAGE(PG8_SB(0, 0), cB, voffB); PG8_STAGE(PG8_SB(0, 1), cB + hstep, voffB); PG8_STAGE(PG8_SA(0, 0), cA, voffA[0]); PG8_STAGE(PG8_SA(0, 1), cA, voffA[1]);
    if (wr == 1) PG8_BAR;
    PG8_WAIT_V(2); PG8_BAR;
    PG8_STAGE(PG8_SB(1, 0), cB + kstep, voffB); PG8_STAGE(PG8_SA(1, 0), cA + kstep, voffA[0]); PG8_STAGE(PG8_SB(1, 1), cB + hstep + kstep, voffB);
    PG8_WAIT_V(6); PG8_BAR;
    for (;;) {
        const bool has_next = S.next(ui + 1, nxt);
        const char* nA = has_next ? nxt.A : cA; const char* nB = has_next ? nxt.B : cB;
        for (int t = 0; t < nt; t += 2) {
            const bool last = (t == nt - 2);
            const char* a1 = cA + (size_t)(t + 1) * kstep;
            const char* a2 = last ? nA : cA + (size_t)(t + 2) * kstep; const char* b2 = last ? nB : cB + (size_t)(t + 2) * kstep;
            const char* a3 = a2 + kstep; const char* b3 = b2 + kstep;
            PG8_LDB(B0, 0, 0); PG8_LDB(B1, 0, 1); PG8_SCHED; PG8_LDA(At, 0, 0); PG8_STAGE(PG8_SA(1, 1), a1, voffA[1]);
            if (last && has_next) {
#pragma unroll
                for (int h = 0; h < 2; ++h)
#pragma unroll
                    for (int i = 0; i < 2; ++i) { int R2, C2; stage_rc(fresh_tid(wave_s) * 16 + i * 8192, R2, C2); voffA[h][i] = S.a_off(nxt, h, R2, C2); }
            }
            PG8_WAIT_V(8); PG8_WAIT_L(0); PG8_BAR; PG8_MMA(0, 0, At, B0); PG8_MMA(0, 1, At, B1); PG8_BAR; PG8_SCHED;
            PG8_LDA(At, 0, 1); PG8_STAGE(PG8_SB(0, 0), b2, voffB); PG8_STAGE(PG8_SB(0, 1), b2 + hstep, voffB); PG8_STAGE(PG8_SA(0, 0), a2, voffA[0]);
            PG8_WAIT_V(8); PG8_WAIT_L(0); PG8_BAR; PG8_MMA(1, 0, At, B0); PG8_MMA(1, 1, At, B1); PG8_BAR; PG8_SCHED;
            PG8_LDB(B0, 1, 0); PG8_LDB(B1, 1, 1); PG8_SCHED; PG8_LDA(At, 1, 0); PG8_STAGE(PG8_SA(0, 1), a2, voffA[1]);
            PG8_WAIT_V(8); PG8_WAIT_L(0); PG8_BAR; PG8_MMA(0, 0, At, B0); PG8_MMA(0, 1, At, B1); PG8_BAR; PG8_SCHED;
            PG8_LDA(At, 1, 1); PG8_STAGE(PG8_SB(1, 0), b3, voffB); PG8_STAGE(PG8_SB(1, 1), b3 + hstep, voffB); PG8_STAGE(PG8_SA(1, 0), a3, voffA[0]);
            PG8_WAIT_V(8); PG8_WAIT_L(0); PG8_BAR; PG8_MMA(1, 0, At, B0); PG8_MMA(1, 1, At, B1); PG8_BAR; PG8_SCHED;
        }
        if (wr == 0) PG8_BAR;
        E(acc, cur, wr, wc, fr, fq);
        if (!has_next) break;
#pragma unroll
        for (int a = 0; a < 2; ++a)
#pragma unroll
            for (int b = 0; b < 2; ++b)
#pragma unroll
                for (int m = 0; m < 4; ++m)
#pragma unroll
                    for (int n = 0; n < 2; ++n) acc[a][b][m][n] = (f32x4){0.f, 0.f, 0.f, 0.f};
        cur = nxt; cA = nA; cB = nB; ++ui;
        if (wr == 1) PG8_BAR;
    }
    PG8_WAIT_V(0);
    PG8_BAR;
#undef PG8_SA
#undef PG8_SB
#undef PG8_STAGE
#undef PG8_LDA
#undef PG8_LDB
#undef PG8_MMA
#undef PG8_WAIT_V
#undef PG8_WAIT_L
#undef PG8_BAR
#undef PG8_SCHED
}

__device__ __forceinline__ void store_bf16_tile(const f32x4 (&acc)[2][2][4][2], bf16* base, int ldd, int row0, int c0, int wr, int wc, int fr, int fq) {
    bf16* rowp = base + (size_t)(row0 + wr * 64 + fr) * ldd + (c0 + wc * 32 + 8 * fq);
#pragma unroll
    for (int ai = 0; ai < 2; ++ai) {
#pragma unroll
        for (int m = 0; m < 4; ++m) {
#pragma unroll
            for (int bj = 0; bj < 2; ++bj) { const f32x4 v0 = acc[ai][bj][m][0], v1 = acc[ai][bj][m][1];
                u32x4 w; w.x = cvt_pk_bf16(v0[0], v0[1]); w.y = cvt_pk_bf16(v0[2], v0[3]); w.z = cvt_pk_bf16(v1[0], v1[1]); w.w = cvt_pk_bf16(v1[2], v1[3]);
                *(u32x4*)(rowp + bj * HALF) = w; }
            rowp += (size_t)16 * ldd; asm volatile("" : "+v"(rowp)); }
        rowp += (size_t)64 * ldd; }
}
struct EpiInA { bf16 *QK, *V, *R, *MQ;
    __device__ __forceinline__ void operator()(const f32x4 (&acc)[2][2][4][2], const Unit& u, int wr, int wc, int fr, int fq) const {
        bf16* base; int ldd, c0; const int pn = u.pn;
        if (pn < 3) { base = QK; ldd = 768; c0 = pn * 256; } else if (pn < 6) { base = V; ldd = 768; c0 = (pn - 3) * 256; } else if (pn < 9) { base = R; ldd = 768; c0 = (pn - 6) * 256; } else { base = MQ; ldd = 256; c0 = 0; }
        store_bf16_tile(acc, base, ldd, u.pm * BM, c0, wr, wc, fr, fq);
    } };
struct EpiPlain { bf16* dst; int ldd;
    __device__ __forceinline__ void operator()(const f32x4 (&acc)[2][2][4][2], const Unit& u, int wr, int wc, int fr, int fq) const { store_bf16_tile(acc, dst, ldd, u.pm * BM, u.pn * BM, wr, wc, fr, fq); } };

#define XB_TMO      128
#define XB_XCNT(j)  (256  + 64 * (j))
#define XB_XSUB(j)  (1280 + 64 * (j))
#define XB_XGEN(j)  (2304 + 64 * (j))
#define XB_TOP      3328
#define XB_TOPGEN   3392
#define XCD_BAR_WORDS 3456
#define XB_SPIN_CAP (1u << 18)
__device__ __forceinline__ unsigned xb_ld(unsigned* p)              { return __hip_atomic_load(p, __ATOMIC_RELAXED, __HIP_MEMORY_SCOPE_AGENT); }
__device__ __forceinline__ unsigned xb_add(unsigned* p, unsigned v) { return __hip_atomic_fetch_add(p, v, __ATOMIC_RELAXED, __HIP_MEMORY_SCOPE_AGENT); }
__device__ __forceinline__ unsigned xb_xcc_id() { return (unsigned)__builtin_amdgcn_s_getreg((3 << 11) | 20) & 0xFu; }
#define XB_SPIN(cond, bar) do { unsigned _sp = 0; while (cond) { __builtin_amdgcn_s_sleep(1); \
    if ((++_sp & 255u) == 0u) { if (xb_ld(&(bar)[XB_TMO])) break; if (_sp > XB_SPIN_CAP) { atomicAdd(&(bar)[XB_TMO], 1u); break; } } } } while (0)
struct XcdBarrier { unsigned* bar; unsigned x; volatile LAS unsigned* st; };
__device__ __forceinline__ XcdBarrier xcd_barrier_post(unsigned* bar, volatile LAS unsigned* st) {
    XcdBarrier b; b.bar = bar; b.x = xb_xcc_id(); b.st = st;
    if (threadIdx.x == 0) (void)xb_add(&bar[XB_XCNT(b.x)], 1u);
    return b;
}
__device__ __forceinline__ void xcd_barrier_complete(unsigned* bar, unsigned x, unsigned& nloc, unsigned& nx) {
    const unsigned G = gridDim.x * gridDim.y * gridDim.z;
    unsigned sum, cnt, mine, sp = 0u;
    for (;;) {
        sum = 0u; cnt = 0u; mine = 0u;
#pragma unroll
        for (unsigned j = 0; j < 16; ++j) { const unsigned c = xb_ld(&bar[XB_XCNT(j)]); sum += c; cnt += (c > 0u) ? 1u : 0u; mine = (j == x) ? c : mine; }
        if (sum == G) break;
        __builtin_amdgcn_s_sleep(1);
        if ((++sp & 255u) == 0u) { if (xb_ld(&bar[XB_TMO])) break; if (sp > XB_SPIN_CAP) { atomicAdd(&bar[XB_TMO], 1u); break; } }
    }
    nloc = mine > 0u ? mine : 1u; nx = cnt > 0u ? cnt : 1u;
}
__device__ __forceinline__ void xcd_barrier(const XcdBarrier& b) {
    asm volatile("s_waitcnt vmcnt(0)" ::: "memory");
    __syncthreads();
    if (threadIdx.x == 0) {
        unsigned* bar = b.bar;
        __builtin_amdgcn_s_waitcnt(0);
        unsigned nloc = b.st[0], nx = b.st[1];
        if (nloc == 0u) { xcd_barrier_complete(bar, b.x, nloc, nx); b.st[0] = nloc; b.st[1] = nx; }
        const unsigned old = xb_add(&bar[XB_XSUB(b.x)], 1u);
        const unsigned gen = old / nloc;
        if (old + 1u == (gen + 1u) * nloc) {
            __builtin_amdgcn_fence(__ATOMIC_RELEASE, "agent");
            asm volatile("s_waitcnt vmcnt(0)" ::: "memory");
            const unsigned og = xb_add(&bar[XB_TOP], 1u);
            const unsigned tg = og / nx;
            if (og + 1u == (tg + 1u) * nx) xb_add(&bar[XB_TOPGEN], 1u);
            else XB_SPIN(xb_ld(&bar[XB_TOPGEN]) == tg, bar);
            __builtin_amdgcn_fence(__ATOMIC_ACQUIRE, "agent");
            xb_add(&bar[XB_XGEN(b.x)], 1u);
            asm volatile("s_waitcnt vmcnt(0)" ::: "memory");
        } else {
            XB_SPIN(xb_ld(&bar[XB_XGEN(b.x)]) == gen, bar);
            __builtin_amdgcn_fence(__ATOMIC_ACQUIRE, "agent");
            asm volatile("s_waitcnt vmcnt(0)" ::: "memory");
        }
    }
    __syncthreads();
}
#define LDS_WAIT() asm volatile("s_waitcnt lgkmcnt(0)" ::: "memory")
__device__ __forceinline__ unsigned pk2(float lo, float hi) { return (unsigned)f2bf(lo) | ((unsigned)f2bf(hi) << 16); }

template <int CTRL> __device__ __forceinline__ float dppf(float v) { return __builtin_bit_cast(float, __builtin_amdgcn_update_dpp(0, __builtin_bit_cast(int, v), CTRL, 0xf, 0xf, true)); }
__device__ __forceinline__ float sum_swap32(float a, float b) { auto r = __builtin_amdgcn_permlane32_swap(__float_as_uint(a), __float_as_uint(b), false, false); return __uint_as_float(r[0]) + __uint_as_float(r[1]); }
__device__ __forceinline__ float sum_swap16(float a, float b) { auto r = __builtin_amdgcn_permlane16_swap(__float_as_uint(a), __float_as_uint(b), false, false); return __uint_as_float(r[0]) + __uint_as_float(r[1]); }
__device__ __forceinline__ float wsum(float v) {
    v += dppf<0xB1>(v); v += dppf<0x4E>(v); v += dppf<0x141>(v); v += dppf<0x140>(v);
    v = sum_swap16(v, v); v = sum_swap32(v, v); return v;
}
__device__ __forceinline__ float multi_reduce16(const float (&a)[16], int lane) {
    float b[8], c[4], d[2], e;
#pragma unroll
    for (int i = 0; i < 8; ++i) b[i] = sum_swap32(a[i], a[i + 8]);
#pragma unroll
    for (int i = 0; i < 4; ++i) c[i] = sum_swap16(b[i], b[i + 4]);
    { const bool hi = (lane & 8) != 0;
#pragma unroll
      for (int i = 0; i < 2; ++i) { const float send = hi ? c[i] : c[i + 2], keep = hi ? c[i + 2] : c[i]; d[i] = keep + dppf<0x140>(send); } }
    { const bool hi = (lane & 4) != 0; const float send = hi ? d[0] : d[1], keep = hi ? d[1] : d[0]; e = keep + dppf<0x141>(send); }
    e += dppf<0x4E>(e); e += dppf<0xB1>(e);
    return e;
}

__device__ __forceinline__ void row_dots16x2(const f32x4 (&v0)[4], const f32x4 (&v1)[4], const LAS float* WT, int lane, float& r0, float& r1) {
    float a0[16], a1[16];
    const LAS float* wl = WT + 4 * lane; asm volatile("" : "+v"(wl));
    f32x4 wa[8], wb[8];
#pragma unroll
    for (int q = 0; q < 8; ++q) wa[q] = *(const LAS f32x4*)(wl + (q >> 2) * D + 256 * (q & 3));
#pragma unroll
    for (int g = 0; g < 8; ++g) {
        if (g + 1 < 8) {
#pragma unroll
            for (int q = 0; q < 8; ++q) { const f32x4 w = *(const LAS f32x4*)(wl + (2 * (g + 1) + (q >> 2)) * D + 256 * (q & 3)); if (g & 1) wa[q] = w; else wb[q] = w; } }
#pragma unroll
        for (int h = 0; h < 2; ++h) { float x = 0.f, y = 0.f;
#pragma unroll
            for (int j = 0; j < 4; ++j) { const f32x4 w = (g & 1) ? wb[4 * h + j] : wa[4 * h + j];
                x += v0[j][0] * w[0] + v0[j][1] * w[1] + v0[j][2] * w[2] + v0[j][3] * w[3]; y += v1[j][0] * w[0] + v1[j][1] * w[1] + v1[j][2] * w[2] + v1[j][3] * w[3]; }
            a0[2 * g + h] = x; a1[2 * g + h] = y; }
        asm volatile("" : "+v"(a0[2 * g]), "+v"(a0[2 * g + 1]), "+v"(a1[2 * g]), "+v"(a1[2 * g + 1]));
    }
    r0 = multi_reduce16(a0, lane); r1 = multi_reduce16(a1, lane);
}
struct TItem { const float* src; bf16* WT; int K, ncols, n0, k0, kind, aux; bool ok; };
__device__ __forceinline__ int titem_dstrow(const TItem& t, int c) {
    switch (t.kind) {
        case 0: return 256 * (c >> 7) + perm8(c & 127);
        case 1: return 256 * (c >> 7) + 128 + perm8(c & 127);
        case 2: return perm8(c);
        case 3: { if (c >= 1536 && c < 1552) return -1; const int L = c < 1536 ? c : c - 16; return perm8(L); }
        case 4: { if (c < 768) return (c & ~255) + head64(c & 255); return perm8(1536 + c); }
        case 5: { if (c < 768) { const int L = 768 + c; return (L & ~255) + head64(L & 255); } if (c < 1536) return perm8(768 + c); return -1; }
        default: return perm8(t.aux * 512 + c);
    }
}
__device__ __forceinline__ void titem_load(const TItem& t, float (&r)[32]) {
#pragma unroll
    for (int i = 0; i < 32; ++i) r[i] = t.ok ? t.src[(size_t)(2 * i) * t.ncols] : 0.f;
}
__device__ __forceinline__ void titem_store(const TItem& t, const float (&r)[32], LAS float* scr, int lane) {
#pragma unroll
    for (int i = 0; i < 32; ++i) scr[(2 * i + (lane >> 5)) * 33 + (lane & 31)] = r[i];
    LDS_WAIT(); asm volatile("" ::: "memory");
    const int c = lane & 7;
#pragma unroll
    for (int j = 0; j < 4; ++j) { const int n = (lane >> 3) + 8 * j; const LAS float* s = scr + (8 * c) * 33 + n;
        u32x4 o; o.x = cvt_pk_bf16(s[0 * 33], s[1 * 33]); o.y = cvt_pk_bf16(s[2 * 33], s[3 * 33]); o.z = cvt_pk_bf16(s[4 * 33], s[5 * 33]); o.w = cvt_pk_bf16(s[6 * 33], s[7 * 33]);
        const int dr = (t.n0 + n) < t.ncols ? titem_dstrow(t, t.n0 + n) : -1;
        if (dr >= 0) *(u32x4*)(t.WT + (size_t)dr * t.K + t.k0 + 8 * c) = o; }
    LDS_WAIT(); asm volatile("" ::: "memory");
}
struct Params { const float* in[22]; float* out; unsigned char* ws; int ph_lo, ph_hi, bar_li, pad; };
enum { I_X = 0, I_MEM, I_WINA, I_WGUP, I_BGATE, I_GLAG, I_WINB, I_QNG, I_WKV, I_BFORGET, I_KNG, I_WMKV, I_WOUT, I_LMG, I_LMB, I_LFG, I_LFB, I_WR, I_BR, I_WEG, I_WEU, I_WED };
constexpr int CW_BAR = 4096;

typedef const __attribute__((address_space(4))) Params* KP;
__device__ __forceinline__ KP fresh_kp() { KP q = (KP)__builtin_amdgcn_kernarg_segment_ptr(); asm volatile("" : "+s"(q)); return q; }

constexpr int CV_STATIC = 3 * 512 + 176 + 112 + 96 + 64 + 128, CV_QUEUE = 3 * 512;
constexpr int CV_A_STATIC = 576, CV_NSTAT = CV_A_STATIC + (CV_STATIC - 1536), CV_QA = 1536 - CV_A_STATIC;
constexpr int CW_CVQ = 1040, CW_CVQA = 1056;
__device__ __forceinline__ void cv_decode(KP p, unsigned char* ws, int it, int lane, int wave, TItem& t) {
    int r = it; const float* W; int nblk, q, l = 0; t.aux = 0;
    if (r >= CV_STATIC) { r -= CV_STATIC; l = 1; }
    else if (r >= 1536) { r -= 1536;
        if (r < 176) { q = r; W = p->in[I_WINA]; t.ncols = A_IN; t.K = D; t.WT = (bf16*)(ws + WS_WA); nblk = 11; t.kind = 3; }
        else if ((r -= 176) < 112) { q = r; W = p->in[I_WINB]; t.ncols = B_IN; t.K = D; t.WT = (bf16*)(ws + WS_WB); nblk = 7; t.kind = 4; }
        else if ((r -= 112) < 96) { q = r; W = p->in[I_WKV]; t.ncols = KV_IN; t.K = D; t.WT = (bf16*)(ws + WS_WB); nblk = 6; t.kind = 5; }
        else if ((r -= 96) < 64) { const int lm = r / 32; q = r % 32; W = p->in[I_WMKV] + (size_t)lm * D * 512; t.ncols = 512; t.K = D; t.WT = (bf16*)(ws + WS_WMKV); nblk = 2; t.kind = 6; t.aux = lm; }
        else { r -= 64; const int lo = r / 64; q = r % 64; W = p->in[I_WOUT] + (size_t)lo * D * D; t.ncols = D; t.K = D; t.WT = (bf16*)(ws + WS_WO) + (size_t)lo * D * D; nblk = 4; t.kind = 2; }
        goto done; }
    if (r < 512) { const int mat = 16 * l + r / 32; q = r % 32; W = p->in[I_WEG] + (size_t)mat * D * DEXP; t.ncols = DEXP; t.K = D; t.WT = (bf16*)(ws + WS_WGU) + (size_t)mat * 1024 * D; nblk = 2; t.kind = 0; }
    else if ((r -= 512) < 512) { const int mat = 16 * l + r / 32; q = r % 32; W = p->in[I_WEU] + (size_t)mat * D * DEXP; t.ncols = DEXP; t.K = D; t.WT = (bf16*)(ws + WS_WGU) + (size_t)mat * 1024 * D; nblk = 2; t.kind = 1; }
    else { r -= 512; const int mat = 16 * l + r / 32; q = r % 32; W = p->in[I_WED] + (size_t)mat * DEXP * D; t.ncols = D; t.K = DEXP; t.WT = (bf16*)(ws + WS_WD) + (size_t)mat * D * DEXP; nblk = 4; t.kind = 2; }
done:
    t.k0 = 64 * (q / nblk); t.n0 = 256 * (q % nblk);
    const int col = t.n0 + 4 * lane; t.ok = col < t.ncols;
    t.src = W + (size_t)(t.k0 + 8 * wave) * t.ncols + (t.ok ? col : 0);
}
#define CV_TLOAD(t, r) do { _Pragma("unroll") for (int i = 0; i < 8; ++i) r[i] = t.ok ? *(const f32x4*)(t.src + (size_t)i * t.ncols) : (f32x4){0.f, 0.f, 0.f, 0.f}; } while (0)
#define CV_TSTORE(t, r) do { __syncthreads(); \
        _Pragma("unroll") for (int i = 0; i < 8; ++i) { LAS float* d_ = T + (8 * wave + i) * 257 + 4 * lane; d_[0] = r[i][0]; d_[1] = r[i][1]; d_[2] = r[i][2]; d_[3] = r[i][3]; } \
        __syncthreads(); \
        const int c_ = lane & 7; \
        _Pragma("unroll") for (int j = 0; j < 4; ++j) { const int n_ = 32 * wave + (lane >> 3) + 8 * j; const LAS float* s_ = T + (8 * c_) * 257 + n_; \
            u32x4 o_; o_.x = cvt_pk_bf16(s_[0 * 257], s_[1 * 257]); o_.y = cvt_pk_bf16(s_[2 * 257], s_[3 * 257]); o_.z = cvt_pk_bf16(s_[4 * 257], s_[5 * 257]); o_.w = cvt_pk_bf16(s_[6 * 257], s_[7 * 257]); \
            const int dr_ = (t.n0 + n_) < t.ncols ? titem_dstrow(t, t.n0 + n_) : -1; \
            if (dr_ >= 0) *(u32x4*)(t.WT + (size_t)dr_ * t.K + t.k0 + 8 * c_) = o_; } } while (0)
__device__ __forceinline__ void convert_static(KP p, unsigned char* ws, LAS unsigned char* lds, int lane, int wave, int G, int bid) {
    LAS float* T = (LAS float*)lds;
    TItem ta; f32x4 ra[8], rb[8];
#define CV_SID(s) ((s) < CV_A_STATIC ? (s) : 1536 + ((s) - CV_A_STATIC))
    int it = bid;
    if (it < CV_NSTAT) { cv_decode(p, ws, CV_SID(it), lane, wave, ta); CV_TLOAD(ta, ra); }
#pragma unroll 1
    for (; it < CV_NSTAT; it += 2 * G) {
        TItem tb; const bool hb = it + G < CV_NSTAT;
        if (hb) { cv_decode(p, ws, CV_SID(it + G), lane, wave, tb); CV_TLOAD(tb, rb); }
        CV_TSTORE(ta, ra);
        if (it + 2 * G < CV_NSTAT) { cv_decode(p, ws, CV_SID(it + 2 * G), lane, wave, ta); CV_TLOAD(ta, ra); }
        if (hb) CV_TSTORE(tb, rb);
    }
#undef CV_SID
    __syncthreads();
}
__device__ __forceinline__ void convert_from_queue(KP p, LAS unsigned char* lds, const int wave_s, int budget, const int qword = CW_CVQ, const int qbase = CV_STATIC, const int qcount = CV_QUEUE) {
    unsigned char* ws = p->ws; LAS float* T = (LAS float*)lds;
    const int tid = fresh_tid(wave_s), lane = tid & 63, wave = wave_s;
    unsigned* qh = (unsigned*)(ws + WS_CTL) + qword; volatile LAS unsigned* slotw = (volatile LAS unsigned*)(lds + MISC_OFF) + 56;
    for (int n = 0; budget < 0 || n < budget; ++n) {
        if (tid == 0) slotw[0] = __hip_atomic_fetch_add(qh, 1u, __ATOMIC_RELAXED, __HIP_MEMORY_SCOPE_AGENT);
        __syncthreads();
        const int q = (int)__builtin_amdgcn_readfirstlane(slotw[0]);
        if (q >= qcount) break;
        TItem t; f32x4 r[8]; cv_decode(p, ws, qbase + q, lane, wave, t); CV_TLOAD(t, r); CV_TSTORE(t, r);
        __syncthreads();
    }
    __syncthreads();
}
__device__ __forceinline__ void phase_prologue(KP p, LAS unsigned char* lds, int G, int bid, const int wave_s) {
    const int tid = fresh_tid(wave_s), lane = tid & 63, wave = wave_s;
    unsigned char* ws = p->ws;
    LAS float* scr = (LAS float*)(lds + wave * 8448);
    const int gw = bid * NWAVES + wave, NGW = G * NWAVES;
    constexpr int NB_A = 81, NB_B = 56, NB_KV = 48;
    constexpr int I_G = 32 * 16 * 16, I_U = I_G, I_D = 32 * 8 * 32, I_A = 16 * NB_A, I_B = 16 * NB_B, I_KV = 16 * NB_KV, I_MK = 2 * 16 * 16, I_O = 2 * 16 * 32;
    constexpr int NITEMS = I_G + I_U + I_D + I_A + I_B + I_KV + I_MK + I_O;
    auto decode = [&](int it, TItem& t) {
        int r = it; const float* W; int nblk, q; t.aux = 0;
        if (r < I_G) { const int mat = r / 256; q = r % 256; W = p->in[I_WEG] + (size_t)mat * D * DEXP; t.ncols = DEXP; t.K = D; t.WT = (bf16*)(ws + WS_WGU) + (size_t)mat * 1024 * D; nblk = 16; t.kind = 0; }
        else if ((r -= I_G) < I_U) { const int mat = r / 256; q = r % 256; W = p->in[I_WEU] + (size_t)mat * D * DEXP; t.ncols = DEXP; t.K = D; t.WT = (bf16*)(ws + WS_WGU) + (size_t)mat * 1024 * D; nblk = 16; t.kind = 1; }
        else if ((r -= I_U) < I_D) { const int mat = r / 256; q = r % 256; W = p->in[I_WED] + (size_t)mat * DEXP * D; t.ncols = D; t.K = DEXP; t.WT = (bf16*)(ws + WS_WD) + (size_t)mat * D * DEXP; nblk = 32; t.kind = 2; }
        else if ((r -= I_D) < I_A) { q = r; W = p->in[I_WINA]; t.ncols = A_IN; t.K = D; t.WT = (bf16*)(ws + WS_WA); nblk = NB_A; t.kind = 3; }
        else if ((r -= I_A) < I_B) { q = r; W = p->in[I_WINB]; t.ncols = B_IN; t.K = D; t.WT = (bf16*)(ws + WS_WB); nblk = NB_B; t.kind = 4; }
        else if ((r -= I_B) < I_KV) { q = r; W = p->in[I_WKV]; t.ncols = KV_IN; t.K = D; t.WT = (bf16*)(ws + WS_WB); nblk = NB_KV; t.kind = 5; }
        else if ((r -= I_KV) < I_MK) { const int l = r / 256; q = r % 256; W = p->in[I_WMKV] + (size_t)l * D * 512; t.ncols = 512; t.K = D; t.WT = (bf16*)(ws + WS_WMKV); nblk = 16; t.kind = 6; t.aux = l; }
        else { r -= I_MK; const int l = r / 512; q = r % 512; W = p->in[I_WOUT] + (size_t)l * D * D; t.ncols = D; t.K = D; t.WT = (bf16*)(ws + WS_WO) + (size_t)l * D * D; nblk = 32; t.kind = 2; }
        t.k0 = 64 * (q / nblk); t.n0 = 32 * (q % nblk);
        const int col = t.n0 + (lane & 31); t.ok = col < t.ncols;
        t.src = W + (size_t)(t.k0 + (lane >> 5)) * t.ncols + (t.ok ? col : 0);
    };
    { PSEC_BEGIN(20); convert_static(p, ws, lds, lane, wave, G, bid); PSEC_END(20); }
    { const f32x4* src = (const f32x4*)p->in[I_MEM]; u32x2* dst = (u32x2*)(ws + WS_MEMB);
      for (int i = bid * NTHREADS + tid; i < NB * NMEM * D / 4; i += G * NTHREADS) { const f32x4 v = src[i]; u32x2 o; o.x = pk2(v[0], v[1]); o.y = pk2(v[2], v[3]); dst[i] = o; } }
    __syncthreads();
    LAS float* WG = (LAS float*)(lds);
    for (int idx = tid; idx < 16 * D; idx += NTHREADS) { const int j = idx & 15, k = idx >> 4; WG[j * D + k] = p->in[I_WINA][(size_t)k * A_IN + 1536 + j]; }
    __syncthreads();
    bf16* XB = (bf16*)(ws + WS_XB); float* GLR = (float*)(ws + WS_GLR);
    { PSEC_BEGIN(22);
    {   f32x4 a0[4], a1[4], b0[4], b1[4];
#define P0_LOAD(va, vb, mm) do { const f32x4* xr_ = (const f32x4*)(p->in[I_X] + (size_t)(mm) * D) + lane; _Pragma("unroll") for (int j = 0; j < 4; ++j) { va[j] = xr_[64 * j]; vb[j] = xr_[64 * j + 256]; } } while (0)
#define P0_PROC(va, vb, mm) do { u32x2* o8_ = (u32x2*)(XB + (size_t)(mm) * D) + lane; \
            _Pragma("unroll") for (int j = 0; j < 4; ++j) { u32x2 o; o.x = cvt_pk_bf16(va[j][0], va[j][1]); o.y = cvt_pk_bf16(va[j][2], va[j][3]); o8_[64 * j] = o; o.x = cvt_pk_bf16(vb[j][0], vb[j][1]); o.y = cvt_pk_bf16(vb[j][2], vb[j][3]); o8_[64 * j + 256] = o; } \
            float r0_, r1_; row_dots16x2(va, vb, WG, lane, r0_, r1_); \
            if ((lane & 3) == 0) { GLR[(size_t)(mm) * 16 + (lane >> 2)] = r0_; GLR[(size_t)((mm) + 1) * 16 + (lane >> 2)] = r1_; } } while (0)
        int m = 2 * gw;
        if (m < NTOK) P0_LOAD(a0, a1, m);
#pragma unroll 1
        for (; m < NTOK; m += 4 * NGW) {
            const bool hb = m + 2 * NGW < NTOK;
            if (hb) P0_LOAD(b0, b1, m + 2 * NGW);
            P0_PROC(a0, a1, m);
            if (m + 4 * NGW < NTOK) P0_LOAD(a0, a1, m + 4 * NGW);
            if (hb) P0_PROC(b0, b1, m + 2 * NGW);
        }
#undef P0_LOAD
#undef P0_PROC
    }
    PSEC_END(22); }
}

template <bool RB> struct EpiRes { const void* xres; bf16* out;
    __device__ __forceinline__ void operator()(const f32x4 (&acc)[2][2][4][2], const Unit& u, int wr, int wc, int fr, int fq) const {
        size_t off = (size_t)(u.pm * BM + wr * 64 + fr) * D + (u.pn * BM + wc * 32 + 8 * fq);
#pragma unroll
        for (int ai = 0; ai < 2; ++ai) {
#pragma unroll
            for (int m = 0; m < 4; ++m) {
#pragma unroll
                for (int bj = 0; bj < 2; ++bj) { f32x4 x0, x1;
                    if (RB) { const u32x4 t = *(const u32x4*)((const bf16*)xres + off + bj * HALF); x0[0] = __uint_as_float(t.x << 16); x0[1] = __uint_as_float(t.x & 0xffff0000u); x0[2] = __uint_as_float(t.y << 16); x0[3] = __uint_as_float(t.y & 0xffff0000u);
                        x1[0] = __uint_as_float(t.z << 16); x1[1] = __uint_as_float(t.z & 0xffff0000u); x1[2] = __uint_as_float(t.w << 16); x1[3] = __uint_as_float(t.w & 0xffff0000u); }
                    else { x0 = *(const f32x4*)((const float*)xres + off + bj * HALF); x1 = *(const f32x4*)((const float*)xres + off + bj * HALF + 4); }
                    const f32x4 v0 = x0 * DN_ALPHA + acc[ai][bj][m][0], v1 = x1 * DN_ALPHA + acc[ai][bj][m][1];
                    u32x4 w; w.x = cvt_pk_bf16(v0[0], v0[1]); w.y = cvt_pk_bf16(v0[2], v0[3]); w.z = cvt_pk_bf16(v1[0], v1[1]); w.w = cvt_pk_bf16(v1[2], v1[3]);
                    *(u32x4*)(out + off + bj * HALF) = w; }
                off += (size_t)16 * D; asm volatile("" : "+v"(off) :: "memory"); }
            off += (size_t)64 * D; }
    } };
struct EpiInB { bf16 *Q, *K, *V, *OG, *MQ; const float* qg; const float* kg;
    __device__ __forceinline__ void operator()(const f32x4 (&acc)[2][2][4][2], const Unit& u, int wr, int wc, int fr, int fq) const {
        const int pn = u.pn;
        if (pn >= 6) { bf16* base; int ldd, c0;
            if (pn < 9) { base = V; ldd = 768; c0 = (pn - 6) * 256; } else if (pn < 12) { base = OG; ldd = 768; c0 = (pn - 9) * 256; } else { base = MQ; ldd = 256; c0 = 0; }
            store_bf16_tile(acc, base, ldd, u.pm * BM, c0, wr, wc, fr, fq); return; }
        const bool isq = pn < 3; bf16* base = isq ? Q : K; const float* g = isq ? qg : kg; const float sc = isq ? QC2 : 1.0f;
        const int c0 = (isq ? pn : pn - 3) * 256 + wc * 64 + 8 * fq, r0 = u.pm * BM + wr * 64 + fr;
        f32x4 gv[2][2];
#pragma unroll
        for (int bj = 0; bj < 2; ++bj)
#pragma unroll
            for (int n = 0; n < 2; ++n) gv[bj][n] = *(const f32x4*)(g + 32 * bj + 8 * fq + 4 * n) * sc;
        bf16* rowp = base + (size_t)r0 * 768 + c0;
#pragma unroll
        for (int ai = 0; ai < 2; ++ai) {
#pragma unroll
            for (int m = 0; m < 4; ++m) {
                float ss = 0.f;
#pragma unroll
                for (int bj = 0; bj < 2; ++bj)
#pragma unroll
                    for (int n = 0; n < 2; ++n) { const f32x4 v = acc[ai][bj][m][n]; ss += (v[0] * v[0] + v[1] * v[1]) + (v[2] * v[2] + v[3] * v[3]); }
                ss = sum_swap16(ss, ss); ss = sum_swap32(ss, ss);
                const float rs = rsqrtf(ss * (1.f / 64.f) + RMS_EPS);
#pragma unroll
                for (int bj = 0; bj < 2; ++bj) { const f32x4 v0 = acc[ai][bj][m][0] * rs * gv[bj][0], v1 = acc[ai][bj][m][1] * rs * gv[bj][1];
                    u32x4 w; w.x = cvt_pk_bf16(v0[0], v0[1]); w.y = cvt_pk_bf16(v0[2], v0[3]); w.z = cvt_pk_bf16(v1[0], v1[1]); w.w = cvt_pk_bf16(v1[2], v1[3]);
                    *(u32x4*)(rowp + 32 * bj) = w; }
                rowp += (size_t)16 * 768; asm volatile("" : "+v"(rowp)); }
            rowp += (size_t)64 * 768; }
    } };

__device__ __forceinline__ void load_wtab(LAS float* WT, const float* W, int ldw, int col0, int ncols, int tid) {
    for (int idx = tid; idx < 16 * D; idx += NTHREADS) { const int j = idx & 15, k = idx >> 4; WT[j * D + k] = j < ncols ? W[(size_t)k * ldw + col0 + j] : 0.f; }
}
__device__ __forceinline__ float row_dots16(const f32x4 (&v)[4], const LAS float* WT, int lane) {
    float acc[16];
    const LAS float* wl = WT + 4 * lane; asm volatile("" : "+v"(wl));
#pragma unroll
    for (int n = 0; n < 16; ++n) { float a = 0.f;
#pragma unroll
        for (int j = 0; j < 4; ++j) { const f32x4 w = *(const LAS f32x4*)(wl + n * D + 256 * j); a += v[j][0] * w[0] + v[j][1] * w[1] + v[j][2] * w[2] + v[j][3] * w[3]; }
        acc[n] = a; if (n & 1) asm volatile("" : "+v"(acc[n - 1]), "+v"(acc[n]) :: "memory"); }
    return multi_reduce16(acc, lane);
}
__device__ __forceinline__ void ln_row(f32x4 (&v)[4], const float* g, const float* b, int lane) {
    float s = 0.f;
#pragma unroll
    for (int j = 0; j < 4; ++j) s += (v[j][0] + v[j][1]) + (v[j][2] + v[j][3]);
    const float mean = wsum(s) * (1.f / D); float q = 0.f;
#pragma unroll
    for (int j = 0; j < 4; ++j) { v[j] = v[j] - mean; q += (v[j][0] * v[j][0] + v[j][1] * v[j][1]) + (v[j][2] * v[j][2] + v[j][3] * v[j][3]); }
    const float rstd = rsqrtf(wsum(q) * (1.f / D) + LN_EPS);
#pragma unroll
    for (int j = 0; j < 4; ++j) { const f32x4 gg = *(const f32x4*)(g + 4 * lane + 256 * j), bb = *(const f32x4*)(b + 4 * lane + 256 * j); v[j] = v[j] * rstd * gg + bb; }
}
__device__ __forceinline__ void store_row_f32_bf16(const f32x4 (&v)[4], float* xf, bf16* xb, int lane) {
#pragma unroll
    for (int j = 0; j < 4; ++j) { if (xf) ((f32x4*)xf)[lane + 64 * j] = v[j]; if (xb) { u32x2 o; o.x = cvt_pk_bf16(v[j][0], v[j][1]); o.y = cvt_pk_bf16(v[j][2], v[j][3]); ((u32x2*)xb)[lane + 64 * j] = o; } }
}

__device__ __forceinline__ void route_thread(const float (&lg)[16], const float (&brv)[16], int m, int lt, int* TOK_E, float* TOK_W, LAS int* tokE) {
    float aff[16], sel[16];
#pragma unroll
    for (int e = 0; e < 16; ++e) { aff[e] = 1.f / (1.f + __expf(-lg[e])); sel[e] = aff[e] + brv[e]; }
    int gbest = 0; float gs = -1e30f;
#pragma unroll
    for (int gi = 0; gi < 4; ++gi) { float a = -1e30f, b2 = -1e30f;
#pragma unroll
        for (int j = 0; j < 4; ++j) { const float x = sel[gi * 4 + j]; const bool gt = x > a; b2 = gt ? a : fmaxf(b2, x); a = gt ? x : a; }
        const bool better = a + b2 > gs; gs = better ? a + b2 : gs; gbest = better ? gi : gbest; }
    int i0 = 0, i1 = 0; float a = -1e30f, b2 = -1e30f, wa = 0.f, wb = 0.f;
#pragma unroll
    for (int j = 0; j < 4; ++j) { float x = sel[j], y = aff[j];
#pragma unroll
        for (int gi = 1; gi < 4; ++gi) { x = (gi == gbest) ? sel[gi * 4 + j] : x; y = (gi == gbest) ? aff[gi * 4 + j] : y; }
        const bool g1 = x > a, g2 = x > b2;
        const float nb = g1 ? a : (g2 ? x : b2), nwb = g1 ? wa : (g2 ? y : wb); const int ni1 = g1 ? i0 : (g2 ? j : i1);
        a = g1 ? x : a; wa = g1 ? y : wa; i0 = g1 ? j : i0; b2 = nb; wb = nwb; i1 = ni1; }
    const float inv = 1.f / (wa + wb); const int e0 = gbest * 4 + i0, e1 = gbest * 4 + i1;
    TOK_E[m * 2] = e0; TOK_E[m * 2 + 1] = e1; TOK_W[m * 2] = wa * inv; TOK_W[m * 2 + 1] = wb * inv; tokE[lt * 2] = e0; tokE[lt * 2 + 1] = e1;
}
__device__ __forceinline__ void phase_ln_router(KP p, int layer, LAS unsigned char* lds, int G, int bid, const int wave_s) {
    const int tid = fresh_tid(wave_s), lane = tid & 63, wave = wave_s;
    PSEC_BEGIN(0);
    unsigned char* ws = p->ws;
    LAS float* WT = (LAS float*)lds; LAS int* tokE = (LAS int*)(lds + 65536);
    load_wtab(WT, p->in[I_WR], 16, 0, 16, tid);
    __syncthreads();
    const bf16* Y1 = (const bf16*)p->out; bf16* XB = (bf16*)(ws + WS_XB); int* TOK_E = (int*)(ws + WS_TOKE); float* TOK_W = (float*)(ws + WS_TOKW); int* CNT = (int*)(ws + WS_CNT); int* SLOT_TOK = (int*)(ws + WS_SLOTTOK);
    const float* g = p->in[I_LMG] + layer * D; const float* b = p->in[I_LMB] + layer * D;
#define LNR_LOAD(va, vb, pr) do { const u32x2* s0_ = (const u32x2*)(Y1 + (size_t)(tb * 128 + wave * 16 + 2 * (pr)) * D) + lane; _Pragma("unroll") for (int j = 0; j < 4; ++j) { const u32x2 a_ = s0_[64 * j], b_ = s0_[64 * j + 256]; \
        va[j][0] = __uint_as_float(a_.x << 16); va[j][1] = __uint_as_float(a_.x & 0xffff0000u); va[j][2] = __uint_as_float(a_.y << 16); va[j][3] = __uint_as_float(a_.y & 0xffff0000u); \
        vb[j][0] = __uint_as_float(b_.x << 16); vb[j][1] = __uint_as_float(b_.x & 0xffff0000u); vb[j][2] = __uint_as_float(b_.y << 16); vb[j][3] = __uint_as_float(b_.y & 0xffff0000u); } } while (0)
#define LNR_PROC(va, vb, pr) do { const int lt_ = wave * 16 + 2 * (pr), m_ = tb * 128 + lt_; \
        { PSEC_BEGIN(1); ln_row(va, g, b, lane); ln_row(vb, g, b, lane); \
        store_row_f32_bf16(va, (float*)nullptr, XB + (size_t)m_ * D, lane); store_row_f32_bf16(vb, (float*)nullptr, XB + (size_t)(m_ + 1) * D, lane); PSEC_END(1); } \
        float l0_, l1_; { PSEC_BEGIN(2); row_dots16x2(va, vb, WT, lane, l0_, l1_); asm volatile("" : "+v"(l0_), "+v"(l1_)); PSEC_END(2); } \
        if ((lane & 3) == 0) { LG[lt_ * 16 + (lane >> 2)] = l0_; LG[(lt_ + 1) * 16 + (lane >> 2)] = l1_; } } while (0)
    LAS float* LG = (LAS float*)(lds + 65536 + 1024);
    for (int tb = bid; tb < NTOK / 128; tb += G) {
        f32x4 a0[4], a1[4], b0[4], b1[4];
        LNR_LOAD(a0, a1, 0);
#pragma unroll 1
        for (int pr = 0; pr < 8; pr += 2) {
            LNR_LOAD(b0, b1, pr + 1);
            LNR_PROC(a0, a1, pr);
            if (pr + 2 < 8) LNR_LOAD(a0, a1, pr + 2);
            LNR_PROC(b0, b1, pr + 1);
        }
        __syncthreads();
        if (tid < 128) { PSEC_BEGIN(3); float lg[16], brv[16];
#pragma unroll
            for (int q = 0; q < 4; ++q) { const f32x4 t4 = *(const LAS f32x4*)(LG + tid * 16 + 4 * q); const f32x4 b4 = *(const f32x4*)(p->in[I_BR] + 4 * q);
#pragma unroll
                for (int j = 0; j < 4; ++j) { lg[4 * q + j] = t4[j]; brv[4 * q + j] = b4[j]; } }
            route_thread(lg, brv, tb * 128 + tid, tid, TOK_E, TOK_W, tokE); PSEC_END(3); }
        __syncthreads();
        if (tid < 256) {
            const int e = tokE[tid]; int rank = 0;
            for (int i = 0; i < tid; ++i) rank += (tokE[i] == e) ? 1 : 0;
            SLOT_TOK[(e * 256 + tb) * 128 + rank] = tb * 256 + tid;
        } else if (tid < 272) { const int e = tid - 256; int c = 0; for (int i = 0; i < 256; ++i) c += (tokE[i] == e) ? 1 : 0; CNT[tb * 16 + e] = c; }
        __syncthreads();
    }
    PSEC_END(0);
#undef LNR_LOAD
#undef LNR_PROC
}
struct FfnRow { u32x2 x[4], ya[4], yc[4]; float w0, w1; };
__device__ __forceinline__ void ffn_combine(FfnRow& r, f32x4 (&v)[4]) {
#pragma unroll
    for (int j = 0; j < 4; ++j) { const u32x2 a = r.ya[j], c = r.yc[j]; f32x4 ya, yc;
        ya[0] = __uint_as_float(a.x << 16); ya[1] = __uint_as_float(a.x & 0xffff0000u); ya[2] = __uint_as_float(a.y << 16); ya[3] = __uint_as_float(a.y & 0xffff0000u);
        yc[0] = __uint_as_float(c.x << 16); yc[1] = __uint_as_float(c.x & 0xffff0000u); yc[2] = __uint_as_float(c.y << 16); yc[3] = __uint_as_float(c.y & 0xffff0000u);
        const u32x2 xx = r.x[j]; f32x4 xv; xv[0] = __uint_as_float(xx.x << 16); xv[1] = __uint_as_float(xx.x & 0xffff0000u); xv[2] = __uint_as_float(xx.y << 16); xv[3] = __uint_as_float(xx.y & 0xffff0000u);
        v[j] = xv * DN_ALPHA + ya * r.w0 + yc * r.w1; }
}
__device__ __forceinline__ void phase_ln_ffn(KP p, int layer, LAS unsigned char* lds, int G, int bid, const int wave_s) {
    const int tid = fresh_tid(wave_s), lane = tid & 63, wave = wave_s;
    unsigned char* ws = p->ws;
    LAS float* WT = (LAS float*)lds;
    if (layer == 0) { load_wtab(WT, p->in[I_WKV], KV_IN, 1536, 12, tid); __syncthreads(); }
    const int eo = (lane >> 2) & 15; const float bf = (layer == 0 && eo < 12) ? p->in[I_BFORGET][eo] : 0.f;
    float* XF = p->out; bf16* XB = (bf16*)(ws + WS_XB); const bf16* YS = (const bf16*)(ws + WS_HREG);
    const int* TOK_S = (const int*)(ws + WS_TOKS); const float* TOK_W = (const float*)(ws + WS_TOKW); float* LOGF = (float*)(ws + WS_LOGF);
    const float* g = p->in[I_LFG] + layer * D; const float* b = p->in[I_LFB] + layer * D;
    const int gw = bid * NWAVES + wave, NGW = G * NWAVES;
#define FFN_LOAD(R, m_) do { const int mm_ = (m_); int mv_ = mm_ * 2; asm volatile("" : "+v"(mv_));        \
        const int s0_ = TOK_S[mv_], s1_ = TOK_S[mv_ + 1]; R.w0 = TOK_W[mv_]; R.w1 = TOK_W[mv_ + 1]; \
        _Pragma("unroll") for (int j = 0; j < 4; ++j) { R.x[j] = ((const u32x2*)(XB + (size_t)mm_ * D))[lane + 64 * j]; R.ya[j] = ((const u32x2*)(YS + (size_t)s0_ * D))[lane + 64 * j]; R.yc[j] = ((const u32x2*)(YS + (size_t)s1_ * D))[lane + 64 * j]; } } while (0)
#define FFN_PROC(R, m_) do { const int mm_ = (m_); f32x4 v_[4]; ffn_combine(R, v_); ln_row(v_, g, b, lane); \
        store_row_f32_bf16(v_, layer == 0 ? (float*)nullptr : XF + (size_t)mm_ * D, layer == 0 ? XB + (size_t)mm_ * D : (bf16*)nullptr, lane); \
        if (layer == 0) { const float t_ = row_dots16(v_, WT, lane); if ((lane & 3) == 0 && eo < 12) LOGF[(size_t)mm_ * 12 + eo] = log_sigmoid(t_ + bf); } } while (0)
    FfnRow A0, A1, B0, B1;
#define FFN_PROC2(R0, R1, m0_, m1_) do { const int ma_ = (m0_), mb_ = (m1_); f32x4 va_[4], vb_[4]; ffn_combine(R0, va_); ffn_combine(R1, vb_); ln_row(va_, g, b, lane); ln_row(vb_, g, b, lane); \
        store_row_f32_bf16(va_, layer == 0 ? (float*)nullptr : XF + (size_t)ma_ * D, layer == 0 ? XB + (size_t)ma_ * D : (bf16*)nullptr, lane); \
        store_row_f32_bf16(vb_, layer == 0 ? (float*)nullptr : XF + (size_t)mb_ * D, layer == 0 ? XB + (size_t)mb_ * D : (bf16*)nullptr, lane); \
        if (layer == 0) { float ta_, tb_; row_dots16x2(va_, vb_, WT, lane, ta_, tb_); if ((lane & 3) == 0 && eo < 12) { LOGF[(size_t)ma_ * 12 + eo] = log_sigmoid(ta_ + bf); LOGF[(size_t)mb_ * 12 + eo] = log_sigmoid(tb_ + bf); } } } while (0)
    int m = gw;
    if (m + NGW < NTOK) { FFN_LOAD(A0, m); FFN_LOAD(A1, m + NGW); }
#pragma unroll 1
    for (; m + NGW < NTOK; m += 4 * NGW) {
        const bool hb = (m + 3 * NGW) < NTOK;
        if (hb) { FFN_LOAD(B0, m + 2 * NGW); FFN_LOAD(B1, m + 3 * NGW); }
        FFN_PROC2(A0, A1, m, m + NGW);
        if (m + 5 * NGW < NTOK) { FFN_LOAD(A0, m + 4 * NGW); FFN_LOAD(A1, m + 5 * NGW); }
        if (hb) FFN_PROC2(B0, B1, m + 2 * NGW, m + 3 * NGW); else { m += 2 * NGW; break; }
    }
    if (m < NTOK) { FFN_LOAD(A0, m); FFN_PROC(A0, m); }
#undef FFN_PROC2
#undef FFN_LOAD
#undef FFN_PROC
}
__device__ __forceinline__ void cum_wave(const float* LOGF, float* CUM, int bh, int lane) {
    const int b = bh / FOX_H, h = bh % FOX_H;
    float loc[64]; float s = 0.f;
#pragma unroll
    for (int i = 0; i < 64; ++i) { s += LOGF[((size_t)b * SEQ + lane * 64 + i) * 12 + h]; loc[i] = s; }
    float inc = s;
#pragma unroll
    for (int o = 1; o < 64; o <<= 1) { const float t = __shfl_up(inc, o); if (lane >= o) inc += t; }
    const float base = inc - s;
#pragma unroll
    for (int i = 0; i < 64; ++i) CUM[(size_t)bh * SEQ + lane * 64 + i] = base + loc[i];
}
constexpr int MOE_MAXU = 6;
__device__ __forceinline__ int moe_setup(unsigned char* ws, LAS unsigned char* lds, int G, int bid, const int wave_s, const bool build_rows) {
    const int tid = fresh_tid(wave_s), lane = tid & 63, wave = wave_s;
    LAS int* PRE = (LAS int*)lds; LAS int* TB = (LAS int*)(lds + 16640); LAS int* TE = TB + 17;
    volatile LAS int* UL = (volatile LAS int*)(lds + MISC_OFF) + 16; LAS int* rowtok = (LAS int*)(lds + ROWTOK_OFF);
    const int* CNT = (const int*)(ws + WS_CNT); const int* SLOT_TOK = (const int*)(ws + WS_SLOTTOK); int* TOK_S = (int*)(ws + WS_TOKS);
#pragma unroll
    for (int q = 0; q < 2; ++q) { const int e = 2 * wave + q;
        int c[4]; int s = 0;
#pragma unroll
        for (int i = 0; i < 4; ++i) { c[i] = CNT[(4 * lane + i) * 16 + e]; s += c[i]; }
        int inc = s;
#pragma unroll
        for (int o = 1; o < 64; o <<= 1) { const int t = __shfl_up(inc, o); if (lane >= o) inc += t; }
        int run = inc - s;
#pragma unroll
        for (int i = 0; i < 4; ++i) { PRE[e * 257 + 4 * lane + i] = run; run += c[i]; }
        if (lane == 63) { PRE[e * 257 + 256] = inc; TE[e] = inc; } }
    __syncthreads();
    if (tid <= 16) { int t = 0; for (int e = 0; e < 16; ++e) { if (e < tid) t += (TE[e] + 255) >> 8; } TB[tid] = t; }
    __syncthreads();
    const int NT = TB[16];
    if (tid < MOE_MAXU) { const int L = tid * G + bid, tile = (L & 7) + 8 * (L >> 5), pn = (L >> 3) & 3;
        int e = 0;
#pragma unroll
        for (int k = 1; k < 16; ++k) e += (TB[k] <= tile) ? 1 : 0;
        UL[3 * tid] = tile; UL[3 * tid + 1] = pn; UL[3 * tid + 2] = e; UL[32 + tid] = (tile < NT) ? 1 : 0; }
    __syncthreads();
    if (tid == 0) { int n = 0;
#pragma unroll
        for (int i = 0; i < MOE_MAXU; ++i) n += (int)UL[32 + i]; UL[24] = n; UL[25] = 32 * ((NT + 7) >> 3); }
    __syncthreads();
    const int nunits = __builtin_amdgcn_readfirstlane(UL[24]);
    if (build_rows) {
        for (int i = (tid >> 8); i < nunits; i += 2) { const int tile = UL[3 * i], pn = UL[3 * i + 1], e = UL[3 * i + 2], j = tid & 255;
            const int r = 256 * (tile - TB[e]) + j; int tok = 0;
            if (r < TE[e]) { int lo = 0, hi = 256;
                while (hi - lo > 1) { const int mid = (lo + hi) >> 1; if (PRE[e * 257 + mid] <= r) lo = mid; else hi = mid; }
                const int ent = SLOT_TOK[(e * 256 + lo) * 128 + (r - PRE[e * 257 + lo])]; tok = ent >> 1;
                if (pn == 0) TOK_S[ent] = 256 * tile + j; }
            rowtok[i * 256 + j] = tok; }
    }
    __syncthreads();
    return nunits;
}
struct MoeGU {
    const char* XBp; const char* W; LAS const int* UL; LAS const int* rowtok; int nunits;
    __device__ __forceinline__ bool next(int i, Unit& u) const { if (i >= nunits) return false;
        u.pm = __builtin_amdgcn_readfirstlane(UL[3 * i]); u.pn = __builtin_amdgcn_readfirstlane(UL[3 * i + 1]); u.e = __builtin_amdgcn_readfirstlane(UL[3 * i + 2]); u.ord = i;
        u.A = XBp; u.B = W + ((size_t)u.e * 1024 + (size_t)u.pn * 256) * D * 2; return true; }
    __device__ __forceinline__ unsigned a_off(const Unit& u, int h, int R, int C) const { return (unsigned)(rowtok[u.ord * 256 + R + HALF * h] * D + C) * 2u; }
};
struct MoeDown {
    const char* Hp; const char* W; LAS const int* UL; int nunits;
    __device__ __forceinline__ bool next(int i, Unit& u) const { if (i >= nunits) return false;
        u.pm = __builtin_amdgcn_readfirstlane(UL[3 * i]); u.pn = __builtin_amdgcn_readfirstlane(UL[3 * i + 1]); u.e = __builtin_amdgcn_readfirstlane(UL[3 * i + 2]); u.ord = i;
        u.A = Hp + (size_t)u.pm * BM * DEXP * 2; u.B = W + ((size_t)u.e * 1024 + (size_t)u.pn * 256) * DEXP * 2; return true; }
    __device__ __forceinline__ unsigned a_off(const Unit&, int h, int R, int C) const { return (unsigned)((R + HALF * h) * DEXP + C) * 2u; }
};
struct EpiGateUp { bf16* H;
    __device__ __forceinline__ void operator()(const f32x4 (&acc)[2][2][4][2], const Unit& u, int wr, int wc, int fr, int fq) const {
        bf16* rowp = H + (size_t)(u.pm * BM + wr * 64 + fr) * DEXP + (u.pn * 128 + wc * 32 + 8 * fq);
#pragma unroll
        for (int ai = 0; ai < 2; ++ai) {
#pragma unroll
            for (int m = 0; m < 4; ++m) { float hv[8];
#pragma unroll
                for (int n = 0; n < 2; ++n)
#pragma unroll
                    for (int j = 0; j < 4; ++j) { const float g = acc[ai][0][m][n][j], up = acc[ai][1][m][n][j]; hv[4 * n + j] = g * __builtin_amdgcn_rcpf(1.f + __expf(-g)) * up; }
                u32x4 w; w.x = cvt_pk_bf16(hv[0], hv[1]); w.y = cvt_pk_bf16(hv[2], hv[3]); w.z = cvt_pk_bf16(hv[4], hv[5]); w.w = cvt_pk_bf16(hv[6], hv[7]);
                *(u32x4*)rowp = w;
                rowp += (size_t)16 * DEXP; asm volatile("" : "+v"(rowp)); }
            rowp += (size_t)64 * DEXP; }
    } };
__device__ __forceinline__ int crow(int r, int hi) { return (r & 3) + 8 * (r >> 2) + 4 * hi; }
__device__ __forceinline__ unsigned cvtpk_s(float lo, float hi) { typedef float f2 __attribute__((ext_vector_type(2))); typedef __bf16 b2 __attribute__((ext_vector_type(2))); f2 v = {lo, hi}; b2 b = __builtin_convertvector(v, b2); return __builtin_bit_cast(unsigned, b); }
__device__ __forceinline__ float bfbits2f(unsigned short v) { return __uint_as_float(((unsigned)v) << 16); }

constexpr int AT_NSLOT = 4, AT_SLOT = 16640, AT_K = 0, AT_V = 8192, AT_KB = 16384, AT_WS = AT_NSLOT * AT_SLOT, AT_OST = AT_WS + 2048, AT_BYTES = AT_OST + 8 * 4096;
static_assert(AT_BYTES <= RING_BYTES, "attention LDS");
__device__ __forceinline__ void glds_asm16(const void* gsrc, unsigned lds_dst) { unsigned keep;
    asm volatile("s_mov_b32 %0, m0\n\ts_mov_b32 m0, %2\n\ts_nop 0\n\tglobal_load_lds_dwordx4 %1, off\n\ts_mov_b32 m0, %0" : "=&s"(keep) : "v"(gsrc), "s"(lds_dst) : "memory"); }
__device__ __forceinline__ void glds_asm4(const void* gsrc, unsigned lds_dst) { unsigned keep;
    asm volatile("s_mov_b32 %0, m0\n\ts_mov_b32 m0, %2\n\ts_nop 0\n\tglobal_load_lds_dword %1, off\n\ts_mov_b32 m0, %0" : "=&s"(keep) : "v"(gsrc), "s"(lds_dst) : "memory"); }
constexpr float AT_THR = 10.0f, AT_SKIP = 40.0f;
template <bool FOX>
__device__ __forceinline__ void attn_qk(const LAS unsigned char* slot, const bf16x8 (&qr)[4], float mref, f32x16& p0, f32x16& p1, int r32, int hi) {
    const LAS unsigned char* kb = slot + AT_K + hi * 1024 + r32 * 16; const LAS float* kbs = (const LAS float*)(slot + AT_KB);
    if (FOX) { const float nm = -mref;
#pragma unroll
        for (int g = 0; g < 4; ++g) { const f32x4 b0 = *(const LAS f32x4*)(kbs + 8 * g + 4 * hi), b1 = *(const LAS f32x4*)(kbs + 32 + 8 * g + 4 * hi);
#pragma unroll
            for (int j = 0; j < 4; ++j) { p0[4 * g + j] = __builtin_fmaf(b0[j], -LOG2E, nm); p1[4 * g + j] = __builtin_fmaf(b1[j], -LOG2E, nm); } }
    } else { p0 = f32x16{}; p1 = f32x16{}; }
#pragma unroll
    for (int d0 = 0; d0 < 4; ++d0) { const bf16x8 b0 = *(const LAS bf16x8*)(kb + d0 * 2048), b1 = *(const LAS bf16x8*)(kb + d0 * 2048 + 512);
        p0 = __builtin_amdgcn_mfma_f32_32x32x16_bf16(b0, qr[d0], p0, 0, 0, 0); p1 = __builtin_amdgcn_mfma_f32_32x32x16_bf16(b1, qr[d0], p1, 0, 0, 0); }
}
template <bool FOX>
__device__ __forceinline__ void attn_sm_pv(const LAS unsigned char* slot, f32x16& p0, f32x16& p1, f32x16& n0, f32x16& n1, bool has_next, f32x16 (&o)[2], float& mref, float& lrun, bool& started, LAS float* wsf, int vb0, int jb, int qrel, int r32, int hi) {
    if (FOX) {
        if (jb >= 0) { const int kbase = 64 * jb + 4 * hi;
#pragma unroll
            for (int r = 0; r < 16; ++r) { const int kv = kbase + (r & 3) + 8 * (r >> 2); if (kv > qrel) p0[r] = -INFINITY; if (kv + 32 > qrel) p1[r] = -INFINITY; } }
    } else { const float nm = -mref;
#pragma unroll
        for (int r = 0; r < 16; ++r) { p0[r] = __builtin_fmaf(p0[r], QC2, nm); p1[r] = __builtin_fmaf(p1[r], QC2, nm); }
    }
    float rm = __builtin_fmaxf(p0[0], p1[0]), rm2 = __builtin_fmaxf(p0[1], p1[1]);
#pragma unroll
    for (int r = 2; r < 16; r += 2) { rm = __builtin_fmaxf(__builtin_fmaxf(rm, p0[r]), p1[r]); rm2 = __builtin_fmaxf(__builtin_fmaxf(rm2, p0[r + 1]), p1[r + 1]); }
    rm = __builtin_fmaxf(rm, rm2);
    { auto rr = __builtin_amdgcn_permlane32_swap(__float_as_uint(rm), __float_as_uint(rm), false, false); rm = fmaxf(__uint_as_float(rr[0]), __uint_as_float(rr[1])); }
    const bool live = rm > -1e30f, move = (rm > AT_THR) || (!started && live);
    started = started || live;
    if (__builtin_expect(__any(move), 0)) {
        const float dl = move ? rm : 0.f, f = __builtin_amdgcn_exp2f(fminf(-dl, 64.f));
        mref += dl; lrun *= f;
#pragma unroll
        for (int r = 0; r < 16; ++r) { p0[r] -= dl; p1[r] -= dl; }
        if (FOX && has_next) {
#pragma unroll
            for (int r = 0; r < 16; ++r) { n0[r] -= dl; n1[r] -= dl; } }
        if (hi == 0) wsf[r32] = f;
        asm volatile("s_waitcnt lgkmcnt(0)" ::: "memory");
#pragma unroll
        for (int g = 0; g < 4; ++g) { const f32x4 a = *(const LAS f32x4*)(wsf + 8 * g + 4 * hi);
#pragma unroll
            for (int j = 0; j < 4; ++j) { o[0][4 * g + j] *= a[j]; o[1][4 * g + j] *= a[j]; } }
    }
    float rs = 0.f;
#pragma unroll
    for (int r = 0; r < 16; ++r) { p0[r] = __builtin_amdgcn_exp2f(p0[r]); p1[r] = __builtin_amdgcn_exp2f(p1[r]); rs += p0[r] + p1[r]; }
    lrun += rs;
    u32x4 pw[4];
#pragma unroll
    for (int k = 0; k < 2; ++k) {
        pw[k] = (u32x4){cvtpk_s(p0[8 * k], p0[8 * k + 1]), cvtpk_s(p0[8 * k + 2], p0[8 * k + 3]), cvtpk_s(p0[8 * k + 4], p0[8 * k + 5]), cvtpk_s(p0[8 * k + 6], p0[8 * k + 7])};
        pw[2 + k] = (u32x4){cvtpk_s(p1[8 * k], p1[8 * k + 1]), cvtpk_s(p1[8 * k + 2], p1[8 * k + 3]), cvtpk_s(p1[8 * k + 4], p1[8 * k + 5]), cvtpk_s(p1[8 * k + 6], p1[8 * k + 7])}; }
    const int vb = vb0 + (int)(unsigned)(size_t)slot;
    s16x4 vlo[2][4], vhi[2][4];
#pragma unroll
    for (int d0 = 0; d0 < 2; ++d0) {
#pragma unroll
        for (int ks = 0; ks < 4; ++ks) {
            asm volatile("ds_read_b64_tr_b16 %0,%1 offset:%c2" : "=&v"(vlo[d0][ks]) : "v"(vb), "i"(d0 * 4096 + ks * 1024) : "memory");
            asm volatile("ds_read_b64_tr_b16 %0,%1 offset:%c2" : "=&v"(vhi[d0][ks]) : "v"(vb), "i"(d0 * 4096 + ks * 1024 + 512) : "memory"); } }
#pragma unroll
    for (int d0 = 0; d0 < 2; ++d0) {
        if (d0 == 0) asm volatile("s_waitcnt lgkmcnt(8)" : "+v"(vlo[0][0]), "+v"(vlo[0][1]), "+v"(vlo[0][2]), "+v"(vlo[0][3]), "+v"(vhi[0][0]), "+v"(vhi[0][1]), "+v"(vhi[0][2]), "+v"(vhi[0][3]) :: "memory");
        else asm volatile("s_waitcnt lgkmcnt(0)" : "+v"(vlo[1][0]), "+v"(vlo[1][1]), "+v"(vlo[1][2]), "+v"(vlo[1][3]), "+v"(vhi[1][0]), "+v"(vhi[1][1]), "+v"(vhi[1][2]), "+v"(vhi[1][3]) :: "memory");
        __builtin_amdgcn_sched_barrier(0);
#pragma unroll
        for (int ks = 0; ks < 4; ++ks) { const bf16x8 vf = (bf16x8){vlo[d0][ks][0], vlo[d0][ks][1], vlo[d0][ks][2], vlo[d0][ks][3], vhi[d0][ks][0], vhi[d0][ks][1], vhi[d0][ks][2], vhi[d0][ks][3]};
            o[d0] = __builtin_amdgcn_mfma_f32_32x32x16_bf16(__builtin_bit_cast(bf16x8, pw[ks]), vf, o[d0], 0, 0, 0); }
    }
}
template <bool FOX>
__device__ __forceinline__ void attn_unit(LAS unsigned char* lds, const bf16* Qp, int qpitch, const bf16* Kp, const bf16* Vp, int kvpitch, int NT, const float* cum, float qk_bound, bf16* Op, int opitch, const bf16* OGp, int gpitch, const int wave_s) {
    const int tid = fresh_tid(wave_s), lane = tid & 63, wid = wave_s, r32 = lane & 31, hi = lane >> 5; const int bid = blockIdx.x;
    LAS float* wsf = (LAS float*)(lds + AT_WS) + wid * 64;
    bf16x8 qr[4];
#pragma unroll
    for (int d0 = 0; d0 < 4; ++d0) qr[d0] = *(const bf16x8*)(Qp + (size_t)(wid * 32 + r32) * qpitch + d0 * 16 + hi * 8);
    const bf16* ksrc = Kp + (size_t)lane * kvpitch + wid * 8;
    const bf16* vsrc = Vp + (size_t)(16 * (wid & 3) + (lane >> 2)) * kvpitch + (wid >> 2) * 32 + (lane & 3) * 8;
    const int vb0 = AT_V + ((lane >> 4) & 1) * 32 + (lane & 3) * 8 + (4 * hi + ((lane & 15) >> 2)) * 64;
    float mref = 0.f, lrun = 0.f; bool started = false; f32x16 o[2]; o[0] = f32x16{}; o[1] = f32x16{};
    const int NTF = NT;
    if (FOX) { int i0 = NTF * 64 - 256; asm volatile("" : "+v"(i0));
        const float c0 = cum[i0], cl = cum[(lane < NTF ? lane : NTF - 1) * 64 + 63];
        const bool need = (lane < NTF) && ((c0 - cl) * LOG2E + 2.f * qk_bound >= -AT_SKIP);
        const int cnt = __builtin_popcountll(__ballot(need)); NT = cnt < 4 ? 4 : ((cnt + 1) & ~1); if (NT > NTF) NT = NTF; }
    const int qrel = wid * 32 + r32; const size_t tstep = (size_t)64 * kvpitch;
    constexpr int ND = FOX ? 3 : 2;
#define AT_TILE(tt) (FOX ? NTF - 1 - (tt) : (tt))
#define AT_ISSUE(tt) do { const unsigned sl_ = ldsb + (unsigned)(((tt) & (AT_NSLOT - 1)) * AT_SLOT); const int kt_ = AT_TILE(tt); \
        glds_asm16(ksrc + (size_t)kt_ * tstep, (unsigned)__builtin_amdgcn_readfirstlane(sl_ + AT_K + wid * 1024)); \
        glds_asm16(vsrc + (size_t)kt_ * tstep, (unsigned)__builtin_amdgcn_readfirstlane(sl_ + AT_V + wid * 1024)); \
        if (FOX) glds_asm4(cum + kt_ * 64 + lane, (unsigned)__builtin_amdgcn_readfirstlane(sl_ + AT_KB)); } while (0)
    const unsigned ldsb = (unsigned)(size_t)lds;
    AT_ISSUE(0); AT_ISSUE(1); AT_ISSUE(2);
#define AT_WAIT1() do { if (FOX) asm volatile("s_waitcnt vmcnt(3)" ::: "memory"); else asm volatile("s_waitcnt vmcnt(2)" ::: "memory"); } while (0)
#define AT_SLOTP(tt) (lds + ((tt) & (AT_NSLOT - 1)) * AT_SLOT)
#define AT_STEP(PC0, PC1, PN0, PN1, tt) do { const int t_ = (tt); const bool hn_ = t_ + 1 < NT; \
        { PSEC_BEGIN(10); if (t_ + 2 < NT) AT_WAIT1(); else asm volatile("s_waitcnt vmcnt(0)" ::: "memory"); \
        __builtin_amdgcn_s_barrier(); asm volatile("" ::: "memory"); PSEC_END(10); } \
        { PSEC_BEGIN(11); if (t_ + 3 < NT) AT_ISSUE(t_ + 3); PSEC_END(11); } \
        { PSEC_BEGIN(12); if (hn_) attn_qk<FOX>(AT_SLOTP(t_ + 1), qr, mref, PN0, PN1, r32, hi); PSEC_END(12); } \
        { PSEC_BEGIN(13); attn_sm_pv<FOX>(AT_SLOTP(t_), PC0, PC1, PN0, PN1, hn_, o, mref, lrun, started, wsf, vb0, AT_TILE(t_) - (NTF - 4), qrel, r32, hi); PSEC_END(13); } } while (0)
    f32x16 a0, a1, b0, b1;
    if (FOX) asm volatile("s_waitcnt vmcnt(6)" ::: "memory"); else asm volatile("s_waitcnt vmcnt(4)" ::: "memory");
    __builtin_amdgcn_s_barrier(); asm volatile("" ::: "memory");
    attn_qk<FOX>(AT_SLOTP(0), qr, mref, a0, a1, r32, hi);
#pragma unroll 1
    for (int t = 0; t < NT; t += 2) { AT_STEP(a0, a1, b0, b1, t); AT_STEP(b0, b1, a0, a1, t + 1); }
#undef AT_STEP
#undef AT_WAIT1
#undef AT_SLOTP
#undef AT_ISSUE
#undef AT_TILE
    static_assert(ND == 3 || ND == 2, "");
    { auto rr = __builtin_amdgcn_permlane32_swap(__float_as_uint(lrun), __float_as_uint(lrun), false, false); lrun = __uint_as_float(rr[0]) + __uint_as_float(rr[1]); }
    if (hi == 0) wsf[32 + r32] = lrun;
    asm volatile("s_waitcnt lgkmcnt(0)" ::: "memory");
    LAS bf16* stg = (LAS bf16*)(lds + AT_OST) + wid * 2048;
#pragma unroll
    for (int r = 0; r < 16; ++r) { const int orow = crow(r, hi); const float rl = __builtin_amdgcn_rcpf(wsf[32 + orow]);
#pragma unroll
        for (int d0 = 0; d0 < 2; ++d0) stg[orow * 64 + d0 * 32 + r32] = f2bf(o[d0][r] * rl); }
    asm volatile("s_waitcnt lgkmcnt(0)" ::: "memory");
#pragma unroll
    for (int i = 0; i < 4; ++i) { const int row = i * 8 + (lane >> 3), ch = lane & 7; u32x4 v = *(const LAS u32x4*)(stg + row * 64 + ch * 8);
        const size_t go = (size_t)(wid * 32 + row) * opitch + ch * 8;
        if (FOX) { const u32x4 g = *(const u32x4*)(OGp + (size_t)(wid * 32 + row) * gpitch + ch * 8); unsigned vv[4] = {v.x, v.y, v.z, v.w}; const unsigned gg[4] = {g.x, g.y, g.z, g.w};
#pragma unroll
            for (int k = 0; k < 4; ++k) { const float a0 = __uint_as_float(vv[k] << 16), a1 = __uint_as_float(vv[k] & 0xffff0000u), g0 = __uint_as_float(gg[k] << 16), g1 = __uint_as_float(gg[k] & 0xffff0000u);
                vv[k] = cvtpk_s(a0 * __builtin_amdgcn_rcpf(1.f + __expf(-g0)), a1 * __builtin_amdgcn_rcpf(1.f + __expf(-g1))); }
            v = (u32x4){vv[0], vv[1], vv[2], vv[3]}; }
        *(u32x4*)(Op + go) = v; }
    __syncthreads();
}
constexpr int CW_Q11 = 1024;
__device__ __forceinline__ float wave_max64(float v) {
    v = fmaxf(v, dppf<0xB1>(v)); v = fmaxf(v, dppf<0x4E>(v)); v = fmaxf(v, dppf<0x141>(v)); v = fmaxf(v, dppf<0x140>(v));
    { auto r = __builtin_amdgcn_permlane16_swap(__float_as_uint(v), __float_as_uint(v), false, false); v = fmaxf(__uint_as_float(r[0]), __uint_as_float(r[1])); }
    { auto r = __builtin_amdgcn_permlane32_swap(__float_as_uint(v), __float_as_uint(v), false, false); v = fmaxf(__uint_as_float(r[0]), __uint_as_float(r[1])); }
    return v;
}
__device__ __forceinline__ void phase_attn_b(KP p, LAS unsigned char* lds, const int wave_s) {
    unsigned char* ws = p->ws;
    const bf16* Q = (const bf16*)(ws + WS_HREG); const bf16* K = (const bf16*)(ws + WS_HREG + HR_48); const bf16* V = (const bf16*)(ws + WS_HREG + 2 * HR_48); const bf16* OG = (const bf16*)(ws + WS_HREG + 3 * HR_48);
    const bf16* MQ = (const bf16*)(ws + WS_HREG + 4 * HR_48); const bf16* MKV = (const bf16*)(ws + WS_MKV);
    const float* CUM = (const float*)(ws + WS_CUM); bf16* OC = (bf16*)(ws + WS_GREG);
    unsigned* qhead = (unsigned*)(ws + WS_CTL) + CW_Q11;
    volatile LAS unsigned* slotw = (volatile LAS unsigned*)(lds + MISC_OFF) + 48;
    float qkb; { const int lane = fresh_lane(); const float gq = wave_max64(fabsf(p->in[I_QNG][lane])), gk = wave_max64(fabsf(p->in[I_KNG][lane])); qkb = 64.f * gq * gk * QC2 * 1.02f; }
    for (;;) {
        if (fresh_tid(wave_s) == 0) slotw[0] = __hip_atomic_fetch_add(qhead, 1u, __ATOMIC_RELAXED, __HIP_MEMORY_SCOPE_AGENT);
        __syncthreads();
        const int u = (int)__builtin_amdgcn_readfirstlane(slotw[0]);
        if (u >= 1536 + 512) break;
        if (u < 1536) { const int qb = 15 - u / 96, bh = u % 96, b = bh / FOX_H, h = bh % FOX_H; const size_t row0 = (size_t)b * SEQ;
            attn_unit<true>(lds, Q + (row0 + qb * 256) * 768 + h * 64, 768, K + row0 * 768 + h * 64, V + row0 * 768 + h * 64, 768, 4 * (qb + 1), CUM + (size_t)bh * SEQ, qkb,
                            OC + (row0 + qb * 256) * D + h * 64, D, OG + (row0 + qb * 256) * 768 + h * 64, 768, wave_s); }
        else { const int m = u - 1536, b = m >> 6, hd = (m >> 4) & 3, qblk = m & 15; const size_t row0 = (size_t)b * SEQ + qblk * 256;
            const bf16* Kp = MKV + (size_t)b * NMEM * 1024 + 512 + hd * 64;
            attn_unit<false>(lds, MQ + row0 * 256 + hd * 64, 256, Kp, Kp + 256, 1024, 4, nullptr, 0.f, OC + row0 * D + 768 + hd * 64, D, nullptr, 0, wave_s); }
    }
}
__device__ __forceinline__ void phase_attn_mem(unsigned char* ws, LAS unsigned char* lds, int layer, int G, int bid, const int wave_s) {
    const bf16* MQ = (const bf16*)(ws + WS_HREG + (layer == 0 ? 3 : 4) * HR_48); const bf16* MKV = (const bf16*)(ws + WS_MKV); bf16* OC = (bf16*)(ws + (layer == 0 ? WS_XB : WS_GREG));
    for (int u = bid; u < 512; u += G) { const int b = u >> 6, hd = (u >> 4) & 3, qblk = u & 15; const size_t row0 = (size_t)b * SEQ + qblk * 256;
        const bf16* Kp = MKV + (size_t)b * NMEM * 1024 + layer * 512 + hd * 64;
        attn_unit<false>(lds, MQ + row0 * 256 + hd * 64, 256, Kp, Kp + 256, 1024, 4, nullptr, 0.f, OC + row0 * D + 768 + hd * 64, D, nullptr, 0, wave_s); }
}
constexpr int GL_QP = 208, GL_VP = 448, GL_KX = 0, GL_QD = 13312, GL_VT = 26624, GL_HEAD = 55296;
constexpr int GL_GLR = 2 * GL_HEAD, GL_TOT = GL_GLR + 4096, GL_SSX = GL_TOT + 1536, GL_BYTES = GL_SSX + 1024;
static_assert(GL_BYTES <= RING_BYTES, "GLA LDS");
typedef short v4i16_t __attribute__((ext_vector_type(4)));
typedef float f32x2 __attribute__((ext_vector_type(2)));
__device__ __forceinline__ s16x4 trd(const LAS unsigned char* p) { return __builtin_bit_cast(s16x4, __builtin_amdgcn_ds_read_tr16_b64_v4i16((LAS v4i16_t*)p)); }
__device__ __forceinline__ float fast_log_sigmoid(float z) { return fminf(z, 0.f) - __logf(1.f + __expf(-fabsf(z))); }

template <int MODE> struct GlaRegs { u32x4 v[6]; u32x4 qk[MODE == 1 ? 6 : 3]; f32x4 g; };
template <int MODE>
__device__ __forceinline__ void gla_fetch(unsigned char* ws, int tid, int unit, GlaRegs<MODE>& R) {
    const int hp = unit & 1, n = (unit >> 1) & 63, b = unit >> 7;
    const bf16* V = (const bf16*)(ws + WS_HREG + HR_48); const float* GLR = (const float*)(ws + WS_GLR); const bf16* QK = (const bf16*)(ws + WS_HREG);
    const size_t m0 = (size_t)b * SEQ + n * 64;
#pragma unroll
    for (int i = 0; i < 6; ++i) { const int pi = tid + 512 * i, u = pi / 1536, rem = pi % 1536, row = rem / 24, ch = rem % 24;
        R.v[i] = *(const u32x4*)(V + (m0 + row) * 768 + 192 * (2 * hp + u) + 8 * ch); }
#pragma unroll
    for (int i = 0; i < (MODE == 1 ? 6 : 3); ++i) { const int pi = tid + 512 * i, ts = pi / 1536, rem = pi % 1536, u = rem / 768, r2 = rem % 768, row = r2 / 12, ch = r2 % 12;
        R.qk[i] = *(const u32x4*)(QK + (m0 + row) * 768 + (ts == 0 ? 384 : 0) + 96 * (2 * hp + u) + 8 * ch); }
    if (tid < 256) R.g = *(const f32x4*)(GLR + m0 * 16 + 4 * tid);
}
template <int MODE>
__device__ __forceinline__ void gla_put(LAS unsigned char* lds, int tid, const GlaRegs<MODE>& R) {
#pragma unroll
    for (int i = 0; i < 6; ++i) { const int pi = tid + 512 * i, u = pi / 1536, rem = pi % 1536, row = rem / 24, ch = rem % 24;
        *(LAS u32x4*)(lds + u * GL_HEAD + GL_VT + row * GL_VP + ch * 16) = R.v[i]; }
#pragma unroll
    for (int i = 0; i < (MODE == 1 ? 6 : 3); ++i) { const int pi = tid + 512 * i, ts = pi / 1536, rem = pi % 1536, u = rem / 768, r2 = rem % 768, row = r2 / 12, ch = r2 % 12;
        *(LAS u32x4*)(lds + u * GL_HEAD + (ts == 0 ? GL_KX : GL_QD) + row * GL_QP + ch * 16) = R.qk[i]; }
    if (tid < 256) *(LAS f32x4*)(lds + GL_GLR + 16 * tid) = R.g;
}
template <int MODE>
__device__ __forceinline__ void gla_gates(KP p, unsigned char* ws, LAS unsigned char* lds, int tid, int b, int n, int hp) {
    float* DEC = (float*)(ws + WS_DEC);
    const size_t m0 = (size_t)b * SEQ + n * 64;
    LAS float* glr = (LAS float*)(lds + GL_GLR); LAS float* totl = (LAS float*)(lds + GL_TOT);
    float la[32]; float tot = 0.f; int col = 0, th = 0, u = 0, kidx = 0, head = 0;
    if (tid < 384) { col = tid % 192; th = tid / 192; u = col / 96; kidx = col % 96; head = 2 * hp + u;
        float w[16];
#pragma unroll
        for (int j = 0; j < 16; ++j) w[j] = p->in[I_WGUP][j * 384 + 96 * head + kidx];
        const float bg = p->in[I_BGATE][96 * head + kidx];
#pragma unroll
        for (int i = 0; i < 32; i += 2) { const LAS float* gr = glr + (32 * th + i) * 16; f32x2 z = (f32x2){bg, bg};
#pragma unroll
            for (int j4 = 0; j4 < 4; ++j4) { const f32x4 g0 = *(const LAS f32x4*)(gr + 4 * j4), g1 = *(const LAS f32x4*)(gr + 16 + 4 * j4);
#pragma unroll
                for (int k = 0; k < 4; ++k) z = (f32x2){g0[k], g1[k]} * w[4 * j4 + k] + z; }
            la[i] = fast_log_sigmoid(z[0]) * (1.f / 16.f); la[i + 1] = fast_log_sigmoid(z[1]) * (1.f / 16.f); tot += la[i] + la[i + 1]; }
        totl[th * 192 + col] = tot; }
    __syncthreads();
    if (tid < 384) {
        LAS bf16* KX = (LAS bf16*)(lds + u * GL_HEAD + GL_KX); LAS bf16* QD = (LAS bf16*)(lds + u * GL_HEAD + GL_QD);
        if (MODE == 0) {
            float run = (th == 1) ? 0.f : totl[192 + col];
            float kraw[32];
#pragma unroll
            for (int i = 0; i < 32; ++i) kraw[i] = bf2f(KX[(32 * th + i) * (GL_QP / 2) + kidx]);
#pragma unroll
            for (int i = 31; i >= 0; --i) { KX[(32 * th + i) * (GL_QP / 2) + kidx] = f2bf(kraw[i] * __expf(run)); run += la[i]; }
            if (th == 0) DEC[(((size_t)b * 64 + n) * 4 + head) * 96 + kidx] = __expf(run);
        } else {
            float run = (th == 0) ? 0.f : totl[col];
            float qraw[32], kraw[32];
#pragma unroll
            for (int i = 0; i < 32; ++i) { qraw[i] = bf2f(QD[(32 * th + i) * (GL_QP / 2) + kidx]); kraw[i] = bf2f(KX[(32 * th + i) * (GL_QP / 2) + kidx]); }
#pragma unroll
            for (int i = 0; i < 32; ++i) { run += la[i]; const unsigned pk = cvt_pk_bf16(qraw[i] * __expf(run) * 0.10206207261596577f, kraw[i] * __expf(-run));
                QD[(32 * th + i) * (GL_QP / 2) + kidx] = (bf16)(pk & 0xffffu); KX[(32 * th + i) * (GL_QP / 2) + kidx] = (bf16)(pk >> 16); }
        }
    }
    __syncthreads();
}
__device__ __forceinline__ void phase_gla_kv(KP p, LAS unsigned char* lds, int G, int bid, const int wave_s) {
    unsigned char* ws = p->ws; bf16* SKV = (bf16*)(ws + WS_GREG);
    GlaRegs<0> R;
    if (bid < NB * 64 * 2) gla_fetch<0>(ws, fresh_tid(wave_s), bid, R);
    for (int unit = bid; unit < NB * 64 * 2; unit += G) {
        const int tid = fresh_tid(wave_s), lane = tid & 63, wid = wave_s;
        const int hp = unit & 1, n = (unit >> 1) & 63, b = unit >> 7;
        { PSEC_BEGIN(40); gla_put<0>(lds, tid, R);
        __syncthreads(); PSEC_END(40); }
        if (unit + G < NB * 64 * 2) gla_fetch<0>(ws, tid, unit + G, R);
        { PSEC_BEGIN(41); gla_gates<0>(p, ws, lds, tid, b, n, hp); PSEC_END(41); }
        PSEC_BEGIN(42);
        const int u = wid >> 2, j4 = wid & 3, head = 2 * hp + u, r32 = lane & 31, h2 = lane >> 5, q = (lane & 15) >> 2, pp = lane & 3, g1 = (lane >> 4) & 1;
        const LAS unsigned char* ka = lds + u * GL_HEAD + GL_KX + (8 * h2 + q) * GL_QP + (16 * g1 + 4 * pp) * 2;
        const LAS unsigned char* va = lds + u * GL_HEAD + GL_VT + (8 * h2 + q) * GL_VP + (16 * g1 + 4 * pp) * 2;
        bf16* outb = SKV + ((((size_t)b * 64 + n) * 4 + head) * 192) * 96;
        for (int id = j4; id < 18; id += 4) { const int kb = id / 6, cb = id % 6;
            f32x16 acc = f32x16{};
#pragma unroll
            for (int ks = 0; ks < 4; ++ks) {
                const s16x4 a0 = trd(ka + ks * 16 * GL_QP + kb * 64), a1 = trd(ka + ks * 16 * GL_QP + 4 * GL_QP + kb * 64);
                const s16x4 b0 = trd(va + ks * 16 * GL_VP + cb * 64), b1 = trd(va + ks * 16 * GL_VP + 4 * GL_VP + cb * 64);
                acc = __builtin_amdgcn_mfma_f32_32x32x16_bf16((bf16x8){a0[0], a0[1], a0[2], a0[3], a1[0], a1[1], a1[2], a1[3]}, (bf16x8){b0[0], b0[1], b0[2], b0[3], b1[0], b1[1], b1[2], b1[3]}, acc, 0, 0, 0); }
            bf16* op = outb + (size_t)(32 * cb + r32) * 96 + 32 * kb + 4 * h2;
#pragma unroll
            for (int g = 0; g < 4; ++g) { u32x2 w; w.x = cvtpk_s(acc[4 * g], acc[4 * g + 1]); w.y = cvtpk_s(acc[4 * g + 2], acc[4 * g + 3]); *(u32x2*)(op + 8 * g) = w; }
        }
        __syncthreads();
        PSEC_END(42);
    }
}
__device__ __forceinline__ void phase_gla_scan(unsigned char* ws, int G, int bid, const int wave_s) {
    bf16* SKV = (bf16*)(ws + WS_GREG); const float* DEC = (const float*)(ws + WS_DEC);
    const int tid = fresh_tid(wave_s);
    constexpr int NITEM = NB * 4 * 192 * 12;
    const int per = (NITEM + G - 1) / G;
    for (int it = tid; it < per; it += NTHREADS) { const int item = bid * per + it; if (item >= NITEM) break;
        const int k8 = item % 12, c = (item / 12) % 192, bh = item / (12 * 192), b = bh >> 2, h = bh & 3;
        float s[8];
#pragma unroll
        for (int j = 0; j < 8; ++j) s[j] = 0.f;
        u32x4* ptr = (u32x4*)(SKV + ((((size_t)b * 64) * 4 + h) * 192 + c) * 96 + 8 * k8); const float* dp = DEC + (((size_t)b * 64) * 4 + h) * 96 + 8 * k8;
#pragma unroll 1
        for (int n0 = 0; n0 < 64; n0 += 8) { u32x4 kv[8]; f32x4 d0[8], d1[8];
#pragma unroll
            for (int i = 0; i < 8; ++i) { kv[i] = ptr[(size_t)(n0 + i) * (4 * 192 * 96 / 8)]; d0[i] = *(const f32x4*)(dp + (size_t)(n0 + i) * 4 * 96); d1[i] = *(const f32x4*)(dp + (size_t)(n0 + i) * 4 * 96 + 4); }
#pragma unroll
            for (int i = 0; i < 8; ++i) { u32x4 o; o.x = cvtpk_s(s[0], s[1]); o.y = cvtpk_s(s[2], s[3]); o.z = cvtpk_s(s[4], s[5]); o.w = cvtpk_s(s[6], s[7]); ptr[(size_t)(n0 + i) * (4 * 192 * 96 / 8)] = o;
                const unsigned kw[4] = {kv[i].x, kv[i].y, kv[i].z, kv[i].w};
#pragma unroll
                for (int j = 0; j < 4; ++j) { const float dlo = j < 2 ? d0[i][2 * j] : d1[i][2 * j - 4], dhi = j < 2 ? d0[i][2 * j + 1] : d1[i][2 * j - 3];
                    s[2 * j] = dlo * s[2 * j] + __uint_as_float(kw[j] << 16); s[2 * j + 1] = dhi * s[2 * j + 1] + __uint_as_float(kw[j] & 0xffff0000u); } } }
    }
}
__device__ __forceinline__ void phase_gla_out(KP p, LAS unsigned char* lds, int G, int bid, const int wave_s) {
    unsigned char* ws = p->ws; const bf16* SKV = (const bf16*)(ws + WS_GREG); const bf16* R = (const bf16*)(ws + WS_HREG + 2 * HR_48); bf16* OC = (bf16*)(ws + WS_XB);
    GlaRegs<1> RG;
    if (bid < NB * 64 * 2) gla_fetch<1>(ws, fresh_tid(wave_s), bid, RG);
    for (int unit = bid; unit < NB * 64 * 2; unit += G) {
        const int tid = fresh_tid(wave_s), lane = tid & 63, wid = wave_s;
        const int hp = unit & 1, n = (unit >> 1) & 63, b = unit >> 7;
        u32x2 rv12[12];
        { const int tb_ = wid & 1, ch_ = (wid >> 1) & 1, head_ = 2 * hp + (wid >> 2); const size_t m_ = (size_t)b * SEQ + n * 64 + 32 * tb_ + (lane & 31);
          const bf16* rp_ = R + m_ * 768 + 192 * head_ + 96 * ch_ + 4 * (lane >> 5);
#pragma unroll
          for (int q = 0; q < 12; ++q) rv12[q] = *(const u32x2*)(rp_ + 32 * (q >> 2) + 8 * (q & 3)); }
        { PSEC_BEGIN(30); gla_put<1>(lds, tid, RG);
        __syncthreads(); PSEC_END(30); }
        if (unit + G < NB * 64 * 2) gla_fetch<1>(ws, tid, unit + G, RG);
        { PSEC_BEGIN(31); gla_gates<1>(p, ws, lds, tid, b, n, hp); PSEC_END(31); }
        PSEC_BEGIN(32);
        const int u = wid >> 2, tb = wid & 1, ch = (wid >> 1) & 1, head = 2 * hp + u, r32 = lane & 31, h2 = lane >> 5, q = (lane & 15) >> 2, pp = lane & 3, g1 = (lane >> 4) & 1;
        const LAS unsigned char* kx = lds + u * GL_HEAD + GL_KX + r32 * GL_QP + 16 * h2;
        const LAS unsigned char* qd = lds + u * GL_HEAD + GL_QD + (32 * tb + r32) * GL_QP + 16 * h2;
        const LAS unsigned char* va = lds + u * GL_HEAD + GL_VT + (4 * h2 + q) * GL_VP + (16 * g1 + 4 * pp) * 2;
        bf16x8 qf[6];
#pragma unroll
        for (int ks = 0; ks < 6; ++ks) qf[ks] = *(const LAS bf16x8*)(qd + 32 * ks);
        f32x16 at0 = f32x16{}, at1 = f32x16{};
#pragma unroll
        for (int ks = 0; ks < 6; ++ks) at0 = __builtin_amdgcn_mfma_f32_32x32x16_bf16(*(const LAS bf16x8*)(kx + 32 * ks), qf[ks], at0, 0, 0, 0);
        if (tb == 1) {
#pragma unroll
            for (int ks = 0; ks < 6; ++ks) at1 = __builtin_amdgcn_mfma_f32_32x32x16_bf16(*(const LAS bf16x8*)(kx + 32 * GL_QP + 32 * ks), qf[ks], at1, 0, 0, 0);
        }
#pragma unroll
        for (int r = 0; r < 16; ++r) { const bool keep = crow(r, h2) <= r32; if (tb == 0) { if (!keep) at0[r] = 0.f; } else { if (!keep) at1[r] = 0.f; } }
        bf16x8 pb[4];
#pragma unroll
        for (int k2 = 0; k2 < 2; ++k2) {
            pb[k2] = __builtin_bit_cast(bf16x8, (u32x4){cvtpk_s(at0[8 * k2], at0[8 * k2 + 1]), cvtpk_s(at0[8 * k2 + 2], at0[8 * k2 + 3]), cvtpk_s(at0[8 * k2 + 4], at0[8 * k2 + 5]), cvtpk_s(at0[8 * k2 + 6], at0[8 * k2 + 7])});
            pb[2 + k2] = __builtin_bit_cast(bf16x8, (u32x4){cvtpk_s(at1[8 * k2], at1[8 * k2 + 1]), cvtpk_s(at1[8 * k2 + 2], at1[8 * k2 + 3]), cvtpk_s(at1[8 * k2 + 4], at1[8 * k2 + 5]), cvtpk_s(at1[8 * k2 + 6], at1[8 * k2 + 7])}); }
        const bf16* sg = SKV + ((((size_t)b * 64 + n) * 4 + head) * 192 + 96 * ch + r32) * 96 + 8 * h2;
        f32x16 o[3];
#pragma unroll
        for (int cbl = 0; cbl < 3; ++cbl) { const int cb = 3 * ch + cbl; f32x16 acc = f32x16{};
#pragma unroll
            for (int kq = 0; kq < 4; ++kq) { if (kq < 2 || tb == 1) {
                const s16x4 a0 = trd(va + kq * 16 * GL_VP + cb * 64), a1 = trd(va + kq * 16 * GL_VP + 8 * GL_VP + cb * 64);
                acc = __builtin_amdgcn_mfma_f32_32x32x16_bf16((bf16x8){a0[0], a0[1], a0[2], a0[3], a1[0], a1[1], a1[2], a1[3]}, pb[kq], acc, 0, 0, 0); } }
#pragma unroll
            for (int ks = 0; ks < 6; ++ks) { const bf16x8 sf = *(const bf16x8*)(sg + (size_t)(32 * cbl) * 96 + 16 * ks);
                acc = __builtin_amdgcn_mfma_f32_32x32x16_bf16(sf, qf[ks], acc, 0, 0, 0); }
            o[cbl] = acc; }
        asm volatile("" : "+v"(o[0]), "+v"(o[1]), "+v"(o[2])); PSEC_END(32);
        PSEC_BEGIN(33);
        float ss = 0.f;
#pragma unroll
        for (int cbl = 0; cbl < 3; ++cbl)
#pragma unroll
            for (int r = 0; r < 16; ++r) ss += o[cbl][r] * o[cbl][r];
        { auto rr = __builtin_amdgcn_permlane32_swap(__float_as_uint(ss), __float_as_uint(ss), false, false); ss = __uint_as_float(rr[0]) + __uint_as_float(rr[1]); }
        LAS float* ssx = (LAS float*)(lds + GL_SSX);
        if (h2 == 0) ssx[((u * 2 + tb) * 2 + ch) * 32 + r32] = ss;
        __syncthreads();
        ss += ssx[((u * 2 + tb) * 2 + (ch ^ 1)) * 32 + r32];
        const float rs = rsqrtf(ss * (1.f / 192.f) + RMS_EPS);
        const size_t m = (size_t)b * SEQ + n * 64 + 32 * tb + r32;
        bf16* op = OC + m * D + 192 * head + 96 * ch + 4 * h2; const float* gp = p->in[I_GLAG] + 96 * ch + 4 * h2;
#pragma unroll
        for (int cbl = 0; cbl < 3; ++cbl)
#pragma unroll
            for (int g = 0; g < 4; ++g) { const int co = 32 * cbl + 8 * g; const u32x2 rv = rv12[4 * cbl + g]; const f32x4 gn = *(const f32x4*)(gp + co);
                const float r0 = __uint_as_float(rv.x << 16), r1 = __uint_as_float(rv.x & 0xffff0000u), r2 = __uint_as_float(rv.y << 16), r3 = __uint_as_float(rv.y & 0xffff0000u);
                const float v0 = o[cbl][4 * g] * rs * gn[0] * (r0 * __builtin_amdgcn_rcpf(1.f + __expf(-r0))), v1 = o[cbl][4 * g + 1] * rs * gn[1] * (r1 * __builtin_amdgcn_rcpf(1.f + __expf(-r1)));
                const float v2 = o[cbl][4 * g + 2] * rs * gn[2] * (r2 * __builtin_amdgcn_rcpf(1.f + __expf(-r2))), v3 = o[cbl][4 * g + 3] * rs * gn[3] * (r3 * __builtin_amdgcn_rcpf(1.f + __expf(-r3)));
                u32x2 w; w.x = cvtpk_s(v0, v1); w.y = cvtpk_s(v2, v3); *(u32x2*)(op + co) = w; }
        __syncthreads();
        PSEC_END(33);
    }
}
constexpr int PROBE_J = -1, PROBE_B = 0, PROBE_K = 4;
__global__ void __launch_bounds__(NTHREADS, 2) mega(Params p_unused) {
    extern __shared__ __attribute__((aligned(16))) unsigned char lds_raw[];
    LAS unsigned char* lds = (LAS unsigned char*)lds_raw;
    const int G = gridDim.x, bid = blockIdx.x; const int wave_s = __builtin_amdgcn_readfirstlane(threadIdx.x >> 6);
    volatile LAS unsigned* MISC = (volatile LAS unsigned*)(lds + MISC_OFF);
    if (threadIdx.x < 64) MISC[threadIdx.x] = 0u;
    __syncthreads();
    KP p = fresh_kp();
    unsigned char* ws = p->ws;
    volatile LAS unsigned* STAMPS = (volatile LAS unsigned*)(lds + ROWTOK_OFF + 6144);
    if (PROBE_J >= 0 && threadIdx.x == 0) { const unsigned long long t_ = __builtin_amdgcn_s_memrealtime(); STAMPS[0] = (unsigned)t_; STAMPS[1] = (unsigned)(t_ >> 32); }
    if (PROBE_SEC >= 0 && threadIdx.x == 0) *(volatile LAS unsigned*)(lds + PSEC_OFF) = 0u;
    XcdBarrier bar = xcd_barrier_post((unsigned*)(ws + WS_CTL) + CW_BAR + p->bar_li * XCD_BAR_WORDS, MISC + 8);
#define WS (fresh_kp()->ws)
#define IN(k) ({ KP _q = fresh_kp(); const bool _r = _q->ph_lo <= (k) && (k) < _q->ph_hi; _r; })
#define SEAM(k) do { if (IN(k) && IN((k) + 1)) xcd_barrier(bar); if (PROBE_J >= 0 && threadIdx.x == 0) { const unsigned long long t_ = __builtin_amdgcn_s_memrealtime(); STAMPS[2 * ((k) + 1)] = (unsigned)t_; STAMPS[2 * ((k) + 1) + 1] = (unsigned)(t_ >> 32); } } while (0)

    if (IN(0)) { phase_prologue(fresh_kp(), lds, G, bid, wave_s); }
    SEAM(0);
    if (IN(1)) { unsigned char* wsl = WS;
        { TileOrder S; S.init(wsl + WS_XB, wsl + WS_WA, NTOK, 2560, D, G, bid);
          EpiInA E{(bf16*)(wsl + WS_HREG), (bf16*)(wsl + WS_HREG + HR_48), (bf16*)(wsl + WS_HREG + 2 * HR_48), (bf16*)(wsl + WS_HREG + 3 * HR_48)};
          gemm_phase(lds + RING_OFF, D, S, E, wave_s); }
    }
    SEAM(1);
    if (IN(2)) phase_gla_kv(fresh_kp(), lds, G, bid, wave_s);
    SEAM(2);
    if (IN(3)) { unsigned char* wsl = WS;
        if (G > 32 && bid < 16) { TileOrder S; S.init(wsl + WS_MEMB, wsl + WS_WMKV, NB * NMEM, 512, D, 16, bid);
            EpiPlain E{(bf16*)(wsl + WS_MKV), 1024};
            gemm_phase(lds + RING_OFF, D, S, E, wave_s); }
        else { phase_gla_scan(wsl, G > 32 ? G - 16 : G, G > 32 ? bid - 16 : bid, wave_s); __syncthreads(); if (G > 32) convert_from_queue(fresh_kp(), lds, wave_s, 4, CW_CVQA, CV_A_STATIC, CV_QA); }
        if (G <= 32) { TileOrder S; S.init(wsl + WS_MEMB, wsl + WS_WMKV, NB * NMEM, 512, D, G, bid); EpiPlain E{(bf16*)(wsl + WS_MKV), 1024}; gemm_phase(lds + RING_OFF, D, S, E, wave_s); } }
    SEAM(3);
    if (IN(4)) { phase_gla_out(fresh_kp(), lds, G, bid, wave_s); unsigned char* wsl = WS; { PSEC_BEGIN(45); phase_attn_mem(wsl, lds, 0, G, bid, wave_s); PSEC_END(45); } }
    SEAM(4);
        if (IN(5)) { unsigned char* wsl = WS;
            KP q = fresh_kp();
            TileOrder S; S.init(wsl + WS_XB, wsl + WS_WO + (size_t)0 * D * D * 2, NTOK, D, D, G, bid);
            EpiRes<false> E{(const void*)q->in[I_X], (bf16*)q->out};
            gemm_phase(lds + RING_OFF, D, S, E, wave_s);
        }
        SEAM(5);
        if (IN(5 + 1)) { phase_ln_router(fresh_kp(), 0, lds, G, bid, wave_s); convert_from_queue(fresh_kp(), lds, wave_s, -1, CW_CVQA, CV_A_STATIC, CV_QA); }
        SEAM(5 + 1);
        if (IN(5 + 2)) { unsigned char* wsl = WS;
            const int nu = moe_setup(wsl, lds, G, bid, wave_s, true);
            MoeGU S{(const char*)(wsl + WS_XB), (const char*)(wsl + WS_WGU) + (size_t)0 * NEXP * 1024 * D * 2, (LAS const int*)(lds + MISC_OFF) + 16, (LAS const int*)(lds + ROWTOK_OFF), nu};
            EpiGateUp E{(bf16*)(wsl + WS_GREG)};
            gemm_phase(lds + RING_OFF, D, S, E, wave_s);
            if (nu * G < (int)__builtin_amdgcn_readfirstlane(((volatile LAS int*)(lds + MISC_OFF))[16 + 25])) convert_from_queue(fresh_kp(), lds, wave_s, 4);
        }
        SEAM(5 + 2);
        if (IN(5 + 3)) { unsigned char* wsl = WS;
            const int nu = moe_setup(wsl, lds, G, bid, wave_s, false);
            MoeDown S{(const char*)(wsl + WS_GREG), (const char*)(wsl + WS_WD) + (size_t)0 * NEXP * 1024 * DEXP * 2, (LAS const int*)(lds + MISC_OFF) + 16, nu};
            EpiPlain E{(bf16*)(wsl + WS_HREG), 1024};
            gemm_phase(lds + RING_OFF, DEXP, S, E, wave_s);
            if (nu * G < (int)__builtin_amdgcn_readfirstlane(((volatile LAS int*)(lds + MISC_OFF))[16 + 25])) convert_from_queue(fresh_kp(), lds, wave_s, 2);
        }
        SEAM(5 + 3);
        if (IN(5 + 4)) phase_ln_ffn(fresh_kp(), 0, lds, G, bid, wave_s);

            SEAM(9);
            if (IN(10)) { unsigned char* wsl = WS;
                KP q = fresh_kp();
                TileOrder S; S.init(wsl + WS_XB, wsl + WS_WB, NTOK, 3328, D, G, bid);
                EpiInB E{(bf16*)(wsl + WS_HREG), (bf16*)(wsl + WS_HREG + HR_48), (bf16*)(wsl + WS_HREG + 2 * HR_48), (bf16*)(wsl + WS_HREG + 3 * HR_48), (bf16*)(wsl + WS_HREG + 4 * HR_48), q->in[I_QNG], q->in[I_KNG]};
                gemm_phase(lds + RING_OFF, D, S, E, wave_s);
                {
                    const int c2 = (G >= 160) ? bid - 128 : bid; const int G2 = (G >= 160) ? 16 : G;
                    if (c2 >= 0 && c2 < G2) { TileOrder S2; S2.init(wsl + WS_MEMB, wsl + WS_WMKV + (size_t)512 * D * 2, NB * NMEM, 512, D, G2, c2);
                        EpiPlain E2{(bf16*)(wsl + WS_MKV) + 512, 1024};
                        gemm_phase(lds + RING_OFF, D, S2, E2, wave_s); } }
                if (G == 256 && bid >= 144 && bid < 244) convert_from_queue(fresh_kp(), lds, wave_s, 4);
                const int gwr = (G - 1 - bid) * NWAVES + wave_s;
                if (gwr < NB * FOX_H) cum_wave((const float*)(wsl + WS_LOGF), (float*)(wsl + WS_CUM), gwr, fresh_lane());
            }
            SEAM(10);
            if (IN(11)) phase_attn_b(fresh_kp(), lds, wave_s);
            SEAM(11);
        if (IN(12)) { unsigned char* wsl = WS;
            KP q = fresh_kp();
            TileOrder S; S.init(wsl + WS_GREG, wsl + WS_WO + (size_t)1 * D * D * 2, NTOK, D, D, G, bid);
            EpiRes<true> E{(const void*)(wsl + WS_XB), (bf16*)q->out};
            gemm_phase(lds + RING_OFF, D, S, E, wave_s);
        }
        SEAM(12);
        if (IN(12 + 1)) { phase_ln_router(fresh_kp(), 1, lds, G, bid, wave_s); convert_from_queue(fresh_kp(), lds, wave_s, -1); }
        SEAM(12 + 1);
        if (IN(12 + 2)) { unsigned char* wsl = WS;
            const int nu = moe_setup(wsl, lds, G, bid, wave_s, true);
            MoeGU S{(const char*)(wsl + WS_XB), (const char*)(wsl + WS_WGU) + (size_t)1 * NEXP * 1024 * D * 2, (LAS const int*)(lds + MISC_OFF) + 16, (LAS const int*)(lds + ROWTOK_OFF), nu};
            EpiGateUp E{(bf16*)(wsl + WS_GREG)};
            gemm_phase(lds + RING_OFF, D, S, E, wave_s);
        }
        SEAM(12 + 2);
        if (IN(12 + 3)) { unsigned char* wsl = WS;
            const int nu = moe_setup(wsl, lds, G, bid, wave_s, false);
            MoeDown S{(const char*)(wsl + WS_GREG), (const char*)(wsl + WS_WD) + (size_t)1 * NEXP * 1024 * DEXP * 2, (LAS const int*)(lds + MISC_OFF) + 16, nu};
            EpiPlain E{(bf16*)(wsl + WS_HREG), 1024};
            gemm_phase(lds + RING_OFF, DEXP, S, E, wave_s);
        }
        SEAM(12 + 3);
        if (IN(12 + 4)) phase_ln_ffn(fresh_kp(), 1, lds, G, bid, wave_s);
        SEAM(16);
    if (PROBE_J >= 0 && blockIdx.x == 0 && threadIdx.x == 0) {
        const unsigned long long t1 = ((unsigned long long)STAMPS[2 * PROBE_B + 1] << 32) | STAMPS[2 * PROBE_B], t0 = ((unsigned long long)STAMPS[2 * PROBE_J + 1] << 32) | STAMPS[2 * PROBE_J];
        const unsigned long long wait = (t1 - t0) * PROBE_K, ts = __builtin_amdgcn_s_memrealtime();
        while (__builtin_amdgcn_s_memrealtime() - ts < wait) __builtin_amdgcn_s_sleep(8);
    }
    if (PROBE_SEC >= 0 && blockIdx.x == 0 && threadIdx.x == 0) {
        const unsigned long long wait = (unsigned long long)(*(volatile LAS unsigned*)(lds + PSEC_OFF)) * PROBE_K, ts = __builtin_amdgcn_s_memrealtime();
        while (__builtin_amdgcn_s_memrealtime() - ts < wait) __builtin_amdgcn_s_sleep(8);
    }
#undef IN
#undef SEAM
#undef WS
}
#undef LAS
#undef GAS
}

static int pk_grid() {
    static int grid = 0;
    if (grid == 0) {
        int dev = 0, cus = 0;
        if (hipGetDevice(&dev) != hipSuccess || hipDeviceGetAttribute(&cus, hipDeviceAttributeMultiprocessorCount, dev) != hipSuccess) { grid = -1; return grid; }
        if (hipFuncSetAttribute((const void*)pk::mega, hipFuncAttributeMaxDynamicSharedMemorySize, pk::LDS_BYTES) != hipSuccess) { fprintf(stderr, "kernel_launch: hipFuncSetAttribute failed\n"); grid = -1; return grid; }
        int per_cu = 0;
        if (hipOccupancyMaxActiveBlocksPerMultiprocessor(&per_cu, (const void*)pk::mega, pk::NTHREADS, pk::LDS_BYTES) != hipSuccess || per_cu < 1) fprintf(stderr, "kernel_launch: occupancy query says %d\n", per_cu);
        (void)hipGetLastError();
        grid = cus;
    }
    return grid;
}
static void pk_launch(pk::Params& P, int lo, int hi, hipStream_t stream) {
    const int grid = pk_grid(); if (grid <= 0) return;
    P.ph_lo = lo; P.ph_hi = hi; P.bar_li += 1;
    hipLaunchKernelGGL(pk::mega, dim3(grid), dim3(pk::NTHREADS), pk::LDS_BYTES, stream, P);
}
extern "C" void kernel_launch(void* const* d_in, const int* in_sizes, int n_in, void* d_out, int out_size, void* d_ws, size_t ws_size, hipStream_t stream) {
    if (n_in != 22 || out_size != NTOK * D || ws_size < WS_END) { fprintf(stderr, "kernel_launch: unexpected shapes (n_in %d out %d ws %zu)\n", n_in, out_size, ws_size); return; }
    const float* w_gate_up = (const float*)d_in[3]; const float* b_gate = (const float*)d_in[4]; const float* gla_g = (const float*)d_in[5];
    const float* w_eg = (const float*)d_in[19]; const float* w_eu = (const float*)d_in[20]; const float* w_ed = (const float*)d_in[21];
    unsigned char* ws = (unsigned char*)d_ws;
    float* GLR = (float*)(ws + WS_GLR); float* CUM = (float*)(ws + WS_CUM);
    bf16* MKV = (bf16*)(ws + WS_MKV);
    int* TOK_E = (int*)(ws + WS_TOKE); int* TOK_S = (int*)(ws + WS_TOKS);
    bf16* XB = (bf16*)(ws + WS_XB); bf16* YS = (bf16*)(ws + WS_HREG);
    bf16* T0 = (bf16*)(ws + WS_HREG), *T1 = (bf16*)(ws + WS_HREG + HR_48), *T2 = (bf16*)(ws + WS_HREG + 2 * HR_48), *T3 = (bf16*)(ws + WS_HREG + 3 * HR_48), *T4 = (bf16*)(ws + WS_HREG + 4 * HR_48);
    (void)hipMemsetAsync(ws + WS_CTL, 0, CTL_ZERO_BYTES, stream);
    pk::Params P{}; for (int i = 0; i < 22; ++i) P.in[i] = (const float*)d_in[i]; P.out = (float*)d_out; P.ws = ws; P.bar_li = -1;
    pk_launch(P, 0, 17, stream);
}
```

```cpp
#include <hip/hip_runtime.h>
#include <cstdio>
#include <cstdint>

typedef unsigned short bf16;
constexpr int NB = 8, SEQ = 4096, D = 1024, NTOK = NB * SEQ;
constexpr int NMEM = 256, A_IN = 2576, B_IN = 1792, KV_IN = 1548;
constexpr int GLA_H = 4, GLA_DK = 96, GLA_DV = 192, FOX_H = 12;
constexpr int NEXP = 16, DEXP = 512;
constexpr float DN_ALPHA = 1.41421356237309515f;
constexpr float LN_EPS = 1e-5f, RMS_EPS = 1e-6f;
constexpr float LOG2E = 1.4426950408889634f;
constexpr float QC2 = 0.125f * LOG2E;
constexpr size_t MiB = 1u << 20;
constexpr size_t WS_CTL = 0, CTL_ZERO_BYTES = 1 * MiB;
constexpr size_t WS_GLR = 1 * MiB, WS_LOGF = 3 * MiB, WS_CUM = 5 * MiB, WS_DEC = 7 * MiB, WS_MEMB = 8 * MiB, WS_MKV = 12 * MiB;
constexpr size_t WS_TOKE = 16 * MiB, WS_TOKW = WS_TOKE + 256 * 1024, WS_TOKS = WS_TOKW + 256 * 1024, WS_CNT = WS_TOKS + 256 * 1024, WS_SLOTTOK = 17 * MiB;
constexpr size_t WS_WA = 20 * MiB, WS_WB = 25 * MiB, WS_WMKV = 32 * MiB, WS_WO = 34 * MiB, WS_WGU = 38 * MiB, WS_WD = 102 * MiB;
constexpr size_t WS_XB = 134 * MiB, WS_GREG = 198 * MiB, WS_HREG = 270 * MiB, WS_END = 478 * MiB;
constexpr size_t HR_48 = 48 * MiB;

__device__ __forceinline__ float bf2f(bf16 v) { return __uint_as_float(((unsigned)v) << 16); }
__device__ __forceinline__ bf16 f2bf(float f) { unsigned u = __float_as_uint(f); return (bf16)((u + 0x7fffu + ((u >> 16) & 1u)) >> 16); }
__device__ __forceinline__ float wave_sum(float v) {
#pragma unroll
    for (int o = 1; o < 64; o <<= 1) v += __shfl_xor(v, o);
    return v;
}
__device__ __forceinline__ float log_sigmoid(float z) { return fminf(z, 0.f) - log1pf(expf(-fabsf(z))); }
__device__ __forceinline__ float sigmoidf(float z) { return 1.f / (1.f + expf(-z)); }

namespace nv {
__global__ void __launch_bounds__(256) p0_x(const float* x, const float* w_in_a, bf16* XB, float* GLR) {
    const int row = blockIdx.x * 4 + (threadIdx.x >> 6), lane = threadIdx.x & 63;
    float acc[16];
#pragma unroll
    for (int j = 0; j < 16; ++j) acc[j] = 0.f;
    for (int k = lane; k < D; k += 64) {
        const float v = x[(size_t)row * D + k]; XB[(size_t)row * D + k] = f2bf(v);
#pragma unroll
        for (int j = 0; j < 16; ++j) acc[j] += v * w_in_a[(size_t)k * A_IN + 1536 + j];
    }
#pragma unroll
    for (int j = 0; j < 16; ++j) { const float s = wave_sum(acc[j]); if (lane == 0) GLR[(size_t)row * 16 + j] = s; }
}
__global__ void __launch_bounds__(256) p0_mem(const float* mem, bf16* MEMB) {
    const size_t i = (size_t)blockIdx.x * 256 + threadIdx.x; MEMB[i] = f2bf(mem[i]);
}
struct GemmArgs { const bf16* A; int lda; const float* W; int ldw; int wcol0; int M, Nn, K; };
struct EpiBf { bf16* dst; int ldd; int dcol0; __device__ void operator()(int m, int n, float v) const { dst[(size_t)m * ldd + dcol0 + n] = f2bf(v); } };
struct EpiRes { const float* xres; float* out; __device__ void operator()(int m, int n, float v) const { out[(size_t)m * D + n] = DN_ALPHA * xres[(size_t)m * D + n] + v; } };
template <class Epi> __global__ void __launch_bounds__(256) gemm(GemmArgs g, Epi E) {
    const int n = blockIdx.x * 64 + (threadIdx.x & 63), m0 = (blockIdx.y * 4 + (threadIdx.x >> 6)) * 4;
    if (n >= g.Nn) return;
    float acc[4] = {0.f, 0.f, 0.f, 0.f};
    for (int k = 0; k < g.K; k += 8) {
        float w[8];
#pragma unroll
        for (int j = 0; j < 8; ++j) w[j] = g.W[(size_t)(k + j) * g.ldw + g.wcol0 + n];
#pragma unroll
        for (int i = 0; i < 4; ++i) {
            const uint4 a = *(const uint4*)(g.A + (size_t)(m0 + i) * g.lda + k);
            const unsigned aw[4] = {a.x, a.y, a.z, a.w};
#pragma unroll
            for (int j = 0; j < 4; ++j) { acc[i] += __uint_as_float(aw[j] << 16) * w[2 * j]; acc[i] += __uint_as_float(aw[j] & 0xffff0000u) * w[2 * j + 1]; }
        }
    }
#pragma unroll
    for (int i = 0; i < 4; ++i) E(m0 + i, n, acc[i]);
}
__global__ void __launch_bounds__(192) gla(const bf16* QK, const bf16* V, const bf16* R, const float* GLR, const float* w_up, const float* b_gate, const float* g_norm, bf16* OC) {
    const int b = blockIdx.x / GLA_H, h = blockIdx.x % GLA_H, tid = threadIdx.x;
    __shared__ float sq[96], sk[96], sa[96], red[4];
    float S[96];
#pragma unroll
    for (int k = 0; k < 96; ++k) S[k] = 0.f;
    float wup[16]; float bg = 0.f;
    if (tid < 96) { for (int j = 0; j < 16; ++j) wup[j] = w_up[j * 384 + h * 96 + tid]; bg = b_gate[h * 96 + tid]; }
    const float gn = g_norm[tid];
    const float qs = 0.10206207261596577f;
    for (int t = 0; t < SEQ; ++t) {
        const size_t m = (size_t)b * SEQ + t;
        __syncthreads();
        if (tid < 96) {
            float z = bg;
#pragma unroll
            for (int j = 0; j < 16; ++j) z += GLR[m * 16 + j] * wup[j];
            sa[tid] = expf(log_sigmoid(z) * (1.f / 16.f));
            sq[tid] = bf2f(QK[m * 768 + h * 96 + tid]) * qs;
            sk[tid] = bf2f(QK[m * 768 + 384 + h * 96 + tid]);
        }
        __syncthreads();
        const float v = bf2f(V[m * 768 + h * 192 + tid]);
        float o = 0.f;
#pragma unroll
        for (int k = 0; k < 96; ++k) { S[k] = sa[k] * S[k] + sk[k] * v; o += sq[k] * S[k]; }
        float ss = wave_sum(o * o);
        if ((tid & 63) == 0) red[tid >> 6] = ss;
        __syncthreads();
        ss = red[0] + red[1] + red[2];
        const float r = bf2f(R[m * 768 + h * 192 + tid]);
        const float on = o * rsqrtf(ss * (1.f / 192.f) + RMS_EPS) * gn;
        OC[m * D + h * 192 + tid] = f2bf(on * (r * sigmoidf(r)));
    }
}
__global__ void __launch_bounds__(256) memattn(const bf16* MQ, const bf16* MKV, int layer, bf16* OC) {
    const int m = blockIdx.x * 256 + threadIdx.x, hd = blockIdx.y, b = m / SEQ;
    float q[64], acc[64];
#pragma unroll
    for (int d = 0; d < 64; ++d) { q[d] = bf2f(MQ[(size_t)m * 256 + hd * 64 + d]) * 0.125f; acc[d] = 0.f; }
    float mx = -1e30f, l = 0.f;
    for (int j = 0; j < NMEM; ++j) {
        const bf16* kr = MKV + (size_t)(b * NMEM + j) * 1024 + layer * 512 + hd * 64;
        float s = 0.f;
#pragma unroll
        for (int d = 0; d < 64; ++d) s += q[d] * bf2f(kr[d]);
        const float mn = fmaxf(mx, s), f = expf(mx - mn), p = expf(s - mn);
        l = l * f + p; mx = mn;
#pragma unroll
        for (int d = 0; d < 64; ++d) acc[d] = acc[d] * f + p * bf2f(kr[256 + d]);
    }
    const float il = 1.f / l;
#pragma unroll
    for (int d = 0; d < 64; ++d) OC[(size_t)m * D + 768 + hd * 64 + d] = f2bf(acc[d] * il);
}
__global__ void __launch_bounds__(256) ln_router(float* XF, bf16* XB, const float* g, const float* bta, const float* w_router, const float* b_router, int* TOK_E, float* TOK_W) {
    const int row = blockIdx.x * 4 + (threadIdx.x >> 6), lane = threadIdx.x & 63;
    float v[16]; float s = 0.f;
#pragma unroll
    for (int i = 0; i < 16; ++i) { v[i] = XF[(size_t)row * D + lane + 64 * i]; s += v[i]; }
    const float mean = wave_sum(s) * (1.f / D); float q = 0.f;
#pragma unroll
    for (int i = 0; i < 16; ++i) { v[i] -= mean; q += v[i] * v[i]; }
    const float rstd = rsqrtf(wave_sum(q) * (1.f / D) + LN_EPS);
    float lg[16];
#pragma unroll
    for (int e = 0; e < 16; ++e) lg[e] = 0.f;
#pragma unroll
    for (int i = 0; i < 16; ++i) { const int k = lane + 64 * i; const float o = v[i] * rstd * g[k] + bta[k]; XF[(size_t)row * D + k] = o; XB[(size_t)row * D + k] = f2bf(o);
#pragma unroll
        for (int e = 0; e < 16; ++e) lg[e] += o * w_router[k * 16 + e]; }
#pragma unroll
    for (int e = 0; e < 16; ++e) lg[e] = wave_sum(lg[e]);
    if (lane == 0) {
        float aff[16], sel[16];
#pragma unroll
        for (int e = 0; e < 16; ++e) { aff[e] = sigmoidf(lg[e]); sel[e] = aff[e] + b_router[e]; }
        int gbest = 0; float gs = -1e30f;
#pragma unroll
        for (int gi = 0; gi < 4; ++gi) { float a = -1e30f, b2 = -1e30f;
#pragma unroll
            for (int j = 0; j < 4; ++j) { const float x = sel[gi * 4 + j]; if (x > a) { b2 = a; a = x; } else if (x > b2) b2 = x; }
            if (a + b2 > gs) { gs = a + b2; gbest = gi; } }
        int i0 = 0, i1 = 0; float a = -1e30f, b2 = -1e30f;
#pragma unroll
        for (int j = 0; j < 4; ++j) { float x = -1e30f;
#pragma unroll
            for (int gi = 0; gi < 4; ++gi) if (gi == gbest) x = sel[gi * 4 + j];
            if (x > a) { b2 = a; i1 = i0; a = x; i0 = j; } else if (x > b2) { b2 = x; i1 = j; } }
        const int e0 = gbest * 4 + i0, e1 = gbest * 4 + i1; float w0 = 0.f, w1 = 0.f;
#pragma unroll
        for (int e = 0; e < 16; ++e) { if (e == e0) w0 = aff[e]; if (e == e1) w1 = aff[e]; }
        const float inv = 1.f / (w0 + w1);
        TOK_E[row * 2] = e0; TOK_E[row * 2 + 1] = e1; TOK_W[row * 2] = w0 * inv; TOK_W[row * 2 + 1] = w1 * inv;
    }
}
__global__ void __launch_bounds__(256) moe(const bf16* XB, const int* TOK_E, const float* wg, const float* wu, const float* wd, bf16* YS, int* TOK_SLOT) {
    const int tok = blockIdx.x >> 1, j = blockIdx.x & 1, tid = threadIdx.x;
    __shared__ float xs[1024], hs[512];
    for (int k = tid; k < 1024; k += 256) xs[k] = bf2f(XB[(size_t)tok * D + k]);
    const int e = TOK_E[tok * 2 + j];
    __syncthreads();
    const float* G = wg + (size_t)e * 1024 * 512; const float* U = wu + (size_t)e * 1024 * 512; const float* Dn = wd + (size_t)e * 512 * 1024;
    float g0 = 0.f, g1 = 0.f, u0 = 0.f, u1 = 0.f;
    for (int k = 0; k < 1024; ++k) { const float x = xs[k]; g0 += x * G[k * 512 + tid]; g1 += x * G[k * 512 + 256 + tid]; u0 += x * U[k * 512 + tid]; u1 += x * U[k * 512 + 256 + tid]; }
    hs[tid] = g0 * sigmoidf(g0) * u0; hs[tid + 256] = g1 * sigmoidf(g1) * u1;
    __syncthreads();
    float o[4] = {0.f, 0.f, 0.f, 0.f};
    for (int k = 0; k < 512; ++k) { const float hh = hs[k];
#pragma unroll
        for (int c = 0; c < 4; ++c) o[c] += hh * Dn[k * 1024 + c * 256 + tid]; }
    const int slot = tok * 2 + j;
#pragma unroll
    for (int c = 0; c < 4; ++c) YS[(size_t)slot * D + c * 256 + tid] = f2bf(o[c]);
    if (tid == 0) TOK_SLOT[slot] = slot;
}
__global__ void __launch_bounds__(256) ln_ffn(float* XF, bf16* XB, const bf16* YS, const int* TOK_SLOT, const float* TOK_W, const float* g, const float* bta,
                                              const float* w_kv, const float* b_forget, float* LOGF, int do_logf) {
    const int row = blockIdx.x * 4 + (threadIdx.x >> 6), lane = threadIdx.x & 63;
    const int s0 = TOK_SLOT[row * 2], s1 = TOK_SLOT[row * 2 + 1]; const float w0 = TOK_W[row * 2], w1 = TOK_W[row * 2 + 1];
    float v[16]; float s = 0.f;
#pragma unroll
    for (int i = 0; i < 16; ++i) { const int k = lane + 64 * i; v[i] = DN_ALPHA * XF[(size_t)row * D + k] + w0 * bf2f(YS[(size_t)s0 * D + k]) + w1 * bf2f(YS[(size_t)s1 * D + k]); s += v[i]; }
    const float mean = wave_sum(s) * (1.f / D); float q = 0.f;
#pragma unroll
    for (int i = 0; i < 16; ++i) { v[i] -= mean; q += v[i] * v[i]; }
    const float rstd = rsqrtf(wave_sum(q) * (1.f / D) + LN_EPS);
    float lf[12];
#pragma unroll
    for (int e = 0; e < 12; ++e) lf[e] = 0.f;
#pragma unroll
    for (int i = 0; i < 16; ++i) { const int k = lane + 64 * i; const float o = v[i] * rstd * g[k] + bta[k]; XF[(size_t)row * D + k] = o; XB[(size_t)row * D + k] = f2bf(o);
        if (do_logf) {
#pragma unroll
            for (int e = 0; e < 12; ++e) lf[e] += o * w_kv[(size_t)k * KV_IN + 1536 + e]; } }
    if (do_logf) {
#pragma unroll
        for (int e = 0; e < 12; ++e) { const float t = wave_sum(lf[e]); if (lane == 0) LOGF[(size_t)row * 12 + e] = log_sigmoid(t + b_forget[e]); }
    }
}
__global__ void __launch_bounds__(256) headproj(const bf16* XB, const float* W, int ldw, const float* gn, float scale, bf16* dst) {
    const int m = blockIdx.x, col = blockIdx.y * 256 + threadIdx.x, lane = threadIdx.x & 63;
    float acc = 0.f;
    for (int k = 0; k < D; k += 8) {
        const uint4 a = *(const uint4*)(XB + (size_t)m * D + k); const unsigned aw[4] = {a.x, a.y, a.z, a.w};
#pragma unroll
        for (int j = 0; j < 4; ++j) { acc += __uint_as_float(aw[j] << 16) * W[(size_t)(k + 2 * j) * ldw + col]; acc += __uint_as_float(aw[j] & 0xffff0000u) * W[(size_t)(k + 2 * j + 1) * ldw + col]; }
    }
    const float ss = wave_sum(acc * acc);
    dst[(size_t)m * 768 + col] = f2bf(acc * rsqrtf(ss * (1.f / 64.f) + RMS_EPS) * gn[lane] * scale);
}
__global__ void __launch_bounds__(64) cumk(const float* LOGF, float* CUM) {
    const int b = blockIdx.x / FOX_H, h = blockIdx.x % FOX_H, lane = threadIdx.x;
    float loc[64]; float s = 0.f;
#pragma unroll
    for (int i = 0; i < 64; ++i) { s += LOGF[((size_t)b * SEQ + lane * 64 + i) * 12 + h]; loc[i] = s; }
    float inc = s;
#pragma unroll
    for (int o = 1; o < 64; o <<= 1) { const float t = __shfl_up(inc, o); if (lane >= o) inc += t; }
    const float base = inc - s;
#pragma unroll
    for (int i = 0; i < 64; ++i) CUM[((size_t)b * FOX_H + h) * SEQ + lane * 64 + i] = base + loc[i];
}
__global__ void __launch_bounds__(256) fox(const bf16* Q, const bf16* K, const bf16* V, const bf16* OG, const float* CUM, bf16* OC) {
    const int t = blockIdx.x * 256 + threadIdx.x, h = blockIdx.y, b = blockIdx.z;
    const size_t m = (size_t)b * SEQ + t;
    float q[64], acc[64];
#pragma unroll
    for (int d = 0; d < 64; ++d) { q[d] = bf2f(Q[m * 768 + h * 64 + d]); acc[d] = 0.f; }
    const float* cum = CUM + ((size_t)b * FOX_H + h) * SEQ; const float ct = cum[t] * LOG2E;
    float mx = -1e30f, l = 0.f;
    const int tmax = blockIdx.x * 256 + 255;
    for (int s = 0; s <= tmax; ++s) {
        const bf16* kr = K + ((size_t)b * SEQ + s) * 768 + h * 64; const bf16* vr = V + ((size_t)b * SEQ + s) * 768 + h * 64;
        float sc = ct - cum[s] * LOG2E;
#pragma unroll
        for (int d = 0; d < 64; ++d) sc += q[d] * bf2f(kr[d]);
        if (s <= t) {
            const float mn = fmaxf(mx, sc), f = exp2f(mx - mn), p = exp2f(sc - mn);
            l = l * f + p; mx = mn;
#pragma unroll
            for (int d = 0; d < 64; ++d) acc[d] = acc[d] * f + p * bf2f(vr[d]);
        }
    }
    const float il = 1.f / l;
#pragma unroll
    for (int d = 0; d < 64; ++d) { const float og = bf2f(OG[m * 768 + h * 64 + d]); OC[m * D + h * 64 + d] = f2bf(acc[d] * il * sigmoidf(og)); }
}
}

namespace pk {
#define LAS __attribute__((address_space(3)))
#define GAS __attribute__((address_space(1)))
typedef short bf16x8 __attribute__((ext_vector_type(8)));
typedef short s16x4 __attribute__((ext_vector_type(4)));
typedef float f32x4 __attribute__((ext_vector_type(4)));
typedef float f32x16 __attribute__((ext_vector_type(16)));
typedef unsigned u32x4 __attribute__((ext_vector_type(4)));
typedef unsigned u32x2 __attribute__((ext_vector_type(2)));
constexpr int NWAVES = 8, NTHREADS = 512;
constexpr int BM = 256, BK = 64, HALF = 128, HTB = HALF * BK * 2, STAGE_BYTES = 8 * HTB, NXCD = 8, WGM = 8;
constexpr int RING_OFF = 0, RING_BYTES = 131072;
constexpr int MISC_OFF = RING_BYTES;
constexpr int ROWTOK_OFF = MISC_OFF + 256;
constexpr size_t OUT_HI = (size_t)64 << 20;
constexpr int LDS_BYTES = 155648;
static_assert(ROWTOK_OFF + 6 * 1024 <= LDS_BYTES, "LDS map");

__device__ __forceinline__ int lds_byte(int r, int c) { const int st = (r >> 4) * 2 + (c >> 5), rr = r & 15, cc = c & 31, ob = rr * 64 + cc * 2; return st * 1024 + (ob ^ (((ob >> 9) & 1) << 5)); }
__device__ __forceinline__ void stage_rc(int b, int& R, int& C) { const int st = b / 1024, sb = b % 1024, swz = sb ^ (((sb >> 9) & 1) << 5); R = (st >> 1) * 16 + swz / 64; C = (st & 1) * 32 + (swz % 64) / 2; }
__device__ __forceinline__ unsigned cvt_pk_bf16(float lo, float hi) { unsigned r; asm volatile("v_cvt_pk_bf16_f32 %0, %1, %2" : "=v"(r) : "v"(lo), "v"(hi)); return r; }
__device__ __forceinline__ int perm8(int c) { return (c & ~31) | (16 * ((c >> 2) & 1) + 4 * ((c >> 3) & 3) + (c & 3)); }
__device__ __forceinline__ int head64(int c) { return 128 * ((c >> 5) & 1) + 32 * (c >> 6) + 16 * ((c >> 2) & 1) + 4 * ((c >> 3) & 3) + (c & 3); }

__device__ __forceinline__ int fresh_lane() { int l; asm volatile("v_mbcnt_lo_u32_b32 %0, -1, 0\n\tv_mbcnt_hi_u32_b32 %0, -1, %0" : "=v"(l)); return l; }
__device__ __forceinline__ int fresh_tid(int wave_s) { asm volatile("" : "+s"(wave_s)); return wave_s * 64 + fresh_lane(); }
constexpr int PROBE_SEC = -1;
constexpr int PSEC_OFF = 131072 + 256 + 6144 + 512;
#define PSEC_BEGIN(id) unsigned long long _ps##id = 0; if (PROBE_SEC == (id) && bid == 0 && wave_s == 0) _ps##id = __builtin_amdgcn_s_memrealtime()
#define PSEC_END(id) do { if (PROBE_SEC == (id) && bid == 0 && wave_s == 0) { const unsigned d_ = (unsigned)(__builtin_amdgcn_s_memrealtime() - _ps##id); volatile LAS unsigned* a_ = (volatile LAS unsigned*)(lds + PSEC_OFF); if (fresh_lane() == 0) a_[0] = a_[0] + d_; } } while (0)
struct Unit { const char* A; const char* B; int pm, pn, e, ord; };

struct TileOrder {
    const char* A; const char* Bt; int K, nM, nN, nwg, G, c;
    __device__ void init(const void* A_, const void* Bt_, int M, int N, int K_, int G_, int c_) { A = (const char*)A_; Bt = (const char*)Bt_; K = K_; nM = M / BM; nN = N / BM; nwg = nM * nN; G = G_; c = c_; }
    __device__ __forceinline__ bool next(int i, Unit& u) const {
        const long L = (long)i * G + c; if (L >= nwg) return false;
        int wgid = (int)L; { const int q = nwg / NXCD, r = nwg % NXCD, xcd = wgid % NXCD, off = wgid / NXCD; wgid = (xcd < r ? xcd * (q + 1) : r * (q + 1) + (xcd - r) * q) + off; }
        const int nig = WGM * nN, gid = wgid / nig, fm = gid * WGM, gsz = (nM - fm) < WGM ? (nM - fm) : WGM;
        u.pm = fm + ((wgid % nig) % gsz); u.pn = (wgid % nig) / gsz; u.e = 0; u.ord = i;
        u.A = A + (size_t)u.pm * BM * K * 2; u.B = Bt + (size_t)u.pn * BM * K * 2; return true;
    }
    __device__ __forceinline__ unsigned a_off(const Unit&, int h, int R, int C) const { return (unsigned)((R + HALF * h) * K + C) * 2u; }
};

template <int SEC = 0, class Epi, class Sched>
__device__ __forceinline__ void gemm_phase(LAS unsigned char* lds, const int K, const Sched& S, const Epi& E, const int wave_s) {
    const int tid = fresh_tid(wave_s), wid = wave_s, lane = tid & 63, wr = wid >> 2, wc = wid & 3, fr = lane & 15, fq = lane >> 4;
    const int nt = K / BK;
    int sR[2], sC[2];
    unsigned voffA[2][2], voffB[2];
#pragma unroll
    for (int i = 0; i < 2; ++i) { stage_rc(tid * 16 + i * 8192, sR[i], sC[i]); voffB[i] = (unsigned)(sR[i] * K + sC[i]) * 2u; }
    const size_t kstep = (size_t)(BK * 2);
    const size_t hstep = (size_t)HALF * K * 2;
    const unsigned ldsw = (unsigned)wid * 1024u;
    const int aoff = lds_byte(wr * 64 + fr, fq * 8), boff = lds_byte(wc * 32 + fr, fq * 8);
#define PG8_SA(b, h) (((b) * 2 + (h)) * HTB)
#define PG8_SB(b, h) ((4 + (b) * 2 + (h)) * HTB)
#define PG8_STAGE(bufoff, gbase, voff) do { _Pragma("unroll") for (int _i = 0; _i < 2; ++_i) \
        __builtin_amdgcn_global_load_lds((const unsigned*)((const char*)(gbase) + (voff)[_i]), (LAS unsigned*)(lds + (bufoff) + ldsw + _i * 8192), 16, 0, 0); } while (0)
#define PG8_LDA(dst, b, h) do { _Pragma("unroll") for (int m = 0; m < 4; ++m) _Pragma("unroll") for (int k = 0; k < 2; ++k) dst[m][k] = *(const LAS bf16x8*)(lds + PG8_SA(b, h) + aoff + m * 2048 + k * 1024); } while (0)
#define PG8_LDB(dst, b, h) do { _Pragma("unroll") for (int n = 0; n < 2; ++n) _Pragma("unroll") for (int k = 0; k < 2; ++k) dst[n][k] = *(const LAS bf16x8*)(lds + PG8_SB(b, h) + boff + n * 2048 + k * 1024); } while (0)
#define PG8_MMA(ai, bj, At, Bt) do { __builtin_amdgcn_s_setprio(1); _Pragma("unroll") for (int m = 0; m < 4; ++m) _Pragma("unroll") for (int n = 0; n < 2; ++n) _Pragma("unroll") for (int k = 0; k < 2; ++k) \
        acc[ai][bj][m][n] = __builtin_amdgcn_mfma_f32_16x16x32_bf16(Bt[n][k], At[m][k], acc[ai][bj][m][n], 0, 0, 0); __builtin_amdgcn_s_setprio(0); } while (0)
#define PG8_WAIT_V(n) asm volatile("s_waitcnt vmcnt(" #n ")" ::: "memory")
#define PG8_WAIT_L(n) asm volatile("s_waitcnt lgkmcnt(" #n ")" ::: "memory")
#define PG8_BAR __builtin_amdgcn_s_barrier()
#define PG8_SCHED __builtin_amdgcn_sched_barrier(0)
    Unit cur, nxt; int ui = 0;
    if (!S.next(0, cur)) return;
    f32x4 acc[2][2][4][2];
#pragma unroll
    for (int a = 0; a < 2; ++a)
#pragma unroll
        for (int b = 0; b < 2; ++b)
#pragma unroll
            for (int m = 0; m < 4; ++m)
#pragma unroll
                for (int n = 0; n < 2; ++n) acc[a][b][m][n] = (f32x4){0.f, 0.f, 0.f, 0.f};
    bf16x8 At[4][2], B0[2][2], B1[2][2];
    const char* cA = cur.A; const char* cB = cur.B;
#pragma unroll
    for (int h = 0; h < 2; ++h)
#pragma unroll
        for (int i = 0; i < 2; ++i) voffA[h][i] = S.a_off(cur, h, sR[i], sC[i]);
    PG8_STAGE(PG8_SB(0, 0), cB, voffB); PG8_STAGE(PG8_SB(0, 1), cB + hstep, voffB); PG8_STAGE(PG8_SA(0, 0), cA, voffA[0]); PG8_STAGE(PG8_SA(0, 1), cA, voffA[1]);
    if (wr == 1) PG8_BAR;
    PG8_WAIT_V(2); PG8_BAR;
    PG8_STAGE(PG8_SB(1, 0), cB + kstep, voffB); PG8_STAGE(PG8_SA(1, 0), cA + kstep, voffA[0]); PG8_STAGE(PG8_SB(1, 1), cB + hstep + kstep, voffB);
    PG8_WAIT_V(6); PG8_BAR;
    for (;;) {
        const bool has_next = S.next(ui + 1, nxt);
        const char* nA = has_next ? nxt.A : cA; const char* nB = has_next ? nxt.B : cB;
        for (int t = 0; t < nt; t += 2) {
            const bool last = (t == nt - 2);
            const char* a1 = cA + (size_t)(t + 1) * kstep;
            const char* a2 = last ? nA : cA + (size_t)(t + 2) * kstep; const char* b2 = last ? nB : cB + (size_t)(t + 2) * kstep;
            const char* a3 = a2 + kstep; const char* b3 = b2 + kstep;
            PG8_LDB(B0, 0, 0); PG8_LDB(B1, 0, 1); PG8_SCHED; PG8_LDA(At, 0, 0); PG8_STAGE(PG8_SA(1, 1), a1, voffA[1]);
            if (last && has_next) {
#pragma unroll
                for (int h = 0; h < 2; ++h)
#pragma unroll
                    for (int i = 0; i < 2; ++i) { int R2, C2; stage_rc(fresh_tid(wave_s) * 16 + i * 8192, R2, C2); voffA[h][i] = S.a_off(nxt, h, R2, C2); }
            }
            PG8_WAIT_V(8); PG8_WAIT_L(0); PG8_BAR; PG8_MMA(0, 0, At, B0); PG8_MMA(0, 1, At, B1); PG8_BAR; PG8_SCHED;
            PG8_LDA(At, 0, 1); PG8_STAGE(PG8_SB(0, 0), b2, voffB); PG8_STAGE(PG8_SB(0, 1), b2 + hstep, voffB); PG8_STAGE(PG8_SA(0, 0), a2, voffA[0]);
            PG8_WAIT_V(8); PG8_WAIT_L(0); PG8_BAR; PG8_MMA(1, 0, At, B0); PG8_MMA(1, 1, At, B1); PG8_BAR; PG8_SCHED;
            PG8_LDB(B0, 1, 0); PG8_LDB(B1, 1, 1); PG8_SCHED; PG8_LDA(At, 1, 0); PG8_STAGE(PG8_SA(0, 1), a2, voffA[1]);
            PG8_WAIT_V(8); PG8_WAIT_L(0); PG8_BAR; PG8_MMA(0, 0, At, B0); PG8_MMA(0, 1, At, B1); PG8_BAR; PG8_SCHED;
            PG8_LDA(At, 1, 1); PG8_STAGE(PG8_SB(1, 0), b3, voffB); PG8_STAGE(PG8_SB(1, 1), b3 + hstep, voffB); PG8_STAGE(PG8_SA(1, 0), a3, voffA[0]);
            PG8_WAIT_V(8); PG8_WAIT_L(0); PG8_BAR; PG8_MMA(1, 0, At, B0); PG8_MMA(1, 1, At, B1); PG8_BAR; PG8_SCHED;
        }
        if (wr == 0) PG8_BAR;
        { const bool pe_ = (PROBE_SEC == 30 || (SEC != 0 && PROBE_SEC == SEC)) && blockIdx.x == 0 && wave_s == 0; unsigned long long t0_ = 0; if (pe_) t0_ = __builtin_amdgcn_s_memrealtime();
          E(acc, cur, wr, wc, fr, fq);
          if (pe_) { const unsigned d_ = (unsigned)(__builtin_amdgcn_s_memrealtime() - t0_); volatile LAS unsigned* a_ = (volatile LAS unsigned*)(lds + PSEC_OFF); if (fresh_lane() == 0) a_[0] = a_[0] + d_; } }
        if (!has_next) break;
#pragma unroll
        for (int a = 0; a < 2; ++a)
#pragma unroll
            for (int b = 0; b < 2; ++b)
#pragma unroll
                for (int m = 0; m < 4; ++m)
#pragma unroll
                    for (int n = 0; n < 2; ++n) acc[a][b][m][n] = (f32x4){0.f, 0.f, 0.f, 0.f};
        cur = nxt; cA = nA; cB = nB; ++ui;
        if (wr == 1) PG8_BAR;
    }
    PG8_WAIT_V(0);
    PG8_BAR;
#undef PG8_SA
#undef PG8_SB
#undef PG8_STAGE
#undef PG8_LDA
#undef PG8_LDB
#undef PG8_MMA
#undef PG8_WAIT_V
#undef PG8_WAIT_L
#undef PG8_BAR
#undef PG8_SCHED
}

__device__ __forceinline__ void store_bf16_tile(const f32x4 (&acc)[2][2][4][2], bf16* base, int ldd, int row0, int c0, int wr, int wc, int fr, int fq) {
    GAS bf16* rowp = (GAS bf16*)base + (size_t)(row0 + wr * 64 + fr) * ldd + (c0 + wc * 32 + 8 * fq);
#pragma unroll
    for (int ai = 0; ai < 2; ++ai) {
#pragma unroll
        for (int m = 0; m < 4; ++m) {
#pragma unroll
            for (int bj = 0; bj < 2; ++bj) { const f32x4 v0 = acc[ai][bj][m][0], v1 = acc[ai][bj][m][1];
                u32x4 w; w.x = cvt_pk_bf16(v0[0], v0[1]); w.y = cvt_pk_bf16(v0[2], v0[3]); w.z = cvt_pk_bf16(v1[0], v1[1]); w.w = cvt_pk_bf16(v1[2], v1[3]);
                *(GAS u32x4*)(rowp + bj * HALF) = w; }
            rowp += (size_t)16 * ldd; asm volatile("" : "+v"(rowp)); }
        rowp += (size_t)64 * ldd; }
}
struct EpiInA { bf16 *QK, *V, *R, *MQ;
    __device__ __forceinline__ void operator()(const f32x4 (&acc)[2][2][4][2], const Unit& u, int wr, int wc, int fr, int fq) const {
        bf16* base; int ldd, c0; const int pn = u.pn;
        if (pn < 3) { base = QK; ldd = 768; c0 = pn * 256; } else if (pn < 6) { base = V; ldd = 768; c0 = (pn - 3) * 256; } else if (pn < 9) { base = R; ldd = 768; c0 = (pn - 6) * 256; } else { base = MQ; ldd = 256; c0 = 0; }
        store_bf16_tile(acc, base, ldd, u.pm * BM, c0, wr, wc, fr, fq);
    } };
struct EpiPlain { bf16* dst; int ldd;
    __device__ __forceinline__ void operator()(const f32x4 (&acc)[2][2][4][2], const Unit& u, int wr, int wc, int fr, int fq) const { store_bf16_tile(acc, dst, ldd, u.pm * BM, u.pn * BM, wr, wc, fr, fq); } };

#define XB_TMO      128
#define XB_XCNT(j)  (256  + 64 * (j))
#define XB_XSUB(j)  (1280 + 64 * (j))
#define XB_XGEN(j)  (2304 + 64 * (j))
#define XB_TOP      3328
#define XB_TOPGEN   3392
#define XCD_BAR_WORDS 3456
#define XB_SPIN_CAP (1u << 18)
__device__ __forceinline__ unsigned xb_ld(unsigned* p)              { return __hip_atomic_load(p, __ATOMIC_RELAXED, __HIP_MEMORY_SCOPE_AGENT); }
__device__ __forceinline__ unsigned xb_add(unsigned* p, unsigned v) { return __hip_atomic_fetch_add(p, v, __ATOMIC_RELAXED, __HIP_MEMORY_SCOPE_AGENT); }
__device__ __forceinline__ unsigned xb_xcc_id() { return (unsigned)__builtin_amdgcn_s_getreg((3 << 11) | 20) & 0xFu; }
#define XB_SPIN(cond, bar) do { unsigned _sp = 0; while (cond) { __builtin_amdgcn_s_sleep(1); \
    if ((++_sp & 255u) == 0u) { if (xb_ld(&(bar)[XB_TMO])) break; if (_sp > XB_SPIN_CAP) { atomicAdd(&(bar)[XB_TMO], 1u); break; } } } } while (0)
struct XcdBarrier { unsigned* bar; unsigned x; volatile LAS unsigned* st; };
__device__ __forceinline__ XcdBarrier xcd_barrier_post(unsigned* bar, volatile LAS unsigned* st) {
    XcdBarrier b; b.bar = bar; b.x = xb_xcc_id(); b.st = st;
    if (threadIdx.x == 0) (void)xb_add(&bar[XB_XCNT(b.x)], 1u);
    return b;
}
__device__ __forceinline__ void xcd_barrier_complete(unsigned* bar, unsigned x, unsigned& nloc, unsigned& nx) {
    const unsigned G = gridDim.x * gridDim.y * gridDim.z;
    unsigned sum, cnt, mine, sp = 0u;
    for (;;) {
        sum = 0u; cnt = 0u; mine = 0u;
#pragma unroll
        for (unsigned j = 0; j < 16; ++j) { const unsigned c = xb_ld(&bar[XB_XCNT(j)]); sum += c; cnt += (c > 0u) ? 1u : 0u; mine = (j == x) ? c : mine; }
        if (sum == G) break;
        __builtin_amdgcn_s_sleep(1);
        if ((++sp & 255u) == 0u) { if (xb_ld(&bar[XB_TMO])) break; if (sp > XB_SPIN_CAP) { atomicAdd(&bar[XB_TMO], 1u); break; } }
    }
    nloc = mine > 0u ? mine : 1u; nx = cnt > 0u ? cnt : 1u;
}
__device__ __forceinline__ void xcd_barrier(const XcdBarrier& b) {
    asm volatile("s_waitcnt vmcnt(0)" ::: "memory");
    __syncthreads();
    if (threadIdx.x == 0) {
        unsigned* bar = b.bar;
        __builtin_amdgcn_s_waitcnt(0);
        unsigned nloc = b.st[0], nx = b.st[1];
        if (nloc == 0u) { xcd_barrier_complete(bar, b.x, nloc, nx); b.st[0] = nloc; b.st[1] = nx; }
        const unsigned old = xb_add(&bar[XB_XSUB(b.x)], 1u);
        const unsigned gen = old / nloc;
        if (old + 1u == (gen + 1u) * nloc) {
            __builtin_amdgcn_fence(__ATOMIC_RELEASE, "agent");
            asm volatile("s_waitcnt vmcnt(0)" ::: "memory");
            const unsigned og = xb_add(&bar[XB_TOP], 1u);
            const unsigned tg = og / nx;
            if (og + 1u == (tg + 1u) * nx) xb_add(&bar[XB_TOPGEN], 1u);
            else XB_SPIN(xb_ld(&bar[XB_TOPGEN]) == tg, bar);
            __builtin_amdgcn_fence(__ATOMIC_ACQUIRE, "agent");
            xb_add(&bar[XB_XGEN(b.x)], 1u);
            asm volatile("s_waitcnt vmcnt(0)" ::: "memory");
        } else {
            XB_SPIN(xb_ld(&bar[XB_XGEN(b.x)]) == gen, bar);
            __builtin_amdgcn_fence(__ATOMIC_ACQUIRE, "agent");
            asm volatile("s_waitcnt vmcnt(0)" ::: "memory");
        }
    }
    __syncthreads();
}
#define LDS_WAIT() asm volatile("s_waitcnt lgkmcnt(0)" ::: "memory")
__device__ __forceinline__ unsigned pk2(float lo, float hi) { return (unsigned)f2bf(lo) | ((unsigned)f2bf(hi) << 16); }

template <int CTRL> __device__ __forceinline__ float dppf(float v) { return __builtin_bit_cast(float, __builtin_amdgcn_update_dpp(0, __builtin_bit_cast(int, v), CTRL, 0xf, 0xf, true)); }
__device__ __forceinline__ float sum_swap32(float a, float b) { auto r = __builtin_amdgcn_permlane32_swap(__float_as_uint(a), __float_as_uint(b), false, false); return __uint_as_float(r[0]) + __uint_as_float(r[1]); }
__device__ __forceinline__ float sum_swap16(float a, float b) { auto r = __builtin_amdgcn_permlane16_swap(__float_as_uint(a), __float_as_uint(b), false, false); return __uint_as_float(r[0]) + __uint_as_float(r[1]); }
__device__ __forceinline__ float wsum(float v) {
    v += dppf<0xB1>(v); v += dppf<0x4E>(v); v += dppf<0x141>(v); v += dppf<0x140>(v);
    v = sum_swap16(v, v); v = sum_swap32(v, v); return v;
}
__device__ __forceinline__ float multi_reduce16(const float (&a)[16], int lane) {
    float b[8], c[4], d[2], e;
#pragma unroll
    for (int i = 0; i < 8; ++i) b[i] = sum_swap32(a[i], a[i + 8]);
#pragma unroll
    for (int i = 0; i < 4; ++i) c[i] = sum_swap16(b[i], b[i + 4]);
    { const bool hi = (lane & 8) != 0;
#pragma unroll
      for (int i = 0; i < 2; ++i) { const float send = hi ? c[i] : c[i + 2], keep = hi ? c[i + 2] : c[i]; d[i] = keep + dppf<0x140>(send); } }
    { const bool hi = (lane & 4) != 0; const float send = hi ? d[0] : d[1], keep = hi ? d[1] : d[0]; e = keep + dppf<0x141>(send); }
    e += dppf<0x4E>(e); e += dppf<0xB1>(e);
    return e;
}

__device__ __forceinline__ void row_dots16x2(const f32x4 (&v0)[4], const f32x4 (&v1)[4], const LAS float* WT, int lane, float& r0, float& r1) {
    float a0[16], a1[16];
    const LAS float* wl = WT + 4 * lane; asm volatile("" : "+v"(wl));
    f32x4 wa[8], wb[8];
#pragma unroll
    for (int q = 0; q < 8; ++q) wa[q] = *(const LAS f32x4*)(wl + (q >> 2) * D + 256 * (q & 3));
#pragma unroll
    for (int g = 0; g < 8; ++g) {
        if (g + 1 < 8) {
#pragma unroll
            for (int q = 0; q < 8; ++q) { const f32x4 w = *(const LAS f32x4*)(wl + (2 * (g + 1) + (q >> 2)) * D + 256 * (q & 3)); if (g & 1) wa[q] = w; else wb[q] = w; } }
#pragma unroll
        for (int h = 0; h < 2; ++h) { float x = 0.f, y = 0.f;
#pragma unroll
            for (int j = 0; j < 4; ++j) { const f32x4 w = (g & 1) ? wb[4 * h + j] : wa[4 * h + j];
                x += v0[j][0] * w[0] + v0[j][1] * w[1] + v0[j][2] * w[2] + v0[j][3] * w[3]; y += v1[j][0] * w[0] + v1[j][1] * w[1] + v1[j][2] * w[2] + v1[j][3] * w[3]; }
            a0[2 * g + h] = x; a1[2 * g + h] = y; }
        asm volatile("" : "+v"(a0[2 * g]), "+v"(a0[2 * g + 1]), "+v"(a1[2 * g]), "+v"(a1[2 * g + 1]));
    }
    r0 = multi_reduce16(a0, lane); r1 = multi_reduce16(a1, lane);
}
struct TItem { const float* src; bf16* WT; int K, ncols, n0, k0, kind, aux; bool ok; };
__device__ __forceinline__ int titem_dstrow(const TItem& t, int c) {
    switch (t.kind) {
        case 0: return 256 * (c >> 7) + perm8(c & 127);
        case 1: return 256 * (c >> 7) + 128 + perm8(c & 127);
        case 2: return perm8(c);
        case 3: { if (c >= 1536 && c < 1552) return -1; const int L = c < 1536 ? c : c - 16; return perm8(L); }
        case 4: { if (c < 768) return (c & ~255) + head64(c & 255); return perm8(1536 + c); }
        case 5: { if (c < 768) { const int L = 768 + c; return (L & ~255) + head64(L & 255); } if (c < 1536) return perm8(768 + c); return -1; }
        default: return perm8(t.aux * 512 + c);
    }
}
__device__ __forceinline__ void titem_load(const TItem& t, float (&r)[32]) {
#pragma unroll
    for (int i = 0; i < 32; ++i) r[i] = t.ok ? t.src[(size_t)(2 * i) * t.ncols] : 0.f;
}
__device__ __forceinline__ void titem_store(const TItem& t, const float (&r)[32], LAS float* scr, int lane) {
#pragma unroll
    for (int i = 0; i < 32; ++i) scr[(2 * i + (lane >> 5)) * 33 + (lane & 31)] = r[i];
    LDS_WAIT(); asm volatile("" ::: "memory");
    const int c = lane & 7;
#pragma unroll
    for (int j = 0; j < 4; ++j) { const int n = (lane >> 3) + 8 * j; const LAS float* s = scr + (8 * c) * 33 + n;
        u32x4 o; o.x = cvt_pk_bf16(s[0 * 33], s[1 * 33]); o.y = cvt_pk_bf16(s[2 * 33], s[3 * 33]); o.z = cvt_pk_bf16(s[4 * 33], s[5 * 33]); o.w = cvt_pk_bf16(s[6 * 33], s[7 * 33]);
        const int dr = (t.n0 + n) < t.ncols ? titem_dstrow(t, t.n0 + n) : -1;
        if (dr >= 0) *(u32x4*)(t.WT + (size_t)dr * t.K + t.k0 + 8 * c) = o; }
    LDS_WAIT(); asm volatile("" ::: "memory");
}
struct Params { const float* in[22]; float* out; unsigned char* ws; int ph_lo, ph_hi, bar_li, pad; };
enum { I_X = 0, I_MEM, I_WINA, I_WGUP, I_BGATE, I_GLAG, I_WINB, I_QNG, I_WKV, I_BFORGET, I_KNG, I_WMKV, I_WOUT, I_LMG, I_LMB, I_LFG, I_LFB, I_WR, I_BR, I_WEG, I_WEU, I_WED };
constexpr int CW_BAR = 4096;

typedef const __attribute__((address_space(4))) Params* KP;
__device__ __forceinline__ KP fresh_kp() { KP q = (KP)__builtin_amdgcn_kernarg_segment_ptr(); asm volatile("" : "+s"(q)); return q; }

constexpr int CV_STATIC = 3 * 512 + 176 + 112 + 96 + 64 + 128, CV_QUEUE = 3 * 512;
constexpr int CV_A_STATIC = 576, CV_NSTAT = CV_A_STATIC + (CV_STATIC - 1536), CV_QA = 1536 - CV_A_STATIC;
constexpr int CW_CVQ = 1040, CW_CVQA = 1056;
__device__ __forceinline__ void cv_decode(KP p, unsigned char* ws, int it, int lane, int wave, TItem& t) {
    int r = it; const float* W; int nblk, q, l = 0; t.aux = 0;
    if (r >= CV_STATIC) { r -= CV_STATIC; l = 1; }
    else if (r >= 1536) { r -= 1536;
        if (r < 176) { q = r; W = p->in[I_WINA]; t.ncols = A_IN; t.K = D; t.WT = (bf16*)(ws + WS_WA); nblk = 11; t.kind = 3; }
        else if ((r -= 176) < 112) { q = r; W = p->in[I_WINB]; t.ncols = B_IN; t.K = D; t.WT = (bf16*)(ws + WS_WB); nblk = 7; t.kind = 4; }
        else if ((r -= 112) < 96) { q = r; W = p->in[I_WKV]; t.ncols = KV_IN; t.K = D; t.WT = (bf16*)(ws + WS_WB); nblk = 6; t.kind = 5; }
        else if ((r -= 96) < 64) { const int lm = r / 32; q = r % 32; W = p->in[I_WMKV] + (size_t)lm * D * 512; t.ncols = 512; t.K = D; t.WT = (bf16*)(ws + WS_WMKV); nblk = 2; t.kind = 6; t.aux = lm; }
        else { r -= 64; const int lo = r / 64; q = r % 64; W = p->in[I_WOUT] + (size_t)lo * D * D; t.ncols = D; t.K = D; t.WT = (bf16*)(ws + WS_WO) + (size_t)lo * D * D; nblk = 4; t.kind = 2; }
        goto done; }
    if (r < 512) { const int mat = 16 * l + r / 32; q = r % 32; W = p->in[I_WEG] + (size_t)mat * D * DEXP; t.ncols = DEXP; t.K = D; t.WT = (bf16*)(ws + WS_WGU) + (size_t)mat * 1024 * D; nblk = 2; t.kind = 0; }
    else if ((r -= 512) < 512) { const int mat = 16 * l + r / 32; q = r % 32; W = p->in[I_WEU] + (size_t)mat * D * DEXP; t.ncols = DEXP; t.K = D; t.WT = (bf16*)(ws + WS_WGU) + (size_t)mat * 1024 * D; nblk = 2; t.kind = 1; }
    else { r -= 512; const int mat = 16 * l + r / 32; q = r % 32; W = p->in[I_WED] + (size_t)mat * DEXP * D; t.ncols = D; t.K = DEXP; t.WT = (bf16*)(ws + WS_WD) + (size_t)mat * D * DEXP; nblk = 4; t.kind = 2; }
done:
    t.k0 = 64 * (q / nblk); t.n0 = 256 * (q % nblk);
    const int col = t.n0 + 4 * lane; t.ok = col < t.ncols;
    t.src = W + (size_t)(t.k0 + 8 * wave) * t.ncols + (t.ok ? col : 0);
}
#define CV_TLOAD(t, r) do { _Pragma("unroll") for (int i = 0; i < 8; ++i) r[i] = t.ok ? *(const f32x4*)(t.src + (size_t)i * t.ncols) : (f32x4){0.f, 0.f, 0.f, 0.f}; } while (0)
#define CV_TSTORE(t, r) do { __syncthreads(); \
        _Pragma("unroll") for (int i = 0; i < 8; ++i) { LAS float* d_ = T + (8 * wave + i) * 257 + 4 * lane; d_[0] = r[i][0]; d_[1] = r[i][1]; d_[2] = r[i][2]; d_[3] = r[i][3]; } \
        __syncthreads(); \
        const int c_ = lane & 7; \
        _Pragma("unroll") for (int j = 0; j < 4; ++j) { const int n_ = 32 * wave + (lane >> 3) + 8 * j; const LAS float* s_ = T + (8 * c_) * 257 + n_; \
            u32x4 o_; o_.x = cvt_pk_bf16(s_[0 * 257], s_[1 * 257]); o_.y = cvt_pk_bf16(s_[2 * 257], s_[3 * 257]); o_.z = cvt_pk_bf16(s_[4 * 257], s_[5 * 257]); o_.w = cvt_pk_bf16(s_[6 * 257], s_[7 * 257]); \
            const int dr_ = (t.n0 + n_) < t.ncols ? titem_dstrow(t, t.n0 + n_) : -1; \
            if (dr_ >= 0) *(u32x4*)(t.WT + (size_t)dr_ * t.K + t.k0 + 8 * c_) = o_; } } while (0)
__device__ __forceinline__ void convert_static(KP p, unsigned char* ws, LAS unsigned char* lds, int lane, int wave, int G, int bid) {
    LAS float* T = (LAS float*)lds;
    TItem ta; f32x4 ra[8], rb[8];
#define CV_SID(s) ((s) < CV_A_STATIC ? (s) : 1536 + ((s) - CV_A_STATIC))
    int it = bid;
    if (it < CV_NSTAT) { cv_decode(p, ws, CV_SID(it), lane, wave, ta); CV_TLOAD(ta, ra); }
#pragma unroll 1
    for (; it < CV_NSTAT; it += 2 * G) {
        TItem tb; const bool hb = it + G < CV_NSTAT;
        if (hb) { cv_decode(p, ws, CV_SID(it + G), lane, wave, tb); CV_TLOAD(tb, rb); }
        CV_TSTORE(ta, ra);
        if (it + 2 * G < CV_NSTAT) { cv_decode(p, ws, CV_SID(it + 2 * G), lane, wave, ta); CV_TLOAD(ta, ra); }
        if (hb) CV_TSTORE(tb, rb);
    }
#undef CV_SID
    __syncthreads();
}
__device__ __forceinline__ void convert_from_queue(KP p, LAS unsigned char* lds, const int wave_s, int budget, const int qword = CW_CVQ, const int qbase = CV_STATIC, const int qcount = CV_QUEUE) {
    unsigned char* ws = p->ws; LAS float* T = (LAS float*)lds;
    const int tid = fresh_tid(wave_s), lane = tid & 63, wave = wave_s;
    unsigned* qh = (unsigned*)(ws + WS_CTL) + qword; volatile LAS unsigned* slotw = (volatile LAS unsigned*)(lds + MISC_OFF) + 56;
    for (int n = 0; budget < 0 || n < budget; ++n) {
        if (tid == 0) slotw[0] = __hip_atomic_fetch_add(qh, 1u, __ATOMIC_RELAXED, __HIP_MEMORY_SCOPE_AGENT);
        __syncthreads();
        const int q = (int)__builtin_amdgcn_readfirstlane(slotw[0]);
        if (q >= qcount) break;
        TItem t; f32x4 r[8]; cv_decode(p, ws, qbase + q, lane, wave, t); CV_TLOAD(t, r); CV_TSTORE(t, r);
        __syncthreads();
    }
    __syncthreads();
}
__device__ __forceinline__ void phase_prologue(KP p, LAS unsigned char* lds, int G, int bid, const int wave_s) {
    const int tid = fresh_tid(wave_s), lane = tid & 63, wave = wave_s;
    unsigned char* ws = p->ws;
    LAS float* scr = (LAS float*)(lds + wave * 8448);
    const int gw = bid * NWAVES + wave, NGW = G * NWAVES;
    constexpr int NB_A = 81, NB_B = 56, NB_KV = 48;
    constexpr int I_G = 32 * 16 * 16, I_U = I_G, I_D = 32 * 8 * 32, I_A = 16 * NB_A, I_B = 16 * NB_B, I_KV = 16 * NB_KV, I_MK = 2 * 16 * 16, I_O = 2 * 16 * 32;
    constexpr int NITEMS = I_G + I_U + I_D + I_A + I_B + I_KV + I_MK + I_O;
    auto decode = [&](int it, TItem& t) {
        int r = it; const float* W; int nblk, q; t.aux = 0;
        if (r < I_G) { const int mat = r / 256; q = r % 256; W = p->in[I_WEG] + (size_t)mat * D * DEXP; t.ncols = DEXP; t.K = D; t.WT = (bf16*)(ws + WS_WGU) + (size_t)mat * 1024 * D; nblk = 16; t.kind = 0; }
        else if ((r -= I_G) < I_U) { const int mat = r / 256; q = r % 256; W = p->in[I_WEU] + (size_t)mat * D * DEXP; t.ncols = DEXP; t.K = D; t.WT = (bf16*)(ws + WS_WGU) + (size_t)mat * 1024 * D; nblk = 16; t.kind = 1; }
        else if ((r -= I_U) < I_D) { const int mat = r / 256; q = r % 256; W = p->in[I_WED] + (size_t)mat * DEXP * D; t.ncols = D; t.K = DEXP; t.WT = (bf16*)(ws + WS_WD) + (size_t)mat * D * DEXP; nblk = 32; t.kind = 2; }
        else if ((r -= I_D) < I_A) { q = r; W = p->in[I_WINA]; t.ncols = A_IN; t.K = D; t.WT = (bf16*)(ws + WS_WA); nblk = NB_A; t.kind = 3; }
        else if ((r -= I_A) < I_B) { q = r; W = p->in[I_WINB]; t.ncols = B_IN; t.K = D; t.WT = (bf16*)(ws + WS_WB); nblk = NB_B; t.kind = 4; }
        else if ((r -= I_B) < I_KV) { q = r; W = p->in[I_WKV]; t.ncols = KV_IN; t.K = D; t.WT = (bf16*)(ws + WS_WB); nblk = NB_KV; t.kind = 5; }
        else if ((r -= I_KV) < I_MK) { const int l = r / 256; q = r % 256; W = p->in[I_WMKV] + (size_t)l * D * 512; t.ncols = 512; t.K = D; t.WT = (bf16*)(ws + WS_WMKV); nblk = 16; t.kind = 6; t.aux = l; }
        else { r -= I_MK; const int l = r / 512; q = r % 512; W = p->in[I_WOUT] + (size_t)l * D * D; t.ncols = D; t.K = D; t.WT = (bf16*)(ws + WS_WO) + (size_t)l * D * D; nblk = 32; t.kind = 2; }
        t.k0 = 64 * (q / nblk); t.n0 = 32 * (q % nblk);
        const int col = t.n0 + (lane & 31); t.ok = col < t.ncols;
        t.src = W + (size_t)(t.k0 + (lane >> 5)) * t.ncols + (t.ok ? col : 0);
    };
    { PSEC_BEGIN(20); convert_static(p, ws, lds, lane, wave, G, bid); PSEC_END(20); }
    { const f32x4* src = (const f32x4*)p->in[I_MEM]; u32x2* dst = (u32x2*)(ws + WS_MEMB);
      for (int i = bid * NTHREADS + tid; i < NB * NMEM * D / 4; i += G * NTHREADS) { const f32x4 v = src[i]; u32x2 o; o.x = pk2(v[0], v[1]); o.y = pk2(v[2], v[3]); dst[i] = o; } }
    __syncthreads();
    LAS float* WG = (LAS float*)(lds);
    for (int idx = tid; idx < 16 * D; idx += NTHREADS) { const int j = idx & 15, k = idx >> 4; WG[j * D + k] = p->in[I_WINA][(size_t)k * A_IN + 1536 + j]; }
    __syncthreads();
    bf16* XB = (bf16*)(ws + WS_XB); float* GLR = (float*)(ws + WS_GLR);
    { PSEC_BEGIN(22);
    {   f32x4 a0[4], a1[4], b0[4], b1[4];
#define P0_LOAD(va, vb, mm) do { const f32x4* xr_ = (const f32x4*)(p->in[I_X] + (size_t)(mm) * D) + lane; _Pragma("unroll") for (int j = 0; j < 4; ++j) { va[j] = xr_[64 * j]; vb[j] = xr_[64 * j + 256]; } } while (0)
#define P0_PROC(va, vb, mm) do { u32x2* o8_ = (u32x2*)(XB + (size_t)(mm) * D) + lane; \
            _Pragma("unroll") for (int j = 0; j < 4; ++j) { u32x2 o; o.x = cvt_pk_bf16(va[j][0], va[j][1]); o.y = cvt_pk_bf16(va[j][2], va[j][3]); o8_[64 * j] = o; o.x = cvt_pk_bf16(vb[j][0], vb[j][1]); o.y = cvt_pk_bf16(vb[j][2], vb[j][3]); o8_[64 * j + 256] = o; } \
            float r0_, r1_; row_dots16x2(va, vb, WG, lane, r0_, r1_); \
            if ((lane & 3) == 0) { GLR[(size_t)(mm) * 16 + (lane >> 2)] = r0_; GLR[(size_t)((mm) + 1) * 16 + (lane >> 2)] = r1_; } } while (0)
        int m = 2 * gw;
        if (m < NTOK) P0_LOAD(a0, a1, m);
#pragma unroll 1
        for (; m < NTOK; m += 4 * NGW) {
            const bool hb = m + 2 * NGW < NTOK;
            if (hb) P0_LOAD(b0, b1, m + 2 * NGW);
            P0_PROC(a0, a1, m);
            if (m + 4 * NGW < NTOK) P0_LOAD(a0, a1, m + 4 * NGW);
            if (hb) P0_PROC(b0, b1, m + 2 * NGW);
        }
#undef P0_LOAD
#undef P0_PROC
    }
    PSEC_END(22); }
}

template <bool RB> struct EpiRes { const void* xres; bf16* out;
    __device__ __forceinline__ void operator()(const f32x4 (&acc)[2][2][4][2], const Unit& u, int wr, int wc, int fr, int fq) const {
        size_t off = (size_t)(u.pm * BM + wr * 64 + fr) * D + (u.pn * BM + wc * 32 + 8 * fq);
#pragma unroll
        for (int ai = 0; ai < 2; ++ai) {
            u32x4 tb[4][2]; f32x4 tf[4][2][2];
#pragma unroll
            for (int m = 0; m < 4; ++m)
#pragma unroll
                for (int bj = 0; bj < 2; ++bj) { const size_t o = off + (size_t)(16 * m) * D + bj * HALF;
                    if (RB) tb[m][bj] = *(const u32x4*)((const bf16*)xres + o);
                    else { tf[m][bj][0] = *(const f32x4*)((const float*)xres + o); tf[m][bj][1] = *(const f32x4*)((const float*)xres + o + 4); } }
            asm volatile("" : "+v"(off) :: "memory");
#pragma unroll
            for (int m = 0; m < 4; ++m) {
#pragma unroll
                for (int bj = 0; bj < 2; ++bj) { f32x4 x0, x1;
                    if (RB) { const u32x4 t = tb[m][bj]; x0[0] = __uint_as_float(t.x << 16); x0[1] = __uint_as_float(t.x & 0xffff0000u); x0[2] = __uint_as_float(t.y << 16); x0[3] = __uint_as_float(t.y & 0xffff0000u);
                        x1[0] = __uint_as_float(t.z << 16); x1[1] = __uint_as_float(t.z & 0xffff0000u); x1[2] = __uint_as_float(t.w << 16); x1[3] = __uint_as_float(t.w & 0xffff0000u); }
                    else { x0 = tf[m][bj][0]; x1 = tf[m][bj][1]; }
                    const f32x4 v0 = x0 * DN_ALPHA + acc[ai][bj][m][0], v1 = x1 * DN_ALPHA + acc[ai][bj][m][1];
                    u32x4 w; w.x = cvt_pk_bf16(v0[0], v0[1]); w.y = cvt_pk_bf16(v0[2], v0[3]); w.z = cvt_pk_bf16(v1[0], v1[1]); w.w = cvt_pk_bf16(v1[2], v1[3]);
                    *(u32x4*)(out + off + bj * HALF) = w; }
                off += (size_t)16 * D; asm volatile("" : "+v"(off)); }
            off += (size_t)64 * D; asm volatile("" : "+v"(off) :: "memory"); }
    } };
struct EpiInB { bf16 *Q, *K, *V, *OG, *MQ; const float* qg; const float* kg;
    __device__ __forceinline__ void operator()(const f32x4 (&acc)[2][2][4][2], const Unit& u, int wr, int wc, int fr, int fq) const {
        const int pn = u.pn;
        if (pn >= 6) { bf16* base; int ldd, c0;
            if (pn < 9) { base = V; ldd = 768; c0 = (pn - 6) * 256; } else if (pn < 12) { base = OG; ldd = 768; c0 = (pn - 9) * 256; } else { base = MQ; ldd = 256; c0 = 0; }
            store_bf16_tile(acc, base, ldd, u.pm * BM, c0, wr, wc, fr, fq); return; }
        const bool isq = pn < 3; bf16* base = isq ? Q : K; const float* g = isq ? qg : kg; const float sc = isq ? QC2 : 1.0f;
        const int c0 = (isq ? pn : pn - 3) * 256 + wc * 64 + 8 * fq, r0 = u.pm * BM + wr * 64 + fr;
        f32x4 gv[2][2];
#pragma unroll
        for (int bj = 0; bj < 2; ++bj)
#pragma unroll
            for (int n = 0; n < 2; ++n) gv[bj][n] = *(const f32x4*)(g + 32 * bj + 8 * fq + 4 * n) * sc;
        GAS bf16* rowp = (GAS bf16*)base + (size_t)r0 * 768 + c0;
#pragma unroll
        for (int ai = 0; ai < 2; ++ai) {
#pragma unroll
            for (int m = 0; m < 4; ++m) {
                float ss = 0.f;
#pragma unroll
                for (int bj = 0; bj < 2; ++bj)
#pragma unroll
                    for (int n = 0; n < 2; ++n) { const f32x4 v = acc[ai][bj][m][n]; ss += (v[0] * v[0] + v[1] * v[1]) + (v[2] * v[2] + v[3] * v[3]); }
                ss = sum_swap16(ss, ss); ss = sum_swap32(ss, ss);
                const float rs = rsqrtf(ss * (1.f / 64.f) + RMS_EPS);
#pragma unroll
                for (int bj = 0; bj < 2; ++bj) { const f32x4 v0 = acc[ai][bj][m][0] * rs * gv[bj][0], v1 = acc[ai][bj][m][1] * rs * gv[bj][1];
                    u32x4 w; w.x = cvt_pk_bf16(v0[0], v0[1]); w.y = cvt_pk_bf16(v0[2], v0[3]); w.z = cvt_pk_bf16(v1[0], v1[1]); w.w = cvt_pk_bf16(v1[2], v1[3]);
                    *(GAS u32x4*)(rowp + 32 * bj) = w; }
                rowp += (size_t)16 * 768; asm volatile("" : "+v"(rowp)); }
            rowp += (size_t)64 * 768; }
    } };

__device__ __forceinline__ void load_wtab(LAS float* WT, const float* W, int ldw, int col0, int ncols, int tid) {
    for (int idx = tid; idx < 16 * D; idx += NTHREADS) { const int j = idx & 15, k = idx >> 4; WT[j * D + k] = j < ncols ? W[(size_t)k * ldw + col0 + j] : 0.f; }
}
__device__ __forceinline__ float row_dots16(const f32x4 (&v)[4], const LAS float* WT, int lane) {
    float acc[16];
    const LAS float* wl = WT + 4 * lane; asm volatile("" : "+v"(wl));
#pragma unroll
    for (int n = 0; n < 16; ++n) { float a = 0.f;
#pragma unroll
        for (int j = 0; j < 4; ++j) { const f32x4 w = *(const LAS f32x4*)(wl + n * D + 256 * j); a += v[j][0] * w[0] + v[j][1] * w[1] + v[j][2] * w[2] + v[j][3] * w[3]; }
        acc[n] = a; if (n & 1) asm volatile("" : "+v"(acc[n - 1]), "+v"(acc[n]) :: "memory"); }
    return multi_reduce16(acc, lane);
}
__device__ __forceinline__ void ln_row(f32x4 (&v)[4], const float* g, const float* b, int lane) {
    float s = 0.f;
#pragma unroll
    for (int j = 0; j < 4; ++j) s += (v[j][0] + v[j][1]) + (v[j][2] + v[j][3]);
    const float mean = wsum(s) * (1.f / D); float q = 0.f;
#pragma unroll
    for (int j = 0; j < 4; ++j) { v[j] = v[j] - mean; q += (v[j][0] * v[j][0] + v[j][1] * v[j][1]) + (v[j][2] * v[j][2] + v[j][3] * v[j][3]); }
    const float rstd = rsqrtf(wsum(q) * (1.f / D) + LN_EPS);
#pragma unroll
    for (int j = 0; j < 4; ++j) { const f32x4 gg = *(const f32x4*)(g + 4 * lane + 256 * j), bb = *(const f32x4*)(b + 4 * lane + 256 * j); v[j] = v[j] * rstd * gg + bb; }
}
__device__ __forceinline__ void store_row_f32_bf16(const f32x4 (&v)[4], float* xf, bf16* xb, int lane) {
#pragma unroll
    for (int j = 0; j < 4; ++j) { if (xf) ((f32x4*)xf)[lane + 64 * j] = v[j]; if (xb) { u32x2 o; o.x = cvt_pk_bf16(v[j][0], v[j][1]); o.y = cvt_pk_bf16(v[j][2], v[j][3]); ((u32x2*)xb)[lane + 64 * j] = o; } }
}

__device__ __forceinline__ void route_thread(const float (&lg)[16], const float (&brv)[16], int m, int lt, int* TOK_E, float* TOK_W, LAS int* tokE) {
    float aff[16], sel[16];
#pragma unroll
    for (int e = 0; e < 16; ++e) { aff[e] = 1.f / (1.f + __expf(-lg[e])); sel[e] = aff[e] + brv[e]; }
    int gbest = 0; float gs = -1e30f;
#pragma unroll
    for (int gi = 0; gi < 4; ++gi) { float a = -1e30f, b2 = -1e30f;
#pragma unroll
        for (int j = 0; j < 4; ++j) { const float x = sel[gi * 4 + j]; const bool gt = x > a; b2 = gt ? a : fmaxf(b2, x); a = gt ? x : a; }
        const bool better = a + b2 > gs; gs = better ? a + b2 : gs; gbest = better ? gi : gbest; }
    int i0 = 0, i1 = 0; float a = -1e30f, b2 = -1e30f, wa = 0.f, wb = 0.f;
#pragma unroll
    for (int j = 0; j < 4; ++j) { float x = sel[j], y = aff[j];
#pragma unroll
        for (int gi = 1; gi < 4; ++gi) { x = (gi == gbest) ? sel[gi * 4 + j] : x; y = (gi == gbest) ? aff[gi * 4 + j] : y; }
        const bool g1 = x > a, g2 = x > b2;
        const float nb = g1 ? a : (g2 ? x : b2), nwb = g1 ? wa : (g2 ? y : wb); const int ni1 = g1 ? i0 : (g2 ? j : i1);
        a = g1 ? x : a; wa = g1 ? y : wa; i0 = g1 ? j : i0; b2 = nb; wb = nwb; i1 = ni1; }
    const float inv = 1.f / (wa + wb); const int e0 = gbest * 4 + i0, e1 = gbest * 4 + i1;
    TOK_E[m * 2] = e0; TOK_E[m * 2 + 1] = e1; TOK_W[m * 2] = wa * inv; TOK_W[m * 2 + 1] = wb * inv; tokE[lt * 2] = e0; tokE[lt * 2 + 1] = e1;
}
__device__ __forceinline__ void phase_ln_router(KP p, int layer, LAS unsigned char* lds, int G, int bid, const int wave_s) {
    const int tid = fresh_tid(wave_s), lane = tid & 63, wave = wave_s;
    PSEC_BEGIN(0);
    unsigned char* ws = p->ws;
    LAS float* WT = (LAS float*)lds; LAS int* tokE = (LAS int*)(lds + 65536);
    load_wtab(WT, p->in[I_WR], 16, 0, 16, tid);
    __syncthreads();
    const bf16* Y1 = (const bf16*)p->out; bf16* XB = (bf16*)(ws + WS_XB); int* TOK_E = (int*)(ws + WS_TOKE); float* TOK_W = (float*)(ws + WS_TOKW); int* CNT = (int*)(ws + WS_CNT); int* SLOT_TOK = (int*)(ws + WS_SLOTTOK);
    const float* g = p->in[I_LMG] + layer * D; const float* b = p->in[I_LMB] + layer * D;
#define LNR_LOAD(va, vb, pr) do { const u32x2* s0_ = (const u32x2*)(Y1 + (size_t)(tb * 128 + wave * 16 + 2 * (pr)) * D) + lane; _Pragma("unroll") for (int j = 0; j < 4; ++j) { const u32x2 a_ = s0_[64 * j], b_ = s0_[64 * j + 256]; \
        va[j][0] = __uint_as_float(a_.x << 16); va[j][1] = __uint_as_float(a_.x & 0xffff0000u); va[j][2] = __uint_as_float(a_.y << 16); va[j][3] = __uint_as_float(a_.y & 0xffff0000u); \
        vb[j][0] = __uint_as_float(b_.x << 16); vb[j][1] = __uint_as_float(b_.x & 0xffff0000u); vb[j][2] = __uint_as_float(b_.y << 16); vb[j][3] = __uint_as_float(b_.y & 0xffff0000u); } } while (0)
#define LNR_PROC(va, vb, pr) do { const int lt_ = wave * 16 + 2 * (pr), m_ = tb * 128 + lt_; \
        { PSEC_BEGIN(1); ln_row(va, g, b, lane); ln_row(vb, g, b, lane); \
        store_row_f32_bf16(va, (float*)nullptr, XB + (size_t)m_ * D, lane); store_row_f32_bf16(vb, (float*)nullptr, XB + (size_t)(m_ + 1) * D, lane); PSEC_END(1); } \
        float l0_, l1_; { PSEC_BEGIN(2); row_dots16x2(va, vb, WT, lane, l0_, l1_); asm volatile("" : "+v"(l0_), "+v"(l1_)); PSEC_END(2); } \
        if ((lane & 3) == 0) { LG[lt_ * 16 + (lane >> 2)] = l0_; LG[(lt_ + 1) * 16 + (lane >> 2)] = l1_; } } while (0)
    LAS float* LG = (LAS float*)(lds + 65536 + 1024);
    for (int tb = bid; tb < NTOK / 128; tb += G) {
        f32x4 a0[4], a1[4], b0[4], b1[4];
        LNR_LOAD(a0, a1, 0);
#pragma unroll 1
        for (int pr = 0; pr < 8; pr += 2) {
            LNR_LOAD(b0, b1, pr + 1);
            LNR_PROC(a0, a1, pr);
            if (pr + 2 < 8) LNR_LOAD(a0, a1, pr + 2);
            LNR_PROC(b0, b1, pr + 1);
        }
        __syncthreads();
        if (tid < 128) { PSEC_BEGIN(3); float lg[16], brv[16];
#pragma unroll
            for (int q = 0; q < 4; ++q) { const f32x4 t4 = *(const LAS f32x4*)(LG + tid * 16 + 4 * q); const f32x4 b4 = *(const f32x4*)(p->in[I_BR] + 4 * q);
#pragma unroll
                for (int j = 0; j < 4; ++j) { lg[4 * q + j] = t4[j]; brv[4 * q + j] = b4[j]; } }
            route_thread(lg, brv, tb * 128 + tid, tid, TOK_E, TOK_W, tokE); PSEC_END(3); }
        __syncthreads();
        if (tid < 256) {
            const int e = tokE[tid]; int rank = 0;
            for (int i = 0; i < tid; ++i) rank += (tokE[i] == e) ? 1 : 0;
            SLOT_TOK[(e * 256 + tb) * 128 + rank] = tb * 256 + tid;
        } else if (tid < 272) { const int e = tid - 256; int c = 0; for (int i = 0; i < 256; ++i) c += (tokE[i] == e) ? 1 : 0; CNT[tb * 16 + e] = c; }
        __syncthreads();
    }
    PSEC_END(0);
#undef LNR_LOAD
#undef LNR_PROC
}
struct FfnRow { u32x2 x[4], ya[4], yc[4]; float w0, w1; };
__device__ __forceinline__ void ffn_combine(FfnRow& r, f32x4 (&v)[4]) {
#pragma unroll
    for (int j = 0; j < 4; ++j) { const u32x2 a = r.ya[j], c = r.yc[j]; f32x4 ya, yc;
        ya[0] = __uint_as_float(a.x << 16); ya[1] = __uint_as_float(a.x & 0xffff0000u); ya[2] = __uint_as_float(a.y << 16); ya[3] = __uint_as_float(a.y & 0xffff0000u);
        yc[0] = __uint_as_float(c.x << 16); yc[1] = __uint_as_float(c.x & 0xffff0000u); yc[2] = __uint_as_float(c.y << 16); yc[3] = __uint_as_float(c.y & 0xffff0000u);
        const u32x2 xx = r.x[j]; f32x4 xv; xv[0] = __uint_as_float(xx.x << 16); xv[1] = __uint_as_float(xx.x & 0xffff0000u); xv[2] = __uint_as_float(xx.y << 16); xv[3] = __uint_as_float(xx.y & 0xffff0000u);
        v[j] = xv * DN_ALPHA + ya * r.w0 + yc * r.w1; }
}
__device__ __forceinline__ void phase_ln_ffn(KP p, int layer, LAS unsigned char* lds, int G, int bid, const int wave_s) {
    const int tid = fresh_tid(wave_s), lane = tid & 63, wave = wave_s;
    unsigned char* ws = p->ws;
    LAS float* WT = (LAS float*)lds;
    if (layer == 0) { load_wtab(WT, p->in[I_WKV], KV_IN, 1536, 12, tid); __syncthreads(); }
    const int eo = (lane >> 2) & 15; const float bf = (layer == 0 && eo < 12) ? p->in[I_BFORGET][eo] : 0.f;
    float* XF = p->out; bf16* XB = (bf16*)(ws + WS_XB); const bf16* YS = (const bf16*)(ws + WS_HREG);
    const int* TOK_S = (const int*)(ws + WS_TOKS); const float* TOK_W = (const float*)(ws + WS_TOKW); float* LOGF = (float*)(ws + WS_LOGF);
    const float* g = p->in[I_LFG] + layer * D; const float* b = p->in[I_LFB] + layer * D;
    const int gw = bid * NWAVES + wave, NGW = G * NWAVES;
#define FFN_LOAD(R, m_) do { const int mm_ = (m_); int mv_ = mm_ * 2; asm volatile("" : "+v"(mv_));        \
        const int s0_ = TOK_S[mv_], s1_ = TOK_S[mv_ + 1]; R.w0 = TOK_W[mv_]; R.w1 = TOK_W[mv_ + 1]; \
        _Pragma("unroll") for (int j = 0; j < 4; ++j) { R.x[j] = ((const u32x2*)(XB + (size_t)mm_ * D))[lane + 64 * j]; R.ya[j] = ((const u32x2*)(YS + (size_t)s0_ * D))[lane + 64 * j]; R.yc[j] = ((const u32x2*)(YS + (size_t)s1_ * D))[lane + 64 * j]; } } while (0)
#define FFN_PROC(R, m_) do { const int mm_ = (m_); f32x4 v_[4]; ffn_combine(R, v_); ln_row(v_, g, b, lane); \
        store_row_f32_bf16(v_, layer == 0 ? (float*)nullptr : XF + (size_t)mm_ * D, layer == 0 ? XB + (size_t)mm_ * D : (bf16*)nullptr, lane); \
        if (layer == 0) { const float t_ = row_dots16(v_, WT, lane); if ((lane & 3) == 0 && eo < 12) LOGF[(size_t)mm_ * 12 + eo] = log_sigmoid(t_ + bf); } } while (0)
    FfnRow A0, A1, B0, B1;
#define FFN_PROC2(R0, R1, m0_, m1_) do { const int ma_ = (m0_), mb_ = (m1_); f32x4 va_[4], vb_[4]; ffn_combine(R0, va_); ffn_combine(R1, vb_); ln_row(va_, g, b, lane); ln_row(vb_, g, b, lane); \
        store_row_f32_bf16(va_, layer == 0 ? (float*)nullptr : XF + (size_t)ma_ * D, layer == 0 ? XB + (size_t)ma_ * D : (bf16*)nullptr, lane); \
        store_row_f32_bf16(vb_, layer == 0 ? (float*)nullptr : XF + (size_t)mb_ * D, layer == 0 ? XB + (size_t)mb_ * D : (bf16*)nullptr, lane); \
        if (layer == 0) { float ta_, tb_; row_dots16x2(va_, vb_, WT, lane, ta_, tb_); if ((lane & 3) == 0 && eo < 12) { LOGF[(size_t)ma_ * 12 + eo] = log_sigmoid(ta_ + bf); LOGF[(size_t)mb_ * 12 + eo] = log_sigmoid(tb_ + bf); } } } while (0)
    int m = gw;
    if (m + NGW < NTOK) { FFN_LOAD(A0, m); FFN_LOAD(A1, m + NGW); }
#pragma unroll 1
    for (; m + NGW < NTOK; m += 4 * NGW) {
        const bool hb = (m + 3 * NGW) < NTOK;
        if (hb) { FFN_LOAD(B0, m + 2 * NGW); FFN_LOAD(B1, m + 3 * NGW); }
        FFN_PROC2(A0, A1, m, m + NGW);
        if (m + 5 * NGW < NTOK) { FFN_LOAD(A0, m + 4 * NGW); FFN_LOAD(A1, m + 5 * NGW); }
        if (hb) FFN_PROC2(B0, B1, m + 2 * NGW, m + 3 * NGW); else { m += 2 * NGW; break; }
    }
    if (m < NTOK) { FFN_LOAD(A0, m); FFN_PROC(A0, m); }
#undef FFN_PROC2
#undef FFN_LOAD
#undef FFN_PROC
}
__device__ __forceinline__ void cum_wave(const float* LOGF, float* CUM, int bh, int lane) {
    const int b = bh / FOX_H, h = bh % FOX_H;
    float loc[64]; float s = 0.f;
#pragma unroll
    for (int i = 0; i < 64; ++i) { s += LOGF[((size_t)b * SEQ + lane * 64 + i) * 12 + h]; loc[i] = s; }
    float inc = s;
#pragma unroll
    for (int o = 1; o < 64; o <<= 1) { const float t = __shfl_up(inc, o); if (lane >= o) inc += t; }
    const float base = inc - s;
#pragma unroll
    for (int i = 0; i < 64; ++i) CUM[(size_t)bh * SEQ + lane * 64 + i] = base + loc[i];
}
constexpr int MOE_MAXU = 6;
__device__ __forceinline__ int moe_setup(unsigned char* ws, LAS unsigned char* lds, int G, int bid, const int wave_s, const bool build_rows) {
    const int tid = fresh_tid(wave_s), lane = tid & 63, wave = wave_s;
    LAS int* PRE = (LAS int*)lds; LAS int* TB = (LAS int*)(lds + 16640); LAS int* TE = TB + 17;
    volatile LAS int* UL = (volatile LAS int*)(lds + MISC_OFF) + 16; LAS int* rowtok = (LAS int*)(lds + ROWTOK_OFF);
    const int* CNT = (const int*)(ws + WS_CNT); const int* SLOT_TOK = (const int*)(ws + WS_SLOTTOK); int* TOK_S = (int*)(ws + WS_TOKS);
#pragma unroll
    for (int q = 0; q < 2; ++q) { const int e = 2 * wave + q;
        int c[4]; int s = 0;
#pragma unroll
        for (int i = 0; i < 4; ++i) { c[i] = CNT[(4 * lane + i) * 16 + e]; s += c[i]; }
        int inc = s;
#pragma unroll
        for (int o = 1; o < 64; o <<= 1) { const int t = __shfl_up(inc, o); if (lane >= o) inc += t; }
        int run = inc - s;
#pragma unroll
        for (int i = 0; i < 4; ++i) { PRE[e * 257 + 4 * lane + i] = run; run += c[i]; }
        if (lane == 63) { PRE[e * 257 + 256] = inc; TE[e] = inc; } }
    __syncthreads();
    if (tid <= 16) { int t = 0; for (int e = 0; e < 16; ++e) { if (e < tid) t += (TE[e] + 255) >> 8; } TB[tid] = t; }
    __syncthreads();
    const int NT = TB[16];
    if (tid < MOE_MAXU) { const int L = tid * G + bid, tile = (L & 7) + 8 * (L >> 5), pn = (L >> 3) & 3;
        int e = 0;
#pragma unroll
        for (int k = 1; k < 16; ++k) e += (TB[k] <= tile) ? 1 : 0;
        UL[3 * tid] = tile; UL[3 * tid + 1] = pn; UL[3 * tid + 2] = e; UL[32 + tid] = (tile < NT) ? 1 : 0; }
    __syncthreads();
    if (tid == 0) { int n = 0;
#pragma unroll
        for (int i = 0; i < MOE_MAXU; ++i) n += (int)UL[32 + i]; UL[24] = n; UL[25] = 32 * ((NT + 7) >> 3); }
    __syncthreads();
    const int nunits = __builtin_amdgcn_readfirstlane(UL[24]);
    if (build_rows) {
        for (int i = (tid >> 8); i < nunits; i += 2) { const int tile = UL[3 * i], pn = UL[3 * i + 1], e = UL[3 * i + 2], j = tid & 255;
            const int r = 256 * (tile - TB[e]) + j; int tok = 0;
            if (r < TE[e]) { int lo = 0, hi = 256;
                while (hi - lo > 1) { const int mid = (lo + hi) >> 1; if (PRE[e * 257 + mid] <= r) lo = mid; else hi = mid; }
                const int ent = SLOT_TOK[(e * 256 + lo) * 128 + (r - PRE[e * 257 + lo])]; tok = ent >> 1;
                if (pn == 0) TOK_S[ent] = 256 * tile + j; }
            rowtok[i * 256 + j] = tok; }
    }
    __syncthreads();
    return nunits;
}
struct MoeGU {
    const char* XBp; const char* W; LAS const int* UL; LAS const int* rowtok; int nunits;
    __device__ __forceinline__ bool next(int i, Unit& u) const { if (i >= nunits) return false;
        u.pm = __builtin_amdgcn_readfirstlane(UL[3 * i]); u.pn = __builtin_amdgcn_readfirstlane(UL[3 * i + 1]); u.e = __builtin_amdgcn_readfirstlane(UL[3 * i + 2]); u.ord = i;
        u.A = XBp; u.B = W + ((size_t)u.e * 1024 + (size_t)u.pn * 256) * D * 2; return true; }
    __device__ __forceinline__ unsigned a_off(const Unit& u, int h, int R, int C) const { return (unsigned)(rowtok[u.ord * 256 + R + HALF * h] * D + C) * 2u; }
};
struct MoeDown {
    const char* Hp; const char* W; LAS const int* UL; int nunits;
    __device__ __forceinline__ bool next(int i, Unit& u) const { if (i >= nunits) return false;
        u.pm = __builtin_amdgcn_readfirstlane(UL[3 * i]); u.pn = __builtin_amdgcn_readfirstlane(UL[3 * i + 1]); u.e = __builtin_amdgcn_readfirstlane(UL[3 * i + 2]); u.ord = i;
        u.A = Hp + (size_t)u.pm * BM * DEXP * 2; u.B = W + ((size_t)u.e * 1024 + (size_t)u.pn * 256) * DEXP * 2; return true; }
    __device__ __forceinline__ unsigned a_off(const Unit&, int h, int R, int C) const { return (unsigned)((R + HALF * h) * DEXP + C) * 2u; }
};
struct EpiGateUp { bf16* H;
    __device__ __forceinline__ void operator()(const f32x4 (&acc)[2][2][4][2], const Unit& u, int wr, int wc, int fr, int fq) const {
        GAS bf16* rowp = (GAS bf16*)H + (size_t)(u.pm * BM + wr * 64 + fr) * DEXP + (u.pn * 128 + wc * 32 + 8 * fq);
#pragma unroll
        for (int ai = 0; ai < 2; ++ai) {
#pragma unroll
            for (int m = 0; m < 4; ++m) { float hv[8];
#pragma unroll
                for (int n = 0; n < 2; ++n)
#pragma unroll
                    for (int j = 0; j < 4; ++j) { const float g = acc[ai][0][m][n][j], up = acc[ai][1][m][n][j]; hv[4 * n + j] = g * __builtin_amdgcn_rcpf(1.f + __expf(-g)) * up; }
                u32x4 w; w.x = cvt_pk_bf16(hv[0], hv[1]); w.y = cvt_pk_bf16(hv[2], hv[3]); w.z = cvt_pk_bf16(hv[4], hv[5]); w.w = cvt_pk_bf16(hv[6], hv[7]);
                *(GAS u32x4*)rowp = w;
                rowp += (size_t)16 * DEXP; asm volatile("" : "+v"(rowp)); }
            rowp += (size_t)64 * DEXP; }
    } };
__device__ __forceinline__ int crow(int r, int hi) { return (r & 3) + 8 * (r >> 2) + 4 * hi; }
__device__ __forceinline__ unsigned cvtpk_s(float lo, float hi) { typedef float f2 __attribute__((ext_vector_type(2))); typedef __bf16 b2 __attribute__((ext_vector_type(2))); f2 v = {lo, hi}; b2 b = __builtin_convertvector(v, b2); return __builtin_bit_cast(unsigned, b); }
__device__ __forceinline__ float bfbits2f(unsigned short v) { return __uint_as_float(((unsigned)v) << 16); }

constexpr int AT_NSLOT = 4, AT_SLOT = 16640, AT_K = 0, AT_V = 8192, AT_KB = 16384, AT_WS = AT_NSLOT * AT_SLOT, AT_OST = AT_WS + 2048, AT_BYTES = AT_OST + 8 * 4096;
static_assert(AT_BYTES <= RING_BYTES, "attention LDS");
__device__ __forceinline__ void glds_asm16(const void* gsrc, unsigned lds_dst) { unsigned keep;
    asm volatile("s_mov_b32 %0, m0\n\ts_mov_b32 m0, %2\n\ts_nop 0\n\tglobal_load_lds_dwordx4 %1, off\n\ts_mov_b32 m0, %0" : "=&s"(keep) : "v"(gsrc), "s"(lds_dst) : "memory"); }
__device__ __forceinline__ void glds_asm4(const void* gsrc, unsigned lds_dst) { unsigned keep;
    asm volatile("s_mov_b32 %0, m0\n\ts_mov_b32 m0, %2\n\ts_nop 0\n\tglobal_load_lds_dword %1, off\n\ts_mov_b32 m0, %0" : "=&s"(keep) : "v"(gsrc), "s"(lds_dst) : "memory"); }
constexpr float AT_THR = 10.0f, AT_SKIP = 40.0f;
template <bool FOX>
__device__ __forceinline__ void attn_qk(const LAS unsigned char* slot, const bf16x8 (&qr)[4], float mref, f32x16& p0, f32x16& p1, int r32, int hi) {
    const LAS unsigned char* kb = slot + AT_K + hi * 1024 + r32 * 16; const LAS float* kbs = (const LAS float*)(slot + AT_KB);
    if (FOX) { const float nm = -mref;
#pragma unroll
        for (int g = 0; g < 4; ++g) { const f32x4 b0 = *(const LAS f32x4*)(kbs + 8 * g + 4 * hi), b1 = *(const LAS f32x4*)(kbs + 32 + 8 * g + 4 * hi);
#pragma unroll
            for (int j = 0; j < 4; ++j) { p0[4 * g + j] = __builtin_fmaf(b0[j], -LOG2E, nm); p1[4 * g + j] = __builtin_fmaf(b1[j], -LOG2E, nm); } }
    } else { p0 = f32x16{}; p1 = f32x16{}; }
#pragma unroll
    for (int d0 = 0; d0 < 4; ++d0) { const bf16x8 b0 = *(const LAS bf16x8*)(kb + d0 * 2048), b1 = *(const LAS bf16x8*)(kb + d0 * 2048 + 512);
        p0 = __builtin_amdgcn_mfma_f32_32x32x16_bf16(b0, qr[d0], p0, 0, 0, 0); p1 = __builtin_amdgcn_mfma_f32_32x32x16_bf16(b1, qr[d0], p1, 0, 0, 0); }
}
template <bool FOX>
__device__ __forceinline__ void attn_sm_pv(const LAS unsigned char* slot, f32x16& p0, f32x16& p1, f32x16& n0, f32x16& n1, bool has_next, f32x16 (&o)[2], float& mref, float& lrun, bool& started, LAS float* wsf, int vb0, int jb, int qrel, int r32, int hi) {
    if (FOX) {
        if (jb >= 0) { const int kbase = 64 * jb + 4 * hi;
#pragma unroll
            for (int r = 0; r < 16; ++r) { const int kv = kbase + (r & 3) + 8 * (r >> 2); if (kv > qrel) p0[r] = -INFINITY; if (kv + 32 > qrel) p1[r] = -INFINITY; } }
    } else { const float nm = -mref;
#pragma unroll
        for (int r = 0; r < 16; ++r) { p0[r] = __builtin_fmaf(p0[r], QC2, nm); p1[r] = __builtin_fmaf(p1[r], QC2, nm); }
    }
    float rm = __builtin_fmaxf(p0[0], p1[0]), rm2 = __builtin_fmaxf(p0[1], p1[1]);
#pragma unroll
    for (int r = 2; r < 16; r += 2) { rm = __builtin_fmaxf(__builtin_fmaxf(rm, p0[r]), p1[r]); rm2 = __builtin_fmaxf(__builtin_fmaxf(rm2, p0[r + 1]), p1[r + 1]); }
    rm = __builtin_fmaxf(rm, rm2);
    { auto rr = __builtin_amdgcn_permlane32_swap(__float_as_uint(rm), __float_as_uint(rm), false, false); rm = fmaxf(__uint_as_float(rr[0]), __uint_as_float(rr[1])); }
    const bool live = rm > -1e30f, move = (rm > AT_THR) || (!started && live);
    started = started || live;
    if (__builtin_expect(__any(move), 0)) {
        const float dl = move ? rm : 0.f, f = __builtin_amdgcn_exp2f(fminf(-dl, 64.f));
        mref += dl; lrun *= f;
#pragma unroll
        for (int r = 0; r < 16; ++r) { p0[r] -= dl; p1[r] -= dl; }
        if (FOX && has_next) {
#pragma unroll
            for (int r = 0; r < 16; ++r) { n0[r] -= dl; n1[r] -= dl; } }
        if (hi == 0) wsf[r32] = f;
        asm volatile("s_waitcnt lgkmcnt(0)" ::: "memory");
#pragma unroll
        for (int g = 0; g < 4; ++g) { const f32x4 a = *(const LAS f32x4*)(wsf + 8 * g + 4 * hi);
#pragma unroll
            for (int j = 0; j < 4; ++j) { o[0][4 * g + j] *= a[j]; o[1][4 * g + j] *= a[j]; } }
    }
    float rs = 0.f;
#pragma unroll
    for (int r = 0; r < 16; ++r) { p0[r] = __builtin_amdgcn_exp2f(p0[r]); p1[r] = __builtin_amdgcn_exp2f(p1[r]); rs += p0[r] + p1[r]; }
    lrun += rs;
    u32x4 pw[4];
#pragma unroll
    for (int k = 0; k < 2; ++k) {
        pw[k] = (u32x4){cvtpk_s(p0[8 * k], p0[8 * k + 1]), cvtpk_s(p0[8 * k + 2], p0[8 * k + 3]), cvtpk_s(p0[8 * k + 4], p0[8 * k + 5]), cvtpk_s(p0[8 * k + 6], p0[8 * k + 7])};
        pw[2 + k] = (u32x4){cvtpk_s(p1[8 * k], p1[8 * k + 1]), cvtpk_s(p1[8 * k + 2], p1[8 * k + 3]), cvtpk_s(p1[8 * k + 4], p1[8 * k + 5]), cvtpk_s(p1[8 * k + 6], p1[8 * k + 7])}; }
    const int vb = vb0 + (int)(unsigned)(size_t)slot;
    s16x4 vlo[2][4], vhi[2][4];
#pragma unroll
    for (int d0 = 0; d0 < 2; ++d0) {
#pragma unroll
        for (int ks = 0; ks < 4; ++ks) {
            asm volatile("ds_read_b64_tr_b16 %0,%1 offset:%c2" : "=&v"(vlo[d0][ks]) : "v"(vb), "i"(d0 * 4096 + ks * 1024) : "memory");
            asm volatile("ds_read_b64_tr_b16 %0,%1 offset:%c2" : "=&v"(vhi[d0][ks]) : "v"(vb), "i"(d0 * 4096 + ks * 1024 + 512) : "memory"); } }
#pragma unroll
    for (int d0 = 0; d0 < 2; ++d0) {
        if (d0 == 0) asm volatile("s_waitcnt lgkmcnt(8)" : "+v"(vlo[0][0]), "+v"(vlo[0][1]), "+v"(vlo[0][2]), "+v"(vlo[0][3]), "+v"(vhi[0][0]), "+v"(vhi[0][1]), "+v"(vhi[0][2]), "+v"(vhi[0][3]) :: "memory");
        else asm volatile("s_waitcnt lgkmcnt(0)" : "+v"(vlo[1][0]), "+v"(vlo[1][1]), "+v"(vlo[1][2]), "+v"(vlo[1][3]), "+v"(vhi[1][0]), "+v"(vhi[1][1]), "+v"(vhi[1][2]), "+v"(vhi[1][3]) :: "memory");
        __builtin_amdgcn_sched_barrier(0);
#pragma unroll
        for (int ks = 0; ks < 4; ++ks) { const bf16x8 vf = (bf16x8){vlo[d0][ks][0], vlo[d0][ks][1], vlo[d0][ks][2], vlo[d0][ks][3], vhi[d0][ks][0], vhi[d0][ks][1], vhi[d0][ks][2], vhi[d0][ks][3]};
            o[d0] = __builtin_amdgcn_mfma_f32_32x32x16_bf16(__builtin_bit_cast(bf16x8, pw[ks]), vf, o[d0], 0, 0, 0); }
    }
}
template <bool FOX>
__device__ __forceinline__ void attn_unit(LAS unsigned char* lds, const bf16* Qp, int qpitch, const bf16* Kp, const bf16* Vp, int kvpitch, int NT, const float* cum, float qk_bound, bf16* Op, int opitch, const bf16* OGp, int gpitch, const int wave_s) {
    const int tid = fresh_tid(wave_s), lane = tid & 63, wid = wave_s, r32 = lane & 31, hi = lane >> 5; const int bid = blockIdx.x;
    LAS float* wsf = (LAS float*)(lds + AT_WS) + wid * 64;
    bf16x8 qr[4];
#pragma unroll
    for (int d0 = 0; d0 < 4; ++d0) qr[d0] = *(const bf16x8*)(Qp + (size_t)(wid * 32 + r32) * qpitch + d0 * 16 + hi * 8);
    const bf16* ksrc = Kp + (size_t)lane * kvpitch + wid * 8;
    const bf16* vsrc = Vp + (size_t)(16 * (wid & 3) + (lane >> 2)) * kvpitch + (wid >> 2) * 32 + (lane & 3) * 8;
    const int vb0 = AT_V + ((lane >> 4) & 1) * 32 + (lane & 3) * 8 + (4 * hi + ((lane & 15) >> 2)) * 64;
    float mref = 0.f, lrun = 0.f; bool started = false; f32x16 o[2]; o[0] = f32x16{}; o[1] = f32x16{};
    const int NTF = NT;
    if (FOX) { int i0 = NTF * 64 - 256; asm volatile("" : "+v"(i0));
        const float c0 = cum[i0], cl = cum[(lane < NTF ? lane : NTF - 1) * 64 + 63];
        const bool need = (lane < NTF) && ((c0 - cl) * LOG2E + 2.f * qk_bound >= -AT_SKIP);
        const int cnt = __builtin_popcountll(__ballot(need)); NT = cnt < 4 ? 4 : ((cnt + 1) & ~1); if (NT > NTF) NT = NTF; }
    const int qrel = wid * 32 + r32; const size_t tstep = (size_t)64 * kvpitch;
    constexpr int ND = FOX ? 3 : 2;
#define AT_TILE(tt) (FOX ? NTF - 1 - (tt) : (tt))
#define AT_ISSUE(tt) do { const unsigned sl_ = ldsb + (unsigned)(((tt) & (AT_NSLOT - 1)) * AT_SLOT); const int kt_ = AT_TILE(tt); \
        glds_asm16(ksrc + (size_t)kt_ * tstep, (unsigned)__builtin_amdgcn_readfirstlane(sl_ + AT_K + wid * 1024)); \
        glds_asm16(vsrc + (size_t)kt_ * tstep, (unsigned)__builtin_amdgcn_readfirstlane(sl_ + AT_V + wid * 1024)); \
        if (FOX) glds_asm4(cum + kt_ * 64 + lane, (unsigned)__builtin_amdgcn_readfirstlane(sl_ + AT_KB)); } while (0)
    const unsigned ldsb = (unsigned)(size_t)lds;
    AT_ISSUE(0); AT_ISSUE(1); AT_ISSUE(2);
#define AT_WAIT1() do { if (FOX) asm volatile("s_waitcnt vmcnt(3)" ::: "memory"); else asm volatile("s_waitcnt vmcnt(2)" ::: "memory"); } while (0)
#define AT_SLOTP(tt) (lds + ((tt) & (AT_NSLOT - 1)) * AT_SLOT)
#define AT_STEP(PC0, PC1, PN0, PN1, tt) do { const int t_ = (tt); const bool hn_ = t_ + 1 < NT; \
        { PSEC_BEGIN(10); if (t_ + 2 < NT) AT_WAIT1(); else asm volatile("s_waitcnt vmcnt(0)" ::: "memory"); \
        __builtin_amdgcn_s_barrier(); asm volatile("" ::: "memory"); PSEC_END(10); } \
        { PSEC_BEGIN(11); if (t_ + 3 < NT) AT_ISSUE(t_ + 3); PSEC_END(11); } \
        { PSEC_BEGIN(12); if (hn_) attn_qk<FOX>(AT_SLOTP(t_ + 1), qr, mref, PN0, PN1, r32, hi); PSEC_END(12); } \
        { PSEC_BEGIN(13); attn_sm_pv<FOX>(AT_SLOTP(t_), PC0, PC1, PN0, PN1, hn_, o, mref, lrun, started, wsf, vb0, AT_TILE(t_) - (NTF - 4), qrel, r32, hi); PSEC_END(13); } } while (0)
    f32x16 a0, a1, b0, b1;
    if (FOX) asm volatile("s_waitcnt vmcnt(6)" ::: "memory"); else asm volatile("s_waitcnt vmcnt(4)" ::: "memory");
    __builtin_amdgcn_s_barrier(); asm volatile("" ::: "memory");
    attn_qk<FOX>(AT_SLOTP(0), qr, mref, a0, a1, r32, hi);
#pragma unroll 1
    for (int t = 0; t < NT; t += 2) { AT_STEP(a0, a1, b0, b1, t); AT_STEP(b0, b1, a0, a1, t + 1); }
#undef AT_STEP
#undef AT_WAIT1
#undef AT_SLOTP
#undef AT_ISSUE
#undef AT_TILE
    static_assert(ND == 3 || ND == 2, "");
    { auto rr = __builtin_amdgcn_permlane32_swap(__float_as_uint(lrun), __float_as_uint(lrun), false, false); lrun = __uint_as_float(rr[0]) + __uint_as_float(rr[1]); }
    if (hi == 0) wsf[32 + r32] = lrun;
    asm volatile("s_waitcnt lgkmcnt(0)" ::: "memory");
    LAS bf16* stg = (LAS bf16*)(lds + AT_OST) + wid * 2048;
#pragma unroll
    for (int r = 0; r < 16; ++r) { const int orow = crow(r, hi); const float rl = __builtin_amdgcn_rcpf(wsf[32 + orow]);
#pragma unroll
        for (int d0 = 0; d0 < 2; ++d0) stg[orow * 64 + d0 * 32 + r32] = f2bf(o[d0][r] * rl); }
    asm volatile("s_waitcnt lgkmcnt(0)" ::: "memory");
#pragma unroll
    for (int i = 0; i < 4; ++i) { const int row = i * 8 + (lane >> 3), ch = lane & 7; u32x4 v = *(const LAS u32x4*)(stg + row * 64 + ch * 8);
        const size_t go = (size_t)(wid * 32 + row) * opitch + ch * 8;
        if (FOX) { const u32x4 g = *(const u32x4*)(OGp + (size_t)(wid * 32 + row) * gpitch + ch * 8); unsigned vv[4] = {v.x, v.y, v.z, v.w}; const unsigned gg[4] = {g.x, g.y, g.z, g.w};
#pragma unroll
            for (int k = 0; k < 4; ++k) { const float a0 = __uint_as_float(vv[k] << 16), a1 = __uint_as_float(vv[k] & 0xffff0000u), g0 = __uint_as_float(gg[k] << 16), g1 = __uint_as_float(gg[k] & 0xffff0000u);
                vv[k] = cvtpk_s(a0 * __builtin_amdgcn_rcpf(1.f + __expf(-g0)), a1 * __builtin_amdgcn_rcpf(1.f + __expf(-g1))); }
            v = (u32x4){vv[0], vv[1], vv[2], vv[3]}; }
        *(u32x4*)(Op + go) = v; }
    __syncthreads();
}
constexpr int CW_Q11 = 1024;
__device__ __forceinline__ float wave_max64(float v) {
    v = fmaxf(v, dppf<0xB1>(v)); v = fmaxf(v, dppf<0x4E>(v)); v = fmaxf(v, dppf<0x141>(v)); v = fmaxf(v, dppf<0x140>(v));
    { auto r = __builtin_amdgcn_permlane16_swap(__float_as_uint(v), __float_as_uint(v), false, false); v = fmaxf(__uint_as_float(r[0]), __uint_as_float(r[1])); }
    { auto r = __builtin_amdgcn_permlane32_swap(__float_as_uint(v), __float_as_uint(v), false, false); v = fmaxf(__uint_as_float(r[0]), __uint_as_float(r[1])); }
    return v;
}
__device__ __forceinline__ void phase_attn_b(KP p, LAS unsigned char* lds, const int wave_s) {
    unsigned char* ws = p->ws;
    const bf16* Q = (const bf16*)(ws + WS_HREG); const bf16* K = (const bf16*)(ws + WS_HREG + HR_48); const bf16* V = (const bf16*)(ws + WS_HREG + 2 * HR_48); const bf16* OG = (const bf16*)(ws + WS_HREG + 3 * HR_48);
    const bf16* MQ = (const bf16*)(ws + WS_HREG + 4 * HR_48); const bf16* MKV = (const bf16*)(ws + WS_MKV);
    const float* CUM = (const float*)(ws + WS_CUM); bf16* OC = (bf16*)(ws + WS_GREG);
    unsigned* qhead = (unsigned*)(ws + WS_CTL) + CW_Q11;
    volatile LAS unsigned* slotw = (volatile LAS unsigned*)(lds + MISC_OFF) + 48;
    float qkb; { const int lane = fresh_lane(); const float gq = wave_max64(fabsf(p->in[I_QNG][lane])), gk = wave_max64(fabsf(p->in[I_KNG][lane])); qkb = 64.f * gq * gk * QC2 * 1.02f; }
    for (;;) {
        if (fresh_tid(wave_s) == 0) slotw[0] = __hip_atomic_fetch_add(qhead, 1u, __ATOMIC_RELAXED, __HIP_MEMORY_SCOPE_AGENT);
        __syncthreads();
        const int u = (int)__builtin_amdgcn_readfirstlane(slotw[0]);
        if (u >= 1536 + 512) break;
        if (u < 1536) { const int qb = 15 - u / 96, bh = u % 96, b = bh / FOX_H, h = bh % FOX_H; const size_t row0 = (size_t)b * SEQ;
            attn_unit<true>(lds, Q + (row0 + qb * 256) * 768 + h * 64, 768, K + row0 * 768 + h * 64, V + row0 * 768 + h * 64, 768, 4 * (qb + 1), CUM + (size_t)bh * SEQ, qkb,
                            OC + (row0 + qb * 256) * D + h * 64, D, OG + (row0 + qb * 256) * 768 + h * 64, 768, wave_s); }
        else { const int m = u - 1536, b = m >> 6, hd = (m >> 4) & 3, qblk = m & 15; const size_t row0 = (size_t)b * SEQ + qblk * 256;
            const bf16* Kp = MKV + (size_t)b * NMEM * 1024 + 512 + hd * 64;
            attn_unit<false>(lds, MQ + row0 * 256 + hd * 64, 256, Kp, Kp + 256, 1024, 4, nullptr, 0.f, OC + row0 * D + 768 + hd * 64, D, nullptr, 0, wave_s); }
    }
}
__device__ __forceinline__ void phase_attn_mem(unsigned char* ws, unsigned char* oc0, LAS unsigned char* lds, int layer, int G, int bid, const int wave_s) {
    const bf16* MQ = (const bf16*)(ws + WS_HREG + (layer == 0 ? 3 : 4) * HR_48); const bf16* MKV = (const bf16*)(ws + WS_MKV); bf16* OC = (bf16*)(layer == 0 ? oc0 : ws + WS_GREG);
    for (int u = bid; u < 512; u += G) { const int b = u >> 6, hd = (u >> 4) & 3, qblk = u & 15; const size_t row0 = (size_t)b * SEQ + qblk * 256;
        const bf16* Kp = MKV + (size_t)b * NMEM * 1024 + layer * 512 + hd * 64;
        attn_unit<false>(lds, MQ + row0 * 256 + hd * 64, 256, Kp, Kp + 256, 1024, 4, nullptr, 0.f, OC + row0 * D + 768 + hd * 64, D, nullptr, 0, wave_s); }
}
constexpr int GL_QP = 208, GL_VP = 448, GL_KX = 0, GL_QD = 13312, GL_VT = 26624, GL_HEAD = 55296;
constexpr int GL_GLR = 2 * GL_HEAD, GL_TOT = GL_GLR + 4096, GL_SSX = GL_TOT + 1536, GL_BYTES = GL_SSX + 1024;
static_assert(GL_BYTES <= RING_BYTES, "GLA LDS");
typedef short v4i16_t __attribute__((ext_vector_type(4)));
typedef float f32x2 __attribute__((ext_vector_type(2)));
__device__ __forceinline__ s16x4 trd(const LAS unsigned char* p) { return __builtin_bit_cast(s16x4, __builtin_amdgcn_ds_read_tr16_b64_v4i16((LAS v4i16_t*)p)); }
__device__ __forceinline__ float fast_log_sigmoid(float z) { return fminf(z, 0.f) - __logf(1.f + __expf(-fabsf(z))); }

template <int MODE> struct GlaRegs { u32x4 v[6]; u32x4 qk[MODE == 1 ? 6 : 3]; f32x4 g; };
template <int MODE>
__device__ __forceinline__ void gla_fetch(unsigned char* ws, int tid, int unit, GlaRegs<MODE>& R) {
    const int hp = unit & 1, n = (unit >> 1) & 63, b = unit >> 7;
    const bf16* V = (const bf16*)(ws + WS_HREG + HR_48); const float* GLR = (const float*)(ws + WS_GLR); const bf16* QK = (const bf16*)(ws + WS_HREG);
    const size_t m0 = (size_t)b * SEQ + n * 64;
#pragma unroll
    for (int i = 0; i < 6; ++i) { const int pi = tid + 512 * i, u = pi / 1536, rem = pi % 1536, row = rem / 24, ch = rem % 24;
        R.v[i] = *(const u32x4*)(V + (m0 + row) * 768 + 192 * (2 * hp + u) + 8 * ch); }
#pragma unroll
    for (int i = 0; i < (MODE == 1 ? 6 : 3); ++i) { const int pi = tid + 512 * i, ts = pi / 1536, rem = pi % 1536, u = rem / 768, r2 = rem % 768, row = r2 / 12, ch = r2 % 12;
        R.qk[i] = *(const u32x4*)(QK + (m0 + row) * 768 + (ts == 0 ? 384 : 0) + 96 * (2 * hp + u) + 8 * ch); }
    if (tid < 256) R.g = *(const f32x4*)(GLR + m0 * 16 + 4 * tid);
}
template <int MODE>
__device__ __forceinline__ void gla_put(LAS unsigned char* lds, int tid, const GlaRegs<MODE>& R) {
#pragma unroll
    for (int i = 0; i < 6; ++i) { const int pi = tid + 512 * i, u = pi / 1536, rem = pi % 1536, row = rem / 24, ch = rem % 24;
        *(LAS u32x4*)(lds + u * GL_HEAD + GL_VT + row * GL_VP + ch * 16) = R.v[i]; }
#pragma unroll
    for (int i = 0; i < (MODE == 1 ? 6 : 3); ++i) { const int pi = tid + 512 * i, ts = pi / 1536, rem = pi % 1536, u = rem / 768, r2 = rem % 768, row = r2 / 12, ch = r2 % 12;
        *(LAS u32x4*)(lds + u * GL_HEAD + (ts == 0 ? GL_KX : GL_QD) + row * GL_QP + ch * 16) = R.qk[i]; }
    if (tid < 256) *(LAS f32x4*)(lds + GL_GLR + 16 * tid) = R.g;
}
template <int MODE>
__device__ __forceinline__ void gla_gates(KP p, unsigned char* ws, LAS unsigned char* lds, int tid, int b, int n, int hp) {
    float* DEC = (float*)(ws + WS_DEC);
    const size_t m0 = (size_t)b * SEQ + n * 64;
    LAS float* glr = (LAS float*)(lds + GL_GLR); LAS float* totl = (LAS float*)(lds + GL_TOT);
    float la[32]; float tot = 0.f; int col = 0, th = 0, u = 0, kidx = 0, head = 0;
    if (tid < 384) { col = tid % 192; th = tid / 192; u = col / 96; kidx = col % 96; head = 2 * hp + u;
        float w[16];
#pragma unroll
        for (int j = 0; j < 16; ++j) w[j] = p->in[I_WGUP][j * 384 + 96 * head + kidx];
        const float bg = p->in[I_BGATE][96 * head + kidx];
#pragma unroll
        for (int i = 0; i < 32; i += 2) { const LAS float* gr = glr + (32 * th + i) * 16; f32x2 z = (f32x2){bg, bg};
#pragma unroll
            for (int j4 = 0; j4 < 4; ++j4) { const f32x4 g0 = *(const LAS f32x4*)(gr + 4 * j4), g1 = *(const LAS f32x4*)(gr + 16 + 4 * j4);
#pragma unroll
                for (int k = 0; k < 4; ++k) z = (f32x2){g0[k], g1[k]} * w[4 * j4 + k] + z; }
            la[i] = fast_log_sigmoid(z[0]) * (1.f / 16.f); la[i + 1] = fast_log_sigmoid(z[1]) * (1.f / 16.f); tot += la[i] + la[i + 1]; }
        totl[th * 192 + col] = tot; }
    __syncthreads();
    if (tid < 384) {
        LAS bf16* KX = (LAS bf16*)(lds + u * GL_HEAD + GL_KX); LAS bf16* QD = (LAS bf16*)(lds + u * GL_HEAD + GL_QD);
        if (MODE == 0) {
            float run = (th == 1) ? 0.f : totl[192 + col];
            float kraw[32];
#pragma unroll
            for (int i = 0; i < 32; ++i) kraw[i] = bf2f(KX[(32 * th + i) * (GL_QP / 2) + kidx]);
#pragma unroll
            for (int i = 31; i >= 0; --i) { KX[(32 * th + i) * (GL_QP / 2) + kidx] = f2bf(kraw[i] * __expf(run)); run += la[i]; }
            if (th == 0) DEC[(((size_t)b * 64 + n) * 4 + head) * 96 + kidx] = __expf(run);
        } else {
            float run = (th == 0) ? 0.f : totl[col];
            float qraw[32], kraw[32];
#pragma unroll
            for (int i = 0; i < 32; ++i) { qraw[i] = bf2f(QD[(32 * th + i) * (GL_QP / 2) + kidx]); kraw[i] = bf2f(KX[(32 * th + i) * (GL_QP / 2) + kidx]); }
#pragma unroll
            for (int i = 0; i < 32; ++i) { run += la[i]; const unsigned pk = cvt_pk_bf16(qraw[i] * __expf(run) * 0.10206207261596577f, kraw[i] * __expf(-run));
                QD[(32 * th + i) * (GL_QP / 2) + kidx] = (bf16)(pk & 0xffffu); KX[(32 * th + i) * (GL_QP / 2) + kidx] = (bf16)(pk >> 16); }
        }
    }
    __syncthreads();
}
__device__ __forceinline__ void phase_gla_kv(KP p, LAS unsigned char* lds, int G, int bid, const int wave_s) {
    unsigned char* ws = p->ws; bf16* SKV = (bf16*)(ws + WS_GREG);
    GlaRegs<0> R;
    if (bid < NB * 64 * 2) gla_fetch<0>(ws, fresh_tid(wave_s), bid, R);
    for (int unit = bid; unit < NB * 64 * 2; unit += G) {
        const int tid = fresh_tid(wave_s), lane = tid & 63, wid = wave_s;
        const int hp = unit & 1, n = (unit >> 1) & 63, b = unit >> 7;
        { PSEC_BEGIN(40); gla_put<0>(lds, tid, R);
        __syncthreads(); PSEC_END(40); }
        if (unit + G < NB * 64 * 2) gla_fetch<0>(ws, tid, unit + G, R);
        { PSEC_BEGIN(41); gla_gates<0>(p, ws, lds, tid, b, n, hp); PSEC_END(41); }
        PSEC_BEGIN(42);
        const int u = wid >> 2, j4 = wid & 3, head = 2 * hp + u, r32 = lane & 31, h2 = lane >> 5, q = (lane & 15) >> 2, pp = lane & 3, g1 = (lane >> 4) & 1;
        const LAS unsigned char* ka = lds + u * GL_HEAD + GL_KX + (8 * h2 + q) * GL_QP + (16 * g1 + 4 * pp) * 2;
        const LAS unsigned char* va = lds + u * GL_HEAD + GL_VT + (8 * h2 + q) * GL_VP + (16 * g1 + 4 * pp) * 2;
        bf16* outb = SKV + ((((size_t)b * 64 + n) * 4 + head) * 192) * 96;
        for (int id = j4; id < 18; id += 4) { const int kb = id / 6, cb = id % 6;
            f32x16 acc = f32x16{};
#pragma unroll
            for (int ks = 0; ks < 4; ++ks) {
                const s16x4 a0 = trd(ka + ks * 16 * GL_QP + kb * 64), a1 = trd(ka + ks * 16 * GL_QP + 4 * GL_QP + kb * 64);
                const s16x4 b0 = trd(va + ks * 16 * GL_VP + cb * 64), b1 = trd(va + ks * 16 * GL_VP + 4 * GL_VP + cb * 64);
                acc = __builtin_amdgcn_mfma_f32_32x32x16_bf16((bf16x8){a0[0], a0[1], a0[2], a0[3], a1[0], a1[1], a1[2], a1[3]}, (bf16x8){b0[0], b0[1], b0[2], b0[3], b1[0], b1[1], b1[2], b1[3]}, acc, 0, 0, 0); }
            bf16* op = outb + (size_t)(32 * cb + r32) * 96 + 32 * kb + 4 * h2;
#pragma unroll
            for (int g = 0; g < 4; ++g) { u32x2 w; w.x = cvtpk_s(acc[4 * g], acc[4 * g + 1]); w.y = cvtpk_s(acc[4 * g + 2], acc[4 * g + 3]); *(u32x2*)(op + 8 * g) = w; }
        }
        __syncthreads();
        PSEC_END(42);
    }
}
__device__ __forceinline__ void phase_gla_scan(unsigned char* ws, int G, int bid, const int wave_s) {
    bf16* SKV = (bf16*)(ws + WS_GREG); const float* DEC = (const float*)(ws + WS_DEC);
    const int tid = fresh_tid(wave_s);
    constexpr int NITEM = NB * 4 * 192 * 12;
    const int per = (NITEM + G - 1) / G;
    for (int it = tid; it < per; it += NTHREADS) { const int item = bid * per + it; if (item >= NITEM) break;
        const int k8 = item % 12, c = (item / 12) % 192, bh = item / (12 * 192), b = bh >> 2, h = bh & 3;
        float s[8];
#pragma unroll
        for (int j = 0; j < 8; ++j) s[j] = 0.f;
        u32x4* ptr = (u32x4*)(SKV + ((((size_t)b * 64) * 4 + h) * 192 + c) * 96 + 8 * k8); const float* dp = DEC + (((size_t)b * 64) * 4 + h) * 96 + 8 * k8;
#pragma unroll 1
        for (int n0 = 0; n0 < 64; n0 += 8) { u32x4 kv[8]; f32x4 d0[8], d1[8];
#pragma unroll
            for (int i = 0; i < 8; ++i) { kv[i] = ptr[(size_t)(n0 + i) * (4 * 192 * 96 / 8)]; d0[i] = *(const f32x4*)(dp + (size_t)(n0 + i) * 4 * 96); d1[i] = *(const f32x4*)(dp + (size_t)(n0 + i) * 4 * 96 + 4); }
#pragma unroll
            for (int i = 0; i < 8; ++i) { u32x4 o; o.x = cvtpk_s(s[0], s[1]); o.y = cvtpk_s(s[2], s[3]); o.z = cvtpk_s(s[4], s[5]); o.w = cvtpk_s(s[6], s[7]); ptr[(size_t)(n0 + i) * (4 * 192 * 96 / 8)] = o;
                const unsigned kw[4] = {kv[i].x, kv[i].y, kv[i].z, kv[i].w};
#pragma unroll
                for (int j = 0; j < 4; ++j) { const float dlo = j < 2 ? d0[i][2 * j] : d1[i][2 * j - 4], dhi = j < 2 ? d0[i][2 * j + 1] : d1[i][2 * j - 3];
                    s[2 * j] = dlo * s[2 * j] + __uint_as_float(kw[j] << 16); s[2 * j + 1] = dhi * s[2 * j + 1] + __uint_as_float(kw[j] & 0xffff0000u); } } }
    }
}
__device__ __forceinline__ void phase_gla_out(KP p, LAS unsigned char* lds, int G, int bid, const int wave_s) {
    unsigned char* ws = p->ws; const bf16* SKV = (const bf16*)(ws + WS_GREG); const bf16* R = (const bf16*)(ws + WS_HREG + 2 * HR_48); bf16* OC = (bf16*)((unsigned char*)p->out + OUT_HI);
    GlaRegs<1> RG;
    if (bid < NB * 64 * 2) gla_fetch<1>(ws, fresh_tid(wave_s), bid, RG);
    for (int unit = bid; unit < NB * 64 * 2; unit += G) {
        const int tid = fresh_tid(wave_s), lane = tid & 63, wid = wave_s;
        const int hp = unit & 1, n = (unit >> 1) & 63, b = unit >> 7;
        u32x2 rv12[12];
        { const int tb_ = wid & 1, ch_ = (wid >> 1) & 1, head_ = 2 * hp + (wid >> 2); const size_t m_ = (size_t)b * SEQ + n * 64 + 32 * tb_ + (lane & 31);
          const bf16* rp_ = R + m_ * 768 + 192 * head_ + 96 * ch_ + 4 * (lane >> 5);
#pragma unroll
          for (int q = 0; q < 12; ++q) rv12[q] = *(const u32x2*)(rp_ + 32 * (q >> 2) + 8 * (q & 3)); }
        { PSEC_BEGIN(30); gla_put<1>(lds, tid, RG);
        __syncthreads(); PSEC_END(30); }
        if (unit + G < NB * 64 * 2) gla_fetch<1>(ws, tid, unit + G, RG);
        { PSEC_BEGIN(31); gla_gates<1>(p, ws, lds, tid, b, n, hp); PSEC_END(31); }
        PSEC_BEGIN(32);
        const int u = wid >> 2, tb = wid & 1, ch = (wid >> 1) & 1, head = 2 * hp + u, r32 = lane & 31, h2 = lane >> 5, q = (lane & 15) >> 2, pp = lane & 3, g1 = (lane >> 4) & 1;
        const LAS unsigned char* kx = lds + u * GL_HEAD + GL_KX + r32 * GL_QP + 16 * h2;
        const LAS unsigned char* qd = lds + u * GL_HEAD + GL_QD + (32 * tb + r32) * GL_QP + 16 * h2;
        const LAS unsigned char* va = lds + u * GL_HEAD + GL_VT + (4 * h2 + q) * GL_VP + (16 * g1 + 4 * pp) * 2;
        bf16x8 qf[6];
#pragma unroll
        for (int ks = 0; ks < 6; ++ks) qf[ks] = *(const LAS bf16x8*)(qd + 32 * ks);
        f32x16 at0 = f32x16{}, at1 = f32x16{};
#pragma unroll
        for (int ks = 0; ks < 6; ++ks) at0 = __builtin_amdgcn_mfma_f32_32x32x16_bf16(*(const LAS bf16x8*)(kx + 32 * ks), qf[ks], at0, 0, 0, 0);
        if (tb == 1) {
#pragma unroll
            for (int ks = 0; ks < 6; ++ks) at1 = __builtin_amdgcn_mfma_f32_32x32x16_bf16(*(const LAS bf16x8*)(kx + 32 * GL_QP + 32 * ks), qf[ks], at1, 0, 0, 0);
        }
#pragma unroll
        for (int r = 0; r < 16; ++r) { const bool keep = crow(r, h2) <= r32; if (tb == 0) { if (!keep) at0[r] = 0.f; } else { if (!keep) at1[r] = 0.f; } }
        bf16x8 pb[4];
#pragma unroll
        for (int k2 = 0; k2 < 2; ++k2) {
            pb[k2] = __builtin_bit_cast(bf16x8, (u32x4){cvtpk_s(at0[8 * k2], at0[8 * k2 + 1]), cvtpk_s(at0[8 * k2 + 2], at0[8 * k2 + 3]), cvtpk_s(at0[8 * k2 + 4], at0[8 * k2 + 5]), cvtpk_s(at0[8 * k2 + 6], at0[8 * k2 + 7])});
            pb[2 + k2] = __builtin_bit_cast(bf16x8, (u32x4){cvtpk_s(at1[8 * k2], at1[8 * k2 + 1]), cvtpk_s(at1[8 * k2 + 2], at1[8 * k2 + 3]), cvtpk_s(at1[8 * k2 + 4], at1[8 * k2 + 5]), cvtpk_s(at1[8 * k2 + 6], at1[8 * k2 + 7])}); }
        const bf16* sg = SKV + ((((size_t)b * 64 + n) * 4 + head) * 192 + 96 * ch + r32) * 96 + 8 * h2;
        f32x16 o[3];
#pragma unroll
        for (int cbl = 0; cbl < 3; ++cbl) { const int cb = 3 * ch + cbl; f32x16 acc = f32x16{};
#pragma unroll
            for (int kq = 0; kq < 4; ++kq) { if (kq < 2 || tb == 1) {
                const s16x4 a0 = trd(va + kq * 16 * GL_VP + cb * 64), a1 = trd(va + kq * 16 * GL_VP + 8 * GL_VP + cb * 64);
                acc = __builtin_amdgcn_mfma_f32_32x32x16_bf16((bf16x8){a0[0], a0[1], a0[2], a0[3], a1[0], a1[1], a1[2], a1[3]}, pb[kq], acc, 0, 0, 0); } }
#pragma unroll
            for (int ks = 0; ks < 6; ++ks) { const bf16x8 sf = *(const bf16x8*)(sg + (size_t)(32 * cbl) * 96 + 16 * ks);
                acc = __builtin_amdgcn_mfma_f32_32x32x16_bf16(sf, qf[ks], acc, 0, 0, 0); }
            o[cbl] = acc; }
        asm volatile("" : "+v"(o[0]), "+v"(o[1]), "+v"(o[2])); PSEC_END(32);
        PSEC_BEGIN(33);
        float ss = 0.f;
#pragma unroll
        for (int cbl = 0; cbl < 3; ++cbl)
#pragma unroll
            for (int r = 0; r < 16; ++r) ss += o[cbl][r] * o[cbl][r];
        { auto rr = __builtin_amdgcn_permlane32_swap(__float_as_uint(ss), __float_as_uint(ss), false, false); ss = __uint_as_float(rr[0]) + __uint_as_float(rr[1]); }
        LAS float* ssx = (LAS float*)(lds + GL_SSX);
        if (h2 == 0) ssx[((u * 2 + tb) * 2 + ch) * 32 + r32] = ss;
        __syncthreads();
        ss += ssx[((u * 2 + tb) * 2 + (ch ^ 1)) * 32 + r32];
        const float rs = rsqrtf(ss * (1.f / 192.f) + RMS_EPS);
        const size_t m = (size_t)b * SEQ + n * 64 + 32 * tb + r32;
        bf16* op = OC + m * D + 192 * head + 96 * ch + 4 * h2; const float* gp = p->in[I_GLAG] + 96 * ch + 4 * h2;
#pragma unroll
        for (int cbl = 0; cbl < 3; ++cbl)
#pragma unroll
            for (int g = 0; g < 4; ++g) { const int co = 32 * cbl + 8 * g; const u32x2 rv = rv12[4 * cbl + g]; const f32x4 gn = *(const f32x4*)(gp + co);
                const float r0 = __uint_as_float(rv.x << 16), r1 = __uint_as_float(rv.x & 0xffff0000u), r2 = __uint_as_float(rv.y << 16), r3 = __uint_as_float(rv.y & 0xffff0000u);
                const float v0 = o[cbl][4 * g] * rs * gn[0] * (r0 * __builtin_amdgcn_rcpf(1.f + __expf(-r0))), v1 = o[cbl][4 * g + 1] * rs * gn[1] * (r1 * __builtin_amdgcn_rcpf(1.f + __expf(-r1)));
                const float v2 = o[cbl][4 * g + 2] * rs * gn[2] * (r2 * __builtin_amdgcn_rcpf(1.f + __expf(-r2))), v3 = o[cbl][4 * g + 3] * rs * gn[3] * (r3 * __builtin_amdgcn_rcpf(1.f + __expf(-r3)));
                u32x2 w; w.x = cvtpk_s(v0, v1); w.y = cvtpk_s(v2, v3); *(u32x2*)(op + co) = w; }
        __syncthreads();
        PSEC_END(33);
    }
}
constexpr int PROBE_J = -1, PROBE_B = 0, PROBE_K = 4;
__global__ void __launch_bounds__(NTHREADS, 2) mega(Params p_unused) {
    extern __shared__ __attribute__((aligned(16))) unsigned char lds_raw[];
    LAS unsigned char* lds = (LAS unsigned char*)lds_raw;
    const int G = gridDim.x, bid = blockIdx.x; const int wave_s = __builtin_amdgcn_readfirstlane(threadIdx.x >> 6);
    volatile LAS unsigned* MISC = (volatile LAS unsigned*)(lds + MISC_OFF);
    if (threadIdx.x < 64) MISC[threadIdx.x] = 0u;
    __syncthreads();
    KP p = fresh_kp();
    unsigned char* ws = p->ws;
    volatile LAS unsigned* STAMPS = (volatile LAS unsigned*)(lds + ROWTOK_OFF + 6144);
    if (PROBE_J >= 0 && threadIdx.x == 0) { const unsigned long long t_ = __builtin_amdgcn_s_memrealtime(); STAMPS[0] = (unsigned)t_; STAMPS[1] = (unsigned)(t_ >> 32); }
    if (PROBE_SEC >= 0 && threadIdx.x == 0) *(volatile LAS unsigned*)(lds + PSEC_OFF) = 0u;
    XcdBarrier bar = xcd_barrier_post((unsigned*)(ws + WS_CTL) + CW_BAR + p->bar_li * XCD_BAR_WORDS, MISC + 8);
#define WS (fresh_kp()->ws)
#define IN(k) ({ KP _q = fresh_kp(); const bool _r = _q->ph_lo <= (k) && (k) < _q->ph_hi; _r; })
#define SEAM(k) do { if (IN(k) && IN((k) + 1)) xcd_barrier(bar); if (PROBE_J >= 0 && threadIdx.x == 0) { const unsigned long long t_ = __builtin_amdgcn_s_memrealtime(); STAMPS[2 * ((k) + 1)] = (unsigned)t_; STAMPS[2 * ((k) + 1) + 1] = (unsigned)(t_ >> 32); } } while (0)

    if (IN(0)) { phase_prologue(fresh_kp(), lds, G, bid, wave_s); }
    SEAM(0);
    if (IN(1)) { unsigned char* wsl = WS;
        { TileOrder S; S.init(wsl + WS_XB, wsl + WS_WA, NTOK, 2560, D, G, bid);
          EpiInA E{(bf16*)(wsl + WS_HREG), (bf16*)(wsl + WS_HREG + HR_48), (bf16*)(wsl + WS_HREG + 2 * HR_48), (bf16*)(wsl + WS_HREG + 3 * HR_48)};
          gemm_phase<41>(lds + RING_OFF, D, S, E, wave_s); }
    }
    SEAM(1);
    if (IN(2)) phase_gla_kv(fresh_kp(), lds, G, bid, wave_s);
    SEAM(2);
    if (IN(3)) { unsigned char* wsl = WS;
        if (G > 32 && bid < 16) { TileOrder S; S.init(wsl + WS_MEMB, wsl + WS_WMKV, NB * NMEM, 512, D, 16, bid);
            EpiPlain E{(bf16*)(wsl + WS_MKV), 1024};
            gemm_phase(lds + RING_OFF, D, S, E, wave_s); }
        else { phase_gla_scan(wsl, G > 32 ? G - 16 : G, G > 32 ? bid - 16 : bid, wave_s); __syncthreads(); if (G > 32) convert_from_queue(fresh_kp(), lds, wave_s, 4, CW_CVQA, CV_A_STATIC, CV_QA); }
        if (G <= 32) { TileOrder S; S.init(wsl + WS_MEMB, wsl + WS_WMKV, NB * NMEM, 512, D, G, bid); EpiPlain E{(bf16*)(wsl + WS_MKV), 1024}; gemm_phase(lds + RING_OFF, D, S, E, wave_s); } }
    SEAM(3);
    if (IN(4)) { phase_gla_out(fresh_kp(), lds, G, bid, wave_s); unsigned char* wsl = WS; { PSEC_BEGIN(45); phase_attn_mem(wsl, (unsigned char*)fresh_kp()->out + OUT_HI, lds, 0, G, bid, wave_s); PSEC_END(45); } }
    SEAM(4);
        if (IN(5)) { unsigned char* wsl = WS;
            KP q = fresh_kp();
            TileOrder S; S.init((unsigned char*)q->out + OUT_HI, wsl + WS_WO + (size_t)0 * D * D * 2, NTOK, D, D, G, bid);
            EpiRes<true> E{(const void*)(wsl + WS_XB), (bf16*)q->out};
            gemm_phase<42>(lds + RING_OFF, D, S, E, wave_s);
        }
        SEAM(5);
        if (IN(5 + 1)) { phase_ln_router(fresh_kp(), 0, lds, G, bid, wave_s); convert_from_queue(fresh_kp(), lds, wave_s, -1, CW_CVQA, CV_A_STATIC, CV_QA); }
        SEAM(5 + 1);
        if (IN(5 + 2)) { unsigned char* wsl = WS;
            const int nu = moe_setup(wsl, lds, G, bid, wave_s, true);
            MoeGU S{(const char*)(wsl + WS_XB), (const char*)(wsl + WS_WGU) + (size_t)0 * NEXP * 1024 * D * 2, (LAS const int*)(lds + MISC_OFF) + 16, (LAS const int*)(lds + ROWTOK_OFF), nu};
            EpiGateUp E{(bf16*)(wsl + WS_GREG)};
            gemm_phase<43>(lds + RING_OFF, D, S, E, wave_s);
            if (nu * G < (int)__builtin_amdgcn_readfirstlane(((volatile LAS int*)(lds + MISC_OFF))[16 + 25])) convert_from_queue(fresh_kp(), lds, wave_s, 4);
        }
        SEAM(5 + 2);
        if (IN(5 + 3)) { unsigned char* wsl = WS;
            const int nu = moe_setup(wsl, lds, G, bid, wave_s, false);
            MoeDown S{(const char*)(wsl + WS_GREG), (const char*)(wsl + WS_WD) + (size_t)0 * NEXP * 1024 * DEXP * 2, (LAS const int*)(lds + MISC_OFF) + 16, nu};
            EpiPlain E{(bf16*)(wsl + WS_HREG), 1024};
            gemm_phase<44>(lds + RING_OFF, DEXP, S, E, wave_s);
            if (nu * G < (int)__builtin_amdgcn_readfirstlane(((volatile LAS int*)(lds + MISC_OFF))[16 + 25])) convert_from_queue(fresh_kp(), lds, wave_s, 2);
        }
        SEAM(5 + 3);
        if (IN(5 + 4)) phase_ln_ffn(fresh_kp(), 0, lds, G, bid, wave_s);

            SEAM(9);
            if (IN(10)) { unsigned char* wsl = WS;
                KP q = fresh_kp();
                TileOrder S; S.init(wsl + WS_XB, wsl + WS_WB, NTOK, 3328, D, G, bid);
                EpiInB E{(bf16*)(wsl + WS_HREG), (bf16*)(wsl + WS_HREG + HR_48), (bf16*)(wsl + WS_HREG + 2 * HR_48), (bf16*)(wsl + WS_HREG + 3 * HR_48), (bf16*)(wsl + WS_HREG + 4 * HR_48), q->in[I_QNG], q->in[I_KNG]};
                gemm_phase<45>(lds + RING_OFF, D, S, E, wave_s);
                {
                    const int c2 = (G >= 160) ? bid - 128 : bid; const int G2 = (G >= 160) ? 16 : G;
                    if (c2 >= 0 && c2 < G2) { TileOrder S2; S2.init(wsl + WS_MEMB, wsl + WS_WMKV + (size_t)512 * D * 2, NB * NMEM, 512, D, G2, c2);
                        EpiPlain E2{(bf16*)(wsl + WS_MKV) + 512, 1024};
                        gemm_phase(lds + RING_OFF, D, S2, E2, wave_s); } }
                if (G == 256 && bid >= 144 && bid < 244) convert_from_queue(fresh_kp(), lds, wave_s, 4);
                const int gwr = (G - 1 - bid) * NWAVES + wave_s;
                if (gwr < NB * FOX_H) cum_wave((const float*)(wsl + WS_LOGF), (float*)(wsl + WS_CUM), gwr, fresh_lane());
            }
            SEAM(10);
            if (IN(11)) phase_attn_b(fresh_kp(), lds, wave_s);
            SEAM(11);
        if (IN(12)) { unsigned char* wsl = WS;
            KP q = fresh_kp();
            TileOrder S; S.init(wsl + WS_GREG, wsl + WS_WO + (size_t)1 * D * D * 2, NTOK, D, D, G, bid);
            EpiRes<true> E{(const void*)(wsl + WS_XB), (bf16*)q->out};
            gemm_phase<46>(lds + RING_OFF, D, S, E, wave_s);
        }
        SEAM(12);
        if (IN(12 + 1)) { phase_ln_router(fresh_kp(), 1, lds, G, bid, wave_s); convert_from_queue(fresh_kp(), lds, wave_s, -1); }
        SEAM(12 + 1);
        if (IN(12 + 2)) { unsigned char* wsl = WS;
            const int nu = moe_setup(wsl, lds, G, bid, wave_s, true);
            MoeGU S{(const char*)(wsl + WS_XB), (const char*)(wsl + WS_WGU) + (size_t)1 * NEXP * 1024 * D * 2, (LAS const int*)(lds + MISC_OFF) + 16, (LAS const int*)(lds + ROWTOK_OFF), nu};
            EpiGateUp E{(bf16*)(wsl + WS_GREG)};
            gemm_phase<47>(lds + RING_OFF, D, S, E, wave_s);
        }
        SEAM(12 + 2);
        if (IN(12 + 3)) { unsigned char* wsl = WS;
            const int nu = moe_setup(wsl, lds, G, bid, wave_s, false);
            MoeDown S{(const char*)(wsl + WS_GREG), (const char*)(wsl + WS_WD) + (size_t)1 * NEXP * 1024 * DEXP * 2, (LAS const int*)(lds + MISC_OFF) + 16, nu};
            EpiPlain E{(bf16*)(wsl + WS_HREG), 1024};
            gemm_phase<48>(lds + RING_OFF, DEXP, S, E, wave_s);
        }
        SEAM(12 + 3);
        if (IN(12 + 4)) phase_ln_ffn(fresh_kp(), 1, lds, G, bid, wave_s);
        SEAM(16);
    if (PROBE_J >= 0 && blockIdx.x == 0 && threadIdx.x == 0) {
        const unsigned long long t1 = ((unsigned long long)STAMPS[2 * PROBE_B + 1] << 32) | STAMPS[2 * PROBE_B], t0 = ((unsigned long long)STAMPS[2 * PROBE_J + 1] << 32) | STAMPS[2 * PROBE_J];
        const unsigned long long wait = (t1 - t0) * PROBE_K, ts = __builtin_amdgcn_s_memrealtime();
        while (__builtin_amdgcn_s_memrealtime() - ts < wait) __builtin_amdgcn_s_sleep(8);
    }
    if (PROBE_SEC >= 0 && blockIdx.x == 0 && threadIdx.x == 0) {
        const unsigned long long wait = (unsigned long long)(*(volatile LAS unsigned*)(lds + PSEC_OFF)) * PROBE_K, ts = __builtin_amdgcn_s_memrealtime();
        while (__builtin_amdgcn_s_memrealtime() - ts < wait) __builtin_amdgcn_s_sleep(8);
    }
#undef IN
#undef SEAM
#undef WS
}
#undef LAS
#undef GAS
}

static int pk_grid() {
    static int grid = 0;
    if (grid == 0) {
        int dev = 0, cus = 0;
        if (hipGetDevice(&dev) != hipSuccess || hipDeviceGetAttribute(&cus, hipDeviceAttributeMultiprocessorCount, dev) != hipSuccess) { grid = -1; return grid; }
        if (hipFuncSetAttribute((const void*)pk::mega, hipFuncAttributeMaxDynamicSharedMemorySize, pk::LDS_BYTES) != hipSuccess) { fprintf(stderr, "kernel_launch: hipFuncSetAttribute failed\n"); grid = -1; return grid; }
        int per_cu = 0;
        if (hipOccupancyMaxActiveBlocksPerMultiprocessor(&per_cu, (const void*)pk::mega, pk::NTHREADS, pk::LDS_BYTES) != hipSuccess || per_cu < 1) fprintf(stderr, "kernel_launch: occupancy query says %d\n", per_cu);
        (void)hipGetLastError();
        grid = cus;
    }
    return grid;
}
static void pk_launch(pk::Params& P, int lo, int hi, hipStream_t stream) {
    const int grid = pk_grid(); if (grid <= 0) return;
    P.ph_lo = lo; P.ph_hi = hi; P.bar_li += 1;
    hipLaunchKernelGGL(pk::mega, dim3(grid), dim3(pk::NTHREADS), pk::LDS_BYTES, stream, P);
}
extern "C" void kernel_launch(void* const* d_in, const int* in_sizes, int n_in, void* d_out, int out_size, void* d_ws, size_t ws_size, hipStream_t stream) {
    if (n_in != 22 || out_size != NTOK * D || ws_size < WS_END) { fprintf(stderr, "kernel_launch: unexpected shapes (n_in %d out %d ws %zu)\n", n_in, out_size, ws_size); return; }
    const float* w_gate_up = (const float*)d_in[3]; const float* b_gate = (const float*)d_in[4]; const float* gla_g = (const float*)d_in[5];
    const float* w_eg = (const float*)d_in[19]; const float* w_eu = (const float*)d_in[20]; const float* w_ed = (const float*)d_in[21];
    unsigned char* ws = (unsigned char*)d_ws;
    float* GLR = (float*)(ws + WS_GLR); float* CUM = (float*)(ws + WS_CUM);
    bf16* MKV = (bf16*)(ws + WS_MKV);
    int* TOK_E = (int*)(ws + WS_TOKE); int* TOK_S = (int*)(ws + WS_TOKS);
    bf16* XB = (bf16*)(ws + WS_XB); bf16* YS = (bf16*)(ws + WS_HREG);
    bf16* T0 = (bf16*)(ws + WS_HREG), *T1 = (bf16*)(ws + WS_HREG + HR_48), *T2 = (bf16*)(ws + WS_HREG + 2 * HR_48), *T3 = (bf16*)(ws + WS_HREG + 3 * HR_48), *T4 = (bf16*)(ws + WS_HREG + 4 * HR_48);
    (void)hipMemsetAsync(ws + WS_CTL, 0, CTL_ZERO_BYTES, stream);
    pk::Params P{}; for (int i = 0; i < 22; ++i) P.in[i] = (const float*)d_in[i]; P.out = (float*)d_out; P.ws = ws; P.bar_li = -1;
    pk_launch(P, 0, 17, stream);
}
```

```cpp
#include <hip/hip_runtime.h>
#include <cstdio>
#include <cstdint>

typedef unsigned short bf16;
constexpr int NB = 8, SEQ = 4096, D = 1024, NTOK = NB * SEQ;
constexpr int NMEM = 256, A_IN = 2576, B_IN = 1792, KV_IN = 1548;
constexpr int GLA_H = 4, GLA_DK = 96, GLA_DV = 192, FOX_H = 12;
constexpr int NEXP = 16, DEXP = 512;
constexpr float DN_ALPHA = 1.41421356237309515f;
constexpr float LN_EPS = 1e-5f, RMS_EPS = 1e-6f;
constexpr float LOG2E = 1.4426950408889634f;
constexpr float QC2 = 0.125f * LOG2E;
constexpr size_t MiB = 1u << 20;
constexpr size_t WS_CTL = 0, CTL_ZERO_BYTES = 1 * MiB;
constexpr size_t WS_GLR = 1 * MiB, WS_LOGF = 3 * MiB, WS_CUM = 5 * MiB, WS_DEC = 7 * MiB, WS_MEMB = 8 * MiB, WS_MKV = 12 * MiB;
constexpr size_t WS_TOKE = 16 * MiB, WS_TOKW = WS_TOKE + 256 * 1024, WS_TOKS = WS_TOKW + 256 * 1024, WS_CNT = WS_TOKS + 256 * 1024, WS_SLOTTOK = 17 * MiB;
constexpr size_t WS_WA = 20 * MiB, WS_WB = 25 * MiB, WS_WMKV = 32 * MiB, WS_WO = 34 * MiB, WS_WGU = 38 * MiB, WS_WD = 102 * MiB;
constexpr size_t WS_XB = 134 * MiB, WS_GREG = 198 * MiB, WS_HREG = 270 * MiB, WS_END = 478 * MiB;
constexpr size_t HR_48 = 48 * MiB;

__device__ __forceinline__ float bf2f(bf16 v) { return __uint_as_float(((unsigned)v) << 16); }
__device__ __forceinline__ bf16 f2bf(float f) { unsigned u = __float_as_uint(f); return (bf16)((u + 0x7fffu + ((u >> 16) & 1u)) >> 16); }
__device__ __forceinline__ float wave_sum(float v) {
#pragma unroll
    for (int o = 1; o < 64; o <<= 1) v += __shfl_xor(v, o);
    return v;
}
__device__ __forceinline__ float log_sigmoid(float z) { return fminf(z, 0.f) - log1pf(expf(-fabsf(z))); }
__device__ __forceinline__ float sigmoidf(float z) { return 1.f / (1.f + expf(-z)); }


namespace pk {
#define LAS __attribute__((address_space(3)))
#define GAS __attribute__((address_space(1)))
typedef short bf16x8 __attribute__((ext_vector_type(8)));
typedef short s16x4 __attribute__((ext_vector_type(4)));
typedef float f32x4 __attribute__((ext_vector_type(4)));
typedef float f32x2 __attribute__((ext_vector_type(2)));
typedef float f32x16 __attribute__((ext_vector_type(16)));
typedef unsigned u32x4 __attribute__((ext_vector_type(4)));
typedef unsigned u32x2 __attribute__((ext_vector_type(2)));
constexpr int NWAVES = 8, NTHREADS = 512;
constexpr int BM = 256, BK = 64, HALF = 128, HTB = HALF * BK * 2, STAGE_BYTES = 8 * HTB, NXCD = 8, WGM = 8;
constexpr int RING_OFF = 0, RING_BYTES = 131072;
constexpr int MISC_OFF = RING_BYTES;
constexpr int ROWTOK_OFF = MISC_OFF + 256;
constexpr size_t OUT_HI = (size_t)64 << 20;
constexpr int LDS_BYTES = 155648;
static_assert(ROWTOK_OFF + 6 * 1024 <= LDS_BYTES, "LDS map");

__device__ __forceinline__ int lds_byte(int r, int c) { const int st = (r >> 4) * 2 + (c >> 5), rr = r & 15, cc = c & 31, ob = rr * 64 + cc * 2; return st * 1024 + (ob ^ (((ob >> 9) & 1) << 5)); }
__device__ __forceinline__ void stage_rc(int b, int& R, int& C) { const int st = b / 1024, sb = b % 1024, swz = sb ^ (((sb >> 9) & 1) << 5); R = (st >> 1) * 16 + swz / 64; C = (st & 1) * 32 + (swz % 64) / 2; }
__device__ __forceinline__ unsigned cvt_pk_bf16(float lo, float hi) { unsigned r; asm volatile("v_cvt_pk_bf16_f32 %0, %1, %2" : "=v"(r) : "v"(lo), "v"(hi)); return r; }
__device__ __forceinline__ int perm8(int c) { return (c & ~31) | (16 * ((c >> 2) & 1) + 4 * ((c >> 3) & 3) + (c & 3)); }
__device__ __forceinline__ int head64(int c);
__device__ __forceinline__ int wave64(int c);
__device__ __forceinline__ int head64(int c) { return 128 * ((c >> 5) & 1) + 32 * (c >> 6) + 16 * ((c >> 2) & 1) + 4 * ((c >> 3) & 3) + (c & 3); }
__device__ __forceinline__ int wave64(int c) { return (c & ~255) + head64(c & 255); }

__device__ __forceinline__ int fresh_lane() { int l; asm volatile("v_mbcnt_lo_u32_b32 %0, -1, 0\n\tv_mbcnt_hi_u32_b32 %0, -1, %0" : "=v"(l)); return l; }
__device__ __forceinline__ int fresh_tid(int wave_s) { asm volatile("" : "+s"(wave_s)); return wave_s * 64 + fresh_lane(); }
constexpr int PROBE_SEC = -1;
constexpr int PSEC_OFF = 131072 + 256 + 6144 + 512;
#define PSEC_BEGIN(id) unsigned long long _ps##id = 0; if (PROBE_SEC == (id) && bid == 0 && wave_s == 0) _ps##id = __builtin_amdgcn_s_memrealtime()
#define PSEC_END(id) do { if (PROBE_SEC == (id) && bid == 0 && wave_s == 0) { const unsigned d_ = (unsigned)(__builtin_amdgcn_s_memrealtime() - _ps##id); volatile LAS unsigned* a_ = (volatile LAS unsigned*)(lds + PSEC_OFF); if (fresh_lane() == 0) a_[0] = a_[0] + d_; } } while (0)
struct Unit { const char* A; const char* B; int pm, pn, e, ord; };

struct TileOrder {
    const char* A; const char* Bt; int K, nM, nN, nwg, G, c;
    __device__ void init(const void* A_, const void* Bt_, int M, int N, int K_, int G_, int c_) { A = (const char*)A_; Bt = (const char*)Bt_; K = K_; nM = M / BM; nN = N / BM; nwg = nM * nN; G = G_; c = c_; }
    __device__ __forceinline__ bool next(int i, Unit& u) const {
        const long L = (long)i * G + c; if (L >= nwg) return false;
        int wgid = (int)L; { const int q = nwg / NXCD, r = nwg % NXCD, xcd = wgid % NXCD, off = wgid / NXCD; wgid = (xcd < r ? xcd * (q + 1) : r * (q + 1) + (xcd - r) * q) + off; }
        const int nig = WGM * nN, gid = wgid / nig, fm = gid * WGM, gsz = (nM - fm) < WGM ? (nM - fm) : WGM;
        u.pm = fm + ((wgid % nig) % gsz); u.pn = (wgid % nig) / gsz; u.e = 0; u.ord = i;
        u.A = A + (size_t)u.pm * BM * K * 2; u.B = Bt + (size_t)u.pn * BM * K * 2; return true;
    }
    __device__ __forceinline__ unsigned a_off(const Unit&, int h, int R, int C) const { return (unsigned)((R + HALF * h) * K + C) * 2u; }
};

template <int SEC = 0, class Epi, class Sched>
__device__ __forceinline__ void gemm_phase(LAS unsigned char* lds, const int K, const Sched& S, const Epi& E, const int wave_s) {
    const int tid = fresh_tid(wave_s), wid = wave_s, lane = tid & 63, wr = wid >> 2, wc = wid & 3, fr = lane & 15, fq = lane >> 4;
    const int nt = K / BK;
    int sR[2], sC[2];
    unsigned voffA[2][2], voffB[2];
#pragma unroll
    for (int i = 0; i < 2; ++i) { stage_rc(tid * 16 + i * 8192, sR[i], sC[i]); voffB[i] = (unsigned)(sR[i] * K + sC[i]) * 2u; }
    const size_t kstep = (size_t)(BK * 2);
    const size_t hstep = (size_t)HALF * K * 2;
    const unsigned ldsw = (unsigned)wid * 1024u;
    const int aoff = lds_byte(wr * 64 + fr, fq * 8), boff = lds_byte(wc * 32 + fr, fq * 8);
#define PG8_SA(b, h) (((b) * 2 + (h)) * HTB)
#define PG8_SB(b, h) ((4 + (b) * 2 + (h)) * HTB)
#define PG8_STAGE(bufoff, gbase, voff) do { _Pragma("unroll") for (int _i = 0; _i < 2; ++_i) \
        __builtin_amdgcn_global_load_lds((const unsigned*)((const char*)(gbase) + (voff)[_i]), (LAS unsigned*)(lds + (bufoff) + ldsw + _i * 8192), 16, 0, 0); } while (0)
#define PG8_LDA(dst, b, h) do { _Pragma("unroll") for (int m = 0; m < 4; ++m) _Pragma("unroll") for (int k = 0; k < 2; ++k) dst[m][k] = *(const LAS bf16x8*)(lds + PG8_SA(b, h) + aoff + m * 2048 + k * 1024); } while (0)
#define PG8_LDB(dst, b, h) do { _Pragma("unroll") for (int n = 0; n < 2; ++n) _Pragma("unroll") for (int k = 0; k < 2; ++k) dst[n][k] = *(const LAS bf16x8*)(lds + PG8_SB(b, h) + boff + n * 2048 + k * 1024); } while (0)
#define PG8_MMA(ai, bj, At, Bt) do { __builtin_amdgcn_s_setprio(1); _Pragma("unroll") for (int m = 0; m < 4; ++m) _Pragma("unroll") for (int n = 0; n < 2; ++n) _Pragma("unroll") for (int k = 0; k < 2; ++k) \
        acc[ai][bj][m][n] = __builtin_amdgcn_mfma_f32_16x16x32_bf16(Bt[n][k], At[m][k], acc[ai][bj][m][n], 0, 0, 0); __builtin_amdgcn_s_setprio(0); } while (0)
#define PG8_WAIT_V(n) asm volatile("s_waitcnt vmcnt(" #n ")" ::: "memory")
#define PG8_WAIT_L(n) asm volatile("s_waitcnt lgkmcnt(" #n ")" ::: "memory")
#define PG8_BAR __builtin_amdgcn_s_barrier()
#define PG8_SCHED __builtin_amdgcn_sched_barrier(0)
    Unit cur, nxt; int ui = 0;
    if (!S.next(0, cur)) return;
    f32x4 acc[2][2][4][2];
#pragma unroll
    for (int a = 0; a < 2; ++a)
#pragma unroll
        for (int b = 0; b < 2; ++b)
#pragma unroll
            for (int m = 0; m < 4; ++m)
#pragma unroll
                for (int n = 0; n < 2; ++n) acc[a][b][m][n] = (f32x4){0.f, 0.f, 0.f, 0.f};
    bf16x8 At[4][2], B0[2][2], B1[2][2];
    const char* cA = cur.A; const char* cB = cur.B;
#pragma unroll
    for (int h = 0; h < 2; ++h)
#pragma unroll
        for (int i = 0; i < 2; ++i) voffA[h][i] = S.a_off(cur, h, sR[i], sC[i]);
    PG8_STAGE(PG8_SB(0, 0), cB, voffB); PG8_STAGE(PG8_SB(0, 1), cB + hstep, voffB); PG8_STAGE(PG8_SA(0, 0), cA, voffA[0]); PG8_STAGE(PG8_SA(0, 1), cA, voffA[1]);
    if (wr == 1) PG8_BAR;
    PG8_WAIT_V(2); PG8_BAR;
    PG8_STAGE(PG8_SB(1, 0), cB + kstep, voffB); PG8_STAGE(PG8_SA(1, 0), cA + kstep, voffA[0]); PG8_STAGE(PG8_SB(1, 1), cB + hstep + kstep, voffB);
    PG8_WAIT_V(6); PG8_BAR;
    for (;;) {
        const bool has_next = S.next(ui + 1, nxt);
        const char* nA = has_next ? nxt.A : cA; const char* nB = has_next ? nxt.B : cB;
        for (int t = 0; t < nt; t += 2) {
            const bool last = (t == nt - 2);
            const char* a1 = cA + (size_t)(t + 1) * kstep;
            const char* a2 = last ? nA : cA + (size_t)(t + 2) * kstep; const char* b2 = last ? nB : cB + (size_t)(t + 2) * kstep;
            const char* a3 = a2 + kstep; const char* b3 = b2 + kstep;
            PG8_LDB(B0, 0, 0); PG8_LDB(B1, 0, 1); PG8_SCHED; PG8_LDA(At, 0, 0); PG8_STAGE(PG8_SA(1, 1), a1, voffA[1]);
            if (last && has_next) {
#pragma unroll
                for (int h = 0; h < 2; ++h)
#pragma unroll
                    for (int i = 0; i < 2; ++i) { int R2, C2; stage_rc(fresh_tid(wave_s) * 16 + i * 8192, R2, C2); voffA[h][i] = S.a_off(nxt, h, R2, C2); }
            }
            PG8_WAIT_V(8); PG8_WAIT_L(0); PG8_BAR; PG8_MMA(0, 0, At, B0); PG8_MMA(0, 1, At, B1); PG8_BAR; PG8_SCHED;
            PG8_LDA(At, 0, 1); PG8_STAGE(PG8_SB(0, 0), b2, voffB); PG8_STAGE(PG8_SB(0, 1), b2 + hstep, voffB); PG8_STAGE(PG8_SA(0, 0), a2, voffA[0]);
            PG8_WAIT_V(8); PG8_WAIT_L(0); PG8_BAR; PG8_MMA(1, 0, At, B0); PG8_MMA(1, 1, At, B1); PG8_BAR; PG8_SCHED;
            PG8_LDB(B0, 1, 0); PG8_LDB(B1, 1, 1); PG8_SCHED; PG8_LDA(At, 1, 0); PG8_STAGE(PG8_SA(0, 1), a2, voffA[1]);
            PG8_WAIT_V(8); PG8_WAIT_L(0); PG8_BAR; PG8_MMA(0, 0, At, B0); PG8_MMA(0, 1, At, B1); PG8_BAR; PG8_SCHED;
            PG8_LDA(At, 1, 1); PG8_STAGE(PG8_SB(1, 0), b3, voffB); PG8_STAGE(PG8_SB(1, 1), b3 + hstep, voffB); PG8_STAGE(PG8_SA(1, 0), a3, voffA[0]);
            PG8_WAIT_V(8); PG8_WAIT_L(0); PG8_BAR; PG8_MMA(1, 0, At, B0); PG8_MMA(1, 1, At, B1); PG8_BAR; PG8_SCHED;
        }
        if (wr == 0) PG8_BAR;
        { const bool pe_ = (PROBE_SEC == 30 || (SEC != 0 && PROBE_SEC == SEC)) && blockIdx.x == 0 && wave_s == 0; unsigned long long t0_ = 0; if (pe_) t0_ = __builtin_amdgcn_s_memrealtime();
          E(acc, cur, wr, wc, fr, fq);
          if (pe_) { const unsigned d_ = (unsigned)(__builtin_amdgcn_s_memrealtime() - t0_); volatile LAS unsigned* a_ = (volatile LAS unsigned*)(lds + PSEC_OFF); if (fresh_lane() == 0) a_[0] = a_[0] + d_; } }
        if (!has_next) break;
#pragma unroll
        for (int a = 0; a < 2; ++a)
#pragma unroll
            for (int b = 0; b < 2; ++b)
#pragma unroll
                for (int m = 0; m < 4; ++m)
#pragma unroll
                    for (int n = 0; n < 2; ++n) acc[a][b][m][n] = (f32x4){0.f, 0.f, 0.f, 0.f};
        cur = nxt; cA = nA; cB = nB; ++ui;
        if (wr == 1) PG8_BAR;
    }
    PG8_WAIT_V(0);
    PG8_BAR;
#undef PG8_SA
#undef PG8_SB
#undef PG8_STAGE
#undef PG8_LDA
#undef PG8_LDB
#undef PG8_MMA
#undef PG8_WAIT_V
#undef PG8_WAIT_L
#undef PG8_BAR
#undef PG8_SCHED
}

__device__ __forceinline__ void store_bf16_tile(const f32x4 (&acc)[2][2][4][2], bf16* base, int ldd, int row0, int c0, int wr, int wc, int fr, int fq) {
    GAS bf16* rowp = (GAS bf16*)base + (size_t)(row0 + wr * 64 + fr) * ldd + (c0 + wc * 64 + 8 * fq);
#pragma unroll
    for (int ai = 0; ai < 2; ++ai) {
#pragma unroll
        for (int m = 0; m < 4; ++m) {
#pragma unroll
            for (int bj = 0; bj < 2; ++bj) { const f32x4 v0 = acc[ai][bj][m][0], v1 = acc[ai][bj][m][1];
                u32x4 w; w.x = cvt_pk_bf16(v0[0], v0[1]); w.y = cvt_pk_bf16(v0[2], v0[3]); w.z = cvt_pk_bf16(v1[0], v1[1]); w.w = cvt_pk_bf16(v1[2], v1[3]);
                *(GAS u32x4*)(rowp + bj * 32) = w; }
            rowp += (size_t)16 * ldd; asm volatile("" : "+v"(rowp)); }
        rowp += (size_t)64 * ldd; }
}
struct EpiInA { bf16 *QK, *V, *R, *MQ;
    __device__ __forceinline__ void operator()(const f32x4 (&acc)[2][2][4][2], const Unit& u, int wr, int wc, int fr, int fq) const {
        bf16* base; int ldd, c0; const int pn = u.pn;
        if (pn < 3) { base = QK; ldd = 768; c0 = pn * 256; } else if (pn < 6) { base = V; ldd = 768; c0 = (pn - 3) * 256; } else if (pn < 9) { base = R; ldd = 768; c0 = (pn - 6) * 256; } else { base = MQ; ldd = 256; c0 = 0; }
        store_bf16_tile(acc, base, ldd, u.pm * BM, c0, wr, wc, fr, fq);
    } };
struct EpiPlain { bf16* dst; int ldd;
    __device__ __forceinline__ void operator()(const f32x4 (&acc)[2][2][4][2], const Unit& u, int wr, int wc, int fr, int fq) const { store_bf16_tile(acc, dst, ldd, u.pm * BM, u.pn * BM, wr, wc, fr, fq); } };

#define XB_TMO      128
#define XB_XCNT(j)  (256  + 64 * (j))
#define XB_XSUB(j)  (1280 + 64 * (j))
#define XB_XGEN(j)  (2304 + 64 * (j))
#define XB_TOP      3328
#define XB_TOPGEN   3392
#define XCD_BAR_WORDS 3456
#define XB_SPIN_CAP (1u << 18)
__device__ __forceinline__ unsigned xb_ld(unsigned* p)              { return __hip_atomic_load(p, __ATOMIC_RELAXED, __HIP_MEMORY_SCOPE_AGENT); }
__device__ __forceinline__ unsigned xb_add(unsigned* p, unsigned v) { return __hip_atomic_fetch_add(p, v, __ATOMIC_RELAXED, __HIP_MEMORY_SCOPE_AGENT); }
__device__ __forceinline__ unsigned xb_xcc_id() { return (unsigned)__builtin_amdgcn_s_getreg((3 << 11) | 20) & 0xFu; }
#define XB_SPIN(cond, bar) do { unsigned _sp = 0; while (cond) { __builtin_amdgcn_s_sleep(1); \
    if ((++_sp & 255u) == 0u) { if (xb_ld(&(bar)[XB_TMO])) break; if (_sp > XB_SPIN_CAP) { atomicAdd(&(bar)[XB_TMO], 1u); break; } } } } while (0)
struct XcdBarrier { unsigned* bar; unsigned x; volatile LAS unsigned* st; };
__device__ __forceinline__ XcdBarrier xcd_barrier_post(unsigned* bar, volatile LAS unsigned* st) {
    XcdBarrier b; b.bar = bar; b.x = xb_xcc_id(); b.st = st;
    if (threadIdx.x == 0) (void)xb_add(&bar[XB_XCNT(b.x)], 1u);
    return b;
}
__device__ __forceinline__ void xcd_barrier_complete(unsigned* bar, unsigned x, unsigned& nloc, unsigned& nx) {
    const unsigned G = gridDim.x * gridDim.y * gridDim.z;
    unsigned sum, cnt, mine, sp = 0u;
    for (;;) {
        sum = 0u; cnt = 0u; mine = 0u;
#pragma unroll
        for (unsigned j = 0; j < 16; ++j) { const unsigned c = xb_ld(&bar[XB_XCNT(j)]); sum += c; cnt += (c > 0u) ? 1u : 0u; mine = (j == x) ? c : mine; }
        if (sum == G) break;
        __builtin_amdgcn_s_sleep(1);
        if ((++sp & 255u) == 0u) { if (xb_ld(&bar[XB_TMO])) break; if (sp > XB_SPIN_CAP) { atomicAdd(&bar[XB_TMO], 1u); break; } }
    }
    nloc = mine > 0u ? mine : 1u; nx = cnt > 0u ? cnt : 1u;
}
__device__ __forceinline__ void xcd_barrier(const XcdBarrier& b) {
    asm volatile("s_waitcnt vmcnt(0)" ::: "memory");
    __syncthreads();
    if (threadIdx.x == 0) {
        unsigned* bar = b.bar;
        __builtin_amdgcn_s_waitcnt(0);
        unsigned nloc = b.st[0], nx = b.st[1];
        if (nloc == 0u) { xcd_barrier_complete(bar, b.x, nloc, nx); b.st[0] = nloc; b.st[1] = nx; }
        const unsigned old = xb_add(&bar[XB_XSUB(b.x)], 1u);
        const unsigned gen = old / nloc;
        if (old + 1u == (gen + 1u) * nloc) {
            __builtin_amdgcn_fence(__ATOMIC_RELEASE, "agent");
            asm volatile("s_waitcnt vmcnt(0)" ::: "memory");
            const unsigned og = xb_add(&bar[XB_TOP], 1u);
            const unsigned tg = og / nx;
            if (og + 1u == (tg + 1u) * nx) xb_add(&bar[XB_TOPGEN], 1u);
            else XB_SPIN(xb_ld(&bar[XB_TOPGEN]) == tg, bar);
            __builtin_amdgcn_fence(__ATOMIC_ACQUIRE, "agent");
            xb_add(&bar[XB_XGEN(b.x)], 1u);
            asm volatile("s_waitcnt vmcnt(0)" ::: "memory");
        } else {
            XB_SPIN(xb_ld(&bar[XB_XGEN(b.x)]) == gen, bar);
            __builtin_amdgcn_fence(__ATOMIC_ACQUIRE, "agent");
            asm volatile("s_waitcnt vmcnt(0)" ::: "memory");
        }
    }
    __syncthreads();
}
#define LDS_WAIT() asm volatile("s_waitcnt lgkmcnt(0)" ::: "memory")
__device__ __forceinline__ unsigned pk2(float lo, float hi) { return (unsigned)f2bf(lo) | ((unsigned)f2bf(hi) << 16); }

template <int CTRL> __device__ __forceinline__ float dppf(float v) { return __builtin_bit_cast(float, __builtin_amdgcn_update_dpp(0, __builtin_bit_cast(int, v), CTRL, 0xf, 0xf, true)); }
__device__ __forceinline__ float sum_swap32(float a, float b) { auto r = __builtin_amdgcn_permlane32_swap(__float_as_uint(a), __float_as_uint(b), false, false); return __uint_as_float(r[0]) + __uint_as_float(r[1]); }
__device__ __forceinline__ float sum_swap16(float a, float b) { auto r = __builtin_amdgcn_permlane16_swap(__float_as_uint(a), __float_as_uint(b), false, false); return __uint_as_float(r[0]) + __uint_as_float(r[1]); }
__device__ __forceinline__ float wsum(float v) {
    v += dppf<0xB1>(v); v += dppf<0x4E>(v); v += dppf<0x141>(v); v += dppf<0x140>(v);
    v = sum_swap16(v, v); v = sum_swap32(v, v); return v;
}
__device__ __forceinline__ float multi_reduce16(const float (&a)[16], int lane) {
    float b[8], c[4], d[2], e;
#pragma unroll
    for (int i = 0; i < 8; ++i) b[i] = sum_swap32(a[i], a[i + 8]);
#pragma unroll
    for (int i = 0; i < 4; ++i) c[i] = sum_swap16(b[i], b[i + 4]);
    { const bool hi = (lane & 8) != 0;
#pragma unroll
      for (int i = 0; i < 2; ++i) { const float send = hi ? c[i] : c[i + 2], keep = hi ? c[i + 2] : c[i]; d[i] = keep + dppf<0x140>(send); } }
    { const bool hi = (lane & 4) != 0; const float send = hi ? d[0] : d[1], keep = hi ? d[1] : d[0]; e = keep + dppf<0x141>(send); }
    e += dppf<0x4E>(e); e += dppf<0xB1>(e);
    return e;
}

template <int NG = 8>
__device__ __forceinline__ void row_dots16x2(const f32x4 (&v0)[4], const f32x4 (&v1)[4], const LAS float* WT, int lane, float& r0, float& r1) {
    float a0[16], a1[16];
#pragma unroll
    for (int i = 2 * NG; i < 16; ++i) { a0[i] = 0.f; a1[i] = 0.f; }
    const LAS float* wl = WT + 4 * lane; asm volatile("" : "+v"(wl));
    f32x4 wa[8], wb[8];
#pragma unroll
    for (int q = 0; q < 8; ++q) wa[q] = *(const LAS f32x4*)(wl + (q >> 2) * D + 256 * (q & 3));
#pragma unroll
    for (int g = 0; g < NG; ++g) {
        if (g + 1 < NG) {
#pragma unroll
            for (int q = 0; q < 8; ++q) { const f32x4 w = *(const LAS f32x4*)(wl + (2 * (g + 1) + (q >> 2)) * D + 256 * (q & 3)); if (g & 1) wa[q] = w; else wb[q] = w; } }
#pragma unroll
        for (int h = 0; h < 2; ++h) { f32x2 x = (f32x2){0.f, 0.f}, y = (f32x2){0.f, 0.f};
#pragma unroll
            for (int j = 0; j < 4; ++j) { const f32x4 w = (g & 1) ? wb[4 * h + j] : wa[4 * h + j]; const f32x2 wl2 = (f32x2){w[0], w[1]}, wh2 = (f32x2){w[2], w[3]};
                x = (f32x2){v0[j][0], v0[j][1]} * wl2 + x; x = (f32x2){v0[j][2], v0[j][3]} * wh2 + x; y = (f32x2){v1[j][0], v1[j][1]} * wl2 + y; y = (f32x2){v1[j][2], v1[j][3]} * wh2 + y; }
            a0[2 * g + h] = x[0] + x[1]; a1[2 * g + h] = y[0] + y[1]; }
        asm volatile("" : "+v"(a0[2 * g]), "+v"(a0[2 * g + 1]), "+v"(a1[2 * g]), "+v"(a1[2 * g + 1]));
    }
    r0 = multi_reduce16(a0, lane); r1 = multi_reduce16(a1, lane);
}
__device__ __forceinline__ void row_dots16x4(const f32x4 (&v0)[4], const f32x4 (&v1)[4], const f32x4 (&v2)[4], const f32x4 (&v3)[4], const LAS float* WT, int lane, float& r0, float& r1, float& r2, float& r3) {
    float a0[16], a1[16], a2[16], a3[16];
    const LAS float* wl = WT + 4 * lane; asm volatile("" : "+v"(wl));
    f32x4 wa[4], wb[4];
#pragma unroll
    for (int j = 0; j < 4; ++j) wa[j] = *(const LAS f32x4*)(wl + 256 * j);
#pragma unroll
    for (int n = 0; n < 16; ++n) {
        if (n + 1 < 16) {
#pragma unroll
            for (int j = 0; j < 4; ++j) { const f32x4 w = *(const LAS f32x4*)(wl + (n + 1) * D + 256 * j); if (n & 1) wa[j] = w; else wb[j] = w; } }
        f32x2 x0 = (f32x2){0.f, 0.f}, x1 = x0, x2 = x0, x3 = x0;
#pragma unroll
        for (int j = 0; j < 4; ++j) { const f32x4 w = (n & 1) ? wb[j] : wa[j]; const f32x2 wl2 = (f32x2){w[0], w[1]}, wh2 = (f32x2){w[2], w[3]};
            x0 = (f32x2){v0[j][0], v0[j][1]} * wl2 + x0; x0 = (f32x2){v0[j][2], v0[j][3]} * wh2 + x0; x1 = (f32x2){v1[j][0], v1[j][1]} * wl2 + x1; x1 = (f32x2){v1[j][2], v1[j][3]} * wh2 + x1;
            x2 = (f32x2){v2[j][0], v2[j][1]} * wl2 + x2; x2 = (f32x2){v2[j][2], v2[j][3]} * wh2 + x2; x3 = (f32x2){v3[j][0], v3[j][1]} * wl2 + x3; x3 = (f32x2){v3[j][2], v3[j][3]} * wh2 + x3; }
        a0[n] = x0[0] + x0[1]; a1[n] = x1[0] + x1[1]; a2[n] = x2[0] + x2[1]; a3[n] = x3[0] + x3[1];
        asm volatile("" : "+v"(a0[n]), "+v"(a1[n]), "+v"(a2[n]), "+v"(a3[n]));
    }
    r0 = multi_reduce16(a0, lane); r1 = multi_reduce16(a1, lane); r2 = multi_reduce16(a2, lane); r3 = multi_reduce16(a3, lane);
}
struct TItem { const float* src; bf16* WT; int K, ncols, n0, k0, kind, aux; bool ok; };
__device__ __forceinline__ int titem_dstrow(const TItem& t, int c) {
    switch (t.kind) {
        case 0: return 256 * (c >> 7) + perm8(c & 127);
        case 1: return 256 * (c >> 7) + 128 + perm8(c & 127);
        case 2: return wave64(c);
        case 3: { if (c >= 1536 && c < 1552) return -1; const int L = c < 1536 ? c : c - 16; return wave64(L); }
        case 4: { if (c < 768) return (c & ~255) + head64(c & 255); return wave64(1536 + c); }
        case 5: { if (c < 768) { const int L = 768 + c; return (L & ~255) + head64(L & 255); } if (c < 1536) return wave64(768 + c); return -1; }
        default: return wave64(t.aux * 512 + c);
    }
}
__device__ __forceinline__ void titem_load(const TItem& t, float (&r)[32]) {
#pragma unroll
    for (int i = 0; i < 32; ++i) r[i] = t.ok ? t.src[(size_t)(2 * i) * t.ncols] : 0.f;
}
__device__ __forceinline__ void titem_store(const TItem& t, const float (&r)[32], LAS float* scr, int lane) {
#pragma unroll
    for (int i = 0; i < 32; ++i) scr[(2 * i + (lane >> 5)) * 33 + (lane & 31)] = r[i];
    LDS_WAIT(); asm volatile("" ::: "memory");
    const int c = lane & 7;
#pragma unroll
    for (int j = 0; j < 4; ++j) { const int n = (lane >> 3) + 8 * j; const LAS float* s = scr + (8 * c) * 33 + n;
        u32x4 o; o.x = cvt_pk_bf16(s[0 * 33], s[1 * 33]); o.y = cvt_pk_bf16(s[2 * 33], s[3 * 33]); o.z = cvt_pk_bf16(s[4 * 33], s[5 * 33]); o.w = cvt_pk_bf16(s[6 * 33], s[7 * 33]);
        const int dr = (t.n0 + n) < t.ncols ? titem_dstrow(t, t.n0 + n) : -1;
        if (dr >= 0) *(u32x4*)(t.WT + (size_t)dr * t.K + t.k0 + 8 * c) = o; }
    LDS_WAIT(); asm volatile("" ::: "memory");
}
struct Params { const float* in[22]; float* out; unsigned char* ws; int ph_lo, ph_hi, bar_li, pad; };
enum { I_X = 0, I_MEM, I_WINA, I_WGUP, I_BGATE, I_GLAG, I_WINB, I_QNG, I_WKV, I_BFORGET, I_KNG, I_WMKV, I_WOUT, I_LMG, I_LMB, I_LFG, I_LFB, I_WR, I_BR, I_WEG, I_WEU, I_WED };
constexpr int CW_BAR = 4096;

typedef const __attribute__((address_space(4))) Params* KP;
__device__ __forceinline__ KP fresh_kp() { KP q = (KP)__builtin_amdgcn_kernarg_segment_ptr(); asm volatile("" : "+s"(q)); return q; }

constexpr int CV_STATIC = 3 * 512 + 176 + 112 + 96 + 64 + 128, CV_QUEUE = 3 * 512;
constexpr int CV_A_STATIC = 576, CV_NSTAT = CV_A_STATIC + (CV_STATIC - 1536), CV_QA = 1536 - CV_A_STATIC;
constexpr int CW_CVQ = 1040, CW_CVQA = 1056;
__device__ __forceinline__ void cv_decode(KP p, unsigned char* ws, int it, int lane, int wave, TItem& t) {
    int r = it; const float* W; int nblk, q, l = 0; t.aux = 0;
    if (r >= CV_STATIC) { r -= CV_STATIC; l = 1; }
    else if (r >= 1536) { r -= 1536;
        if (r < 176) { q = r; W = p->in[I_WINA]; t.ncols = A_IN; t.K = D; t.WT = (bf16*)(ws + WS_WA); nblk = 11; t.kind = 3; }
        else if ((r -= 176) < 112) { q = r; W = p->in[I_WINB]; t.ncols = B_IN; t.K = D; t.WT = (bf16*)(ws + WS_WB); nblk = 7; t.kind = 4; }
        else if ((r -= 112) < 96) { q = r; W = p->in[I_WKV]; t.ncols = KV_IN; t.K = D; t.WT = (bf16*)(ws + WS_WB); nblk = 6; t.kind = 5; }
        else if ((r -= 96) < 64) { const int lm = r / 32; q = r % 32; W = p->in[I_WMKV] + (size_t)lm * D * 512; t.ncols = 512; t.K = D; t.WT = (bf16*)(ws + WS_WMKV); nblk = 2; t.kind = 6; t.aux = lm; }
        else { r -= 64; const int lo = r / 64; q = r % 64; W = p->in[I_WOUT] + (size_t)lo * D * D; t.ncols = D; t.K = D; t.WT = (bf16*)(ws + WS_WO) + (size_t)lo * D * D; nblk = 4; t.kind = 2; }
        goto done; }
    if (r < 512) { const int mat = 16 * l + r / 32; q = r % 32; W = p->in[I_WEG] + (size_t)mat * D * DEXP; t.ncols = DEXP; t.K = D; t.WT = (bf16*)(ws + WS_WGU) + (size_t)mat * 1024 * D; nblk = 2; t.kind = 0; }
    else if ((r -= 512) < 512) { const int mat = 16 * l + r / 32; q = r % 32; W = p->in[I_WEU] + (size_t)mat * D * DEXP; t.ncols = DEXP; t.K = D; t.WT = (bf16*)(ws + WS_WGU) + (size_t)mat * 1024 * D; nblk = 2; t.kind = 1; }
    else { r -= 512; const int mat = 16 * l + r / 32; q = r % 32; W = p->in[I_WED] + (size_t)mat * DEXP * D; t.ncols = D; t.K = DEXP; t.WT = (bf16*)(ws + WS_WD) + (size_t)mat * D * DEXP; nblk = 4; t.kind = 2; }
done:
    t.k0 = 64 * (q / nblk); t.n0 = 256 * (q % nblk);
    const int col = t.n0 + 4 * lane; t.ok = col < t.ncols;
    t.src = W + (size_t)(t.k0 + 8 * wave) * t.ncols + (t.ok ? col : 0);
}
#define CV_TLOAD(t, r) do { _Pragma("unroll") for (int i = 0; i < 8; ++i) r[i] = t.ok ? *(const f32x4*)(t.src + (size_t)i * t.ncols) : (f32x4){0.f, 0.f, 0.f, 0.f}; } while (0)
#define CV_TSTORE(t, r) do { __syncthreads(); \
        _Pragma("unroll") for (int i = 0; i < 8; ++i) { LAS float* d_ = T + (8 * wave + i) * 257 + 4 * lane; d_[0] = r[i][0]; d_[1] = r[i][1]; d_[2] = r[i][2]; d_[3] = r[i][3]; } \
        __syncthreads(); \
        const int c_ = lane & 7; \
        _Pragma("unroll") for (int j = 0; j < 4; ++j) { const int n_ = 32 * wave + (lane >> 3) + 8 * j; const LAS float* s_ = T + (8 * c_) * 257 + n_; \
            u32x4 o_; o_.x = cvt_pk_bf16(s_[0 * 257], s_[1 * 257]); o_.y = cvt_pk_bf16(s_[2 * 257], s_[3 * 257]); o_.z = cvt_pk_bf16(s_[4 * 257], s_[5 * 257]); o_.w = cvt_pk_bf16(s_[6 * 257], s_[7 * 257]); \
            const int dr_ = (t.n0 + n_) < t.ncols ? titem_dstrow(t, t.n0 + n_) : -1; \
            if (dr_ >= 0) *(u32x4*)(t.WT + (size_t)dr_ * t.K + t.k0 + 8 * c_) = o_; } } while (0)
__device__ __forceinline__ void convert_static(KP p, unsigned char* ws, LAS unsigned char* lds, int lane, int wave, int G, int bid) {
    LAS float* T = (LAS float*)lds;
    TItem ta; f32x4 ra[8], rb[8];
#define CV_SID(s) ((s) < CV_A_STATIC ? (s) : 1536 + ((s) - CV_A_STATIC))
    int it = bid;
    if (it < CV_NSTAT) { cv_decode(p, ws, CV_SID(it), lane, wave, ta); CV_TLOAD(ta, ra); }
#pragma unroll 1
    for (; it < CV_NSTAT; it += 2 * G) {
        TItem tb; const bool hb = it + G < CV_NSTAT;
        if (hb) { cv_decode(p, ws, CV_SID(it + G), lane, wave, tb); CV_TLOAD(tb, rb); }
        CV_TSTORE(ta, ra);
        if (it + 2 * G < CV_NSTAT) { cv_decode(p, ws, CV_SID(it + 2 * G), lane, wave, ta); CV_TLOAD(ta, ra); }
        if (hb) CV_TSTORE(tb, rb);
    }
#undef CV_SID
    __syncthreads();
}
__device__ __forceinline__ void convert_from_queue(KP p, LAS unsigned char* lds, const int wave_s, int budget, const int qword = CW_CVQ, const int qbase = CV_STATIC, const int qcount = CV_QUEUE) {
    unsigned char* ws = p->ws; LAS float* T = (LAS float*)lds;
    const int tid = fresh_tid(wave_s), lane = tid & 63, wave = wave_s;
    unsigned* qh = (unsigned*)(ws + WS_CTL) + qword; volatile LAS unsigned* slotw = (volatile LAS unsigned*)(lds + MISC_OFF) + 56;
    for (int n = 0; budget < 0 || n < budget; ++n) {
        if (tid == 0) slotw[0] = __hip_atomic_fetch_add(qh, 1u, __ATOMIC_RELAXED, __HIP_MEMORY_SCOPE_AGENT);
        __syncthreads();
        const int q = (int)__builtin_amdgcn_readfirstlane(slotw[0]);
        if (q >= qcount) break;
        TItem t; f32x4 r[8]; cv_decode(p, ws, qbase + q, lane, wave, t); CV_TLOAD(t, r); CV_TSTORE(t, r);
        __syncthreads();
    }
    __syncthreads();
}
__device__ __forceinline__ void phase_prologue(KP p, LAS unsigned char* lds, int G, int bid, const int wave_s) {
    const int tid = fresh_tid(wave_s), lane = tid & 63, wave = wave_s;
    unsigned char* ws = p->ws;
    LAS float* scr = (LAS float*)(lds + wave * 8448);
    const int gw = bid * NWAVES + wave, NGW = G * NWAVES;
    constexpr int NB_A = 81, NB_B = 56, NB_KV = 48;
    constexpr int I_G = 32 * 16 * 16, I_U = I_G, I_D = 32 * 8 * 32, I_A = 16 * NB_A, I_B = 16 * NB_B, I_KV = 16 * NB_KV, I_MK = 2 * 16 * 16, I_O = 2 * 16 * 32;
    constexpr int NITEMS = I_G + I_U + I_D + I_A + I_B + I_KV + I_MK + I_O;
    auto decode = [&](int it, TItem& t) {
        int r = it; const float* W; int nblk, q; t.aux = 0;
        if (r < I_G) { const int mat = r / 256; q = r % 256; W = p->in[I_WEG] + (size_t)mat * D * DEXP; t.ncols = DEXP; t.K = D; t.WT = (bf16*)(ws + WS_WGU) + (size_t)mat * 1024 * D; nblk = 16; t.kind = 0; }
        else if ((r -= I_G) < I_U) { const int mat = r / 256; q = r % 256; W = p->in[I_WEU] + (size_t)mat * D * DEXP; t.ncols = DEXP; t.K = D; t.WT = (bf16*)(ws + WS_WGU) + (size_t)mat * 1024 * D; nblk = 16; t.kind = 1; }
        else if ((r -= I_U) < I_D) { const int mat = r / 256; q = r % 256; W = p->in[I_WED] + (size_t)mat * DEXP * D; t.ncols = D; t.K = DEXP; t.WT = (bf16*)(ws + WS_WD) + (size_t)mat * D * DEXP; nblk = 32; t.kind = 2; }
        else if ((r -= I_D) < I_A) { q = r; W = p->in[I_WINA]; t.ncols = A_IN; t.K = D; t.WT = (bf16*)(ws + WS_WA); nblk = NB_A; t.kind = 3; }
        else if ((r -= I_A) < I_B) { q = r; W = p->in[I_WINB]; t.ncols = B_IN; t.K = D; t.WT = (bf16*)(ws + WS_WB); nblk = NB_B; t.kind = 4; }
        else if ((r -= I_B) < I_KV) { q = r; W = p->in[I_WKV]; t.ncols = KV_IN; t.K = D; t.WT = (bf16*)(ws + WS_WB); nblk = NB_KV; t.kind = 5; }
        else if ((r -= I_KV) < I_MK) { const int l = r / 256; q = r % 256; W = p->in[I_WMKV] + (size_t)l * D * 512; t.ncols = 512; t.K = D; t.WT = (bf16*)(ws + WS_WMKV); nblk = 16; t.kind = 6; t.aux = l; }
        else { r -= I_MK; const int l = r / 512; q = r % 512; W = p->in[I_WOUT] + (size_t)l * D * D; t.ncols = D; t.K = D; t.WT = (bf16*)(ws + WS_WO) + (size_t)l * D * D; nblk = 32; t.kind = 2; }
        t.k0 = 64 * (q / nblk); t.n0 = 32 * (q % nblk);
        const int col = t.n0 + (lane & 31); t.ok = col < t.ncols;
        t.src = W + (size_t)(t.k0 + (lane >> 5)) * t.ncols + (t.ok ? col : 0);
    };
    { PSEC_BEGIN(20); convert_static(p, ws, lds, lane, wave, G, bid); PSEC_END(20); }
    { const f32x4* src = (const f32x4*)p->in[I_MEM]; u32x2* dst = (u32x2*)(ws + WS_MEMB);
      for (int i = bid * NTHREADS + tid; i < NB * NMEM * D / 4; i += G * NTHREADS) { const f32x4 v = src[i]; u32x2 o; o.x = pk2(v[0], v[1]); o.y = pk2(v[2], v[3]); dst[i] = o; } }
    __syncthreads();
    LAS float* WG = (LAS float*)(lds);
#pragma unroll
    for (int i = 0; i < 4 * D / NTHREADS; ++i) { const int idx = tid + NTHREADS * i, j4 = idx >> 10, k = idx & (D - 1);
        const f32x4 w = *(const f32x4*)(p->in[I_WINA] + (size_t)k * A_IN + 1536 + 4 * j4);
        WG[(4 * j4) * D + k] = w[0]; WG[(4 * j4 + 1) * D + k] = w[1]; WG[(4 * j4 + 2) * D + k] = w[2]; WG[(4 * j4 + 3) * D + k] = w[3]; }
    __syncthreads();
    bf16* XB = (bf16*)(ws + WS_XB); float* GLR = (float*)(ws + WS_GLR);
    { PSEC_BEGIN(22);
    {   f32x4 a0[4], a1[4], b0[4], b1[4];
#define P0_LOAD(va, vb, mm) do { const f32x4* xr_ = (const f32x4*)(p->in[I_X] + (size_t)(mm) * D) + lane; _Pragma("unroll") for (int j = 0; j < 4; ++j) { va[j] = xr_[64 * j]; vb[j] = xr_[64 * j + 256]; } } while (0)
#define P0_PROC(va, vb, mm) do { u32x2* o8_ = (u32x2*)(XB + (size_t)(mm) * D) + lane; \
            _Pragma("unroll") for (int j = 0; j < 4; ++j) { u32x2 o; o.x = cvt_pk_bf16(va[j][0], va[j][1]); o.y = cvt_pk_bf16(va[j][2], va[j][3]); o8_[64 * j] = o; o.x = cvt_pk_bf16(vb[j][0], vb[j][1]); o.y = cvt_pk_bf16(vb[j][2], vb[j][3]); o8_[64 * j + 256] = o; } \
            float r0_, r1_; row_dots16x2(va, vb, WG, lane, r0_, r1_); \
            if ((lane & 3) == 0) { GLR[(size_t)(mm) * 16 + (lane >> 2)] = r0_; GLR[(size_t)((mm) + 1) * 16 + (lane >> 2)] = r1_; } } while (0)
        int m = 2 * gw;
        if (m < NTOK) P0_LOAD(a0, a1, m);
#pragma unroll 1
        for (; m < NTOK; m += 4 * NGW) {
            const bool hb = m + 2 * NGW < NTOK;
            if (hb) P0_LOAD(b0, b1, m + 2 * NGW);
            P0_PROC(a0, a1, m);
            if (m + 4 * NGW < NTOK) P0_LOAD(a0, a1, m + 4 * NGW);
            if (hb) P0_PROC(b0, b1, m + 2 * NGW);
        }
#undef P0_LOAD
#undef P0_PROC
    }
    PSEC_END(22); }
}

template <bool RB> struct EpiRes { const void* xres; bf16* out;
    __device__ __forceinline__ void operator()(const f32x4 (&acc)[2][2][4][2], const Unit& u, int wr, int wc, int fr, int fq) const {
        static_assert(RB, "the residual is read as bf16");
        size_t off = (size_t)(u.pm * BM + wr * 64 + fr) * D + (u.pn * BM + wc * 64 + 8 * fq);
        u32x4 tb[2][4][2];
#pragma unroll
        for (int ai = 0; ai < 2; ++ai)
#pragma unroll
            for (int m = 0; m < 4; ++m)
#pragma unroll
                for (int bj = 0; bj < 2; ++bj) tb[ai][m][bj] = *(const u32x4*)((const bf16*)xres + off + (size_t)(128 * ai + 16 * m) * D + bj * 32);
        asm volatile("" : "+v"(off) :: "memory");
#pragma unroll
        for (int ai = 0; ai < 2; ++ai) {
#pragma unroll
            for (int m = 0; m < 4; ++m) {
#pragma unroll
                for (int bj = 0; bj < 2; ++bj) { f32x4 x0, x1; const u32x4 t = tb[ai][m][bj];
                    x0[0] = __uint_as_float(t.x << 16); x0[1] = __uint_as_float(t.x & 0xffff0000u); x0[2] = __uint_as_float(t.y << 16); x0[3] = __uint_as_float(t.y & 0xffff0000u);
                    x1[0] = __uint_as_float(t.z << 16); x1[1] = __uint_as_float(t.z & 0xffff0000u); x1[2] = __uint_as_float(t.w << 16); x1[3] = __uint_as_float(t.w & 0xffff0000u);
                    const f32x4 v0 = x0 * DN_ALPHA + acc[ai][bj][m][0], v1 = x1 * DN_ALPHA + acc[ai][bj][m][1];
                    u32x4 w; w.x = cvt_pk_bf16(v0[0], v0[1]); w.y = cvt_pk_bf16(v0[2], v0[3]); w.z = cvt_pk_bf16(v1[0], v1[1]); w.w = cvt_pk_bf16(v1[2], v1[3]);
                    *(u32x4*)(out + off + bj * 32) = w; }
                off += (size_t)16 * D; asm volatile("" : "+v"(off)); }
            off += (size_t)64 * D; asm volatile("" : "+v"(off)); }
    } };
struct EpiInB { bf16 *Q, *K, *V, *OG, *MQ; const float* qg; const float* kg;
    __device__ __forceinline__ void operator()(const f32x4 (&acc)[2][2][4][2], const Unit& u, int wr, int wc, int fr, int fq) const {
        const int pn = u.pn;
        if (pn >= 6) { bf16* base; int ldd, c0;
            if (pn < 9) { base = V; ldd = 768; c0 = (pn - 6) * 256; } else if (pn < 12) { base = OG; ldd = 768; c0 = (pn - 9) * 256; } else { base = MQ; ldd = 256; c0 = 0; }
            store_bf16_tile(acc, base, ldd, u.pm * BM, c0, wr, wc, fr, fq); return; }
        const bool isq = pn < 3; bf16* base = isq ? Q : K; const float* g = isq ? qg : kg; const float sc = isq ? QC2 : 1.0f;
        const int c0 = (isq ? pn : pn - 3) * 256 + wc * 64 + 8 * fq, r0 = u.pm * BM + wr * 64 + fr;
        f32x4 gv[2][2];
#pragma unroll
        for (int bj = 0; bj < 2; ++bj)
#pragma unroll
            for (int n = 0; n < 2; ++n) gv[bj][n] = *(const f32x4*)(g + 32 * bj + 8 * fq + 4 * n) * sc;
        GAS bf16* rowp = (GAS bf16*)base + (size_t)r0 * 768 + c0;
#pragma unroll
        for (int ai = 0; ai < 2; ++ai) {
#pragma unroll
            for (int m = 0; m < 4; ++m) {
                float ss = 0.f;
#pragma unroll
                for (int bj = 0; bj < 2; ++bj)
#pragma unroll
                    for (int n = 0; n < 2; ++n) { const f32x4 v = acc[ai][bj][m][n]; ss += (v[0] * v[0] + v[1] * v[1]) + (v[2] * v[2] + v[3] * v[3]); }
                ss = sum_swap16(ss, ss); ss = sum_swap32(ss, ss);
                const float rs = rsqrtf(ss * (1.f / 64.f) + RMS_EPS);
#pragma unroll
                for (int bj = 0; bj < 2; ++bj) { const f32x4 v0 = acc[ai][bj][m][0] * rs * gv[bj][0], v1 = acc[ai][bj][m][1] * rs * gv[bj][1];
                    u32x4 w; w.x = cvt_pk_bf16(v0[0], v0[1]); w.y = cvt_pk_bf16(v0[2], v0[3]); w.z = cvt_pk_bf16(v1[0], v1[1]); w.w = cvt_pk_bf16(v1[2], v1[3]);
                    *(GAS u32x4*)(rowp + 32 * bj) = w; }
                rowp += (size_t)16 * 768; asm volatile("" : "+v"(rowp)); }
            rowp += (size_t)64 * 768; }
    } };

__device__ __forceinline__ void load_wtab(LAS float* WT, const float* W, int ldw, int col0, int ncols, int tid) {
#pragma unroll
    for (int i = 0; i < 4 * D / NTHREADS; ++i) { const int idx = tid + NTHREADS * i, j4 = idx >> 10, k = idx & (D - 1);
        const f32x4 w = 4 * j4 < ncols ? *(const f32x4*)(W + (size_t)k * ldw + col0 + 4 * j4) : (f32x4){0.f, 0.f, 0.f, 0.f};
        WT[(4 * j4) * D + k] = w[0]; WT[(4 * j4 + 1) * D + k] = w[1]; WT[(4 * j4 + 2) * D + k] = w[2]; WT[(4 * j4 + 3) * D + k] = w[3]; }
}
__device__ __forceinline__ float row_dots16(const f32x4 (&v)[4], const LAS float* WT, int lane) {
    float acc[16];
    const LAS float* wl = WT + 4 * lane; asm volatile("" : "+v"(wl));
#pragma unroll
    for (int n = 0; n < 16; ++n) { float a = 0.f;
#pragma unroll
        for (int j = 0; j < 4; ++j) { const f32x4 w = *(const LAS f32x4*)(wl + n * D + 256 * j); a += v[j][0] * w[0] + v[j][1] * w[1] + v[j][2] * w[2] + v[j][3] * w[3]; }
        acc[n] = a; if (n & 1) asm volatile("" : "+v"(acc[n - 1]), "+v"(acc[n]) :: "memory"); }
    return multi_reduce16(acc, lane);
}
constexpr int LN_GB_OFF = 81920;
__device__ __forceinline__ void ln_stage_gb(LAS unsigned char* lds, const float* g, const float* b, int tid) { LAS float* d = (LAS float*)(lds + LN_GB_OFF); for (int i = tid; i < D; i += NTHREADS) { d[i] = g[i]; d[D + i] = b[i]; } }
__device__ __forceinline__ void ln_row(f32x4 (&v)[4], const LAS float* g, const LAS float* b, int lane) {
    float s = 0.f;
#pragma unroll
    for (int j = 0; j < 4; ++j) s += (v[j][0] + v[j][1]) + (v[j][2] + v[j][3]);
    const float mean = wsum(s) * (1.f / D); float q = 0.f;
#pragma unroll
    for (int j = 0; j < 4; ++j) { v[j] = v[j] - mean; q += (v[j][0] * v[j][0] + v[j][1] * v[j][1]) + (v[j][2] * v[j][2] + v[j][3] * v[j][3]); }
    const float rstd = rsqrtf(wsum(q) * (1.f / D) + LN_EPS);
#pragma unroll
    for (int j = 0; j < 4; ++j) { const f32x4 gg = *(const LAS f32x4*)(g + 4 * lane + 256 * j), bb = *(const LAS f32x4*)(b + 4 * lane + 256 * j); v[j] = v[j] * rstd * gg + bb; }
}
__device__ __forceinline__ void store_row_f32_bf16(const f32x4 (&v)[4], float* xf, bf16* xb, int lane) {
#pragma unroll
    for (int j = 0; j < 4; ++j) { if (xf) ((f32x4*)xf)[lane + 64 * j] = v[j]; if (xb) { u32x2 o; o.x = cvt_pk_bf16(v[j][0], v[j][1]); o.y = cvt_pk_bf16(v[j][2], v[j][3]); ((u32x2*)xb)[lane + 64 * j] = o; } }
}

__device__ __forceinline__ void route_thread(const float (&lg)[16], const float (&brv)[16], int m, int lt, int* TOK_E, float* TOK_W, LAS int* tokE) {
    float aff[16], sel[16];
#pragma unroll
    for (int e = 0; e < 16; ++e) { aff[e] = 1.f / (1.f + __expf(-lg[e])); sel[e] = aff[e] + brv[e]; }
    int gbest = 0; float gs = -1e30f;
#pragma unroll
    for (int gi = 0; gi < 4; ++gi) { float a = -1e30f, b2 = -1e30f;
#pragma unroll
        for (int j = 0; j < 4; ++j) { const float x = sel[gi * 4 + j]; const bool gt = x > a; b2 = gt ? a : fmaxf(b2, x); a = gt ? x : a; }
        const bool better = a + b2 > gs; gs = better ? a + b2 : gs; gbest = better ? gi : gbest; }
    int i0 = 0, i1 = 0; float a = -1e30f, b2 = -1e30f, wa = 0.f, wb = 0.f;
#pragma unroll
    for (int j = 0; j < 4; ++j) { float x = sel[j], y = aff[j];
#pragma unroll
        for (int gi = 1; gi < 4; ++gi) { x = (gi == gbest) ? sel[gi * 4 + j] : x; y = (gi == gbest) ? aff[gi * 4 + j] : y; }
        const bool g1 = x > a, g2 = x > b2;
        const float nb = g1 ? a : (g2 ? x : b2), nwb = g1 ? wa : (g2 ? y : wb); const int ni1 = g1 ? i0 : (g2 ? j : i1);
        a = g1 ? x : a; wa = g1 ? y : wa; i0 = g1 ? j : i0; b2 = nb; wb = nwb; i1 = ni1; }
    const float inv = 1.f / (wa + wb); const int e0 = gbest * 4 + i0, e1 = gbest * 4 + i1;
    TOK_E[m * 2] = e0; TOK_E[m * 2 + 1] = e1; TOK_W[m * 2] = wa * inv; TOK_W[m * 2 + 1] = wb * inv; tokE[lt * 2] = e0; tokE[lt * 2 + 1] = e1;
}
__device__ __forceinline__ void phase_ln_router(KP p, int layer, LAS unsigned char* lds, int G, int bid, const int wave_s) {
    const int tid = fresh_tid(wave_s), lane = tid & 63, wave = wave_s;
    PSEC_BEGIN(0);
    unsigned char* ws = p->ws;
    LAS float* WT = (LAS float*)lds; LAS int* tokE = (LAS int*)(lds + 65536);
    load_wtab(WT, p->in[I_WR], 16, 0, 16, tid);
    ln_stage_gb(lds, p->in[I_LMG] + layer * D, p->in[I_LMB] + layer * D, tid);
    __syncthreads();
    const bf16* Y1 = (const bf16*)p->out; bf16* XB = (bf16*)(ws + WS_XB); int* TOK_E = (int*)(ws + WS_TOKE); float* TOK_W = (float*)(ws + WS_TOKW); int* CNT = (int*)(ws + WS_CNT); int* SLOT_TOK = (int*)(ws + WS_SLOTTOK);
    const LAS float* g = (const LAS float*)(lds + LN_GB_OFF); const LAS float* b = g + D;
#define LNR_LOAD(R, q) do { _Pragma("unroll") for (int r_ = 0; r_ < 4; ++r_) { const u32x2* s0_ = (const u32x2*)(Y1 + (size_t)(tb * 128 + wave * 16 + 4 * (q) + r_) * D) + lane; \
        _Pragma("unroll") for (int j = 0; j < 4; ++j) R[r_][j] = s0_[64 * j]; } } while (0)
#define LNR_CVT(v, R, r_) do { _Pragma("unroll") for (int j = 0; j < 4; ++j) { const u32x2 a_ = R[r_][j]; \
        v[j][0] = __uint_as_float(a_.x << 16); v[j][1] = __uint_as_float(a_.x & 0xffff0000u); v[j][2] = __uint_as_float(a_.y << 16); v[j][3] = __uint_as_float(a_.y & 0xffff0000u); } } while (0)
#define LNR_PROC(R, q) do { const int lt_ = wave * 16 + 4 * (q), m_ = tb * 128 + lt_; f32x4 v0_[4], v1_[4], v2_[4], v3_[4]; \
        { PSEC_BEGIN(1); LNR_CVT(v0_, R, 0); LNR_CVT(v1_, R, 1); LNR_CVT(v2_, R, 2); LNR_CVT(v3_, R, 3); ln_row(v0_, g, b, lane); ln_row(v1_, g, b, lane); ln_row(v2_, g, b, lane); ln_row(v3_, g, b, lane); \
        store_row_f32_bf16(v0_, (float*)nullptr, XB + (size_t)m_ * D, lane); store_row_f32_bf16(v1_, (float*)nullptr, XB + (size_t)(m_ + 1) * D, lane); \
        store_row_f32_bf16(v2_, (float*)nullptr, XB + (size_t)(m_ + 2) * D, lane); store_row_f32_bf16(v3_, (float*)nullptr, XB + (size_t)(m_ + 3) * D, lane); PSEC_END(1); } \
        float l0_, l1_, l2_, l3_; { PSEC_BEGIN(2); row_dots16x4(v0_, v1_, v2_, v3_, WT, lane, l0_, l1_, l2_, l3_); asm volatile("" : "+v"(l0_), "+v"(l1_), "+v"(l2_), "+v"(l3_)); PSEC_END(2); } \
        if ((lane & 3) == 0) { LG[lt_ * 16 + (lane >> 2)] = l0_; LG[(lt_ + 1) * 16 + (lane >> 2)] = l1_; LG[(lt_ + 2) * 16 + (lane >> 2)] = l2_; LG[(lt_ + 3) * 16 + (lane >> 2)] = l3_; } } while (0)
    LAS float* LG = (LAS float*)(lds + 65536 + 1024);
    for (int tb = bid; tb < NTOK / 128; tb += G) {
        u32x2 qa[4][4], qb[4][4];
        LNR_LOAD(qa, 0); LNR_LOAD(qb, 1);
        LNR_PROC(qa, 0); LNR_LOAD(qa, 2);
        LNR_PROC(qb, 1); LNR_LOAD(qb, 3);
        LNR_PROC(qa, 2); LNR_PROC(qb, 3);
        __syncthreads();
        if (tid < 128) { PSEC_BEGIN(3); float lg[16], brv[16];
#pragma unroll
            for (int q = 0; q < 4; ++q) { const f32x4 t4 = *(const LAS f32x4*)(LG + tid * 16 + 4 * q); const f32x4 b4 = *(const f32x4*)(p->in[I_BR] + 4 * q);
#pragma unroll
                for (int j = 0; j < 4; ++j) { lg[4 * q + j] = t4[j]; brv[4 * q + j] = b4[j]; } }
            route_thread(lg, brv, tb * 128 + tid, tid, TOK_E, TOK_W, tokE); PSEC_END(3); }
        __syncthreads();
        LAS int* WC = (LAS int*)(lds + 65536 + 1024 + 8192);
        int e_ = 0, rk_ = 0;
        if (tid < 256) { e_ = tokE[tid]; int cnt_ = 0;
#pragma unroll 1
            for (int x = 0; x < 16; ++x) { const unsigned long long m_ = __ballot(e_ == x); if (e_ == x) rk_ = (int)__builtin_amdgcn_mbcnt_hi((unsigned)(m_ >> 32), __builtin_amdgcn_mbcnt_lo((unsigned)m_, 0u)); if (lane == x) cnt_ = __builtin_popcountll(m_); }
            if (lane < 16) WC[wave * 16 + lane] = cnt_; }
        __syncthreads();
        if (tid < 256) {
            for (int w = 0; w < wave; ++w) rk_ += WC[w * 16 + e_];
            SLOT_TOK[(e_ * 256 + tb) * 128 + rk_] = tb * 256 + tid;
            if (tid < 16) CNT[tb * 16 + tid] = WC[tid] + WC[16 + tid] + WC[32 + tid] + WC[48 + tid]; }
        __syncthreads();
    }
    PSEC_END(0);
#undef LNR_LOAD
#undef LNR_CVT
#undef LNR_PROC
}
struct FfnRow { u32x2 x[4], ya[4], yc[4]; float w0, w1; };
__device__ __forceinline__ void ffn_combine(FfnRow& r, f32x4 (&v)[4]) {
#pragma unroll
    for (int j = 0; j < 4; ++j) { const u32x2 a = r.ya[j], c = r.yc[j]; f32x4 ya, yc;
        ya[0] = __uint_as_float(a.x << 16); ya[1] = __uint_as_float(a.x & 0xffff0000u); ya[2] = __uint_as_float(a.y << 16); ya[3] = __uint_as_float(a.y & 0xffff0000u);
        yc[0] = __uint_as_float(c.x << 16); yc[1] = __uint_as_float(c.x & 0xffff0000u); yc[2] = __uint_as_float(c.y << 16); yc[3] = __uint_as_float(c.y & 0xffff0000u);
        const u32x2 xx = r.x[j]; f32x4 xv; xv[0] = __uint_as_float(xx.x << 16); xv[1] = __uint_as_float(xx.x & 0xffff0000u); xv[2] = __uint_as_float(xx.y << 16); xv[3] = __uint_as_float(xx.y & 0xffff0000u);
        v[j] = xv * DN_ALPHA + ya * r.w0 + yc * r.w1; }
}
__device__ __forceinline__ void phase_ln_ffn(KP p, int layer, LAS unsigned char* lds, int G, int bid, const int wave_s) {
    const int tid = fresh_tid(wave_s), lane = tid & 63, wave = wave_s;
    unsigned char* ws = p->ws;
    LAS float* WT = (LAS float*)lds;
    if (layer == 0) { load_wtab(WT, p->in[I_WKV], KV_IN, 1536, 12, tid); __syncthreads(); }
    const int eo = (lane >> 2) & 15; const float bf = (layer == 0 && eo < 12) ? p->in[I_BFORGET][eo] : 0.f;
    float* XF = p->out; bf16* XB = (bf16*)(ws + WS_XB); const bf16* YS = (const bf16*)(ws + WS_HREG);
    const int* TOK_S = (const int*)(ws + WS_TOKS); const float* TOK_W = (const float*)(ws + WS_TOKW); float* LOGF = (float*)(ws + WS_LOGF);
    ln_stage_gb(lds, p->in[I_LFG] + layer * D, p->in[I_LFB] + layer * D, tid); __syncthreads(); const LAS float* g = (const LAS float*)(lds + LN_GB_OFF); const LAS float* b = g + D;
    const int gw = bid * NWAVES + wave, NGW = G * NWAVES;
#define FFN_LOAD(R, m_) do { const int mm_ = (m_); int mv_ = mm_ * 2; asm volatile("" : "+v"(mv_));        \
        const int s0_ = TOK_S[mv_], s1_ = TOK_S[mv_ + 1]; R.w0 = TOK_W[mv_]; R.w1 = TOK_W[mv_ + 1]; \
        _Pragma("unroll") for (int j = 0; j < 4; ++j) { R.x[j] = ((const u32x2*)(XB + (size_t)mm_ * D))[lane + 64 * j]; R.ya[j] = ((const u32x2*)(YS + (size_t)s0_ * D))[lane + 64 * j]; R.yc[j] = ((const u32x2*)(YS + (size_t)s1_ * D))[lane + 64 * j]; } } while (0)
#define FFN_PROC(R, m_) do { const int mm_ = (m_); f32x4 v_[4]; ffn_combine(R, v_); ln_row(v_, g, b, lane); \
        store_row_f32_bf16(v_, layer == 0 ? (float*)nullptr : XF + (size_t)mm_ * D, layer == 0 ? XB + (size_t)mm_ * D : (bf16*)nullptr, lane); \
        if (layer == 0) { const float t_ = row_dots16(v_, WT, lane); if ((lane & 3) == 0 && eo < 12) LOGF[(size_t)mm_ * 12 + eo] = log_sigmoid(t_ + bf); } } while (0)
    FfnRow A0, A1, B0, B1;
#define FFN_PROC2(R0, R1, m0_, m1_) do { const int ma_ = (m0_), mb_ = (m1_); f32x4 va_[4], vb_[4]; ffn_combine(R0, va_); ffn_combine(R1, vb_); ln_row(va_, g, b, lane); ln_row(vb_, g, b, lane); \
        store_row_f32_bf16(va_, layer == 0 ? (float*)nullptr : XF + (size_t)ma_ * D, layer == 0 ? XB + (size_t)ma_ * D : (bf16*)nullptr, lane); \
        store_row_f32_bf16(vb_, layer == 0 ? (float*)nullptr : XF + (size_t)mb_ * D, layer == 0 ? XB + (size_t)mb_ * D : (bf16*)nullptr, lane); \
        if (layer == 0) { float ta_, tb_; row_dots16x2<6>(va_, vb_, WT, lane, ta_, tb_); if ((lane & 3) == 0 && eo < 12) { LOGF[(size_t)ma_ * 12 + eo] = log_sigmoid(ta_ + bf); LOGF[(size_t)mb_ * 12 + eo] = log_sigmoid(tb_ + bf); } } } while (0)
    int m = gw;
    if (m + NGW < NTOK) { FFN_LOAD(A0, m); FFN_LOAD(A1, m + NGW); }
#pragma unroll 1
    for (; m + NGW < NTOK; m += 4 * NGW) {
        const bool hb = (m + 3 * NGW) < NTOK;
        if (hb) { FFN_LOAD(B0, m + 2 * NGW); FFN_LOAD(B1, m + 3 * NGW); }
        FFN_PROC2(A0, A1, m, m + NGW);
        if (m + 5 * NGW < NTOK) { FFN_LOAD(A0, m + 4 * NGW); FFN_LOAD(A1, m + 5 * NGW); }
        if (hb) FFN_PROC2(B0, B1, m + 2 * NGW, m + 3 * NGW); else { m += 2 * NGW; break; }
    }
    if (m < NTOK) { FFN_LOAD(A0, m); FFN_PROC(A0, m); }
#undef FFN_PROC2
#undef FFN_LOAD
#undef FFN_PROC
}
__device__ __forceinline__ void cum_wave(const float* LOGF, float* CUM, int bh, int lane) {
    const int b = bh / FOX_H, h = bh % FOX_H;
    float loc[64]; float s = 0.f;
#pragma unroll
    for (int i = 0; i < 64; ++i) { s += LOGF[((size_t)b * SEQ + lane * 64 + i) * 12 + h]; loc[i] = s; }
    float inc = s;
#pragma unroll
    for (int o = 1; o < 64; o <<= 1) { const float t = __shfl_up(inc, o); if (lane >= o) inc += t; }
    const float base = inc - s;
#pragma unroll
    for (int i = 0; i < 64; ++i) CUM[(size_t)bh * SEQ + lane * 64 + i] = base + loc[i];
}
constexpr int MOE_MAXU = 6;
__device__ __forceinline__ int moe_setup(unsigned char* ws, LAS unsigned char* lds, int G, int bid, const int wave_s, const bool build_rows) {
    const int tid = fresh_tid(wave_s), lane = tid & 63, wave = wave_s;
    LAS int* PRE = (LAS int*)lds; LAS int* TB = (LAS int*)(lds + 16640); LAS int* TE = TB + 17;
    volatile LAS int* UL = (volatile LAS int*)(lds + MISC_OFF) + 16; LAS int* rowtok = (LAS int*)(lds + ROWTOK_OFF);
    const int* CNT = (const int*)(ws + WS_CNT); const int* SLOT_TOK = (const int*)(ws + WS_SLOTTOK); int* TOK_S = (int*)(ws + WS_TOKS);
#pragma unroll
    for (int q = 0; q < 2; ++q) { const int e = 2 * wave + q;
        int c[4]; int s = 0;
#pragma unroll
        for (int i = 0; i < 4; ++i) { c[i] = CNT[(4 * lane + i) * 16 + e]; s += c[i]; }
        int inc = s;
#pragma unroll
        for (int o = 1; o < 64; o <<= 1) { const int t = __shfl_up(inc, o); if (lane >= o) inc += t; }
        int run = inc - s;
#pragma unroll
        for (int i = 0; i < 4; ++i) { PRE[e * 257 + 4 * lane + i] = run; run += c[i]; }
        if (lane == 63) { PRE[e * 257 + 256] = inc; TE[e] = inc; } }
    __syncthreads();
    if (tid <= 16) { int t = 0; for (int e = 0; e < 16; ++e) { if (e < tid) t += (TE[e] + 255) >> 8; } TB[tid] = t; }
    __syncthreads();
    const int NT = TB[16];
    if (tid < MOE_MAXU) { const int L = tid * G + bid, tile = (L & 7) + 8 * (L >> 5), pn = (L >> 3) & 3;
        int e = 0;
#pragma unroll
        for (int k = 1; k < 16; ++k) e += (TB[k] <= tile) ? 1 : 0;
        UL[3 * tid] = tile; UL[3 * tid + 1] = pn; UL[3 * tid + 2] = e; UL[32 + tid] = (tile < NT) ? 1 : 0; }
    __syncthreads();
    if (tid == 0) { int n = 0;
#pragma unroll
        for (int i = 0; i < MOE_MAXU; ++i) n += (int)UL[32 + i]; UL[24] = n; UL[25] = 32 * ((NT + 7) >> 3); }
    __syncthreads();
    const int nunits = __builtin_amdgcn_readfirstlane(UL[24]);
    if (build_rows) {
        for (int i = (tid >> 8); i < nunits; i += 2) { const int tile = UL[3 * i], pn = UL[3 * i + 1], e = UL[3 * i + 2], j = tid & 255;
            const int r = 256 * (tile - TB[e]) + j; int tok = 0;
            if (r < TE[e]) { int lo = 0, hi = 256;
                while (hi - lo > 1) { const int mid = (lo + hi) >> 1; if (PRE[e * 257 + mid] <= r) lo = mid; else hi = mid; }
                const int ent = SLOT_TOK[(e * 256 + lo) * 128 + (r - PRE[e * 257 + lo])]; tok = ent >> 1;
                if (pn == 0) TOK_S[ent] = 256 * tile + j; }
            rowtok[i * 256 + j] = tok; }
    }
    __syncthreads();
    return nunits;
}
struct MoeGU {
    const char* XBp; const char* W; LAS const int* UL; LAS const int* rowtok; int nunits;
    __device__ __forceinline__ bool next(int i, Unit& u) const { if (i >= nunits) return false;
        u.pm = __builtin_amdgcn_readfirstlane(UL[3 * i]); u.pn = __builtin_amdgcn_readfirstlane(UL[3 * i + 1]); u.e = __builtin_amdgcn_readfirstlane(UL[3 * i + 2]); u.ord = i;
        u.A = XBp; u.B = W + ((size_t)u.e * 1024 + (size_t)u.pn * 256) * D * 2; return true; }
    __device__ __forceinline__ unsigned a_off(const Unit& u, int h, int R, int C) const { return (unsigned)(rowtok[u.ord * 256 + R + HALF * h] * D + C) * 2u; }
};
struct MoeDown {
    const char* Hp; const char* W; LAS const int* UL; int nunits;
    __device__ __forceinline__ bool next(int i, Unit& u) const { if (i >= nunits) return false;
        u.pm = __builtin_amdgcn_readfirstlane(UL[3 * i]); u.pn = __builtin_amdgcn_readfirstlane(UL[3 * i + 1]); u.e = __builtin_amdgcn_readfirstlane(UL[3 * i + 2]); u.ord = i;
        u.A = Hp + (size_t)u.pm * BM * DEXP * 2; u.B = W + ((size_t)u.e * 1024 + (size_t)u.pn * 256) * DEXP * 2; return true; }
    __device__ __forceinline__ unsigned a_off(const Unit&, int h, int R, int C) const { return (unsigned)((R + HALF * h) * DEXP + C) * 2u; }
};
struct EpiGateUp { bf16* H;
    __device__ __forceinline__ void operator()(const f32x4 (&acc)[2][2][4][2], const Unit& u, int wr, int wc, int fr, int fq) const {
        GAS bf16* rowp = (GAS bf16*)H + (size_t)(u.pm * BM + wr * 64 + fr) * DEXP + (u.pn * 128 + wc * 32 + 8 * fq);
#pragma unroll
        for (int ai = 0; ai < 2; ++ai) {
#pragma unroll
            for (int m = 0; m < 4; ++m) { float hv[8];
#pragma unroll
                for (int n = 0; n < 2; ++n)
#pragma unroll
                    for (int j = 0; j < 4; ++j) { const float g = acc[ai][0][m][n][j], up = acc[ai][1][m][n][j]; hv[4 * n + j] = g * __builtin_amdgcn_rcpf(1.f + __expf(-g)) * up; }
                u32x4 w; w.x = cvt_pk_bf16(hv[0], hv[1]); w.y = cvt_pk_bf16(hv[2], hv[3]); w.z = cvt_pk_bf16(hv[4], hv[5]); w.w = cvt_pk_bf16(hv[6], hv[7]);
                *(GAS u32x4*)rowp = w;
                rowp += (size_t)16 * DEXP; asm volatile("" : "+v"(rowp)); }
            rowp += (size_t)64 * DEXP; }
    } };
__device__ __forceinline__ int crow(int r, int hi) { return (r & 3) + 8 * (r >> 2) + 4 * hi; }
__device__ __forceinline__ unsigned cvtpk_s(float lo, float hi) { typedef float f2 __attribute__((ext_vector_type(2))); typedef __bf16 b2 __attribute__((ext_vector_type(2))); f2 v = {lo, hi}; b2 b = __builtin_convertvector(v, b2); return __builtin_bit_cast(unsigned, b); }
__device__ __forceinline__ float bfbits2f(unsigned short v) { return __uint_as_float(((unsigned)v) << 16); }

constexpr int AT_NSLOT = 4, AT_SLOT = 16640, AT_K = 0, AT_V = 8192, AT_KB = 16384, AT_WS = AT_NSLOT * AT_SLOT, AT_OST = AT_WS + 2048, AT_BYTES = AT_OST + 8 * 4096;
static_assert(AT_BYTES <= RING_BYTES, "attention LDS");
__device__ __forceinline__ void glds_asm16(const void* gsrc, unsigned lds_dst) { unsigned keep;
    asm volatile("s_mov_b32 %0, m0\n\ts_mov_b32 m0, %2\n\ts_nop 0\n\tglobal_load_lds_dwordx4 %1, off\n\ts_mov_b32 m0, %0" : "=&s"(keep) : "v"(gsrc), "s"(lds_dst) : "memory"); }
__device__ __forceinline__ void glds_asm4(const void* gsrc, unsigned lds_dst) { unsigned keep;
    asm volatile("s_mov_b32 %0, m0\n\ts_mov_b32 m0, %2\n\ts_nop 0\n\tglobal_load_lds_dword %1, off\n\ts_mov_b32 m0, %0" : "=&s"(keep) : "v"(gsrc), "s"(lds_dst) : "memory"); }
constexpr float AT_THR = 10.0f, AT_SKIP = 40.0f;
template <bool FOX>
__device__ __forceinline__ void attn_qk(const LAS unsigned char* slot, const bf16x8 (&qr)[4], float mref, f32x16& p0, f32x16& p1, int r32, int hi) {
    const LAS unsigned char* kb = slot + AT_K + hi * 1024 + r32 * 16; const LAS float* kbs = (const LAS float*)(slot + AT_KB);
    if (FOX) { const float nm = -mref;
#pragma unroll
        for (int g = 0; g < 4; ++g) { const f32x4 b0 = *(const LAS f32x4*)(kbs + 8 * g + 4 * hi), b1 = *(const LAS f32x4*)(kbs + 32 + 8 * g + 4 * hi);
#pragma unroll
            for (int j = 0; j < 4; ++j) { p0[4 * g + j] = __builtin_fmaf(b0[j], -LOG2E, nm); p1[4 * g + j] = __builtin_fmaf(b1[j], -LOG2E, nm); } }
    } else { p0 = f32x16{}; p1 = f32x16{}; }
#pragma unroll
    for (int d0 = 0; d0 < 4; ++d0) { const bf16x8 b0 = *(const LAS bf16x8*)(kb + d0 * 2048), b1 = *(const LAS bf16x8*)(kb + d0 * 2048 + 512);
        p0 = __builtin_amdgcn_mfma_f32_32x32x16_bf16(b0, qr[d0], p0, 0, 0, 0); p1 = __builtin_amdgcn_mfma_f32_32x32x16_bf16(b1, qr[d0], p1, 0, 0, 0); }
}
template <bool FOX>
__device__ __forceinline__ void attn_sm_pv(const LAS unsigned char* slot, f32x16& p0, f32x16& p1, f32x16& n0, f32x16& n1, bool has_next, f32x16 (&o)[2], float& mref, float& lrun, bool& started, LAS float* wsf, int vb0, int jb, int qrel, int r32, int hi) {
    if (FOX) {
        if (jb >= 0) { const int kbase = 64 * jb + 4 * hi;
#pragma unroll
            for (int r = 0; r < 16; ++r) { const int kv = kbase + (r & 3) + 8 * (r >> 2); if (kv > qrel) p0[r] = -INFINITY; if (kv + 32 > qrel) p1[r] = -INFINITY; } }
    } else { const float nm = -mref;
#pragma unroll
        for (int r = 0; r < 16; ++r) { p0[r] = __builtin_fmaf(p0[r], QC2, nm); p1[r] = __builtin_fmaf(p1[r], QC2, nm); }
    }
    float rm = __builtin_fmaxf(p0[0], p1[0]), rm2 = __builtin_fmaxf(p0[1], p1[1]);
#pragma unroll
    for (int r = 2; r < 16; r += 2) { rm = __builtin_fmaxf(__builtin_fmaxf(rm, p0[r]), p1[r]); rm2 = __builtin_fmaxf(__builtin_fmaxf(rm2, p0[r + 1]), p1[r + 1]); }
    rm = __builtin_fmaxf(rm, rm2);
    { auto rr = __builtin_amdgcn_permlane32_swap(__float_as_uint(rm), __float_as_uint(rm), false, false); rm = fmaxf(__uint_as_float(rr[0]), __uint_as_float(rr[1])); }
    const bool live = rm > -1e30f, move = (rm > AT_THR) || (!started && live);
    started = started || live;
    if (__builtin_expect(__any(move), 0)) {
        const float dl = move ? rm : 0.f, f = __builtin_amdgcn_exp2f(fminf(-dl, 64.f));
        mref += dl; lrun *= f;
#pragma unroll
        for (int r = 0; r < 16; ++r) { p0[r] -= dl; p1[r] -= dl; }
        if (FOX && has_next) {
#pragma unroll
            for (int r = 0; r < 16; ++r) { n0[r] -= dl; n1[r] -= dl; } }
        if (hi == 0) wsf[r32] = f;
        asm volatile("s_waitcnt lgkmcnt(0)" ::: "memory");
#pragma unroll
        for (int g = 0; g < 4; ++g) { const f32x4 a = *(const LAS f32x4*)(wsf + 8 * g + 4 * hi);
#pragma unroll
            for (int j = 0; j < 4; ++j) { o[0][4 * g + j] *= a[j]; o[1][4 * g + j] *= a[j]; } }
    }
    float rs = 0.f;
#pragma unroll
    for (int r = 0; r < 16; ++r) { p0[r] = __builtin_amdgcn_exp2f(p0[r]); p1[r] = __builtin_amdgcn_exp2f(p1[r]); rs += p0[r] + p1[r]; }
    lrun += rs;
    u32x4 pw[4];
#pragma unroll
    for (int k = 0; k < 2; ++k) {
        pw[k] = (u32x4){cvtpk_s(p0[8 * k], p0[8 * k + 1]), cvtpk_s(p0[8 * k + 2], p0[8 * k + 3]), cvtpk_s(p0[8 * k + 4], p0[8 * k + 5]), cvtpk_s(p0[8 * k + 6], p0[8 * k + 7])};
        pw[2 + k] = (u32x4){cvtpk_s(p1[8 * k], p1[8 * k + 1]), cvtpk_s(p1[8 * k + 2], p1[8 * k + 3]), cvtpk_s(p1[8 * k + 4], p1[8 * k + 5]), cvtpk_s(p1[8 * k + 6], p1[8 * k + 7])}; }
    const int vb = vb0 + (int)(unsigned)(size_t)slot;
    s16x4 vlo[2][4], vhi[2][4];
#pragma unroll
    for (int d0 = 0; d0 < 2; ++d0) {
#pragma unroll
        for (int ks = 0; ks < 4; ++ks) {
            asm volatile("ds_read_b64_tr_b16 %0,%1 offset:%c2" : "=&v"(vlo[d0][ks]) : "v"(vb), "i"(d0 * 4096 + ks * 1024) : "memory");
            asm volatile("ds_read_b64_tr_b16 %0,%1 offset:%c2" : "=&v"(vhi[d0][ks]) : "v"(vb), "i"(d0 * 4096 + ks * 1024 + 512) : "memory"); } }
#pragma unroll
    for (int d0 = 0; d0 < 2; ++d0) {
        if (d0 == 0) asm volatile("s_waitcnt lgkmcnt(8)" : "+v"(vlo[0][0]), "+v"(vlo[0][1]), "+v"(vlo[0][2]), "+v"(vlo[0][3]), "+v"(vhi[0][0]), "+v"(vhi[0][1]), "+v"(vhi[0][2]), "+v"(vhi[0][3]) :: "memory");
        else asm volatile("s_waitcnt lgkmcnt(0)" : "+v"(vlo[1][0]), "+v"(vlo[1][1]), "+v"(vlo[1][2]), "+v"(vlo[1][3]), "+v"(vhi[1][0]), "+v"(vhi[1][1]), "+v"(vhi[1][2]), "+v"(vhi[1][3]) :: "memory");
        __builtin_amdgcn_sched_barrier(0);
#pragma unroll
        for (int ks = 0; ks < 4; ++ks) { const bf16x8 vf = (bf16x8){vlo[d0][ks][0], vlo[d0][ks][1], vlo[d0][ks][2], vlo[d0][ks][3], vhi[d0][ks][0], vhi[d0][ks][1], vhi[d0][ks][2], vhi[d0][ks][3]};
            o[d0] = __builtin_amdgcn_mfma_f32_32x32x16_bf16(__builtin_bit_cast(bf16x8, pw[ks]), vf, o[d0], 0, 0, 0); }
    }
}
template <bool FOX>
__device__ __forceinline__ void attn_unit(LAS unsigned char* lds, const bf16* Qp, int qpitch, const bf16* Kp, const bf16* Vp, int kvpitch, int NT, const float* cum, float qk_bound, bf16* Op, int opitch, const bf16* OGp, int gpitch, const int wave_s) {
    const int tid = fresh_tid(wave_s), lane = tid & 63, wid = wave_s, r32 = lane & 31, hi = lane >> 5; const int bid = blockIdx.x;
    LAS float* wsf = (LAS float*)(lds + AT_WS) + wid * 64;
    const bf16* ksrc = Kp + (size_t)lane * kvpitch + wid * 8;
    const bf16* vsrc = Vp + (size_t)(16 * (wid & 3) + (lane >> 2)) * kvpitch + (wid >> 2) * 32 + (lane & 3) * 8;
    const int vb0 = AT_V + ((lane >> 4) & 1) * 32 + (lane & 3) * 8 + (4 * hi + ((lane & 15) >> 2)) * 64;
    const int NTF = NT; const size_t tstep = (size_t)64 * kvpitch;
    constexpr int ND = FOX ? 3 : 2;
#define AT_TILE(tt) (FOX ? NTF - 1 - (tt) : (tt))
#define AT_ISSUE(tt) do { const unsigned sl_ = ldsb + (unsigned)(((tt) & (AT_NSLOT - 1)) * AT_SLOT); const int kt_ = AT_TILE(tt); \
        glds_asm16(ksrc + (size_t)kt_ * tstep, (unsigned)__builtin_amdgcn_readfirstlane(sl_ + AT_K + wid * 1024)); \
        glds_asm16(vsrc + (size_t)kt_ * tstep, (unsigned)__builtin_amdgcn_readfirstlane(sl_ + AT_V + wid * 1024)); \
        if (FOX) glds_asm4(cum + kt_ * 64 + lane, (unsigned)__builtin_amdgcn_readfirstlane(sl_ + AT_KB)); } while (0)
    const unsigned ldsb = (unsigned)(size_t)lds;
    AT_ISSUE(0); AT_ISSUE(1); AT_ISSUE(2);
    bf16x8 qr[4];
#pragma unroll
    for (int d0 = 0; d0 < 4; ++d0) qr[d0] = *(const bf16x8*)(Qp + (size_t)(wid * 32 + r32) * qpitch + d0 * 16 + hi * 8);
    float mref = 0.f, lrun = 0.f; bool started = false; f32x16 o[2]; o[0] = f32x16{}; o[1] = f32x16{};
    if (FOX) { int i0 = NTF * 64 - 256; asm volatile("" : "+v"(i0));
        const float c0 = cum[i0], cl = cum[(lane < NTF ? lane : NTF - 1) * 64 + 63];
        const bool need = (lane < NTF) && ((c0 - cl) * LOG2E + 2.f * qk_bound >= -AT_SKIP);
        const int cnt = __builtin_popcountll(__ballot(need)); NT = cnt < 4 ? 4 : ((cnt + 1) & ~1); if (NT > NTF) NT = NTF; }
    const int qrel = wid * 32 + r32;
#define AT_WAIT1() do { if (FOX) asm volatile("s_waitcnt vmcnt(3)" ::: "memory"); else asm volatile("s_waitcnt vmcnt(2)" ::: "memory"); } while (0)
#define AT_SLOTP(tt) (lds + ((tt) & (AT_NSLOT - 1)) * AT_SLOT)
#define AT_STEP(PC0, PC1, PN0, PN1, tt) do { const int t_ = (tt); const bool hn_ = t_ + 1 < NT; \
        { PSEC_BEGIN(10); if (t_ + 2 < NT) AT_WAIT1(); else asm volatile("s_waitcnt vmcnt(0)" ::: "memory"); \
        __builtin_amdgcn_s_barrier(); asm volatile("" ::: "memory"); PSEC_END(10); } \
        { PSEC_BEGIN(11); if (t_ + 3 < NT) AT_ISSUE(t_ + 3); PSEC_END(11); } \
        { PSEC_BEGIN(12); if (hn_) attn_qk<FOX>(AT_SLOTP(t_ + 1), qr, mref, PN0, PN1, r32, hi); PSEC_END(12); } \
        { PSEC_BEGIN(13); attn_sm_pv<FOX>(AT_SLOTP(t_), PC0, PC1, PN0, PN1, hn_, o, mref, lrun, started, wsf, vb0, AT_TILE(t_) - (NTF - 4), qrel, r32, hi); PSEC_END(13); } } while (0)
    f32x16 a0, a1, b0, b1;
    if (FOX) asm volatile("s_waitcnt vmcnt(6)" ::: "memory"); else asm volatile("s_waitcnt vmcnt(4)" ::: "memory");
    __builtin_amdgcn_s_barrier(); asm volatile("" ::: "memory");
    attn_qk<FOX>(AT_SLOTP(0), qr, mref, a0, a1, r32, hi);
#pragma unroll 1
    for (int t = 0; t < NT; t += 2) { AT_STEP(a0, a1, b0, b1, t); AT_STEP(b0, b1, a0, a1, t + 1); }
#undef AT_STEP
#undef AT_WAIT1
#undef AT_SLOTP
#undef AT_ISSUE
#undef AT_TILE
    static_assert(ND == 3 || ND == 2, "");
    { auto rr = __builtin_amdgcn_permlane32_swap(__float_as_uint(lrun), __float_as_uint(lrun), false, false); lrun = __uint_as_float(rr[0]) + __uint_as_float(rr[1]); }
    u32x4 ogv[4];
    if (FOX) {
#pragma unroll
        for (int i = 0; i < 4; ++i) ogv[i] = *(const u32x4*)(OGp + (size_t)(wid * 32 + i * 8 + (lane >> 3)) * gpitch + (lane & 7) * 8); }
    if (hi == 0) wsf[32 + r32] = lrun;
    asm volatile("s_waitcnt lgkmcnt(0)" ::: "memory");
    LAS bf16* stg = (LAS bf16*)(lds + AT_OST) + wid * 2048;
#pragma unroll
    for (int r = 0; r < 16; ++r) { const int orow = crow(r, hi); const float rl = __builtin_amdgcn_rcpf(wsf[32 + orow]);
#pragma unroll
        for (int d0 = 0; d0 < 2; ++d0) stg[orow * 64 + d0 * 32 + r32] = f2bf(o[d0][r] * rl); }
    asm volatile("s_waitcnt lgkmcnt(0)" ::: "memory");
#pragma unroll
    for (int i = 0; i < 4; ++i) { const int row = i * 8 + (lane >> 3), ch = lane & 7; u32x4 v = *(const LAS u32x4*)(stg + row * 64 + ch * 8);
        const size_t go = (size_t)(wid * 32 + row) * opitch + ch * 8;
        if (FOX) { const u32x4 g = ogv[i]; unsigned vv[4] = {v.x, v.y, v.z, v.w}; const unsigned gg[4] = {g.x, g.y, g.z, g.w};
#pragma unroll
            for (int k = 0; k < 4; ++k) { const float a0 = __uint_as_float(vv[k] << 16), a1 = __uint_as_float(vv[k] & 0xffff0000u), g0 = __uint_as_float(gg[k] << 16), g1 = __uint_as_float(gg[k] & 0xffff0000u);
                vv[k] = cvtpk_s(a0 * __builtin_amdgcn_rcpf(1.f + __expf(-g0)), a1 * __builtin_amdgcn_rcpf(1.f + __expf(-g1))); }
            v = (u32x4){vv[0], vv[1], vv[2], vv[3]}; }
        *(u32x4*)(Op + go) = v; }
    __syncthreads();
}
constexpr int CW_Q11 = 1024;
__device__ __forceinline__ float wave_max64(float v) {
    v = fmaxf(v, dppf<0xB1>(v)); v = fmaxf(v, dppf<0x4E>(v)); v = fmaxf(v, dppf<0x141>(v)); v = fmaxf(v, dppf<0x140>(v));
    { auto r = __builtin_amdgcn_permlane16_swap(__float_as_uint(v), __float_as_uint(v), false, false); v = fmaxf(__uint_as_float(r[0]), __uint_as_float(r[1])); }
    { auto r = __builtin_amdgcn_permlane32_swap(__float_as_uint(v), __float_as_uint(v), false, false); v = fmaxf(__uint_as_float(r[0]), __uint_as_float(r[1])); }
    return v;
}
__device__ __forceinline__ void phase_attn_b(KP p, LAS unsigned char* lds, const int wave_s) {
    unsigned char* ws = p->ws;
    const bf16* Q = (const bf16*)(ws + WS_HREG); const bf16* K = (const bf16*)(ws + WS_HREG + HR_48); const bf16* V = (const bf16*)(ws + WS_HREG + 2 * HR_48); const bf16* OG = (const bf16*)(ws + WS_HREG + 3 * HR_48);
    const bf16* MQ = (const bf16*)(ws + WS_HREG + 4 * HR_48); const bf16* MKV = (const bf16*)(ws + WS_MKV);
    const float* CUM = (const float*)(ws + WS_CUM); bf16* OC = (bf16*)(ws + WS_GREG);
    unsigned* qhead = (unsigned*)(ws + WS_CTL) + CW_Q11;
    volatile LAS unsigned* slotw = (volatile LAS unsigned*)(lds + MISC_OFF) + 48;
    float qkb; { const int lane = fresh_lane(); const float gq = wave_max64(fabsf(p->in[I_QNG][lane])), gk = wave_max64(fabsf(p->in[I_KNG][lane])); qkb = 64.f * gq * gk * QC2 * 1.02f; }
    unsigned nxt = 0;
    if (fresh_tid(wave_s) == 0) nxt = __hip_atomic_fetch_add(qhead, 1u, __ATOMIC_RELAXED, __HIP_MEMORY_SCOPE_AGENT);
    for (;;) {
        if (fresh_tid(wave_s) == 0) slotw[0] = nxt;
        __syncthreads();
        const int u = (int)__builtin_amdgcn_readfirstlane(slotw[0]);
        if (u >= 1536 + 512) break;
        if (fresh_tid(wave_s) == 0) nxt = __hip_atomic_fetch_add(qhead, 1u, __ATOMIC_RELAXED, __HIP_MEMORY_SCOPE_AGENT);
        if (u < 1536) { const int qb = 15 - u / 96, bh = u % 96, b = bh / FOX_H, h = bh % FOX_H; const size_t row0 = (size_t)b * SEQ;
            attn_unit<true>(lds, Q + (row0 + qb * 256) * 768 + h * 64, 768, K + row0 * 768 + h * 64, V + row0 * 768 + h * 64, 768, 4 * (qb + 1), CUM + (size_t)bh * SEQ, qkb,
                            OC + (row0 + qb * 256) * D + h * 64, D, OG + (row0 + qb * 256) * 768 + h * 64, 768, wave_s); }
        else { const int m = u - 1536, b = m >> 6, hd = (m >> 4) & 3, qblk = m & 15; const size_t row0 = (size_t)b * SEQ + qblk * 256;
            const bf16* Kp = MKV + (size_t)b * NMEM * 1024 + 512 + hd * 64;
            attn_unit<false>(lds, MQ + row0 * 256 + hd * 64, 256, Kp, Kp + 256, 1024, 4, nullptr, 0.f, OC + row0 * D + 768 + hd * 64, D, nullptr, 0, wave_s); }
    }
}
__device__ __forceinline__ void phase_attn_mem(unsigned char* ws, unsigned char* oc0, LAS unsigned char* lds, int layer, int G, int bid, const int wave_s) {
    const bf16* MQ = (const bf16*)(ws + WS_HREG + (layer == 0 ? 3 : 4) * HR_48); const bf16* MKV = (const bf16*)(ws + WS_MKV); bf16* OC = (bf16*)(layer == 0 ? oc0 : ws + WS_GREG);
    for (int u = bid; u < 512; u += G) { const int b = u >> 6, hd = (u >> 4) & 3, qblk = u & 15; const size_t row0 = (size_t)b * SEQ + qblk * 256;
        const bf16* Kp = MKV + (size_t)b * NMEM * 1024 + layer * 512 + hd * 64;
        attn_unit<false>(lds, MQ + row0 * 256 + hd * 64, 256, Kp, Kp + 256, 1024, 4, nullptr, 0.f, OC + row0 * D + 768 + hd * 64, D, nullptr, 0, wave_s); }
}
constexpr int GL_QP = 208, GL_VP = 448, GL_KX = 0, GL_QD = 13312, GL_VT = 26624, GL_HEAD = 55296;
constexpr int GL_GLR = 2 * GL_HEAD, GL_TOT = GL_GLR + 4096, GL_SSX = GL_TOT + 1536, GL_WT = GL_SSX + 1024, GL_BYTES = GL_WT + (16 * 192 + 192 + 192) * 4;
static_assert(GL_BYTES <= RING_BYTES, "GLA LDS");
typedef short v4i16_t __attribute__((ext_vector_type(4)));
typedef float f32x2 __attribute__((ext_vector_type(2)));
__device__ __forceinline__ s16x4 trd(const LAS unsigned char* p) { return __builtin_bit_cast(s16x4, __builtin_amdgcn_ds_read_tr16_b64_v4i16((LAS v4i16_t*)p)); }
__device__ __forceinline__ float fast_log2_sigmoid(float z) { const float t = z * 1.4426950408889634f; return fminf(t, 0.f) - __builtin_amdgcn_logf(1.f + __builtin_amdgcn_exp2f(-fabsf(t))); }

__device__ __forceinline__ u32x4 pair16(u32x2 pa, u32x2 pb) {
    const auto rx = __builtin_amdgcn_permlane32_swap(pa.x, pb.x, false, false), ry = __builtin_amdgcn_permlane32_swap(pa.y, pb.y, false, false);
    return (u32x4){rx[0], ry[0], rx[1], ry[1]};
}
template <int MODE> struct GlaRegs { u32x4 v[6]; u32x4 qk[MODE == 1 ? 6 : 3]; f32x4 g; };
template <int MODE>
__device__ __forceinline__ void gla_fetch(unsigned char* ws, int tid, int unit, GlaRegs<MODE>& R) {
    const int hp = unit & 1, n = (unit >> 1) & 63, b = unit >> 7;
    const bf16* V = (const bf16*)(ws + WS_HREG + HR_48); const float* GLR = (const float*)(ws + WS_GLR); const bf16* QK = (const bf16*)(ws + WS_HREG);
    const size_t m0 = (size_t)b * SEQ + n * 64;
#pragma unroll
    for (int i = 0; i < 6; ++i) { const int pi = tid + 512 * i, u = pi / 1536, rem = pi % 1536, row = rem / 24, ch = rem % 24;
        R.v[i] = *(const u32x4*)(V + (m0 + row) * 768 + 192 * (2 * hp + u) + 8 * ch); }
#pragma unroll
    for (int i = 0; i < (MODE == 1 ? 6 : 3); ++i) { const int pi = tid + 512 * i, ts = pi / 1536, rem = pi % 1536, u = rem / 768, r2 = rem % 768, row = r2 / 12, ch = r2 % 12;
        R.qk[i] = *(const u32x4*)(QK + (m0 + row) * 768 + (ts == 0 ? 384 : 0) + 96 * (2 * hp + u) + 8 * ch); }
    if (tid < 256) R.g = *(const f32x4*)(GLR + m0 * 16 + 4 * tid);
}
template <int MODE>
__device__ __forceinline__ void gla_put(LAS unsigned char* lds, int tid, const GlaRegs<MODE>& R) {
#pragma unroll
    for (int i = 0; i < 6; ++i) { const int pi = tid + 512 * i, u = pi / 1536, rem = pi % 1536, row = rem / 24, ch = rem % 24;
        *(LAS u32x4*)(lds + u * GL_HEAD + GL_VT + row * GL_VP + ch * 16) = R.v[i]; }
#pragma unroll
    for (int i = 0; i < (MODE == 1 ? 6 : 3); ++i) { const int pi = tid + 512 * i, ts = pi / 1536, rem = pi % 1536, u = rem / 768, r2 = rem % 768, row = r2 / 12, ch = r2 % 12;
        *(LAS u32x4*)(lds + u * GL_HEAD + (ts == 0 ? GL_KX : GL_QD) + row * GL_QP + ch * 16) = R.qk[i]; }
    if (tid < 256) { LAS float* gd = (LAS float*)(lds + GL_GLR) + ((tid >> 3) * 16 + 4 * (tid & 3)) * 2 + ((tid >> 2) & 1);
#pragma unroll
        for (int k = 0; k < 4; ++k) gd[2 * k] = R.g[k]; }
}
__device__ __forceinline__ void gla_stage_w(KP p, LAS unsigned char* lds, int tid, int hp) {
    LAS float* wt = (LAS float*)(lds + GL_WT);
    for (int i = tid; i < 16 * 192; i += NTHREADS) wt[i] = p->in[I_WGUP][(i / 192) * 384 + 192 * hp + i % 192];
    if (tid < 192) { wt[3072 + tid] = p->in[I_BGATE][192 * hp + tid]; wt[3264 + tid] = p->in[I_GLAG][tid]; }
}
template <int MODE>
__device__ __forceinline__ void gla_gates(KP p, unsigned char* ws, LAS unsigned char* lds, int tid, int b, int n, int hp) {
    float* DEC = (float*)(ws + WS_DEC);
    const size_t m0 = (size_t)b * SEQ + n * 64;
    LAS float* glr = (LAS float*)(lds + GL_GLR); LAS float* totl = (LAS float*)(lds + GL_TOT); const LAS float* wt = (const LAS float*)(lds + GL_WT);
    float la[32]; float tot = 0.f; int col = 0, th = 0, u = 0, kidx = 0, head = 0;
    if (tid < 384) { col = tid % 192; th = tid / 192; u = col / 96; kidx = col % 96; head = 2 * hp + u;
        float w[16];
#pragma unroll
        for (int j = 0; j < 16; ++j) w[j] = wt[j * 192 + col];
        const float bg = wt[3072 + col];
#pragma unroll
        for (int i = 0; i < 32; i += 2) { const LAS float* gr = glr + (32 * th + i) * 16; f32x2 z = (f32x2){bg, bg};
#pragma unroll
            for (int j2 = 0; j2 < 8; ++j2) { const f32x4 gg = *(const LAS f32x4*)(gr + 4 * j2);
                z = (f32x2){gg[0], gg[1]} * w[2 * j2] + z; z = (f32x2){gg[2], gg[3]} * w[2 * j2 + 1] + z; }
            la[i] = fast_log2_sigmoid(z[0]) * (1.f / 16.f); la[i + 1] = fast_log2_sigmoid(z[1]) * (1.f / 16.f); tot += la[i] + la[i + 1]; }
        totl[th * 192 + col] = tot; }
    __syncthreads();
    if (tid < 384) {
        LAS bf16* KX = (LAS bf16*)(lds + u * GL_HEAD + GL_KX); LAS bf16* QD = (LAS bf16*)(lds + u * GL_HEAD + GL_QD);
        if (MODE == 0) {
            float run = (th == 1) ? 0.f : totl[192 + col];
            float kraw[32];
#pragma unroll
            for (int i = 0; i < 32; ++i) kraw[i] = bf2f(KX[(32 * th + i) * (GL_QP / 2) + kidx]);
#pragma unroll
            for (int i = 31; i >= 0; --i) { KX[(32 * th + i) * (GL_QP / 2) + kidx] = f2bf(kraw[i] * __builtin_amdgcn_exp2f(run)); run += la[i]; }
            if (th == 0) DEC[(((size_t)b * 64 + n) * 4 + head) * 96 + kidx] = __builtin_amdgcn_exp2f(run);
        } else {
            float run = (th == 0) ? 0.f : totl[col];
            float qraw[32], kraw[32];
#pragma unroll
            for (int i = 0; i < 32; ++i) { qraw[i] = bf2f(QD[(32 * th + i) * (GL_QP / 2) + kidx]); kraw[i] = bf2f(KX[(32 * th + i) * (GL_QP / 2) + kidx]); }
#pragma unroll
            for (int i = 0; i < 32; ++i) { run += la[i]; const unsigned pk = cvt_pk_bf16(qraw[i] * __builtin_amdgcn_exp2f(run) * 0.10206207261596577f, kraw[i] * __builtin_amdgcn_exp2f(-run));
                QD[(32 * th + i) * (GL_QP / 2) + kidx] = (bf16)(pk & 0xffffu); KX[(32 * th + i) * (GL_QP / 2) + kidx] = (bf16)(pk >> 16); }
        }
    }
    __syncthreads();
}
__device__ __forceinline__ void phase_gla_kv(KP p, LAS unsigned char* lds, int G, int bid, const int wave_s) {
    unsigned char* ws = p->ws; bf16* SKV = (bf16*)(ws + WS_GREG);
    GlaRegs<0> R;
    if (bid < NB * 64 * 2) gla_fetch<0>(ws, fresh_tid(wave_s), bid, R);
    int staged = -1;
    for (int unit = bid; unit < NB * 64 * 2; unit += G) {
        const int tid = fresh_tid(wave_s), lane = tid & 63, wid = wave_s;
        const int hp = unit & 1, n = (unit >> 1) & 63, b = unit >> 7;
        if (hp != staged) { if (staged >= 0) __syncthreads(); gla_stage_w(p, lds, tid, hp); staged = hp; }
        { PSEC_BEGIN(40); gla_put<0>(lds, tid, R);
        __syncthreads(); PSEC_END(40); }
        if (unit + G < NB * 64 * 2) gla_fetch<0>(ws, tid, unit + G, R);
        { PSEC_BEGIN(41); gla_gates<0>(p, ws, lds, tid, b, n, hp); PSEC_END(41); }
        PSEC_BEGIN(42);
        const int u = wid >> 2, j4 = wid & 3, head = 2 * hp + u, r32 = lane & 31, h2 = lane >> 5, q = (lane & 15) >> 2, pp = lane & 3, g1 = (lane >> 4) & 1;
        const LAS unsigned char* ka = lds + u * GL_HEAD + GL_KX + (8 * h2 + q) * GL_QP + (16 * g1 + 4 * pp) * 2;
        const LAS unsigned char* va = lds + u * GL_HEAD + GL_VT + (8 * h2 + q) * GL_VP + (16 * g1 + 4 * pp) * 2;
        bf16* outb = SKV + ((((size_t)b * 64 + n) * 4 + head) * 192) * 96;
        for (int id = j4; id < 18; id += 4) { const int kb = id / 6, cb = id % 6;
            f32x16 acc = f32x16{};
#pragma unroll
            for (int ks = 0; ks < 4; ++ks) {
                const s16x4 a0 = trd(ka + ks * 16 * GL_QP + kb * 64), a1 = trd(ka + ks * 16 * GL_QP + 4 * GL_QP + kb * 64);
                const s16x4 b0 = trd(va + ks * 16 * GL_VP + cb * 64), b1 = trd(va + ks * 16 * GL_VP + 4 * GL_VP + cb * 64);
                acc = __builtin_amdgcn_mfma_f32_32x32x16_bf16((bf16x8){a0[0], a0[1], a0[2], a0[3], a1[0], a1[1], a1[2], a1[3]}, (bf16x8){b0[0], b0[1], b0[2], b0[3], b1[0], b1[1], b1[2], b1[3]}, acc, 0, 0, 0); }
            bf16* op = outb + (size_t)(32 * cb + r32) * 96 + 32 * kb + 8 * h2;
#pragma unroll
            for (int g = 0; g < 4; g += 2) { u32x2 wa, wb; wa.x = cvtpk_s(acc[4 * g], acc[4 * g + 1]); wa.y = cvtpk_s(acc[4 * g + 2], acc[4 * g + 3]); wb.x = cvtpk_s(acc[4 * g + 4], acc[4 * g + 5]); wb.y = cvtpk_s(acc[4 * g + 6], acc[4 * g + 7]);
                *(u32x4*)(op + 8 * g) = pair16(wa, wb); }
        }
        __syncthreads();
        PSEC_END(42);
    }
}
__device__ __forceinline__ void phase_gla_scan(unsigned char* ws, int G, int bid, const int wave_s) {
    bf16* SKV = (bf16*)(ws + WS_GREG); const float* DEC = (const float*)(ws + WS_DEC);
    const int tid = fresh_tid(wave_s);
    constexpr int NITEM = NB * 4 * 192 * 12;
    const int per = (NITEM + G - 1) / G;
    for (int it = tid; it < per; it += NTHREADS) { const int item = bid * per + it; if (item >= NITEM) break;
        const int k8 = item % 12, c = (item / 12) % 192, bh = item / (12 * 192), b = bh >> 2, h = bh & 3;
        float s[8];
#pragma unroll
        for (int j = 0; j < 8; ++j) s[j] = 0.f;
        u32x4* ptr = (u32x4*)(SKV + ((((size_t)b * 64) * 4 + h) * 192 + c) * 96 + 8 * k8); const float* dp = DEC + (((size_t)b * 64) * 4 + h) * 96 + 8 * k8;
#pragma unroll 1
        for (int n0 = 0; n0 < 64; n0 += 8) { u32x4 kv[8]; f32x4 d0[8], d1[8];
#pragma unroll
            for (int i = 0; i < 8; ++i) { kv[i] = ptr[(size_t)(n0 + i) * (4 * 192 * 96 / 8)]; d0[i] = *(const f32x4*)(dp + (size_t)(n0 + i) * 4 * 96); d1[i] = *(const f32x4*)(dp + (size_t)(n0 + i) * 4 * 96 + 4); }
#pragma unroll
            for (int i = 0; i < 8; ++i) { u32x4 o; o.x = cvtpk_s(s[0], s[1]); o.y = cvtpk_s(s[2], s[3]); o.z = cvtpk_s(s[4], s[5]); o.w = cvtpk_s(s[6], s[7]); ptr[(size_t)(n0 + i) * (4 * 192 * 96 / 8)] = o;
                const unsigned kw[4] = {kv[i].x, kv[i].y, kv[i].z, kv[i].w};
#pragma unroll
                for (int j = 0; j < 4; ++j) { const float dlo = j < 2 ? d0[i][2 * j] : d1[i][2 * j - 4], dhi = j < 2 ? d0[i][2 * j + 1] : d1[i][2 * j - 3];
                    s[2 * j] = dlo * s[2 * j] + __uint_as_float(kw[j] << 16); s[2 * j + 1] = dhi * s[2 * j + 1] + __uint_as_float(kw[j] & 0xffff0000u); } } }
    }
}
__device__ __forceinline__ void phase_gla_out(KP p, LAS unsigned char* lds, int G, int bid, const int wave_s) {
    unsigned char* ws = p->ws; const bf16* SKV = (const bf16*)(ws + WS_GREG); const bf16* R = (const bf16*)(ws + WS_HREG + 2 * HR_48); bf16* OC = (bf16*)((unsigned char*)p->out + OUT_HI);
    GlaRegs<1> RG;
    if (bid < NB * 64 * 2) gla_fetch<1>(ws, fresh_tid(wave_s), bid, RG);
    int staged = -1;
    for (int unit = bid; unit < NB * 64 * 2; unit += G) {
        const int tid = fresh_tid(wave_s), lane = tid & 63, wid = wave_s;
        const int hp = unit & 1, n = (unit >> 1) & 63, b = unit >> 7;
        if (hp != staged) { if (staged >= 0) __syncthreads(); gla_stage_w(p, lds, tid, hp); staged = hp; }
        u32x2 rv12[12];
        { const int tb_ = wid & 1, ch_ = (wid >> 1) & 1, head_ = 2 * hp + (wid >> 2); const size_t m_ = (size_t)b * SEQ + n * 64 + 32 * tb_ + (lane & 31);
          const bf16* rp_ = R + m_ * 768 + 192 * head_ + 96 * ch_ + 4 * (lane >> 5);
#pragma unroll
          for (int q = 0; q < 12; ++q) rv12[q] = *(const u32x2*)(rp_ + 32 * (q >> 2) + 8 * (q & 3)); }
        { PSEC_BEGIN(30); gla_put<1>(lds, tid, RG);
        __syncthreads(); PSEC_END(30); }
        if (unit + G < NB * 64 * 2) gla_fetch<1>(ws, tid, unit + G, RG);
        { PSEC_BEGIN(31); gla_gates<1>(p, ws, lds, tid, b, n, hp); PSEC_END(31); }
        PSEC_BEGIN(32);
        const int u = wid >> 2, tb = wid & 1, ch = (wid >> 1) & 1, head = 2 * hp + u, r32 = lane & 31, h2 = lane >> 5, q = (lane & 15) >> 2, pp = lane & 3, g1 = (lane >> 4) & 1;
        const LAS unsigned char* kx = lds + u * GL_HEAD + GL_KX + r32 * GL_QP + 16 * h2;
        const LAS unsigned char* qd = lds + u * GL_HEAD + GL_QD + (32 * tb + r32) * GL_QP + 16 * h2;
        const LAS unsigned char* va = lds + u * GL_HEAD + GL_VT + (4 * h2 + q) * GL_VP + (16 * g1 + 4 * pp) * 2;
        bf16x8 qf[6];
#pragma unroll
        for (int ks = 0; ks < 6; ++ks) qf[ks] = *(const LAS bf16x8*)(qd + 32 * ks);
        f32x16 at0 = f32x16{}, at1 = f32x16{};
#pragma unroll
        for (int ks = 0; ks < 6; ++ks) at0 = __builtin_amdgcn_mfma_f32_32x32x16_bf16(*(const LAS bf16x8*)(kx + 32 * ks), qf[ks], at0, 0, 0, 0);
        if (tb == 1) {
#pragma unroll
            for (int ks = 0; ks < 6; ++ks) at1 = __builtin_amdgcn_mfma_f32_32x32x16_bf16(*(const LAS bf16x8*)(kx + 32 * GL_QP + 32 * ks), qf[ks], at1, 0, 0, 0);
        }
#pragma unroll
        for (int r = 0; r < 16; ++r) { const bool keep = crow(r, h2) <= r32; if (tb == 0) { if (!keep) at0[r] = 0.f; } else { if (!keep) at1[r] = 0.f; } }
        bf16x8 pb[4];
#pragma unroll
        for (int k2 = 0; k2 < 2; ++k2) {
            pb[k2] = __builtin_bit_cast(bf16x8, (u32x4){cvtpk_s(at0[8 * k2], at0[8 * k2 + 1]), cvtpk_s(at0[8 * k2 + 2], at0[8 * k2 + 3]), cvtpk_s(at0[8 * k2 + 4], at0[8 * k2 + 5]), cvtpk_s(at0[8 * k2 + 6], at0[8 * k2 + 7])});
            pb[2 + k2] = __builtin_bit_cast(bf16x8, (u32x4){cvtpk_s(at1[8 * k2], at1[8 * k2 + 1]), cvtpk_s(at1[8 * k2 + 2], at1[8 * k2 + 3]), cvtpk_s(at1[8 * k2 + 4], at1[8 * k2 + 5]), cvtpk_s(at1[8 * k2 + 6], at1[8 * k2 + 7])}); }
        const bf16* sg = SKV + ((((size_t)b * 64 + n) * 4 + head) * 192 + 96 * ch + r32) * 96 + 8 * h2;
        f32x16 o[3];
#pragma unroll
        for (int cbl = 0; cbl < 3; ++cbl) { const int cb = 3 * ch + cbl; f32x16 acc = f32x16{};
#pragma unroll
            for (int kq = 0; kq < 4; ++kq) { if (kq < 2 || tb == 1) {
                const s16x4 a0 = trd(va + kq * 16 * GL_VP + cb * 64), a1 = trd(va + kq * 16 * GL_VP + 8 * GL_VP + cb * 64);
                acc = __builtin_amdgcn_mfma_f32_32x32x16_bf16((bf16x8){a0[0], a0[1], a0[2], a0[3], a1[0], a1[1], a1[2], a1[3]}, pb[kq], acc, 0, 0, 0); } }
#pragma unroll
            for (int ks = 0; ks < 6; ++ks) { const bf16x8 sf = *(const bf16x8*)(sg + (size_t)(32 * cbl) * 96 + 16 * ks);
                acc = __builtin_amdgcn_mfma_f32_32x32x16_bf16(sf, qf[ks], acc, 0, 0, 0); }
            o[cbl] = acc; }
        asm volatile("" : "+v"(o[0]), "+v"(o[1]), "+v"(o[2])); PSEC_END(32);
        PSEC_BEGIN(33);
        float ss = 0.f;
#pragma unroll
        for (int cbl = 0; cbl < 3; ++cbl)
#pragma unroll
            for (int r = 0; r < 16; ++r) ss += o[cbl][r] * o[cbl][r];
        { auto rr = __builtin_amdgcn_permlane32_swap(__float_as_uint(ss), __float_as_uint(ss), false, false); ss = __uint_as_float(rr[0]) + __uint_as_float(rr[1]); }
        LAS float* ssx = (LAS float*)(lds + GL_SSX);
        if (h2 == 0) ssx[((u * 2 + tb) * 2 + ch) * 32 + r32] = ss;
        __syncthreads();
        ss += ssx[((u * 2 + tb) * 2 + (ch ^ 1)) * 32 + r32];
        const float rs = rsqrtf(ss * (1.f / 192.f) + RMS_EPS);
        const size_t m = (size_t)b * SEQ + n * 64 + 32 * tb + r32;
        bf16* op = OC + m * D + 192 * head + 96 * ch + 8 * h2; const LAS float* gp = (const LAS float*)(lds + GL_WT) + 3264 + 96 * ch + 4 * h2;
#pragma unroll
        for (int cbl = 0; cbl < 3; ++cbl)
#pragma unroll
            for (int g = 0; g < 4; g += 2) { u32x2 wp[2];
#pragma unroll
                for (int e = 0; e < 2; ++e) { const int co = 32 * cbl + 8 * (g + e); const u32x2 rv = rv12[4 * cbl + g + e]; const f32x4 gn = *(const LAS f32x4*)(gp + co);
                    const float r0 = __uint_as_float(rv.x << 16), r1 = __uint_as_float(rv.x & 0xffff0000u), r2 = __uint_as_float(rv.y << 16), r3 = __uint_as_float(rv.y & 0xffff0000u);
                    const float v0 = o[cbl][4 * (g + e)] * rs * gn[0] * (r0 * __builtin_amdgcn_rcpf(1.f + __expf(-r0))), v1 = o[cbl][4 * (g + e) + 1] * rs * gn[1] * (r1 * __builtin_amdgcn_rcpf(1.f + __expf(-r1)));
                    const float v2 = o[cbl][4 * (g + e) + 2] * rs * gn[2] * (r2 * __builtin_amdgcn_rcpf(1.f + __expf(-r2))), v3 = o[cbl][4 * (g + e) + 3] * rs * gn[3] * (r3 * __builtin_amdgcn_rcpf(1.f + __expf(-r3)));
                    wp[e].x = cvtpk_s(v0, v1); wp[e].y = cvtpk_s(v2, v3); }
                *(u32x4*)(op + 32 * cbl + 8 * g) = pair16(wp[0], wp[1]); }
        __syncthreads();
        PSEC_END(33);
    }
}
constexpr int PROBE_J = -1, PROBE_B = 0, PROBE_K = 4;
__global__ void __launch_bounds__(NTHREADS, 2) mega(Params p_unused) {
    extern __shared__ __attribute__((aligned(16))) unsigned char lds_raw[];
    LAS unsigned char* lds = (LAS unsigned char*)lds_raw;
    const int G = gridDim.x, bid = blockIdx.x; const int wave_s = __builtin_amdgcn_readfirstlane(threadIdx.x >> 6);
    volatile LAS unsigned* MISC = (volatile LAS unsigned*)(lds + MISC_OFF);
    if (threadIdx.x < 64) MISC[threadIdx.x] = 0u;
    __syncthreads();
    KP p = fresh_kp();
    unsigned char* ws = p->ws;
    volatile LAS unsigned* STAMPS = (volatile LAS unsigned*)(lds + ROWTOK_OFF + 6144);
    if (PROBE_J >= 0 && threadIdx.x == 0) { const unsigned long long t_ = __builtin_amdgcn_s_memrealtime(); STAMPS[0] = (unsigned)t_; STAMPS[1] = (unsigned)(t_ >> 32); }
    if (PROBE_SEC >= 0 && threadIdx.x == 0) *(volatile LAS unsigned*)(lds + PSEC_OFF) = 0u;
    XcdBarrier bar = xcd_barrier_post((unsigned*)(ws + WS_CTL) + CW_BAR + p->bar_li * XCD_BAR_WORDS, MISC + 8);
#define WS (fresh_kp()->ws)
#define IN(k) ({ KP _q = fresh_kp(); const bool _r = _q->ph_lo <= (k) && (k) < _q->ph_hi; _r; })
#define SEAM(k) do { if (IN(k) && IN((k) + 1)) xcd_barrier(bar); if (PROBE_J >= 0 && threadIdx.x == 0) { const unsigned long long t_ = __builtin_amdgcn_s_memrealtime(); STAMPS[2 * ((k) + 1)] = (unsigned)t_; STAMPS[2 * ((k) + 1) + 1] = (unsigned)(t_ >> 32); } } while (0)

    if (IN(0)) { phase_prologue(fresh_kp(), lds, G, bid, wave_s); }
    SEAM(0);
    if (IN(1)) { unsigned char* wsl = WS;
        { TileOrder S; S.init(wsl + WS_XB, wsl + WS_WA, NTOK, 2560, D, G, bid);
          EpiInA E{(bf16*)(wsl + WS_HREG), (bf16*)(wsl + WS_HREG + HR_48), (bf16*)(wsl + WS_HREG + 2 * HR_48), (bf16*)(wsl + WS_HREG + 3 * HR_48)};
          gemm_phase<41>(lds + RING_OFF, D, S, E, wave_s); }
    }
    SEAM(1);
    if (IN(2)) phase_gla_kv(fresh_kp(), lds, G, bid, wave_s);
    SEAM(2);
    if (IN(3)) { unsigned char* wsl = WS;
        if (G > 32 && bid < 16) { TileOrder S; S.init(wsl + WS_MEMB, wsl + WS_WMKV, NB * NMEM, 512, D, 16, bid);
            EpiPlain E{(bf16*)(wsl + WS_MKV), 1024};
            gemm_phase(lds + RING_OFF, D, S, E, wave_s); }
        else { phase_gla_scan(wsl, G > 32 ? G - 16 : G, G > 32 ? bid - 16 : bid, wave_s); __syncthreads(); if (G > 32) convert_from_queue(fresh_kp(), lds, wave_s, -1, CW_CVQA, CV_A_STATIC, CV_QA); }
        if (G <= 32) { TileOrder S; S.init(wsl + WS_MEMB, wsl + WS_WMKV, NB * NMEM, 512, D, G, bid); EpiPlain E{(bf16*)(wsl + WS_MKV), 1024}; gemm_phase(lds + RING_OFF, D, S, E, wave_s); } }
    SEAM(3);
    if (IN(4)) { phase_gla_out(fresh_kp(), lds, G, bid, wave_s); unsigned char* wsl = WS; { PSEC_BEGIN(45); phase_attn_mem(wsl, (unsigned char*)fresh_kp()->out + OUT_HI, lds, 0, G, bid, wave_s); PSEC_END(45); } }
    SEAM(4);
        if (IN(5)) { unsigned char* wsl = WS;
            KP q = fresh_kp();
            TileOrder S; S.init((unsigned char*)q->out + OUT_HI, wsl + WS_WO + (size_t)0 * D * D * 2, NTOK, D, D, G, bid);
            EpiRes<true> E{(const void*)(wsl + WS_XB), (bf16*)q->out};
            gemm_phase<42>(lds + RING_OFF, D, S, E, wave_s);
        }
        SEAM(5);
        if (IN(5 + 1)) { phase_ln_router(fresh_kp(), 0, lds, G, bid, wave_s); convert_from_queue(fresh_kp(), lds, wave_s, -1, CW_CVQA, CV_A_STATIC, CV_QA); }
        SEAM(5 + 1);
        if (IN(5 + 2)) { unsigned char* wsl = WS;
            const int nu = moe_setup(wsl, lds, G, bid, wave_s, true);
            MoeGU S{(const char*)(wsl + WS_XB), (const char*)(wsl + WS_WGU) + (size_t)0 * NEXP * 1024 * D * 2, (LAS const int*)(lds + MISC_OFF) + 16, (LAS const int*)(lds + ROWTOK_OFF), nu};
            EpiGateUp E{(bf16*)(wsl + WS_GREG)};
            gemm_phase<43>(lds + RING_OFF, D, S, E, wave_s);
            if (nu * G < (int)__builtin_amdgcn_readfirstlane(((volatile LAS int*)(lds + MISC_OFF))[16 + 25])) convert_from_queue(fresh_kp(), lds, wave_s, 4);
        }
        SEAM(5 + 2);
        if (IN(5 + 3)) { unsigned char* wsl = WS;
            const int nu = IN(5 + 2) ? (int)__builtin_amdgcn_readfirstlane(((volatile LAS int*)(lds + MISC_OFF))[16 + 24]) : moe_setup(wsl, lds, G, bid, wave_s, false);
            MoeDown S{(const char*)(wsl + WS_GREG), (const char*)(wsl + WS_WD) + (size_t)0 * NEXP * 1024 * DEXP * 2, (LAS const int*)(lds + MISC_OFF) + 16, nu};
            EpiPlain E{(bf16*)(wsl + WS_HREG), 1024};
            gemm_phase<44>(lds + RING_OFF, DEXP, S, E, wave_s);
            if (nu * G < (int)__builtin_amdgcn_readfirstlane(((volatile LAS int*)(lds + MISC_OFF))[16 + 25])) convert_from_queue(fresh_kp(), lds, wave_s, 2);
        }
        SEAM(5 + 3);
        if (IN(5 + 4)) phase_ln_ffn(fresh_kp(), 0, lds, G, bid, wave_s);

            SEAM(9);
            if (IN(10)) { unsigned char* wsl = WS;
                KP q = fresh_kp();
                TileOrder S; S.init(wsl + WS_XB, wsl + WS_WB, NTOK, 3328, D, G, bid);
                EpiInB E{(bf16*)(wsl + WS_HREG), (bf16*)(wsl + WS_HREG + HR_48), (bf16*)(wsl + WS_HREG + 2 * HR_48), (bf16*)(wsl + WS_HREG + 3 * HR_48), (bf16*)(wsl + WS_HREG + 4 * HR_48), q->in[I_QNG], q->in[I_KNG]};
                gemm_phase<45>(lds + RING_OFF, D, S, E, wave_s);
                {
                    const int c2 = (G >= 160) ? bid - 128 : bid; const int G2 = (G >= 160) ? 16 : G;
                    if (c2 >= 0 && c2 < G2) { TileOrder S2; S2.init(wsl + WS_MEMB, wsl + WS_WMKV + (size_t)512 * D * 2, NB * NMEM, 512, D, G2, c2);
                        EpiPlain E2{(bf16*)(wsl + WS_MKV) + 512, 1024};
                        gemm_phase(lds + RING_OFF, D, S2, E2, wave_s); } }
                if (G == 256 && bid >= 144 && bid < 244) convert_from_queue(fresh_kp(), lds, wave_s, 4);
                const int gwr = (G - 1 - bid) * NWAVES + wave_s;
                if (gwr < NB * FOX_H) cum_wave((const float*)(wsl + WS_LOGF), (float*)(wsl + WS_CUM), gwr, fresh_lane());
            }
            SEAM(10);
            if (IN(11)) phase_attn_b(fresh_kp(), lds, wave_s);
            SEAM(11);
        if (IN(12)) { unsigned char* wsl = WS;
            KP q = fresh_kp();
            TileOrder S; S.init(wsl + WS_GREG, wsl + WS_WO + (size_t)1 * D * D * 2, NTOK, D, D, G, bid);
            EpiRes<true> E{(const void*)(wsl + WS_XB), (bf16*)q->out};
            gemm_phase<46>(lds + RING_OFF, D, S, E, wave_s);
        }
        SEAM(12);
        if (IN(12 + 1)) { phase_ln_router(fresh_kp(), 1, lds, G, bid, wave_s); convert_from_queue(fresh_kp(), lds, wave_s, -1); }
        SEAM(12 + 1);
        if (IN(12 + 2)) { unsigned char* wsl = WS;
            const int nu = moe_setup(wsl, lds, G, bid, wave_s, true);
            MoeGU S{(const char*)(wsl + WS_XB), (const char*)(wsl + WS_WGU) + (size_t)1 * NEXP * 1024 * D * 2, (LAS const int*)(lds + MISC_OFF) + 16, (LAS const int*)(lds + ROWTOK_OFF), nu};
            EpiGateUp E{(bf16*)(wsl + WS_GREG)};
            gemm_phase<47>(lds + RING_OFF, D, S, E, wave_s);
        }
        SEAM(12 + 2);
        if (IN(12 + 3)) { unsigned char* wsl = WS;
            const int nu = IN(12 + 2) ? (int)__builtin_amdgcn_readfirstlane(((volatile LAS int*)(lds + MISC_OFF))[16 + 24]) : moe_setup(wsl, lds, G, bid, wave_s, false);
            MoeDown S{(const char*)(wsl + WS_GREG), (const char*)(wsl + WS_WD) + (size_t)1 * NEXP * 1024 * DEXP * 2, (LAS const int*)(lds + MISC_OFF) + 16, nu};
            EpiPlain E{(bf16*)(wsl + WS_HREG), 1024};
            gemm_phase<48>(lds + RING_OFF, DEXP, S, E, wave_s);
        }
        SEAM(12 + 3);
        if (IN(12 + 4)) phase_ln_ffn(fresh_kp(), 1, lds, G, bid, wave_s);
        SEAM(16);
    if (PROBE_J >= 0 && blockIdx.x == 0 && threadIdx.x == 0) {
        const unsigned long long t1 = ((unsigned long long)STAMPS[2 * PROBE_B + 1] << 32) | STAMPS[2 * PROBE_B], t0 = ((unsigned long long)STAMPS[2 * PROBE_J + 1] << 32) | STAMPS[2 * PROBE_J];
        const unsigned long long wait = (t1 - t0) * PROBE_K, ts = __builtin_amdgcn_s_memrealtime();
        while (__builtin_amdgcn_s_memrealtime() - ts < wait) __builtin_amdgcn_s_sleep(8);
    }
    if (PROBE_SEC >= 0 && blockIdx.x == 0 && threadIdx.x == 0) {
        const unsigned long long wait = (unsigned long long)(*(volatile LAS unsigned*)(lds + PSEC_OFF)) * PROBE_K, ts = __builtin_amdgcn_s_memrealtime();
        while (__builtin_amdgcn_s_memrealtime() - ts < wait) __builtin_amdgcn_s_sleep(8);
    }
#undef IN
#undef SEAM
#undef WS
}
#undef LAS
#undef GAS
}

static int pk_grid() {
    static int grid = 0;
    if (grid == 0) {
        int dev = 0, cus = 0;
        if (hipGetDevice(&dev) != hipSuccess || hipDeviceGetAttribute(&cus, hipDeviceAttributeMultiprocessorCount, dev) != hipSuccess) { grid = -1; return grid; }
        if (hipFuncSetAttribute((const void*)pk::mega, hipFuncAttributeMaxDynamicSharedMemorySize, pk::LDS_BYTES) != hipSuccess) { fprintf(stderr, "kernel_launch: hipFuncSetAttribute failed\n"); grid = -1; return grid; }
        int per_cu = 0;
        if (hipOccupancyMaxActiveBlocksPerMultiprocessor(&per_cu, (const void*)pk::mega, pk::NTHREADS, pk::LDS_BYTES) != hipSuccess || per_cu < 1) fprintf(stderr, "kernel_launch: occupancy query says %d\n", per_cu);
        (void)hipGetLastError();
        grid = cus;
    }
    return grid;
}
static void pk_launch(pk::Params& P, int lo, int hi, hipStream_t stream) {
    const int grid = pk_grid(); if (grid <= 0) return;
    P.ph_lo = lo; P.ph_hi = hi; P.bar_li += 1;
    hipLaunchKernelGGL(pk::mega, dim3(grid), dim3(pk::NTHREADS), pk::LDS_BYTES, stream, P);
}
extern "C" void kernel_launch(void* const* d_in, const int* in_sizes, int n_in, void* d_out, int out_size, void* d_ws, size_t ws_size, hipStream_t stream) {
    if (n_in != 22 || out_size != NTOK * D || ws_size < WS_END) { fprintf(stderr, "kernel_launch: unexpected shapes (n_in %d out %d ws %zu)\n", n_in, out_size, ws_size); return; }
    const float* w_gate_up = (const float*)d_in[3]; const float* b_gate = (const float*)d_in[4]; const float* gla_g = (const float*)d_in[5];
    const float* w_eg = (const float*)d_in[19]; const float* w_eu = (const float*)d_in[20]; const float* w_ed = (const float*)d_in[21];
    unsigned char* ws = (unsigned char*)d_ws;
    float* GLR = (float*)(ws + WS_GLR); float* CUM = (float*)(ws + WS_CUM);
    bf16* MKV = (bf16*)(ws + WS_MKV);
    int* TOK_E = (int*)(ws + WS_TOKE); int* TOK_S = (int*)(ws + WS_TOKS);
    bf16* XB = (bf16*)(ws + WS_XB); bf16* YS = (bf16*)(ws + WS_HREG);
    bf16* T0 = (bf16*)(ws + WS_HREG), *T1 = (bf16*)(ws + WS_HREG + HR_48), *T2 = (bf16*)(ws + WS_HREG + 2 * HR_48), *T3 = (bf16*)(ws + WS_HREG + 3 * HR_48), *T4 = (bf16*)(ws + WS_HREG + 4 * HR_48);
    (void)hipMemsetAsync(ws + WS_CTL, 0, CTL_ZERO_BYTES, stream);
    pk::Params P{}; for (int i = 0; i < 22; ++i) P.in[i] = (const float*)d_in[i]; P.out = (float*)d_out; P.ws = ws; P.bar_li = -1;
    pk_launch(P, 0, 17, stream);
}
```
